# Optimizing an MI355X kernel written in HIP

```python
import jax, jax.numpy as jnp
from jax import lax
import numpy as np


D_MODEL = 2048
BATCH = 4
SEQ = 2048
DEPTH = 4

RET_HEADS = 4
RET_DK = 64
RET_DV = 128
RET_CHUNK = 128
ROPE_BASE = 10000.0
SGU_GROUPS = 4
SGU_DIM = 128
SGU_CHUNK = 128
NSA_HEADS = 16
NSA_GROUPS = 4
NSA_HPG = NSA_HEADS // NSA_GROUPS
NSA_DK = 64
CMP_LEN = 32
CMP_STRIDE = 16
CMP_HIDDEN = 256
SEL_LEN = 64
SEL_TOPN = 8
WINDOW = 512
Q_BLOCK = 128
PEER_HEADS = 8
PEER_NKEYS = 128
PEER_EXPERTS = PEER_NKEYS * PEER_NKEYS
PEER_QDIM = 256
PEER_HALF = PEER_QDIM // 2
PEER_TOPK = 16
PEER_CHUNK = 128

RET_W = RET_HEADS * RET_DV
SGU_W = SGU_GROUPS * SGU_DIM
NSA_W = NSA_HEADS * NSA_DK
NSA_KV = NSA_GROUPS * NSA_DK
MIX_W = RET_W + SGU_W + NSA_W
IN_WIDTHS = (RET_HEADS * RET_DK, RET_HEADS * RET_DK, RET_W, RET_W, SGU_W, SGU_W, NSA_W, NSA_KV, NSA_KV, NSA_KV, NSA_KV, NSA_KV, NSA_KV, NSA_HEADS * 3)
IN_W = sum(IN_WIDTHS)

DEEPNORM_ALPHA = (2 * DEPTH) ** 0.25
DEEPNORM_BETA = (8 * DEPTH) ** -0.25
LN_EPS = 1e-5
NEG_INF = -1e9
FORCE_SCORE = 1e6

kernel_name = 'hybrid_retention_gmlp_nsa_peer_deepnorm'


def _layer_norm(x, g, b):
    xf = x.astype(jnp.float32)
    mu = jnp.mean(xf, -1, keepdims=True)
    var = jnp.mean(jnp.square(xf - mu), -1, keepdims=True)
    return (xf - mu) * lax.rsqrt(var + LN_EPS) * g + b


def _rms_normalize(y):
    yf = y.astype(jnp.float32)
    return yf * lax.rsqrt(jnp.mean(jnp.square(yf), -1, keepdims=True) + LN_EPS)


def _rotate(x, pos):
    half = x.shape[-1] // 2
    inv = ROPE_BASE ** (-jnp.arange(half, dtype=jnp.float32) / half)
    ang = pos.astype(jnp.float32)[:, None] * inv[None, :]
    cos = jnp.cos(ang)[None, :, None, :]
    sin = jnp.sin(ang)[None, :, None, :]
    x1, x2 = x[..., :half], x[..., half:]
    return jnp.concatenate([x1 * cos - x2 * sin, x1 * sin + x2 * cos], -1)


def _retention(q, k, v, g, gn_g, gn_b):
    B, T = q.shape[:2]
    pos = jnp.arange(T)
    q = _rotate(q.astype(jnp.float32), pos)
    k = _rotate(k.astype(jnp.float32), pos) * (RET_DK ** -0.5)
    v = v.astype(jnp.float32)
    gamma = 1.0 - 2.0 ** (-5.0 - jnp.arange(RET_HEADS, dtype=jnp.float32))
    lg = jnp.log(gamma)
    n = jnp.arange(RET_CHUNK, dtype=jnp.float32)
    diff = n[:, None] - n[None, :]
    d_in = jnp.where(diff[None] >= 0, jnp.exp(lg[:, None, None] * jnp.maximum(diff, 0.0)[None]), 0.0)
    xi = jnp.exp(lg[:, None] * (n[None, :] + 1.0))
    zeta = jnp.exp(lg[:, None] * (RET_CHUNK - 1.0 - n[None, :]))
    g_chunk = jnp.exp(lg * RET_CHUNK)
    nc = T // RET_CHUNK

    def to_chunks(a):
        return a.reshape(B, nc, RET_CHUNK, RET_HEADS, a.shape[-1]).transpose(1, 0, 3, 2, 4)

    def step(state, inp):
        qi, ki, vi = inp
        att = jnp.einsum('bhnd,bhmd->bhnm', qi, ki) * d_in[None]
        inner = jnp.einsum('bhnm,bhme->bhne', att, vi)
        cross = jnp.einsum('bhnd,bhde->bhne', qi, state) * xi[None, :, :, None]
        state = state * g_chunk[None, :, None, None] + jnp.einsum('bhmd,bhme->bhde', ki * zeta[None, :, :, None], vi)
        return state, inner + cross

    s0 = jnp.zeros((B, RET_HEADS, RET_DK, RET_DV), jnp.float32)
    _, y = lax.scan(step, s0, (to_chunks(q), to_chunks(k), to_chunks(v)))
    y = y.transpose(1, 0, 3, 2, 4).reshape(B, T, RET_HEADS, RET_DV)
    mu = jnp.mean(y, -1, keepdims=True)
    var = jnp.mean(jnp.square(y - mu), -1, keepdims=True)
    y = ((y - mu) * lax.rsqrt(var + LN_EPS)).reshape(B, T, RET_W) * gn_g + gn_b
    return jax.nn.silu(g.astype(jnp.float32)) * y


def _spatial_gating(u, v, ln_g, ln_b, w_s, b_s):
    B, T = u.shape[:2]
    nc = T // SGU_CHUNK
    v = _layer_norm(v.reshape(B, T, SGU_GROUPS, SGU_DIM), ln_g.reshape(SGU_GROUPS, SGU_DIM), ln_b.reshape(SGU_GROUPS, SGU_DIM))
    v = v.reshape(B, nc, SGU_CHUNK, SGU_GROUPS, SGU_DIM)
    causal = jnp.tril(jnp.ones((SGU_CHUNK, SGU_CHUNK), jnp.float32))
    w = w_s.astype(jnp.float32) * causal[None]
    s = jnp.einsum('gts,bcsgd->bctgd', w, v) + b_s.T.astype(jnp.float32)[None, None, :, :, None]
    return u.astype(jnp.float32) * s.reshape(B, T, SGU_W)


def _compress(k, pe, w1, w2):
    B, G, T, dk = k.shape
    nseg = T // CMP_STRIDE
    r = CMP_LEN // CMP_STRIDE
    nc = nseg - r + 1
    seg = k.reshape(B, G, nseg, CMP_STRIDE, dk)
    blk = jnp.concatenate([seg[:, :, j:j + nc] for j in range(r)], axis=3) + pe
    hid = jax.nn.gelu(blk.reshape(B, G, nc, CMP_LEN * dk) @ w1)
    return hid @ w2


def _nsa(q, k_cmp, v_cmp, k_slc, v_slc, k_win, v_win, gate, pe_k, w1_k, w2_k, pe_v, w1_v, w2_v):
    B, T = q.shape[:2]
    G, H, dk = NSA_GROUPS, NSA_HPG, NSA_DK
    scale = dk ** -0.5
    qh = q.reshape(B, T, G, H, dk).transpose(0, 2, 3, 1, 4)

    def kv(a):
        return a.reshape(B, T, G, dk).transpose(0, 2, 1, 3)

    t = jnp.arange(T)

    kc = _compress(kv(k_cmp), pe_k, w1_k, w2_k)
    vc = _compress(kv(v_cmp), pe_v, w1_v, w2_v)
    ncmp = kc.shape[2]
    cmp_start = jnp.arange(ncmp) * CMP_STRIDE
    cmask = (cmp_start[None, :] + CMP_LEN - 1) <= t[:, None]
    s = jnp.einsum('bghtd,bgcd->bghtc', qh, kc).astype(jnp.float32) * scale
    p_cmp = jnp.where(cmask, jax.nn.softmax(jnp.where(cmask, s, NEG_INF), -1), 0.0)
    o_cmp = jnp.einsum('bghtc,bgcd->bghtd', p_cmp, vc.astype(jnp.float32))

    nsel = T // SEL_LEN
    topn = min(SEL_TOPN, nsel)
    sel_start = jnp.arange(nsel) * SEL_LEN
    overlap = ((cmp_start[:, None] < sel_start[None, :] + SEL_LEN) & (cmp_start[:, None] + CMP_LEN > sel_start[None, :])).astype(jnp.float32)
    imp = jnp.einsum('bghtc,cj->bgtj', p_cmp, overlap)
    jj = jnp.arange(nsel)[None, :]
    cur = (t // SEL_LEN)[:, None]
    forced = (jj == 0) | (jj == cur) | (jj == cur - 1)
    causal_blk = sel_start[None, :] <= t[:, None]
    imp = jnp.where(causal_blk, jnp.where(forced, FORCE_SCORE, imp), NEG_INF)
    _, idx = lax.top_k(imp, topn)
    kb = kv(k_slc).reshape(B, G, nsel, SEL_LEN, dk)
    vb = kv(v_slc).reshape(B, G, nsel, SEL_LEN, dk)
    nq = T // Q_BLOCK
    q_blocks = qh.reshape(B, G, H, nq, Q_BLOCK, dk).transpose(3, 0, 1, 2, 4, 5)
    idx_blocks = idx.reshape(B, G, nq, Q_BLOCK, topn).transpose(2, 0, 1, 3, 4)
    t_blocks = t.reshape(nq, Q_BLOCK)
    bi = jnp.arange(B)[:, None, None, None]
    gi = jnp.arange(G)[None, :, None, None]

    def sel_block(args):
        qb, ib, tb = args
        kg = kb[bi, gi, ib]
        vg = vb[bi, gi, ib]
        sc = jnp.einsum('bghqd,bgqnld->bghqnl', qb, kg).astype(jnp.float32) * scale
        kpos = ib[..., None] * SEL_LEN + jnp.arange(SEL_LEN)
        m = (kpos <= tb[None, None, :, None, None])[:, :, None]
        sc = jnp.where(m, sc, NEG_INF)
        shp = sc.shape
        pr = jax.nn.softmax(sc.reshape(shp[0], shp[1], shp[2], shp[3], -1), -1).reshape(shp)
        return jnp.einsum('bghqnl,bgqnld->bghqd', pr, vg.astype(jnp.float32))

    o_sel = lax.map(sel_block, (q_blocks, idx_blocks, t_blocks))
    o_sel = o_sel.transpose(1, 2, 3, 0, 4, 5).reshape(B, G, H, T, dk)

    npad = WINDOW // Q_BLOCK
    nkeys = (npad + 1) * Q_BLOCK
    kp = jnp.pad(kv(k_win), ((0, 0), (0, 0), (WINDOW, 0), (0, 0))).reshape(B, G, nq + npad, Q_BLOCK, dk)
    vp = jnp.pad(kv(v_win), ((0, 0), (0, 0), (WINDOW, 0), (0, 0))).reshape(B, G, nq + npad, Q_BLOCK, dk)
    kband = jnp.concatenate([kp[:, :, j:j + nq] for j in range(npad + 1)], axis=3)
    vband = jnp.concatenate([vp[:, :, j:j + nq] for j in range(npad + 1)], axis=3)
    qw = qh.reshape(B, G, H, nq, Q_BLOCK, dk)
    sw = jnp.einsum('bghnqd,bgnkd->bghnqk', qw, kband).astype(jnp.float32) * scale
    qpos = jnp.arange(nq)[:, None] * Q_BLOCK + jnp.arange(Q_BLOCK)[None, :]
    kpos = jnp.arange(nq)[:, None] * Q_BLOCK - WINDOW + jnp.arange(nkeys)[None, :]
    dist = qpos[:, :, None] - kpos[:, None, :]
    wmask = (dist >= 0) & (dist < WINDOW) & (kpos[:, None, :] >= 0)
    pw = jax.nn.softmax(jnp.where(wmask, sw, NEG_INF), -1)
    o_win = jnp.einsum('bghnqk,bgnkd->bghnqd', pw, vband.astype(jnp.float32)).reshape(B, G, H, T, dk)

    gt = jax.nn.sigmoid(gate.astype(jnp.float32)).reshape(B, T, G, H, 3).transpose(0, 2, 3, 1, 4)
    o = gt[..., 0:1] * o_cmp + gt[..., 1:2] * o_sel + gt[..., 2:3] * o_win
    return o.transpose(0, 3, 1, 2, 4).reshape(B, T, NSA_W)


def _peer(x, wq, k1, k2, u_tab, v_tab):
    B, T, D = x.shape
    ntok = B * T
    xf = x.reshape(ntok, D)
    q = (xf @ wq).reshape(ntok, PEER_HEADS, 2, PEER_HALF)
    s1 = jnp.einsum('nhd,hkd->nhk', q[:, :, 0], k1).astype(jnp.float32)
    s2 = jnp.einsum('nhd,hkd->nhk', q[:, :, 1], k2).astype(jnp.float32)
    v1, i1 = lax.top_k(s1, PEER_TOPK)
    v2, i2 = lax.top_k(s2, PEER_TOPK)
    cand = (v1[..., :, None] + v2[..., None, :]).reshape(ntok, PEER_HEADS, PEER_TOPK * PEER_TOPK)
    sc, ci = lax.top_k(cand, PEER_TOPK)
    e = jnp.take_along_axis(i1, ci // PEER_TOPK, -1) * PEER_NKEYS + jnp.take_along_axis(i2, ci % PEER_TOPK, -1)
    gw = jax.nn.softmax(sc, -1)
    nch = ntok // PEER_CHUNK

    def chunk(args):
        xc, ec, gc = args
        ue = u_tab[ec]
        hact = jax.nn.gelu(jnp.einsum('nd,nhkd->nhk', xc, ue).astype(jnp.float32))
        return jnp.einsum('nhk,nhkd->nd', (gc * hact).astype(v_tab.dtype), v_tab[ec])

    out = lax.map(chunk, (xf.reshape(nch, PEER_CHUNK, D), e.reshape(nch, PEER_CHUNK, PEER_HEADS, PEER_TOPK), gw.reshape(nch, PEER_CHUNK, PEER_HEADS, PEER_TOPK)))
    return out.reshape(B, T, D).astype(x.dtype)


def setup_inputs(seed: int = 0) -> dict:
    key = jax.random.key(seed)
    ks = jax.random.split(key, 32)
    L = DEPTH

    def nrm(k, shape, std):
        return jax.random.normal(k, shape, jnp.float32) * std

    return {
        'x': nrm(ks[0], (BATCH, SEQ, D_MODEL), 1.0),
        'w_in': nrm(ks[1], (L, D_MODEL, IN_W), D_MODEL ** -0.5),
        'ret_gn_g': 1.0 + nrm(ks[2], (L, RET_W), 0.02),
        'ret_gn_b': nrm(ks[3], (L, RET_W), 0.02),
        'sgu_ln_g': 1.0 + nrm(ks[4], (L, SGU_W), 0.02),
        'sgu_ln_b': nrm(ks[5], (L, SGU_W), 0.02),
        'sgu_w': nrm(ks[6], (L, SGU_GROUPS, SGU_CHUNK, SGU_CHUNK), SGU_CHUNK ** -0.5),
        'sgu_b': 1.0 + nrm(ks[7], (L, SGU_GROUPS, SGU_CHUNK), 0.02),
        'cmp_pe_k': nrm(ks[8], (L, CMP_LEN, NSA_DK), 0.02),
        'cmp_w1_k': nrm(ks[9], (L, CMP_LEN * NSA_DK, CMP_HIDDEN), (CMP_LEN * NSA_DK) ** -0.5),
        'cmp_w2_k': nrm(ks[10], (L, CMP_HIDDEN, NSA_DK), CMP_HIDDEN ** -0.5),
        'cmp_pe_v': nrm(ks[11], (L, CMP_LEN, NSA_DK), 0.02),
        'cmp_w1_v': nrm(ks[12], (L, CMP_LEN * NSA_DK, CMP_HIDDEN), (CMP_LEN * NSA_DK) ** -0.5),
        'cmp_w2_v': nrm(ks[13], (L, CMP_HIDDEN, NSA_DK), CMP_HIDDEN ** -0.5),
        'mix_norm_g': 1.0 + nrm(ks[14], (L, MIX_W), 0.02),
        'w_out': nrm(ks[15], (L, MIX_W, D_MODEL), (MIX_W ** -0.5) * DEEPNORM_BETA),
        'ln1_g': 1.0 + nrm(ks[16], (L, D_MODEL), 0.02),
        'ln1_b': nrm(ks[17], (L, D_MODEL), 0.02),
        'peer_wq': nrm(ks[18], (L, D_MODEL, PEER_HEADS * PEER_QDIM), D_MODEL ** -0.5),
        'peer_k1': nrm(ks[19], (L, PEER_HEADS, PEER_NKEYS, PEER_HALF), PEER_HALF ** -0.5),
        'peer_k2': nrm(ks[20], (L, PEER_HEADS, PEER_NKEYS, PEER_HALF), PEER_HALF ** -0.5),
        'peer_u': nrm(ks[21], (L, PEER_EXPERTS, D_MODEL), D_MODEL ** -0.5),
        'peer_v': nrm(ks[22], (L, PEER_EXPERTS, D_MODEL), DEEPNORM_BETA * PEER_HEADS ** -0.5),
        'ln2_g': 1.0 + nrm(ks[23], (L, D_MODEL), 0.02),
        'ln2_b': nrm(ks[24], (L, D_MODEL), 0.02),
    }


def reference(x, w_in, ret_gn_g, ret_gn_b, sgu_ln_g, sgu_ln_b, sgu_w, sgu_b, cmp_pe_k, cmp_w1_k, cmp_w2_k, cmp_pe_v, cmp_w1_v, cmp_w2_v, mix_norm_g, w_out, ln1_g, ln1_b, peer_wq, peer_k1, peer_k2, peer_u, peer_v, ln2_g, ln2_b):
    B, T, _ = x.shape
    offsets = [int(o) for o in np.cumsum(IN_WIDTHS)[:-1]]
    for l in range(DEPTH):
        h = x @ w_in[l]
        rq, rk, rv, rg, su, sv, nq_, kc, vc, ksl, vsl, kw, vw, ng = jnp.split(h, offsets, axis=-1)
        y_ret = _retention(rq.reshape(B, T, RET_HEADS, RET_DK), rk.reshape(B, T, RET_HEADS, RET_DK), rv.reshape(B, T, RET_HEADS, RET_DV), rg, ret_gn_g[l], ret_gn_b[l])
        y_sgu = _spatial_gating(jax.nn.gelu(su), jax.nn.gelu(sv), sgu_ln_g[l], sgu_ln_b[l], sgu_w[l], sgu_b[l])
        y_nsa = _nsa(nq_, kc, vc, ksl, vsl, kw, vw, ng, cmp_pe_k[l], cmp_w1_k[l], cmp_w2_k[l], cmp_pe_v[l], cmp_w1_v[l], cmp_w2_v[l])
        mixed = jnp.concatenate([_rms_normalize(y_ret), _rms_normalize(y_sgu), _rms_normalize(y_nsa)], -1) * mix_norm_g[l]
        x = _layer_norm(DEEPNORM_ALPHA * x + mixed.astype(x.dtype) @ w_out[l], ln1_g[l], ln1_b[l]).astype(x.dtype)
        x = _layer_norm(DEEPNORM_ALPHA * x + _peer(x, peer_wq[l], peer_k1[l], peer_k2[l], peer_u[l], peer_v[l]), ln2_g[l], ln2_b[l]).astype(x.dtype)
    return x
```

```cpp
#include <hip/hip_runtime.h>
#include <cstdio>
#include <cstdint>
#include <cmath>
#define LAS __attribute__((address_space(3)))
namespace pg8 {
#define PG8_LAS __attribute__((address_space(3)))
typedef unsigned short bf16_t;
typedef short bf16x8 __attribute__((ext_vector_type(8)));
typedef float f32x4 __attribute__((ext_vector_type(4)));
typedef unsigned u32x4 __attribute__((ext_vector_type(4)));
constexpr int BM = 256, BK = 64, HALF = 128, HTB = HALF * BK * 2  , STAGE_BYTES = 8 * HTB, NXCD = 8, WGM = 8;

__host__ __device__ __forceinline__ int lds_byte(int r, int c) { const int st = (r >> 4) * 2 + (c >> 5), rr = r & 15, cc = c & 31, ob = rr * 64 + cc * 2; return st * 1024 + (ob ^ (((ob >> 9) & 1) << 5)); }
__host__ __device__ __forceinline__ void stage_rc(int b, int& R, int& C) { const int st = b / 1024, sb = b % 1024, swz = sb ^ (((sb >> 9) & 1) << 5); R = (st >> 1) * 16 + swz / 64; C = (st & 1) * 32 + (swz % 64) / 2; }
__host__ __device__ __forceinline__ int perm32(int rho) { const int n = rho >> 4, i = rho & 15; return 8 * (i >> 2) + 4 * n + (i & 3); }

struct Unit { int pm, pn; };
struct Gemm { const bf16_t* A; const bf16_t* Bt; int M, N, K; };

struct StaticOrder {
    int nM, nN, nwg, G, c;
    __host__ __device__ void init(int M, int N, int G_, int c_) { nM = M / BM; nN = N / BM; nwg = nM * nN; G = G_; c = c_; }
    __host__ __device__ bool next(int i, Unit& u) const {
        const long L = (long)i * G + c; if (L >= nwg) return false;
        int wgid = (int)L; { const int q = nwg / NXCD, r = nwg % NXCD, xcd = wgid % NXCD, off = wgid / NXCD; wgid = (xcd < r ? xcd * (q + 1) : r * (q + 1) + (xcd - r) * q) + off; }
        const int nig = WGM * nN, gid = wgid / nig, fm = gid * WGM, gsz = (nM - fm) < WGM ? (nM - fm) : WGM;
        u.pm = fm + ((wgid % nig) % gsz); u.pn = (wgid % nig) / gsz; return true;
    }
    __device__ __forceinline__ void a_ready(const Unit&) const {}
    __device__ __forceinline__ void done(const Unit&) const {}
};
__device__ __forceinline__ unsigned cvt_pk_bf16(float lo, float hi) { unsigned r; asm volatile("v_cvt_pk_bf16_f32 %0, %1, %2" : "=v"(r) : "v"(lo), "v"(hi)); return r; }
typedef float f32x2 __attribute__((ext_vector_type(2)));
__device__ __forceinline__ float gelu_tanh_f(float x) {
    const float u = 1.5957691216057308f * (x + 0.044715f * x * x * x);
    return x * __builtin_amdgcn_rcpf(1.0f + __expf(-u));
}
struct EpiH {
    static constexpr bool PERM = true, AFTER_DRAIN = false;
    bf16_t* O; int ldc; int act_lo, act_hi;
    __device__ __forceinline__ void operator()(const f32x4 (&acc)[2][2][4][2], const Unit& u, int wr, int wc, int fr, int fq) const {
        const int row0 = u.pm * BM + wr * 64 + fr; const int col0 = u.pn * BM + wc * 32 + 8 * fq;
        const bool act = (u.pn >= act_lo) && (u.pn < act_hi);
#pragma unroll
        for (int ai = 0; ai < 2; ++ai)
#pragma unroll
            for (int m = 0; m < 4; ++m) { bf16_t* rowp = O + (size_t)(row0 + ai * HALF + m * 16) * ldc + col0;
#pragma unroll
                for (int bj = 0; bj < 2; ++bj) { f32x4 v0 = acc[ai][bj][m][0], v1 = acc[ai][bj][m][1];
                    if (act) {
#pragma unroll
                        for (int j = 0; j < 4; ++j) { v0[j] = gelu_tanh_f(v0[j]); v1[j] = gelu_tanh_f(v1[j]); } }
                    u32x4 w; w.x = cvt_pk_bf16(v0[0], v0[1]); w.y = cvt_pk_bf16(v0[2], v0[3]); w.z = cvt_pk_bf16(v1[0], v1[1]); w.w = cvt_pk_bf16(v1[2], v1[3]);
                    *(u32x4*)(rowp + bj * HALF) = w; } }
    }
};
struct EpiRes {
    static constexpr bool PERM = false, AFTER_DRAIN = false;
    float* C; const float* X; int ldc; float alpha;
    __device__ __forceinline__ void operator()(const f32x4 (&acc)[2][2][4][2], const Unit& u, int wr, int wc, int fr, int fq) const {
        const int row0 = u.pm * BM + wr * 64 + fr, col0 = u.pn * BM + wc * 32 + 4 * fq;
#pragma unroll
        for (int ai = 0; ai < 2; ++ai)
#pragma unroll
            for (int m = 0; m < 4; ++m) { const size_t off = (size_t)(row0 + ai * HALF + m * 16) * ldc + col0;
#pragma unroll
                for (int bj = 0; bj < 2; ++bj)
#pragma unroll
                    for (int n = 0; n < 2; ++n) { const size_t o2 = off + bj * HALF + n * 16; const f32x4 xv = *(const f32x4*)(X + o2); *(f32x4*)(C + o2) = acc[ai][bj][m][n] + xv * alpha; } }
    }
};
struct EpiF32 {
    static constexpr bool PERM = false, AFTER_DRAIN = false;
    float* C; int ldc;
    __device__ __forceinline__ void operator()(const f32x4 (&acc)[2][2][4][2], const Unit& u, int wr, int wc, int fr, int fq) const {
        const int row0 = u.pm * BM + wr * 64 + fr, col0 = u.pn * BM + wc * 32 + 4 * fq;
#pragma unroll
        for (int ai = 0; ai < 2; ++ai)
#pragma unroll
            for (int m = 0; m < 4; ++m) { float* rowp = C + (size_t)(row0 + ai * HALF + m * 16) * ldc + col0;
#pragma unroll
                for (int bj = 0; bj < 2; ++bj)
#pragma unroll
                    for (int n = 0; n < 2; ++n) *(f32x4*)(rowp + bj * HALF + n * 16) = acc[ai][bj][m][n]; }
    }
};
template <class Epi, class Sched, bool ALIGN_EPI = false, bool SP2 = false>
__device__ __forceinline__ void gemm_phase(PG8_LAS unsigned char* lds, const Gemm g, const Sched& S, const Epi& E, const int tid) {
    const int wid = __builtin_amdgcn_readfirstlane(tid >> 6), lane = tid & 63, wr = wid >> 2, wc = wid & 3, fr = lane & 15, fq = lane >> 4;
    const int K = g.K, nt = K / BK;
    unsigned voffA[2], voffB[2];
#pragma unroll
    for (int i = 0; i < 2; ++i) { int R, C; stage_rc(tid * 16 + i * 8192, R, C); const int Rb = Epi::PERM ? ((R & ~31) + perm32(R & 31)) : R;
        voffA[i] = (unsigned)(R * K + C) * 2u; voffB[i] = (unsigned)(Rb * K + C) * 2u; }
    const size_t kstep = (size_t)(BK * 2);
    const size_t hstep = (size_t)HALF * K * 2;
    const size_t tstep = 2 * hstep;
    const unsigned ldsw = (unsigned)wid * 1024u;
    const int aoff = lds_byte(wr * 64 + fr, fq * 8), boff = lds_byte(wc * 32 + fr, fq * 8);
#define PG8_SA(b, h) (((b) * 2 + (h)) * HTB)
#define PG8_SB(b, h) ((4 + (b) * 2 + (h)) * HTB)
#define PG8_STAGE(bufoff, gbase, voff) do { _Pragma("unroll") for (int _i = 0; _i < 2; ++_i) \
        __builtin_amdgcn_global_load_lds((const unsigned*)((const char*)(gbase) + (voff)[_i]), (PG8_LAS unsigned*)(lds + (bufoff) + ldsw + _i * 8192), 16, 0, 0); } while (0)
#define PG8_LDA(dst, b, h) do { _Pragma("unroll") for (int m = 0; m < 4; ++m) _Pragma("unroll") for (int k = 0; k < 2; ++k) dst[m][k] = *(const PG8_LAS bf16x8*)(lds + PG8_SA(b, h) + aoff + m * 2048 + k * 1024); } while (0)
#define PG8_LDB(dst, b, h) do { _Pragma("unroll") for (int n = 0; n < 2; ++n) _Pragma("unroll") for (int k = 0; k < 2; ++k) dst[n][k] = *(const PG8_LAS bf16x8*)(lds + PG8_SB(b, h) + boff + n * 2048 + k * 1024); } while (0)
#define PG8_MMA(ai, bj, At, Bt) do { __builtin_amdgcn_s_setprio(1); _Pragma("unroll") for (int m = 0; m < 4; ++m) _Pragma("unroll") for (int n = 0; n < 2; ++n) _Pragma("unroll") for (int k = 0; k < 2; ++k) \
        acc[ai][bj][m][n] = __builtin_amdgcn_mfma_f32_16x16x32_bf16(Bt[n][k], At[m][k], acc[ai][bj][m][n], 0, 0, 0); __builtin_amdgcn_s_setprio(0); } while (0)
#define PG8_WAIT_V(n) asm volatile("s_waitcnt vmcnt(" #n ")" ::: "memory")
#define PG8_WAIT_L(n) asm volatile("s_waitcnt lgkmcnt(" #n ")" ::: "memory")
#define PG8_BAR __builtin_amdgcn_s_barrier()
#define PG8_SCHED __builtin_amdgcn_sched_barrier(0)
    Unit cur, nxt; int ui = 0;
    if (!S.next(0, cur)) return;
    f32x4 acc[2][2][4][2];
#pragma unroll
    for (int a = 0; a < 2; ++a)
#pragma unroll
        for (int b = 0; b < 2; ++b)
#pragma unroll
            for (int m = 0; m < 4; ++m)
#pragma unroll
                for (int n = 0; n < 2; ++n) acc[a][b][m][n] = (f32x4){0.f, 0.f, 0.f, 0.f};
    bf16x8 At[4][2], B0[2][2], B1[2][2];
    const char* cA = (const char*)g.A + (size_t)cur.pm * tstep; const char* cB = (const char*)g.Bt + (size_t)cur.pn * tstep;
    S.a_ready(cur);
    if constexpr (SP2) {
        PG8_STAGE(PG8_SB(0, 0), cB, voffB); PG8_STAGE(PG8_SB(0, 1), cB + hstep, voffB); PG8_STAGE(PG8_SA(0, 0), cA, voffA); PG8_STAGE(PG8_SA(0, 1), cA + hstep, voffA);
        if (wr == 1) PG8_BAR;
        PG8_WAIT_V(2); PG8_BAR;
        PG8_STAGE(PG8_SB(1, 0), cB + kstep, voffB); PG8_STAGE(PG8_SA(1, 0), cA + kstep, voffA); PG8_STAGE(PG8_SB(1, 1), cB + hstep + kstep, voffB);
        PG8_WAIT_V(6); PG8_BAR;
    } else {
        PG8_STAGE(PG8_SB(0, 0), cB, voffB); PG8_STAGE(PG8_SA(0, 0), cA, voffA); PG8_STAGE(PG8_SB(0, 1), cB + hstep, voffB); PG8_STAGE(PG8_SA(0, 1), cA + hstep, voffA);
        if (wr == 1) PG8_BAR;
        PG8_WAIT_V(4); PG8_BAR;
        PG8_STAGE(PG8_SB(1, 0), cB + kstep, voffB); PG8_STAGE(PG8_SA(1, 0), cA + kstep, voffA); PG8_STAGE(PG8_SB(1, 1), cB + hstep + kstep, voffB);
        PG8_WAIT_V(6); PG8_BAR;
    }
    for (;;) {
        const bool has_next = S.next(ui + 1, nxt);
        const char* nA = has_next ? (const char*)g.A + (size_t)nxt.pm * tstep : cA; const char* nB = has_next ? (const char*)g.Bt + (size_t)nxt.pn * tstep : cB;
        for (int t = 0; t < nt; t += 2) {
            const bool last = (t == nt - 2);
            const char* a1 = cA + (size_t)(t + 1) * kstep;
            const char* a2 = last ? nA : cA + (size_t)(t + 2) * kstep; const char* b2 = last ? nB : cB + (size_t)(t + 2) * kstep;
            const char* a3 = a2 + kstep; const char* b3 = b2 + kstep;
            if (last && has_next) S.a_ready(nxt);
            if constexpr (SP2) {
            PG8_LDB(B0, 0, 0); PG8_LDB(B1, 0, 1); PG8_SCHED; PG8_LDA(At, 0, 0); PG8_STAGE(PG8_SA(1, 1), a1 + hstep, voffA);
            PG8_WAIT_V(8); PG8_WAIT_L(0); PG8_BAR; PG8_MMA(0, 0, At, B0); PG8_MMA(0, 1, At, B1); PG8_BAR; PG8_SCHED;
            PG8_LDA(At, 0, 1); PG8_STAGE(PG8_SB(0, 0), b2, voffB); PG8_STAGE(PG8_SB(0, 1), b2 + hstep, voffB); PG8_STAGE(PG8_SA(0, 0), a2, voffA);
            PG8_WAIT_V(8); PG8_WAIT_L(0); PG8_BAR; PG8_MMA(1, 0, At, B0); PG8_MMA(1, 1, At, B1); PG8_BAR; PG8_SCHED;
            PG8_LDB(B0, 1, 0); PG8_LDB(B1, 1, 1); PG8_SCHED; PG8_LDA(At, 1, 0); PG8_STAGE(PG8_SA(0, 1), a2 + hstep, voffA);
            PG8_WAIT_V(8); PG8_WAIT_L(0); PG8_BAR; PG8_MMA(0, 0, At, B0); PG8_MMA(0, 1, At, B1); PG8_BAR; PG8_SCHED;
            PG8_LDA(At, 1, 1); PG8_STAGE(PG8_SB(1, 0), b3, voffB); PG8_STAGE(PG8_SB(1, 1), b3 + hstep, voffB); PG8_STAGE(PG8_SA(1, 0), a3, voffA);
            PG8_WAIT_V(8); PG8_WAIT_L(0); PG8_BAR; PG8_MMA(1, 0, At, B0); PG8_MMA(1, 1, At, B1); PG8_BAR; PG8_SCHED;
            } else {
            PG8_LDB(B0, 0, 0); PG8_SCHED; PG8_LDA(At, 0, 0); PG8_STAGE(PG8_SA(1, 1), a1 + hstep, voffA);
            PG8_WAIT_L(8); PG8_BAR; PG8_WAIT_L(0); PG8_MMA(0, 0, At, B0); PG8_BAR; PG8_SCHED;
            PG8_LDB(B1, 0, 1); PG8_STAGE(PG8_SB(0, 0), b2, voffB);
            PG8_BAR; PG8_WAIT_L(0); PG8_MMA(0, 1, At, B1); PG8_BAR;
            PG8_LDA(At, 0, 1); PG8_STAGE(PG8_SA(0, 0), a2, voffA);
            PG8_BAR; PG8_WAIT_L(0); PG8_MMA(1, 0, At, B0); PG8_BAR; PG8_SCHED;
            PG8_STAGE(PG8_SB(0, 1), b2 + hstep, voffB);
            PG8_WAIT_V(6); PG8_BAR; PG8_MMA(1, 1, At, B1); PG8_BAR;
            PG8_LDB(B0, 1, 0); PG8_SCHED; PG8_LDA(At, 1, 0); PG8_STAGE(PG8_SA(0, 1), a2 + hstep, voffA);
            PG8_WAIT_L(8); PG8_BAR; PG8_WAIT_L(0); PG8_MMA(0, 0, At, B0); PG8_BAR; PG8_SCHED;
            PG8_LDB(B1, 1, 1); PG8_STAGE(PG8_SB(1, 0), b3, voffB);
            PG8_BAR; PG8_WAIT_L(0); PG8_MMA(0, 1, At, B1); PG8_BAR;
            PG8_LDA(At, 1, 1); PG8_STAGE(PG8_SA(1, 0), a3, voffA);
            PG8_BAR; PG8_WAIT_L(0); PG8_MMA(1, 0, At, B0); PG8_BAR; PG8_SCHED;
            PG8_STAGE(PG8_SB(1, 1), b3 + hstep, voffB);
            PG8_WAIT_V(6); PG8_BAR; PG8_MMA(1, 1, At, B1); PG8_BAR;
            }
        }
        if constexpr (ALIGN_EPI) { if (wr == 0) PG8_BAR; }
        if constexpr (!Epi::AFTER_DRAIN) { E(acc, cur, wr, wc, fr, fq); S.done(cur); }
        if (!has_next) break;
#pragma unroll
        for (int a = 0; a < 2; ++a)
#pragma unroll
            for (int b = 0; b < 2; ++b)
#pragma unroll
                for (int m = 0; m < 4; ++m)
#pragma unroll
                    for (int n = 0; n < 2; ++n) acc[a][b][m][n] = (f32x4){0.f, 0.f, 0.f, 0.f};
        cur = nxt; cA = nA; cB = nB; ++ui;
        if constexpr (ALIGN_EPI) { if (wr == 1) PG8_BAR; }
    }
    PG8_WAIT_V(0);
    if constexpr (!ALIGN_EPI) { if (wr == 0) PG8_BAR; }
    PG8_BAR;
    if constexpr (Epi::AFTER_DRAIN) { E.fused(acc, cur, wr, wc, fr, fq, lds, wid, lane); S.done(cur); }
#undef PG8_SA
#undef PG8_SB
#undef PG8_STAGE
#undef PG8_LDA
#undef PG8_LDB
#undef PG8_MMA
#undef PG8_WAIT_V
#undef PG8_WAIT_L
#undef PG8_BAR
#undef PG8_SCHED
}
}
#define XB_TMO      128
#define XB_XCNT(j)  (256  + 64 * (j))
#define XB_XSUB(j)  (1280 + 64 * (j))
#define XB_XGEN(j)  (2304 + 64 * (j))
#define XB_TOP      3328
#define XB_TOPGEN   3392
#define XCD_BAR_WORDS 3456
#define XB_SPIN_CAP (1u << 18)

__device__ __forceinline__ unsigned xb_ld(unsigned* p)              { return __hip_atomic_load(p, __ATOMIC_RELAXED, __HIP_MEMORY_SCOPE_AGENT); }
__device__ __forceinline__ unsigned xb_add(unsigned* p, unsigned v) { return __hip_atomic_fetch_add(p, v, __ATOMIC_RELAXED, __HIP_MEMORY_SCOPE_AGENT); }
__device__ __forceinline__ unsigned xb_xcc_id() { return (unsigned)__builtin_amdgcn_s_getreg((3 << 11) | 20) & 0xFu; }
#define XB_SPIN(cond, bar) do { unsigned _sp = 0; while (cond) { __builtin_amdgcn_s_sleep(1); \
    if ((++_sp & 255u) == 0u) { if (xb_ld(&(bar)[XB_TMO])) break; if (_sp > XB_SPIN_CAP) { atomicAdd(&(bar)[XB_TMO], 1u); break; } } } } while (0)

struct XcdBarrier {
    unsigned* bar; unsigned x;
    volatile LAS unsigned* st;
};

__device__ __forceinline__ XcdBarrier xcd_barrier_post(unsigned* bar, volatile LAS unsigned* st) {
    XcdBarrier b; b.bar = bar; b.x = xb_xcc_id(); b.st = st;
    if (threadIdx.x == 0) (void)xb_add(&bar[XB_XCNT(b.x)], 1u);
    return b;
}
__device__ __forceinline__ void xcd_barrier_complete(unsigned* bar, unsigned x, unsigned& nloc, unsigned& nx) {
    const unsigned G = gridDim.x * gridDim.y * gridDim.z;
    unsigned sum, cnt, mine, sp = 0u;
    for (;;) {
        sum = 0u; cnt = 0u; mine = 0u;
#pragma unroll
        for (unsigned j = 0; j < 16; ++j) { const unsigned c = xb_ld(&bar[XB_XCNT(j)]); sum += c; cnt += (c > 0u) ? 1u : 0u; mine = (j == x) ? c : mine; }
        if (sum == G) break;
        __builtin_amdgcn_s_sleep(1);
        if ((++sp & 255u) == 0u) { if (xb_ld(&bar[XB_TMO])) break; if (sp > XB_SPIN_CAP) { atomicAdd(&bar[XB_TMO], 1u); break; } }
    }
    nloc = mine > 0u ? mine : 1u; nx = cnt > 0u ? cnt : 1u;
}

__device__ __forceinline__ void xcd_barrier(const XcdBarrier& b) {
    asm volatile("s_waitcnt vmcnt(0)" ::: "memory");
    __syncthreads();
    if (threadIdx.x == 0) {
        unsigned* bar = b.bar;
        __builtin_amdgcn_s_waitcnt(0);
        unsigned nloc = b.st[0], nx = b.st[1];
        if (nloc == 0u) { xcd_barrier_complete(bar, b.x, nloc, nx); b.st[0] = nloc; b.st[1] = nx; }
        const unsigned old = xb_add(&bar[XB_XSUB(b.x)], 1u);
        const unsigned gen = old / nloc;
        if (old + 1u == (gen + 1u) * nloc) {
            __builtin_amdgcn_fence(__ATOMIC_RELEASE, "agent");
            asm volatile("s_waitcnt vmcnt(0)" ::: "memory");
            const unsigned og = xb_add(&bar[XB_TOP], 1u);
            const unsigned tg = og / nx;
            if (og + 1u == (tg + 1u) * nx) xb_add(&bar[XB_TOPGEN], 1u);
            else XB_SPIN(xb_ld(&bar[XB_TOPGEN]) == tg, bar);
            __builtin_amdgcn_fence(__ATOMIC_ACQUIRE, "agent");
            xb_add(&bar[XB_XGEN(b.x)], 1u);
            asm volatile("s_waitcnt vmcnt(0)" ::: "memory");
        } else {
            XB_SPIN(xb_ld(&bar[XB_XGEN(b.x)]) == gen, bar);
            __builtin_amdgcn_fence(__ATOMIC_ACQUIRE, "agent");
            asm volatile("s_waitcnt vmcnt(0)" ::: "memory");
        }
    }
    __syncthreads();
}

constexpr int NB = 4, T = 2048, D = 2048, NTOK = NB * T, DEPTH = 4;
constexpr int INW = 5168, INWP = 5376;
constexpr int C_RQ = 0, C_RK = 256, C_RV = 512, C_RG = 1024, C_SU = 1536, C_SV = 2048, C_NQ = 2560, C_KC = 3584, C_VC = 3840, C_KS = 4096, C_VS = 4352, C_KW = 4608, C_VW = 4864, C_NG = 5120;
constexpr float ALPHA = 1.6817928305074290f;
constexpr float LN_EPS = 1e-5f;
constexpr float LOG2E = 1.4426950408889634f;

constexpr size_t MiB = (size_t)1 << 20;
constexpr size_t WS_CTL = 0, CTL_ZERO_BYTES = 1 * MiB;
constexpr size_t WS_ROPE = 1 * MiB;
constexpr size_t WS_WIN = 2 * MiB;
constexpr size_t WS_WOUT = 86 * MiB;
constexpr size_t WS_WQ = 118 * MiB;
constexpr size_t WS_PU = 160 * MiB;
constexpr size_t WS_PV = 416 * MiB;
constexpr size_t WS_H = 672 * MiB;
constexpr size_t WS_YMIX = 756 * MiB;
constexpr size_t WS_MIXED = 820 * MiB;
constexpr size_t WS_Z = 852 * MiB;
constexpr size_t WS_X1 = 916 * MiB;
constexpr size_t WS_X1B = 980 * MiB;
constexpr size_t WS_QP = 1012 * MiB;
constexpr size_t WS_XC = 1076 * MiB;
constexpr size_t WS_XB = 1140 * MiB;
constexpr size_t WS_KC = 1172 * MiB;
constexpr size_t WS_KVST = 1174 * MiB;
constexpr size_t WS_SC = 1184 * MiB;
constexpr size_t WS_END = 1248 * MiB;
constexpr int CW_BAR = 4096;

constexpr int LDS_BYTES = 147456;
constexpr int MISC_OFF = 143360;

#define GAS __attribute__((address_space(1)))
typedef float f4 __attribute__((ext_vector_type(4)));
typedef float f2 __attribute__((ext_vector_type(2)));
typedef unsigned u4 __attribute__((ext_vector_type(4)));
typedef unsigned u2 __attribute__((ext_vector_type(2)));
__device__ __forceinline__ f4 mk_f4(float a, float b, float c, float d) { f4 r; r.x = a; r.y = b; r.z = c; r.w = d; return r; }
__device__ __forceinline__ f2 mk_f2(float a, float b) { f2 r; r.x = a; r.y = b; return r; }
__device__ __forceinline__ u2 mk_u2(unsigned a, unsigned b) { u2 r; r.x = a; r.y = b; return r; }
typedef unsigned short bf16;
#define LDS_WAIT() asm volatile("s_waitcnt lgkmcnt(0)" ::: "memory")
#define VM_WAIT() asm volatile("s_waitcnt vmcnt(0)" ::: "memory")

struct Params {
    const float* in[25];
    float* out;
    unsigned char* ws;
    double inv_rev[32];
    float lg2[4];
    int ph_lo, ph_hi, use_bar, pad0;
};

__device__ __forceinline__ float bf2f(unsigned short b) { return __uint_as_float(((unsigned)b) << 16); }
__device__ __forceinline__ unsigned f2bf(float f) { unsigned u = __float_as_uint(f); return (u + 0x7fffu + ((u >> 16) & 1u)) >> 16; }
__device__ __forceinline__ unsigned pk2(float lo, float hi) { return f2bf(lo) | (f2bf(hi) << 16); }
__device__ __forceinline__ float wave_sum(float v) {
#pragma unroll
    for (int o = 1; o < 64; o <<= 1) v += __shfl_xor(v, o);
    return v;
}
__device__ __forceinline__ void unpack8(const u4& v, float* f) {
    f[0] = __uint_as_float(v.x << 16); f[1] = __uint_as_float(v.x & 0xffff0000u);
    f[2] = __uint_as_float(v.y << 16); f[3] = __uint_as_float(v.y & 0xffff0000u);
    f[4] = __uint_as_float(v.z << 16); f[5] = __uint_as_float(v.z & 0xffff0000u);
    f[6] = __uint_as_float(v.w << 16); f[7] = __uint_as_float(v.w & 0xffff0000u);
}
__device__ __forceinline__ float gelu_tanh(float x) { return pg8::gelu_tanh_f(x); }

__device__ __forceinline__ void transpose_tile(const float* __restrict__ W, int K, int N, bf16* __restrict__ WT, LAS float* scr, int kb, int nb, int lane) {
    const int k0 = kb * 64, n0 = nb * 32, nn = lane & 31; const bool ok = (n0 + nn) < N;
#pragma unroll 8
    for (int i = 0; i < 32; ++i) { const int kk = 2 * i + (lane >> 5); scr[kk * 33 + nn] = ok ? W[(size_t)(k0 + kk) * N + n0 + nn] : 0.f; }
    LDS_WAIT();
    const int c = lane & 7;
#pragma unroll
    for (int j = 0; j < 4; ++j) { const int n = (lane >> 3) + 8 * j; const LAS float* s = scr + (8 * c) * 33 + n;
        u4 o; o.x = pk2(s[0 * 33], s[1 * 33]); o.y = pk2(s[2 * 33], s[3 * 33]); o.z = pk2(s[4 * 33], s[5 * 33]); o.w = pk2(s[6 * 33], s[7 * 33]);
        *(u4*)(WT + (size_t)(n0 + n) * K + k0 + 8 * c) = o; }
    LDS_WAIT();
}
__device__ __forceinline__ void cvt_bf16_stream(const float* __restrict__ src, bf16* __restrict__ dst, size_t nchunks, size_t gt, size_t GT) {
    for (size_t c = gt; c < nchunks; c += GT) { const f4 a = ((const f4*)src)[2 * c], b = ((const f4*)src)[2 * c + 1];
        u4 o; o.x = pk2(a.x, a.y); o.y = pk2(a.z, a.w); o.z = pk2(b.x, b.y); o.w = pk2(b.z, b.w); ((u4*)dst)[c] = o; }
}
__device__ __forceinline__ void phase_prologue(const Params& P, LAS unsigned char* lds, int tid, int lane, int wave) {
    unsigned char* ws = P.ws;
    LAS float* scr = (LAS float*)(lds + wave * 8704);
    const int gw = blockIdx.x * 8 + wave, NGW = gridDim.x * 8;
    constexpr int I_IN = 32 * 168, I_SQ = 32 * 64, I_L = I_IN + 2 * I_SQ;
    for (int it = gw; it < DEPTH * I_L; it += NGW) {
        const int l = it / I_L; int r = it % I_L;
        if (r < I_IN) transpose_tile(P.in[1] + (size_t)l * D * INW, D, INW, (bf16*)(ws + WS_WIN) + (size_t)l * INWP * D, scr, r / 168, r % 168, lane);
        else { r -= I_IN;
            if (r < I_SQ) transpose_tile(P.in[15] + (size_t)l * D * D, D, D, (bf16*)(ws + WS_WOUT) + (size_t)l * D * D, scr, r / 64, r % 64, lane);
            else { r -= I_SQ; transpose_tile(P.in[18] + (size_t)l * D * D, D, D, (bf16*)(ws + WS_WQ) + (size_t)l * D * D, scr, r / 64, r % 64, lane); } }
    }
    const size_t gt = (size_t)blockIdx.x * 512 + tid, GT = (size_t)gridDim.x * 512;
    cvt_bf16_stream(P.in[21], (bf16*)(ws + WS_PU), (size_t)DEPTH * 16384 * 2048 / 8, gt, GT);
    cvt_bf16_stream(P.in[22], (bf16*)(ws + WS_PV), (size_t)DEPTH * 16384 * 2048 / 8, gt, GT);
    cvt_bf16_stream(P.in[0], (bf16*)(ws + WS_XB), (size_t)NTOK * D / 8, gt, GT);
    f2* rope = (f2*)(ws + WS_ROPE);
    for (size_t idx = gt; idx < (size_t)T * 32; idx += GT) { const int t = (int)(idx >> 5), i = (int)(idx & 31);
        double a = (double)t * P.inv_rev[i]; a -= floor(a); const float fr = (float)a;
        rope[idx] = mk_f2(__builtin_amdgcn_cosf(fr), __builtin_amdgcn_sinf(fr)); }
}

__device__ __forceinline__ void stage_rot_k(const bf16* __restrict__ Hb, const f2* __restrict__ rope, LAS float* ks, int tok0, int tpos0, int colK, float lg2h, bool zeta, int tid) {
    const int m = tid >> 2, p = tid & 3;
    const bf16* src = Hb + (size_t)(tok0 + m) * INWP + colK + p * 8;
    const u4 a = *(const u4*)src, b = *(const u4*)(src + 32);
    float x1[8], x2[8]; unpack8(a, x1); unpack8(b, x2);
    const f4* rp = (const f4*)(rope + (size_t)(tpos0 + m) * 32 + p * 8);
    const f4 r0 = rp[0], r1 = rp[1], r2 = rp[2], r3 = rp[3];
    const float cs[8] = {r0.x, r0.z, r1.x, r1.z, r2.x, r2.z, r3.x, r3.z}, sn[8] = {r0.y, r0.w, r1.y, r1.w, r2.y, r2.w, r3.y, r3.w};
    const float sc = 0.125f * (zeta ? exp2f(lg2h * (float)(127 - m)) : 1.0f);
    float o1[8], o2[8];
#pragma unroll
    for (int i = 0; i < 8; ++i) { o1[i] = (x1[i] * cs[i] - x2[i] * sn[i]) * sc; o2[i] = (x1[i] * sn[i] + x2[i] * cs[i]) * sc; }
    LAS f4* d1 = (LAS f4*)(ks + m * 64 + p * 8); LAS f4* d2 = (LAS f4*)(ks + m * 64 + 32 + p * 8);
    d1[0] = mk_f4(o1[0], o1[1], o1[2], o1[3]); d1[1] = mk_f4(o1[4], o1[5], o1[6], o1[7]);
    d2[0] = mk_f4(o2[0], o2[1], o2[2], o2[3]); d2[1] = mk_f4(o2[4], o2[5], o2[6], o2[7]);
}
__device__ __forceinline__ void stage_v128(const bf16* __restrict__ Hb, LAS float* vs, int tok0, int colV, int tid) {
    const int m = tid >> 2, p = tid & 3;
    const u4* src = (const u4*)(Hb + (size_t)(tok0 + m) * INWP + colV + p * 32);
    LAS f4* dst = (LAS f4*)(vs + m * 128 + p * 32);
#pragma unroll
    for (int j = 0; j < 4; ++j) { const u4 a = src[j]; float f[8]; unpack8(a, f); dst[2 * j] = mk_f4(f[0], f[1], f[2], f[3]); dst[2 * j + 1] = mk_f4(f[4], f[5], f[6], f[7]); }
}

__device__ __forceinline__ void unit_kvstate(const Params& P, LAS unsigned char* lds, int u, int tid) {
    const int b = u / 60, r = u % 60, h = r / 15, j = r % 15;
    const bf16* Hb = (const bf16*)(P.ws + WS_H); const f2* rope = (const f2*)(P.ws + WS_ROPE);
    LAS float* ks = (LAS float*)lds; LAS float* vs = (LAS float*)(lds + 32768);
    const int tok0 = b * T + j * 128;
    stage_rot_k(Hb, rope, ks, tok0, j * 128, C_RK + h * 64, P.lg2[h], true, tid);
    stage_v128(Hb, vs, tok0, C_RV + h * 128, tid);
    __syncthreads();
    const int d = tid >> 3, e0 = (tid & 7) * 16;
    float acc[16];
#pragma unroll
    for (int i = 0; i < 16; ++i) acc[i] = 0.f;
    #pragma unroll 1
    for (int m = 0; m < 128; ++m) { const float kd = ks[m * 64 + d]; const LAS f4* vp = (const LAS f4*)(vs + m * 128 + e0);
#pragma unroll
        for (int q = 0; q < 4; ++q) { const f4 v = vp[q]; acc[4 * q] += kd * v.x; acc[4 * q + 1] += kd * v.y; acc[4 * q + 2] += kd * v.z; acc[4 * q + 3] += kd * v.w; } }
    f4* dst = (f4*)((float*)(P.ws + WS_KVST) + ((size_t)((b * 4 + h) * 16 + j) * 64 + d) * 128 + e0);
#pragma unroll
    for (int q = 0; q < 4; ++q) dst[q] = mk_f4(acc[4 * q], acc[4 * q + 1], acc[4 * q + 2], acc[4 * q + 3]);
    __syncthreads();
}

__device__ __forceinline__ void unit_sgu(const Params& P, int l, LAS unsigned char* lds, int u, int tid, int lane, int wave) {
    const int b = u >> 6, c = (u >> 2) & 15, g = u & 3;
    const bf16* Hb = (const bf16*)(P.ws + WS_H);
    LAS float* vn = (LAS float*)lds;
    LAS float* wsm = (LAS float*)(lds + 65536);
    const int tok0 = b * T + c * 128;
    const float* lng = P.in[4] + l * 512 + g * 128; const float* lnb = P.in[5] + l * 512 + g * 128;
    const float g0 = lng[2 * lane], g1 = lng[2 * lane + 1], b0 = lnb[2 * lane], b1 = lnb[2 * lane + 1];
    for (int i = 0; i < 16; ++i) { const int s = wave * 16 + i;
        const unsigned pr = *(const unsigned*)(Hb + (size_t)(tok0 + s) * INWP + C_SV + g * 128 + 2 * lane);
        const float v0 = __uint_as_float(pr << 16), v1 = __uint_as_float(pr & 0xffff0000u);
        const float mu = wave_sum(v0 + v1) * (1.f / 128.f); const float d0 = v0 - mu, d1 = v1 - mu;
        const float var = wave_sum(d0 * d0 + d1 * d1) * (1.f / 128.f); const float rstd = rsqrtf(var + LN_EPS);
        *(LAS f2*)(vn + s * 128 + 2 * lane) = mk_f2(d0 * rstd * g0 + b0, d1 * rstd * g1 + b1); }
    const float* wg = P.in[6] + ((size_t)l * 4 + g) * 16384;
    for (int i = 0; i < 32; ++i) { const int idx = tid + 512 * i; wsm[(idx >> 7) * 129 + (idx & 127)] = wg[idx]; }
    __syncthreads();
    const int t = tid >> 2, dg = tid & 3; const int smax = (t | 15);
    float acc[32];
#pragma unroll
    for (int i = 0; i < 32; ++i) acc[i] = 0.f;
    #pragma unroll 1
    for (int s = 0; s <= smax; ++s) { const float wv = (s <= t) ? wsm[t * 129 + s] : 0.f; const LAS f4* vp = (const LAS f4*)(vn + s * 128 + dg * 32);
#pragma unroll
        for (int q = 0; q < 8; ++q) { const f4 v = vp[q]; acc[4 * q] += wv * v.x; acc[4 * q + 1] += wv * v.y; acc[4 * q + 2] += wv * v.z; acc[4 * q + 3] += wv * v.w; } }
    const float bs = P.in[7][(l * 4 + g) * 128 + t];
    const u4* up = (const u4*)(Hb + (size_t)(tok0 + t) * INWP + C_SU + g * 128 + dg * 32);
    f4* yo = (f4*)((float*)(P.ws + WS_YMIX) + (size_t)(tok0 + t) * D + 512 + g * 128 + dg * 32);
#pragma unroll
    for (int j = 0; j < 4; ++j) { const u4 a = up[j]; float f[8]; unpack8(a, f);
        yo[2 * j] = mk_f4(f[0] * (acc[8 * j] + bs), f[1] * (acc[8 * j + 1] + bs), f[2] * (acc[8 * j + 2] + bs), f[3] * (acc[8 * j + 3] + bs));
        yo[2 * j + 1] = mk_f4(f[4] * (acc[8 * j + 4] + bs), f[5] * (acc[8 * j + 5] + bs), f[6] * (acc[8 * j + 6] + bs), f[7] * (acc[8 * j + 7] + bs)); }
    __syncthreads();
}

__device__ __forceinline__ void unit_compress(const Params& P, int l, LAS unsigned char* lds, int u, int tid) {
    const int kv = u >> 7, b = (u >> 5) & 3, g = (u >> 3) & 3, r = u & 7;
    const bf16* Hb = (const bf16*)(P.ws + WS_H);
    LAS float* seg = (LAS float*)lds;
    LAS float* hid = (LAS float*)(lds + 69632);
    const int col0 = (kv ? C_VC : C_KC) + g * 64;
    const float* pe = P.in[kv ? 11 : 8] + (size_t)l * 2048;
    const float* w1 = P.in[kv ? 12 : 9] + (size_t)l * 2048 * 256;
    const float* w2 = P.in[kv ? 13 : 10] + (size_t)l * 256 * 64;
    for (int idx = tid; idx < 272 * 8; idx += 512) { const int tt = idx >> 3, d8 = (idx & 7) * 8; const int t = 256 * r + tt;
        float f[8];
        if (t < T) { const u4 a = *(const u4*)(Hb + (size_t)(b * T + t) * INWP + col0 + d8); unpack8(a, f); }
        else {
#pragma unroll
            for (int i = 0; i < 8; ++i) f[i] = 0.f; }
        LAS f4* dp = (LAS f4*)(seg + tt * 64 + d8); dp[0] = mk_f4(f[0], f[1], f[2], f[3]); dp[1] = mk_f4(f[4], f[5], f[6], f[7]); }
    __syncthreads();
    const int j = tid & 255, hb = tid >> 8;
    float acc[8], accpe = 0.f;
#pragma unroll
    for (int i = 0; i < 8; ++i) acc[i] = 0.f;
    for (int pos = 0; pos < 32; ++pos) {
#pragma unroll 2
        for (int d4 = 0; d4 < 16; ++d4) { const int kk = pos * 64 + d4 * 4;
            const float w0 = w1[(size_t)(kk + 0) * 256 + j], w1v = w1[(size_t)(kk + 1) * 256 + j], w2v = w1[(size_t)(kk + 2) * 256 + j], w3 = w1[(size_t)(kk + 3) * 256 + j];
            const f4 p4 = *(const f4*)(pe + kk);
            accpe += w0 * p4.x + w1v * p4.y + w2v * p4.z + w3 * p4.w;
#pragma unroll
            for (int ib = 0; ib < 8; ++ib) { const f4 s4 = *(const LAS f4*)(seg + (16 * (hb * 8 + ib) + pos) * 64 + d4 * 4);
                acc[ib] += w0 * s4.x + w1v * s4.y + w2v * s4.z + w3 * s4.w; } } }
#pragma unroll
    for (int ib = 0; ib < 8; ++ib) hid[(hb * 8 + ib) * 256 + j] = gelu_tanh(acc[ib] + accpe);
    __syncthreads();
    { const int i = tid >> 5, o2 = (tid & 31) * 2; float a0 = 0.f, a1 = 0.f;
        for (int jj = 0; jj < 256; ++jj) { const float hv = hid[i * 256 + jj]; const f2 w = *(const f2*)(w2 + jj * 64 + o2); a0 += hv * w.x; a1 += hv * w.y; }
        const int ci = 16 * r + i;
        if (ci <= 126) *(f2*)((float*)(P.ws + WS_KC) + ((size_t)((kv * 4 + b) * 4 + g) * 128 + ci) * 64 + o2) = mk_f2(a0, a1); }
    __syncthreads();
}

__device__ __forceinline__ void unit_retention(const Params& P, int l, LAS unsigned char* lds, int u, int tid) {
    const int b = u >> 6, h = (u >> 4) & 3, c = u & 15;
    const bf16* Hb = (const bf16*)(P.ws + WS_H); const f2* rope = (const f2*)(P.ws + WS_ROPE);
    LAS float* regB = (LAS float*)lds;
    LAS float* vs = (LAS float*)(lds + 32768);
    LAS float* Qs = (LAS float*)(lds + 98304);
    const float lg2h = P.lg2[h];
    const int tok0 = b * T + c * 128;
    { float a[16];
#pragma unroll
        for (int i = 0; i < 16; ++i) a[i] = 0.f;
        const float* kvb = (const float*)(P.ws + WS_KVST) + (size_t)((b * 4 + h) * 16) * 8192 + tid * 16;
#pragma unroll 1
        for (int j = 0; j < c; ++j) { const float w = exp2f(lg2h * 128.f * (float)(c - 1 - j)); const f4* sp = (const f4*)(kvb + (size_t)j * 8192);
#pragma unroll
            for (int q = 0; q < 4; ++q) { const f4 v = sp[q]; a[4 * q] += w * v.x; a[4 * q + 1] += w * v.y; a[4 * q + 2] += w * v.z; a[4 * q + 3] += w * v.w; } }
        LAS f4* dp = (LAS f4*)(regB + tid * 16);
#pragma unroll
        for (int q = 0; q < 4; ++q) dp[q] = mk_f4(a[4 * q], a[4 * q + 1], a[4 * q + 2], a[4 * q + 3]); }
    const int n = tid >> 2, eg = tid & 3;
    float qa[8], qb[8];
    { const bf16* src = Hb + (size_t)(tok0 + n) * INWP + C_RQ + h * 64 + eg * 8;
        const u4 a = *(const u4*)src, bb = *(const u4*)(src + 32);
        float x1[8], x2[8]; unpack8(a, x1); unpack8(bb, x2);
        const f4* rp = (const f4*)(rope + (size_t)(c * 128 + n) * 32 + eg * 8);
        const f4 r0 = rp[0], r1 = rp[1], r2 = rp[2], r3 = rp[3];
        const float cs[8] = {r0.x, r0.z, r1.x, r1.z, r2.x, r2.z, r3.x, r3.z}, sn[8] = {r0.y, r0.w, r1.y, r1.w, r2.y, r2.w, r3.y, r3.w};
#pragma unroll
        for (int i = 0; i < 8; ++i) { qa[i] = x1[i] * cs[i] - x2[i] * sn[i]; qb[i] = x1[i] * sn[i] + x2[i] * cs[i]; Qs[n * 65 + eg * 8 + i] = qa[i]; Qs[n * 65 + 32 + eg * 8 + i] = qb[i]; } }
    __syncthreads();
    float acc[32];
#pragma unroll
    for (int i = 0; i < 32; ++i) acc[i] = 0.f;
#pragma unroll 2
    for (int d = 0; d < 64; ++d) { const float qd = Qs[n * 65 + d]; const LAS f4* sp = (const LAS f4*)(regB + d * 128 + eg * 32);
#pragma unroll
        for (int qq = 0; qq < 8; ++qq) { const f4 v = sp[qq]; acc[4 * qq] += qd * v.x; acc[4 * qq + 1] += qd * v.y; acc[4 * qq + 2] += qd * v.z; acc[4 * qq + 3] += qd * v.w; } }
    { const float xi = exp2f(lg2h * (float)(n + 1));
#pragma unroll
        for (int i = 0; i < 32; ++i) acc[i] *= xi; }
    __syncthreads();
    stage_rot_k(Hb, rope, regB, tok0, c * 128, C_RK + h * 64, lg2h, false, tid);
    stage_v128(Hb, vs, tok0, C_RV + h * 128, tid);
    __syncthreads();
    const int mmax = n | 15;
#pragma unroll 1
    for (int m = 0; m <= mmax; ++m) { const LAS f4* kp = (const LAS f4*)(regB + m * 64 + eg * 8); const LAS f4* kp2 = (const LAS f4*)(regB + m * 64 + 32 + eg * 8);
        const f4 k0 = kp[0], k1 = kp[1], k2 = kp2[0], k3 = kp2[1];
        float s = ((qa[0] * k0.x + qa[1] * k0.y) + (qa[2] * k0.z + qa[3] * k0.w)) + ((qa[4] * k1.x + qa[5] * k1.y) + (qa[6] * k1.z + qa[7] * k1.w))
                + ((qb[0] * k2.x + qb[1] * k2.y) + (qb[2] * k2.z + qb[3] * k2.w)) + ((qb[4] * k3.x + qb[5] * k3.y) + (qb[6] * k3.z + qb[7] * k3.w));
        s += __shfl_xor(s, 1); s += __shfl_xor(s, 2);
        const float a = (m <= n) ? s * exp2f(lg2h * (float)(n - m)) : 0.f;
        const LAS f4* vp = (const LAS f4*)(vs + m * 128 + eg * 32);
#pragma unroll
        for (int qq = 0; qq < 8; ++qq) { const f4 v = vp[qq]; acc[4 * qq] += a * v.x; acc[4 * qq + 1] += a * v.y; acc[4 * qq + 2] += a * v.z; acc[4 * qq + 3] += a * v.w; } }
    float s1 = 0.f;
#pragma unroll
    for (int i = 0; i < 32; ++i) s1 += acc[i];
    s1 += __shfl_xor(s1, 1); s1 += __shfl_xor(s1, 2);
    const float mu = s1 * (1.f / 128.f); float s2 = 0.f;
#pragma unroll
    for (int i = 0; i < 32; ++i) { const float dd = acc[i] - mu; s2 += dd * dd; }
    s2 += __shfl_xor(s2, 1); s2 += __shfl_xor(s2, 2);
    const float rstd = rsqrtf(s2 * (1.f / 128.f) + LN_EPS);
    const float* gg = P.in[2] + l * 512 + h * 128 + eg * 32; const float* gb = P.in[3] + l * 512 + h * 128 + eg * 32;
    const u4* gp = (const u4*)(Hb + (size_t)(tok0 + n) * INWP + C_RG + h * 128 + eg * 32);
    f4* yo = (f4*)((float*)(P.ws + WS_YMIX) + (size_t)(tok0 + n) * D + h * 128 + eg * 32);
#pragma unroll
    for (int j = 0; j < 4; ++j) { const u4 a = gp[j]; float f[8]; unpack8(a, f); float o[8];
#pragma unroll
        for (int i = 0; i < 8; ++i) { const float y = (acc[8 * j + i] - mu) * rstd * gg[8 * j + i] + gb[8 * j + i]; const float gv = f[i]; o[i] = y * gv * __builtin_amdgcn_rcpf(1.f + __expf(-gv)); }
        yo[2 * j] = mk_f4(o[0], o[1], o[2], o[3]); yo[2 * j + 1] = mk_f4(o[4], o[5], o[6], o[7]); }
    __syncthreads();
}

__device__ __forceinline__ unsigned long long mask64_le(int lim) { return lim < 0 ? 0ull : (lim >= 63 ? ~0ull : ((1ull << (lim + 1)) - 1ull)); }
__device__ __forceinline__ float pair_dot(const float (&q)[32], const LAS float* kp) {
    float a = 0.f;
#pragma unroll
    for (int d4 = 0; d4 < 8; ++d4) { const f4 k4 = ((const LAS f4*)kp)[d4]; a += (q[4 * d4] * k4.x + q[4 * d4 + 1] * k4.y) + (q[4 * d4 + 2] * k4.z + q[4 * d4 + 3] * k4.w); }
    return a + __shfl_xor(a, 1);
}
__device__ __forceinline__ void chunk_attend(float& m, float& lsum, float (&acc)[32], const float (&q)[32], const LAS float* Kc, const LAS float* Vc, int dh, unsigned long long vmask) {
#pragma unroll 1
    for (int kk = 0; kk < 64; ++kk) {
        const bool valid = (vmask >> kk) & 1ull;
        if (__builtin_amdgcn_ballot_w64(valid) == 0ull) continue;
        const float s = pair_dot(q, Kc + kk * 64 + dh * 32);
        const float mn = valid ? fmaxf(m, s) : m;
        if (mn != m) { const float corr = exp2f(m - mn); lsum *= corr;
#pragma unroll
            for (int d = 0; d < 32; ++d) acc[d] *= corr;
            m = mn; }
        const float p = valid ? exp2f(s - m) : 0.f; lsum += p;
        const LAS f4* vp = (const LAS f4*)(Vc + kk * 64 + dh * 32);
#pragma unroll
        for (int d4 = 0; d4 < 8; ++d4) { const f4 v = vp[d4]; acc[4 * d4] += p * v.x; acc[4 * d4 + 1] += p * v.y; acc[4 * d4 + 2] += p * v.z; acc[4 * d4 + 3] += p * v.w; }
    }
}
__device__ __forceinline__ void stage_kv64_bf16(const bf16* __restrict__ Hb, LAS float* Kc, LAS float* Vc, int tokbase, int colK, int colV, int tid) {
    const int kk = tid >> 3, d8 = (tid & 7) * 8;
    const u4 a = *(const u4*)(Hb + (size_t)(tokbase + kk) * INWP + colK + d8), bq = *(const u4*)(Hb + (size_t)(tokbase + kk) * INWP + colV + d8);
    float f[8], gq[8]; unpack8(a, f); unpack8(bq, gq);
    LAS f4* kd = (LAS f4*)(Kc + kk * 64 + d8); kd[0] = mk_f4(f[0], f[1], f[2], f[3]); kd[1] = mk_f4(f[4], f[5], f[6], f[7]);
    LAS f4* vd = (LAS f4*)(Vc + kk * 64 + d8); vd[0] = mk_f4(gq[0], gq[1], gq[2], gq[3]); vd[1] = mk_f4(gq[4], gq[5], gq[6], gq[7]);
}
__device__ __forceinline__ void nsa_flush(LAS float* Ob, int row, int dh, const float (&acc)[32], float lsum, float gate, bool add) {
    const float inv = (lsum > 0.f) ? gate / lsum : 0.f;
    LAS f4* op = (LAS f4*)(Ob + row * 64 + dh * 32);
#pragma unroll
    for (int d4 = 0; d4 < 8; ++d4) { f4 o = add ? op[d4] : mk_f4(0.f, 0.f, 0.f, 0.f);
        o.x += acc[4 * d4] * inv; o.y += acc[4 * d4 + 1] * inv; o.z += acc[4 * d4 + 2] * inv; o.w += acc[4 * d4 + 3] * inv; op[d4] = o; }
}
__device__ __forceinline__ void unit_nsa(const Params& P, int l, LAS unsigned char* lds, int u, int tid) {
    const int b = u >> 7, g = (u >> 5) & 3, qt = u & 31;
    const bf16* Hb = (const bf16*)(P.ws + WS_H);
    LAS float* Kc = (LAS float*)lds;
    LAS float* Vc = (LAS float*)(lds + 16384);
    LAS float* Ob = (LAS float*)(lds + 32768);
    LAS float* impH = (LAS float*)(lds + 98304);
    LAS unsigned* selm = (LAS unsigned*)(lds + 131072);
    const int row = tid >> 1, dh = tid & 1, h = row >> 6, tq = row & 63;
    const int t0 = qt * 64, t = t0 + tq; const size_t tok = (size_t)b * T + t;
    float q[32];
    { const u4* qp = (const u4*)(Hb + tok * INWP + C_NQ + g * 256 + h * 64 + dh * 32);
#pragma unroll
        for (int j = 0; j < 4; ++j) { const u4 a = qp[j]; float f[8]; unpack8(a, f);
#pragma unroll
            for (int i = 0; i < 8; ++i) q[8 * j + i] = f[i] * (0.125f * LOG2E); } }
    float gate[3];
#pragma unroll
    for (int k = 0; k < 3; ++k) { const float gv = bf2f(Hb[tok * INWP + C_NG + g * 12 + h * 3 + k]); gate[k] = __builtin_amdgcn_rcpf(1.f + __expf(-gv)); }
    if (tid == 0) selm[64] = 0u;
    float m, lsum, acc[32];
    const float* KCk = (const float*)(P.ws + WS_KC) + (size_t)((0 * 4 + b) * 4 + g) * 8192;
    const float* KCv = (const float*)(P.ws + WS_KC) + (size_t)((1 * 4 + b) * 4 + g) * 8192;
    const int cmax = (t >= 31) ? (((t - 31) >> 4) < 126 ? ((t - 31) >> 4) : 126) : -1;
    m = -1e30f; lsum = 0.f;
#pragma unroll
    for (int d = 0; d < 32; ++d) acc[d] = 0.f;
#pragma unroll 1
    for (int cc = 0; cc < 2; ++cc) {
        if (cc * 64 * 16 + 31 > t0 + 63) break;
        __syncthreads();
        { const f4* ks = (const f4*)(KCk + cc * 4096); const f4* vs = (const f4*)(KCv + cc * 4096);
            ((LAS f4*)Kc)[tid] = ks[tid]; ((LAS f4*)Kc)[tid + 512] = ks[tid + 512]; ((LAS f4*)Vc)[tid] = vs[tid]; ((LAS f4*)Vc)[tid + 512] = vs[tid + 512]; }
        __syncthreads();
        chunk_attend(m, lsum, acc, q, Kc, Vc, dh, mask64_le(cmax - 64 * cc));
    }
    nsa_flush(Ob, row, dh, acc, lsum, gate[0], false);
    { const float invl = (lsum > 0.f) ? 1.f / lsum : 0.f;
        float carry = 0.f, cur = 0.f;
#pragma unroll 1
        for (int cc = 0; cc < 2; ++cc) {
            __syncthreads();
            { const f4* ks = (const f4*)(KCk + cc * 4096); ((LAS f4*)Kc)[tid] = ks[tid]; ((LAS f4*)Kc)[tid + 512] = ks[tid + 512]; }
            __syncthreads();
#pragma unroll 1
            for (int cl = 0; cl < 64; ++cl) { const int c = 64 * cc + cl;
                const float s = pair_dot(q, Kc + cl * 64 + dh * 32);
                const float p = (c <= cmax) ? exp2f(s - m) * invl : 0.f;
                cur += p;
                if ((c & 3) == 3) { if (dh == 0) impH[(h * 64 + tq) * 32 + (c >> 2)] = carry + cur; carry = p; cur = 0.f; } }
        } }
    __syncthreads();
    if (tid < 64) { const int tqs = tid; float tv[8]; int ti[8];
#pragma unroll
        for (int k = 0; k < 8; ++k) { tv[k] = -3e38f; ti[k] = 0; }
#pragma unroll
        for (int j = 0; j < 32; ++j) { float v;
            if (j <= qt) { const bool forced = (j == 0) || (j == qt) || (j == qt - 1);
                v = forced ? 1e6f : (impH[(0 * 64 + tqs) * 32 + j] + impH[(1 * 64 + tqs) * 32 + j] + impH[(2 * 64 + tqs) * 32 + j] + impH[(3 * 64 + tqs) * 32 + j]); }
            else v = -1e9f;
            int vi = j;
#pragma unroll
            for (int k = 0; k < 8; ++k) { const bool gt = v > tv[k]; const float nv = gt ? tv[k] : v; const int ni = gt ? ti[k] : vi; tv[k] = gt ? v : tv[k]; ti[k] = gt ? vi : ti[k]; v = nv; vi = ni; } }
        unsigned msk = 0u;
#pragma unroll
        for (int k = 0; k < 8; ++k) if (ti[k] <= qt) msk |= (1u << ti[k]);
        selm[tqs] = msk; atomicOr((unsigned*)&selm[64], msk); }
    __syncthreads();
    const unsigned mymask = selm[tq], umask = selm[64];
    m = -1e30f; lsum = 0.f;
#pragma unroll
    for (int d = 0; d < 32; ++d) acc[d] = 0.f;
#pragma unroll 1
    for (int j = 0; j <= qt; ++j) {
        if (!((umask >> j) & 1u)) continue;
        __syncthreads();
        stage_kv64_bf16(Hb, Kc, Vc, b * T + 64 * j, C_KS + g * 64, C_VS + g * 64, tid);
        __syncthreads();
        const unsigned long long vm = ((mymask >> j) & 1u) ? ((j == qt) ? mask64_le(tq) : ~0ull) : 0ull;
        chunk_attend(m, lsum, acc, q, Kc, Vc, dh, vm);
    }
    nsa_flush(Ob, row, dh, acc, lsum, gate[1], true);
    m = -1e30f; lsum = 0.f;
#pragma unroll
    for (int d = 0; d < 32; ++d) acc[d] = 0.f;
#pragma unroll 1
    for (int jw = (qt >= 8 ? qt - 8 : 0); jw <= qt; ++jw) {
        __syncthreads();
        stage_kv64_bf16(Hb, Kc, Vc, b * T + 64 * jw, C_KW + g * 64, C_VW + g * 64, tid);
        __syncthreads();
        unsigned long long vm = ~0ull;
        if (jw == qt) vm = mask64_le(tq);
        else if (jw == qt - 8) vm = ~mask64_le(tq);
        chunk_attend(m, lsum, acc, q, Kc, Vc, dh, vm);
    }
    nsa_flush(Ob, row, dh, acc, lsum, gate[2], true);
    __syncthreads();
    float* ymix = (float*)(P.ws + WS_YMIX);
#pragma unroll
    for (int k = 0; k < 8; ++k) { const int idx = tid + 512 * k; const int rr = idx >> 4, d4 = idx & 15; const int hh = rr >> 6, tt = rr & 63;
        *(f4*)(ymix + ((size_t)b * T + t0 + tt) * D + 1024 + g * 256 + hh * 64 + d4 * 4) = ((const LAS f4*)(Ob + rr * 64))[d4]; }
    __syncthreads();
}

__device__ __forceinline__ void row_mixnorm(const Params& P, int l, int rowi, int lane) {
    const f4* yp = (const f4*)((const float*)(P.ws + WS_YMIX) + (size_t)rowi * D) + lane;
    const f4* gp = (const f4*)(P.in[14] + (size_t)l * D) + lane;
    f4 v[8]; float ss[8];
#pragma unroll
    for (int j = 0; j < 8; ++j) { v[j] = yp[64 * j]; ss[j] = v[j].x * v[j].x + v[j].y * v[j].y + v[j].z * v[j].z + v[j].w * v[j].w; }
    const float r0 = rsqrtf(wave_sum(ss[0] + ss[1]) * (1.f / 512.f) + LN_EPS);
    const float r1 = rsqrtf(wave_sum(ss[2] + ss[3]) * (1.f / 512.f) + LN_EPS);
    const float r2 = rsqrtf(wave_sum((ss[4] + ss[5]) + (ss[6] + ss[7])) * (1.f / 1024.f) + LN_EPS);
    u2* op = (u2*)((bf16*)(P.ws + WS_MIXED) + (size_t)rowi * D) + lane;
#pragma unroll
    for (int j = 0; j < 8; ++j) { const float r = (j < 2) ? r0 : ((j < 4) ? r1 : r2); const f4 g4 = gp[64 * j];
        op[64 * j] = mk_u2(pk2(v[j].x * r * g4.x, v[j].y * r * g4.y), pk2(v[j].z * r * g4.z, v[j].w * r * g4.w)); }
}
__device__ __forceinline__ void row_ln(const float* __restrict__ zin, const float* __restrict__ gam, const float* __restrict__ bet, float* __restrict__ of32, bf16* __restrict__ obf, int rowi, int lane) {
    const f4* zp = (const f4*)(zin + (size_t)rowi * D) + lane;
    f4 v[8]; float s = 0.f;
#pragma unroll
    for (int j = 0; j < 8; ++j) { v[j] = zp[64 * j]; s += (v[j].x + v[j].y) + (v[j].z + v[j].w); }
    const float mu = wave_sum(s) * (1.f / D); float s2 = 0.f;
#pragma unroll
    for (int j = 0; j < 8; ++j) { v[j].x -= mu; v[j].y -= mu; v[j].z -= mu; v[j].w -= mu; s2 += (v[j].x * v[j].x + v[j].y * v[j].y) + (v[j].z * v[j].z + v[j].w * v[j].w); }
    const float rstd = rsqrtf(wave_sum(s2) * (1.f / D) + LN_EPS);
    f4* o4 = (f4*)(of32 + (size_t)rowi * D) + lane; u2* o2 = (u2*)(obf + (size_t)rowi * D) + lane;
    const f4* gp = (const f4*)gam + lane; const f4* bp = (const f4*)bet + lane;
#pragma unroll
    for (int j = 0; j < 8; ++j) { const f4 g4 = gp[64 * j], b4 = bp[64 * j];
        const f4 o = mk_f4(v[j].x * rstd * g4.x + b4.x, v[j].y * rstd * g4.y + b4.y, v[j].z * rstd * g4.z + b4.z, v[j].w * rstd * g4.w + b4.w);
        o4[64 * j] = o; o2[64 * j] = mk_u2(pk2(o.x, o.y), pk2(o.z, o.w)); }
}

__device__ __forceinline__ float dot8_bf16(const u4& w, const float* x) {
    float f[8]; unpack8(w, f);
    return ((f[0] * x[0] + f[1] * x[1]) + (f[2] * x[2] + f[3] * x[3])) + ((f[4] * x[4] + f[5] * x[5]) + (f[6] * x[6] + f[7] * x[7]));
}
__device__ __forceinline__ void unit_peer(const Params& P, int l, LAS unsigned char* lds, int u, int tid, int lane, int wave, float* __restrict__ xout) {
    const int n0 = u * 32;
    const float* QP = (const float*)(P.ws + WS_QP); float* SC = (float*)(P.ws + WS_SC);
    LAS float* keys = (LAS float*)lds;
    LAS float* qs = (LAS float*)(lds + 67584);
    for (int hh = 0; hh < 16; ++hh) { const int h = hh >> 1, half = hh & 1;
        const float* kg = P.in[half ? 20 : 19] + ((size_t)l * 8 + h) * 16384;
        __syncthreads();
#pragma unroll
        for (int i = 0; i < 8; ++i) { const int idx = tid + 512 * i; const int k = idx >> 5, d4 = idx & 31; *(LAS f4*)(keys + k * 132 + d4 * 4) = ((const f4*)kg)[idx]; }
#pragma unroll
        for (int i = 0; i < 2; ++i) { const int idx = tid + 512 * i; const int tk = idx >> 5, d4 = idx & 31; *(LAS f4*)(qs + tk * 128 + d4 * 4) = *(const f4*)(QP + (size_t)(n0 + tk) * D + h * 256 + half * 128 + d4 * 4); }
        __syncthreads();
        const int k = tid & 127, tg = tid >> 7;
        float a[8];
#pragma unroll
        for (int i = 0; i < 8; ++i) a[i] = 0.f;
        for (int d4 = 0; d4 < 32; ++d4) { const f4 kv = *(const LAS f4*)(keys + k * 132 + d4 * 4);
#pragma unroll
            for (int i = 0; i < 8; ++i) { const f4 q4 = *(const LAS f4*)(qs + (tg * 8 + i) * 128 + d4 * 4); a[i] += kv.x * q4.x + kv.y * q4.y + kv.z * q4.z + kv.w * q4.w; } }
#pragma unroll
        for (int i = 0; i < 8; ++i) SC[((size_t)(n0 + tg * 8 + i) * 16 + hh) * 128 + k] = a[i];
    }
    VM_WAIT();
    __syncthreads();
    LAS float* TV = (LAS float*)lds;
    LAS int* TI = (LAS int*)(lds + 34816);
    { const int tk = tid >> 4, hh = tid & 15;
        const f4* sp = (const f4*)(SC + ((size_t)(n0 + tk) * 16 + hh) * 128);
        float tv[16]; int ti[16];
#pragma unroll
        for (int k = 0; k < 16; ++k) { tv[k] = -3e38f; ti[k] = 0; }
        for (int c4 = 0; c4 < 32; ++c4) { const f4 s4 = sp[c4]; const float sv[4] = {s4.x, s4.y, s4.z, s4.w};
#pragma unroll
            for (int e = 0; e < 4; ++e) { float v = sv[e]; int vi = c4 * 4 + e;
#pragma unroll
                for (int k = 0; k < 16; ++k) { const bool gt = v > tv[k]; const float nv = gt ? tv[k] : v; const int ni = gt ? ti[k] : vi; tv[k] = gt ? v : tv[k]; ti[k] = gt ? vi : ti[k]; v = nv; vi = ni; } } }
#pragma unroll
        for (int k = 0; k < 16; ++k) { TV[tid * 17 + k] = tv[k]; TI[tid * 17 + k] = ti[k]; } }
    __syncthreads();
    LAS int* PE = (LAS int*)(lds + 69632);
    LAS float* PW = (LAS float*)(lds + 86016);
    if (tid < 256) { const int tk = tid >> 3, h = tid & 7; const int r1 = tk * 16 + 2 * h, r2 = r1 + 1;
        float v1[16], v2[16]; int i1[16], i2[16];
#pragma unroll
        for (int k = 0; k < 16; ++k) { v1[k] = TV[r1 * 17 + k]; i1[k] = TI[r1 * 17 + k]; v2[k] = TV[r2 * 17 + k]; i2[k] = TI[r2 * 17 + k]; }
        float tv[16]; int te[16];
#pragma unroll
        for (int k = 0; k < 16; ++k) { tv[k] = -3e38f; te[k] = 0; }
#pragma unroll
        for (int a = 0; a < 16; ++a)
#pragma unroll
            for (int bq = 0; bq < 16; ++bq) if ((a + 1) * (bq + 1) <= 16) { float v = v1[a] + v2[bq]; int ve = i1[a] * 128 + i2[bq];
#pragma unroll
                for (int k = 0; k < 16; ++k) { const bool gt = v > tv[k]; const float nv = gt ? tv[k] : v; const int ni = gt ? te[k] : ve; tv[k] = gt ? v : tv[k]; te[k] = gt ? ve : te[k]; v = nv; ve = ni; } }
        float wsum = 0.f; float w[16];
#pragma unroll
        for (int k = 0; k < 16; ++k) { w[k] = __expf(tv[k] - tv[0]); wsum += w[k]; }
        const float inv = 1.f / wsum;
#pragma unroll
        for (int k = 0; k < 16; ++k) { PE[tk * 128 + h * 16 + k] = te[k]; PW[tk * 128 + h * 16 + k] = w[k] * inv; } }
    __syncthreads();
    LAS float* HW = (LAS float*)(lds + 102400);
    const bf16* PU = (const bf16*)(P.ws + WS_PU) + (size_t)l * 16384 * 2048; const bf16* PV = (const bf16*)(P.ws + WS_PV) + (size_t)l * 16384 * 2048;
    const float* X1 = (const float*)(P.ws + WS_X1);
    for (int it = 0; it < 4; ++it) { const int tk = wave * 4 + it; const size_t n = (size_t)n0 + tk;
        float xr[32];
#pragma unroll
        for (int j = 0; j < 4; ++j) { const f4 a = *(const f4*)(X1 + n * D + 512 * j + lane * 8), bq = *(const f4*)(X1 + n * D + 512 * j + lane * 8 + 4);
            xr[8 * j] = a.x; xr[8 * j + 1] = a.y; xr[8 * j + 2] = a.z; xr[8 * j + 3] = a.w; xr[8 * j + 4] = bq.x; xr[8 * j + 5] = bq.y; xr[8 * j + 6] = bq.z; xr[8 * j + 7] = bq.w; }
        for (int grp = 0; grp < 32; ++grp) { u4 w[4][4];
#pragma unroll
            for (int k = 0; k < 4; ++k) { const int e = __builtin_amdgcn_readfirstlane(PE[tk * 128 + grp * 4 + k]); const u4* up = (const u4*)(PU + (size_t)e * 2048) + lane;
#pragma unroll
                for (int j = 0; j < 4; ++j) w[k][j] = up[64 * j]; }
#pragma unroll
            for (int k = 0; k < 4; ++k) { float dsum = 0.f;
#pragma unroll
                for (int j = 0; j < 4; ++j) dsum += dot8_bf16(w[k][j], xr + 8 * j);
                dsum = wave_sum(dsum);
                if (lane == 0) HW[tk * 128 + grp * 4 + k] = PW[tk * 128 + grp * 4 + k] * gelu_tanh(dsum); } }
        LDS_WAIT();
        float acc[32];
#pragma unroll
        for (int i = 0; i < 32; ++i) acc[i] = 0.f;
        for (int grp = 0; grp < 32; ++grp) { u4 w[4][4];
#pragma unroll
            for (int k = 0; k < 4; ++k) { const int e = __builtin_amdgcn_readfirstlane(PE[tk * 128 + grp * 4 + k]); const u4* vp = (const u4*)(PV + (size_t)e * 2048) + lane;
#pragma unroll
                for (int j = 0; j < 4; ++j) w[k][j] = vp[64 * j]; }
#pragma unroll
            for (int k = 0; k < 4; ++k) { const float hw = HW[tk * 128 + grp * 4 + k];
#pragma unroll
                for (int j = 0; j < 4; ++j) { float f[8]; unpack8(w[k][j], f);
#pragma unroll
                    for (int i = 0; i < 8; ++i) acc[8 * j + i] += hw * f[i]; } } }
        float s = 0.f;
#pragma unroll
        for (int i = 0; i < 32; ++i) { acc[i] += ALPHA * xr[i]; s += acc[i]; }
        const float mu = wave_sum(s) * (1.f / D); float s2 = 0.f;
#pragma unroll
        for (int i = 0; i < 32; ++i) { acc[i] -= mu; s2 += acc[i] * acc[i]; }
        const float rstd = rsqrtf(wave_sum(s2) * (1.f / D) + LN_EPS);
        const float* gam = P.in[23] + (size_t)l * D; const float* bet = P.in[24] + (size_t)l * D;
        bf16* xb = (bf16*)(P.ws + WS_XB);
#pragma unroll
        for (int j = 0; j < 4; ++j) { const int col = 512 * j + lane * 8;
            const f4 g0 = *(const f4*)(gam + col), g1 = *(const f4*)(gam + col + 4), b0 = *(const f4*)(bet + col), b1 = *(const f4*)(bet + col + 4);
            const f4 o0 = mk_f4(acc[8 * j] * rstd * g0.x + b0.x, acc[8 * j + 1] * rstd * g0.y + b0.y, acc[8 * j + 2] * rstd * g0.z + b0.z, acc[8 * j + 3] * rstd * g0.w + b0.w);
            const f4 o1 = mk_f4(acc[8 * j + 4] * rstd * g1.x + b1.x, acc[8 * j + 5] * rstd * g1.y + b1.y, acc[8 * j + 6] * rstd * g1.z + b1.z, acc[8 * j + 7] * rstd * g1.w + b1.w);
            *(f4*)(xout + n * D + col) = o0; *(f4*)(xout + n * D + col + 4) = o1;
            u4 pk; pk.x = pk2(o0.x, o0.y); pk.y = pk2(o0.z, o0.w); pk.z = pk2(o1.x, o1.y); pk.w = pk2(o1.z, o1.w);
            *(u4*)(xb + n * D + col) = pk; }
    }
    __syncthreads();
}

constexpr int PH_PER_LAYER = 8, N_PHASES = 1 + DEPTH * PH_PER_LAYER;
#ifndef ONLY_PHASE
#define ONLY_PHASE -1
#endif
#define EN(i) (ONLY_PHASE < 0 || ONLY_PHASE == (i))
__global__ void __launch_bounds__(512, 2) mk_fwd(Params P) {
    extern __shared__ __attribute__((aligned(16))) unsigned char lds_raw[];
    LAS unsigned char* lds = (LAS unsigned char*)lds_raw;
    volatile LAS unsigned* MISC = (volatile LAS unsigned*)(lds + MISC_OFF);
    const int tid = threadIdx.x, lane = tid & 63, wave = __builtin_amdgcn_readfirstlane(tid >> 6);
    const int G = gridDim.x, bid = blockIdx.x;
    if (tid < 64) MISC[tid] = 0u;
    __syncthreads();
    unsigned* ctl = (unsigned*)(P.ws + WS_CTL);
    XcdBarrier bar; bar.bar = ctl + CW_BAR; bar.x = 0; bar.st = nullptr;
    if (P.use_bar) bar = xcd_barrier_post(ctl + CW_BAR, MISC + 8);
    const int lo = P.ph_lo, hi = P.ph_hi;
#define IN(k) (lo <= (k) && (k) < hi)
#define LAUNDER() int tl = tid; asm volatile("" : "+v"(tl)); const int ll = tl & 63; const int wl = __builtin_amdgcn_readfirstlane(tl >> 6); (void)ll; (void)wl
#define SEAM(k) do { if (IN((k) + 1)) xcd_barrier(bar); } while (0)
    unsigned char* ws = P.ws;
    if (IN(0) && EN(8)) { LAUNDER(); phase_prologue(P, lds, tl, ll, wl); SEAM(0); }
    for (int l = 0; l < DEPTH; ++l) {
        const int pb = 1 + l * PH_PER_LAYER;
        const float* xres = (l == 0) ? P.in[0] : (const float*)(ws + WS_XC);
        float* xout = (l == DEPTH - 1) ? P.out : (float*)(ws + WS_XC);
        if (IN(pb + 0) && EN(0)) { LAUNDER();
            pg8::Gemm g{(const pg8::bf16_t*)(ws + WS_XB), (const pg8::bf16_t*)(ws + WS_WIN) + (size_t)l * INWP * D, NTOK, INWP, D};
            pg8::StaticOrder S; S.init(NTOK, INWP, G, bid);
            pg8::EpiH E{(pg8::bf16_t*)(ws + WS_H), INWP, 6, 10};
            pg8::gemm_phase<pg8::EpiH, pg8::StaticOrder, true, true>(lds, g, S, E, tl);
            SEAM(pb + 0);
        }
        if (IN(pb + 1) && EN(1)) { LAUNDER();
            for (int u = bid; u < 240; u += G) unit_kvstate(P, lds, u, tl);
            for (int u = bid; u < 256; u += G) unit_sgu(P, l, lds, u, tl, ll, wl);
            for (int u = bid; u < 256; u += G) unit_compress(P, l, lds, u, tl);
            SEAM(pb + 1);
        }
        if (IN(pb + 2) && EN(2)) { LAUNDER();
            for (int u = bid; u < 256; u += G) unit_retention(P, l, lds, u, tl);
            for (int u = bid; u < 512; u += G) unit_nsa(P, l, lds, u, tl);
            SEAM(pb + 2);
        }
        if (IN(pb + 3) && EN(3)) { LAUNDER();
            for (int r = bid * 8 + wl; r < NTOK; r += G * 8) row_mixnorm(P, l, r, ll);
            SEAM(pb + 3);
        }
        if (IN(pb + 4) && EN(4)) { LAUNDER();
            pg8::Gemm g{(const pg8::bf16_t*)(ws + WS_MIXED), (const pg8::bf16_t*)(ws + WS_WOUT) + (size_t)l * D * D, NTOK, D, D};
            pg8::StaticOrder S; S.init(NTOK, D, G, bid);
            pg8::EpiRes E{(float*)(ws + WS_Z), xres, D, ALPHA};
            pg8::gemm_phase<pg8::EpiRes, pg8::StaticOrder, true, true>(lds, g, S, E, tl);
            SEAM(pb + 4);
        }
        if (IN(pb + 5) && EN(5)) { LAUNDER();
            for (int r = bid * 8 + wl; r < NTOK; r += G * 8) row_ln((const float*)(ws + WS_Z), P.in[16] + (size_t)l * D, P.in[17] + (size_t)l * D, (float*)(ws + WS_X1), (bf16*)(ws + WS_X1B), r, ll);
            SEAM(pb + 5);
        }
        if (IN(pb + 6) && EN(6)) { LAUNDER();
            pg8::Gemm g{(const pg8::bf16_t*)(ws + WS_X1B), (const pg8::bf16_t*)(ws + WS_WQ) + (size_t)l * D * D, NTOK, D, D};
            pg8::StaticOrder S; S.init(NTOK, D, G, bid);
            pg8::EpiF32 E{(float*)(ws + WS_QP), D};
            pg8::gemm_phase<pg8::EpiF32, pg8::StaticOrder, true, true>(lds, g, S, E, tl);
            SEAM(pb + 6);
        }
        if (IN(pb + 7) && EN(7)) { LAUNDER();
            for (int u = bid; u < NTOK / 32; u += G) unit_peer(P, l, lds, u, tl, ll, wl, xout);
            SEAM(pb + 7);
        }
    }
#undef IN
#undef SEAM
}

#ifndef MK_ONE_LAUNCH
#define MK_ONE_LAUNCH 1
#endif
extern "C" void kernel_launch(void* const* d_in, const int* in_sizes, int n_in, void* d_out, int out_size, void* d_ws, size_t ws_size, hipStream_t stream) {
    static int grid = 0;
    if (grid == 0) {
        if (n_in != 25 || out_size != NTOK * D || ws_size < WS_END) { fprintf(stderr, "kernel_launch: unexpected shapes: n_in %d out %d ws %zu (need %zu)\n", n_in, out_size, ws_size, (size_t)WS_END); grid = -1; return; }
        int dev = 0, cus = 0, per_cu = 0;
        if (hipGetDevice(&dev) != hipSuccess || hipDeviceGetAttribute(&cus, hipDeviceAttributeMultiprocessorCount, dev) != hipSuccess) { grid = -1; return; }
        if (hipFuncSetAttribute((const void*)mk_fwd, hipFuncAttributeMaxDynamicSharedMemorySize, LDS_BYTES) != hipSuccess) { fprintf(stderr, "kernel_launch: hipFuncSetAttribute failed\n"); grid = -1; return; }
        if (hipOccupancyMaxActiveBlocksPerMultiprocessor(&per_cu, (const void*)mk_fwd, 512, LDS_BYTES) != hipSuccess || per_cu < 1) fprintf(stderr, "kernel_launch: occupancy query says %d\n", per_cu);
        (void)hipGetLastError();
        grid = cus;
    }
    if (grid < 0) return;
    (void)hipMemsetAsync((char*)d_ws + WS_CTL, 0, CTL_ZERO_BYTES, stream);
    Params p{};
    for (int i = 0; i < 25; ++i) p.in[i] = (const float*)d_in[i];
    p.out = (float*)d_out; p.ws = (unsigned char*)d_ws;
    for (int i = 0; i < 32; ++i) p.inv_rev[i] = pow(10000.0, -(double)i / 32.0) / (2.0 * 3.14159265358979323846);
    for (int h = 0; h < 4; ++h) p.lg2[h] = (float)log2(1.0 - pow(2.0, -5.0 - (double)h));
#if MK_ONE_LAUNCH
    p.ph_lo = 0; p.ph_hi = N_PHASES; p.use_bar = 1;
    hipLaunchKernelGGL(mk_fwd, dim3(grid), dim3(512), LDS_BYTES, stream, p);
#else
    for (int k = 0; k < N_PHASES; ++k) { p.ph_lo = k; p.ph_hi = k + 1; p.use_bar = 0;
        hipLaunchKernelGGL(mk_fwd, dim3(grid), dim3(512), LDS_BYTES, stream, p); }
#endif
}
```

```cpp
#include <hip/hip_runtime.h>
#include <cstdio>
#include <cstdint>
#include <cmath>
#define LAS __attribute__((address_space(3)))
namespace pg8 {
#define PG8_LAS __attribute__((address_space(3)))
typedef unsigned short bf16_t;
typedef short bf16x8 __attribute__((ext_vector_type(8)));
typedef float f32x4 __attribute__((ext_vector_type(4)));
typedef unsigned u32x4 __attribute__((ext_vector_type(4)));
constexpr int BM = 256, BK = 64, HALF = 128, HTB = HALF * BK * 2  , STAGE_BYTES = 8 * HTB, NXCD = 8, WGM = 8;

__host__ __device__ __forceinline__ int lds_byte(int r, int c) { const int st = (r >> 4) * 2 + (c >> 5), rr = r & 15, cc = c & 31, ob = rr * 64 + cc * 2; return st * 1024 + (ob ^ (((ob >> 9) & 1) << 5)); }
__host__ __device__ __forceinline__ void stage_rc(int b, int& R, int& C) { const int st = b / 1024, sb = b % 1024, swz = sb ^ (((sb >> 9) & 1) << 5); R = (st >> 1) * 16 + swz / 64; C = (st & 1) * 32 + (swz % 64) / 2; }
__host__ __device__ __forceinline__ int perm32(int rho) { const int n = rho >> 4, i = rho & 15; return 8 * (i >> 2) + 4 * n + (i & 3); }

struct Unit { int pm, pn; };
struct Gemm { const bf16_t* A; const bf16_t* Bt; int M, N, K; };

struct StaticOrder {
    int nM, nN, nwg, G, c;
    __host__ __device__ void init(int M, int N, int G_, int c_) { nM = M / BM; nN = N / BM; nwg = nM * nN; G = G_; c = c_; }
    __host__ __device__ bool next(int i, Unit& u) const {
        const long L = (long)i * G + c; if (L >= nwg) return false;
        int wgid = (int)L; { const int q = nwg / NXCD, r = nwg % NXCD, xcd = wgid % NXCD, off = wgid / NXCD; wgid = (xcd < r ? xcd * (q + 1) : r * (q + 1) + (xcd - r) * q) + off; }
        const int nig = WGM * nN, gid = wgid / nig, fm = gid * WGM, gsz = (nM - fm) < WGM ? (nM - fm) : WGM;
        u.pm = fm + ((wgid % nig) % gsz); u.pn = (wgid % nig) / gsz; return true;
    }
    __device__ __forceinline__ void a_ready(const Unit&) const {}
    __device__ __forceinline__ void done(const Unit&) const {}
};
__device__ __forceinline__ unsigned cvt_pk_bf16(float lo, float hi) { unsigned r; asm volatile("v_cvt_pk_bf16_f32 %0, %1, %2" : "=v"(r) : "v"(lo), "v"(hi)); return r; }
typedef float f32x2 __attribute__((ext_vector_type(2)));
__device__ __forceinline__ float gelu_tanh_f(float x) {
    const float u = 1.5957691216057308f * (x + 0.044715f * x * x * x);
    return x * __builtin_amdgcn_rcpf(1.0f + __expf(-u));
}
struct EpiH {
    static constexpr bool PERM = true, AFTER_DRAIN = false;
    bf16_t* O; int ldc; int act_lo, act_hi;
    __device__ __forceinline__ void operator()(const f32x4 (&acc)[2][2][4][2], const Unit& u, int wr, int wc, int fr, int fq) const {
        const int row0 = u.pm * BM + wr * 64 + fr; const int col0 = u.pn * BM + wc * 32 + 8 * fq;
        const bool act = (u.pn >= act_lo) && (u.pn < act_hi);
#pragma unroll
        for (int ai = 0; ai < 2; ++ai)
#pragma unroll
            for (int m = 0; m < 4; ++m) { bf16_t* rowp = O + (size_t)(row0 + ai * HALF + m * 16) * ldc + col0;
#pragma unroll
                for (int bj = 0; bj < 2; ++bj) { f32x4 v0 = acc[ai][bj][m][0], v1 = acc[ai][bj][m][1];
                    if (act) {
#pragma unroll
                        for (int j = 0; j < 4; ++j) { v0[j] = gelu_tanh_f(v0[j]); v1[j] = gelu_tanh_f(v1[j]); } }
                    u32x4 w; w.x = cvt_pk_bf16(v0[0], v0[1]); w.y = cvt_pk_bf16(v0[2], v0[3]); w.z = cvt_pk_bf16(v1[0], v1[1]); w.w = cvt_pk_bf16(v1[2], v1[3]);
                    *(u32x4*)(rowp + bj * HALF) = w; } }
    }
};
struct EpiRes {
    static constexpr bool PERM = false, AFTER_DRAIN = false;
    float* C; const float* X; int ldc; float alpha;
    __device__ __forceinline__ void operator()(const f32x4 (&acc)[2][2][4][2], const Unit& u, int wr, int wc, int fr, int fq) const {
        const int row0 = u.pm * BM + wr * 64 + fr, col0 = u.pn * BM + wc * 32 + 4 * fq;
#pragma unroll
        for (int ai = 0; ai < 2; ++ai)
#pragma unroll
            for (int m = 0; m < 4; ++m) { const size_t off = (size_t)(row0 + ai * HALF + m * 16) * ldc + col0;
#pragma unroll
                for (int bj = 0; bj < 2; ++bj)
#pragma unroll
                    for (int n = 0; n < 2; ++n) { const size_t o2 = off + bj * HALF + n * 16; const f32x4 xv = *(const f32x4*)(X + o2); *(f32x4*)(C + o2) = acc[ai][bj][m][n] + xv * alpha; } }
    }
};
struct EpiF32 {
    static constexpr bool PERM = false, AFTER_DRAIN = false;
    float* C; int ldc;
    __device__ __forceinline__ void operator()(const f32x4 (&acc)[2][2][4][2], const Unit& u, int wr, int wc, int fr, int fq) const {
        const int row0 = u.pm * BM + wr * 64 + fr, col0 = u.pn * BM + wc * 32 + 4 * fq;
#pragma unroll
        for (int ai = 0; ai < 2; ++ai)
#pragma unroll
            for (int m = 0; m < 4; ++m) { float* rowp = C + (size_t)(row0 + ai * HALF + m * 16) * ldc + col0;
#pragma unroll
                for (int bj = 0; bj < 2; ++bj)
#pragma unroll
                    for (int n = 0; n < 2; ++n) *(f32x4*)(rowp + bj * HALF + n * 16) = acc[ai][bj][m][n]; }
    }
};
template <class Epi, class Sched, bool ALIGN_EPI = false, bool SP2 = false>
__device__ __forceinline__ void gemm_phase(PG8_LAS unsigned char* lds, const Gemm g, const Sched& S, const Epi& E, const int tid) {
    const int wid = __builtin_amdgcn_readfirstlane(tid >> 6), lane = tid & 63, wr = wid >> 2, wc = wid & 3, fr = lane & 15, fq = lane >> 4;
    const int K = g.K, nt = K / BK;
    unsigned voffA[2], voffB[2];
#pragma unroll
    for (int i = 0; i < 2; ++i) { int R, C; stage_rc(tid * 16 + i * 8192, R, C); const int Rb = Epi::PERM ? ((R & ~31) + perm32(R & 31)) : R;
        voffA[i] = (unsigned)(R * K + C) * 2u; voffB[i] = (unsigned)(Rb * K + C) * 2u; }
    const size_t kstep = (size_t)(BK * 2);
    const size_t hstep = (size_t)HALF * K * 2;
    const size_t tstep = 2 * hstep;
    const unsigned ldsw = (unsigned)wid * 1024u;
    const int aoff = lds_byte(wr * 64 + fr, fq * 8), boff = lds_byte(wc * 32 + fr, fq * 8);
#define PG8_SA(b, h) (((b) * 2 + (h)) * HTB)
#define PG8_SB(b, h) ((4 + (b) * 2 + (h)) * HTB)
#define PG8_STAGE(bufoff, gbase, voff) do { _Pragma("unroll") for (int _i = 0; _i < 2; ++_i) \
        __builtin_amdgcn_global_load_lds((const unsigned*)((const char*)(gbase) + (voff)[_i]), (PG8_LAS unsigned*)(lds + (bufoff) + ldsw + _i * 8192), 16, 0, 0); } while (0)
#define PG8_LDA(dst, b, h) do { _Pragma("unroll") for (int m = 0; m < 4; ++m) _Pragma("unroll") for (int k = 0; k < 2; ++k) dst[m][k] = *(const PG8_LAS bf16x8*)(lds + PG8_SA(b, h) + aoff + m * 2048 + k * 1024); } while (0)
#define PG8_LDB(dst, b, h) do { _Pragma("unroll") for (int n = 0; n < 2; ++n) _Pragma("unroll") for (int k = 0; k < 2; ++k) dst[n][k] = *(const PG8_LAS bf16x8*)(lds + PG8_SB(b, h) + boff + n * 2048 + k * 1024); } while (0)
#define PG8_MMA(ai, bj, At, Bt) do { __builtin_amdgcn_s_setprio(1); _Pragma("unroll") for (int m = 0; m < 4; ++m) _Pragma("unroll") for (int n = 0; n < 2; ++n) _Pragma("unroll") for (int k = 0; k < 2; ++k) \
        acc[ai][bj][m][n] = __builtin_amdgcn_mfma_f32_16x16x32_bf16(Bt[n][k], At[m][k], acc[ai][bj][m][n], 0, 0, 0); __builtin_amdgcn_s_setprio(0); } while (0)
#define PG8_WAIT_V(n) asm volatile("s_waitcnt vmcnt(" #n ")" ::: "memory")
#define PG8_WAIT_L(n) asm volatile("s_waitcnt lgkmcnt(" #n ")" ::: "memory")
#define PG8_BAR __builtin_amdgcn_s_barrier()
#define PG8_SCHED __builtin_amdgcn_sched_barrier(0)
    Unit cur, nxt; int ui = 0;
    if (!S.next(0, cur)) return;
    f32x4 acc[2][2][4][2];
#pragma unroll
    for (int a = 0; a < 2; ++a)
#pragma unroll
        for (int b = 0; b < 2; ++b)
#pragma unroll
            for (int m = 0; m < 4; ++m)
#pragma unroll
                for (int n = 0; n < 2; ++n) acc[a][b][m][n] = (f32x4){0.f, 0.f, 0.f, 0.f};
    bf16x8 At[4][2], B0[2][2], B1[2][2];
    const char* cA = (const char*)g.A + (size_t)cur.pm * tstep; const char* cB = (const char*)g.Bt + (size_t)cur.pn * tstep;
    S.a_ready(cur);
    if constexpr (SP2) {
        PG8_STAGE(PG8_SB(0, 0), cB, voffB); PG8_STAGE(PG8_SB(0, 1), cB + hstep, voffB); PG8_STAGE(PG8_SA(0, 0), cA, voffA); PG8_STAGE(PG8_SA(0, 1), cA + hstep, voffA);
        if (wr == 1) PG8_BAR;
        PG8_WAIT_V(2); PG8_BAR;
        PG8_STAGE(PG8_SB(1, 0), cB + kstep, voffB); PG8_STAGE(PG8_SA(1, 0), cA + kstep, voffA); PG8_STAGE(PG8_SB(1, 1), cB + hstep + kstep, voffB);
        PG8_WAIT_V(6); PG8_BAR;
    } else {
        PG8_STAGE(PG8_SB(0, 0), cB, voffB); PG8_STAGE(PG8_SA(0, 0), cA, voffA); PG8_STAGE(PG8_SB(0, 1), cB + hstep, voffB); PG8_STAGE(PG8_SA(0, 1), cA + hstep, voffA);
        if (wr == 1) PG8_BAR;
        PG8_WAIT_V(4); PG8_BAR;
        PG8_STAGE(PG8_SB(1, 0), cB + kstep, voffB); PG8_STAGE(PG8_SA(1, 0), cA + kstep, voffA); PG8_STAGE(PG8_SB(1, 1), cB + hstep + kstep, voffB);
        PG8_WAIT_V(6); PG8_BAR;
    }
    for (;;) {
        const bool has_next = S.next(ui + 1, nxt);
        const char* nA = has_next ? (const char*)g.A + (size_t)nxt.pm * tstep : cA; const char* nB = has_next ? (const char*)g.Bt + (size_t)nxt.pn * tstep : cB;
        for (int t = 0; t < nt; t += 2) {
            const bool last = (t == nt - 2);
            const char* a1 = cA + (size_t)(t + 1) * kstep;
            const char* a2 = last ? nA : cA + (size_t)(t + 2) * kstep; const char* b2 = last ? nB : cB + (size_t)(t + 2) * kstep;
            const char* a3 = a2 + kstep; const char* b3 = b2 + kstep;
            if (last && has_next) S.a_ready(nxt);
            if constexpr (SP2) {
            PG8_LDB(B0, 0, 0); PG8_LDB(B1, 0, 1); PG8_SCHED; PG8_LDA(At, 0, 0); PG8_STAGE(PG8_SA(1, 1), a1 + hstep, voffA);
            PG8_WAIT_V(8); PG8_WAIT_L(0); PG8_BAR; PG8_MMA(0, 0, At, B0); PG8_MMA(0, 1, At, B1); PG8_BAR; PG8_SCHED;
            PG8_LDA(At, 0, 1); PG8_STAGE(PG8_SB(0, 0), b2, voffB); PG8_STAGE(PG8_SB(0, 1), b2 + hstep, voffB); PG8_STAGE(PG8_SA(0, 0), a2, voffA);
            PG8_WAIT_V(8); PG8_WAIT_L(0); PG8_BAR; PG8_MMA(1, 0, At, B0); PG8_MMA(1, 1, At, B1); PG8_BAR; PG8_SCHED;
            PG8_LDB(B0, 1, 0); PG8_LDB(B1, 1, 1); PG8_SCHED; PG8_LDA(At, 1, 0); PG8_STAGE(PG8_SA(0, 1), a2 + hstep, voffA);
            PG8_WAIT_V(8); PG8_WAIT_L(0); PG8_BAR; PG8_MMA(0, 0, At, B0); PG8_MMA(0, 1, At, B1); PG8_BAR; PG8_SCHED;
            PG8_LDA(At, 1, 1); PG8_STAGE(PG8_SB(1, 0), b3, voffB); PG8_STAGE(PG8_SB(1, 1), b3 + hstep, voffB); PG8_STAGE(PG8_SA(1, 0), a3, voffA);
            PG8_WAIT_V(8); PG8_WAIT_L(0); PG8_BAR; PG8_MMA(1, 0, At, B0); PG8_MMA(1, 1, At, B1); PG8_BAR; PG8_SCHED;
            } else {
            PG8_LDB(B0, 0, 0); PG8_SCHED; PG8_LDA(At, 0, 0); PG8_STAGE(PG8_SA(1, 1), a1 + hstep, voffA);
            PG8_WAIT_L(8); PG8_BAR; PG8_WAIT_L(0); PG8_MMA(0, 0, At, B0); PG8_BAR; PG8_SCHED;
            PG8_LDB(B1, 0, 1); PG8_STAGE(PG8_SB(0, 0), b2, voffB);
            PG8_BAR; PG8_WAIT_L(0); PG8_MMA(0, 1, At, B1); PG8_BAR;
            PG8_LDA(At, 0, 1); PG8_STAGE(PG8_SA(0, 0), a2, voffA);
            PG8_BAR; PG8_WAIT_L(0); PG8_MMA(1, 0, At, B0); PG8_BAR; PG8_SCHED;
            PG8_STAGE(PG8_SB(0, 1), b2 + hstep, voffB);
            PG8_WAIT_V(6); PG8_BAR; PG8_MMA(1, 1, At, B1); PG8_BAR;
            PG8_LDB(B0, 1, 0); PG8_SCHED; PG8_LDA(At, 1, 0); PG8_STAGE(PG8_SA(0, 1), a2 + hstep, voffA);
            PG8_WAIT_L(8); PG8_BAR; PG8_WAIT_L(0); PG8_MMA(0, 0, At, B0); PG8_BAR; PG8_SCHED;
            PG8_LDB(B1, 1, 1); PG8_STAGE(PG8_SB(1, 0), b3, voffB);
            PG8_BAR; PG8_WAIT_L(0); PG8_MMA(0, 1, At, B1); PG8_BAR;
            PG8_LDA(At, 1, 1); PG8_STAGE(PG8_SA(1, 0), a3, voffA);
            PG8_BAR; PG8_WAIT_L(0); PG8_MMA(1, 0, At, B0); PG8_BAR; PG8_SCHED;
            PG8_STAGE(PG8_SB(1, 1), b3 + hstep, voffB);
            PG8_WAIT_V(6); PG8_BAR; PG8_MMA(1, 1, At, B1); PG8_BAR;
            }
        }
        if constexpr (ALIGN_EPI) { if (wr == 0) PG8_BAR; }
        if constexpr (!Epi::AFTER_DRAIN) { E(acc, cur, wr, wc, fr, fq); S.done(cur); }
        if (!has_next) break;
#pragma unroll
        for (int a = 0; a < 2; ++a)
#pragma unroll
            for (int b = 0; b < 2; ++b)
#pragma unroll
                for (int m = 0; m < 4; ++m)
#pragma unroll
                    for (int n = 0; n < 2; ++n) acc[a][b][m][n] = (f32x4){0.f, 0.f, 0.f, 0.f};
        cur = nxt; cA = nA; cB = nB; ++ui;
        if constexpr (ALIGN_EPI) { if (wr == 1) PG8_BAR; }
    }
    PG8_WAIT_V(0);
    if constexpr (!ALIGN_EPI) { if (wr == 0) PG8_BAR; }
    PG8_BAR;
    if constexpr (Epi::AFTER_DRAIN) { E.fused(acc, cur, wr, wc, fr, fq, lds, wid, lane); S.done(cur); }
#undef PG8_SA
#undef PG8_SB
#undef PG8_STAGE
#undef PG8_LDA
#undef PG8_LDB
#undef PG8_MMA
#undef PG8_WAIT_V
#undef PG8_WAIT_L
#undef PG8_BAR
#undef PG8_SCHED
}
}
#define XB_TMO      128
#define XB_XCNT(j)  (256  + 64 * (j))
#define XB_XSUB(j)  (1280 + 64 * (j))
#define XB_XGEN(j)  (2304 + 64 * (j))
#define XB_TOP      3328
#define XB_TOPGEN   3392
#define XCD_BAR_WORDS 3456
#define XB_SPIN_CAP (1u << 18)

__device__ __forceinline__ unsigned xb_ld(unsigned* p)              { return __hip_atomic_load(p, __ATOMIC_RELAXED, __HIP_MEMORY_SCOPE_AGENT); }
__device__ __forceinline__ unsigned xb_add(unsigned* p, unsigned v) { return __hip_atomic_fetch_add(p, v, __ATOMIC_RELAXED, __HIP_MEMORY_SCOPE_AGENT); }
__device__ __forceinline__ unsigned xb_xcc_id() { return (unsigned)__builtin_amdgcn_s_getreg((3 << 11) | 20) & 0xFu; }
#define XB_SPIN(cond, bar) do { unsigned _sp = 0; while (cond) { __builtin_amdgcn_s_sleep(1); \
    if ((++_sp & 255u) == 0u) { if (xb_ld(&(bar)[XB_TMO])) break; if (_sp > XB_SPIN_CAP) { atomicAdd(&(bar)[XB_TMO], 1u); break; } } } } while (0)

struct XcdBarrier {
    unsigned* bar; unsigned x;
    volatile LAS unsigned* st;
};

__device__ __forceinline__ XcdBarrier xcd_barrier_post(unsigned* bar, volatile LAS unsigned* st) {
    XcdBarrier b; b.bar = bar; b.x = xb_xcc_id(); b.st = st;
    if (threadIdx.x == 0) (void)xb_add(&bar[XB_XCNT(b.x)], 1u);
    return b;
}
__device__ __forceinline__ void xcd_barrier_complete(unsigned* bar, unsigned x, unsigned& nloc, unsigned& nx) {
    const unsigned G = gridDim.x * gridDim.y * gridDim.z;
    unsigned sum, cnt, mine, sp = 0u;
    for (;;) {
        sum = 0u; cnt = 0u; mine = 0u;
#pragma unroll
        for (unsigned j = 0; j < 16; ++j) { const unsigned c = xb_ld(&bar[XB_XCNT(j)]); sum += c; cnt += (c > 0u) ? 1u : 0u; mine = (j == x) ? c : mine; }
        if (sum == G) break;
        __builtin_amdgcn_s_sleep(1);
        if ((++sp & 255u) == 0u) { if (xb_ld(&bar[XB_TMO])) break; if (sp > XB_SPIN_CAP) { atomicAdd(&bar[XB_TMO], 1u); break; } }
    }
    nloc = mine > 0u ? mine : 1u; nx = cnt > 0u ? cnt : 1u;
}

__device__ __forceinline__ void xcd_barrier(const XcdBarrier& b) {
    asm volatile("s_waitcnt vmcnt(0)" ::: "memory");
    __syncthreads();
    if (threadIdx.x == 0) {
        unsigned* bar = b.bar;
        __builtin_amdgcn_s_waitcnt(0);
        unsigned nloc = b.st[0], nx = b.st[1];
        if (nloc == 0u) { xcd_barrier_complete(bar, b.x, nloc, nx); b.st[0] = nloc; b.st[1] = nx; }
        const unsigned old = xb_add(&bar[XB_XSUB(b.x)], 1u);
        const unsigned gen = old / nloc;
        if (old + 1u == (gen + 1u) * nloc) {
            __builtin_amdgcn_fence(__ATOMIC_RELEASE, "agent");
            asm volatile("s_waitcnt vmcnt(0)" ::: "memory");
            const unsigned og = xb_add(&bar[XB_TOP], 1u);
            const unsigned tg = og / nx;
            if (og + 1u == (tg + 1u) * nx) xb_add(&bar[XB_TOPGEN], 1u);
            else XB_SPIN(xb_ld(&bar[XB_TOPGEN]) == tg, bar);
            __builtin_amdgcn_fence(__ATOMIC_ACQUIRE, "agent");
            xb_add(&bar[XB_XGEN(b.x)], 1u);
            asm volatile("s_waitcnt vmcnt(0)" ::: "memory");
        } else {
            XB_SPIN(xb_ld(&bar[XB_XGEN(b.x)]) == gen, bar);
            __builtin_amdgcn_fence(__ATOMIC_ACQUIRE, "agent");
            asm volatile("s_waitcnt vmcnt(0)" ::: "memory");
        }
    }
    __syncthreads();
}

constexpr int NB = 4, T = 2048, D = 2048, NTOK = NB * T, DEPTH = 4;
constexpr int INW = 5168, INWP = 5376;
constexpr int C_RQ = 0, C_RK = 256, C_RV = 512, C_RG = 1024, C_SU = 1536, C_SV = 2048, C_NQ = 2560, C_KC = 3584, C_VC = 3840, C_KS = 4096, C_VS = 4352, C_KW = 4608, C_VW = 4864, C_NG = 5120;
constexpr float ALPHA = 1.6817928305074290f;
constexpr float LN_EPS = 1e-5f;
constexpr float LOG2E = 1.4426950408889634f;

constexpr size_t MiB = (size_t)1 << 20;
constexpr size_t WS_CTL = 0, CTL_ZERO_BYTES = 1 * MiB;
constexpr size_t WS_ROPE = 1 * MiB;
constexpr size_t WS_WIN = 2 * MiB;
constexpr size_t WS_WOUT = 86 * MiB;
constexpr size_t WS_WQ = 118 * MiB;
constexpr size_t WS_PU = 160 * MiB;
constexpr size_t WS_PV = 416 * MiB;
constexpr size_t WS_H = 672 * MiB;
constexpr size_t WS_YMIX = 756 * MiB;
constexpr size_t WS_MIXED = 820 * MiB;
constexpr size_t WS_Z = 852 * MiB;
constexpr size_t WS_X1 = 916 * MiB;
constexpr size_t WS_X1B = 980 * MiB;
constexpr size_t WS_QP = 1012 * MiB;
constexpr size_t WS_XC = 1076 * MiB;
constexpr size_t WS_XB = 1140 * MiB;
constexpr size_t WS_KC = 1172 * MiB;
constexpr size_t WS_KVST = 1174 * MiB;
constexpr size_t WS_SC = 1184 * MiB;
constexpr size_t WS_END = 1248 * MiB;
constexpr int CW_BAR = 4096;

constexpr int LDS_BYTES = 147456;
constexpr int MISC_OFF = 143360;

#define GAS __attribute__((address_space(1)))
typedef float f4 __attribute__((ext_vector_type(4)));
typedef float f2 __attribute__((ext_vector_type(2)));
typedef unsigned u4 __attribute__((ext_vector_type(4)));
typedef unsigned u2 __attribute__((ext_vector_type(2)));
__device__ __forceinline__ f4 mk_f4(float a, float b, float c, float d) { f4 r; r.x = a; r.y = b; r.z = c; r.w = d; return r; }
__device__ __forceinline__ f2 mk_f2(float a, float b) { f2 r; r.x = a; r.y = b; return r; }
__device__ __forceinline__ u2 mk_u2(unsigned a, unsigned b) { u2 r; r.x = a; r.y = b; return r; }
typedef unsigned short bf16;
#define LDS_WAIT() asm volatile("s_waitcnt lgkmcnt(0)" ::: "memory")
#define VM_WAIT() asm volatile("s_waitcnt vmcnt(0)" ::: "memory")

struct Params {
    const float* in[25];
    float* out;
    unsigned char* ws;
    double inv_rev[32];
    float lg2[4];
    int ph_lo, ph_hi, use_bar, pad0;
};

__device__ __forceinline__ float bf2f(unsigned short b) { return __uint_as_float(((unsigned)b) << 16); }
__device__ __forceinline__ unsigned f2bf(float f) { unsigned u = __float_as_uint(f); return (u + 0x7fffu + ((u >> 16) & 1u)) >> 16; }
__device__ __forceinline__ unsigned pk2(float lo, float hi) { return f2bf(lo) | (f2bf(hi) << 16); }
__device__ __forceinline__ float wave_sum(float v) {
#pragma unroll
    for (int o = 1; o < 64; o <<= 1) v += __shfl_xor(v, o);
    return v;
}
__device__ __forceinline__ void unpack8(const u4& v, float* f) {
    f[0] = __uint_as_float(v.x << 16); f[1] = __uint_as_float(v.x & 0xffff0000u);
    f[2] = __uint_as_float(v.y << 16); f[3] = __uint_as_float(v.y & 0xffff0000u);
    f[4] = __uint_as_float(v.z << 16); f[5] = __uint_as_float(v.z & 0xffff0000u);
    f[6] = __uint_as_float(v.w << 16); f[7] = __uint_as_float(v.w & 0xffff0000u);
}
__device__ __forceinline__ float gelu_tanh(float x) { return pg8::gelu_tanh_f(x); }

__device__ __forceinline__ void transpose_tile(const float* __restrict__ W, int K, int N, bf16* __restrict__ WT, LAS float* scr, int kb, int nb, int lane) {
    const int k0 = kb * 64, n0 = nb * 32, nn = lane & 31; const bool ok = (n0 + nn) < N;
#pragma unroll 8
    for (int i = 0; i < 32; ++i) { const int kk = 2 * i + (lane >> 5); scr[kk * 33 + nn] = ok ? W[(size_t)(k0 + kk) * N + n0 + nn] : 0.f; }
    LDS_WAIT();
    const int c = lane & 7;
#pragma unroll
    for (int j = 0; j < 4; ++j) { const int n = (lane >> 3) + 8 * j; const LAS float* s = scr + (8 * c) * 33 + n;
        u4 o; o.x = pk2(s[0 * 33], s[1 * 33]); o.y = pk2(s[2 * 33], s[3 * 33]); o.z = pk2(s[4 * 33], s[5 * 33]); o.w = pk2(s[6 * 33], s[7 * 33]);
        *(u4*)(WT + (size_t)(n0 + n) * K + k0 + 8 * c) = o; }
    LDS_WAIT();
}
__device__ __forceinline__ void cvt_bf16_stream(const float* __restrict__ src, bf16* __restrict__ dst, size_t nchunks, size_t gt, size_t GT) {
    for (size_t c = gt; c < nchunks; c += GT) { const f4 a = ((const f4*)src)[2 * c], b = ((const f4*)src)[2 * c + 1];
        u4 o; o.x = pk2(a.x, a.y); o.y = pk2(a.z, a.w); o.z = pk2(b.x, b.y); o.w = pk2(b.z, b.w); ((u4*)dst)[c] = o; }
}
__device__ __forceinline__ void phase_prologue(const Params& P, LAS unsigned char* lds, int tid, int lane, int wave) {
    unsigned char* ws = P.ws;
    LAS float* scr = (LAS float*)(lds + wave * 8704);
    const int gw = blockIdx.x * 8 + wave, NGW = gridDim.x * 8;
    constexpr int I_IN = 32 * 168, I_SQ = 32 * 64, I_L = I_IN + 2 * I_SQ;
    for (int it = gw; it < DEPTH * I_L; it += NGW) {
        const int l = it / I_L; int r = it % I_L;
        if (r < I_IN) transpose_tile(P.in[1] + (size_t)l * D * INW, D, INW, (bf16*)(ws + WS_WIN) + (size_t)l * INWP * D, scr, r / 168, r % 168, lane);
        else { r -= I_IN;
            if (r < I_SQ) transpose_tile(P.in[15] + (size_t)l * D * D, D, D, (bf16*)(ws + WS_WOUT) + (size_t)l * D * D, scr, r / 64, r % 64, lane);
            else { r -= I_SQ; transpose_tile(P.in[18] + (size_t)l * D * D, D, D, (bf16*)(ws + WS_WQ) + (size_t)l * D * D, scr, r / 64, r % 64, lane); } }
    }
    const size_t gt = (size_t)blockIdx.x * 512 + tid, GT = (size_t)gridDim.x * 512;
    cvt_bf16_stream(P.in[21], (bf16*)(ws + WS_PU), (size_t)DEPTH * 16384 * 2048 / 8, gt, GT);
    cvt_bf16_stream(P.in[22], (bf16*)(ws + WS_PV), (size_t)DEPTH * 16384 * 2048 / 8, gt, GT);
    cvt_bf16_stream(P.in[0], (bf16*)(ws + WS_XB), (size_t)NTOK * D / 8, gt, GT);
    f2* rope = (f2*)(ws + WS_ROPE);
    for (size_t idx = gt; idx < (size_t)T * 32; idx += GT) { const int t = (int)(idx >> 5), i = (int)(idx & 31);
        double a = (double)t * P.inv_rev[i]; a -= floor(a); const float fr = (float)a;
        rope[idx] = mk_f2(__builtin_amdgcn_cosf(fr), __builtin_amdgcn_sinf(fr)); }
}

__device__ __forceinline__ void stage_rot_k(const bf16* __restrict__ Hb, const f2* __restrict__ rope, LAS float* ks, int tok0, int tpos0, int colK, float lg2h, bool zeta, int tid) {
    const int m = tid >> 2, p = tid & 3;
    const bf16* src = Hb + (size_t)(tok0 + m) * INWP + colK + p * 8;
    const u4 a = *(const u4*)src, b = *(const u4*)(src + 32);
    float x1[8], x2[8]; unpack8(a, x1); unpack8(b, x2);
    const f4* rp = (const f4*)(rope + (size_t)(tpos0 + m) * 32 + p * 8);
    const f4 r0 = rp[0], r1 = rp[1], r2 = rp[2], r3 = rp[3];
    const float cs[8] = {r0.x, r0.z, r1.x, r1.z, r2.x, r2.z, r3.x, r3.z}, sn[8] = {r0.y, r0.w, r1.y, r1.w, r2.y, r2.w, r3.y, r3.w};
    const float sc = 0.125f * (zeta ? exp2f(lg2h * (float)(127 - m)) : 1.0f);
    float o1[8], o2[8];
#pragma unroll
    for (int i = 0; i < 8; ++i) { o1[i] = (x1[i] * cs[i] - x2[i] * sn[i]) * sc; o2[i] = (x1[i] * sn[i] + x2[i] * cs[i]) * sc; }
    LAS f4* d1 = (LAS f4*)(ks + m * 64 + p * 8); LAS f4* d2 = (LAS f4*)(ks + m * 64 + 32 + p * 8);
    d1[0] = mk_f4(o1[0], o1[1], o1[2], o1[3]); d1[1] = mk_f4(o1[4], o1[5], o1[6], o1[7]);
    d2[0] = mk_f4(o2[0], o2[1], o2[2], o2[3]); d2[1] = mk_f4(o2[4], o2[5], o2[6], o2[7]);
}
__device__ __forceinline__ void stage_v128(const bf16* __restrict__ Hb, LAS float* vs, int tok0, int colV, int tid) {
    const int m = tid >> 2, p = tid & 3;
    const u4* src = (const u4*)(Hb + (size_t)(tok0 + m) * INWP + colV + p * 32);
    LAS f4* dst = (LAS f4*)(vs + m * 128 + p * 32);
#pragma unroll
    for (int j = 0; j < 4; ++j) { const u4 a = src[j]; float f[8]; unpack8(a, f); dst[2 * j] = mk_f4(f[0], f[1], f[2], f[3]); dst[2 * j + 1] = mk_f4(f[4], f[5], f[6], f[7]); }
}

__device__ __forceinline__ void unit_kvstate(const Params& P, LAS unsigned char* lds, int u, int tid) {
    const int b = u / 60, r = u % 60, h = r / 15, j = r % 15;
    const bf16* Hb = (const bf16*)(P.ws + WS_H); const f2* rope = (const f2*)(P.ws + WS_ROPE);
    LAS float* ks = (LAS float*)lds; LAS float* vs = (LAS float*)(lds + 32768);
    const int tok0 = b * T + j * 128;
    stage_rot_k(Hb, rope, ks, tok0, j * 128, C_RK + h * 64, P.lg2[h], true, tid);
    stage_v128(Hb, vs, tok0, C_RV + h * 128, tid);
    __syncthreads();
    const int d = tid >> 3, e0 = (tid & 7) * 16;
    float acc[16];
#pragma unroll
    for (int i = 0; i < 16; ++i) acc[i] = 0.f;
    #pragma unroll 1
    for (int m = 0; m < 128; ++m) { const float kd = ks[m * 64 + d]; const LAS f4* vp = (const LAS f4*)(vs + m * 128 + e0);
#pragma unroll
        for (int q = 0; q < 4; ++q) { const f4 v = vp[q]; acc[4 * q] += kd * v.x; acc[4 * q + 1] += kd * v.y; acc[4 * q + 2] += kd * v.z; acc[4 * q + 3] += kd * v.w; } }
    f4* dst = (f4*)((float*)(P.ws + WS_KVST) + ((size_t)((b * 4 + h) * 16 + j) * 64 + d) * 128 + e0);
#pragma unroll
    for (int q = 0; q < 4; ++q) dst[q] = mk_f4(acc[4 * q], acc[4 * q + 1], acc[4 * q + 2], acc[4 * q + 3]);
    __syncthreads();
}

__device__ __forceinline__ void unit_sgu(const Params& P, int l, LAS unsigned char* lds, int u, int tid, int lane, int wave) {
    const int b = u >> 6, c = (u >> 2) & 15, g = u & 3;
    const bf16* Hb = (const bf16*)(P.ws + WS_H);
    LAS float* vn = (LAS float*)lds;
    LAS float* wsm = (LAS float*)(lds + 65536);
    const int tok0 = b * T + c * 128;
    const float* lng = P.in[4] + l * 512 + g * 128; const float* lnb = P.in[5] + l * 512 + g * 128;
    const float g0 = lng[2 * lane], g1 = lng[2 * lane + 1], b0 = lnb[2 * lane], b1 = lnb[2 * lane + 1];
    for (int i = 0; i < 16; ++i) { const int s = wave * 16 + i;
        const unsigned pr = *(const unsigned*)(Hb + (size_t)(tok0 + s) * INWP + C_SV + g * 128 + 2 * lane);
        const float v0 = __uint_as_float(pr << 16), v1 = __uint_as_float(pr & 0xffff0000u);
        const float mu = wave_sum(v0 + v1) * (1.f / 128.f); const float d0 = v0 - mu, d1 = v1 - mu;
        const float var = wave_sum(d0 * d0 + d1 * d1) * (1.f / 128.f); const float rstd = rsqrtf(var + LN_EPS);
        *(LAS f2*)(vn + s * 128 + 2 * lane) = mk_f2(d0 * rstd * g0 + b0, d1 * rstd * g1 + b1); }
    const float* wg = P.in[6] + ((size_t)l * 4 + g) * 16384;
    for (int i = 0; i < 32; ++i) { const int idx = tid + 512 * i; wsm[(idx >> 7) * 129 + (idx & 127)] = wg[idx]; }
    __syncthreads();
    const int t = tid >> 2, dg = tid & 3; const int smax = (t | 15);
    float acc[32];
#pragma unroll
    for (int i = 0; i < 32; ++i) acc[i] = 0.f;
    #pragma unroll 1
    for (int s = 0; s <= smax; ++s) { const float wv = (s <= t) ? wsm[t * 129 + s] : 0.f; const LAS f4* vp = (const LAS f4*)(vn + s * 128 + dg * 32);
#pragma unroll
        for (int q = 0; q < 8; ++q) { const f4 v = vp[q]; acc[4 * q] += wv * v.x; acc[4 * q + 1] += wv * v.y; acc[4 * q + 2] += wv * v.z; acc[4 * q + 3] += wv * v.w; } }
    const float bs = P.in[7][(l * 4 + g) * 128 + t];
    const u4* up = (const u4*)(Hb + (size_t)(tok0 + t) * INWP + C_SU + g * 128 + dg * 32);
    f4* yo = (f4*)((float*)(P.ws + WS_YMIX) + (size_t)(tok0 + t) * D + 512 + g * 128 + dg * 32);
#pragma unroll
    for (int j = 0; j < 4; ++j) { const u4 a = up[j]; float f[8]; unpack8(a, f);
        yo[2 * j] = mk_f4(f[0] * (acc[8 * j] + bs), f[1] * (acc[8 * j + 1] + bs), f[2] * (acc[8 * j + 2] + bs), f[3] * (acc[8 * j + 3] + bs));
        yo[2 * j + 1] = mk_f4(f[4] * (acc[8 * j + 4] + bs), f[5] * (acc[8 * j + 5] + bs), f[6] * (acc[8 * j + 6] + bs), f[7] * (acc[8 * j + 7] + bs)); }
    __syncthreads();
}

__device__ __forceinline__ void unit_compress(const Params& P, int l, LAS unsigned char* lds, int u, int tid) {
    const int kv = u >> 7, b = (u >> 5) & 3, g = (u >> 3) & 3, r = u & 7;
    const bf16* Hb = (const bf16*)(P.ws + WS_H);
    LAS float* seg = (LAS float*)lds;
    LAS float* hid = (LAS float*)(lds + 69632);
    const int col0 = (kv ? C_VC : C_KC) + g * 64;
    const float* pe = P.in[kv ? 11 : 8] + (size_t)l * 2048;
    const float* w1 = P.in[kv ? 12 : 9] + (size_t)l * 2048 * 256;
    const float* w2 = P.in[kv ? 13 : 10] + (size_t)l * 256 * 64;
    for (int idx = tid; idx < 272 * 8; idx += 512) { const int tt = idx >> 3, d8 = (idx & 7) * 8; const int t = 256 * r + tt;
        float f[8];
        if (t < T) { const u4 a = *(const u4*)(Hb + (size_t)(b * T + t) * INWP + col0 + d8); unpack8(a, f); }
        else {
#pragma unroll
            for (int i = 0; i < 8; ++i) f[i] = 0.f; }
        LAS f4* dp = (LAS f4*)(seg + tt * 64 + d8); dp[0] = mk_f4(f[0], f[1], f[2], f[3]); dp[1] = mk_f4(f[4], f[5], f[6], f[7]); }
    __syncthreads();
    const int j = tid & 255, hb = tid >> 8;
    float acc[8], accpe = 0.f;
#pragma unroll
    for (int i = 0; i < 8; ++i) acc[i] = 0.f;
    for (int pos = 0; pos < 32; ++pos) {
#pragma unroll 2
        for (int d4 = 0; d4 < 16; ++d4) { const int kk = pos * 64 + d4 * 4;
            const float w0 = w1[(size_t)(kk + 0) * 256 + j], w1v = w1[(size_t)(kk + 1) * 256 + j], w2v = w1[(size_t)(kk + 2) * 256 + j], w3 = w1[(size_t)(kk + 3) * 256 + j];
            const f4 p4 = *(const f4*)(pe + kk);
            accpe += w0 * p4.x + w1v * p4.y + w2v * p4.z + w3 * p4.w;
#pragma unroll
            for (int ib = 0; ib < 8; ++ib) { const f4 s4 = *(const LAS f4*)(seg + (16 * (hb * 8 + ib) + pos) * 64 + d4 * 4);
                acc[ib] += w0 * s4.x + w1v * s4.y + w2v * s4.z + w3 * s4.w; } } }
#pragma unroll
    for (int ib = 0; ib < 8; ++ib) hid[(hb * 8 + ib) * 256 + j] = gelu_tanh(acc[ib] + accpe);
    __syncthreads();
    { const int i = tid >> 5, o2 = (tid & 31) * 2; float a0 = 0.f, a1 = 0.f;
        for (int jj = 0; jj < 256; ++jj) { const float hv = hid[i * 256 + jj]; const f2 w = *(const f2*)(w2 + jj * 64 + o2); a0 += hv * w.x; a1 += hv * w.y; }
        const int ci = 16 * r + i;
        if (ci <= 126) *(f2*)((float*)(P.ws + WS_KC) + ((size_t)((kv * 4 + b) * 4 + g) * 128 + ci) * 64 + o2) = mk_f2(a0, a1); }
    __syncthreads();
}

__device__ __forceinline__ void unit_retention(const Params& P, int l, LAS unsigned char* lds, int u, int tid) {
    const int b = u >> 6, h = (u >> 4) & 3, c = u & 15;
    const bf16* Hb = (const bf16*)(P.ws + WS_H); const f2* rope = (const f2*)(P.ws + WS_ROPE);
    LAS float* regB = (LAS float*)lds;
    LAS float* vs = (LAS float*)(lds + 32768);
    LAS float* Qs = (LAS float*)(lds + 98304);
    const float lg2h = P.lg2[h];
    const int tok0 = b * T + c * 128;
    { float a[16];
#pragma unroll
        for (int i = 0; i < 16; ++i) a[i] = 0.f;
        const float* kvb = (const float*)(P.ws + WS_KVST) + (size_t)((b * 4 + h) * 16) * 8192 + tid * 16;
#pragma unroll 1
        for (int j = 0; j < c; ++j) { const float w = exp2f(lg2h * 128.f * (float)(c - 1 - j)); const f4* sp = (const f4*)(kvb + (size_t)j * 8192);
#pragma unroll
            for (int q = 0; q < 4; ++q) { const f4 v = sp[q]; a[4 * q] += w * v.x; a[4 * q + 1] += w * v.y; a[4 * q + 2] += w * v.z; a[4 * q + 3] += w * v.w; } }
        LAS f4* dp = (LAS f4*)(regB + tid * 16);
#pragma unroll
        for (int q = 0; q < 4; ++q) dp[q] = mk_f4(a[4 * q], a[4 * q + 1], a[4 * q + 2], a[4 * q + 3]); }
    const int n = tid >> 2, eg = tid & 3;
    float qa[8], qb[8];
    { const bf16* src = Hb + (size_t)(tok0 + n) * INWP + C_RQ + h * 64 + eg * 8;
        const u4 a = *(const u4*)src, bb = *(const u4*)(src + 32);
        float x1[8], x2[8]; unpack8(a, x1); unpack8(bb, x2);
        const f4* rp = (const f4*)(rope + (size_t)(c * 128 + n) * 32 + eg * 8);
        const f4 r0 = rp[0], r1 = rp[1], r2 = rp[2], r3 = rp[3];
        const float cs[8] = {r0.x, r0.z, r1.x, r1.z, r2.x, r2.z, r3.x, r3.z}, sn[8] = {r0.y, r0.w, r1.y, r1.w, r2.y, r2.w, r3.y, r3.w};
#pragma unroll
        for (int i = 0; i < 8; ++i) { qa[i] = x1[i] * cs[i] - x2[i] * sn[i]; qb[i] = x1[i] * sn[i] + x2[i] * cs[i]; Qs[n * 65 + eg * 8 + i] = qa[i]; Qs[n * 65 + 32 + eg * 8 + i] = qb[i]; } }
    __syncthreads();
    float acc[32];
#pragma unroll
    for (int i = 0; i < 32; ++i) acc[i] = 0.f;
#pragma unroll 2
    for (int d = 0; d < 64; ++d) { const float qd = Qs[n * 65 + d]; const LAS f4* sp = (const LAS f4*)(regB + d * 128 + eg * 32);
#pragma unroll
        for (int qq = 0; qq < 8; ++qq) { const f4 v = sp[qq]; acc[4 * qq] += qd * v.x; acc[4 * qq + 1] += qd * v.y; acc[4 * qq + 2] += qd * v.z; acc[4 * qq + 3] += qd * v.w; } }
    { const float xi = exp2f(lg2h * (float)(n + 1));
#pragma unroll
        for (int i = 0; i < 32; ++i) acc[i] *= xi; }
    __syncthreads();
    stage_rot_k(Hb, rope, regB, tok0, c * 128, C_RK + h * 64, lg2h, false, tid);
    stage_v128(Hb, vs, tok0, C_RV + h * 128, tid);
    __syncthreads();
    const int mmax = n | 15;
#pragma unroll 1
    for (int m = 0; m <= mmax; ++m) { const LAS f4* kp = (const LAS f4*)(regB + m * 64 + eg * 8); const LAS f4* kp2 = (const LAS f4*)(regB + m * 64 + 32 + eg * 8);
        const f4 k0 = kp[0], k1 = kp[1], k2 = kp2[0], k3 = kp2[1];
        float s = ((qa[0] * k0.x + qa[1] * k0.y) + (qa[2] * k0.z + qa[3] * k0.w)) + ((qa[4] * k1.x + qa[5] * k1.y) + (qa[6] * k1.z + qa[7] * k1.w))
                + ((qb[0] * k2.x + qb[1] * k2.y) + (qb[2] * k2.z + qb[3] * k2.w)) + ((qb[4] * k3.x + qb[5] * k3.y) + (qb[6] * k3.z + qb[7] * k3.w));
        s += __shfl_xor(s, 1); s += __shfl_xor(s, 2);
        const float a = (m <= n) ? s * exp2f(lg2h * (float)(n - m)) : 0.f;
        const LAS f4* vp = (const LAS f4*)(vs + m * 128 + eg * 32);
#pragma unroll
        for (int qq = 0; qq < 8; ++qq) { const f4 v = vp[qq]; acc[4 * qq] += a * v.x; acc[4 * qq + 1] += a * v.y; acc[4 * qq + 2] += a * v.z; acc[4 * qq + 3] += a * v.w; } }
    float s1 = 0.f;
#pragma unroll
    for (int i = 0; i < 32; ++i) s1 += acc[i];
    s1 += __shfl_xor(s1, 1); s1 += __shfl_xor(s1, 2);
    const float mu = s1 * (1.f / 128.f); float s2 = 0.f;
#pragma unroll
    for (int i = 0; i < 32; ++i) { const float dd = acc[i] - mu; s2 += dd * dd; }
    s2 += __shfl_xor(s2, 1); s2 += __shfl_xor(s2, 2);
    const float rstd = rsqrtf(s2 * (1.f / 128.f) + LN_EPS);
    const float* gg = P.in[2] + l * 512 + h * 128 + eg * 32; const float* gb = P.in[3] + l * 512 + h * 128 + eg * 32;
    const u4* gp = (const u4*)(Hb + (size_t)(tok0 + n) * INWP + C_RG + h * 128 + eg * 32);
    f4* yo = (f4*)((float*)(P.ws + WS_YMIX) + (size_t)(tok0 + n) * D + h * 128 + eg * 32);
#pragma unroll
    for (int j = 0; j < 4; ++j) { const u4 a = gp[j]; float f[8]; unpack8(a, f); float o[8];
#pragma unroll
        for (int i = 0; i < 8; ++i) { const float y = (acc[8 * j + i] - mu) * rstd * gg[8 * j + i] + gb[8 * j + i]; const float gv = f[i]; o[i] = y * gv * __builtin_amdgcn_rcpf(1.f + __expf(-gv)); }
        yo[2 * j] = mk_f4(o[0], o[1], o[2], o[3]); yo[2 * j + 1] = mk_f4(o[4], o[5], o[6], o[7]); }
    __syncthreads();
}

typedef pg8::bf16x8 bf16x8;
typedef short s16x4 __attribute__((ext_vector_type(4)));
typedef __bf16 bf16x2_t __attribute__((ext_vector_type(2)));
__device__ __forceinline__ unsigned pkbf(float a, float b) { f2 v; v.x = a; v.y = b; return __builtin_bit_cast(unsigned, __builtin_convertvector(v, bf16x2_t)); }
#define MFMA16(a, b, c) __builtin_amdgcn_mfma_f32_16x16x32_bf16((a), (b), (c), 0, 0, 0)
constexpr int NSA_KST = 72, NSA_VST = 136;
constexpr float NSA_SC = 0.125f * LOG2E;
__device__ __forceinline__ void nsa_scores(f4 (&st)[4][2], const LAS bf16* Kl, const bf16x8 (&Yq)[2][2], int lane) {
    const int r = lane & 15, kq = lane >> 4;
#pragma unroll
    for (int kt = 0; kt < 4; ++kt) { const LAS bf16* kp = Kl + (16 * kt + r) * NSA_KST + 8 * kq;
        const bf16x8 k0 = *(const LAS bf16x8*)kp, k1 = *(const LAS bf16x8*)(kp + 32);
#pragma unroll
        for (int qp = 0; qp < 2; ++qp) { f4 a = mk_f4(0.f, 0.f, 0.f, 0.f); a = MFMA16(k0, Yq[qp][0], a); a = MFMA16(k1, Yq[qp][1], a); st[kt][qp] = a; } }
}
__device__ __forceinline__ void nsa_softmax_pv(f4 (&st)[4][2], float (&m)[2], float (&l)[2], f4 (&ot)[4][2], const LAS bf16* Vt, const int (&lo)[2], const int (&hi)[2], bool need_mask, int lane) {
    const int r = lane & 15, kq = lane >> 4;
    bf16x8 Pf[2][2];
#pragma unroll
    for (int qp = 0; qp < 2; ++qp) {
        if (need_mask) {
#pragma unroll
            for (int kt = 0; kt < 4; ++kt)
#pragma unroll
                for (int i = 0; i < 4; ++i) { const int kl = 16 * kt + 4 * kq + i; if (kl < lo[qp] || kl > hi[qp]) st[kt][qp][i] = -1e30f; } }
        float mx = st[0][qp][0];
#pragma unroll
        for (int kt = 0; kt < 4; ++kt)
#pragma unroll
            for (int i = 0; i < 4; ++i) mx = fmaxf(mx, st[kt][qp][i]);
        mx = fmaxf(mx, __shfl_xor(mx, 16)); mx = fmaxf(mx, __shfl_xor(mx, 32));
        const float mn = fmaxf(m[qp], mx); const float corr = __builtin_amdgcn_exp2f((m[qp] - mn) * NSA_SC); m[qp] = mn; l[qp] *= corr;
#pragma unroll
        for (int dt = 0; dt < 4; ++dt) ot[dt][qp] *= corr;
        const float msc = mn * NSA_SC; float ps = 0.f;
#pragma unroll
        for (int kt = 0; kt < 4; ++kt)
#pragma unroll
            for (int i = 0; i < 4; ++i) { const float p = __builtin_amdgcn_exp2f(st[kt][qp][i] * NSA_SC - msc); st[kt][qp][i] = p; ps += p; }
        l[qp] += ps;
#pragma unroll
        for (int ksp = 0; ksp < 2; ++ksp) { u4 w; w.x = pkbf(st[2 * ksp][qp][0], st[2 * ksp][qp][1]); w.y = pkbf(st[2 * ksp][qp][2], st[2 * ksp][qp][3]);
            w.z = pkbf(st[2 * ksp + 1][qp][0], st[2 * ksp + 1][qp][1]); w.w = pkbf(st[2 * ksp + 1][qp][2], st[2 * ksp + 1][qp][3]); Pf[qp][ksp] = __builtin_bit_cast(bf16x8, w); }
    }
#pragma unroll
    for (int dt = 0; dt < 4; ++dt)
#pragma unroll
        for (int ksp = 0; ksp < 2; ++ksp) { const LAS bf16* vp = Vt + (16 * dt + r) * NSA_VST + 32 * ksp + 4 * kq;
            const s16x4 va = *(const LAS s16x4*)vp, vb = *(const LAS s16x4*)(vp + 16);
            const bf16x8 vf = __builtin_shufflevector(va, vb, 0, 1, 2, 3, 4, 5, 6, 7);
#pragma unroll
            for (int qp = 0; qp < 2; ++qp) ot[dt][qp] = MFMA16(vf, Pf[qp][ksp], ot[dt][qp]); }
}
__device__ __forceinline__ void nsa_accum(f4 (&tot)[4][2], const f4 (&ot)[4][2], const float (&l)[2], const float (&gate)[2]) {
#pragma unroll
    for (int qp = 0; qp < 2; ++qp) { float lt = l[qp]; lt += __shfl_xor(lt, 16); lt += __shfl_xor(lt, 32); const float sc = (lt > 0.f) ? gate[qp] / lt : 0.f;
#pragma unroll
        for (int dt = 0; dt < 4; ++dt) tot[dt][qp] += ot[dt][qp] * sc; }
}
__device__ __forceinline__ void nsa_kv_prefetch(const bf16* __restrict__ Hb, int tokbase, int colK, int colV, int tid, u4& kreg, u4& vreg) {
    kreg = *(const u4*)(Hb + (size_t)(tokbase + (tid >> 3)) * INWP + colK + (tid & 7) * 8);
    vreg = *(const u4*)(Hb + (size_t)(tokbase + (tid & 63)) * INWP + colV + (tid >> 6) * 8);
}
__device__ __forceinline__ void nsa_kv_store(LAS bf16* Kl, LAS bf16* Vt, int tid, const u4& kreg, const u4& vreg) {
    *(LAS u4*)(Kl + (tid >> 3) * NSA_KST + (tid & 7) * 8) = kreg;
    LAS bf16* vp = Vt + ((tid >> 6) * 8) * NSA_VST + (tid & 63);
    vp[0 * NSA_VST] = (bf16)(vreg.x & 0xffffu); vp[1 * NSA_VST] = (bf16)(vreg.x >> 16); vp[2 * NSA_VST] = (bf16)(vreg.y & 0xffffu); vp[3 * NSA_VST] = (bf16)(vreg.y >> 16);
    vp[4 * NSA_VST] = (bf16)(vreg.z & 0xffffu); vp[5 * NSA_VST] = (bf16)(vreg.z >> 16); vp[6 * NSA_VST] = (bf16)(vreg.w & 0xffffu); vp[7 * NSA_VST] = (bf16)(vreg.w >> 16);
}
__device__ __forceinline__ void unit_nsa(const Params& P, int l_, LAS unsigned char* lds, int u, int tid) {
    const int b = u >> 7, g = (u >> 5) & 3, qt = u & 31;
    const bf16* Hb = (const bf16*)(P.ws + WS_H);
    LAS bf16* Kl = (LAS bf16*)lds;
    LAS bf16* Vt = (LAS bf16*)(lds + 18432);
    LAS float* impG = (LAS float*)(lds + 36864);
    LAS float* impE = (LAS float*)(lds + 69632);
    LAS unsigned* selm = (LAS unsigned*)(lds + 102400);
    const int lane = tid & 63, wv = __builtin_amdgcn_readfirstlane(tid >> 6), h = wv >> 1, qh = wv & 1;
    const int c = lane & 15, kq = lane >> 4;
    const int t0 = qt * 64;
    int tq[2]; size_t tok[2];
#pragma unroll
    for (int qp = 0; qp < 2; ++qp) { tq[qp] = 32 * qh + 16 * qp + c; tok[qp] = (size_t)b * T + t0 + tq[qp]; }
    bf16x8 Yq[2][2];
#pragma unroll
    for (int qp = 0; qp < 2; ++qp)
#pragma unroll
        for (int ks = 0; ks < 2; ++ks) Yq[qp][ks] = *(const bf16x8*)(Hb + tok[qp] * INWP + C_NQ + g * 256 + h * 64 + 32 * ks + 8 * kq);
    float gate[3][2];
#pragma unroll
    for (int k = 0; k < 3; ++k)
#pragma unroll
        for (int qp = 0; qp < 2; ++qp) { const float gv = bf2f(Hb[tok[qp] * INWP + C_NG + g * 12 + h * 3 + k]); gate[k][qp] = __builtin_amdgcn_rcpf(1.f + __expf(-gv)); }
    if (tid == 0) selm[64] = 0u;
    f4 tot[4][2], ot[4][2], st[4][2]; float m[2], l[2]; int lo[2], hi[2];
#pragma unroll
    for (int dt = 0; dt < 4; ++dt)
#pragma unroll
        for (int qp = 0; qp < 2; ++qp) { tot[dt][qp] = mk_f4(0.f, 0.f, 0.f, 0.f); ot[dt][qp] = mk_f4(0.f, 0.f, 0.f, 0.f); }
    int cmax[2];
#pragma unroll
    for (int qp = 0; qp < 2; ++qp) { const int t = t0 + tq[qp]; cmax[qp] = (t >= 31) ? (((t - 31) >> 4) < 126 ? ((t - 31) >> 4) : 126) : -1; }
    __syncthreads();
    { const float* KCk = (const float*)(P.ws + WS_KC) + (size_t)((0 * 4 + b) * 4 + g) * 8192;
        const float* KCv = (const float*)(P.ws + WS_KC) + (size_t)((1 * 4 + b) * 4 + g) * 8192;
        { const int key = tid >> 2, q4 = tid & 3; const f4* sp = (const f4*)(KCk + key * 64 + q4 * 16); const f4 a0 = sp[0], a1 = sp[1], a2 = sp[2], a3 = sp[3];
            u4 w0, w1; w0.x = pkbf(a0.x, a0.y); w0.y = pkbf(a0.z, a0.w); w0.z = pkbf(a1.x, a1.y); w0.w = pkbf(a1.z, a1.w); w1.x = pkbf(a2.x, a2.y); w1.y = pkbf(a2.z, a2.w); w1.z = pkbf(a3.x, a3.y); w1.w = pkbf(a3.z, a3.w);
            LAS u4* dp = (LAS u4*)(Kl + key * NSA_KST + q4 * 16); dp[0] = w0; dp[1] = w1; }
        { const int key = tid & 127, dq = tid >> 7; const f4* sp = (const f4*)(KCv + key * 64 + dq * 16); LAS bf16* vp = Vt + (dq * 16) * NSA_VST + key;
#pragma unroll
            for (int q = 0; q < 4; ++q) { const f4 a = sp[q]; vp[(4 * q) * NSA_VST] = (bf16)f2bf(a.x); vp[(4 * q + 1) * NSA_VST] = (bf16)f2bf(a.y); vp[(4 * q + 2) * NSA_VST] = (bf16)f2bf(a.z); vp[(4 * q + 3) * NSA_VST] = (bf16)f2bf(a.w); } } }
    __syncthreads();
    m[0] = m[1] = -1e4f; l[0] = l[1] = 0.f;
#pragma unroll 1
    for (int cc = 0; cc < 2; ++cc) {
        if (cc * 64 * 16 + 31 > t0 + 63) break;
#pragma unroll
        for (int qp = 0; qp < 2; ++qp) { lo[qp] = 0; hi[qp] = cmax[qp] - 64 * cc; }
        nsa_scores(st, Kl + cc * 64 * NSA_KST, Yq, lane);
        nsa_softmax_pv(st, m, l, ot, Vt + cc * 64, lo, hi, true, lane);
    }
    { const float g2[2] = {gate[0][0], gate[0][1]}; nsa_accum(tot, ot, l, g2); }
    { float invl[2], msc[2];
#pragma unroll
        for (int qp = 0; qp < 2; ++qp) { float lt = l[qp]; lt += __shfl_xor(lt, 16); lt += __shfl_xor(lt, 32); invl[qp] = (lt > 0.f) ? 1.f / lt : 0.f; msc[qp] = m[qp] * NSA_SC; }
#pragma unroll 1
        for (int cc = 0; cc < 2; ++cc) {
            nsa_scores(st, Kl + cc * 64 * NSA_KST, Yq, lane);
#pragma unroll
            for (int kt = 0; kt < 4; ++kt)
#pragma unroll
                for (int qp = 0; qp < 2; ++qp) { float p[4];
#pragma unroll
                    for (int i = 0; i < 4; ++i) { const int ci = 64 * cc + 16 * kt + 4 * kq + i; p[i] = (ci <= cmax[qp]) ? __builtin_amdgcn_exp2f(st[kt][qp][i] * NSA_SC - msc[qp]) * invl[qp] : 0.f; }
                    const int j = 16 * cc + 4 * kt + kq;
                    impG[(h * 32 + j) * 64 + tq[qp]] = (p[0] + p[1]) + (p[2] + p[3]);
                    if (j < 31) impE[(h * 32 + j + 1) * 64 + tq[qp]] = p[3]; }
        } }
    __syncthreads();
    if (tid < 64) { const int tqs = tid; float tv[8]; int ti[8];
#pragma unroll
        for (int k = 0; k < 8; ++k) { tv[k] = -3e38f; ti[k] = 0; }
#pragma unroll 1
        for (int j = 0; j < 32; ++j) { float v;
            if (j <= qt) { const bool forced = (j == 0) || (j == qt) || (j == qt - 1);
                float s4 = (impG[(0 * 32 + j) * 64 + tqs] + impG[(1 * 32 + j) * 64 + tqs]) + (impG[(2 * 32 + j) * 64 + tqs] + impG[(3 * 32 + j) * 64 + tqs]);
                if (j > 0) s4 += (impE[(0 * 32 + j) * 64 + tqs] + impE[(1 * 32 + j) * 64 + tqs]) + (impE[(2 * 32 + j) * 64 + tqs] + impE[(3 * 32 + j) * 64 + tqs]);
                v = forced ? 1e6f : s4; }
            else v = -1e9f;
            int vi = j;
#pragma unroll
            for (int k = 0; k < 8; ++k) { const bool gt = v > tv[k]; const float nv = gt ? tv[k] : v; const int ni = gt ? ti[k] : vi; tv[k] = gt ? v : tv[k]; ti[k] = gt ? vi : ti[k]; v = nv; vi = ni; } }
        unsigned msk = 0u;
#pragma unroll
        for (int k = 0; k < 8; ++k) if (ti[k] <= qt) msk |= (1u << ti[k]);
        selm[tqs] = msk; atomicOr((unsigned*)&selm[64], msk); }
    __syncthreads();
    unsigned mymask[2];
#pragma unroll
    for (int qp = 0; qp < 2; ++qp) mymask[qp] = selm[tq[qp]];
    const unsigned umask = selm[64];
#pragma unroll
    for (int dt = 0; dt < 4; ++dt)
#pragma unroll
        for (int qp = 0; qp < 2; ++qp) ot[dt][qp] = mk_f4(0.f, 0.f, 0.f, 0.f);
    m[0] = m[1] = -1e4f; l[0] = l[1] = 0.f;
    { u4 kreg, vreg; unsigned rem = umask;
        int j = __builtin_ctz(rem); rem &= rem - 1u;
        nsa_kv_prefetch(Hb, b * T + 64 * j, C_KS + g * 64, C_VS + g * 64, tid, kreg, vreg);
#pragma unroll 1
        for (;;) {
            __syncthreads();
            nsa_kv_store(Kl, Vt, tid, kreg, vreg);
            __syncthreads();
            const int jc = j; const bool more = (rem != 0u);
            if (more) { j = __builtin_ctz(rem); rem &= rem - 1u; nsa_kv_prefetch(Hb, b * T + 64 * j, C_KS + g * 64, C_VS + g * 64, tid, kreg, vreg); }
            bool anyv = false, full = true;
#pragma unroll
            for (int qp = 0; qp < 2; ++qp) { const bool sel = (mymask[qp] >> jc) & 1u; lo[qp] = sel ? 0 : 64; hi[qp] = sel ? ((jc == qt) ? tq[qp] : 63) : -1; anyv |= sel; full &= (sel && jc != qt); }
            if (__builtin_amdgcn_ballot_w64(anyv) != 0ull) {
                const bool need_mask = __builtin_amdgcn_ballot_w64(!full) != 0ull;
                nsa_scores(st, Kl, Yq, lane);
                nsa_softmax_pv(st, m, l, ot, Vt, lo, hi, need_mask, lane); }
            if (!more) break;
        } }
    { const float g2[2] = {gate[1][0], gate[1][1]}; nsa_accum(tot, ot, l, g2); }
#pragma unroll
    for (int dt = 0; dt < 4; ++dt)
#pragma unroll
        for (int qp = 0; qp < 2; ++qp) ot[dt][qp] = mk_f4(0.f, 0.f, 0.f, 0.f);
    m[0] = m[1] = -1e4f; l[0] = l[1] = 0.f;
    { u4 kreg, vreg; int jw = (qt >= 8 ? qt - 8 : 0);
        nsa_kv_prefetch(Hb, b * T + 64 * jw, C_KW + g * 64, C_VW + g * 64, tid, kreg, vreg);
#pragma unroll 1
        for (;;) {
            __syncthreads();
            nsa_kv_store(Kl, Vt, tid, kreg, vreg);
            __syncthreads();
            const int jc = jw; const bool more = (jw < qt);
            if (more) { ++jw; nsa_kv_prefetch(Hb, b * T + 64 * jw, C_KW + g * 64, C_VW + g * 64, tid, kreg, vreg); }
#pragma unroll
            for (int qp = 0; qp < 2; ++qp) { lo[qp] = (jc == qt - 8) ? tq[qp] + 1 : 0; hi[qp] = (jc == qt) ? tq[qp] : 63; }
            const bool need_mask = (jc == qt) || (jc == qt - 8);
            nsa_scores(st, Kl, Yq, lane);
            nsa_softmax_pv(st, m, l, ot, Vt, lo, hi, need_mask, lane);
            if (!more) break;
        } }
    { const float g2[2] = {gate[2][0], gate[2][1]}; nsa_accum(tot, ot, l, g2); }
    float* ymix = (float*)(P.ws + WS_YMIX);
#pragma unroll
    for (int qp = 0; qp < 2; ++qp)
#pragma unroll
        for (int dt = 0; dt < 4; ++dt) *(f4*)(ymix + tok[qp] * D + 1024 + g * 256 + h * 64 + 16 * dt + 4 * kq) = tot[dt][qp];
    __syncthreads();
}

__device__ __forceinline__ void row_mixnorm(const Params& P, int l, int rowi, int lane) {
    const f4* yp = (const f4*)((const float*)(P.ws + WS_YMIX) + (size_t)rowi * D) + lane;
    const f4* gp = (const f4*)(P.in[14] + (size_t)l * D) + lane;
    f4 v[8]; float ss[8];
#pragma unroll
    for (int j = 0; j < 8; ++j) { v[j] = yp[64 * j]; ss[j] = v[j].x * v[j].x + v[j].y * v[j].y + v[j].z * v[j].z + v[j].w * v[j].w; }
    const float r0 = rsqrtf(wave_sum(ss[0] + ss[1]) * (1.f / 512.f) + LN_EPS);
    const float r1 = rsqrtf(wave_sum(ss[2] + ss[3]) * (1.f / 512.f) + LN_EPS);
    const float r2 = rsqrtf(wave_sum((ss[4] + ss[5]) + (ss[6] + ss[7])) * (1.f / 1024.f) + LN_EPS);
    u2* op = (u2*)((bf16*)(P.ws + WS_MIXED) + (size_t)rowi * D) + lane;
#pragma unroll
    for (int j = 0; j < 8; ++j) { const float r = (j < 2) ? r0 : ((j < 4) ? r1 : r2); const f4 g4 = gp[64 * j];
        op[64 * j] = mk_u2(pk2(v[j].x * r * g4.x, v[j].y * r * g4.y), pk2(v[j].z * r * g4.z, v[j].w * r * g4.w)); }
}
__device__ __forceinline__ void row_ln(const float* __restrict__ zin, const float* __restrict__ gam, const float* __restrict__ bet, float* __restrict__ of32, bf16* __restrict__ obf, int rowi, int lane) {
    const f4* zp = (const f4*)(zin + (size_t)rowi * D) + lane;
    f4 v[8]; float s = 0.f;
#pragma unroll
    for (int j = 0; j < 8; ++j) { v[j] = zp[64 * j]; s += (v[j].x + v[j].y) + (v[j].z + v[j].w); }
    const float mu = wave_sum(s) * (1.f / D); float s2 = 0.f;
#pragma unroll
    for (int j = 0; j < 8; ++j) { v[j].x -= mu; v[j].y -= mu; v[j].z -= mu; v[j].w -= mu; s2 += (v[j].x * v[j].x + v[j].y * v[j].y) + (v[j].z * v[j].z + v[j].w * v[j].w); }
    const float rstd = rsqrtf(wave_sum(s2) * (1.f / D) + LN_EPS);
    f4* o4 = (f4*)(of32 + (size_t)rowi * D) + lane; u2* o2 = (u2*)(obf + (size_t)rowi * D) + lane;
    const f4* gp = (const f4*)gam + lane; const f4* bp = (const f4*)bet + lane;
#pragma unroll
    for (int j = 0; j < 8; ++j) { const f4 g4 = gp[64 * j], b4 = bp[64 * j];
        const f4 o = mk_f4(v[j].x * rstd * g4.x + b4.x, v[j].y * rstd * g4.y + b4.y, v[j].z * rstd * g4.z + b4.z, v[j].w * rstd * g4.w + b4.w);
        o4[64 * j] = o; o2[64 * j] = mk_u2(pk2(o.x, o.y), pk2(o.z, o.w)); }
}

__device__ __forceinline__ float dot8_bf16(const u4& w, const float* x) {
    float f[8]; unpack8(w, f);
    return ((f[0] * x[0] + f[1] * x[1]) + (f[2] * x[2] + f[3] * x[3])) + ((f[4] * x[4] + f[5] * x[5]) + (f[6] * x[6] + f[7] * x[7]));
}
__device__ __forceinline__ void unit_peer(const Params& P, int l, LAS unsigned char* lds, int u, int tid, int lane, int wave, float* __restrict__ xout) {
    const int n0 = u * 32;
    const float* QP = (const float*)(P.ws + WS_QP); float* SC = (float*)(P.ws + WS_SC);
    LAS float* keys = (LAS float*)lds;
    LAS float* qs = (LAS float*)(lds + 67584);
    for (int hh = 0; hh < 16; ++hh) { const int h = hh >> 1, half = hh & 1;
        const float* kg = P.in[half ? 20 : 19] + ((size_t)l * 8 + h) * 16384;
        __syncthreads();
#pragma unroll
        for (int i = 0; i < 8; ++i) { const int idx = tid + 512 * i; const int k = idx >> 5, d4 = idx & 31; *(LAS f4*)(keys + k * 132 + d4 * 4) = ((const f4*)kg)[idx]; }
#pragma unroll
        for (int i = 0; i < 2; ++i) { const int idx = tid + 512 * i; const int tk = idx >> 5, d4 = idx & 31; *(LAS f4*)(qs + tk * 128 + d4 * 4) = *(const f4*)(QP + (size_t)(n0 + tk) * D + h * 256 + half * 128 + d4 * 4); }
        __syncthreads();
        const int k = tid & 127, tg = tid >> 7;
        float a[8];
#pragma unroll
        for (int i = 0; i < 8; ++i) a[i] = 0.f;
        for (int d4 = 0; d4 < 32; ++d4) { const f4 kv = *(const LAS f4*)(keys + k * 132 + d4 * 4);
#pragma unroll
            for (int i = 0; i < 8; ++i) { const f4 q4 = *(const LAS f4*)(qs + (tg * 8 + i) * 128 + d4 * 4); a[i] += kv.x * q4.x + kv.y * q4.y + kv.z * q4.z + kv.w * q4.w; } }
#pragma unroll
        for (int i = 0; i < 8; ++i) SC[((size_t)(n0 + tg * 8 + i) * 16 + hh) * 128 + k] = a[i];
    }
    VM_WAIT();
    __syncthreads();
    LAS float* TV = (LAS float*)lds;
    LAS int* TI = (LAS int*)(lds + 34816);
    { const int tk = tid >> 4, hh = tid & 15;
        const f4* sp = (const f4*)(SC + ((size_t)(n0 + tk) * 16 + hh) * 128);
        float tv[16]; int ti[16];
#pragma unroll
        for (int k = 0; k < 16; ++k) { tv[k] = -3e38f; ti[k] = 0; }
        for (int c4 = 0; c4 < 32; ++c4) { const f4 s4 = sp[c4]; const float sv[4] = {s4.x, s4.y, s4.z, s4.w};
#pragma unroll
            for (int e = 0; e < 4; ++e) { float v = sv[e]; int vi = c4 * 4 + e;
#pragma unroll
                for (int k = 0; k < 16; ++k) { const bool gt = v > tv[k]; const float nv = gt ? tv[k] : v; const int ni = gt ? ti[k] : vi; tv[k] = gt ? v : tv[k]; ti[k] = gt ? vi : ti[k]; v = nv; vi = ni; } } }
#pragma unroll
        for (int k = 0; k < 16; ++k) { TV[tid * 17 + k] = tv[k]; TI[tid * 17 + k] = ti[k]; } }
    __syncthreads();
    LAS int* PE = (LAS int*)(lds + 69632);
    LAS float* PW = (LAS float*)(lds + 86016);
    if (tid < 256) { const int tk = tid >> 3, h = tid & 7; const int r1 = tk * 16 + 2 * h, r2 = r1 + 1;
        float v1[16], v2[16]; int i1[16], i2[16];
#pragma unroll
        for (int k = 0; k < 16; ++k) { v1[k] = TV[r1 * 17 + k]; i1[k] = TI[r1 * 17 + k]; v2[k] = TV[r2 * 17 + k]; i2[k] = TI[r2 * 17 + k]; }
        float tv[16]; int te[16];
#pragma unroll
        for (int k = 0; k < 16; ++k) { tv[k] = -3e38f; te[k] = 0; }
#pragma unroll
        for (int a = 0; a < 16; ++a)
#pragma unroll
            for (int bq = 0; bq < 16; ++bq) if ((a + 1) * (bq + 1) <= 16) { float v = v1[a] + v2[bq]; int ve = i1[a] * 128 + i2[bq];
#pragma unroll
                for (int k = 0; k < 16; ++k) { const bool gt = v > tv[k]; const float nv = gt ? tv[k] : v; const int ni = gt ? te[k] : ve; tv[k] = gt ? v : tv[k]; te[k] = gt ? ve : te[k]; v = nv; ve = ni; } }
        float wsum = 0.f; float w[16];
#pragma unroll
        for (int k = 0; k < 16; ++k) { w[k] = __expf(tv[k] - tv[0]); wsum += w[k]; }
        const float inv = 1.f / wsum;
#pragma unroll
        for (int k = 0; k < 16; ++k) { PE[tk * 128 + h * 16 + k] = te[k]; PW[tk * 128 + h * 16 + k] = w[k] * inv; } }
    __syncthreads();
    LAS float* HW = (LAS float*)(lds + 102400);
    const bf16* PU = (const bf16*)(P.ws + WS_PU) + (size_t)l * 16384 * 2048; const bf16* PV = (const bf16*)(P.ws + WS_PV) + (size_t)l * 16384 * 2048;
    const float* X1 = (const float*)(P.ws + WS_X1);
    for (int it = 0; it < 4; ++it) { const int tk = wave * 4 + it; const size_t n = (size_t)n0 + tk;
        float xr[32];
#pragma unroll
        for (int j = 0; j < 4; ++j) { const f4 a = *(const f4*)(X1 + n * D + 512 * j + lane * 8), bq = *(const f4*)(X1 + n * D + 512 * j + lane * 8 + 4);
            xr[8 * j] = a.x; xr[8 * j + 1] = a.y; xr[8 * j + 2] = a.z; xr[8 * j + 3] = a.w; xr[8 * j + 4] = bq.x; xr[8 * j + 5] = bq.y; xr[8 * j + 6] = bq.z; xr[8 * j + 7] = bq.w; }
        for (int grp = 0; grp < 32; ++grp) { u4 w[4][4];
#pragma unroll
            for (int k = 0; k < 4; ++k) { const int e = __builtin_amdgcn_readfirstlane(PE[tk * 128 + grp * 4 + k]); const u4* up = (const u4*)(PU + (size_t)e * 2048) + lane;
#pragma unroll
                for (int j = 0; j < 4; ++j) w[k][j] = up[64 * j]; }
#pragma unroll
            for (int k = 0; k < 4; ++k) { float dsum = 0.f;
#pragma unroll
                for (int j = 0; j < 4; ++j) dsum += dot8_bf16(w[k][j], xr + 8 * j);
                dsum = wave_sum(dsum);
                if (lane == 0) HW[tk * 128 + grp * 4 + k] = PW[tk * 128 + grp * 4 + k] * gelu_tanh(dsum); } }
        LDS_WAIT();
        float acc[32];
#pragma unroll
        for (int i = 0; i < 32; ++i) acc[i] = 0.f;
        for (int grp = 0; grp < 32; ++grp) { u4 w[4][4];
#pragma unroll
            for (int k = 0; k < 4; ++k) { const int e = __builtin_amdgcn_readfirstlane(PE[tk * 128 + grp * 4 + k]); const u4* vp = (const u4*)(PV + (size_t)e * 2048) + lane;
#pragma unroll
                for (int j = 0; j < 4; ++j) w[k][j] = vp[64 * j]; }
#pragma unroll
            for (int k = 0; k < 4; ++k) { const float hw = HW[tk * 128 + grp * 4 + k];
#pragma unroll
                for (int j = 0; j < 4; ++j) { float f[8]; unpack8(w[k][j], f);
#pragma unroll
                    for (int i = 0; i < 8; ++i) acc[8 * j + i] += hw * f[i]; } } }
        float s = 0.f;
#pragma unroll
        for (int i = 0; i < 32; ++i) { acc[i] += ALPHA * xr[i]; s += acc[i]; }
        const float mu = wave_sum(s) * (1.f / D); float s2 = 0.f;
#pragma unroll
        for (int i = 0; i < 32; ++i) { acc[i] -= mu; s2 += acc[i] * acc[i]; }
        const float rstd = rsqrtf(wave_sum(s2) * (1.f / D) + LN_EPS);
        const float* gam = P.in[23] + (size_t)l * D; const float* bet = P.in[24] + (size_t)l * D;
        bf16* xb = (bf16*)(P.ws + WS_XB);
#pragma unroll
        for (int j = 0; j < 4; ++j) { const int col = 512 * j + lane * 8;
            const f4 g0 = *(const f4*)(gam + col), g1 = *(const f4*)(gam + col + 4), b0 = *(const f4*)(bet + col), b1 = *(const f4*)(bet + col + 4);
            const f4 o0 = mk_f4(acc[8 * j] * rstd * g0.x + b0.x, acc[8 * j + 1] * rstd * g0.y + b0.y, acc[8 * j + 2] * rstd * g0.z + b0.z, acc[8 * j + 3] * rstd * g0.w + b0.w);
            const f4 o1 = mk_f4(acc[8 * j + 4] * rstd * g1.x + b1.x, acc[8 * j + 5] * rstd * g1.y + b1.y, acc[8 * j + 6] * rstd * g1.z + b1.z, acc[8 * j + 7] * rstd * g1.w + b1.w);
            *(f4*)(xout + n * D + col) = o0; *(f4*)(xout + n * D + col + 4) = o1;
            u4 pk; pk.x = pk2(o0.x, o0.y); pk.y = pk2(o0.z, o0.w); pk.z = pk2(o1.x, o1.y); pk.w = pk2(o1.z, o1.w);
            *(u4*)(xb + n * D + col) = pk; }
    }
    __syncthreads();
}

constexpr int PH_PER_LAYER = 8, N_PHASES = 1 + DEPTH * PH_PER_LAYER;
#ifndef ONLY_PHASE
#define ONLY_PHASE -1
#endif
#define EN(i) (ONLY_PHASE < 0 || ONLY_PHASE == (i))
#ifndef PROBE_DUP
#define PROBE_DUP -1
#endif
#define REP(i) for (int rep_ = 0; rep_ < ((PROBE_DUP == (i)) ? 2 : 1); ++rep_)
__global__ void __launch_bounds__(512, 2) mk_fwd(Params P) {
    extern __shared__ __attribute__((aligned(16))) unsigned char lds_raw[];
    LAS unsigned char* lds = (LAS unsigned char*)lds_raw;
    volatile LAS unsigned* MISC = (volatile LAS unsigned*)(lds + MISC_OFF);
    const int tid = threadIdx.x, lane = tid & 63, wave = __builtin_amdgcn_readfirstlane(tid >> 6);
    const int G = gridDim.x, bid = blockIdx.x;
    if (tid < 64) MISC[tid] = 0u;
    __syncthreads();
    unsigned* ctl = (unsigned*)(P.ws + WS_CTL);
    XcdBarrier bar; bar.bar = ctl + CW_BAR; bar.x = 0; bar.st = nullptr;
    if (P.use_bar) bar = xcd_barrier_post(ctl + CW_BAR, MISC + 8);
    const int lo = P.ph_lo, hi = P.ph_hi;
#define IN(k) (lo <= (k) && (k) < hi)
#define LAUNDER() int tl = tid; asm volatile("" : "+v"(tl)); const int ll = tl & 63; const int wl = __builtin_amdgcn_readfirstlane(tl >> 6); (void)ll; (void)wl
#define SEAM(k) do { if (IN((k) + 1)) xcd_barrier(bar); } while (0)
    unsigned char* ws = P.ws;
    if (IN(0) && EN(8)) { LAUNDER(); phase_prologue(P, lds, tl, ll, wl); SEAM(0); }
    for (int l = 0; l < DEPTH; ++l) {
        const int pb = 1 + l * PH_PER_LAYER;
        const float* xres = (l == 0) ? P.in[0] : (const float*)(ws + WS_XC);
        float* xout = (l == DEPTH - 1) ? P.out : (float*)(ws + WS_XC);
        if (IN(pb + 0) && EN(0)) { LAUNDER();
            pg8::Gemm g{(const pg8::bf16_t*)(ws + WS_XB), (const pg8::bf16_t*)(ws + WS_WIN) + (size_t)l * INWP * D, NTOK, INWP, D};
            pg8::StaticOrder S; S.init(NTOK, INWP, G, bid);
            pg8::EpiH E{(pg8::bf16_t*)(ws + WS_H), INWP, 6, 10};
            pg8::gemm_phase<pg8::EpiH, pg8::StaticOrder, true, true>(lds, g, S, E, tl);
            SEAM(pb + 0);
        }
        if (IN(pb + 1) && EN(1)) { LAUNDER();
            REP(1) for (int u = bid; u < 240; u += G) unit_kvstate(P, lds, u, tl);
            REP(1) for (int u = bid; u < 256; u += G) unit_sgu(P, l, lds, u, tl, ll, wl);
            REP(1) for (int u = bid; u < 256; u += G) unit_compress(P, l, lds, u, tl);
            SEAM(pb + 1);
        }
        if (IN(pb + 2) && EN(2)) { LAUNDER();
            REP(2) for (int u = bid; u < 256; u += G) unit_retention(P, l, lds, u, tl);
            REP(2) for (int u = bid; u < 512; u += G) unit_nsa(P, l, lds, u, tl);
            SEAM(pb + 2);
        }
        if (IN(pb + 3) && EN(3)) { LAUNDER();
            for (int r = bid * 8 + wl; r < NTOK; r += G * 8) row_mixnorm(P, l, r, ll);
            SEAM(pb + 3);
        }
        if (IN(pb + 4) && EN(4)) { LAUNDER();
            pg8::Gemm g{(const pg8::bf16_t*)(ws + WS_MIXED), (const pg8::bf16_t*)(ws + WS_WOUT) + (size_t)l * D * D, NTOK, D, D};
            pg8::StaticOrder S; S.init(NTOK, D, G, bid);
            pg8::EpiRes E{(float*)(ws + WS_Z), xres, D, ALPHA};
            pg8::gemm_phase<pg8::EpiRes, pg8::StaticOrder, true, true>(lds, g, S, E, tl);
            SEAM(pb + 4);
        }
        if (IN(pb + 5) && EN(5)) { LAUNDER();
            for (int r = bid * 8 + wl; r < NTOK; r += G * 8) row_ln((const float*)(ws + WS_Z), P.in[16] + (size_t)l * D, P.in[17] + (size_t)l * D, (float*)(ws + WS_X1), (bf16*)(ws + WS_X1B), r, ll);
            SEAM(pb + 5);
        }
        if (IN(pb + 6) && EN(6)) { LAUNDER();
            pg8::Gemm g{(const pg8::bf16_t*)(ws + WS_X1B), (const pg8::bf16_t*)(ws + WS_WQ) + (size_t)l * D * D, NTOK, D, D};
            pg8::StaticOrder S; S.init(NTOK, D, G, bid);
            pg8::EpiF32 E{(float*)(ws + WS_QP), D};
            pg8::gemm_phase<pg8::EpiF32, pg8::StaticOrder, true, true>(lds, g, S, E, tl);
            SEAM(pb + 6);
        }
        if (IN(pb + 7) && EN(7)) { LAUNDER();
            REP(7) for (int u = bid; u < NTOK / 32; u += G) unit_peer(P, l, lds, u, tl, ll, wl, xout);
            SEAM(pb + 7);
        }
    }
#undef IN
#undef SEAM
}

#ifndef MK_ONE_LAUNCH
#define MK_ONE_LAUNCH 1
#endif
extern "C" void kernel_launch(void* const* d_in, const int* in_sizes, int n_in, void* d_out, int out_size, void* d_ws, size_t ws_size, hipStream_t stream) {
    static int grid = 0;
    if (grid == 0) {
        if (n_in != 25 || out_size != NTOK * D || ws_size < WS_END) { fprintf(stderr, "kernel_launch: unexpected shapes: n_in %d out %d ws %zu (need %zu)\n", n_in, out_size, ws_size, (size_t)WS_END); grid = -1; return; }
        int dev = 0, cus = 0, per_cu = 0;
        if (hipGetDevice(&dev) != hipSuccess || hipDeviceGetAttribute(&cus, hipDeviceAttributeMultiprocessorCount, dev) != hipSuccess) { grid = -1; return; }
        if (hipFuncSetAttribute((const void*)mk_fwd, hipFuncAttributeMaxDynamicSharedMemorySize, LDS_BYTES) != hipSuccess) { fprintf(stderr, "kernel_launch: hipFuncSetAttribute failed\n"); grid = -1; return; }
        if (hipOccupancyMaxActiveBlocksPerMultiprocessor(&per_cu, (const void*)mk_fwd, 512, LDS_BYTES) != hipSuccess || per_cu < 1) fprintf(stderr, "kernel_launch: occupancy query says %d\n", per_cu);
        (void)hipGetLastError();
        grid = cus;
    }
    if (grid < 0) return;
    (void)hipMemsetAsync((char*)d_ws + WS_CTL, 0, CTL_ZERO_BYTES, stream);
    Params p{};
    for (int i = 0; i < 25; ++i) p.in[i] = (const float*)d_in[i];
    p.out = (float*)d_out; p.ws = (unsigned char*)d_ws;
    for (int i = 0; i < 32; ++i) p.inv_rev[i] = pow(10000.0, -(double)i / 32.0) / (2.0 * 3.14159265358979323846);
    for (int h = 0; h < 4; ++h) p.lg2[h] = (float)log2(1.0 - pow(2.0, -5.0 - (double)h));
#if MK_ONE_LAUNCH
    p.ph_lo = 0; p.ph_hi = N_PHASES; p.use_bar = 1;
    hipLaunchKernelGGL(mk_fwd, dim3(grid), dim3(512), LDS_BYTES, stream, p);
#else
    for (int k = 0; k < N_PHASES; ++k) { p.ph_lo = k; p.ph_hi = k + 1; p.use_bar = 0;
        hipLaunchKernelGGL(mk_fwd, dim3(grid), dim3(512), LDS_BYTES, stream, p); }
#endif
}
```

```cpp
#include <hip/hip_runtime.h>
#include <cstdio>
#include <cstdint>
#include <cmath>
#define LAS __attribute__((address_space(3)))
namespace pg8 {
#define PG8_LAS __attribute__((address_space(3)))
typedef unsigned short bf16_t;
typedef short bf16x8 __attribute__((ext_vector_type(8)));
typedef float f32x4 __attribute__((ext_vector_type(4)));
typedef unsigned u32x4 __attribute__((ext_vector_type(4)));
constexpr int BM = 256, BK = 64, HALF = 128, HTB = HALF * BK * 2  , STAGE_BYTES = 8 * HTB, NXCD = 8, WGM = 8;

__host__ __device__ __forceinline__ int lds_byte(int r, int c) { const int st = (r >> 4) * 2 + (c >> 5), rr = r & 15, cc = c & 31, ob = rr * 64 + cc * 2; return st * 1024 + (ob ^ (((ob >> 9) & 1) << 5)); }
__host__ __device__ __forceinline__ void stage_rc(int b, int& R, int& C) { const int st = b / 1024, sb = b % 1024, swz = sb ^ (((sb >> 9) & 1) << 5); R = (st >> 1) * 16 + swz / 64; C = (st & 1) * 32 + (swz % 64) / 2; }
__host__ __device__ __forceinline__ int perm32(int rho) { const int n = rho >> 4, i = rho & 15; return 8 * (i >> 2) + 4 * n + (i & 3); }

struct Unit { int pm, pn; };
struct Gemm { const bf16_t* A; const bf16_t* Bt; int M, N, K; };

struct StaticOrder {
    int nM, nN, nwg, G, c;
    __host__ __device__ void init(int M, int N, int G_, int c_) { nM = M / BM; nN = N / BM; nwg = nM * nN; G = G_; c = c_; }
    __host__ __device__ bool next(int i, Unit& u) const {
        const long L = (long)i * G + c; if (L >= nwg) return false;
        int wgid = (int)L; { const int q = nwg / NXCD, r = nwg % NXCD, xcd = wgid % NXCD, off = wgid / NXCD; wgid = (xcd < r ? xcd * (q + 1) : r * (q + 1) + (xcd - r) * q) + off; }
        const int nig = WGM * nN, gid = wgid / nig, fm = gid * WGM, gsz = (nM - fm) < WGM ? (nM - fm) : WGM;
        u.pm = fm + ((wgid % nig) % gsz); u.pn = (wgid % nig) / gsz; return true;
    }
    __device__ __forceinline__ void a_ready(const Unit&) const {}
    __device__ __forceinline__ void done(const Unit&) const {}
};
__device__ __forceinline__ unsigned cvt_pk_bf16(float lo, float hi) { unsigned r; asm volatile("v_cvt_pk_bf16_f32 %0, %1, %2" : "=v"(r) : "v"(lo), "v"(hi)); return r; }
typedef float f32x2 __attribute__((ext_vector_type(2)));
__device__ __forceinline__ float gelu_tanh_f(float x) {
    const float u = 1.5957691216057308f * (x + 0.044715f * x * x * x);
    return x * __builtin_amdgcn_rcpf(1.0f + __expf(-u));
}
struct EpiH {
    static constexpr bool PERM = true, AFTER_DRAIN = false;
    bf16_t* O; int ldc; int act_lo, act_hi;
    __device__ __forceinline__ void operator()(const f32x4 (&acc)[2][2][4][2], const Unit& u, int wr, int wc, int fr, int fq) const {
        const int row0 = u.pm * BM + wr * 64 + fr; const int col0 = u.pn * BM + wc * 32 + 8 * fq;
        const bool act = (u.pn >= act_lo) && (u.pn < act_hi);
#pragma unroll
        for (int ai = 0; ai < 2; ++ai)
#pragma unroll
            for (int m = 0; m < 4; ++m) { bf16_t* rowp = O + (size_t)(row0 + ai * HALF + m * 16) * ldc + col0;
#pragma unroll
                for (int bj = 0; bj < 2; ++bj) { f32x4 v0 = acc[ai][bj][m][0], v1 = acc[ai][bj][m][1];
                    if (act) {
#pragma unroll
                        for (int j = 0; j < 4; ++j) { v0[j] = gelu_tanh_f(v0[j]); v1[j] = gelu_tanh_f(v1[j]); } }
                    u32x4 w; w.x = cvt_pk_bf16(v0[0], v0[1]); w.y = cvt_pk_bf16(v0[2], v0[3]); w.z = cvt_pk_bf16(v1[0], v1[1]); w.w = cvt_pk_bf16(v1[2], v1[3]);
                    *(u32x4*)(rowp + bj * HALF) = w; } }
    }
};
struct EpiRes {
    static constexpr bool PERM = false, AFTER_DRAIN = false;
    float* C; const float* X; int ldc; float alpha;
    __device__ __forceinline__ void operator()(const f32x4 (&acc)[2][2][4][2], const Unit& u, int wr, int wc, int fr, int fq) const {
        const int row0 = u.pm * BM + wr * 64 + fr, col0 = u.pn * BM + wc * 32 + 4 * fq;
#pragma unroll
        for (int ai = 0; ai < 2; ++ai)
#pragma unroll
            for (int m = 0; m < 4; ++m) { const size_t off = (size_t)(row0 + ai * HALF + m * 16) * ldc + col0;
#pragma unroll
                for (int bj = 0; bj < 2; ++bj)
#pragma unroll
                    for (int n = 0; n < 2; ++n) { const size_t o2 = off + bj * HALF + n * 16; const f32x4 xv = *(const f32x4*)(X + o2); *(f32x4*)(C + o2) = acc[ai][bj][m][n] + xv * alpha; } }
    }
};
struct EpiF32 {
    static constexpr bool PERM = false, AFTER_DRAIN = false;
    float* C; int ldc;
    __device__ __forceinline__ void operator()(const f32x4 (&acc)[2][2][4][2], const Unit& u, int wr, int wc, int fr, int fq) const {
        const int row0 = u.pm * BM + wr * 64 + fr, col0 = u.pn * BM + wc * 32 + 4 * fq;
#pragma unroll
        for (int ai = 0; ai < 2; ++ai)
#pragma unroll
            for (int m = 0; m < 4; ++m) { float* rowp = C + (size_t)(row0 + ai * HALF + m * 16) * ldc + col0;
#pragma unroll
                for (int bj = 0; bj < 2; ++bj)
#pragma unroll
                    for (int n = 0; n < 2; ++n) *(f32x4*)(rowp + bj * HALF + n * 16) = acc[ai][bj][m][n]; }
    }
};
template <class Epi, class Sched, bool ALIGN_EPI = false, bool SP2 = false>
__device__ __forceinline__ void gemm_phase(PG8_LAS unsigned char* lds, const Gemm g, const Sched& S, const Epi& E, const int tid) {
    const int wid = __builtin_amdgcn_readfirstlane(tid >> 6), lane = tid & 63, wr = wid >> 2, wc = wid & 3, fr = lane & 15, fq = lane >> 4;
    const int K = g.K, nt = K / BK;
    unsigned voffA[2], voffB[2];
#pragma unroll
    for (int i = 0; i < 2; ++i) { int R, C; stage_rc(tid * 16 + i * 8192, R, C); const int Rb = Epi::PERM ? ((R & ~31) + perm32(R & 31)) : R;
        voffA[i] = (unsigned)(R * K + C) * 2u; voffB[i] = (unsigned)(Rb * K + C) * 2u; }
    const size_t kstep = (size_t)(BK * 2);
    const size_t hstep = (size_t)HALF * K * 2;
    const size_t tstep = 2 * hstep;
    const unsigned ldsw = (unsigned)wid * 1024u;
    const int aoff = lds_byte(wr * 64 + fr, fq * 8), boff = lds_byte(wc * 32 + fr, fq * 8);
#define PG8_SA(b, h) (((b) * 2 + (h)) * HTB)
#define PG8_SB(b, h) ((4 + (b) * 2 + (h)) * HTB)
#define PG8_STAGE(bufoff, gbase, voff) do { _Pragma("unroll") for (int _i = 0; _i < 2; ++_i) \
        __builtin_amdgcn_global_load_lds((const unsigned*)((const char*)(gbase) + (voff)[_i]), (PG8_LAS unsigned*)(lds + (bufoff) + ldsw + _i * 8192), 16, 0, 0); } while (0)
#define PG8_LDA(dst, b, h) do { _Pragma("unroll") for (int m = 0; m < 4; ++m) _Pragma("unroll") for (int k = 0; k < 2; ++k) dst[m][k] = *(const PG8_LAS bf16x8*)(lds + PG8_SA(b, h) + aoff + m * 2048 + k * 1024); } while (0)
#define PG8_LDB(dst, b, h) do { _Pragma("unroll") for (int n = 0; n < 2; ++n) _Pragma("unroll") for (int k = 0; k < 2; ++k) dst[n][k] = *(const PG8_LAS bf16x8*)(lds + PG8_SB(b, h) + boff + n * 2048 + k * 1024); } while (0)
#define PG8_MMA(ai, bj, At, Bt) do { __builtin_amdgcn_s_setprio(1); _Pragma("unroll") for (int m = 0; m < 4; ++m) _Pragma("unroll") for (int n = 0; n < 2; ++n) _Pragma("unroll") for (int k = 0; k < 2; ++k) \
        acc[ai][bj][m][n] = __builtin_amdgcn_mfma_f32_16x16x32_bf16(Bt[n][k], At[m][k], acc[ai][bj][m][n], 0, 0, 0); __builtin_amdgcn_s_setprio(0); } while (0)
#define PG8_WAIT_V(n) asm volatile("s_waitcnt vmcnt(" #n ")" ::: "memory")
#define PG8_WAIT_L(n) asm volatile("s_waitcnt lgkmcnt(" #n ")" ::: "memory")
#define PG8_BAR __builtin_amdgcn_s_barrier()
#define PG8_SCHED __builtin_amdgcn_sched_barrier(0)
    Unit cur, nxt; int ui = 0;
    if (!S.next(0, cur)) return;
    f32x4 acc[2][2][4][2];
#pragma unroll
    for (int a = 0; a < 2; ++a)
#pragma unroll
        for (int b = 0; b < 2; ++b)
#pragma unroll
            for (int m = 0; m < 4; ++m)
#pragma unroll
                for (int n = 0; n < 2; ++n) acc[a][b][m][n] = (f32x4){0.f, 0.f, 0.f, 0.f};
    bf16x8 At[4][2], B0[2][2], B1[2][2];
    const char* cA = (const char*)g.A + (size_t)cur.pm * tstep; const char* cB = (const char*)g.Bt + (size_t)cur.pn * tstep;
    S.a_ready(cur);
    if constexpr (SP2) {
        PG8_STAGE(PG8_SB(0, 0), cB, voffB); PG8_STAGE(PG8_SB(0, 1), cB + hstep, voffB); PG8_STAGE(PG8_SA(0, 0), cA, voffA); PG8_STAGE(PG8_SA(0, 1), cA + hstep, voffA);
        if (wr == 1) PG8_BAR;
        PG8_WAIT_V(2); PG8_BAR;
        PG8_STAGE(PG8_SB(1, 0), cB + kstep, voffB); PG8_STAGE(PG8_SA(1, 0), cA + kstep, voffA); PG8_STAGE(PG8_SB(1, 1), cB + hstep + kstep, voffB);
        PG8_WAIT_V(6); PG8_BAR;
    } else {
        PG8_STAGE(PG8_SB(0, 0), cB, voffB); PG8_STAGE(PG8_SA(0, 0), cA, voffA); PG8_STAGE(PG8_SB(0, 1), cB + hstep, voffB); PG8_STAGE(PG8_SA(0, 1), cA + hstep, voffA);
        if (wr == 1) PG8_BAR;
        PG8_WAIT_V(4); PG8_BAR;
        PG8_STAGE(PG8_SB(1, 0), cB + kstep, voffB); PG8_STAGE(PG8_SA(1, 0), cA + kstep, voffA); PG8_STAGE(PG8_SB(1, 1), cB + hstep + kstep, voffB);
        PG8_WAIT_V(6); PG8_BAR;
    }
    for (;;) {
        const bool has_next = S.next(ui + 1, nxt);
        const char* nA = has_next ? (const char*)g.A + (size_t)nxt.pm * tstep : cA; const char* nB = has_next ? (const char*)g.Bt + (size_t)nxt.pn * tstep : cB;
        for (int t = 0; t < nt; t += 2) {
            const bool last = (t == nt - 2);
            const char* a1 = cA + (size_t)(t + 1) * kstep;
            const char* a2 = last ? nA : cA + (size_t)(t + 2) * kstep; const char* b2 = last ? nB : cB + (size_t)(t + 2) * kstep;
            const char* a3 = a2 + kstep; const char* b3 = b2 + kstep;
            if (last && has_next) S.a_ready(nxt);
            if constexpr (SP2) {
            PG8_LDB(B0, 0, 0); PG8_LDB(B1, 0, 1); PG8_SCHED; PG8_LDA(At, 0, 0); PG8_STAGE(PG8_SA(1, 1), a1 + hstep, voffA);
            PG8_WAIT_V(8); PG8_WAIT_L(0); PG8_BAR; PG8_MMA(0, 0, At, B0); PG8_MMA(0, 1, At, B1); PG8_BAR; PG8_SCHED;
            PG8_LDA(At, 0, 1); PG8_STAGE(PG8_SB(0, 0), b2, voffB); PG8_STAGE(PG8_SB(0, 1), b2 + hstep, voffB); PG8_STAGE(PG8_SA(0, 0), a2, voffA);
            PG8_WAIT_V(8); PG8_WAIT_L(0); PG8_BAR; PG8_MMA(1, 0, At, B0); PG8_MMA(1, 1, At, B1); PG8_BAR; PG8_SCHED;
            PG8_LDB(B0, 1, 0); PG8_LDB(B1, 1, 1); PG8_SCHED; PG8_LDA(At, 1, 0); PG8_STAGE(PG8_SA(0, 1), a2 + hstep, voffA);
            PG8_WAIT_V(8); PG8_WAIT_L(0); PG8_BAR; PG8_MMA(0, 0, At, B0); PG8_MMA(0, 1, At, B1); PG8_BAR; PG8_SCHED;
            PG8_LDA(At, 1, 1); PG8_STAGE(PG8_SB(1, 0), b3, voffB); PG8_STAGE(PG8_SB(1, 1), b3 + hstep, voffB); PG8_STAGE(PG8_SA(1, 0), a3, voffA);
            PG8_WAIT_V(8); PG8_WAIT_L(0); PG8_BAR; PG8_MMA(1, 0, At, B0); PG8_MMA(1, 1, At, B1); PG8_BAR; PG8_SCHED;
            } else {
            PG8_LDB(B0, 0, 0); PG8_SCHED; PG8_LDA(At, 0, 0); PG8_STAGE(PG8_SA(1, 1), a1 + hstep, voffA);
            PG8_WAIT_L(8); PG8_BAR; PG8_WAIT_L(0); PG8_MMA(0, 0, At, B0); PG8_BAR; PG8_SCHED;
            PG8_LDB(B1, 0, 1); PG8_STAGE(PG8_SB(0, 0), b2, voffB);
            PG8_BAR; PG8_WAIT_L(0); PG8_MMA(0, 1, At, B1); PG8_BAR;
            PG8_LDA(At, 0, 1); PG8_STAGE(PG8_SA(0, 0), a2, voffA);
            PG8_BAR; PG8_WAIT_L(0); PG8_MMA(1, 0, At, B0); PG8_BAR; PG8_SCHED;
            PG8_STAGE(PG8_SB(0, 1), b2 + hstep, voffB);
            PG8_WAIT_V(6); PG8_BAR; PG8_MMA(1, 1, At, B1); PG8_BAR;
            PG8_LDB(B0, 1, 0); PG8_SCHED; PG8_LDA(At, 1, 0); PG8_STAGE(PG8_SA(0, 1), a2 + hstep, voffA);
            PG8_WAIT_L(8); PG8_BAR; PG8_WAIT_L(0); PG8_MMA(0, 0, At, B0); PG8_BAR; PG8_SCHED;
            PG8_LDB(B1, 1, 1); PG8_STAGE(PG8_SB(1, 0), b3, voffB);
            PG8_BAR; PG8_WAIT_L(0); PG8_MMA(0, 1, At, B1); PG8_BAR;
            PG8_LDA(At, 1, 1); PG8_STAGE(PG8_SA(1, 0), a3, voffA);
            PG8_BAR; PG8_WAIT_L(0); PG8_MMA(1, 0, At, B0); PG8_BAR; PG8_SCHED;
            PG8_STAGE(PG8_SB(1, 1), b3 + hstep, voffB);
            PG8_WAIT_V(6); PG8_BAR; PG8_MMA(1, 1, At, B1); PG8_BAR;
            }
        }
        if constexpr (ALIGN_EPI) { if (wr == 0) PG8_BAR; }
        if constexpr (!Epi::AFTER_DRAIN) { E(acc, cur, wr, wc, fr, fq); S.done(cur); }
        if (!has_next) break;
#pragma unroll
        for (int a = 0; a < 2; ++a)
#pragma unroll
            for (int b = 0; b < 2; ++b)
#pragma unroll
                for (int m = 0; m < 4; ++m)
#pragma unroll
                    for (int n = 0; n < 2; ++n) acc[a][b][m][n] = (f32x4){0.f, 0.f, 0.f, 0.f};
        cur = nxt; cA = nA; cB = nB; ++ui;
        if constexpr (ALIGN_EPI) { if (wr == 1) PG8_BAR; }
    }
    PG8_WAIT_V(0);
    if constexpr (!ALIGN_EPI) { if (wr == 0) PG8_BAR; }
    PG8_BAR;
    if constexpr (Epi::AFTER_DRAIN) { E.fused(acc, cur, wr, wc, fr, fq, lds, wid, lane); S.done(cur); }
#undef PG8_SA
#undef PG8_SB
#undef PG8_STAGE
#undef PG8_LDA
#undef PG8_LDB
#undef PG8_MMA
#undef PG8_WAIT_V
#undef PG8_WAIT_L
#undef PG8_BAR
#undef PG8_SCHED
}
}
#define XB_TMO      128
#define XB_XCNT(j)  (256  + 64 * (j))
#define XB_XSUB(j)  (1280 + 64 * (j))
#define XB_XGEN(j)  (2304 + 64 * (j))
#define XB_TOP      3328
#define XB_TOPGEN   3392
#define XCD_BAR_WORDS 3456
#define XB_SPIN_CAP (1u << 18)

__device__ __forceinline__ unsigned xb_ld(unsigned* p)              { return __hip_atomic_load(p, __ATOMIC_RELAXED, __HIP_MEMORY_SCOPE_AGENT); }
__device__ __forceinline__ unsigned xb_add(unsigned* p, unsigned v) { return __hip_atomic_fetch_add(p, v, __ATOMIC_RELAXED, __HIP_MEMORY_SCOPE_AGENT); }
__device__ __forceinline__ unsigned xb_xcc_id() { return (unsigned)__builtin_amdgcn_s_getreg((3 << 11) | 20) & 0xFu; }
#define XB_SPIN(cond, bar) do { unsigned _sp = 0; while (cond) { __builtin_amdgcn_s_sleep(1); \
    if ((++_sp & 255u) == 0u) { if (xb_ld(&(bar)[XB_TMO])) break; if (_sp > XB_SPIN_CAP) { atomicAdd(&(bar)[XB_TMO], 1u); break; } } } } while (0)

struct XcdBarrier {
    unsigned* bar; unsigned x;
    volatile LAS unsigned* st;
};

__device__ __forceinline__ XcdBarrier xcd_barrier_post(unsigned* bar, volatile LAS unsigned* st) {
    XcdBarrier b; b.bar = bar; b.x = xb_xcc_id(); b.st = st;
    if (threadIdx.x == 0) (void)xb_add(&bar[XB_XCNT(b.x)], 1u);
    return b;
}
__device__ __forceinline__ void xcd_barrier_complete(unsigned* bar, unsigned x, unsigned& nloc, unsigned& nx) {
    const unsigned G = gridDim.x * gridDim.y * gridDim.z;
    unsigned sum, cnt, mine, sp = 0u;
    for (;;) {
        sum = 0u; cnt = 0u; mine = 0u;
#pragma unroll
        for (unsigned j = 0; j < 16; ++j) { const unsigned c = xb_ld(&bar[XB_XCNT(j)]); sum += c; cnt += (c > 0u) ? 1u : 0u; mine = (j == x) ? c : mine; }
        if (sum == G) break;
        __builtin_amdgcn_s_sleep(1);
        if ((++sp & 255u) == 0u) { if (xb_ld(&bar[XB_TMO])) break; if (sp > XB_SPIN_CAP) { atomicAdd(&bar[XB_TMO], 1u); break; } }
    }
    nloc = mine > 0u ? mine : 1u; nx = cnt > 0u ? cnt : 1u;
}

__device__ __forceinline__ void xcd_barrier(const XcdBarrier& b) {
    asm volatile("s_waitcnt vmcnt(0)" ::: "memory");
    __syncthreads();
    if (threadIdx.x == 0) {
        unsigned* bar = b.bar;
        __builtin_amdgcn_s_waitcnt(0);
        unsigned nloc = b.st[0], nx = b.st[1];
        if (nloc == 0u) { xcd_barrier_complete(bar, b.x, nloc, nx); b.st[0] = nloc; b.st[1] = nx; }
        const unsigned old = xb_add(&bar[XB_XSUB(b.x)], 1u);
        const unsigned gen = old / nloc;
        if (old + 1u == (gen + 1u) * nloc) {
            __builtin_amdgcn_fence(__ATOMIC_RELEASE, "agent");
            asm volatile("s_waitcnt vmcnt(0)" ::: "memory");
            const unsigned og = xb_add(&bar[XB_TOP], 1u);
            const unsigned tg = og / nx;
            if (og + 1u == (tg + 1u) * nx) xb_add(&bar[XB_TOPGEN], 1u);
            else XB_SPIN(xb_ld(&bar[XB_TOPGEN]) == tg, bar);
            __builtin_amdgcn_fence(__ATOMIC_ACQUIRE, "agent");
            xb_add(&bar[XB_XGEN(b.x)], 1u);
            asm volatile("s_waitcnt vmcnt(0)" ::: "memory");
        } else {
            XB_SPIN(xb_ld(&bar[XB_XGEN(b.x)]) == gen, bar);
            __builtin_amdgcn_fence(__ATOMIC_ACQUIRE, "agent");
            asm volatile("s_waitcnt vmcnt(0)" ::: "memory");
        }
    }
    __syncthreads();
}

constexpr int NB = 4, T = 2048, D = 2048, NTOK = NB * T, DEPTH = 4;
constexpr int INW = 5168, INWP = 5376;
constexpr int C_RQ = 0, C_RK = 256, C_RV = 512, C_RG = 1024, C_SU = 1536, C_SV = 2048, C_NQ = 2560, C_KC = 3584, C_VC = 3840, C_KS = 4096, C_VS = 4352, C_KW = 4608, C_VW = 4864, C_NG = 5120;
constexpr float ALPHA = 1.6817928305074290f;
constexpr float LN_EPS = 1e-5f;
constexpr float LOG2E = 1.4426950408889634f;

constexpr size_t MiB = (size_t)1 << 20;
constexpr size_t WS_CTL = 0, CTL_ZERO_BYTES = 1 * MiB;
constexpr size_t WS_ROPE = 1 * MiB;
constexpr size_t WS_WIN = 2 * MiB;
constexpr size_t WS_WOUT = 86 * MiB;
constexpr size_t WS_WQ = 118 * MiB;
constexpr size_t WS_PU = 160 * MiB;
constexpr size_t WS_PV = 416 * MiB;
constexpr size_t WS_H = 672 * MiB;
constexpr size_t WS_YMIX = 756 * MiB;
constexpr size_t WS_MIXED = 820 * MiB;
constexpr size_t WS_Z = 852 * MiB;
constexpr size_t WS_X1 = 916 * MiB;
constexpr size_t WS_X1B = 980 * MiB;
constexpr size_t WS_QP = 1012 * MiB;
constexpr size_t WS_XC = 1076 * MiB;
constexpr size_t WS_XB = 1140 * MiB;
constexpr size_t WS_KC = 1172 * MiB;
constexpr size_t WS_KVST = 1174 * MiB;
constexpr size_t WS_SC = 1184 * MiB;
constexpr size_t WS_PSC = 1248 * MiB;
constexpr size_t WS_END = 1250 * MiB;
constexpr int CW_BAR = 4096;

constexpr int LDS_BYTES = 147456;
constexpr int MISC_OFF = 143360;

#define GAS __attribute__((address_space(1)))
typedef float f4 __attribute__((ext_vector_type(4)));
typedef float f2 __attribute__((ext_vector_type(2)));
typedef unsigned u4 __attribute__((ext_vector_type(4)));
typedef unsigned u2 __attribute__((ext_vector_type(2)));
__device__ __forceinline__ f4 mk_f4(float a, float b, float c, float d) { f4 r; r.x = a; r.y = b; r.z = c; r.w = d; return r; }
__device__ __forceinline__ f2 mk_f2(float a, float b) { f2 r; r.x = a; r.y = b; return r; }
__device__ __forceinline__ u2 mk_u2(unsigned a, unsigned b) { u2 r; r.x = a; r.y = b; return r; }
typedef unsigned short bf16;
#define LDS_WAIT() asm volatile("s_waitcnt lgkmcnt(0)" ::: "memory")
#define VM_WAIT() asm volatile("s_waitcnt vmcnt(0)" ::: "memory")

struct Params {
    const float* in[25];
    float* out;
    unsigned char* ws;
    double inv_rev[32];
    float lg2[4];
    int ph_lo, ph_hi, use_bar, pad0;
};

__device__ __forceinline__ float bf2f(unsigned short b) { return __uint_as_float(((unsigned)b) << 16); }
__device__ __forceinline__ unsigned f2bf(float f) { unsigned u = __float_as_uint(f); return (u + 0x7fffu + ((u >> 16) & 1u)) >> 16; }
__device__ __forceinline__ unsigned pk2(float lo, float hi) { return f2bf(lo) | (f2bf(hi) << 16); }
__device__ __forceinline__ float wave_sum(float v) {
#pragma unroll
    for (int o = 1; o < 64; o <<= 1) v += __shfl_xor(v, o);
    return v;
}
__device__ __forceinline__ void unpack8(const u4& v, float* f) {
    f[0] = __uint_as_float(v.x << 16); f[1] = __uint_as_float(v.x & 0xffff0000u);
    f[2] = __uint_as_float(v.y << 16); f[3] = __uint_as_float(v.y & 0xffff0000u);
    f[4] = __uint_as_float(v.z << 16); f[5] = __uint_as_float(v.z & 0xffff0000u);
    f[6] = __uint_as_float(v.w << 16); f[7] = __uint_as_float(v.w & 0xffff0000u);
}
__device__ __forceinline__ float gelu_tanh(float x) { return pg8::gelu_tanh_f(x); }

__device__ __forceinline__ void transpose_tile(const float* __restrict__ W, int K, int N, bf16* __restrict__ WT, LAS float* scr, int kb, int nb, int lane) {
    const int k0 = kb * 64, n0 = nb * 32, nn = lane & 31; const bool ok = (n0 + nn) < N;
#pragma unroll 8
    for (int i = 0; i < 32; ++i) { const int kk = 2 * i + (lane >> 5); scr[kk * 33 + nn] = ok ? W[(size_t)(k0 + kk) * N + n0 + nn] : 0.f; }
    LDS_WAIT();
    const int c = lane & 7;
#pragma unroll
    for (int j = 0; j < 4; ++j) { const int n = (lane >> 3) + 8 * j; const LAS float* s = scr + (8 * c) * 33 + n;
        u4 o; o.x = pk2(s[0 * 33], s[1 * 33]); o.y = pk2(s[2 * 33], s[3 * 33]); o.z = pk2(s[4 * 33], s[5 * 33]); o.w = pk2(s[6 * 33], s[7 * 33]);
        *(u4*)(WT + (size_t)(n0 + n) * K + k0 + 8 * c) = o; }
    LDS_WAIT();
}
__device__ __forceinline__ void cvt_bf16_stream(const float* __restrict__ src, bf16* __restrict__ dst, size_t nchunks, size_t gt, size_t GT) {
    for (size_t c = gt; c < nchunks; c += GT) { const f4 a = ((const f4*)src)[2 * c], b = ((const f4*)src)[2 * c + 1];
        u4 o; o.x = pk2(a.x, a.y); o.y = pk2(a.z, a.w); o.z = pk2(b.x, b.y); o.w = pk2(b.z, b.w); ((u4*)dst)[c] = o; }
}
__device__ __forceinline__ void phase_prologue(const Params& P, unsigned char* ws, LAS unsigned char* lds, int tid, int lane, int wave) {
    LAS float* scr = (LAS float*)(lds + wave * 8704);
    const int gw = blockIdx.x * 8 + wave, NGW = gridDim.x * 8;
    constexpr int I_IN = 32 * 168, I_SQ = 32 * 64, I_L = I_IN + 2 * I_SQ;
    for (int it = gw; it < DEPTH * I_L; it += NGW) {
        const int l = it / I_L; int r = it % I_L;
        if (r < I_IN) transpose_tile(P.in[1] + (size_t)l * D * INW, D, INW, (bf16*)(ws + WS_WIN) + (size_t)l * INWP * D, scr, r / 168, r % 168, lane);
        else { r -= I_IN;
            if (r < I_SQ) transpose_tile(P.in[15] + (size_t)l * D * D, D, D, (bf16*)(ws + WS_WOUT) + (size_t)l * D * D, scr, r / 64, r % 64, lane);
            else { r -= I_SQ; transpose_tile(P.in[18] + (size_t)l * D * D, D, D, (bf16*)(ws + WS_WQ) + (size_t)l * D * D, scr, r / 64, r % 64, lane); } }
    }
    const size_t gt = (size_t)blockIdx.x * 512 + tid, GT = (size_t)gridDim.x * 512;
    for (int row = gw; row < 2 * DEPTH * 16384; row += NGW) {
        const int tab = row / (DEPTH * 16384), rr = row % (DEPTH * 16384);
        const float* src = P.in[21 + tab] + (size_t)rr * 2048;
        f4 v[8]; float am = 0.f;
#pragma unroll
        for (int j = 0; j < 2; ++j)
#pragma unroll
            for (int q = 0; q < 4; ++q) { const f4 a = *(const f4*)(src + 1024 * j + 16 * lane + 4 * q); v[4 * j + q] = a; am = fmaxf(am, fmaxf(fmaxf(fabsf(a.x), fabsf(a.y)), fmaxf(fabsf(a.z), fabsf(a.w)))); }
#pragma unroll
        for (int o = 1; o < 64; o <<= 1) am = fmaxf(am, __shfl_xor(am, o));
        const float sc = (am > 0.f) ? 448.f / am : 1.f;
        if (lane == 0) ((float*)(ws + WS_PSC))[row] = (am > 0.f) ? am * (1.f / 448.f) : 1.f;
        unsigned char* dst = ws + (tab ? WS_PV : WS_PU) + (size_t)rr * 2048;
#pragma unroll
        for (int j = 0; j < 2; ++j) { u4 w;
#pragma unroll
            for (int q = 0; q < 4; ++q) { const f4 a = v[4 * j + q]; int r = __builtin_amdgcn_cvt_pk_fp8_f32(a.x * sc, a.y * sc, 0, false); r = __builtin_amdgcn_cvt_pk_fp8_f32(a.z * sc, a.w * sc, r, true); w[q] = (unsigned)r; }
            *(u4*)(dst + 1024 * j + 16 * lane) = w; }
    }
    cvt_bf16_stream(P.in[0], (bf16*)(ws + WS_XB), (size_t)NTOK * D / 8, gt, GT);
    f2* rope = (f2*)(ws + WS_ROPE);
    for (size_t idx = gt; idx < (size_t)T * 32; idx += GT) { const int t = (int)(idx >> 5), i = (int)(idx & 31);
        double a = (double)t * P.inv_rev[i]; a -= floor(a); const float fr = (float)a;
        rope[idx] = mk_f2(__builtin_amdgcn_cosf(fr), __builtin_amdgcn_sinf(fr)); }
}

__device__ __forceinline__ void stage_rot_k(const bf16* __restrict__ Hb, const f2* __restrict__ rope, LAS float* ks, int tok0, int tpos0, int colK, float lg2h, bool zeta, int tid) {
    const int m = tid >> 2, p = tid & 3;
    const bf16* src = Hb + (size_t)(tok0 + m) * INWP + colK + p * 8;
    const u4 a = *(const u4*)src, b = *(const u4*)(src + 32);
    float x1[8], x2[8]; unpack8(a, x1); unpack8(b, x2);
    const f4* rp = (const f4*)(rope + (size_t)(tpos0 + m) * 32 + p * 8);
    const f4 r0 = rp[0], r1 = rp[1], r2 = rp[2], r3 = rp[3];
    const float cs[8] = {r0.x, r0.z, r1.x, r1.z, r2.x, r2.z, r3.x, r3.z}, sn[8] = {r0.y, r0.w, r1.y, r1.w, r2.y, r2.w, r3.y, r3.w};
    const float sc = 0.125f * (zeta ? exp2f(lg2h * (float)(127 - m)) : 1.0f);
    float o1[8], o2[8];
#pragma unroll
    for (int i = 0; i < 8; ++i) { o1[i] = (x1[i] * cs[i] - x2[i] * sn[i]) * sc; o2[i] = (x1[i] * sn[i] + x2[i] * cs[i]) * sc; }
    LAS f4* d1 = (LAS f4*)(ks + m * 64 + p * 8); LAS f4* d2 = (LAS f4*)(ks + m * 64 + 32 + p * 8);
    d1[0] = mk_f4(o1[0], o1[1], o1[2], o1[3]); d1[1] = mk_f4(o1[4], o1[5], o1[6], o1[7]);
    d2[0] = mk_f4(o2[0], o2[1], o2[2], o2[3]); d2[1] = mk_f4(o2[4], o2[5], o2[6], o2[7]);
}
__device__ __forceinline__ void stage_v128(const bf16* __restrict__ Hb, LAS float* vs, int tok0, int colV, int tid) {
    const int m = tid >> 2, p = tid & 3;
    const u4* src = (const u4*)(Hb + (size_t)(tok0 + m) * INWP + colV + p * 32);
    LAS f4* dst = (LAS f4*)(vs + m * 128 + p * 32);
#pragma unroll
    for (int j = 0; j < 4; ++j) { const u4 a = src[j]; float f[8]; unpack8(a, f); dst[2 * j] = mk_f4(f[0], f[1], f[2], f[3]); dst[2 * j + 1] = mk_f4(f[4], f[5], f[6], f[7]); }
}

__device__ __forceinline__ void unit_kvstate(const Params& P, unsigned char* ws, LAS unsigned char* lds, int u, int tid) {
    const int b = u / 60, r = u % 60, h = r / 15, j = r % 15;
    const bf16* Hb = (const bf16*)(ws + WS_H); const f2* rope = (const f2*)(ws + WS_ROPE);
    LAS float* ks = (LAS float*)lds; LAS float* vs = (LAS float*)(lds + 32768);
    const int tok0 = b * T + j * 128;
    stage_rot_k(Hb, rope, ks, tok0, j * 128, C_RK + h * 64, P.lg2[h], true, tid);
    stage_v128(Hb, vs, tok0, C_RV + h * 128, tid);
    __syncthreads();
    const int d = tid >> 3, e0 = (tid & 7) * 16;
    float acc[16];
#pragma unroll
    for (int i = 0; i < 16; ++i) acc[i] = 0.f;
    #pragma unroll 1
    for (int m = 0; m < 128; ++m) { const float kd = ks[m * 64 + d]; const LAS f4* vp = (const LAS f4*)(vs + m * 128 + e0);
#pragma unroll
        for (int q = 0; q < 4; ++q) { const f4 v = vp[q]; acc[4 * q] += kd * v.x; acc[4 * q + 1] += kd * v.y; acc[4 * q + 2] += kd * v.z; acc[4 * q + 3] += kd * v.w; } }
    f4* dst = (f4*)((float*)(ws + WS_KVST) + ((size_t)((b * 4 + h) * 16 + j) * 64 + d) * 128 + e0);
#pragma unroll
    for (int q = 0; q < 4; ++q) dst[q] = mk_f4(acc[4 * q], acc[4 * q + 1], acc[4 * q + 2], acc[4 * q + 3]);
    __syncthreads();
}

__device__ __forceinline__ void unit_sgu(const Params& P, unsigned char* ws, int l, LAS unsigned char* lds, int u, int tid, int lane, int wave) {
    const int b = u >> 6, c = (u >> 2) & 15, g = u & 3;
    const bf16* Hb = (const bf16*)(ws + WS_H);
    LAS float* vn = (LAS float*)lds;
    LAS float* wsm = (LAS float*)(lds + 65536);
    const int tok0 = b * T + c * 128;
    const float* lng = P.in[4] + l * 512 + g * 128; const float* lnb = P.in[5] + l * 512 + g * 128;
    const float g0 = lng[2 * lane], g1 = lng[2 * lane + 1], b0 = lnb[2 * lane], b1 = lnb[2 * lane + 1];
    for (int i = 0; i < 16; ++i) { const int s = wave * 16 + i;
        const unsigned pr = *(const unsigned*)(Hb + (size_t)(tok0 + s) * INWP + C_SV + g * 128 + 2 * lane);
        const float v0 = __uint_as_float(pr << 16), v1 = __uint_as_float(pr & 0xffff0000u);
        const float mu = wave_sum(v0 + v1) * (1.f / 128.f); const float d0 = v0 - mu, d1 = v1 - mu;
        const float var = wave_sum(d0 * d0 + d1 * d1) * (1.f / 128.f); const float rstd = rsqrtf(var + LN_EPS);
        *(LAS f2*)(vn + s * 128 + 2 * lane) = mk_f2(d0 * rstd * g0 + b0, d1 * rstd * g1 + b1); }
    const float* wg = P.in[6] + ((size_t)l * 4 + g) * 16384;
    for (int i = 0; i < 32; ++i) { const int idx = tid + 512 * i; wsm[(idx >> 7) * 129 + (idx & 127)] = wg[idx]; }
    __syncthreads();
    const int t = tid >> 2, dg = tid & 3; const int smax = (t | 15);
    float acc[32];
#pragma unroll
    for (int i = 0; i < 32; ++i) acc[i] = 0.f;
    #pragma unroll 1
    for (int s = 0; s <= smax; ++s) { const float wv = (s <= t) ? wsm[t * 129 + s] : 0.f; const LAS f4* vp = (const LAS f4*)(vn + s * 128 + dg * 32);
#pragma unroll
        for (int q = 0; q < 8; ++q) { const f4 v = vp[q]; acc[4 * q] += wv * v.x; acc[4 * q + 1] += wv * v.y; acc[4 * q + 2] += wv * v.z; acc[4 * q + 3] += wv * v.w; } }
    const float bs = P.in[7][(l * 4 + g) * 128 + t];
    const u4* up = (const u4*)(Hb + (size_t)(tok0 + t) * INWP + C_SU + g * 128 + dg * 32);
    f4* yo = (f4*)((float*)(ws + WS_YMIX) + (size_t)(tok0 + t) * D + 512 + g * 128 + dg * 32);
#pragma unroll
    for (int j = 0; j < 4; ++j) { const u4 a = up[j]; float f[8]; unpack8(a, f);
        yo[2 * j] = mk_f4(f[0] * (acc[8 * j] + bs), f[1] * (acc[8 * j + 1] + bs), f[2] * (acc[8 * j + 2] + bs), f[3] * (acc[8 * j + 3] + bs));
        yo[2 * j + 1] = mk_f4(f[4] * (acc[8 * j + 4] + bs), f[5] * (acc[8 * j + 5] + bs), f[6] * (acc[8 * j + 6] + bs), f[7] * (acc[8 * j + 7] + bs)); }
    __syncthreads();
}

__device__ __forceinline__ void unit_compress(const Params& P, unsigned char* ws, int l, LAS unsigned char* lds, int u, int tid) {
    const int kv = u >> 7, b = (u >> 5) & 3, g = (u >> 3) & 3, r = u & 7;
    const bf16* Hb = (const bf16*)(ws + WS_H);
    LAS float* seg = (LAS float*)lds;
    LAS float* hid = (LAS float*)(lds + 69632);
    const int col0 = (kv ? C_VC : C_KC) + g * 64;
    const float* pe = P.in[kv ? 11 : 8] + (size_t)l * 2048;
    const float* w1 = P.in[kv ? 12 : 9] + (size_t)l * 2048 * 256;
    const float* w2 = P.in[kv ? 13 : 10] + (size_t)l * 256 * 64;
    for (int idx = tid; idx < 272 * 8; idx += 512) { const int tt = idx >> 3, d8 = (idx & 7) * 8; const int t = 256 * r + tt;
        float f[8];
        if (t < T) { const u4 a = *(const u4*)(Hb + (size_t)(b * T + t) * INWP + col0 + d8); unpack8(a, f); }
        else {
#pragma unroll
            for (int i = 0; i < 8; ++i) f[i] = 0.f; }
        LAS f4* dp = (LAS f4*)(seg + tt * 64 + d8); dp[0] = mk_f4(f[0], f[1], f[2], f[3]); dp[1] = mk_f4(f[4], f[5], f[6], f[7]); }
    __syncthreads();
    const int j = tid & 255, hb = tid >> 8;
    float acc[8], accpe = 0.f;
#pragma unroll
    for (int i = 0; i < 8; ++i) acc[i] = 0.f;
    for (int pos = 0; pos < 32; ++pos) {
#pragma unroll 2
        for (int d4 = 0; d4 < 16; ++d4) { const int kk = pos * 64 + d4 * 4;
            const float w0 = w1[(size_t)(kk + 0) * 256 + j], w1v = w1[(size_t)(kk + 1) * 256 + j], w2v = w1[(size_t)(kk + 2) * 256 + j], w3 = w1[(size_t)(kk + 3) * 256 + j];
            const f4 p4 = *(const f4*)(pe + kk);
            accpe += w0 * p4.x + w1v * p4.y + w2v * p4.z + w3 * p4.w;
#pragma unroll
            for (int ib = 0; ib < 8; ++ib) { const f4 s4 = *(const LAS f4*)(seg + (16 * (hb * 8 + ib) + pos) * 64 + d4 * 4);
                acc[ib] += w0 * s4.x + w1v * s4.y + w2v * s4.z + w3 * s4.w; } } }
#pragma unroll
    for (int ib = 0; ib < 8; ++ib) hid[(hb * 8 + ib) * 256 + j] = gelu_tanh(acc[ib] + accpe);
    __syncthreads();
    { const int i = tid >> 5, o2 = (tid & 31) * 2; float a0 = 0.f, a1 = 0.f;
        for (int jj = 0; jj < 256; ++jj) { const float hv = hid[i * 256 + jj]; const f2 w = *(const f2*)(w2 + jj * 64 + o2); a0 += hv * w.x; a1 += hv * w.y; }
        const int ci = 16 * r + i;
        if (ci <= 126) *(f2*)((float*)(ws + WS_KC) + ((size_t)((kv * 4 + b) * 4 + g) * 128 + ci) * 64 + o2) = mk_f2(a0, a1); }
    __syncthreads();
}

__device__ __forceinline__ void unit_retention(const Params& P, unsigned char* ws, int l, LAS unsigned char* lds, int u, int tid) {
    const int b = u >> 6, h = (u >> 4) & 3, c = u & 15;
    const bf16* Hb = (const bf16*)(ws + WS_H); const f2* rope = (const f2*)(ws + WS_ROPE);
    LAS float* regB = (LAS float*)lds;
    LAS float* vs = (LAS float*)(lds + 32768);
    LAS float* Qs = (LAS float*)(lds + 98304);
    const float lg2h = P.lg2[h];
    const int tok0 = b * T + c * 128;
    { float a[16];
#pragma unroll
        for (int i = 0; i < 16; ++i) a[i] = 0.f;
        const float* kvb = (const float*)(ws + WS_KVST) + (size_t)((b * 4 + h) * 16) * 8192 + tid * 16;
#pragma unroll 1
        for (int j = 0; j < c; ++j) { const float w = exp2f(lg2h * 128.f * (float)(c - 1 - j)); const f4* sp = (const f4*)(kvb + (size_t)j * 8192);
#pragma unroll
            for (int q = 0; q < 4; ++q) { const f4 v = sp[q]; a[4 * q] += w * v.x; a[4 * q + 1] += w * v.y; a[4 * q + 2] += w * v.z; a[4 * q + 3] += w * v.w; } }
        LAS f4* dp = (LAS f4*)(regB + tid * 16);
#pragma unroll
        for (int q = 0; q < 4; ++q) dp[q] = mk_f4(a[4 * q], a[4 * q + 1], a[4 * q + 2], a[4 * q + 3]); }
    const int n = tid >> 2, eg = tid & 3;
    float qa[8], qb[8];
    { const bf16* src = Hb + (size_t)(tok0 + n) * INWP + C_RQ + h * 64 + eg * 8;
        const u4 a = *(const u4*)src, bb = *(const u4*)(src + 32);
        float x1[8], x2[8]; unpack8(a, x1); unpack8(bb, x2);
        const f4* rp = (const f4*)(rope + (size_t)(c * 128 + n) * 32 + eg * 8);
        const f4 r0 = rp[0], r1 = rp[1], r2 = rp[2], r3 = rp[3];
        const float cs[8] = {r0.x, r0.z, r1.x, r1.z, r2.x, r2.z, r3.x, r3.z}, sn[8] = {r0.y, r0.w, r1.y, r1.w, r2.y, r2.w, r3.y, r3.w};
#pragma unroll
        for (int i = 0; i < 8; ++i) { qa[i] = x1[i] * cs[i] - x2[i] * sn[i]; qb[i] = x1[i] * sn[i] + x2[i] * cs[i]; Qs[n * 65 + eg * 8 + i] = qa[i]; Qs[n * 65 + 32 + eg * 8 + i] = qb[i]; } }
    __syncthreads();
    float acc[32];
#pragma unroll
    for (int i = 0; i < 32; ++i) acc[i] = 0.f;
#pragma unroll 2
    for (int d = 0; d < 64; ++d) { const float qd = Qs[n * 65 + d]; const LAS f4* sp = (const LAS f4*)(regB + d * 128 + eg * 32);
#pragma unroll
        for (int qq = 0; qq < 8; ++qq) { const f4 v = sp[qq]; acc[4 * qq] += qd * v.x; acc[4 * qq + 1] += qd * v.y; acc[4 * qq + 2] += qd * v.z; acc[4 * qq + 3] += qd * v.w; } }
    { const float xi = exp2f(lg2h * (float)(n + 1));
#pragma unroll
        for (int i = 0; i < 32; ++i) acc[i] *= xi; }
    __syncthreads();
    stage_rot_k(Hb, rope, regB, tok0, c * 128, C_RK + h * 64, lg2h, false, tid);
    stage_v128(Hb, vs, tok0, C_RV + h * 128, tid);
    __syncthreads();
    const int mmax = n | 15;
#pragma unroll 1
    for (int m = 0; m <= mmax; ++m) { const LAS f4* kp = (const LAS f4*)(regB + m * 64 + eg * 8); const LAS f4* kp2 = (const LAS f4*)(regB + m * 64 + 32 + eg * 8);
        const f4 k0 = kp[0], k1 = kp[1], k2 = kp2[0], k3 = kp2[1];
        float s = ((qa[0] * k0.x + qa[1] * k0.y) + (qa[2] * k0.z + qa[3] * k0.w)) + ((qa[4] * k1.x + qa[5] * k1.y) + (qa[6] * k1.z + qa[7] * k1.w))
                + ((qb[0] * k2.x + qb[1] * k2.y) + (qb[2] * k2.z + qb[3] * k2.w)) + ((qb[4] * k3.x + qb[5] * k3.y) + (qb[6] * k3.z + qb[7] * k3.w));
        s += __shfl_xor(s, 1); s += __shfl_xor(s, 2);
        const float a = (m <= n) ? s * exp2f(lg2h * (float)(n - m)) : 0.f;
        const LAS f4* vp = (const LAS f4*)(vs + m * 128 + eg * 32);
#pragma unroll
        for (int qq = 0; qq < 8; ++qq) { const f4 v = vp[qq]; acc[4 * qq] += a * v.x; acc[4 * qq + 1] += a * v.y; acc[4 * qq + 2] += a * v.z; acc[4 * qq + 3] += a * v.w; } }
    float s1 = 0.f;
#pragma unroll
    for (int i = 0; i < 32; ++i) s1 += acc[i];
    s1 += __shfl_xor(s1, 1); s1 += __shfl_xor(s1, 2);
    const float mu = s1 * (1.f / 128.f); float s2 = 0.f;
#pragma unroll
    for (int i = 0; i < 32; ++i) { const float dd = acc[i] - mu; s2 += dd * dd; }
    s2 += __shfl_xor(s2, 1); s2 += __shfl_xor(s2, 2);
    const float rstd = rsqrtf(s2 * (1.f / 128.f) + LN_EPS);
    const float* gg = P.in[2] + l * 512 + h * 128 + eg * 32; const float* gb = P.in[3] + l * 512 + h * 128 + eg * 32;
    const u4* gp = (const u4*)(Hb + (size_t)(tok0 + n) * INWP + C_RG + h * 128 + eg * 32);
    f4* yo = (f4*)((float*)(ws + WS_YMIX) + (size_t)(tok0 + n) * D + h * 128 + eg * 32);
#pragma unroll
    for (int j = 0; j < 4; ++j) { const u4 a = gp[j]; float f[8]; unpack8(a, f); float o[8];
#pragma unroll
        for (int i = 0; i < 8; ++i) { const float y = (acc[8 * j + i] - mu) * rstd * gg[8 * j + i] + gb[8 * j + i]; const float gv = f[i]; o[i] = y * gv * __builtin_amdgcn_rcpf(1.f + __expf(-gv)); }
        yo[2 * j] = mk_f4(o[0], o[1], o[2], o[3]); yo[2 * j + 1] = mk_f4(o[4], o[5], o[6], o[7]); }
    __syncthreads();
}

typedef pg8::bf16x8 bf16x8;
typedef short s16x4 __attribute__((ext_vector_type(4)));
typedef __bf16 bf16x2_t __attribute__((ext_vector_type(2)));
__device__ __forceinline__ unsigned pkbf(float a, float b) { f2 v; v.x = a; v.y = b; return __builtin_bit_cast(unsigned, __builtin_convertvector(v, bf16x2_t)); }
#define MFMA16(a, b, c) __builtin_amdgcn_mfma_f32_16x16x32_bf16((a), (b), (c), 0, 0, 0)
constexpr int NSA_KST = 72, NSA_VST = 136;
constexpr float NSA_SC = 0.125f * LOG2E;
__device__ __forceinline__ void nsa_scores(f4 (&st)[4][2], const LAS bf16* Kl, const bf16x8 (&Yq)[2][2], int lane) {
    const int r = lane & 15, kq = lane >> 4;
#pragma unroll
    for (int kt = 0; kt < 4; ++kt) { const LAS bf16* kp = Kl + (16 * kt + r) * NSA_KST + 8 * kq;
        const bf16x8 k0 = *(const LAS bf16x8*)kp, k1 = *(const LAS bf16x8*)(kp + 32);
#pragma unroll
        for (int qp = 0; qp < 2; ++qp) { f4 a = mk_f4(0.f, 0.f, 0.f, 0.f); a = MFMA16(k0, Yq[qp][0], a); a = MFMA16(k1, Yq[qp][1], a); st[kt][qp] = a; } }
}
__device__ __forceinline__ void nsa_softmax_pv(f4 (&st)[4][2], float (&m)[2], float (&l)[2], f4 (&ot)[4][2], const LAS bf16* Vt, const int (&lo)[2], const int (&hi)[2], bool need_mask, int lane) {
    const int r = lane & 15, kq = lane >> 4;
    bf16x8 Pf[2][2];
#pragma unroll
    for (int qp = 0; qp < 2; ++qp) {
        if (need_mask) {
#pragma unroll
            for (int kt = 0; kt < 4; ++kt)
#pragma unroll
                for (int i = 0; i < 4; ++i) { const int kl = 16 * kt + 4 * kq + i; if (kl < lo[qp] || kl > hi[qp]) st[kt][qp][i] = -1e30f; } }
        float mx = st[0][qp][0];
#pragma unroll
        for (int kt = 0; kt < 4; ++kt)
#pragma unroll
            for (int i = 0; i < 4; ++i) mx = fmaxf(mx, st[kt][qp][i]);
        mx = fmaxf(mx, __shfl_xor(mx, 16)); mx = fmaxf(mx, __shfl_xor(mx, 32));
        const float mn = fmaxf(m[qp], mx); const float corr = __builtin_amdgcn_exp2f((m[qp] - mn) * NSA_SC); m[qp] = mn; l[qp] *= corr;
#pragma unroll
        for (int dt = 0; dt < 4; ++dt) ot[dt][qp] *= corr;
        const float msc = mn * NSA_SC; float ps = 0.f;
#pragma unroll
        for (int kt = 0; kt < 4; ++kt)
#pragma unroll
            for (int i = 0; i < 4; ++i) { const float p = __builtin_amdgcn_exp2f(st[kt][qp][i] * NSA_SC - msc); st[kt][qp][i] = p; ps += p; }
        l[qp] += ps;
#pragma unroll
        for (int ksp = 0; ksp < 2; ++ksp) { u4 w; w.x = pkbf(st[2 * ksp][qp][0], st[2 * ksp][qp][1]); w.y = pkbf(st[2 * ksp][qp][2], st[2 * ksp][qp][3]);
            w.z = pkbf(st[2 * ksp + 1][qp][0], st[2 * ksp + 1][qp][1]); w.w = pkbf(st[2 * ksp + 1][qp][2], st[2 * ksp + 1][qp][3]); Pf[qp][ksp] = __builtin_bit_cast(bf16x8, w); }
    }
#pragma unroll
    for (int dt = 0; dt < 4; ++dt)
#pragma unroll
        for (int ksp = 0; ksp < 2; ++ksp) { const LAS bf16* vp = Vt + (16 * dt + r) * NSA_VST + 32 * ksp + 4 * kq;
            const s16x4 va = *(const LAS s16x4*)vp, vb = *(const LAS s16x4*)(vp + 16);
            const bf16x8 vf = __builtin_shufflevector(va, vb, 0, 1, 2, 3, 4, 5, 6, 7);
#pragma unroll
            for (int qp = 0; qp < 2; ++qp) ot[dt][qp] = MFMA16(vf, Pf[qp][ksp], ot[dt][qp]); }
}
__device__ __forceinline__ void nsa_accum(f4 (&tot)[4][2], const f4 (&ot)[4][2], const float (&l)[2], const float (&gate)[2]) {
#pragma unroll
    for (int qp = 0; qp < 2; ++qp) { float lt = l[qp]; lt += __shfl_xor(lt, 16); lt += __shfl_xor(lt, 32); const float sc = (lt > 0.f) ? gate[qp] / lt : 0.f;
#pragma unroll
        for (int dt = 0; dt < 4; ++dt) tot[dt][qp] += ot[dt][qp] * sc; }
}
__device__ __forceinline__ void nsa_kv_prefetch(const bf16* __restrict__ Hb, int tokbase, int colK, int colV, int tid, u4& kreg, u4& vreg) {
    kreg = *(const u4*)(Hb + (size_t)(tokbase + (tid >> 3)) * INWP + colK + (tid & 7) * 8);
    vreg = *(const u4*)(Hb + (size_t)(tokbase + (tid & 63)) * INWP + colV + (tid >> 6) * 8);
}
__device__ __forceinline__ void nsa_kv_store(LAS bf16* Kl, LAS bf16* Vt, int tid, const u4& kreg, const u4& vreg) {
    *(LAS u4*)(Kl + (tid >> 3) * NSA_KST + (tid & 7) * 8) = kreg;
    LAS bf16* vp = Vt + ((tid >> 6) * 8) * NSA_VST + (tid & 63);
    vp[0 * NSA_VST] = (bf16)(vreg.x & 0xffffu); vp[1 * NSA_VST] = (bf16)(vreg.x >> 16); vp[2 * NSA_VST] = (bf16)(vreg.y & 0xffffu); vp[3 * NSA_VST] = (bf16)(vreg.y >> 16);
    vp[4 * NSA_VST] = (bf16)(vreg.z & 0xffffu); vp[5 * NSA_VST] = (bf16)(vreg.z >> 16); vp[6 * NSA_VST] = (bf16)(vreg.w & 0xffffu); vp[7 * NSA_VST] = (bf16)(vreg.w >> 16);
}
__device__ __forceinline__ void unit_nsa(const Params& P, unsigned char* ws, int l_, LAS unsigned char* lds, int u, int tid) {
    const int b = u >> 7, g = (u >> 5) & 3, qt = u & 31;
    const bf16* Hb = (const bf16*)(ws + WS_H);
    LAS bf16* Kl = (LAS bf16*)lds;
    LAS bf16* Vt = (LAS bf16*)(lds + 18432);
    LAS float* impG = (LAS float*)(lds + 36864);
    LAS float* impE = (LAS float*)(lds + 69632);
    LAS unsigned* selm = (LAS unsigned*)(lds + 102400);
    const int lane = tid & 63, wv = __builtin_amdgcn_readfirstlane(tid >> 6), h = wv >> 1, qh = wv & 1;
    const int c = lane & 15, kq = lane >> 4;
    const int t0 = qt * 64;
    int tq[2]; size_t tok[2];
#pragma unroll
    for (int qp = 0; qp < 2; ++qp) { tq[qp] = 32 * qh + 16 * qp + c; tok[qp] = (size_t)b * T + t0 + tq[qp]; }
    bf16x8 Yq[2][2];
#pragma unroll
    for (int qp = 0; qp < 2; ++qp)
#pragma unroll
        for (int ks = 0; ks < 2; ++ks) Yq[qp][ks] = *(const bf16x8*)(Hb + tok[qp] * INWP + C_NQ + g * 256 + h * 64 + 32 * ks + 8 * kq);
    float gate[3][2];
#pragma unroll
    for (int k = 0; k < 3; ++k)
#pragma unroll
        for (int qp = 0; qp < 2; ++qp) { const float gv = bf2f(Hb[tok[qp] * INWP + C_NG + g * 12 + h * 3 + k]); gate[k][qp] = __builtin_amdgcn_rcpf(1.f + __expf(-gv)); }
    if (tid == 0) selm[64] = 0u;
    f4 tot[4][2], ot[4][2], st[4][2]; float m[2], l[2]; int lo[2], hi[2];
#pragma unroll
    for (int dt = 0; dt < 4; ++dt)
#pragma unroll
        for (int qp = 0; qp < 2; ++qp) { tot[dt][qp] = mk_f4(0.f, 0.f, 0.f, 0.f); ot[dt][qp] = mk_f4(0.f, 0.f, 0.f, 0.f); }
    int cmax[2];
#pragma unroll
    for (int qp = 0; qp < 2; ++qp) { const int t = t0 + tq[qp]; cmax[qp] = (t >= 31) ? (((t - 31) >> 4) < 126 ? ((t - 31) >> 4) : 126) : -1; }
    __syncthreads();
    { const float* KCk = (const float*)(ws + WS_KC) + (size_t)((0 * 4 + b) * 4 + g) * 8192;
        const float* KCv = (const float*)(ws + WS_KC) + (size_t)((1 * 4 + b) * 4 + g) * 8192;
        { const int key = tid >> 2, q4 = tid & 3; const f4* sp = (const f4*)(KCk + key * 64 + q4 * 16); const f4 a0 = sp[0], a1 = sp[1], a2 = sp[2], a3 = sp[3];
            u4 w0, w1; w0.x = pkbf(a0.x, a0.y); w0.y = pkbf(a0.z, a0.w); w0.z = pkbf(a1.x, a1.y); w0.w = pkbf(a1.z, a1.w); w1.x = pkbf(a2.x, a2.y); w1.y = pkbf(a2.z, a2.w); w1.z = pkbf(a3.x, a3.y); w1.w = pkbf(a3.z, a3.w);
            LAS u4* dp = (LAS u4*)(Kl + key * NSA_KST + q4 * 16); dp[0] = w0; dp[1] = w1; }
        { const int key = tid & 127, dq = tid >> 7; const f4* sp = (const f4*)(KCv + key * 64 + dq * 16); LAS bf16* vp = Vt + (dq * 16) * NSA_VST + key;
#pragma unroll
            for (int q = 0; q < 4; ++q) { const f4 a = sp[q]; vp[(4 * q) * NSA_VST] = (bf16)f2bf(a.x); vp[(4 * q + 1) * NSA_VST] = (bf16)f2bf(a.y); vp[(4 * q + 2) * NSA_VST] = (bf16)f2bf(a.z); vp[(4 * q + 3) * NSA_VST] = (bf16)f2bf(a.w); } } }
    __syncthreads();
    m[0] = m[1] = -1e4f; l[0] = l[1] = 0.f;
#pragma unroll 1
    for (int cc = 0; cc < 2; ++cc) {
        if (cc * 64 * 16 + 31 > t0 + 63) break;
#pragma unroll
        for (int qp = 0; qp < 2; ++qp) { lo[qp] = 0; hi[qp] = cmax[qp] - 64 * cc; }
        nsa_scores(st, Kl + cc * 64 * NSA_KST, Yq, lane);
        nsa_softmax_pv(st, m, l, ot, Vt + cc * 64, lo, hi, true, lane);
    }
    { const float g2[2] = {gate[0][0], gate[0][1]}; nsa_accum(tot, ot, l, g2); }
    { float invl[2], msc[2];
#pragma unroll
        for (int qp = 0; qp < 2; ++qp) { float lt = l[qp]; lt += __shfl_xor(lt, 16); lt += __shfl_xor(lt, 32); invl[qp] = (lt > 0.f) ? 1.f / lt : 0.f; msc[qp] = m[qp] * NSA_SC; }
#pragma unroll 1
        for (int cc = 0; cc < 2; ++cc) {
            nsa_scores(st, Kl + cc * 64 * NSA_KST, Yq, lane);
#pragma unroll
            for (int kt = 0; kt < 4; ++kt)
#pragma unroll
                for (int qp = 0; qp < 2; ++qp) { float p[4];
#pragma unroll
                    for (int i = 0; i < 4; ++i) { const int ci = 64 * cc + 16 * kt + 4 * kq + i; p[i] = (ci <= cmax[qp]) ? __builtin_amdgcn_exp2f(st[kt][qp][i] * NSA_SC - msc[qp]) * invl[qp] : 0.f; }
                    const int j = 16 * cc + 4 * kt + kq;
                    impG[(h * 32 + j) * 64 + tq[qp]] = (p[0] + p[1]) + (p[2] + p[3]);
                    if (j < 31) impE[(h * 32 + j + 1) * 64 + tq[qp]] = p[3]; }
        } }
    __syncthreads();
    if (tid < 64) { const int tqs = tid; float tv[8]; int ti[8];
#pragma unroll
        for (int k = 0; k < 8; ++k) { tv[k] = -3e38f; ti[k] = 0; }
#pragma unroll 1
        for (int j = 0; j < 32; ++j) { float v;
            if (j <= qt) { const bool forced = (j == 0) || (j == qt) || (j == qt - 1);
                float s4 = (impG[(0 * 32 + j) * 64 + tqs] + impG[(1 * 32 + j) * 64 + tqs]) + (impG[(2 * 32 + j) * 64 + tqs] + impG[(3 * 32 + j) * 64 + tqs]);
                if (j > 0) s4 += (impE[(0 * 32 + j) * 64 + tqs] + impE[(1 * 32 + j) * 64 + tqs]) + (impE[(2 * 32 + j) * 64 + tqs] + impE[(3 * 32 + j) * 64 + tqs]);
                v = forced ? 1e6f : s4; }
            else v = -1e9f;
            int vi = j;
#pragma unroll
            for (int k = 0; k < 8; ++k) { const bool gt = v > tv[k]; const float nv = gt ? tv[k] : v; const int ni = gt ? ti[k] : vi; tv[k] = gt ? v : tv[k]; ti[k] = gt ? vi : ti[k]; v = nv; vi = ni; } }
        unsigned msk = 0u;
#pragma unroll
        for (int k = 0; k < 8; ++k) if (ti[k] <= qt) msk |= (1u << ti[k]);
        selm[tqs] = msk; atomicOr((unsigned*)&selm[64], msk); }
    __syncthreads();
    unsigned mymask[2];
#pragma unroll
    for (int qp = 0; qp < 2; ++qp) mymask[qp] = selm[tq[qp]];
    const unsigned umask = selm[64];
#pragma unroll
    for (int dt = 0; dt < 4; ++dt)
#pragma unroll
        for (int qp = 0; qp < 2; ++qp) ot[dt][qp] = mk_f4(0.f, 0.f, 0.f, 0.f);
    m[0] = m[1] = -1e4f; l[0] = l[1] = 0.f;
    { u4 kreg, vreg; unsigned rem = umask;
        int j = __builtin_ctz(rem); rem &= rem - 1u;
        nsa_kv_prefetch(Hb, b * T + 64 * j, C_KS + g * 64, C_VS + g * 64, tid, kreg, vreg);
#pragma unroll 1
        for (;;) {
            __syncthreads();
            nsa_kv_store(Kl, Vt, tid, kreg, vreg);
            __syncthreads();
            const int jc = j; const bool more = (rem != 0u);
            if (more) { j = __builtin_ctz(rem); rem &= rem - 1u; nsa_kv_prefetch(Hb, b * T + 64 * j, C_KS + g * 64, C_VS + g * 64, tid, kreg, vreg); }
            bool anyv = false, full = true;
#pragma unroll
            for (int qp = 0; qp < 2; ++qp) { const bool sel = (mymask[qp] >> jc) & 1u; lo[qp] = sel ? 0 : 64; hi[qp] = sel ? ((jc == qt) ? tq[qp] : 63) : -1; anyv |= sel; full &= (sel && jc != qt); }
            if (__builtin_amdgcn_ballot_w64(anyv) != 0ull) {
                const bool need_mask = __builtin_amdgcn_ballot_w64(!full) != 0ull;
                nsa_scores(st, Kl, Yq, lane);
                nsa_softmax_pv(st, m, l, ot, Vt, lo, hi, need_mask, lane); }
            if (!more) break;
        } }
    { const float g2[2] = {gate[1][0], gate[1][1]}; nsa_accum(tot, ot, l, g2); }
#pragma unroll
    for (int dt = 0; dt < 4; ++dt)
#pragma unroll
        for (int qp = 0; qp < 2; ++qp) ot[dt][qp] = mk_f4(0.f, 0.f, 0.f, 0.f);
    m[0] = m[1] = -1e4f; l[0] = l[1] = 0.f;
    { u4 kreg, vreg; int jw = (qt >= 8 ? qt - 8 : 0);
        nsa_kv_prefetch(Hb, b * T + 64 * jw, C_KW + g * 64, C_VW + g * 64, tid, kreg, vreg);
#pragma unroll 1
        for (;;) {
            __syncthreads();
            nsa_kv_store(Kl, Vt, tid, kreg, vreg);
            __syncthreads();
            const int jc = jw; const bool more = (jw < qt);
            if (more) { ++jw; nsa_kv_prefetch(Hb, b * T + 64 * jw, C_KW + g * 64, C_VW + g * 64, tid, kreg, vreg); }
#pragma unroll
            for (int qp = 0; qp < 2; ++qp) { lo[qp] = (jc == qt - 8) ? tq[qp] + 1 : 0; hi[qp] = (jc == qt) ? tq[qp] : 63; }
            const bool need_mask = (jc == qt) || (jc == qt - 8);
            nsa_scores(st, Kl, Yq, lane);
            nsa_softmax_pv(st, m, l, ot, Vt, lo, hi, need_mask, lane);
            if (!more) break;
        } }
    { const float g2[2] = {gate[2][0], gate[2][1]}; nsa_accum(tot, ot, l, g2); }
    float* ymix = (float*)(ws + WS_YMIX);
#pragma unroll
    for (int qp = 0; qp < 2; ++qp)
#pragma unroll
        for (int dt = 0; dt < 4; ++dt) *(f4*)(ymix + tok[qp] * D + 1024 + g * 256 + h * 64 + 16 * dt + 4 * kq) = tot[dt][qp];
    __syncthreads();
}

__device__ __forceinline__ void row_mixnorm(const Params& P, unsigned char* ws, int l, int rowi, int lane) {
    const f4* yp = (const f4*)((const float*)(ws + WS_YMIX) + (size_t)rowi * D) + lane;
    const f4* gp = (const f4*)(P.in[14] + (size_t)l * D) + lane;
    f4 v[8]; float ss[8];
#pragma unroll
    for (int j = 0; j < 8; ++j) { v[j] = yp[64 * j]; ss[j] = v[j].x * v[j].x + v[j].y * v[j].y + v[j].z * v[j].z + v[j].w * v[j].w; }
    const float r0 = rsqrtf(wave_sum(ss[0] + ss[1]) * (1.f / 512.f) + LN_EPS);
    const float r1 = rsqrtf(wave_sum(ss[2] + ss[3]) * (1.f / 512.f) + LN_EPS);
    const float r2 = rsqrtf(wave_sum((ss[4] + ss[5]) + (ss[6] + ss[7])) * (1.f / 1024.f) + LN_EPS);
    u2* op = (u2*)((bf16*)(ws + WS_MIXED) + (size_t)rowi * D) + lane;
#pragma unroll
    for (int j = 0; j < 8; ++j) { const float r = (j < 2) ? r0 : ((j < 4) ? r1 : r2); const f4 g4 = gp[64 * j];
        op[64 * j] = mk_u2(pk2(v[j].x * r * g4.x, v[j].y * r * g4.y), pk2(v[j].z * r * g4.z, v[j].w * r * g4.w)); }
}
__device__ __forceinline__ void row_ln(const float* __restrict__ zin, const float* __restrict__ gam, const float* __restrict__ bet, float* __restrict__ of32, bf16* __restrict__ obf, int rowi, int lane) {
    const f4* zp = (const f4*)(zin + (size_t)rowi * D) + lane;
    f4 v[8]; float s = 0.f;
#pragma unroll
    for (int j = 0; j < 8; ++j) { v[j] = zp[64 * j]; s += (v[j].x + v[j].y) + (v[j].z + v[j].w); }
    const float mu = wave_sum(s) * (1.f / D); float s2 = 0.f;
#pragma unroll
    for (int j = 0; j < 8; ++j) { v[j].x -= mu; v[j].y -= mu; v[j].z -= mu; v[j].w -= mu; s2 += (v[j].x * v[j].x + v[j].y * v[j].y) + (v[j].z * v[j].z + v[j].w * v[j].w); }
    const float rstd = rsqrtf(wave_sum(s2) * (1.f / D) + LN_EPS);
    f4* o4 = (f4*)(of32 + (size_t)rowi * D) + lane; u2* o2 = (u2*)(obf + (size_t)rowi * D) + lane;
    const f4* gp = (const f4*)gam + lane; const f4* bp = (const f4*)bet + lane;
#pragma unroll
    for (int j = 0; j < 8; ++j) { const f4 g4 = gp[64 * j], b4 = bp[64 * j];
        const f4 o = mk_f4(v[j].x * rstd * g4.x + b4.x, v[j].y * rstd * g4.y + b4.y, v[j].z * rstd * g4.z + b4.z, v[j].w * rstd * g4.w + b4.w);
        o4[64 * j] = o; o2[64 * j] = mk_u2(pk2(o.x, o.y), pk2(o.z, o.w)); }
}

__device__ __forceinline__ float dot8_bf16(const u4& w, const float* x) {
    float f[8]; unpack8(w, f);
    return ((f[0] * x[0] + f[1] * x[1]) + (f[2] * x[2] + f[3] * x[3])) + ((f[4] * x[4] + f[5] * x[5]) + (f[6] * x[6] + f[7] * x[7]));
}
__device__ __forceinline__ void peer_load4(u4 (&R)[4][2], const unsigned char* __restrict__ TAB, const LAS int* pe, int grp, int lane) {
#pragma unroll
    for (int k = 0; k < 4; ++k) { const int e = __builtin_amdgcn_readfirstlane(pe[grp * 4 + k]); const u4* p = (const u4*)(TAB + (size_t)e * 2048) + lane; R[k][0] = p[0]; R[k][1] = p[64]; }
}
__device__ __forceinline__ float dot16_fp8(const u4& w, const float* x) {
    float s = 0.f;
#pragma unroll
    for (int q = 0; q < 4; ++q) { const f2 lo = __builtin_amdgcn_cvt_pk_f32_fp8((int)w[q], false), hi = __builtin_amdgcn_cvt_pk_f32_fp8((int)w[q], true);
        s += (lo.x * x[4 * q] + lo.y * x[4 * q + 1]) + (hi.x * x[4 * q + 2] + hi.y * x[4 * q + 3]); }
    return s;
}
__device__ __forceinline__ void peer_dot4(const u4 (&R)[4][2], const float (&xr)[32], const float* __restrict__ USC, const LAS int* pe, const LAS float* pw, const float* __restrict__ VSC, LAS float* hwp, int grp, int lane) {
    float d[4];
#pragma unroll
    for (int k = 0; k < 4; ++k) d[k] = dot16_fp8(R[k][0], xr) + dot16_fp8(R[k][1], xr + 16);
#pragma unroll
    for (int o = 1; o < 64; o <<= 1) {
#pragma unroll
        for (int k = 0; k < 4; ++k) d[k] += __shfl_xor(d[k], o); }
#pragma unroll
    for (int k = 0; k < 4; ++k) { const int e = __builtin_amdgcn_readfirstlane(pe[grp * 4 + k]);
        const float hv = pw[grp * 4 + k] * gelu_tanh(d[k] * USC[e]) * VSC[e];
        if (lane == 0) hwp[grp * 4 + k] = hv; }
}
__device__ __forceinline__ void peer_axpy4(const u4 (&R)[4][2], float (&acc)[32], const LAS float* hwp, int grp) {
#pragma unroll
    for (int k = 0; k < 4; ++k) { const float hw = hwp[grp * 4 + k];
#pragma unroll
        for (int j = 0; j < 2; ++j)
#pragma unroll
            for (int q = 0; q < 4; ++q) { const f2 lo = __builtin_amdgcn_cvt_pk_f32_fp8((int)R[k][j][q], false), hi = __builtin_amdgcn_cvt_pk_f32_fp8((int)R[k][j][q], true);
                acc[16 * j + 4 * q] += hw * lo.x; acc[16 * j + 4 * q + 1] += hw * lo.y; acc[16 * j + 4 * q + 2] += hw * hi.x; acc[16 * j + 4 * q + 3] += hw * hi.y; } }
}
__device__ __forceinline__ void unit_peer(const Params& P, unsigned char* ws, int l, LAS unsigned char* lds, int u, int tid_in, int lane_in, int wave, float* __restrict__ xout) {
    int tid = tid_in; asm volatile("" : "+v"(tid)); int lane = tid & 63;
    const int n0 = u * 32;
    const float* QP = (const float*)(ws + WS_QP); float* SC = (float*)(ws + WS_SC);
    LAS float* keys = (LAS float*)lds;
    LAS float* qs = (LAS float*)(lds + 67584);
    #pragma unroll 1
    for (int hh = 0; hh < 16; ++hh) { const int h = hh >> 1, half = hh & 1;
        const float* kg = P.in[half ? 20 : 19] + ((size_t)l * 8 + h) * 16384;
        __syncthreads();
#pragma unroll
        for (int i = 0; i < 8; ++i) { const int idx = tid + 512 * i; const int k = idx >> 5, d4 = idx & 31; *(LAS f4*)(keys + k * 132 + d4 * 4) = ((const f4*)kg)[idx]; }
#pragma unroll
        for (int i = 0; i < 2; ++i) { const int idx = tid + 512 * i; const int tk = idx >> 5, d4 = idx & 31; *(LAS f4*)(qs + tk * 128 + d4 * 4) = *(const f4*)(QP + (size_t)(n0 + tk) * D + h * 256 + half * 128 + d4 * 4); }
        __syncthreads();
        const int k = tid & 127, tg = tid >> 7;
        float a[8];
#pragma unroll
        for (int i = 0; i < 8; ++i) a[i] = 0.f;
        #pragma unroll 1
    for (int d4 = 0; d4 < 32; ++d4) { const f4 kv = *(const LAS f4*)(keys + k * 132 + d4 * 4);
#pragma unroll
            for (int i = 0; i < 8; ++i) { const f4 q4 = *(const LAS f4*)(qs + (tg * 8 + i) * 128 + d4 * 4); a[i] += kv.x * q4.x + kv.y * q4.y + kv.z * q4.z + kv.w * q4.w; } }
#pragma unroll
        for (int i = 0; i < 8; ++i) SC[((size_t)(n0 + tg * 8 + i) * 16 + hh) * 128 + k] = a[i];
    }
    VM_WAIT();
    __syncthreads();
    tid = tid_in; asm volatile("" : "+v"(tid)); lane = tid & 63;
    LAS float* TV = (LAS float*)lds;
    LAS int* TI = (LAS int*)(lds + 34816);
    { const int tk = tid >> 4, hh = tid & 15;
        const f4* sp = (const f4*)(SC + ((size_t)(n0 + tk) * 16 + hh) * 128);
        float tv[16]; int ti[16];
#pragma unroll
        for (int k = 0; k < 16; ++k) { tv[k] = -3e38f; ti[k] = 0; }
        #pragma unroll 1
    for (int c4 = 0; c4 < 32; ++c4) { const f4 s4 = sp[c4]; const float sv[4] = {s4.x, s4.y, s4.z, s4.w};
#pragma unroll
            for (int e = 0; e < 4; ++e) { float v = sv[e]; int vi = c4 * 4 + e;
#pragma unroll
                for (int k = 0; k < 16; ++k) { const bool gt = v > tv[k]; const float nv = gt ? tv[k] : v; const int ni = gt ? ti[k] : vi; tv[k] = gt ? v : tv[k]; ti[k] = gt ? vi : ti[k]; v = nv; vi = ni; } } }
#pragma unroll
        for (int k = 0; k < 16; ++k) { TV[tid * 17 + k] = tv[k]; TI[tid * 17 + k] = ti[k]; } }
    __syncthreads();
    tid = tid_in; asm volatile("" : "+v"(tid)); lane = tid & 63;
    LAS int* PE = (LAS int*)(lds + 69632);
    LAS float* PW = (LAS float*)(lds + 86016);
    if (tid < 256) { const int tk = tid >> 3, h = tid & 7; const int r1 = tk * 16 + 2 * h, r2 = r1 + 1;
        float v1[16], v2[16]; int i1[16], i2[16];
#pragma unroll
        for (int k = 0; k < 16; ++k) { v1[k] = TV[r1 * 17 + k]; i1[k] = TI[r1 * 17 + k]; v2[k] = TV[r2 * 17 + k]; i2[k] = TI[r2 * 17 + k]; }
        float tv[16]; int te[16];
#pragma unroll
        for (int k = 0; k < 16; ++k) { tv[k] = -3e38f; te[k] = 0; }
#pragma unroll
        for (int a = 0; a < 16; ++a)
#pragma unroll
            for (int bq = 0; bq < 16; ++bq) if ((a + 1) * (bq + 1) <= 16) { float v = v1[a] + v2[bq]; int ve = i1[a] * 128 + i2[bq];
#pragma unroll
                for (int k = 0; k < 16; ++k) { const bool gt = v > tv[k]; const float nv = gt ? tv[k] : v; const int ni = gt ? te[k] : ve; tv[k] = gt ? v : tv[k]; te[k] = gt ? ve : te[k]; v = nv; ve = ni; } }
        float wsum = 0.f; float w[16];
#pragma unroll
        for (int k = 0; k < 16; ++k) { w[k] = __expf(tv[k] - tv[0]); wsum += w[k]; }
        const float inv = 1.f / wsum;
#pragma unroll
        for (int k = 0; k < 16; ++k) { PE[tk * 128 + h * 16 + k] = te[k]; PW[tk * 128 + h * 16 + k] = w[k] * inv; } }
    __syncthreads();
    tid = tid_in; asm volatile("" : "+v"(tid)); lane = tid & 63;
    LAS float* HW = (LAS float*)(lds + 102400);
    const unsigned char* PU = ws + WS_PU + (size_t)l * 16384 * 2048; const unsigned char* PV = ws + WS_PV + (size_t)l * 16384 * 2048;
    const float* USC = (const float*)(ws + WS_PSC) + (size_t)l * 16384; const float* VSC = (const float*)(ws + WS_PSC) + (size_t)(DEPTH + l) * 16384;
    const float* X1 = (const float*)(ws + WS_X1);
    #pragma unroll 1
    for (int it = 0; it < 4; ++it) { const int tk = wave * 4 + it; const size_t n = (size_t)n0 + tk;
        float xr[32];
#pragma unroll
        for (int j = 0; j < 2; ++j)
#pragma unroll
            for (int q = 0; q < 4; ++q) { const f4 a = *(const f4*)(X1 + n * D + 1024 * j + 16 * lane + 4 * q); xr[16 * j + 4 * q] = a.x; xr[16 * j + 4 * q + 1] = a.y; xr[16 * j + 4 * q + 2] = a.z; xr[16 * j + 4 * q + 3] = a.w; }
        const LAS int* pe = PE + tk * 128; const LAS float* pw = PW + tk * 128; LAS float* hwp = HW + tk * 128;
        { u4 A[4][2], B[4][2];
            peer_load4(A, PU, pe, 0, lane);
#pragma unroll 1
            for (int g2 = 0; g2 < 16; ++g2) {
                peer_load4(B, PU, pe, 2 * g2 + 1, lane);
                peer_dot4(A, xr, USC, pe, pw, VSC, hwp, 2 * g2, lane);
                if (g2 < 15) peer_load4(A, PU, pe, 2 * g2 + 2, lane);
                peer_dot4(B, xr, USC, pe, pw, VSC, hwp, 2 * g2 + 1, lane);
            } }
        LDS_WAIT();
        float acc[32];
#pragma unroll
        for (int i = 0; i < 32; ++i) acc[i] = 0.f;
        { u4 A[4][2], B[4][2];
            peer_load4(A, PV, pe, 0, lane);
#pragma unroll 1
            for (int g2 = 0; g2 < 16; ++g2) {
                peer_load4(B, PV, pe, 2 * g2 + 1, lane);
                peer_axpy4(A, acc, hwp, 2 * g2);
                if (g2 < 15) peer_load4(A, PV, pe, 2 * g2 + 2, lane);
                peer_axpy4(B, acc, hwp, 2 * g2 + 1);
            } }
        float s = 0.f;
#pragma unroll
        for (int i = 0; i < 32; ++i) { acc[i] += ALPHA * xr[i]; s += acc[i]; }
        const float mu = wave_sum(s) * (1.f / D); float s2 = 0.f;
#pragma unroll
        for (int i = 0; i < 32; ++i) { acc[i] -= mu; s2 += acc[i] * acc[i]; }
        const float rstd = rsqrtf(wave_sum(s2) * (1.f / D) + LN_EPS);
        const float* gam = P.in[23] + (size_t)l * D; const float* bet = P.in[24] + (size_t)l * D;
        bf16* xb = (bf16*)(ws + WS_XB);
#pragma unroll
        for (int j = 0; j < 2; ++j) { const int col = 1024 * j + 16 * lane; float o[16];
#pragma unroll
            for (int q = 0; q < 4; ++q) { const f4 g4 = *(const f4*)(gam + col + 4 * q), b4 = *(const f4*)(bet + col + 4 * q);
                o[4 * q] = acc[16 * j + 4 * q] * rstd * g4.x + b4.x; o[4 * q + 1] = acc[16 * j + 4 * q + 1] * rstd * g4.y + b4.y; o[4 * q + 2] = acc[16 * j + 4 * q + 2] * rstd * g4.z + b4.z; o[4 * q + 3] = acc[16 * j + 4 * q + 3] * rstd * g4.w + b4.w;
                *(f4*)(xout + n * D + col + 4 * q) = mk_f4(o[4 * q], o[4 * q + 1], o[4 * q + 2], o[4 * q + 3]); }
            u4 p0, p1; p0.x = pk2(o[0], o[1]); p0.y = pk2(o[2], o[3]); p0.z = pk2(o[4], o[5]); p0.w = pk2(o[6], o[7]); p1.x = pk2(o[8], o[9]); p1.y = pk2(o[10], o[11]); p1.z = pk2(o[12], o[13]); p1.w = pk2(o[14], o[15]);
            *(u4*)(xb + n * D + col) = p0; *(u4*)(xb + n * D + col + 8) = p1; }
    }
    __syncthreads();
}

template <class T> __device__ __forceinline__ T* uniform_ptr(T* p) { const unsigned long long v = (unsigned long long)p; const unsigned lo = __builtin_amdgcn_readfirstlane((unsigned)v), hi = __builtin_amdgcn_readfirstlane((unsigned)(v >> 32)); return (T*)(((unsigned long long)hi << 32) | lo); }
constexpr int PH_PER_LAYER = 8, N_PHASES = 1 + DEPTH * PH_PER_LAYER;
#ifndef ONLY_PHASE
#define ONLY_PHASE -1
#endif
#define EN(i) (ONLY_PHASE < 0 || ONLY_PHASE == (i))
#ifndef PROBE_DUP
#define PROBE_DUP -1
#endif
#define REP(i) for (int rep_ = 0; rep_ < ((PROBE_DUP == (i)) ? 2 : 1); ++rep_)
__global__ void __launch_bounds__(512, 2) mk_fwd(Params P) {
    extern __shared__ __attribute__((aligned(16))) unsigned char lds_raw[];
    LAS unsigned char* lds = (LAS unsigned char*)lds_raw;
    volatile LAS unsigned* MISC = (volatile LAS unsigned*)(lds + MISC_OFF);
    const int tid = threadIdx.x, lane = tid & 63, wave = __builtin_amdgcn_readfirstlane(tid >> 6);
    const int G = gridDim.x, bid = blockIdx.x;
    if (tid < 64) MISC[tid] = 0u;
    __syncthreads();
    unsigned char* const ws = uniform_ptr(P.ws);
    unsigned* ctl = (unsigned*)(ws + WS_CTL);
    const XcdBarrier bar = xcd_barrier_post(ctl + CW_BAR, MISC + 8);
    const int lo = P.ph_lo, hi = P.ph_hi;
#define IN(k) (lo <= (k) && (k) < hi)
#define LAUNDER() int tl = (wave << 6) | (int)__builtin_amdgcn_mbcnt_hi(0xffffffffu, __builtin_amdgcn_mbcnt_lo(0xffffffffu, 0u)); asm volatile("" : "+v"(tl)); const int ll = tl & 63; const int wl = __builtin_amdgcn_readfirstlane(tl >> 6); (void)ll; (void)wl
#define SEAM(k) do { if (IN((k) + 1)) xcd_barrier(bar); } while (0)
    if (IN(0) && EN(8)) { LAUNDER(); phase_prologue(P, ws, lds, tl, ll, wl); SEAM(0); }
    for (int l = 0; l < DEPTH; ++l) {
        const int pb = 1 + l * PH_PER_LAYER;
        const float* xres = (l == 0) ? P.in[0] : (const float*)(ws + WS_XC);
        float* xout = (l == DEPTH - 1) ? P.out : (float*)(ws + WS_XC);
        if (IN(pb + 0) && EN(0)) { LAUNDER();
            pg8::Gemm g{(const pg8::bf16_t*)(ws + WS_XB), (const pg8::bf16_t*)(ws + WS_WIN) + (size_t)l * INWP * D, NTOK, INWP, D};
            pg8::StaticOrder S; S.init(NTOK, INWP, G, bid);
            pg8::EpiH E{(pg8::bf16_t*)(ws + WS_H), INWP, 6, 10};
            pg8::gemm_phase<pg8::EpiH, pg8::StaticOrder, true, true>(lds, g, S, E, tl);
            SEAM(pb + 0);
        }
        if (IN(pb + 1) && EN(1)) { LAUNDER();
            REP(1) for (int u = bid; u < 240; u += G) unit_kvstate(P, ws, lds, u, tl);
            REP(1) for (int u = bid; u < 256; u += G) unit_sgu(P, ws, l, lds, u, tl, ll, wl);
            REP(1) for (int u = bid; u < 256; u += G) unit_compress(P, ws, l, lds, u, tl);
            SEAM(pb + 1);
        }
        if (IN(pb + 2) && EN(2)) { LAUNDER();
            REP(2) for (int u = bid; u < 256; u += G) unit_retention(P, ws, l, lds, u, tl);
            REP(2) for (int u = bid; u < 512; u += G) unit_nsa(P, ws, l, lds, u, tl);
            SEAM(pb + 2);
        }
        if (IN(pb + 3) && EN(3)) { LAUNDER();
            for (int r = bid * 8 + wl; r < NTOK; r += G * 8) row_mixnorm(P, ws, l, r, ll);
            SEAM(pb + 3);
        }
        if (IN(pb + 4) && EN(4)) { LAUNDER();
            pg8::Gemm g{(const pg8::bf16_t*)(ws + WS_MIXED), (const pg8::bf16_t*)(ws + WS_WOUT) + (size_t)l * D * D, NTOK, D, D};
            pg8::StaticOrder S; S.init(NTOK, D, G, bid);
            pg8::EpiRes E{(float*)(ws + WS_Z), xres, D, ALPHA};
            pg8::gemm_phase<pg8::EpiRes, pg8::StaticOrder, true, true>(lds, g, S, E, tl);
            SEAM(pb + 4);
        }
        if (IN(pb + 5) && EN(5)) { LAUNDER();
            for (int r = bid * 8 + wl; r < NTOK; r += G * 8) row_ln((const float*)(ws + WS_Z), P.in[16] + (size_t)l * D, P.in[17] + (size_t)l * D, (float*)(ws + WS_X1), (bf16*)(ws + WS_X1B), r, ll);
            SEAM(pb + 5);
        }
        if (IN(pb + 6) && EN(6)) { LAUNDER();
            pg8::Gemm g{(const pg8::bf16_t*)(ws + WS_X1B), (const pg8::bf16_t*)(ws + WS_WQ) + (size_t)l * D * D, NTOK, D, D};
            pg8::StaticOrder S; S.init(NTOK, D, G, bid);
            pg8::EpiF32 E{(float*)(ws + WS_QP), D};
            pg8::gemm_phase<pg8::EpiF32, pg8::StaticOrder, true, true>(lds, g, S, E, tl);
            SEAM(pb + 6);
        }
        if (IN(pb + 7) && EN(7)) { LAUNDER();
            REP(7) for (int u = bid; u < NTOK / 32; u += G) unit_peer(P, ws, l, lds, u, tl, ll, wl, xout);
            SEAM(pb + 7);
        }
    }
#undef IN
#undef SEAM
}

#ifndef MK_ONE_LAUNCH
#define MK_ONE_LAUNCH 1
#endif
extern "C" void kernel_launch(void* const* d_in, const int* in_sizes, int n_in, void* d_out, int out_size, void* d_ws, size_t ws_size, hipStream_t stream) {
    static int grid = 0;
    if (grid == 0) {
        if (n_in != 25 || out_size != NTOK * D || ws_size < WS_END) { fprintf(stderr, "kernel_launch: unexpected shapes: n_in %d out %d ws %zu (need %zu)\n", n_in, out_size, ws_size, (size_t)WS_END); grid = -1; return; }
        int dev = 0, cus = 0, per_cu = 0;
        if (hipGetDevice(&dev) != hipSuccess || hipDeviceGetAttribute(&cus, hipDeviceAttributeMultiprocessorCount, dev) != hipSuccess) { grid = -1; return; }
        if (hipFuncSetAttribute((const void*)mk_fwd, hipFuncAttributeMaxDynamicSharedMemorySize, LDS_BYTES) != hipSuccess) { fprintf(stderr, "kernel_launch: hipFuncSetAttribute failed\n"); grid = -1; return; }
        if (hipOccupancyMaxActiveBlocksPerMultiprocessor(&per_cu, (const void*)mk_fwd, 512, LDS_BYTES) != hipSuccess || per_cu < 1) fprintf(stderr, "kernel_launch: occupancy query says %d\n", per_cu);
        (void)hipGetLastError();
        grid = cus;
    }
    if (grid < 0) return;
    (void)hipMemsetAsync((char*)d_ws + WS_CTL, 0, CTL_ZERO_BYTES, stream);
    Params p{};
    for (int i = 0; i < 25; ++i) p.in[i] = (const float*)d_in[i];
    p.out = (float*)d_out; p.ws = (unsigned char*)d_ws;
    for (int i = 0; i < 32; ++i) p.inv_rev[i] = pow(10000.0, -(double)i / 32.0) / (2.0 * 3.14159265358979323846);
    for (int h = 0; h < 4; ++h) p.lg2[h] = (float)log2(1.0 - pow(2.0, -5.0 - (double)h));
#if MK_ONE_LAUNCH
    p.ph_lo = 0; p.ph_hi = N_PHASES; p.use_bar = 1;
    hipLaunchKernelGGL(mk_fwd, dim3(grid), dim3(512), LDS_BYTES, stream, p);
#else
    for (int k = 0; k < N_PHASES; ++k) { p.ph_lo = k; p.ph_hi = k + 1; p.use_bar = 0;
        hipLaunchKernelGGL(mk_fwd, dim3(grid), dim3(512), LDS_BYTES, stream, p); }
#endif
}
```

```cpp
#include <hip/hip_runtime.h>
#include <cstdio>
#include <cstdint>
#include <cmath>
#define LAS __attribute__((address_space(3)))
namespace pg8 {
#define PG8_LAS __attribute__((address_space(3)))
typedef unsigned short bf16_t;
typedef short bf16x8 __attribute__((ext_vector_type(8)));
typedef float f32x4 __attribute__((ext_vector_type(4)));
typedef unsigned u32x4 __attribute__((ext_vector_type(4)));
constexpr int BM = 256, BK = 64, HALF = 128, HTB = HALF * BK * 2  , STAGE_BYTES = 8 * HTB, NXCD = 8, WGM = 8;

__host__ __device__ __forceinline__ int lds_byte(int r, int c) { const int st = (r >> 4) * 2 + (c >> 5), rr = r & 15, cc = c & 31, ob = rr * 64 + cc * 2; return st * 1024 + (ob ^ (((ob >> 9) & 1) << 5)); }
__host__ __device__ __forceinline__ void stage_rc(int b, int& R, int& C) { const int st = b / 1024, sb = b % 1024, swz = sb ^ (((sb >> 9) & 1) << 5); R = (st >> 1) * 16 + swz / 64; C = (st & 1) * 32 + (swz % 64) / 2; }
__host__ __device__ __forceinline__ int perm32(int rho) { const int n = rho >> 4, i = rho & 15; return 8 * (i >> 2) + 4 * n + (i & 3); }

struct Unit { int pm, pn; };
struct Gemm { const bf16_t* A; const bf16_t* Bt; int M, N, K; };

struct StaticOrder {
    int nM, nN, nwg, G, c;
    __host__ __device__ void init(int M, int N, int G_, int c_) { nM = M / BM; nN = N / BM; nwg = nM * nN; G = G_; c = c_; }
    __host__ __device__ bool next(int i, Unit& u) const {
        const long L = (long)i * G + c; if (L >= nwg) return false;
        int wgid = (int)L; { const int q = nwg / NXCD, r = nwg % NXCD, xcd = wgid % NXCD, off = wgid / NXCD; wgid = (xcd < r ? xcd * (q + 1) : r * (q + 1) + (xcd - r) * q) + off; }
        const int nig = WGM * nN, gid = wgid / nig, fm = gid * WGM, gsz = (nM - fm) < WGM ? (nM - fm) : WGM;
        u.pm = fm + ((wgid % nig) % gsz); u.pn = (wgid % nig) / gsz; return true;
    }
    __device__ __forceinline__ void a_ready(const Unit&) const {}
    __device__ __forceinline__ void done(const Unit&) const {}
};
__device__ __forceinline__ unsigned cvt_pk_bf16(float lo, float hi) { unsigned r; asm volatile("v_cvt_pk_bf16_f32 %0, %1, %2" : "=v"(r) : "v"(lo), "v"(hi)); return r; }
typedef float f32x2 __attribute__((ext_vector_type(2)));
__device__ __forceinline__ float gelu_tanh_f(float x) {
    const float u = 1.5957691216057308f * (x + 0.044715f * x * x * x);
    return x * __builtin_amdgcn_rcpf(1.0f + __expf(-u));
}
struct EpiH {
    static constexpr bool PERM = true, AFTER_DRAIN = false;
    bf16_t* O; int ldc; int act_lo, act_hi;
    __device__ __forceinline__ void operator()(const f32x4 (&acc)[2][2][4][2], const Unit& u, int wr, int wc, int fr, int fq) const {
        const int row0 = u.pm * BM + wr * 64 + fr; const int col0 = u.pn * BM + wc * 32 + 8 * fq;
        const bool act = (u.pn >= act_lo) && (u.pn < act_hi);
#pragma unroll
        for (int ai = 0; ai < 2; ++ai)
#pragma unroll
            for (int m = 0; m < 4; ++m) { bf16_t* rowp = O + (size_t)(row0 + ai * HALF + m * 16) * ldc + col0;
#pragma unroll
                for (int bj = 0; bj < 2; ++bj) { f32x4 v0 = acc[ai][bj][m][0], v1 = acc[ai][bj][m][1];
                    if (act) {
#pragma unroll
                        for (int j = 0; j < 4; ++j) { v0[j] = gelu_tanh_f(v0[j]); v1[j] = gelu_tanh_f(v1[j]); } }
                    u32x4 w; w.x = cvt_pk_bf16(v0[0], v0[1]); w.y = cvt_pk_bf16(v0[2], v0[3]); w.z = cvt_pk_bf16(v1[0], v1[1]); w.w = cvt_pk_bf16(v1[2], v1[3]);
                    *(u32x4*)(rowp + bj * HALF) = w; } }
    }
};
struct EpiRes {
    static constexpr bool PERM = false, AFTER_DRAIN = false;
    float* C; const float* X; int ldc; float alpha;
    __device__ __forceinline__ void operator()(const f32x4 (&acc)[2][2][4][2], const Unit& u, int wr, int wc, int fr, int fq) const {
        const int row0 = u.pm * BM + wr * 64 + fr, col0 = u.pn * BM + wc * 32 + 4 * fq;
#pragma unroll
        for (int ai = 0; ai < 2; ++ai)
#pragma unroll
            for (int m = 0; m < 4; ++m) { const size_t off = (size_t)(row0 + ai * HALF + m * 16) * ldc + col0;
#pragma unroll
                for (int bj = 0; bj < 2; ++bj)
#pragma unroll
                    for (int n = 0; n < 2; ++n) { const size_t o2 = off + bj * HALF + n * 16; const f32x4 xv = *(const f32x4*)(X + o2); *(f32x4*)(C + o2) = acc[ai][bj][m][n] + xv * alpha; } }
    }
};
struct EpiF32 {
    static constexpr bool PERM = false, AFTER_DRAIN = false;
    float* C; int ldc;
    __device__ __forceinline__ void operator()(const f32x4 (&acc)[2][2][4][2], const Unit& u, int wr, int wc, int fr, int fq) const {
        const int row0 = u.pm * BM + wr * 64 + fr, col0 = u.pn * BM + wc * 32 + 4 * fq;
#pragma unroll
        for (int ai = 0; ai < 2; ++ai)
#pragma unroll
            for (int m = 0; m < 4; ++m) { float* rowp = C + (size_t)(row0 + ai * HALF + m * 16) * ldc + col0;
#pragma unroll
                for (int bj = 0; bj < 2; ++bj)
#pragma unroll
                    for (int n = 0; n < 2; ++n) *(f32x4*)(rowp + bj * HALF + n * 16) = acc[ai][bj][m][n]; }
    }
};
template <class Epi, class Sched, bool ALIGN_EPI = false, bool SP2 = false>
__device__ __forceinline__ void gemm_phase(PG8_LAS unsigned char* lds, const Gemm g, const Sched& S, const Epi& E, const int tid) {
    const int wid = __builtin_amdgcn_readfirstlane(tid >> 6), lane = tid & 63, wr = wid >> 2, wc = wid & 3, fr = lane & 15, fq = lane >> 4;
    const int K = g.K, nt = K / BK;
    unsigned voffA[2], voffB[2];
#pragma unroll
    for (int i = 0; i < 2; ++i) { int R, C; stage_rc(tid * 16 + i * 8192, R, C); const int Rb = Epi::PERM ? ((R & ~31) + perm32(R & 31)) : R;
        voffA[i] = (unsigned)(R * K + C) * 2u; voffB[i] = (unsigned)(Rb * K + C) * 2u; }
    const size_t kstep = (size_t)(BK * 2);
    const size_t hstep = (size_t)HALF * K * 2;
    const size_t tstep = 2 * hstep;
    const unsigned ldsw = (unsigned)wid * 1024u;
    const int aoff = lds_byte(wr * 64 + fr, fq * 8), boff = lds_byte(wc * 32 + fr, fq * 8);
#define PG8_SA(b, h) (((b) * 2 + (h)) * HTB)
#define PG8_SB(b, h) ((4 + (b) * 2 + (h)) * HTB)
#define PG8_STAGE(bufoff, gbase, voff) do { _Pragma("unroll") for (int _i = 0; _i < 2; ++_i) \
        __builtin_amdgcn_global_load_lds((const unsigned*)((const char*)(gbase) + (voff)[_i]), (PG8_LAS unsigned*)(lds + (bufoff) + ldsw + _i * 8192), 16, 0, 0); } while (0)
#define PG8_LDA(dst, b, h) do { _Pragma("unroll") for (int m = 0; m < 4; ++m) _Pragma("unroll") for (int k = 0; k < 2; ++k) dst[m][k] = *(const PG8_LAS bf16x8*)(lds + PG8_SA(b, h) + aoff + m * 2048 + k * 1024); } while (0)
#define PG8_LDB(dst, b, h) do { _Pragma("unroll") for (int n = 0; n < 2; ++n) _Pragma("unroll") for (int k = 0; k < 2; ++k) dst[n][k] = *(const PG8_LAS bf16x8*)(lds + PG8_SB(b, h) + boff + n * 2048 + k * 1024); } while (0)
#define PG8_MMA(ai, bj, At, Bt) do { __builtin_amdgcn_s_setprio(1); _Pragma("unroll") for (int m = 0; m < 4; ++m) _Pragma("unroll") for (int n = 0; n < 2; ++n) _Pragma("unroll") for (int k = 0; k < 2; ++k) \
        acc[ai][bj][m][n] = __builtin_amdgcn_mfma_f32_16x16x32_bf16(Bt[n][k], At[m][k], acc[ai][bj][m][n], 0, 0, 0); __builtin_amdgcn_s_setprio(0); } while (0)
#define PG8_WAIT_V(n) asm volatile("s_waitcnt vmcnt(" #n ")" ::: "memory")
#define PG8_WAIT_L(n) asm volatile("s_waitcnt lgkmcnt(" #n ")" ::: "memory")
#define PG8_BAR __builtin_amdgcn_s_barrier()
#define PG8_SCHED __builtin_amdgcn_sched_barrier(0)
    Unit cur, nxt; int ui = 0;
    if (!S.next(0, cur)) return;
    f32x4 acc[2][2][4][2];
#pragma unroll
    for (int a = 0; a < 2; ++a)
#pragma unroll
        for (int b = 0; b < 2; ++b)
#pragma unroll
            for (int m = 0; m < 4; ++m)
#pragma unroll
                for (int n = 0; n < 2; ++n) acc[a][b][m][n] = (f32x4){0.f, 0.f, 0.f, 0.f};
    bf16x8 At[4][2], B0[2][2], B1[2][2];
    const char* cA = (const char*)g.A + (size_t)cur.pm * tstep; const char* cB = (const char*)g.Bt + (size_t)cur.pn * tstep;
    S.a_ready(cur);
    if constexpr (SP2) {
        PG8_STAGE(PG8_SB(0, 0), cB, voffB); PG8_STAGE(PG8_SB(0, 1), cB + hstep, voffB); PG8_STAGE(PG8_SA(0, 0), cA, voffA); PG8_STAGE(PG8_SA(0, 1), cA + hstep, voffA);
        if (wr == 1) PG8_BAR;
        PG8_WAIT_V(2); PG8_BAR;
        PG8_STAGE(PG8_SB(1, 0), cB + kstep, voffB); PG8_STAGE(PG8_SA(1, 0), cA + kstep, voffA); PG8_STAGE(PG8_SB(1, 1), cB + hstep + kstep, voffB);
        PG8_WAIT_V(6); PG8_BAR;
    } else {
        PG8_STAGE(PG8_SB(0, 0), cB, voffB); PG8_STAGE(PG8_SA(0, 0), cA, voffA); PG8_STAGE(PG8_SB(0, 1), cB + hstep, voffB); PG8_STAGE(PG8_SA(0, 1), cA + hstep, voffA);
        if (wr == 1) PG8_BAR;
        PG8_WAIT_V(4); PG8_BAR;
        PG8_STAGE(PG8_SB(1, 0), cB + kstep, voffB); PG8_STAGE(PG8_SA(1, 0), cA + kstep, voffA); PG8_STAGE(PG8_SB(1, 1), cB + hstep + kstep, voffB);
        PG8_WAIT_V(6); PG8_BAR;
    }
    for (;;) {
        const bool has_next = S.next(ui + 1, nxt);
        const char* nA = has_next ? (const char*)g.A + (size_t)nxt.pm * tstep : cA; const char* nB = has_next ? (const char*)g.Bt + (size_t)nxt.pn * tstep : cB;
        for (int t = 0; t < nt; t += 2) {
            const bool last = (t == nt - 2);
            const char* a1 = cA + (size_t)(t + 1) * kstep;
            const char* a2 = last ? nA : cA + (size_t)(t + 2) * kstep; const char* b2 = last ? nB : cB + (size_t)(t + 2) * kstep;
            const char* a3 = a2 + kstep; const char* b3 = b2 + kstep;
            if (last && has_next) S.a_ready(nxt);
            if constexpr (SP2) {
            PG8_LDB(B0, 0, 0); PG8_LDB(B1, 0, 1); PG8_SCHED; PG8_LDA(At, 0, 0); PG8_STAGE(PG8_SA(1, 1), a1 + hstep, voffA);
            PG8_WAIT_V(8); PG8_WAIT_L(0); PG8_BAR; PG8_MMA(0, 0, At, B0); PG8_MMA(0, 1, At, B1); PG8_BAR; PG8_SCHED;
            PG8_LDA(At, 0, 1); PG8_STAGE(PG8_SB(0, 0), b2, voffB); PG8_STAGE(PG8_SB(0, 1), b2 + hstep, voffB); PG8_STAGE(PG8_SA(0, 0), a2, voffA);
            PG8_WAIT_V(8); PG8_WAIT_L(0); PG8_BAR; PG8_MMA(1, 0, At, B0); PG8_MMA(1, 1, At, B1); PG8_BAR; PG8_SCHED;
            PG8_LDB(B0, 1, 0); PG8_LDB(B1, 1, 1); PG8_SCHED; PG8_LDA(At, 1, 0); PG8_STAGE(PG8_SA(0, 1), a2 + hstep, voffA);
            PG8_WAIT_V(8); PG8_WAIT_L(0); PG8_BAR; PG8_MMA(0, 0, At, B0); PG8_MMA(0, 1, At, B1); PG8_BAR; PG8_SCHED;
            PG8_LDA(At, 1, 1); PG8_STAGE(PG8_SB(1, 0), b3, voffB); PG8_STAGE(PG8_SB(1, 1), b3 + hstep, voffB); PG8_STAGE(PG8_SA(1, 0), a3, voffA);
            PG8_WAIT_V(8); PG8_WAIT_L(0); PG8_BAR; PG8_MMA(1, 0, At, B0); PG8_MMA(1, 1, At, B1); PG8_BAR; PG8_SCHED;
            } else {
            PG8_LDB(B0, 0, 0); PG8_SCHED; PG8_LDA(At, 0, 0); PG8_STAGE(PG8_SA(1, 1), a1 + hstep, voffA);
            PG8_WAIT_L(8); PG8_BAR; PG8_WAIT_L(0); PG8_MMA(0, 0, At, B0); PG8_BAR; PG8_SCHED;
            PG8_LDB(B1, 0, 1); PG8_STAGE(PG8_SB(0, 0), b2, voffB);
            PG8_BAR; PG8_WAIT_L(0); PG8_MMA(0, 1, At, B1); PG8_BAR;
            PG8_LDA(At, 0, 1); PG8_STAGE(PG8_SA(0, 0), a2, voffA);
            PG8_BAR; PG8_WAIT_L(0); PG8_MMA(1, 0, At, B0); PG8_BAR; PG8_SCHED;
            PG8_STAGE(PG8_SB(0, 1), b2 + hstep, voffB);
            PG8_WAIT_V(6); PG8_BAR; PG8_MMA(1, 1, At, B1); PG8_BAR;
            PG8_LDB(B0, 1, 0); PG8_SCHED; PG8_LDA(At, 1, 0); PG8_STAGE(PG8_SA(0, 1), a2 + hstep, voffA);
            PG8_WAIT_L(8); PG8_BAR; PG8_WAIT_L(0); PG8_MMA(0, 0, At, B0); PG8_BAR; PG8_SCHED;
            PG8_LDB(B1, 1, 1); PG8_STAGE(PG8_SB(1, 0), b3, voffB);
            PG8_BAR; PG8_WAIT_L(0); PG8_MMA(0, 1, At, B1); PG8_BAR;
            PG8_LDA(At, 1, 1); PG8_STAGE(PG8_SA(1, 0), a3, voffA);
            PG8_BAR; PG8_WAIT_L(0); PG8_MMA(1, 0, At, B0); PG8_BAR; PG8_SCHED;
            PG8_STAGE(PG8_SB(1, 1), b3 + hstep, voffB);
            PG8_WAIT_V(6); PG8_BAR; PG8_MMA(1, 1, At, B1); PG8_BAR;
            }
        }
        if constexpr (ALIGN_EPI) { if (wr == 0) PG8_BAR; }
        if constexpr (!Epi::AFTER_DRAIN) { E(acc, cur, wr, wc, fr, fq); S.done(cur); }
        if (!has_next) break;
#pragma unroll
        for (int a = 0; a < 2; ++a)
#pragma unroll
            for (int b = 0; b < 2; ++b)
#pragma unroll
                for (int m = 0; m < 4; ++m)
#pragma unroll
                    for (int n = 0; n < 2; ++n) acc[a][b][m][n] = (f32x4){0.f, 0.f, 0.f, 0.f};
        cur = nxt; cA = nA; cB = nB; ++ui;
        if constexpr (ALIGN_EPI) { if (wr == 1) PG8_BAR; }
    }
    PG8_WAIT_V(0);
    if constexpr (!ALIGN_EPI) { if (wr == 0) PG8_BAR; }
    PG8_BAR;
    if constexpr (Epi::AFTER_DRAIN) { E.fused(acc, cur, wr, wc, fr, fq, lds, wid, lane); S.done(cur); }
#undef PG8_SA
#undef PG8_SB
#undef PG8_STAGE
#undef PG8_LDA
#undef PG8_LDB
#undef PG8_MMA
#undef PG8_WAIT_V
#undef PG8_WAIT_L
#undef PG8_BAR
#undef PG8_SCHED
}
}
#define XB_TMO      128
#define XB_XCNT(j)  (256  + 64 * (j))
#define XB_XSUB(j)  (1280 + 64 * (j))
#define XB_XGEN(j)  (2304 + 64 * (j))
#define XB_TOP      3328
#define XB_TOPGEN   3392
#define XCD_BAR_WORDS 3456
#define XB_SPIN_CAP (1u << 18)

__device__ __forceinline__ unsigned xb_ld(unsigned* p)              { return __hip_atomic_load(p, __ATOMIC_RELAXED, __HIP_MEMORY_SCOPE_AGENT); }
__device__ __forceinline__ unsigned xb_add(unsigned* p, unsigned v) { return __hip_atomic_fetch_add(p, v, __ATOMIC_RELAXED, __HIP_MEMORY_SCOPE_AGENT); }
__device__ __forceinline__ unsigned xb_xcc_id() { return (unsigned)__builtin_amdgcn_s_getreg((3 << 11) | 20) & 0xFu; }
#define XB_SPIN(cond, bar) do { unsigned _sp = 0; while (cond) { __builtin_amdgcn_s_sleep(1); \
    if ((++_sp & 255u) == 0u) { if (xb_ld(&(bar)[XB_TMO])) break; if (_sp > XB_SPIN_CAP) { atomicAdd(&(bar)[XB_TMO], 1u); break; } } } } while (0)

struct XcdBarrier {
    unsigned* bar; unsigned x;
    volatile LAS unsigned* st;
};

__device__ __forceinline__ XcdBarrier xcd_barrier_post(unsigned* bar, volatile LAS unsigned* st) {
    XcdBarrier b; b.bar = bar; b.x = xb_xcc_id(); b.st = st;
    if (threadIdx.x == 0) (void)xb_add(&bar[XB_XCNT(b.x)], 1u);
    return b;
}
__device__ __forceinline__ void xcd_barrier_complete(unsigned* bar, unsigned x, unsigned& nloc, unsigned& nx) {
    const unsigned G = gridDim.x * gridDim.y * gridDim.z;
    unsigned sum, cnt, mine, sp = 0u;
    for (;;) {
        sum = 0u; cnt = 0u; mine = 0u;
#pragma unroll
        for (unsigned j = 0; j < 16; ++j) { const unsigned c = xb_ld(&bar[XB_XCNT(j)]); sum += c; cnt += (c > 0u) ? 1u : 0u; mine = (j == x) ? c : mine; }
        if (sum == G) break;
        __builtin_amdgcn_s_sleep(1);
        if ((++sp & 255u) == 0u) { if (xb_ld(&bar[XB_TMO])) break; if (sp > XB_SPIN_CAP) { atomicAdd(&bar[XB_TMO], 1u); break; } }
    }
    nloc = mine > 0u ? mine : 1u; nx = cnt > 0u ? cnt : 1u;
}

__device__ __forceinline__ void xcd_barrier(const XcdBarrier& b) {
    asm volatile("s_waitcnt vmcnt(0)" ::: "memory");
    __syncthreads();
    if (threadIdx.x == 0) {
        unsigned* bar = b.bar;
        __builtin_amdgcn_s_waitcnt(0);
        unsigned nloc = b.st[0], nx = b.st[1];
        if (nloc == 0u) { xcd_barrier_complete(bar, b.x, nloc, nx); b.st[0] = nloc; b.st[1] = nx; }
        const unsigned old = xb_add(&bar[XB_XSUB(b.x)], 1u);
        const unsigned gen = old / nloc;
        if (old + 1u == (gen + 1u) * nloc) {
            __builtin_amdgcn_fence(__ATOMIC_RELEASE, "agent");
            asm volatile("s_waitcnt vmcnt(0)" ::: "memory");
            const unsigned og = xb_add(&bar[XB_TOP], 1u);
            const unsigned tg = og / nx;
            if (og + 1u == (tg + 1u) * nx) xb_add(&bar[XB_TOPGEN], 1u);
            else XB_SPIN(xb_ld(&bar[XB_TOPGEN]) == tg, bar);
            __builtin_amdgcn_fence(__ATOMIC_ACQUIRE, "agent");
            xb_add(&bar[XB_XGEN(b.x)], 1u);
            asm volatile("s_waitcnt vmcnt(0)" ::: "memory");
        } else {
            XB_SPIN(xb_ld(&bar[XB_XGEN(b.x)]) == gen, bar);
            __builtin_amdgcn_fence(__ATOMIC_ACQUIRE, "agent");
            asm volatile("s_waitcnt vmcnt(0)" ::: "memory");
        }
    }
    __syncthreads();
}

constexpr int NB = 4, T = 2048, D = 2048, NTOK = NB * T, DEPTH = 4;
constexpr int INW = 5168, INWP = 5376;
constexpr int C_RQ = 0, C_RK = 256, C_RV = 512, C_RG = 1024, C_SU = 1536, C_SV = 2048, C_NQ = 2560, C_KC = 3584, C_VC = 3840, C_KS = 4096, C_VS = 4352, C_KW = 4608, C_VW = 4864, C_NG = 5120;
constexpr float ALPHA = 1.6817928305074290f;
constexpr float LN_EPS = 1e-5f;
constexpr float LOG2E = 1.4426950408889634f;

constexpr size_t MiB = (size_t)1 << 20;
constexpr size_t WS_CTL = 0, CTL_ZERO_BYTES = 1 * MiB;
constexpr size_t WS_ROPE = 1 * MiB;
constexpr size_t WS_WIN = 2 * MiB;
constexpr size_t WS_WOUT = 86 * MiB;
constexpr size_t WS_WQ = 118 * MiB;
constexpr size_t WS_PU = 160 * MiB;
constexpr size_t WS_PV = 416 * MiB;
constexpr size_t WS_H = 672 * MiB;
constexpr size_t WS_YMIX = 756 * MiB;
constexpr size_t WS_MIXED = 820 * MiB;
constexpr size_t WS_Z = 852 * MiB;
constexpr size_t WS_X1 = 916 * MiB;
constexpr size_t WS_X1B = 980 * MiB;
constexpr size_t WS_QP = 1012 * MiB;
constexpr size_t WS_XC = 1076 * MiB;
constexpr size_t WS_XB = 1140 * MiB;
constexpr size_t WS_KC = 1172 * MiB;
constexpr size_t WS_KVST = 1174 * MiB;
constexpr size_t WS_SC = 1184 * MiB;
constexpr size_t WS_PSC = 1248 * MiB;
constexpr size_t WS_W1T = 1250 * MiB;
constexpr size_t WS_W2T = 1258 * MiB;
constexpr size_t WS_END = 1260 * MiB;
constexpr int CW_BAR = 4096;

constexpr int LDS_BYTES = 147456;
constexpr int MISC_OFF = 143360;

#define GAS __attribute__((address_space(1)))
typedef float f4 __attribute__((ext_vector_type(4)));
typedef float f2 __attribute__((ext_vector_type(2)));
typedef unsigned u4 __attribute__((ext_vector_type(4)));
typedef unsigned u2 __attribute__((ext_vector_type(2)));
__device__ __forceinline__ f4 mk_f4(float a, float b, float c, float d) { f4 r; r.x = a; r.y = b; r.z = c; r.w = d; return r; }
__device__ __forceinline__ f2 mk_f2(float a, float b) { f2 r; r.x = a; r.y = b; return r; }
__device__ __forceinline__ u2 mk_u2(unsigned a, unsigned b) { u2 r; r.x = a; r.y = b; return r; }
typedef unsigned short bf16;
#define LDS_WAIT() asm volatile("s_waitcnt lgkmcnt(0)" ::: "memory")
#define VM_WAIT() asm volatile("s_waitcnt vmcnt(0)" ::: "memory")

struct Params {
    const float* in[25];
    float* out;
    unsigned char* ws;
    double inv_rev[32];
    float lg2[4];
    int ph_lo, ph_hi, use_bar, pad0;
};

__device__ __forceinline__ float bf2f(unsigned short b) { return __uint_as_float(((unsigned)b) << 16); }
__device__ __forceinline__ unsigned f2bf(float f) { unsigned u = __float_as_uint(f); return (u + 0x7fffu + ((u >> 16) & 1u)) >> 16; }
__device__ __forceinline__ unsigned pk2(float lo, float hi) { return f2bf(lo) | (f2bf(hi) << 16); }
__device__ __forceinline__ float wave_sum(float v) {
#pragma unroll
    for (int o = 1; o < 64; o <<= 1) v += __shfl_xor(v, o);
    return v;
}
__device__ __forceinline__ void unpack8(const u4& v, float* f) {
    f[0] = __uint_as_float(v.x << 16); f[1] = __uint_as_float(v.x & 0xffff0000u);
    f[2] = __uint_as_float(v.y << 16); f[3] = __uint_as_float(v.y & 0xffff0000u);
    f[4] = __uint_as_float(v.z << 16); f[5] = __uint_as_float(v.z & 0xffff0000u);
    f[6] = __uint_as_float(v.w << 16); f[7] = __uint_as_float(v.w & 0xffff0000u);
}
__device__ __forceinline__ float gelu_tanh(float x) { return pg8::gelu_tanh_f(x); }

__device__ __forceinline__ void transpose_tile(const float* __restrict__ W, int K, int N, bf16* __restrict__ WT, LAS float* scr, int kb, int nb, int lane) {
    const int k0 = kb * 64, n0 = nb * 32, nn = lane & 31; const bool ok = (n0 + nn) < N;
#pragma unroll 8
    for (int i = 0; i < 32; ++i) { const int kk = 2 * i + (lane >> 5); scr[kk * 33 + nn] = ok ? W[(size_t)(k0 + kk) * N + n0 + nn] : 0.f; }
    LDS_WAIT();
    const int c = lane & 7;
#pragma unroll
    for (int j = 0; j < 4; ++j) { const int n = (lane >> 3) + 8 * j; const LAS float* s = scr + (8 * c) * 33 + n;
        u4 o; o.x = pk2(s[0 * 33], s[1 * 33]); o.y = pk2(s[2 * 33], s[3 * 33]); o.z = pk2(s[4 * 33], s[5 * 33]); o.w = pk2(s[6 * 33], s[7 * 33]);
        *(u4*)(WT + (size_t)(n0 + n) * K + k0 + 8 * c) = o; }
    LDS_WAIT();
}
__device__ __forceinline__ void cvt_bf16_stream(const float* __restrict__ src, bf16* __restrict__ dst, size_t nchunks, size_t gt, size_t GT) {
    for (size_t c = gt; c < nchunks; c += GT) { const f4 a = ((const f4*)src)[2 * c], b = ((const f4*)src)[2 * c + 1];
        u4 o; o.x = pk2(a.x, a.y); o.y = pk2(a.z, a.w); o.z = pk2(b.x, b.y); o.w = pk2(b.z, b.w); ((u4*)dst)[c] = o; }
}
__device__ __forceinline__ void phase_prologue(const Params& P, unsigned char* ws, LAS unsigned char* lds, int tid, int lane, int wave) {
    LAS float* scr = (LAS float*)(lds + wave * 8704);
    const int gw = blockIdx.x * 8 + wave, NGW = gridDim.x * 8;
    constexpr int I_IN = 32 * 168, I_SQ = 32 * 64, I_L = I_IN + 2 * I_SQ;
    for (int it = gw; it < DEPTH * I_L; it += NGW) {
        const int l = it / I_L; int r = it % I_L;
        if (r < I_IN) transpose_tile(P.in[1] + (size_t)l * D * INW, D, INW, (bf16*)(ws + WS_WIN) + (size_t)l * INWP * D, scr, r / 168, r % 168, lane);
        else { r -= I_IN;
            if (r < I_SQ) transpose_tile(P.in[15] + (size_t)l * D * D, D, D, (bf16*)(ws + WS_WOUT) + (size_t)l * D * D, scr, r / 64, r % 64, lane);
            else { r -= I_SQ; transpose_tile(P.in[18] + (size_t)l * D * D, D, D, (bf16*)(ws + WS_WQ) + (size_t)l * D * D, scr, r / 64, r % 64, lane); } }
    }
    for (int it = gw; it < DEPTH * 2 * (32 * 8 + 4 * 2); it += NGW) {
        const int lk = it / 264, r = it % 264, l = lk >> 1, kv = lk & 1;
        if (r < 256) transpose_tile(P.in[kv ? 12 : 9] + (size_t)l * 2048 * 256, 2048, 256, (bf16*)(ws + WS_W1T) + (size_t)lk * 256 * 2048, scr, r >> 3, r & 7, lane);
        else transpose_tile(P.in[kv ? 13 : 10] + (size_t)l * 256 * 64, 256, 64, (bf16*)(ws + WS_W2T) + (size_t)lk * 64 * 256, scr, (r - 256) >> 1, (r - 256) & 1, lane);
    }
    const size_t gt = (size_t)blockIdx.x * 512 + tid, GT = (size_t)gridDim.x * 512;
    for (int row = gw; row < 2 * DEPTH * 16384; row += NGW) {
        const int tab = row / (DEPTH * 16384), rr = row % (DEPTH * 16384);
        const float* src = P.in[21 + tab] + (size_t)rr * 2048;
        f4 v[8]; float am = 0.f;
#pragma unroll
        for (int j = 0; j < 2; ++j)
#pragma unroll
            for (int q = 0; q < 4; ++q) { const f4 a = *(const f4*)(src + 1024 * j + 16 * lane + 4 * q); v[4 * j + q] = a; am = fmaxf(am, fmaxf(fmaxf(fabsf(a.x), fabsf(a.y)), fmaxf(fabsf(a.z), fabsf(a.w)))); }
#pragma unroll
        for (int o = 1; o < 64; o <<= 1) am = fmaxf(am, __shfl_xor(am, o));
        const float sc = (am > 0.f) ? 448.f / am : 1.f;
        if (lane == 0) ((float*)(ws + WS_PSC))[row] = (am > 0.f) ? am * (1.f / 448.f) : 1.f;
        unsigned char* dst = ws + (tab ? WS_PV : WS_PU) + (size_t)rr * 2048;
#pragma unroll
        for (int j = 0; j < 2; ++j) { u4 w;
#pragma unroll
            for (int q = 0; q < 4; ++q) { const f4 a = v[4 * j + q]; int r = __builtin_amdgcn_cvt_pk_fp8_f32(a.x * sc, a.y * sc, 0, false); r = __builtin_amdgcn_cvt_pk_fp8_f32(a.z * sc, a.w * sc, r, true); w[q] = (unsigned)r; }
            *(u4*)(dst + 1024 * j + 16 * lane) = w; }
    }
    cvt_bf16_stream(P.in[0], (bf16*)(ws + WS_XB), (size_t)NTOK * D / 8, gt, GT);
    f2* rope = (f2*)(ws + WS_ROPE);
    for (size_t idx = gt; idx < (size_t)T * 32; idx += GT) { const int t = (int)(idx >> 5), i = (int)(idx & 31);
        double a = (double)t * P.inv_rev[i]; a -= floor(a); const float fr = (float)a;
        rope[idx] = mk_f2(__builtin_amdgcn_cosf(fr), __builtin_amdgcn_sinf(fr)); }
}

__device__ __forceinline__ void stage_rot_k(const bf16* __restrict__ Hb, const f2* __restrict__ rope, LAS float* ks, int tok0, int tpos0, int colK, float lg2h, bool zeta, int tid) {
    const int m = tid >> 2, p = tid & 3;
    const bf16* src = Hb + (size_t)(tok0 + m) * INWP + colK + p * 8;
    const u4 a = *(const u4*)src, b = *(const u4*)(src + 32);
    float x1[8], x2[8]; unpack8(a, x1); unpack8(b, x2);
    const f4* rp = (const f4*)(rope + (size_t)(tpos0 + m) * 32 + p * 8);
    const f4 r0 = rp[0], r1 = rp[1], r2 = rp[2], r3 = rp[3];
    const float cs[8] = {r0.x, r0.z, r1.x, r1.z, r2.x, r2.z, r3.x, r3.z}, sn[8] = {r0.y, r0.w, r1.y, r1.w, r2.y, r2.w, r3.y, r3.w};
    const float sc = 0.125f * (zeta ? exp2f(lg2h * (float)(127 - m)) : 1.0f);
    float o1[8], o2[8];
#pragma unroll
    for (int i = 0; i < 8; ++i) { o1[i] = (x1[i] * cs[i] - x2[i] * sn[i]) * sc; o2[i] = (x1[i] * sn[i] + x2[i] * cs[i]) * sc; }
    LAS f4* d1 = (LAS f4*)(ks + m * 64 + p * 8); LAS f4* d2 = (LAS f4*)(ks + m * 64 + 32 + p * 8);
    d1[0] = mk_f4(o1[0], o1[1], o1[2], o1[3]); d1[1] = mk_f4(o1[4], o1[5], o1[6], o1[7]);
    d2[0] = mk_f4(o2[0], o2[1], o2[2], o2[3]); d2[1] = mk_f4(o2[4], o2[5], o2[6], o2[7]);
}
__device__ __forceinline__ void stage_v128(const bf16* __restrict__ Hb, LAS float* vs, int tok0, int colV, int tid) {
    const int m = tid >> 2, p = tid & 3;
    const u4* src = (const u4*)(Hb + (size_t)(tok0 + m) * INWP + colV + p * 32);
    LAS f4* dst = (LAS f4*)(vs + m * 128 + p * 32);
#pragma unroll
    for (int j = 0; j < 4; ++j) { const u4 a = src[j]; float f[8]; unpack8(a, f); dst[2 * j] = mk_f4(f[0], f[1], f[2], f[3]); dst[2 * j + 1] = mk_f4(f[4], f[5], f[6], f[7]); }
}

__device__ __forceinline__ void unit_kvstate(const Params& P, unsigned char* ws, LAS unsigned char* lds, int u, int tid) {
    const int b = u / 60, r = u % 60, h = r / 15, j = r % 15;
    const bf16* Hb = (const bf16*)(ws + WS_H); const f2* rope = (const f2*)(ws + WS_ROPE);
    LAS float* ks = (LAS float*)lds; LAS float* vs = (LAS float*)(lds + 32768);
    const int tok0 = b * T + j * 128;
    stage_rot_k(Hb, rope, ks, tok0, j * 128, C_RK + h * 64, P.lg2[h], true, tid);
    stage_v128(Hb, vs, tok0, C_RV + h * 128, tid);
    __syncthreads();
    const int d = tid >> 3, e0 = (tid & 7) * 16;
    float acc[16];
#pragma unroll
    for (int i = 0; i < 16; ++i) acc[i] = 0.f;
    #pragma unroll 1
    for (int m = 0; m < 128; ++m) { const float kd = ks[m * 64 + d]; const LAS f4* vp = (const LAS f4*)(vs + m * 128 + e0);
#pragma unroll
        for (int q = 0; q < 4; ++q) { const f4 v = vp[q]; acc[4 * q] += kd * v.x; acc[4 * q + 1] += kd * v.y; acc[4 * q + 2] += kd * v.z; acc[4 * q + 3] += kd * v.w; } }
    f4* dst = (f4*)((float*)(ws + WS_KVST) + ((size_t)((b * 4 + h) * 16 + j) * 64 + d) * 128 + e0);
#pragma unroll
    for (int q = 0; q < 4; ++q) dst[q] = mk_f4(acc[4 * q], acc[4 * q + 1], acc[4 * q + 2], acc[4 * q + 3]);
    __syncthreads();
}

__device__ __forceinline__ void unit_sgu(const Params& P, unsigned char* ws, int l, LAS unsigned char* lds, int u, int tid, int lane, int wave) {
    const int b = u >> 6, c = (u >> 2) & 15, g = u & 3;
    const bf16* Hb = (const bf16*)(ws + WS_H);
    LAS float* vn = (LAS float*)lds;
    LAS float* wsm = (LAS float*)(lds + 65536);
    const int tok0 = b * T + c * 128;
    const float* lng = P.in[4] + l * 512 + g * 128; const float* lnb = P.in[5] + l * 512 + g * 128;
    const float g0 = lng[2 * lane], g1 = lng[2 * lane + 1], b0 = lnb[2 * lane], b1 = lnb[2 * lane + 1];
    for (int i = 0; i < 16; ++i) { const int s = wave * 16 + i;
        const unsigned pr = *(const unsigned*)(Hb + (size_t)(tok0 + s) * INWP + C_SV + g * 128 + 2 * lane);
        const float v0 = __uint_as_float(pr << 16), v1 = __uint_as_float(pr & 0xffff0000u);
        const float mu = wave_sum(v0 + v1) * (1.f / 128.f); const float d0 = v0 - mu, d1 = v1 - mu;
        const float var = wave_sum(d0 * d0 + d1 * d1) * (1.f / 128.f); const float rstd = rsqrtf(var + LN_EPS);
        *(LAS f2*)(vn + s * 128 + 2 * lane) = mk_f2(d0 * rstd * g0 + b0, d1 * rstd * g1 + b1); }
    const float* wg = P.in[6] + ((size_t)l * 4 + g) * 16384;
    for (int i = 0; i < 32; ++i) { const int idx = tid + 512 * i; wsm[(idx >> 7) * 129 + (idx & 127)] = wg[idx]; }
    __syncthreads();
    const int t = tid >> 2, dg = tid & 3; const int smax = (t | 15);
    float acc[32];
#pragma unroll
    for (int i = 0; i < 32; ++i) acc[i] = 0.f;
    #pragma unroll 1
    for (int s = 0; s <= smax; ++s) { const float wv = (s <= t) ? wsm[t * 129 + s] : 0.f; const LAS f4* vp = (const LAS f4*)(vn + s * 128 + dg * 32);
#pragma unroll
        for (int q = 0; q < 8; ++q) { const f4 v = vp[q]; acc[4 * q] += wv * v.x; acc[4 * q + 1] += wv * v.y; acc[4 * q + 2] += wv * v.z; acc[4 * q + 3] += wv * v.w; } }
    const float bs = P.in[7][(l * 4 + g) * 128 + t];
    const u4* up = (const u4*)(Hb + (size_t)(tok0 + t) * INWP + C_SU + g * 128 + dg * 32);
    f4* yo = (f4*)((float*)(ws + WS_YMIX) + (size_t)(tok0 + t) * D + 512 + g * 128 + dg * 32);
#pragma unroll
    for (int j = 0; j < 4; ++j) { const u4 a = up[j]; float f[8]; unpack8(a, f);
        yo[2 * j] = mk_f4(f[0] * (acc[8 * j] + bs), f[1] * (acc[8 * j + 1] + bs), f[2] * (acc[8 * j + 2] + bs), f[3] * (acc[8 * j + 3] + bs));
        yo[2 * j + 1] = mk_f4(f[4] * (acc[8 * j + 4] + bs), f[5] * (acc[8 * j + 5] + bs), f[6] * (acc[8 * j + 6] + bs), f[7] * (acc[8 * j + 7] + bs)); }
    __syncthreads();
}

__device__ __forceinline__ void unit_compress(const Params& P, unsigned char* ws, int l, LAS unsigned char* lds, int u, int tid) {
    const int kv = u >> 7, b = (u >> 5) & 3, g = (u >> 3) & 3, r = u & 7;
    const bf16* Hb = (const bf16*)(ws + WS_H);
    LAS float* seg = (LAS float*)lds;
    LAS float* hid = (LAS float*)(lds + 69632);
    const int col0 = (kv ? C_VC : C_KC) + g * 64;
    const float* pe = P.in[kv ? 11 : 8] + (size_t)l * 2048;
    const float* w1 = P.in[kv ? 12 : 9] + (size_t)l * 2048 * 256;
    const float* w2 = P.in[kv ? 13 : 10] + (size_t)l * 256 * 64;
    for (int idx = tid; idx < 272 * 8; idx += 512) { const int tt = idx >> 3, d8 = (idx & 7) * 8; const int t = 256 * r + tt;
        float f[8];
        if (t < T) { const u4 a = *(const u4*)(Hb + (size_t)(b * T + t) * INWP + col0 + d8); unpack8(a, f); }
        else {
#pragma unroll
            for (int i = 0; i < 8; ++i) f[i] = 0.f; }
        LAS f4* dp = (LAS f4*)(seg + tt * 64 + d8); dp[0] = mk_f4(f[0], f[1], f[2], f[3]); dp[1] = mk_f4(f[4], f[5], f[6], f[7]); }
    __syncthreads();
    const int j = tid & 255, hb = tid >> 8;
    float acc[8], accpe = 0.f;
#pragma unroll
    for (int i = 0; i < 8; ++i) acc[i] = 0.f;
    for (int pos = 0; pos < 32; ++pos) {
#pragma unroll 2
        for (int d4 = 0; d4 < 16; ++d4) { const int kk = pos * 64 + d4 * 4;
            const float w0 = w1[(size_t)(kk + 0) * 256 + j], w1v = w1[(size_t)(kk + 1) * 256 + j], w2v = w1[(size_t)(kk + 2) * 256 + j], w3 = w1[(size_t)(kk + 3) * 256 + j];
            const f4 p4 = *(const f4*)(pe + kk);
            accpe += w0 * p4.x + w1v * p4.y + w2v * p4.z + w3 * p4.w;
#pragma unroll
            for (int ib = 0; ib < 8; ++ib) { const f4 s4 = *(const LAS f4*)(seg + (16 * (hb * 8 + ib) + pos) * 64 + d4 * 4);
                acc[ib] += w0 * s4.x + w1v * s4.y + w2v * s4.z + w3 * s4.w; } } }
#pragma unroll
    for (int ib = 0; ib < 8; ++ib) hid[(hb * 8 + ib) * 256 + j] = gelu_tanh(acc[ib] + accpe);
    __syncthreads();
    { const int i = tid >> 5, o2 = (tid & 31) * 2; float a0 = 0.f, a1 = 0.f;
        for (int jj = 0; jj < 256; ++jj) { const float hv = hid[i * 256 + jj]; const f2 w = *(const f2*)(w2 + jj * 64 + o2); a0 += hv * w.x; a1 += hv * w.y; }
        const int ci = 16 * r + i;
        if (ci <= 126) *(f2*)((float*)(ws + WS_KC) + ((size_t)((kv * 4 + b) * 4 + g) * 128 + ci) * 64 + o2) = mk_f2(a0, a1); }
    __syncthreads();
}

__device__ __forceinline__ void unit_retention(const Params& P, unsigned char* ws, int l, LAS unsigned char* lds, int u, int tid) {
    const int b = u >> 6, h = (u >> 4) & 3, c = u & 15;
    const bf16* Hb = (const bf16*)(ws + WS_H); const f2* rope = (const f2*)(ws + WS_ROPE);
    LAS float* regB = (LAS float*)lds;
    LAS float* vs = (LAS float*)(lds + 32768);
    LAS float* Qs = (LAS float*)(lds + 98304);
    const float lg2h = P.lg2[h];
    const int tok0 = b * T + c * 128;
    { float a[16];
#pragma unroll
        for (int i = 0; i < 16; ++i) a[i] = 0.f;
        const float* kvb = (const float*)(ws + WS_KVST) + (size_t)((b * 4 + h) * 16) * 8192 + tid * 16;
#pragma unroll 1
        for (int j = 0; j < c; ++j) { const float w = exp2f(lg2h * 128.f * (float)(c - 1 - j)); const f4* sp = (const f4*)(kvb + (size_t)j * 8192);
#pragma unroll
            for (int q = 0; q < 4; ++q) { const f4 v = sp[q]; a[4 * q] += w * v.x; a[4 * q + 1] += w * v.y; a[4 * q + 2] += w * v.z; a[4 * q + 3] += w * v.w; } }
        LAS f4* dp = (LAS f4*)(regB + tid * 16);
#pragma unroll
        for (int q = 0; q < 4; ++q) dp[q] = mk_f4(a[4 * q], a[4 * q + 1], a[4 * q + 2], a[4 * q + 3]); }
    const int n = tid >> 2, eg = tid & 3;
    float qa[8], qb[8];
    { const bf16* src = Hb + (size_t)(tok0 + n) * INWP + C_RQ + h * 64 + eg * 8;
        const u4 a = *(const u4*)src, bb = *(const u4*)(src + 32);
        float x1[8], x2[8]; unpack8(a, x1); unpack8(bb, x2);
        const f4* rp = (const f4*)(rope + (size_t)(c * 128 + n) * 32 + eg * 8);
        const f4 r0 = rp[0], r1 = rp[1], r2 = rp[2], r3 = rp[3];
        const float cs[8] = {r0.x, r0.z, r1.x, r1.z, r2.x, r2.z, r3.x, r3.z}, sn[8] = {r0.y, r0.w, r1.y, r1.w, r2.y, r2.w, r3.y, r3.w};
#pragma unroll
        for (int i = 0; i < 8; ++i) { qa[i] = x1[i] * cs[i] - x2[i] * sn[i]; qb[i] = x1[i] * sn[i] + x2[i] * cs[i]; Qs[n * 65 + eg * 8 + i] = qa[i]; Qs[n * 65 + 32 + eg * 8 + i] = qb[i]; } }
    __syncthreads();
    float acc[32];
#pragma unroll
    for (int i = 0; i < 32; ++i) acc[i] = 0.f;
#pragma unroll 2
    for (int d = 0; d < 64; ++d) { const float qd = Qs[n * 65 + d]; const LAS f4* sp = (const LAS f4*)(regB + d * 128 + eg * 32);
#pragma unroll
        for (int qq = 0; qq < 8; ++qq) { const f4 v = sp[qq]; acc[4 * qq] += qd * v.x; acc[4 * qq + 1] += qd * v.y; acc[4 * qq + 2] += qd * v.z; acc[4 * qq + 3] += qd * v.w; } }
    { const float xi = exp2f(lg2h * (float)(n + 1));
#pragma unroll
        for (int i = 0; i < 32; ++i) acc[i] *= xi; }
    __syncthreads();
    stage_rot_k(Hb, rope, regB, tok0, c * 128, C_RK + h * 64, lg2h, false, tid);
    stage_v128(Hb, vs, tok0, C_RV + h * 128, tid);
    __syncthreads();
    const int mmax = n | 15;
#pragma unroll 1
    for (int m = 0; m <= mmax; ++m) { const LAS f4* kp = (const LAS f4*)(regB + m * 64 + eg * 8); const LAS f4* kp2 = (const LAS f4*)(regB + m * 64 + 32 + eg * 8);
        const f4 k0 = kp[0], k1 = kp[1], k2 = kp2[0], k3 = kp2[1];
        float s = ((qa[0] * k0.x + qa[1] * k0.y) + (qa[2] * k0.z + qa[3] * k0.w)) + ((qa[4] * k1.x + qa[5] * k1.y) + (qa[6] * k1.z + qa[7] * k1.w))
                + ((qb[0] * k2.x + qb[1] * k2.y) + (qb[2] * k2.z + qb[3] * k2.w)) + ((qb[4] * k3.x + qb[5] * k3.y) + (qb[6] * k3.z + qb[7] * k3.w));
        s += __shfl_xor(s, 1); s += __shfl_xor(s, 2);
        const float a = (m <= n) ? s * exp2f(lg2h * (float)(n - m)) : 0.f;
        const LAS f4* vp = (const LAS f4*)(vs + m * 128 + eg * 32);
#pragma unroll
        for (int qq = 0; qq < 8; ++qq) { const f4 v = vp[qq]; acc[4 * qq] += a * v.x; acc[4 * qq + 1] += a * v.y; acc[4 * qq + 2] += a * v.z; acc[4 * qq + 3] += a * v.w; } }
    float s1 = 0.f;
#pragma unroll
    for (int i = 0; i < 32; ++i) s1 += acc[i];
    s1 += __shfl_xor(s1, 1); s1 += __shfl_xor(s1, 2);
    const float mu = s1 * (1.f / 128.f); float s2 = 0.f;
#pragma unroll
    for (int i = 0; i < 32; ++i) { const float dd = acc[i] - mu; s2 += dd * dd; }
    s2 += __shfl_xor(s2, 1); s2 += __shfl_xor(s2, 2);
    const float rstd = rsqrtf(s2 * (1.f / 128.f) + LN_EPS);
    const float* gg = P.in[2] + l * 512 + h * 128 + eg * 32; const float* gb = P.in[3] + l * 512 + h * 128 + eg * 32;
    const u4* gp = (const u4*)(Hb + (size_t)(tok0 + n) * INWP + C_RG + h * 128 + eg * 32);
    f4* yo = (f4*)((float*)(ws + WS_YMIX) + (size_t)(tok0 + n) * D + h * 128 + eg * 32);
#pragma unroll
    for (int j = 0; j < 4; ++j) { const u4 a = gp[j]; float f[8]; unpack8(a, f); float o[8];
#pragma unroll
        for (int i = 0; i < 8; ++i) { const float y = (acc[8 * j + i] - mu) * rstd * gg[8 * j + i] + gb[8 * j + i]; const float gv = f[i]; o[i] = y * gv * __builtin_amdgcn_rcpf(1.f + __expf(-gv)); }
        yo[2 * j] = mk_f4(o[0], o[1], o[2], o[3]); yo[2 * j + 1] = mk_f4(o[4], o[5], o[6], o[7]); }
    __syncthreads();
}

typedef pg8::bf16x8 bf16x8;
typedef short s16x4 __attribute__((ext_vector_type(4)));
typedef __bf16 bf16x2_t __attribute__((ext_vector_type(2)));
__device__ __forceinline__ unsigned pkbf(float a, float b) { f2 v; v.x = a; v.y = b; return __builtin_bit_cast(unsigned, __builtin_convertvector(v, bf16x2_t)); }
#define MFMA16(a, b, c) __builtin_amdgcn_mfma_f32_16x16x32_bf16((a), (b), (c), 0, 0, 0)
constexpr int NSA_KST = 72, NSA_VST = 136;
constexpr float NSA_SC = 0.125f * LOG2E;
__device__ __forceinline__ void nsa_scores(f4 (&st)[4][2], const LAS bf16* Kl, const bf16x8 (&Yq)[2][2], int lane) {
    const int r = lane & 15, kq = lane >> 4;
#pragma unroll
    for (int kt = 0; kt < 4; ++kt) { const LAS bf16* kp = Kl + (16 * kt + r) * NSA_KST + 8 * kq;
        const bf16x8 k0 = *(const LAS bf16x8*)kp, k1 = *(const LAS bf16x8*)(kp + 32);
#pragma unroll
        for (int qp = 0; qp < 2; ++qp) { f4 a = mk_f4(0.f, 0.f, 0.f, 0.f); a = MFMA16(k0, Yq[qp][0], a); a = MFMA16(k1, Yq[qp][1], a); st[kt][qp] = a; } }
}
__device__ __forceinline__ void nsa_softmax_pv(f4 (&st)[4][2], float (&m)[2], float (&l)[2], f4 (&ot)[4][2], const LAS bf16* Vt, const int (&lo)[2], const int (&hi)[2], bool need_mask, int lane) {
    const int r = lane & 15, kq = lane >> 4;
    bf16x8 Pf[2][2];
#pragma unroll
    for (int qp = 0; qp < 2; ++qp) {
        if (need_mask) {
#pragma unroll
            for (int kt = 0; kt < 4; ++kt)
#pragma unroll
                for (int i = 0; i < 4; ++i) { const int kl = 16 * kt + 4 * kq + i; if (kl < lo[qp] || kl > hi[qp]) st[kt][qp][i] = -1e30f; } }
        float mx = st[0][qp][0];
#pragma unroll
        for (int kt = 0; kt < 4; ++kt)
#pragma unroll
            for (int i = 0; i < 4; ++i) mx = fmaxf(mx, st[kt][qp][i]);
        mx = fmaxf(mx, __shfl_xor(mx, 16)); mx = fmaxf(mx, __shfl_xor(mx, 32));
        const float mn = fmaxf(m[qp], mx); const float corr = __builtin_amdgcn_exp2f((m[qp] - mn) * NSA_SC); m[qp] = mn; l[qp] *= corr;
#pragma unroll
        for (int dt = 0; dt < 4; ++dt) ot[dt][qp] *= corr;
        const float msc = mn * NSA_SC; float ps = 0.f;
#pragma unroll
        for (int kt = 0; kt < 4; ++kt)
#pragma unroll
            for (int i = 0; i < 4; ++i) { const float p = __builtin_amdgcn_exp2f(st[kt][qp][i] * NSA_SC - msc); st[kt][qp][i] = p; ps += p; }
        l[qp] += ps;
#pragma unroll
        for (int ksp = 0; ksp < 2; ++ksp) { u4 w; w.x = pkbf(st[2 * ksp][qp][0], st[2 * ksp][qp][1]); w.y = pkbf(st[2 * ksp][qp][2], st[2 * ksp][qp][3]);
            w.z = pkbf(st[2 * ksp + 1][qp][0], st[2 * ksp + 1][qp][1]); w.w = pkbf(st[2 * ksp + 1][qp][2], st[2 * ksp + 1][qp][3]); Pf[qp][ksp] = __builtin_bit_cast(bf16x8, w); }
    }
#pragma unroll
    for (int dt = 0; dt < 4; ++dt)
#pragma unroll
        for (int ksp = 0; ksp < 2; ++ksp) { const LAS bf16* vp = Vt + (16 * dt + r) * NSA_VST + 32 * ksp + 4 * kq;
            const s16x4 va = *(const LAS s16x4*)vp, vb = *(const LAS s16x4*)(vp + 16);
            const bf16x8 vf = __builtin_shufflevector(va, vb, 0, 1, 2, 3, 4, 5, 6, 7);
#pragma unroll
            for (int qp = 0; qp < 2; ++qp) ot[dt][qp] = MFMA16(vf, Pf[qp][ksp], ot[dt][qp]); }
}
__device__ __forceinline__ void nsa_accum(f4 (&tot)[4][2], const f4 (&ot)[4][2], const float (&l)[2], const float (&gate)[2]) {
#pragma unroll
    for (int qp = 0; qp < 2; ++qp) { float lt = l[qp]; lt += __shfl_xor(lt, 16); lt += __shfl_xor(lt, 32); const float sc = (lt > 0.f) ? gate[qp] / lt : 0.f;
#pragma unroll
        for (int dt = 0; dt < 4; ++dt) tot[dt][qp] += ot[dt][qp] * sc; }
}
__device__ __forceinline__ void nsa_kv_prefetch(const bf16* __restrict__ Hb, int tokbase, int colK, int colV, int tid, u4& kreg, u4& vreg) {
    kreg = *(const u4*)(Hb + (size_t)(tokbase + (tid >> 3)) * INWP + colK + (tid & 7) * 8);
    vreg = *(const u4*)(Hb + (size_t)(tokbase + (tid & 63)) * INWP + colV + (tid >> 6) * 8);
}
__device__ __forceinline__ void nsa_kv_store(LAS bf16* Kl, LAS bf16* Vt, int tid, const u4& kreg, const u4& vreg) {
    *(LAS u4*)(Kl + (tid >> 3) * NSA_KST + (tid & 7) * 8) = kreg;
    LAS bf16* vp = Vt + ((tid >> 6) * 8) * NSA_VST + (tid & 63);
    vp[0 * NSA_VST] = (bf16)(vreg.x & 0xffffu); vp[1 * NSA_VST] = (bf16)(vreg.x >> 16); vp[2 * NSA_VST] = (bf16)(vreg.y & 0xffffu); vp[3 * NSA_VST] = (bf16)(vreg.y >> 16);
    vp[4 * NSA_VST] = (bf16)(vreg.z & 0xffffu); vp[5 * NSA_VST] = (bf16)(vreg.z >> 16); vp[6 * NSA_VST] = (bf16)(vreg.w & 0xffffu); vp[7 * NSA_VST] = (bf16)(vreg.w >> 16);
}
__device__ __forceinline__ void unit_nsa(const Params& P, unsigned char* ws, int l_, LAS unsigned char* lds, int u, int tid) {
    const int b = u >> 7, g = (u >> 5) & 3, qt = u & 31;
    const bf16* Hb = (const bf16*)(ws + WS_H);
    LAS bf16* Kl = (LAS bf16*)lds;
    LAS bf16* Vt = (LAS bf16*)(lds + 18432);
    LAS float* impG = (LAS float*)(lds + 36864);
    LAS float* impE = (LAS float*)(lds + 69632);
    LAS unsigned* selm = (LAS unsigned*)(lds + 102400);
    const int lane = tid & 63, wv = __builtin_amdgcn_readfirstlane(tid >> 6), h = wv >> 1, qh = wv & 1;
    const int c = lane & 15, kq = lane >> 4;
    const int t0 = qt * 64;
    int tq[2]; size_t tok[2];
#pragma unroll
    for (int qp = 0; qp < 2; ++qp) { tq[qp] = 32 * qh + 16 * qp + c; tok[qp] = (size_t)b * T + t0 + tq[qp]; }
    bf16x8 Yq[2][2];
#pragma unroll
    for (int qp = 0; qp < 2; ++qp)
#pragma unroll
        for (int ks = 0; ks < 2; ++ks) Yq[qp][ks] = *(const bf16x8*)(Hb + tok[qp] * INWP + C_NQ + g * 256 + h * 64 + 32 * ks + 8 * kq);
    float gate[3][2];
#pragma unroll
    for (int k = 0; k < 3; ++k)
#pragma unroll
        for (int qp = 0; qp < 2; ++qp) { const float gv = bf2f(Hb[tok[qp] * INWP + C_NG + g * 12 + h * 3 + k]); gate[k][qp] = __builtin_amdgcn_rcpf(1.f + __expf(-gv)); }
    if (tid == 0) selm[64] = 0u;
    f4 tot[4][2], ot[4][2], st[4][2]; float m[2], l[2]; int lo[2], hi[2];
#pragma unroll
    for (int dt = 0; dt < 4; ++dt)
#pragma unroll
        for (int qp = 0; qp < 2; ++qp) { tot[dt][qp] = mk_f4(0.f, 0.f, 0.f, 0.f); ot[dt][qp] = mk_f4(0.f, 0.f, 0.f, 0.f); }
    int cmax[2];
#pragma unroll
    for (int qp = 0; qp < 2; ++qp) { const int t = t0 + tq[qp]; cmax[qp] = (t >= 31) ? (((t - 31) >> 4) < 126 ? ((t - 31) >> 4) : 126) : -1; }
    __syncthreads();
    { const float* KCk = (const float*)(ws + WS_KC) + (size_t)((0 * 4 + b) * 4 + g) * 8192;
        const float* KCv = (const float*)(ws + WS_KC) + (size_t)((1 * 4 + b) * 4 + g) * 8192;
        { const int key = tid >> 2, q4 = tid & 3; const f4* sp = (const f4*)(KCk + key * 64 + q4 * 16); const f4 a0 = sp[0], a1 = sp[1], a2 = sp[2], a3 = sp[3];
            u4 w0, w1; w0.x = pkbf(a0.x, a0.y); w0.y = pkbf(a0.z, a0.w); w0.z = pkbf(a1.x, a1.y); w0.w = pkbf(a1.z, a1.w); w1.x = pkbf(a2.x, a2.y); w1.y = pkbf(a2.z, a2.w); w1.z = pkbf(a3.x, a3.y); w1.w = pkbf(a3.z, a3.w);
            LAS u4* dp = (LAS u4*)(Kl + key * NSA_KST + q4 * 16); dp[0] = w0; dp[1] = w1; }
        { const int key = tid & 127, dq = tid >> 7; const f4* sp = (const f4*)(KCv + key * 64 + dq * 16); LAS bf16* vp = Vt + (dq * 16) * NSA_VST + key;
#pragma unroll
            for (int q = 0; q < 4; ++q) { const f4 a = sp[q]; vp[(4 * q) * NSA_VST] = (bf16)f2bf(a.x); vp[(4 * q + 1) * NSA_VST] = (bf16)f2bf(a.y); vp[(4 * q + 2) * NSA_VST] = (bf16)f2bf(a.z); vp[(4 * q + 3) * NSA_VST] = (bf16)f2bf(a.w); } } }
    __syncthreads();
    m[0] = m[1] = -1e4f; l[0] = l[1] = 0.f;
#pragma unroll 1
    for (int cc = 0; cc < 2; ++cc) {
        if (cc * 64 * 16 + 31 > t0 + 63) break;
#pragma unroll
        for (int qp = 0; qp < 2; ++qp) { lo[qp] = 0; hi[qp] = cmax[qp] - 64 * cc; }
        nsa_scores(st, Kl + cc * 64 * NSA_KST, Yq, lane);
        nsa_softmax_pv(st, m, l, ot, Vt + cc * 64, lo, hi, true, lane);
    }
    { const float g2[2] = {gate[0][0], gate[0][1]}; nsa_accum(tot, ot, l, g2); }
    { float invl[2], msc[2];
#pragma unroll
        for (int qp = 0; qp < 2; ++qp) { float lt = l[qp]; lt += __shfl_xor(lt, 16); lt += __shfl_xor(lt, 32); invl[qp] = (lt > 0.f) ? 1.f / lt : 0.f; msc[qp] = m[qp] * NSA_SC; }
#pragma unroll 1
        for (int cc = 0; cc < 2; ++cc) {
            nsa_scores(st, Kl + cc * 64 * NSA_KST, Yq, lane);
#pragma unroll
            for (int kt = 0; kt < 4; ++kt)
#pragma unroll
                for (int qp = 0; qp < 2; ++qp) { float p[4];
#pragma unroll
                    for (int i = 0; i < 4; ++i) { const int ci = 64 * cc + 16 * kt + 4 * kq + i; p[i] = (ci <= cmax[qp]) ? __builtin_amdgcn_exp2f(st[kt][qp][i] * NSA_SC - msc[qp]) * invl[qp] : 0.f; }
                    const int j = 16 * cc + 4 * kt + kq;
                    impG[(h * 32 + j) * 64 + tq[qp]] = (p[0] + p[1]) + (p[2] + p[3]);
                    if (j < 31) impE[(h * 32 + j + 1) * 64 + tq[qp]] = p[3]; }
        } }
    __syncthreads();
    if (tid < 64) { const int tqs = tid; float tv[8]; int ti[8];
#pragma unroll
        for (int k = 0; k < 8; ++k) { tv[k] = -3e38f; ti[k] = 0; }
#pragma unroll 1
        for (int j = 0; j < 32; ++j) { float v;
            if (j <= qt) { const bool forced = (j == 0) || (j == qt) || (j == qt - 1);
                float s4 = (impG[(0 * 32 + j) * 64 + tqs] + impG[(1 * 32 + j) * 64 + tqs]) + (impG[(2 * 32 + j) * 64 + tqs] + impG[(3 * 32 + j) * 64 + tqs]);
                if (j > 0) s4 += (impE[(0 * 32 + j) * 64 + tqs] + impE[(1 * 32 + j) * 64 + tqs]) + (impE[(2 * 32 + j) * 64 + tqs] + impE[(3 * 32 + j) * 64 + tqs]);
                v = forced ? 1e6f : s4; }
            else v = -1e9f;
            int vi = j;
#pragma unroll
            for (int k = 0; k < 8; ++k) { const bool gt = v > tv[k]; const float nv = gt ? tv[k] : v; const int ni = gt ? ti[k] : vi; tv[k] = gt ? v : tv[k]; ti[k] = gt ? vi : ti[k]; v = nv; vi = ni; } }
        unsigned msk = 0u;
#pragma unroll
        for (int k = 0; k < 8; ++k) if (ti[k] <= qt) msk |= (1u << ti[k]);
        selm[tqs] = msk; atomicOr((unsigned*)&selm[64], msk); }
    __syncthreads();
    unsigned mymask[2];
#pragma unroll
    for (int qp = 0; qp < 2; ++qp) mymask[qp] = selm[tq[qp]];
    const unsigned umask = selm[64];
#pragma unroll
    for (int dt = 0; dt < 4; ++dt)
#pragma unroll
        for (int qp = 0; qp < 2; ++qp) ot[dt][qp] = mk_f4(0.f, 0.f, 0.f, 0.f);
    m[0] = m[1] = -1e4f; l[0] = l[1] = 0.f;
    { u4 kreg, vreg; unsigned rem = umask;
        int j = __builtin_ctz(rem); rem &= rem - 1u;
        nsa_kv_prefetch(Hb, b * T + 64 * j, C_KS + g * 64, C_VS + g * 64, tid, kreg, vreg);
#pragma unroll 1
        for (;;) {
            __syncthreads();
            nsa_kv_store(Kl, Vt, tid, kreg, vreg);
            __syncthreads();
            const int jc = j; const bool more = (rem != 0u);
            if (more) { j = __builtin_ctz(rem); rem &= rem - 1u; nsa_kv_prefetch(Hb, b * T + 64 * j, C_KS + g * 64, C_VS + g * 64, tid, kreg, vreg); }
            bool anyv = false, full = true;
#pragma unroll
            for (int qp = 0; qp < 2; ++qp) { const bool sel = (mymask[qp] >> jc) & 1u; lo[qp] = sel ? 0 : 64; hi[qp] = sel ? ((jc == qt) ? tq[qp] : 63) : -1; anyv |= sel; full &= (sel && jc != qt); }
            if (__builtin_amdgcn_ballot_w64(anyv) != 0ull) {
                const bool need_mask = __builtin_amdgcn_ballot_w64(!full) != 0ull;
                nsa_scores(st, Kl, Yq, lane);
                nsa_softmax_pv(st, m, l, ot, Vt, lo, hi, need_mask, lane); }
            if (!more) break;
        } }
    { const float g2[2] = {gate[1][0], gate[1][1]}; nsa_accum(tot, ot, l, g2); }
#pragma unroll
    for (int dt = 0; dt < 4; ++dt)
#pragma unroll
        for (int qp = 0; qp < 2; ++qp) ot[dt][qp] = mk_f4(0.f, 0.f, 0.f, 0.f);
    m[0] = m[1] = -1e4f; l[0] = l[1] = 0.f;
    { u4 kreg, vreg; int jw = (qt >= 8 ? qt - 8 : 0);
        nsa_kv_prefetch(Hb, b * T + 64 * jw, C_KW + g * 64, C_VW + g * 64, tid, kreg, vreg);
#pragma unroll 1
        for (;;) {
            __syncthreads();
            nsa_kv_store(Kl, Vt, tid, kreg, vreg);
            __syncthreads();
            const int jc = jw; const bool more = (jw < qt);
            if (more) { ++jw; nsa_kv_prefetch(Hb, b * T + 64 * jw, C_KW + g * 64, C_VW + g * 64, tid, kreg, vreg); }
#pragma unroll
            for (int qp = 0; qp < 2; ++qp) { lo[qp] = (jc == qt - 8) ? tq[qp] + 1 : 0; hi[qp] = (jc == qt) ? tq[qp] : 63; }
            const bool need_mask = (jc == qt) || (jc == qt - 8);
            nsa_scores(st, Kl, Yq, lane);
            nsa_softmax_pv(st, m, l, ot, Vt, lo, hi, need_mask, lane);
            if (!more) break;
        } }
    { const float g2[2] = {gate[2][0], gate[2][1]}; nsa_accum(tot, ot, l, g2); }
    float* ymix = (float*)(ws + WS_YMIX);
#pragma unroll
    for (int qp = 0; qp < 2; ++qp)
#pragma unroll
        for (int dt = 0; dt < 4; ++dt) *(f4*)(ymix + tok[qp] * D + 1024 + g * 256 + h * 64 + 16 * dt + 4 * kq) = tot[dt][qp];
    __syncthreads();
}

__device__ __forceinline__ bf16x8 cmp_afrag(const bf16* __restrict__ p, const float* __restrict__ pe) {
    const u4 a = *(const u4*)p; float f[8]; unpack8(a, f);
    const f4 p0 = *(const f4*)pe, p1 = *(const f4*)(pe + 4);
    u4 w; w.x = pkbf(f[0] + p0.x, f[1] + p0.y); w.y = pkbf(f[2] + p0.z, f[3] + p0.w); w.z = pkbf(f[4] + p1.x, f[5] + p1.y); w.w = pkbf(f[6] + p1.z, f[7] + p1.w);
    return __builtin_bit_cast(bf16x8, w);
}
__device__ __forceinline__ void unit_compress_mfma(const Params& P, unsigned char* ws, int l, LAS unsigned char* lds, int u, int tid) {
    const int kv = u >> 6, b = (u >> 4) & 3, g = (u >> 2) & 3, r4 = u & 3, i0 = 32 * r4;
    const bf16* Hb = (const bf16*)(ws + WS_H);
    const bf16* W1T = (const bf16*)(ws + WS_W1T) + (size_t)(l * 2 + kv) * 256 * 2048;
    const bf16* W2T = (const bf16*)(ws + WS_W2T) + (size_t)(l * 2 + kv) * 64 * 256;
    const float* pe = P.in[kv ? 11 : 8] + (size_t)l * 2048;
    LAS bf16* hidL = (LAS bf16*)lds;
    const int lane = tid & 63, wv = __builtin_amdgcn_readfirstlane(tid >> 6), c = lane & 15, kq = lane >> 4;
    const int col0 = (kv ? C_VC : C_KC) + g * 64;
    int tb[2];
#pragma unroll
    for (int rt = 0; rt < 2; ++rt) tb[rt] = 16 * (i0 + 16 * rt + c);
    f4 acc[2][2];
#pragma unroll
    for (int nt = 0; nt < 2; ++nt)
#pragma unroll
        for (int rt = 0; rt < 2; ++rt) acc[nt][rt] = mk_f4(0.f, 0.f, 0.f, 0.f);
    const bf16* wrow[2];
#pragma unroll
    for (int nt = 0; nt < 2; ++nt) wrow[nt] = W1T + (size_t)(32 * wv + 16 * nt + c) * 2048 + 8 * kq;
#pragma unroll 2
    for (int pos = 0; pos < 32; ++pos) {
        bf16x8 xf[2][2], yf[2][2];
#pragma unroll
        for (int nt = 0; nt < 2; ++nt)
#pragma unroll
            for (int ks = 0; ks < 2; ++ks) xf[nt][ks] = *(const bf16x8*)(wrow[nt] + pos * 64 + 32 * ks);
#pragma unroll
        for (int rt = 0; rt < 2; ++rt) { int t = tb[rt] + pos; t = t < T ? t : T - 1;
            const bf16* ap = Hb + (size_t)(b * T + t) * INWP + col0 + 8 * kq;
#pragma unroll
            for (int ks = 0; ks < 2; ++ks) yf[rt][ks] = cmp_afrag(ap + 32 * ks, pe + pos * 64 + 32 * ks + 8 * kq); }
#pragma unroll
        for (int nt = 0; nt < 2; ++nt)
#pragma unroll
            for (int rt = 0; rt < 2; ++rt)
#pragma unroll
                for (int ks = 0; ks < 2; ++ks) acc[nt][rt] = MFMA16(xf[nt][ks], yf[rt][ks], acc[nt][rt]);
    }
#pragma unroll
    for (int nt = 0; nt < 2; ++nt)
#pragma unroll
        for (int rt = 0; rt < 2; ++rt) { const f4 a = acc[nt][rt]; u2 w; w.x = pkbf(gelu_tanh(a.x), gelu_tanh(a.y)); w.y = pkbf(gelu_tanh(a.z), gelu_tanh(a.w));
            *(LAS u2*)(hidL + (16 * rt + c) * 264 + 32 * wv + 16 * nt + 4 * kq) = w; }
    __syncthreads();
    { const int ot = wv & 3, rt = wv >> 2; f4 o = mk_f4(0.f, 0.f, 0.f, 0.f);
        const bf16* w2p = W2T + (size_t)(16 * ot + c) * 256 + 8 * kq; const LAS bf16* hp = hidL + (16 * rt + c) * 264 + 8 * kq;
#pragma unroll
        for (int ks = 0; ks < 8; ++ks) { const bf16x8 xw = *(const bf16x8*)(w2p + 32 * ks); const bf16x8 yh = *(const LAS bf16x8*)(hp + 32 * ks); o = MFMA16(xw, yh, o); }
        const int ci = i0 + 16 * rt + c;
        if (ci <= 126) *(f4*)((float*)(ws + WS_KC) + ((size_t)((kv * 4 + b) * 4 + g) * 128 + ci) * 64 + 16 * ot + 4 * kq) = o; }
    __syncthreads();
}

__device__ __forceinline__ void row_mixnorm(const Params& P, unsigned char* ws, int l, int rowi, int lane) {
    const f4* yp = (const f4*)((const float*)(ws + WS_YMIX) + (size_t)rowi * D) + lane;
    const f4* gp = (const f4*)(P.in[14] + (size_t)l * D) + lane;
    f4 v[8]; float ss[8];
#pragma unroll
    for (int j = 0; j < 8; ++j) { v[j] = yp[64 * j]; ss[j] = v[j].x * v[j].x + v[j].y * v[j].y + v[j].z * v[j].z + v[j].w * v[j].w; }
    const float r0 = rsqrtf(wave_sum(ss[0] + ss[1]) * (1.f / 512.f) + LN_EPS);
    const float r1 = rsqrtf(wave_sum(ss[2] + ss[3]) * (1.f / 512.f) + LN_EPS);
    const float r2 = rsqrtf(wave_sum((ss[4] + ss[5]) + (ss[6] + ss[7])) * (1.f / 1024.f) + LN_EPS);
    u2* op = (u2*)((bf16*)(ws + WS_MIXED) + (size_t)rowi * D) + lane;
#pragma unroll
    for (int j = 0; j < 8; ++j) { const float r = (j < 2) ? r0 : ((j < 4) ? r1 : r2); const f4 g4 = gp[64 * j];
        op[64 * j] = mk_u2(pk2(v[j].x * r * g4.x, v[j].y * r * g4.y), pk2(v[j].z * r * g4.z, v[j].w * r * g4.w)); }
}
__device__ __forceinline__ void row_ln(const float* __restrict__ zin, const float* __restrict__ gam, const float* __restrict__ bet, float* __restrict__ of32, bf16* __restrict__ obf, int rowi, int lane) {
    const f4* zp = (const f4*)(zin + (size_t)rowi * D) + lane;
    f4 v[8]; float s = 0.f;
#pragma unroll
    for (int j = 0; j < 8; ++j) { v[j] = zp[64 * j]; s += (v[j].x + v[j].y) + (v[j].z + v[j].w); }
    const float mu = wave_sum(s) * (1.f / D); float s2 = 0.f;
#pragma unroll
    for (int j = 0; j < 8; ++j) { v[j].x -= mu; v[j].y -= mu; v[j].z -= mu; v[j].w -= mu; s2 += (v[j].x * v[j].x + v[j].y * v[j].y) + (v[j].z * v[j].z + v[j].w * v[j].w); }
    const float rstd = rsqrtf(wave_sum(s2) * (1.f / D) + LN_EPS);
    f4* o4 = (f4*)(of32 + (size_t)rowi * D) + lane; u2* o2 = (u2*)(obf + (size_t)rowi * D) + lane;
    const f4* gp = (const f4*)gam + lane; const f4* bp = (const f4*)bet + lane;
#pragma unroll
    for (int j = 0; j < 8; ++j) { const f4 g4 = gp[64 * j], b4 = bp[64 * j];
        const f4 o = mk_f4(v[j].x * rstd * g4.x + b4.x, v[j].y * rstd * g4.y + b4.y, v[j].z * rstd * g4.z + b4.z, v[j].w * rstd * g4.w + b4.w);
        o4[64 * j] = o; o2[64 * j] = mk_u2(pk2(o.x, o.y), pk2(o.z, o.w)); }
}

__device__ __forceinline__ float dot8_bf16(const u4& w, const float* x) {
    float f[8]; unpack8(w, f);
    return ((f[0] * x[0] + f[1] * x[1]) + (f[2] * x[2] + f[3] * x[3])) + ((f[4] * x[4] + f[5] * x[5]) + (f[6] * x[6] + f[7] * x[7]));
}
__device__ __forceinline__ void peer_load4(u4 (&R)[4][2], const unsigned char* __restrict__ TAB, const LAS int* pe, int grp, int lane) {
#pragma unroll
    for (int k = 0; k < 4; ++k) { const int e = __builtin_amdgcn_readfirstlane(pe[grp * 4 + k]); const u4* p = (const u4*)(TAB + (size_t)e * 2048) + lane; R[k][0] = p[0]; R[k][1] = p[64]; }
}
__device__ __forceinline__ float dot16_fp8(const u4& w, const float* x) {
    float s = 0.f;
#pragma unroll
    for (int q = 0; q < 4; ++q) { const f2 lo = __builtin_amdgcn_cvt_pk_f32_fp8((int)w[q], false), hi = __builtin_amdgcn_cvt_pk_f32_fp8((int)w[q], true);
        s += (lo.x * x[4 * q] + lo.y * x[4 * q + 1]) + (hi.x * x[4 * q + 2] + hi.y * x[4 * q + 3]); }
    return s;
}
__device__ __forceinline__ void peer_dot4(const u4 (&R)[4][2], const float (&xr)[32], const float* __restrict__ USC, const LAS int* pe, const LAS float* pw, const float* __restrict__ VSC, LAS float* hwp, int grp, int lane) {
    float d[4];
#pragma unroll
    for (int k = 0; k < 4; ++k) d[k] = dot16_fp8(R[k][0], xr) + dot16_fp8(R[k][1], xr + 16);
#pragma unroll
    for (int o = 1; o < 64; o <<= 1) {
#pragma unroll
        for (int k = 0; k < 4; ++k) d[k] += __shfl_xor(d[k], o); }
#pragma unroll
    for (int k = 0; k < 4; ++k) { const int e = __builtin_amdgcn_readfirstlane(pe[grp * 4 + k]);
        const float hv = pw[grp * 4 + k] * gelu_tanh(d[k] * USC[e]) * VSC[e];
        if (lane == 0) hwp[grp * 4 + k] = hv; }
}
__device__ __forceinline__ void peer_axpy4(const u4 (&R)[4][2], float (&acc)[32], const LAS float* hwp, int grp) {
#pragma unroll
    for (int k = 0; k < 4; ++k) { const float hw = hwp[grp * 4 + k];
#pragma unroll
        for (int j = 0; j < 2; ++j)
#pragma unroll
            for (int q = 0; q < 4; ++q) { const f2 lo = __builtin_amdgcn_cvt_pk_f32_fp8((int)R[k][j][q], false), hi = __builtin_amdgcn_cvt_pk_f32_fp8((int)R[k][j][q], true);
                acc[16 * j + 4 * q] += hw * lo.x; acc[16 * j + 4 * q + 1] += hw * lo.y; acc[16 * j + 4 * q + 2] += hw * hi.x; acc[16 * j + 4 * q + 3] += hw * hi.y; } }
}
__device__ __forceinline__ void unit_peer(const Params& P, unsigned char* ws, int l, LAS unsigned char* lds, int u, int tid_in, int lane_in, int wave, float* __restrict__ xout) {
    int tid = tid_in; asm volatile("" : "+v"(tid)); int lane = tid & 63;
    const int n0 = u * 32;
    const float* QP = (const float*)(ws + WS_QP); float* SC = (float*)(ws + WS_SC);
    LAS float* keys = (LAS float*)lds;
    LAS float* qs = (LAS float*)(lds + 67584);
    #pragma unroll 1
    for (int hh = 0; hh < 16; ++hh) { const int h = hh >> 1, half = hh & 1;
        const float* kg = P.in[half ? 20 : 19] + ((size_t)l * 8 + h) * 16384;
        __syncthreads();
#pragma unroll
        for (int i = 0; i < 8; ++i) { const int idx = tid + 512 * i; const int k = idx >> 5, d4 = idx & 31; *(LAS f4*)(keys + k * 132 + d4 * 4) = ((const f4*)kg)[idx]; }
#pragma unroll
        for (int i = 0; i < 2; ++i) { const int idx = tid + 512 * i; const int tk = idx >> 5, d4 = idx & 31; *(LAS f4*)(qs + tk * 128 + d4 * 4) = *(const f4*)(QP + (size_t)(n0 + tk) * D + h * 256 + half * 128 + d4 * 4); }
        __syncthreads();
        const int k = tid & 127, tg = tid >> 7;
        float a[8];
#pragma unroll
        for (int i = 0; i < 8; ++i) a[i] = 0.f;
        #pragma unroll 1
    for (int d4 = 0; d4 < 32; ++d4) { const f4 kv = *(const LAS f4*)(keys + k * 132 + d4 * 4);
#pragma unroll
            for (int i = 0; i < 8; ++i) { const f4 q4 = *(const LAS f4*)(qs + (tg * 8 + i) * 128 + d4 * 4); a[i] += kv.x * q4.x + kv.y * q4.y + kv.z * q4.z + kv.w * q4.w; } }
#pragma unroll
        for (int i = 0; i < 8; ++i) SC[((size_t)(n0 + tg * 8 + i) * 16 + hh) * 128 + k] = a[i];
    }
    VM_WAIT();
    __syncthreads();
    tid = tid_in; asm volatile("" : "+v"(tid)); lane = tid & 63;
    LAS float* TV = (LAS float*)lds;
    LAS int* TI = (LAS int*)(lds + 34816);
    { const int tk = tid >> 4, hh = tid & 15;
        const f4* sp = (const f4*)(SC + ((size_t)(n0 + tk) * 16 + hh) * 128);
        float tv[16]; int ti[16];
#pragma unroll
        for (int k = 0; k < 16; ++k) { tv[k] = -3e38f; ti[k] = 0; }
        #pragma unroll 1
    for (int c4 = 0; c4 < 32; ++c4) { const f4 s4 = sp[c4]; const float sv[4] = {s4.x, s4.y, s4.z, s4.w};
#pragma unroll
            for (int e = 0; e < 4; ++e) { float v = sv[e]; int vi = c4 * 4 + e;
#pragma unroll
                for (int k = 0; k < 16; ++k) { const bool gt = v > tv[k]; const float nv = gt ? tv[k] : v; const int ni = gt ? ti[k] : vi; tv[k] = gt ? v : tv[k]; ti[k] = gt ? vi : ti[k]; v = nv; vi = ni; } } }
#pragma unroll
        for (int k = 0; k < 16; ++k) { TV[tid * 17 + k] = tv[k]; TI[tid * 17 + k] = ti[k]; } }
    __syncthreads();
    tid = tid_in; asm volatile("" : "+v"(tid)); lane = tid & 63;
    LAS int* PE = (LAS int*)(lds + 69632);
    LAS float* PW = (LAS float*)(lds + 86016);
    if (tid < 256) { const int tk = tid >> 3, h = tid & 7; const int r1 = tk * 16 + 2 * h, r2 = r1 + 1;
        float v1[16], v2[16]; int i1[16], i2[16];
#pragma unroll
        for (int k = 0; k < 16; ++k) { v1[k] = TV[r1 * 17 + k]; i1[k] = TI[r1 * 17 + k]; v2[k] = TV[r2 * 17 + k]; i2[k] = TI[r2 * 17 + k]; }
        float tv[16]; int te[16];
#pragma unroll
        for (int k = 0; k < 16; ++k) { tv[k] = -3e38f; te[k] = 0; }
#pragma unroll
        for (int a = 0; a < 16; ++a)
#pragma unroll
            for (int bq = 0; bq < 16; ++bq) if ((a + 1) * (bq + 1) <= 16) { float v = v1[a] + v2[bq]; int ve = i1[a] * 128 + i2[bq];
#pragma unroll
                for (int k = 0; k < 16; ++k) { const bool gt = v > tv[k]; const float nv = gt ? tv[k] : v; const int ni = gt ? te[k] : ve; tv[k] = gt ? v : tv[k]; te[k] = gt ? ve : te[k]; v = nv; ve = ni; } }
        float wsum = 0.f; float w[16];
#pragma unroll
        for (int k = 0; k < 16; ++k) { w[k] = __expf(tv[k] - tv[0]); wsum += w[k]; }
        const float inv = 1.f / wsum;
#pragma unroll
        for (int k = 0; k < 16; ++k) { PE[tk * 128 + h * 16 + k] = te[k]; PW[tk * 128 + h * 16 + k] = w[k] * inv; } }
    __syncthreads();
    tid = tid_in; asm volatile("" : "+v"(tid)); lane = tid & 63;
    LAS float* HW = (LAS float*)(lds + 102400);
    const unsigned char* PU = ws + WS_PU + (size_t)l * 16384 * 2048; const unsigned char* PV = ws + WS_PV + (size_t)l * 16384 * 2048;
    const float* USC = (const float*)(ws + WS_PSC) + (size_t)l * 16384; const float* VSC = (const float*)(ws + WS_PSC) + (size_t)(DEPTH + l) * 16384;
    const float* X1 = (const float*)(ws + WS_X1);
    #pragma unroll 1
    for (int it = 0; it < 4; ++it) { const int tk = wave * 4 + it; const size_t n = (size_t)n0 + tk;
        float xr[32];
#pragma unroll
        for (int j = 0; j < 2; ++j)
#pragma unroll
            for (int q = 0; q < 4; ++q) { const f4 a = *(const f4*)(X1 + n * D + 1024 * j + 16 * lane + 4 * q); xr[16 * j + 4 * q] = a.x; xr[16 * j + 4 * q + 1] = a.y; xr[16 * j + 4 * q + 2] = a.z; xr[16 * j + 4 * q + 3] = a.w; }
        const LAS int* pe = PE + tk * 128; const LAS float* pw = PW + tk * 128; LAS float* hwp = HW + tk * 128;
        { u4 A[4][2], B[4][2];
            peer_load4(A, PU, pe, 0, lane);
#pragma unroll 1
            for (int g2 = 0; g2 < 16; ++g2) {
                peer_load4(B, PU, pe, 2 * g2 + 1, lane);
                peer_dot4(A, xr, USC, pe, pw, VSC, hwp, 2 * g2, lane);
                if (g2 < 15) peer_load4(A, PU, pe, 2 * g2 + 2, lane);
                peer_dot4(B, xr, USC, pe, pw, VSC, hwp, 2 * g2 + 1, lane);
            } }
        LDS_WAIT();
        float acc[32];
#pragma unroll
        for (int i = 0; i < 32; ++i) acc[i] = 0.f;
        { u4 A[4][2], B[4][2];
            peer_load4(A, PV, pe, 0, lane);
#pragma unroll 1
            for (int g2 = 0; g2 < 16; ++g2) {
                peer_load4(B, PV, pe, 2 * g2 + 1, lane);
                peer_axpy4(A, acc, hwp, 2 * g2);
                if (g2 < 15) peer_load4(A, PV, pe, 2 * g2 + 2, lane);
                peer_axpy4(B, acc, hwp, 2 * g2 + 1);
            } }
        float s = 0.f;
#pragma unroll
        for (int i = 0; i < 32; ++i) { acc[i] += ALPHA * xr[i]; s += acc[i]; }
        const float mu = wave_sum(s) * (1.f / D); float s2 = 0.f;
#pragma unroll
        for (int i = 0; i < 32; ++i) { acc[i] -= mu; s2 += acc[i] * acc[i]; }
        const float rstd = rsqrtf(wave_sum(s2) * (1.f / D) + LN_EPS);
        const float* gam = P.in[23] + (size_t)l * D; const float* bet = P.in[24] + (size_t)l * D;
        bf16* xb = (bf16*)(ws + WS_XB);
#pragma unroll
        for (int j = 0; j < 2; ++j) { const int col = 1024 * j + 16 * lane; float o[16];
#pragma unroll
            for (int q = 0; q < 4; ++q) { const f4 g4 = *(const f4*)(gam + col + 4 * q), b4 = *(const f4*)(bet + col + 4 * q);
                o[4 * q] = acc[16 * j + 4 * q] * rstd * g4.x + b4.x; o[4 * q + 1] = acc[16 * j + 4 * q + 1] * rstd * g4.y + b4.y; o[4 * q + 2] = acc[16 * j + 4 * q + 2] * rstd * g4.z + b4.z; o[4 * q + 3] = acc[16 * j + 4 * q + 3] * rstd * g4.w + b4.w;
                *(f4*)(xout + n * D + col + 4 * q) = mk_f4(o[4 * q], o[4 * q + 1], o[4 * q + 2], o[4 * q + 3]); }
            u4 p0, p1; p0.x = pk2(o[0], o[1]); p0.y = pk2(o[2], o[3]); p0.z = pk2(o[4], o[5]); p0.w = pk2(o[6], o[7]); p1.x = pk2(o[8], o[9]); p1.y = pk2(o[10], o[11]); p1.z = pk2(o[12], o[13]); p1.w = pk2(o[14], o[15]);
            *(u4*)(xb + n * D + col) = p0; *(u4*)(xb + n * D + col + 8) = p1; }
    }
    __syncthreads();
}

template <class T> __device__ __forceinline__ T* uniform_ptr(T* p) { const unsigned long long v = (unsigned long long)p; const unsigned lo = __builtin_amdgcn_readfirstlane((unsigned)v), hi = __builtin_amdgcn_readfirstlane((unsigned)(v >> 32)); return (T*)(((unsigned long long)hi << 32) | lo); }
constexpr int PH_PER_LAYER = 8, N_PHASES = 1 + DEPTH * PH_PER_LAYER;
#ifndef ONLY_PHASE
#define ONLY_PHASE -1
#endif
#define EN(i) (ONLY_PHASE < 0 || ONLY_PHASE == (i))
#ifndef PROBE_DUP
#define PROBE_DUP -1
#endif
#define REP(i) for (int rep_ = 0; rep_ < ((PROBE_DUP == (i)) ? 2 : 1); ++rep_)
__global__ void __launch_bounds__(512, 2) mk_fwd(Params P) {
    extern __shared__ __attribute__((aligned(16))) unsigned char lds_raw[];
    LAS unsigned char* lds = (LAS unsigned char*)lds_raw;
    volatile LAS unsigned* MISC = (volatile LAS unsigned*)(lds + MISC_OFF);
    const int tid = threadIdx.x, lane = tid & 63, wave = __builtin_amdgcn_readfirstlane(tid >> 6);
    const int G = gridDim.x, bid = blockIdx.x;
    if (tid < 64) MISC[tid] = 0u;
    __syncthreads();
    unsigned char* const ws = uniform_ptr(P.ws);
    unsigned* ctl = (unsigned*)(ws + WS_CTL);
    const XcdBarrier bar = xcd_barrier_post(ctl + CW_BAR, MISC + 8);
    const int lo = P.ph_lo, hi = P.ph_hi;
#define IN(k) (lo <= (k) && (k) < hi)
#define LAUNDER() int tl = (wave << 6) | (int)__builtin_amdgcn_mbcnt_hi(0xffffffffu, __builtin_amdgcn_mbcnt_lo(0xffffffffu, 0u)); asm volatile("" : "+v"(tl)); const int ll = tl & 63; const int wl = __builtin_amdgcn_readfirstlane(tl >> 6); (void)ll; (void)wl
#define SEAM(k) do { if (IN((k) + 1)) xcd_barrier(bar); } while (0)
    if (IN(0) && EN(8)) { LAUNDER(); phase_prologue(P, ws, lds, tl, ll, wl); SEAM(0); }
    for (int l = 0; l < DEPTH; ++l) {
        const int pb = 1 + l * PH_PER_LAYER;
        const float* xres = (l == 0) ? P.in[0] : (const float*)(ws + WS_XC);
        float* xout = (l == DEPTH - 1) ? P.out : (float*)(ws + WS_XC);
        if (IN(pb + 0) && EN(0)) { LAUNDER();
            pg8::Gemm g{(const pg8::bf16_t*)(ws + WS_XB), (const pg8::bf16_t*)(ws + WS_WIN) + (size_t)l * INWP * D, NTOK, INWP, D};
            pg8::StaticOrder S; S.init(NTOK, INWP, G, bid);
            pg8::EpiH E{(pg8::bf16_t*)(ws + WS_H), INWP, 6, 10};
            pg8::gemm_phase<pg8::EpiH, pg8::StaticOrder, true, true>(lds, g, S, E, tl);
            SEAM(pb + 0);
        }
        if (IN(pb + 1) && EN(1)) { LAUNDER();
            REP(1) for (int u = bid; u < 240; u += G) unit_kvstate(P, ws, lds, u, tl);
            REP(1) for (int u = bid; u < 256; u += G) unit_sgu(P, ws, l, lds, u, tl, ll, wl);
            REP(1) for (int u = bid; u < 128; u += G) unit_compress_mfma(P, ws, l, lds, u, tl);
            SEAM(pb + 1);
        }
        if (IN(pb + 2) && EN(2)) { LAUNDER();
            REP(2) for (int u = bid; u < 256; u += G) unit_retention(P, ws, l, lds, u, tl);
            REP(2) for (int u = bid; u < 512; u += G) unit_nsa(P, ws, l, lds, u, tl);
            SEAM(pb + 2);
        }
        if (IN(pb + 3) && EN(3)) { LAUNDER();
            for (int r = bid * 8 + wl; r < NTOK; r += G * 8) row_mixnorm(P, ws, l, r, ll);
            SEAM(pb + 3);
        }
        if (IN(pb + 4) && EN(4)) { LAUNDER();
            pg8::Gemm g{(const pg8::bf16_t*)(ws + WS_MIXED), (const pg8::bf16_t*)(ws + WS_WOUT) + (size_t)l * D * D, NTOK, D, D};
            pg8::StaticOrder S; S.init(NTOK, D, G, bid);
            pg8::EpiRes E{(float*)(ws + WS_Z), xres, D, ALPHA};
            pg8::gemm_phase<pg8::EpiRes, pg8::StaticOrder, true, true>(lds, g, S, E, tl);
            SEAM(pb + 4);
        }
        if (IN(pb + 5) && EN(5)) { LAUNDER();
            for (int r = bid * 8 + wl; r < NTOK; r += G * 8) row_ln((const float*)(ws + WS_Z), P.in[16] + (size_t)l * D, P.in[17] + (size_t)l * D, (float*)(ws + WS_X1), (bf16*)(ws + WS_X1B), r, ll);
            SEAM(pb + 5);
        }
        if (IN(pb + 6) && EN(6)) { LAUNDER();
            pg8::Gemm g{(const pg8::bf16_t*)(ws + WS_X1B), (const pg8::bf16_t*)(ws + WS_WQ) + (size_t)l * D * D, NTOK, D, D};
            pg8::StaticOrder S; S.init(NTOK, D, G, bid);
            pg8::EpiF32 E{(float*)(ws + WS_QP), D};
            pg8::gemm_phase<pg8::EpiF32, pg8::StaticOrder, true, true>(lds, g, S, E, tl);
            SEAM(pb + 6);
        }
        if (IN(pb + 7) && EN(7)) { LAUNDER();
            REP(7) for (int u = bid; u < NTOK / 32; u += G) unit_peer(P, ws, l, lds, u, tl, ll, wl, xout);
            SEAM(pb + 7);
        }
    }
#undef IN
#undef SEAM
}

#ifndef MK_ONE_LAUNCH
#define MK_ONE_LAUNCH 1
#endif
extern "C" void kernel_launch(void* const* d_in, const int* in_sizes, int n_in, void* d_out, int out_size, void* d_ws, size_t ws_size, hipStream_t stream) {
    static int grid = 0;
    if (grid == 0) {
        if (n_in != 25 || out_size != NTOK * D || ws_size < WS_END) { fprintf(stderr, "kernel_launch: unexpected shapes: n_in %d out %d ws %zu (need %zu)\n", n_in, out_size, ws_size, (size_t)WS_END); grid = -1; return; }
        int dev = 0, cus = 0, per_cu = 0;
        if (hipGetDevice(&dev) != hipSuccess || hipDeviceGetAttribute(&cus, hipDeviceAttributeMultiprocessorCount, dev) != hipSuccess) { grid = -1; return; }
        if (hipFuncSetAttribute((const void*)mk_fwd, hipFuncAttributeMaxDynamicSharedMemorySize, LDS_BYTES) != hipSuccess) { fprintf(stderr, "kernel_launch: hipFuncSetAttribute failed\n"); grid = -1; return; }
        if (hipOccupancyMaxActiveBlocksPerMultiprocessor(&per_cu, (const void*)mk_fwd, 512, LDS_BYTES) != hipSuccess || per_cu < 1) fprintf(stderr, "kernel_launch: occupancy query says %d\n", per_cu);
        (void)hipGetLastError();
        grid = cus;
    }
    if (grid < 0) return;
    (void)hipMemsetAsync((char*)d_ws + WS_CTL, 0, CTL_ZERO_BYTES, stream);
    Params p{};
    for (int i = 0; i < 25; ++i) p.in[i] = (const float*)d_in[i];
    p.out = (float*)d_out; p.ws = (unsigned char*)d_ws;
    for (int i = 0; i < 32; ++i) p.inv_rev[i] = pow(10000.0, -(double)i / 32.0) / (2.0 * 3.14159265358979323846);
    for (int h = 0; h < 4; ++h) p.lg2[h] = (float)log2(1.0 - pow(2.0, -5.0 - (double)h));
#if MK_ONE_LAUNCH
    p.ph_lo = 0; p.ph_hi = N_PHASES; p.use_bar = 1;
    hipLaunchKernelGGL(mk_fwd, dim3(grid), dim3(512), LDS_BYTES, stream, p);
#else
    for (int k = 0; k < N_PHASES; ++k) { p.ph_lo = k; p.ph_hi = k + 1; p.use_bar = 0;
        hipLaunchKernelGGL(mk_fwd, dim3(grid), dim3(512), LDS_BYTES, stream, p); }
#endif
}
```

```cpp
#include <hip/hip_runtime.h>
#include <cstdio>
#include <cstdint>
#include <cmath>
#define LAS __attribute__((address_space(3)))
namespace pg8 {
#define PG8_LAS __attribute__((address_space(3)))
typedef unsigned short bf16_t;
typedef short bf16x8 __attribute__((ext_vector_type(8)));
typedef float f32x4 __attribute__((ext_vector_type(4)));
typedef unsigned u32x4 __attribute__((ext_vector_type(4)));
constexpr int BM = 256, BK = 64, HALF = 128, HTB = HALF * BK * 2  , STAGE_BYTES = 8 * HTB, NXCD = 8, WGM = 8;

__host__ __device__ __forceinline__ int lds_byte(int r, int c) { const int st = (r >> 4) * 2 + (c >> 5), rr = r & 15, cc = c & 31, ob = rr * 64 + cc * 2; return st * 1024 + (ob ^ (((ob >> 9) & 1) << 5)); }
__host__ __device__ __forceinline__ void stage_rc(int b, int& R, int& C) { const int st = b / 1024, sb = b % 1024, swz = sb ^ (((sb >> 9) & 1) << 5); R = (st >> 1) * 16 + swz / 64; C = (st & 1) * 32 + (swz % 64) / 2; }
__host__ __device__ __forceinline__ int perm32(int rho) { const int n = rho >> 4, i = rho & 15; return 8 * (i >> 2) + 4 * n + (i & 3); }

struct Unit { int pm, pn; };
struct Gemm { const bf16_t* A; const bf16_t* Bt; int M, N, K; };

struct StaticOrder {
    int nM, nN, nwg, G, c;
    __host__ __device__ void init(int M, int N, int G_, int c_) { nM = M / BM; nN = N / BM; nwg = nM * nN; G = G_; c = c_; }
    __host__ __device__ bool next(int i, Unit& u) const {
        const long L = (long)i * G + c; if (L >= nwg) return false;
        int wgid = (int)L; { const int q = nwg / NXCD, r = nwg % NXCD, xcd = wgid % NXCD, off = wgid / NXCD; wgid = (xcd < r ? xcd * (q + 1) : r * (q + 1) + (xcd - r) * q) + off; }
        const int nig = WGM * nN, gid = wgid / nig, fm = gid * WGM, gsz = (nM - fm) < WGM ? (nM - fm) : WGM;
        u.pm = fm + ((wgid % nig) % gsz); u.pn = (wgid % nig) / gsz; return true;
    }
    __device__ __forceinline__ void a_ready(const Unit&) const {}
    __device__ __forceinline__ void done(const Unit&) const {}
};
__device__ __forceinline__ unsigned cvt_pk_bf16(float lo, float hi) { unsigned r; asm volatile("v_cvt_pk_bf16_f32 %0, %1, %2" : "=v"(r) : "v"(lo), "v"(hi)); return r; }
typedef float f32x2 __attribute__((ext_vector_type(2)));
__device__ __forceinline__ float gelu_tanh_f(float x) {
    const float u = 1.5957691216057308f * (x + 0.044715f * x * x * x);
    return x * __builtin_amdgcn_rcpf(1.0f + __expf(-u));
}
struct EpiH {
    static constexpr bool PERM = true, AFTER_DRAIN = false;
    bf16_t* O; int ldc; int act_lo, act_hi;
    __device__ __forceinline__ void operator()(const f32x4 (&acc)[2][2][4][2], const Unit& u, int wr, int wc, int fr, int fq) const {
        const int row0 = u.pm * BM + wr * 64 + fr; const int col0 = u.pn * BM + wc * 32 + 8 * fq;
        const bool act = (u.pn >= act_lo) && (u.pn < act_hi);
#pragma unroll
        for (int ai = 0; ai < 2; ++ai)
#pragma unroll
            for (int m = 0; m < 4; ++m) { bf16_t* rowp = O + (size_t)(row0 + ai * HALF + m * 16) * ldc + col0;
#pragma unroll
                for (int bj = 0; bj < 2; ++bj) { f32x4 v0 = acc[ai][bj][m][0], v1 = acc[ai][bj][m][1];
                    if (act) {
#pragma unroll
                        for (int j = 0; j < 4; ++j) { v0[j] = gelu_tanh_f(v0[j]); v1[j] = gelu_tanh_f(v1[j]); } }
                    u32x4 w; w.x = cvt_pk_bf16(v0[0], v0[1]); w.y = cvt_pk_bf16(v0[2], v0[3]); w.z = cvt_pk_bf16(v1[0], v1[1]); w.w = cvt_pk_bf16(v1[2], v1[3]);
                    *(u32x4*)(rowp + bj * HALF) = w; } }
    }
};
struct EpiRes {
    static constexpr bool PERM = false, AFTER_DRAIN = false;
    float* C; const float* X; int ldc; float alpha;
    __device__ __forceinline__ void operator()(const f32x4 (&acc)[2][2][4][2], const Unit& u, int wr, int wc, int fr, int fq) const {
        const int row0 = u.pm * BM + wr * 64 + fr, col0 = u.pn * BM + wc * 32 + 4 * fq;
#pragma unroll
        for (int ai = 0; ai < 2; ++ai)
#pragma unroll
            for (int m = 0; m < 4; ++m) { const size_t off = (size_t)(row0 + ai * HALF + m * 16) * ldc + col0;
#pragma unroll
                for (int bj = 0; bj < 2; ++bj)
#pragma unroll
                    for (int n = 0; n < 2; ++n) { const size_t o2 = off + bj * HALF + n * 16; const f32x4 xv = *(const f32x4*)(X + o2); *(f32x4*)(C + o2) = acc[ai][bj][m][n] + xv * alpha; } }
    }
};
struct EpiF32 {
    static constexpr bool PERM = false, AFTER_DRAIN = false;
    float* C; int ldc;
    __device__ __forceinline__ void operator()(const f32x4 (&acc)[2][2][4][2], const Unit& u, int wr, int wc, int fr, int fq) const {
        const int row0 = u.pm * BM + wr * 64 + fr, col0 = u.pn * BM + wc * 32 + 4 * fq;
#pragma unroll
        for (int ai = 0; ai < 2; ++ai)
#pragma unroll
            for (int m = 0; m < 4; ++m) { float* rowp = C + (size_t)(row0 + ai * HALF + m * 16) * ldc + col0;
#pragma unroll
                for (int bj = 0; bj < 2; ++bj)
#pragma unroll
                    for (int n = 0; n < 2; ++n) *(f32x4*)(rowp + bj * HALF + n * 16) = acc[ai][bj][m][n]; }
    }
};
template <class Epi, class Sched, bool ALIGN_EPI = false, bool SP2 = false>
__device__ __forceinline__ void gemm_phase(PG8_LAS unsigned char* lds, const Gemm g, const Sched& S, const Epi& E, const int tid) {
    const int wid = __builtin_amdgcn_readfirstlane(tid >> 6), lane = tid & 63, wr = wid >> 2, wc = wid & 3, fr = lane & 15, fq = lane >> 4;
    const int K = g.K, nt = K / BK;
    unsigned voffA[2], voffB[2];
#pragma unroll
    for (int i = 0; i < 2; ++i) { int R, C; stage_rc(tid * 16 + i * 8192, R, C); const int Rb = Epi::PERM ? ((R & ~31) + perm32(R & 31)) : R;
        voffA[i] = (unsigned)(R * K + C) * 2u; voffB[i] = (unsigned)(Rb * K + C) * 2u; }
    const size_t kstep = (size_t)(BK * 2);
    const size_t hstep = (size_t)HALF * K * 2;
    const size_t tstep = 2 * hstep;
    const unsigned ldsw = (unsigned)wid * 1024u;
    const int aoff = lds_byte(wr * 64 + fr, fq * 8), boff = lds_byte(wc * 32 + fr, fq * 8);
#define PG8_SA(b, h) (((b) * 2 + (h)) * HTB)
#define PG8_SB(b, h) ((4 + (b) * 2 + (h)) * HTB)
#define PG8_STAGE(bufoff, gbase, voff) do { _Pragma("unroll") for (int _i = 0; _i < 2; ++_i) \
        __builtin_amdgcn_global_load_lds((const unsigned*)((const char*)(gbase) + (voff)[_i]), (PG8_LAS unsigned*)(lds + (bufoff) + ldsw + _i * 8192), 16, 0, 0); } while (0)
#define PG8_LDA(dst, b, h) do { _Pragma("unroll") for (int m = 0; m < 4; ++m) _Pragma("unroll") for (int k = 0; k < 2; ++k) dst[m][k] = *(const PG8_LAS bf16x8*)(lds + PG8_SA(b, h) + aoff + m * 2048 + k * 1024); } while (0)
#define PG8_LDB(dst, b, h) do { _Pragma("unroll") for (int n = 0; n < 2; ++n) _Pragma("unroll") for (int k = 0; k < 2; ++k) dst[n][k] = *(const PG8_LAS bf16x8*)(lds + PG8_SB(b, h) + boff + n * 2048 + k * 1024); } while (0)
#define PG8_MMA(ai, bj, At, Bt) do { __builtin_amdgcn_s_setprio(1); _Pragma("unroll") for (int m = 0; m < 4; ++m) _Pragma("unroll") for (int n = 0; n < 2; ++n) _Pragma("unroll") for (int k = 0; k < 2; ++k) \
        acc[ai][bj][m][n] = __builtin_amdgcn_mfma_f32_16x16x32_bf16(Bt[n][k], At[m][k], acc[ai][bj][m][n], 0, 0, 0); __builtin_amdgcn_s_setprio(0); } while (0)
#define PG8_WAIT_V(n) asm volatile("s_waitcnt vmcnt(" #n ")" ::: "memory")
#define PG8_WAIT_L(n) asm volatile("s_waitcnt lgkmcnt(" #n ")" ::: "memory")
#define PG8_BAR __builtin_amdgcn_s_barrier()
#define PG8_SCHED __builtin_amdgcn_sched_barrier(0)
    Unit cur, nxt; int ui = 0;
    if (!S.next(0, cur)) return;
    f32x4 acc[2][2][4][2];
#pragma unroll
    for (int a = 0; a < 2; ++a)
#pragma unroll
        for (int b = 0; b < 2; ++b)
#pragma unroll
            for (int m = 0; m < 4; ++m)
#pragma unroll
                for (int n = 0; n < 2; ++n) acc[a][b][m][n] = (f32x4){0.f, 0.f, 0.f, 0.f};
    bf16x8 At[4][2], B0[2][2], B1[2][2];
    const char* cA = (const char*)g.A + (size_t)cur.pm * tstep; const char* cB = (const char*)g.Bt + (size_t)cur.pn * tstep;
    S.a_ready(cur);
    if constexpr (SP2) {
        PG8_STAGE(PG8_SB(0, 0), cB, voffB); PG8_STAGE(PG8_SB(0, 1), cB + hstep, voffB); PG8_STAGE(PG8_SA(0, 0), cA, voffA); PG8_STAGE(PG8_SA(0, 1), cA + hstep, voffA);
        if (wr == 1) PG8_BAR;
        PG8_WAIT_V(2); PG8_BAR;
        PG8_STAGE(PG8_SB(1, 0), cB + kstep, voffB); PG8_STAGE(PG8_SA(1, 0), cA + kstep, voffA); PG8_STAGE(PG8_SB(1, 1), cB + hstep + kstep, voffB);
        PG8_WAIT_V(6); PG8_BAR;
    } else {
        PG8_STAGE(PG8_SB(0, 0), cB, voffB); PG8_STAGE(PG8_SA(0, 0), cA, voffA); PG8_STAGE(PG8_SB(0, 1), cB + hstep, voffB); PG8_STAGE(PG8_SA(0, 1), cA + hstep, voffA);
        if (wr == 1) PG8_BAR;
        PG8_WAIT_V(4); PG8_BAR;
        PG8_STAGE(PG8_SB(1, 0), cB + kstep, voffB); PG8_STAGE(PG8_SA(1, 0), cA + kstep, voffA); PG8_STAGE(PG8_SB(1, 1), cB + hstep + kstep, voffB);
        PG8_WAIT_V(6); PG8_BAR;
    }
    for (;;) {
        const bool has_next = S.next(ui + 1, nxt);
        const char* nA = has_next ? (const char*)g.A + (size_t)nxt.pm * tstep : cA; const char* nB = has_next ? (const char*)g.Bt + (size_t)nxt.pn * tstep : cB;
        for (int t = 0; t < nt; t += 2) {
            const bool last = (t == nt - 2);
            const char* a1 = cA + (size_t)(t + 1) * kstep;
            const char* a2 = last ? nA : cA + (size_t)(t + 2) * kstep; const char* b2 = last ? nB : cB + (size_t)(t + 2) * kstep;
            const char* a3 = a2 + kstep; const char* b3 = b2 + kstep;
            if (last && has_next) S.a_ready(nxt);
            if constexpr (SP2) {
            PG8_LDB(B0, 0, 0); PG8_LDB(B1, 0, 1); PG8_SCHED; PG8_LDA(At, 0, 0); PG8_STAGE(PG8_SA(1, 1), a1 + hstep, voffA);
            PG8_WAIT_V(8); PG8_WAIT_L(0); PG8_BAR; PG8_MMA(0, 0, At, B0); PG8_MMA(0, 1, At, B1); PG8_BAR; PG8_SCHED;
            PG8_LDA(At, 0, 1); PG8_STAGE(PG8_SB(0, 0), b2, voffB); PG8_STAGE(PG8_SB(0, 1), b2 + hstep, voffB); PG8_STAGE(PG8_SA(0, 0), a2, voffA);
            PG8_WAIT_V(8); PG8_WAIT_L(0); PG8_BAR; PG8_MMA(1, 0, At, B0); PG8_MMA(1, 1, At, B1); PG8_BAR; PG8_SCHED;
            PG8_LDB(B0, 1, 0); PG8_LDB(B1, 1, 1); PG8_SCHED; PG8_LDA(At, 1, 0); PG8_STAGE(PG8_SA(0, 1), a2 + hstep, voffA);
            PG8_WAIT_V(8); PG8_WAIT_L(0); PG8_BAR; PG8_MMA(0, 0, At, B0); PG8_MMA(0, 1, At, B1); PG8_BAR; PG8_SCHED;
            PG8_LDA(At, 1, 1); PG8_STAGE(PG8_SB(1, 0), b3, voffB); PG8_STAGE(PG8_SB(1, 1), b3 + hstep, voffB); PG8_STAGE(PG8_SA(1, 0), a3, voffA);
            PG8_WAIT_V(8); PG8_WAIT_L(0); PG8_BAR; PG8_MMA(1, 0, At, B0); PG8_MMA(1, 1, At, B1); PG8_BAR; PG8_SCHED;
            } else {
            PG8_LDB(B0, 0, 0); PG8_SCHED; PG8_LDA(At, 0, 0); PG8_STAGE(PG8_SA(1, 1), a1 + hstep, voffA);
            PG8_WAIT_L(8); PG8_BAR; PG8_WAIT_L(0); PG8_MMA(0, 0, At, B0); PG8_BAR; PG8_SCHED;
            PG8_LDB(B1, 0, 1); PG8_STAGE(PG8_SB(0, 0), b2, voffB);
            PG8_BAR; PG8_WAIT_L(0); PG8_MMA(0, 1, At, B1); PG8_BAR;
            PG8_LDA(At, 0, 1); PG8_STAGE(PG8_SA(0, 0), a2, voffA);
            PG8_BAR; PG8_WAIT_L(0); PG8_MMA(1, 0, At, B0); PG8_BAR; PG8_SCHED;
            PG8_STAGE(PG8_SB(0, 1), b2 + hstep, voffB);
            PG8_WAIT_V(6); PG8_BAR; PG8_MMA(1, 1, At, B1); PG8_BAR;
            PG8_LDB(B0, 1, 0); PG8_SCHED; PG8_LDA(At, 1, 0); PG8_STAGE(PG8_SA(0, 1), a2 + hstep, voffA);
            PG8_WAIT_L(8); PG8_BAR; PG8_WAIT_L(0); PG8_MMA(0, 0, At, B0); PG8_BAR; PG8_SCHED;
            PG8_LDB(B1, 1, 1); PG8_STAGE(PG8_SB(1, 0), b3, voffB);
            PG8_BAR; PG8_WAIT_L(0); PG8_MMA(0, 1, At, B1); PG8_BAR;
            PG8_LDA(At, 1, 1); PG8_STAGE(PG8_SA(1, 0), a3, voffA);
            PG8_BAR; PG8_WAIT_L(0); PG8_MMA(1, 0, At, B0); PG8_BAR; PG8_SCHED;
            PG8_STAGE(PG8_SB(1, 1), b3 + hstep, voffB);
            PG8_WAIT_V(6); PG8_BAR; PG8_MMA(1, 1, At, B1); PG8_BAR;
            }
        }
        if constexpr (ALIGN_EPI) { if (wr == 0) PG8_BAR; }
        if constexpr (!Epi::AFTER_DRAIN) { E(acc, cur, wr, wc, fr, fq); S.done(cur); }
        if (!has_next) break;
#pragma unroll
        for (int a = 0; a < 2; ++a)
#pragma unroll
            for (int b = 0; b < 2; ++b)
#pragma unroll
                for (int m = 0; m < 4; ++m)
#pragma unroll
                    for (int n = 0; n < 2; ++n) acc[a][b][m][n] = (f32x4){0.f, 0.f, 0.f, 0.f};
        cur = nxt; cA = nA; cB = nB; ++ui;
        if constexpr (ALIGN_EPI) { if (wr == 1) PG8_BAR; }
    }
    PG8_WAIT_V(0);
    if constexpr (!ALIGN_EPI) { if (wr == 0) PG8_BAR; }
    PG8_BAR;
    if constexpr (Epi::AFTER_DRAIN) { E.fused(acc, cur, wr, wc, fr, fq, lds, wid, lane); S.done(cur); }
#undef PG8_SA
#undef PG8_SB
#undef PG8_STAGE
#undef PG8_LDA
#undef PG8_LDB
#undef PG8_MMA
#undef PG8_WAIT_V
#undef PG8_WAIT_L
#undef PG8_BAR
#undef PG8_SCHED
}
}
#define XB_TMO      128
#define XB_XCNT(j)  (256  + 64 * (j))
#define XB_XSUB(j)  (1280 + 64 * (j))
#define XB_XGEN(j)  (2304 + 64 * (j))
#define XB_TOP      3328
#define XB_TOPGEN   3392
#define XCD_BAR_WORDS 3456
#define XB_SPIN_CAP (1u << 18)

__device__ __forceinline__ unsigned xb_ld(unsigned* p)              { return __hip_atomic_load(p, __ATOMIC_RELAXED, __HIP_MEMORY_SCOPE_AGENT); }
__device__ __forceinline__ unsigned xb_add(unsigned* p, unsigned v) { return __hip_atomic_fetch_add(p, v, __ATOMIC_RELAXED, __HIP_MEMORY_SCOPE_AGENT); }
__device__ __forceinline__ unsigned xb_xcc_id() { return (unsigned)__builtin_amdgcn_s_getreg((3 << 11) | 20) & 0xFu; }
#define XB_SPIN(cond, bar) do { unsigned _sp = 0; while (cond) { __builtin_amdgcn_s_sleep(1); \
    if ((++_sp & 255u) == 0u) { if (xb_ld(&(bar)[XB_TMO])) break; if (_sp > XB_SPIN_CAP) { atomicAdd(&(bar)[XB_TMO], 1u); break; } } } } while (0)

struct XcdBarrier {
    unsigned* bar; unsigned x;
    volatile LAS unsigned* st;
};

__device__ __forceinline__ XcdBarrier xcd_barrier_post(unsigned* bar, volatile LAS unsigned* st) {
    XcdBarrier b; b.bar = bar; b.x = xb_xcc_id(); b.st = st;
    if (threadIdx.x == 0) (void)xb_add(&bar[XB_XCNT(b.x)], 1u);
    return b;
}
__device__ __forceinline__ void xcd_barrier_complete(unsigned* bar, unsigned x, unsigned& nloc, unsigned& nx) {
    const unsigned G = gridDim.x * gridDim.y * gridDim.z;
    unsigned sum, cnt, mine, sp = 0u;
    for (;;) {
        sum = 0u; cnt = 0u; mine = 0u;
#pragma unroll
        for (unsigned j = 0; j < 16; ++j) { const unsigned c = xb_ld(&bar[XB_XCNT(j)]); sum += c; cnt += (c > 0u) ? 1u : 0u; mine = (j == x) ? c : mine; }
        if (sum == G) break;
        __builtin_amdgcn_s_sleep(1);
        if ((++sp & 255u) == 0u) { if (xb_ld(&bar[XB_TMO])) break; if (sp > XB_SPIN_CAP) { atomicAdd(&bar[XB_TMO], 1u); break; } }
    }
    nloc = mine > 0u ? mine : 1u; nx = cnt > 0u ? cnt : 1u;
}

__device__ __forceinline__ void xcd_barrier(const XcdBarrier& b) {
    asm volatile("s_waitcnt vmcnt(0)" ::: "memory");
    __syncthreads();
    if (threadIdx.x == 0) {
        unsigned* bar = b.bar;
        __builtin_amdgcn_s_waitcnt(0);
        unsigned nloc = b.st[0], nx = b.st[1];
        if (nloc == 0u) { xcd_barrier_complete(bar, b.x, nloc, nx); b.st[0] = nloc; b.st[1] = nx; }
        const unsigned old = xb_add(&bar[XB_XSUB(b.x)], 1u);
        const unsigned gen = old / nloc;
        if (old + 1u == (gen + 1u) * nloc) {
            __builtin_amdgcn_fence(__ATOMIC_RELEASE, "agent");
            asm volatile("s_waitcnt vmcnt(0)" ::: "memory");
            const unsigned og = xb_add(&bar[XB_TOP], 1u);
            const unsigned tg = og / nx;
            if (og + 1u == (tg + 1u) * nx) xb_add(&bar[XB_TOPGEN], 1u);
            else XB_SPIN(xb_ld(&bar[XB_TOPGEN]) == tg, bar);
            __builtin_amdgcn_fence(__ATOMIC_ACQUIRE, "agent");
            xb_add(&bar[XB_XGEN(b.x)], 1u);
            asm volatile("s_waitcnt vmcnt(0)" ::: "memory");
        } else {
            XB_SPIN(xb_ld(&bar[XB_XGEN(b.x)]) == gen, bar);
            __builtin_amdgcn_fence(__ATOMIC_ACQUIRE, "agent");
            asm volatile("s_waitcnt vmcnt(0)" ::: "memory");
        }
    }
    __syncthreads();
}

#ifndef PROBE_DUP
#define PROBE_DUP -1
#endif
#define REP(i) for (int rep_ = 0; rep_ < ((PROBE_DUP == (i)) ? 2 : 1); ++rep_)
constexpr int NB = 4, T = 2048, D = 2048, NTOK = NB * T, DEPTH = 4;
constexpr int INW = 5168, INWP = 5376;
constexpr int C_RQ = 0, C_RK = 256, C_RV = 512, C_RG = 1024, C_SU = 1536, C_SV = 2048, C_NQ = 2560, C_KC = 3584, C_VC = 3840, C_KS = 4096, C_VS = 4352, C_KW = 4608, C_VW = 4864, C_NG = 5120;
constexpr float ALPHA = 1.6817928305074290f;
constexpr float LN_EPS = 1e-5f;
constexpr float LOG2E = 1.4426950408889634f;

constexpr size_t MiB = (size_t)1 << 20;
constexpr size_t WS_CTL = 0, CTL_ZERO_BYTES = 1 * MiB;
constexpr size_t WS_ROPE = 1 * MiB;
constexpr size_t WS_WIN = 2 * MiB;
constexpr size_t WS_WOUT = 86 * MiB;
constexpr size_t WS_WQ = 118 * MiB;
constexpr size_t WS_PU = 160 * MiB;
constexpr size_t WS_PV = 416 * MiB;
constexpr size_t WS_H = 672 * MiB;
constexpr size_t WS_YMIX = 756 * MiB;
constexpr size_t WS_MIXED = 820 * MiB;
constexpr size_t WS_Z = 852 * MiB;
constexpr size_t WS_X1 = 916 * MiB;
constexpr size_t WS_X1B = 980 * MiB;
constexpr size_t WS_QP = 1012 * MiB;
constexpr size_t WS_XC = 1076 * MiB;
constexpr size_t WS_XB = 1140 * MiB;
constexpr size_t WS_KC = 1172 * MiB;
constexpr size_t WS_KVST = 1174 * MiB;
constexpr size_t WS_SC = 1184 * MiB;
constexpr size_t WS_PSC = 1248 * MiB;
constexpr size_t WS_W1T = 1250 * MiB;
constexpr size_t WS_W2T = 1258 * MiB;
constexpr size_t WS_PKB = 1260 * MiB;
constexpr size_t WS_END = 1262 * MiB;
constexpr int CW_BAR = 4096;

constexpr int LDS_BYTES = 147456;
constexpr int MISC_OFF = 143360;

#define GAS __attribute__((address_space(1)))
typedef float f4 __attribute__((ext_vector_type(4)));
typedef float f2 __attribute__((ext_vector_type(2)));
typedef unsigned u4 __attribute__((ext_vector_type(4)));
typedef unsigned u2 __attribute__((ext_vector_type(2)));
__device__ __forceinline__ f4 mk_f4(float a, float b, float c, float d) { f4 r; r.x = a; r.y = b; r.z = c; r.w = d; return r; }
__device__ __forceinline__ f2 mk_f2(float a, float b) { f2 r; r.x = a; r.y = b; return r; }
__device__ __forceinline__ u2 mk_u2(unsigned a, unsigned b) { u2 r; r.x = a; r.y = b; return r; }
typedef unsigned short bf16;
#define LDS_WAIT() asm volatile("s_waitcnt lgkmcnt(0)" ::: "memory")
#define VM_WAIT() asm volatile("s_waitcnt vmcnt(0)" ::: "memory")

struct Params {
    const float* in[25];
    float* out;
    unsigned char* ws;
    double inv_rev[32];
    float lg2[4];
    int ph_lo, ph_hi, use_bar, pad0;
};

__device__ __forceinline__ float bf2f(unsigned short b) { return __uint_as_float(((unsigned)b) << 16); }
__device__ __forceinline__ unsigned f2bf(float f) { unsigned u = __float_as_uint(f); return (u + 0x7fffu + ((u >> 16) & 1u)) >> 16; }
__device__ __forceinline__ unsigned pk2(float lo, float hi) { return f2bf(lo) | (f2bf(hi) << 16); }
__device__ __forceinline__ float wave_sum(float v) {
#pragma unroll
    for (int o = 1; o < 64; o <<= 1) v += __shfl_xor(v, o);
    return v;
}
__device__ __forceinline__ void unpack8(const u4& v, float* f) {
    f[0] = __uint_as_float(v.x << 16); f[1] = __uint_as_float(v.x & 0xffff0000u);
    f[2] = __uint_as_float(v.y << 16); f[3] = __uint_as_float(v.y & 0xffff0000u);
    f[4] = __uint_as_float(v.z << 16); f[5] = __uint_as_float(v.z & 0xffff0000u);
    f[6] = __uint_as_float(v.w << 16); f[7] = __uint_as_float(v.w & 0xffff0000u);
}
__device__ __forceinline__ float gelu_tanh(float x) { return pg8::gelu_tanh_f(x); }

__device__ __forceinline__ void transpose_tile(const float* __restrict__ W, int K, int N, bf16* __restrict__ WT, LAS float* scr, int kb, int nb, int lane) {
    const int k0 = kb * 64, n0 = nb * 32, nn = lane & 31; const bool ok = (n0 + nn) < N;
#pragma unroll 8
    for (int i = 0; i < 32; ++i) { const int kk = 2 * i + (lane >> 5); scr[kk * 33 + nn] = ok ? W[(size_t)(k0 + kk) * N + n0 + nn] : 0.f; }
    LDS_WAIT();
    const int c = lane & 7;
#pragma unroll
    for (int j = 0; j < 4; ++j) { const int n = (lane >> 3) + 8 * j; const LAS float* s = scr + (8 * c) * 33 + n;
        u4 o; o.x = pk2(s[0 * 33], s[1 * 33]); o.y = pk2(s[2 * 33], s[3 * 33]); o.z = pk2(s[4 * 33], s[5 * 33]); o.w = pk2(s[6 * 33], s[7 * 33]);
        *(u4*)(WT + (size_t)(n0 + n) * K + k0 + 8 * c) = o; }
    LDS_WAIT();
}
__device__ __forceinline__ void cvt_bf16_stream(const float* __restrict__ src, bf16* __restrict__ dst, size_t nchunks, size_t gt, size_t GT) {
    for (size_t c = gt; c < nchunks; c += GT) { const f4 a = ((const f4*)src)[2 * c], b = ((const f4*)src)[2 * c + 1];
        u4 o; o.x = pk2(a.x, a.y); o.y = pk2(a.z, a.w); o.z = pk2(b.x, b.y); o.w = pk2(b.z, b.w); ((u4*)dst)[c] = o; }
}
__device__ __forceinline__ void phase_prologue(const Params& P, unsigned char* ws, LAS unsigned char* lds, int tid, int lane, int wave) {
    LAS float* scr = (LAS float*)(lds + wave * 8704);
    const int gw = blockIdx.x * 8 + wave, NGW = gridDim.x * 8;
    constexpr int I_IN = 32 * 168, I_SQ = 32 * 64, I_L = I_IN + 2 * I_SQ;
    for (int it = gw; it < DEPTH * I_L; it += NGW) {
        const int l = it / I_L; int r = it % I_L;
        if (r < I_IN) transpose_tile(P.in[1] + (size_t)l * D * INW, D, INW, (bf16*)(ws + WS_WIN) + (size_t)l * INWP * D, scr, r / 168, r % 168, lane);
        else { r -= I_IN;
            if (r < I_SQ) transpose_tile(P.in[15] + (size_t)l * D * D, D, D, (bf16*)(ws + WS_WOUT) + (size_t)l * D * D, scr, r / 64, r % 64, lane);
            else { r -= I_SQ; transpose_tile(P.in[18] + (size_t)l * D * D, D, D, (bf16*)(ws + WS_WQ) + (size_t)l * D * D, scr, r / 64, r % 64, lane); } }
    }
    for (int it = gw; it < DEPTH * 2 * (32 * 8 + 4 * 2); it += NGW) {
        const int lk = it / 264, r = it % 264, l = lk >> 1, kv = lk & 1;
        if (r < 256) transpose_tile(P.in[kv ? 12 : 9] + (size_t)l * 2048 * 256, 2048, 256, (bf16*)(ws + WS_W1T) + (size_t)lk * 256 * 2048, scr, r >> 3, r & 7, lane);
        else transpose_tile(P.in[kv ? 13 : 10] + (size_t)l * 256 * 64, 256, 64, (bf16*)(ws + WS_W2T) + (size_t)lk * 64 * 256, scr, (r - 256) >> 1, (r - 256) & 1, lane);
    }
    const size_t gt = (size_t)blockIdx.x * 512 + tid, GT = (size_t)gridDim.x * 512;
    for (int row = gw; row < 2 * DEPTH * 16384; row += NGW) {
        const int tab = row / (DEPTH * 16384), rr = row % (DEPTH * 16384);
        const float* src = P.in[21 + tab] + (size_t)rr * 2048;
        f4 v[8]; float am = 0.f;
#pragma unroll
        for (int j = 0; j < 2; ++j)
#pragma unroll
            for (int q = 0; q < 4; ++q) { const f4 a = *(const f4*)(src + 1024 * j + 16 * lane + 4 * q); v[4 * j + q] = a; am = fmaxf(am, fmaxf(fmaxf(fabsf(a.x), fabsf(a.y)), fmaxf(fabsf(a.z), fabsf(a.w)))); }
#pragma unroll
        for (int o = 1; o < 64; o <<= 1) am = fmaxf(am, __shfl_xor(am, o));
        const float sc = (am > 0.f) ? 448.f / am : 1.f;
        if (lane == 0) ((float*)(ws + WS_PSC))[row] = (am > 0.f) ? am * (1.f / 448.f) : 1.f;
        unsigned char* dst = ws + (tab ? WS_PV : WS_PU) + (size_t)rr * 2048;
#pragma unroll
        for (int j = 0; j < 2; ++j) { u4 w;
#pragma unroll
            for (int q = 0; q < 4; ++q) { const f4 a = v[4 * j + q]; int r = __builtin_amdgcn_cvt_pk_fp8_f32(a.x * sc, a.y * sc, 0, false); r = __builtin_amdgcn_cvt_pk_fp8_f32(a.z * sc, a.w * sc, r, true); w[q] = (unsigned)r; }
            *(u4*)(dst + 1024 * j + 16 * lane) = w; }
    }
    cvt_bf16_stream(P.in[0], (bf16*)(ws + WS_XB), (size_t)NTOK * D / 8, gt, GT);
    cvt_bf16_stream(P.in[19], (bf16*)(ws + WS_PKB), (size_t)DEPTH * 8 * 128 * 128 / 8, gt, GT);
    cvt_bf16_stream(P.in[20], (bf16*)(ws + WS_PKB) + (size_t)DEPTH * 8 * 128 * 128, (size_t)DEPTH * 8 * 128 * 128 / 8, gt, GT);
    f2* rope = (f2*)(ws + WS_ROPE);
    for (size_t idx = gt; idx < (size_t)T * 32; idx += GT) { const int t = (int)(idx >> 5), i = (int)(idx & 31);
        double a = (double)t * P.inv_rev[i]; a -= floor(a); const float fr = (float)a;
        rope[idx] = mk_f2(__builtin_amdgcn_cosf(fr), __builtin_amdgcn_sinf(fr)); }
}

__device__ __forceinline__ void stage_rot_k(const bf16* __restrict__ Hb, const f2* __restrict__ rope, LAS float* ks, int tok0, int tpos0, int colK, float lg2h, bool zeta, int tid) {
    const int m = tid >> 2, p = tid & 3;
    const bf16* src = Hb + (size_t)(tok0 + m) * INWP + colK + p * 8;
    const u4 a = *(const u4*)src, b = *(const u4*)(src + 32);
    float x1[8], x2[8]; unpack8(a, x1); unpack8(b, x2);
    const f4* rp = (const f4*)(rope + (size_t)(tpos0 + m) * 32 + p * 8);
    const f4 r0 = rp[0], r1 = rp[1], r2 = rp[2], r3 = rp[3];
    const float cs[8] = {r0.x, r0.z, r1.x, r1.z, r2.x, r2.z, r3.x, r3.z}, sn[8] = {r0.y, r0.w, r1.y, r1.w, r2.y, r2.w, r3.y, r3.w};
    const float sc = 0.125f * (zeta ? exp2f(lg2h * (float)(127 - m)) : 1.0f);
    float o1[8], o2[8];
#pragma unroll
    for (int i = 0; i < 8; ++i) { o1[i] = (x1[i] * cs[i] - x2[i] * sn[i]) * sc; o2[i] = (x1[i] * sn[i] + x2[i] * cs[i]) * sc; }
    LAS f4* d1 = (LAS f4*)(ks + m * 64 + p * 8); LAS f4* d2 = (LAS f4*)(ks + m * 64 + 32 + p * 8);
    d1[0] = mk_f4(o1[0], o1[1], o1[2], o1[3]); d1[1] = mk_f4(o1[4], o1[5], o1[6], o1[7]);
    d2[0] = mk_f4(o2[0], o2[1], o2[2], o2[3]); d2[1] = mk_f4(o2[4], o2[5], o2[6], o2[7]);
}
__device__ __forceinline__ void stage_v128(const bf16* __restrict__ Hb, LAS float* vs, int tok0, int colV, int tid) {
    const int m = tid >> 2, p = tid & 3;
    const u4* src = (const u4*)(Hb + (size_t)(tok0 + m) * INWP + colV + p * 32);
    LAS f4* dst = (LAS f4*)(vs + m * 128 + p * 32);
#pragma unroll
    for (int j = 0; j < 4; ++j) { const u4 a = src[j]; float f[8]; unpack8(a, f); dst[2 * j] = mk_f4(f[0], f[1], f[2], f[3]); dst[2 * j + 1] = mk_f4(f[4], f[5], f[6], f[7]); }
}

__device__ __forceinline__ void unit_kvstate(const Params& P, unsigned char* ws, LAS unsigned char* lds, int u, int tid) {
    const int b = u / 60, r = u % 60, h = r / 15, j = r % 15;
    const bf16* Hb = (const bf16*)(ws + WS_H); const f2* rope = (const f2*)(ws + WS_ROPE);
    LAS float* ks = (LAS float*)lds; LAS float* vs = (LAS float*)(lds + 32768);
    const int tok0 = b * T + j * 128;
    stage_rot_k(Hb, rope, ks, tok0, j * 128, C_RK + h * 64, P.lg2[h], true, tid);
    stage_v128(Hb, vs, tok0, C_RV + h * 128, tid);
    __syncthreads();
    const int d = tid >> 3, e0 = (tid & 7) * 16;
    float acc[16];
#pragma unroll
    for (int i = 0; i < 16; ++i) acc[i] = 0.f;
    #pragma unroll 1
    for (int m = 0; m < 128; ++m) { const float kd = ks[m * 64 + d]; const LAS f4* vp = (const LAS f4*)(vs + m * 128 + e0);
#pragma unroll
        for (int q = 0; q < 4; ++q) { const f4 v = vp[q]; acc[4 * q] += kd * v.x; acc[4 * q + 1] += kd * v.y; acc[4 * q + 2] += kd * v.z; acc[4 * q + 3] += kd * v.w; } }
    f4* dst = (f4*)((float*)(ws + WS_KVST) + ((size_t)((b * 4 + h) * 16 + j) * 64 + d) * 128 + e0);
#pragma unroll
    for (int q = 0; q < 4; ++q) dst[q] = mk_f4(acc[4 * q], acc[4 * q + 1], acc[4 * q + 2], acc[4 * q + 3]);
    __syncthreads();
}

__device__ __forceinline__ void unit_sgu(const Params& P, unsigned char* ws, int l, LAS unsigned char* lds, int u, int tid, int lane, int wave) {
    const int b = u >> 6, c = (u >> 2) & 15, g = u & 3;
    const bf16* Hb = (const bf16*)(ws + WS_H);
    LAS float* vn = (LAS float*)lds;
    LAS float* wsm = (LAS float*)(lds + 65536);
    const int tok0 = b * T + c * 128;
    const float* lng = P.in[4] + l * 512 + g * 128; const float* lnb = P.in[5] + l * 512 + g * 128;
    const float g0 = lng[2 * lane], g1 = lng[2 * lane + 1], b0 = lnb[2 * lane], b1 = lnb[2 * lane + 1];
    for (int i = 0; i < 16; ++i) { const int s = wave * 16 + i;
        const unsigned pr = *(const unsigned*)(Hb + (size_t)(tok0 + s) * INWP + C_SV + g * 128 + 2 * lane);
        const float v0 = __uint_as_float(pr << 16), v1 = __uint_as_float(pr & 0xffff0000u);
        const float mu = wave_sum(v0 + v1) * (1.f / 128.f); const float d0 = v0 - mu, d1 = v1 - mu;
        const float var = wave_sum(d0 * d0 + d1 * d1) * (1.f / 128.f); const float rstd = rsqrtf(var + LN_EPS);
        *(LAS f2*)(vn + s * 128 + 2 * lane) = mk_f2(d0 * rstd * g0 + b0, d1 * rstd * g1 + b1); }
    const float* wg = P.in[6] + ((size_t)l * 4 + g) * 16384;
    for (int i = 0; i < 32; ++i) { const int idx = tid + 512 * i; wsm[(idx >> 7) * 129 + (idx & 127)] = wg[idx]; }
    __syncthreads();
    const int t = tid >> 2, dg = tid & 3; const int smax = (t | 15);
    float acc[32];
#pragma unroll
    for (int i = 0; i < 32; ++i) acc[i] = 0.f;
    #pragma unroll 1
    for (int s = 0; s <= smax; ++s) { const float wv = (s <= t) ? wsm[t * 129 + s] : 0.f; const LAS f4* vp = (const LAS f4*)(vn + s * 128 + dg * 32);
#pragma unroll
        for (int q = 0; q < 8; ++q) { const f4 v = vp[q]; acc[4 * q] += wv * v.x; acc[4 * q + 1] += wv * v.y; acc[4 * q + 2] += wv * v.z; acc[4 * q + 3] += wv * v.w; } }
    const float bs = P.in[7][(l * 4 + g) * 128 + t];
    const u4* up = (const u4*)(Hb + (size_t)(tok0 + t) * INWP + C_SU + g * 128 + dg * 32);
    f4* yo = (f4*)((float*)(ws + WS_YMIX) + (size_t)(tok0 + t) * D + 512 + g * 128 + dg * 32);
#pragma unroll
    for (int j = 0; j < 4; ++j) { const u4 a = up[j]; float f[8]; unpack8(a, f);
        yo[2 * j] = mk_f4(f[0] * (acc[8 * j] + bs), f[1] * (acc[8 * j + 1] + bs), f[2] * (acc[8 * j + 2] + bs), f[3] * (acc[8 * j + 3] + bs));
        yo[2 * j + 1] = mk_f4(f[4] * (acc[8 * j + 4] + bs), f[5] * (acc[8 * j + 5] + bs), f[6] * (acc[8 * j + 6] + bs), f[7] * (acc[8 * j + 7] + bs)); }
    __syncthreads();
}

__device__ __forceinline__ void unit_compress(const Params& P, unsigned char* ws, int l, LAS unsigned char* lds, int u, int tid) {
    const int kv = u >> 7, b = (u >> 5) & 3, g = (u >> 3) & 3, r = u & 7;
    const bf16* Hb = (const bf16*)(ws + WS_H);
    LAS float* seg = (LAS float*)lds;
    LAS float* hid = (LAS float*)(lds + 69632);
    const int col0 = (kv ? C_VC : C_KC) + g * 64;
    const float* pe = P.in[kv ? 11 : 8] + (size_t)l * 2048;
    const float* w1 = P.in[kv ? 12 : 9] + (size_t)l * 2048 * 256;
    const float* w2 = P.in[kv ? 13 : 10] + (size_t)l * 256 * 64;
    for (int idx = tid; idx < 272 * 8; idx += 512) { const int tt = idx >> 3, d8 = (idx & 7) * 8; const int t = 256 * r + tt;
        float f[8];
        if (t < T) { const u4 a = *(const u4*)(Hb + (size_t)(b * T + t) * INWP + col0 + d8); unpack8(a, f); }
        else {
#pragma unroll
            for (int i = 0; i < 8; ++i) f[i] = 0.f; }
        LAS f4* dp = (LAS f4*)(seg + tt * 64 + d8); dp[0] = mk_f4(f[0], f[1], f[2], f[3]); dp[1] = mk_f4(f[4], f[5], f[6], f[7]); }
    __syncthreads();
    const int j = tid & 255, hb = tid >> 8;
    float acc[8], accpe = 0.f;
#pragma unroll
    for (int i = 0; i < 8; ++i) acc[i] = 0.f;
    for (int pos = 0; pos < 32; ++pos) {
#pragma unroll 2
        for (int d4 = 0; d4 < 16; ++d4) { const int kk = pos * 64 + d4 * 4;
            const float w0 = w1[(size_t)(kk + 0) * 256 + j], w1v = w1[(size_t)(kk + 1) * 256 + j], w2v = w1[(size_t)(kk + 2) * 256 + j], w3 = w1[(size_t)(kk + 3) * 256 + j];
            const f4 p4 = *(const f4*)(pe + kk);
            accpe += w0 * p4.x + w1v * p4.y + w2v * p4.z + w3 * p4.w;
#pragma unroll
            for (int ib = 0; ib < 8; ++ib) { const f4 s4 = *(const LAS f4*)(seg + (16 * (hb * 8 + ib) + pos) * 64 + d4 * 4);
                acc[ib] += w0 * s4.x + w1v * s4.y + w2v * s4.z + w3 * s4.w; } } }
#pragma unroll
    for (int ib = 0; ib < 8; ++ib) hid[(hb * 8 + ib) * 256 + j] = gelu_tanh(acc[ib] + accpe);
    __syncthreads();
    { const int i = tid >> 5, o2 = (tid & 31) * 2; float a0 = 0.f, a1 = 0.f;
        for (int jj = 0; jj < 256; ++jj) { const float hv = hid[i * 256 + jj]; const f2 w = *(const f2*)(w2 + jj * 64 + o2); a0 += hv * w.x; a1 += hv * w.y; }
        const int ci = 16 * r + i;
        if (ci <= 126) *(f2*)((float*)(ws + WS_KC) + ((size_t)((kv * 4 + b) * 4 + g) * 128 + ci) * 64 + o2) = mk_f2(a0, a1); }
    __syncthreads();
}

__device__ __forceinline__ void unit_retention(const Params& P, unsigned char* ws, int l, LAS unsigned char* lds, int u, int tid) {
    const int b = u >> 6, h = (u >> 4) & 3, c = u & 15;
    const bf16* Hb = (const bf16*)(ws + WS_H); const f2* rope = (const f2*)(ws + WS_ROPE);
    LAS float* regB = (LAS float*)lds;
    LAS float* vs = (LAS float*)(lds + 32768);
    LAS float* Qs = (LAS float*)(lds + 98304);
    const float lg2h = P.lg2[h];
    const int tok0 = b * T + c * 128;
    { float a[16];
#pragma unroll
        for (int i = 0; i < 16; ++i) a[i] = 0.f;
        const float* kvb = (const float*)(ws + WS_KVST) + (size_t)((b * 4 + h) * 16) * 8192 + tid * 16;
#pragma unroll 1
        for (int j = 0; j < c; ++j) { const float w = exp2f(lg2h * 128.f * (float)(c - 1 - j)); const f4* sp = (const f4*)(kvb + (size_t)j * 8192);
#pragma unroll
            for (int q = 0; q < 4; ++q) { const f4 v = sp[q]; a[4 * q] += w * v.x; a[4 * q + 1] += w * v.y; a[4 * q + 2] += w * v.z; a[4 * q + 3] += w * v.w; } }
        LAS f4* dp = (LAS f4*)(regB + tid * 16);
#pragma unroll
        for (int q = 0; q < 4; ++q) dp[q] = mk_f4(a[4 * q], a[4 * q + 1], a[4 * q + 2], a[4 * q + 3]); }
    const int n = tid >> 2, eg = tid & 3;
    float qa[8], qb[8];
    { const bf16* src = Hb + (size_t)(tok0 + n) * INWP + C_RQ + h * 64 + eg * 8;
        const u4 a = *(const u4*)src, bb = *(const u4*)(src + 32);
        float x1[8], x2[8]; unpack8(a, x1); unpack8(bb, x2);
        const f4* rp = (const f4*)(rope + (size_t)(c * 128 + n) * 32 + eg * 8);
        const f4 r0 = rp[0], r1 = rp[1], r2 = rp[2], r3 = rp[3];
        const float cs[8] = {r0.x, r0.z, r1.x, r1.z, r2.x, r2.z, r3.x, r3.z}, sn[8] = {r0.y, r0.w, r1.y, r1.w, r2.y, r2.w, r3.y, r3.w};
#pragma unroll
        for (int i = 0; i < 8; ++i) { qa[i] = x1[i] * cs[i] - x2[i] * sn[i]; qb[i] = x1[i] * sn[i] + x2[i] * cs[i]; Qs[n * 65 + eg * 8 + i] = qa[i]; Qs[n * 65 + 32 + eg * 8 + i] = qb[i]; } }
    __syncthreads();
    float acc[32];
#pragma unroll
    for (int i = 0; i < 32; ++i) acc[i] = 0.f;
#pragma unroll 2
    for (int d = 0; d < 64; ++d) { const float qd = Qs[n * 65 + d]; const LAS f4* sp = (const LAS f4*)(regB + d * 128 + eg * 32);
#pragma unroll
        for (int qq = 0; qq < 8; ++qq) { const f4 v = sp[qq]; acc[4 * qq] += qd * v.x; acc[4 * qq + 1] += qd * v.y; acc[4 * qq + 2] += qd * v.z; acc[4 * qq + 3] += qd * v.w; } }
    { const float xi = exp2f(lg2h * (float)(n + 1));
#pragma unroll
        for (int i = 0; i < 32; ++i) acc[i] *= xi; }
    __syncthreads();
    stage_rot_k(Hb, rope, regB, tok0, c * 128, C_RK + h * 64, lg2h, false, tid);
    stage_v128(Hb, vs, tok0, C_RV + h * 128, tid);
    __syncthreads();
    const int mmax = n | 15;
#pragma unroll 1
    for (int m = 0; m <= mmax; ++m) { const LAS f4* kp = (const LAS f4*)(regB + m * 64 + eg * 8); const LAS f4* kp2 = (const LAS f4*)(regB + m * 64 + 32 + eg * 8);
        const f4 k0 = kp[0], k1 = kp[1], k2 = kp2[0], k3 = kp2[1];
        float s = ((qa[0] * k0.x + qa[1] * k0.y) + (qa[2] * k0.z + qa[3] * k0.w)) + ((qa[4] * k1.x + qa[5] * k1.y) + (qa[6] * k1.z + qa[7] * k1.w))
                + ((qb[0] * k2.x + qb[1] * k2.y) + (qb[2] * k2.z + qb[3] * k2.w)) + ((qb[4] * k3.x + qb[5] * k3.y) + (qb[6] * k3.z + qb[7] * k3.w));
        s += __shfl_xor(s, 1); s += __shfl_xor(s, 2);
        const float a = (m <= n) ? s * exp2f(lg2h * (float)(n - m)) : 0.f;
        const LAS f4* vp = (const LAS f4*)(vs + m * 128 + eg * 32);
#pragma unroll
        for (int qq = 0; qq < 8; ++qq) { const f4 v = vp[qq]; acc[4 * qq] += a * v.x; acc[4 * qq + 1] += a * v.y; acc[4 * qq + 2] += a * v.z; acc[4 * qq + 3] += a * v.w; } }
    float s1 = 0.f;
#pragma unroll
    for (int i = 0; i < 32; ++i) s1 += acc[i];
    s1 += __shfl_xor(s1, 1); s1 += __shfl_xor(s1, 2);
    const float mu = s1 * (1.f / 128.f); float s2 = 0.f;
#pragma unroll
    for (int i = 0; i < 32; ++i) { const float dd = acc[i] - mu; s2 += dd * dd; }
    s2 += __shfl_xor(s2, 1); s2 += __shfl_xor(s2, 2);
    const float rstd = rsqrtf(s2 * (1.f / 128.f) + LN_EPS);
    const float* gg = P.in[2] + l * 512 + h * 128 + eg * 32; const float* gb = P.in[3] + l * 512 + h * 128 + eg * 32;
    const u4* gp = (const u4*)(Hb + (size_t)(tok0 + n) * INWP + C_RG + h * 128 + eg * 32);
    f4* yo = (f4*)((float*)(ws + WS_YMIX) + (size_t)(tok0 + n) * D + h * 128 + eg * 32);
#pragma unroll
    for (int j = 0; j < 4; ++j) { const u4 a = gp[j]; float f[8]; unpack8(a, f); float o[8];
#pragma unroll
        for (int i = 0; i < 8; ++i) { const float y = (acc[8 * j + i] - mu) * rstd * gg[8 * j + i] + gb[8 * j + i]; const float gv = f[i]; o[i] = y * gv * __builtin_amdgcn_rcpf(1.f + __expf(-gv)); }
        yo[2 * j] = mk_f4(o[0], o[1], o[2], o[3]); yo[2 * j + 1] = mk_f4(o[4], o[5], o[6], o[7]); }
    __syncthreads();
}

typedef pg8::bf16x8 bf16x8;
typedef short s16x4 __attribute__((ext_vector_type(4)));
typedef __bf16 bf16x2_t __attribute__((ext_vector_type(2)));
__device__ __forceinline__ unsigned pkbf(float a, float b) { f2 v; v.x = a; v.y = b; return __builtin_bit_cast(unsigned, __builtin_convertvector(v, bf16x2_t)); }
#define MFMA16(a, b, c) __builtin_amdgcn_mfma_f32_16x16x32_bf16((a), (b), (c), 0, 0, 0)
constexpr int NSA_KST = 72, NSA_VST = 136;
constexpr float NSA_SC = 0.125f * LOG2E;
__device__ __forceinline__ void nsa_scores(f4 (&st)[4][2], const LAS bf16* Kl, const bf16x8 (&Yq)[2][2], int lane) {
    const int r = lane & 15, kq = lane >> 4;
#pragma unroll
    for (int kt = 0; kt < 4; ++kt) { const LAS bf16* kp = Kl + (16 * kt + r) * NSA_KST + 8 * kq;
        const bf16x8 k0 = *(const LAS bf16x8*)kp, k1 = *(const LAS bf16x8*)(kp + 32);
#pragma unroll
        for (int qp = 0; qp < 2; ++qp) { f4 a = mk_f4(0.f, 0.f, 0.f, 0.f); a = MFMA16(k0, Yq[qp][0], a); a = MFMA16(k1, Yq[qp][1], a); st[kt][qp] = a; } }
}
__device__ __forceinline__ void nsa_softmax_pv(f4 (&st)[4][2], float (&m)[2], float (&l)[2], f4 (&ot)[4][2], const LAS bf16* Vt, const int (&lo)[2], const int (&hi)[2], bool need_mask, int lane) {
    const int r = lane & 15, kq = lane >> 4;
    bf16x8 Pf[2][2];
#pragma unroll
    for (int qp = 0; qp < 2; ++qp) {
        if (need_mask) {
#pragma unroll
            for (int kt = 0; kt < 4; ++kt)
#pragma unroll
                for (int i = 0; i < 4; ++i) { const int kl = 16 * kt + 4 * kq + i; if (kl < lo[qp] || kl > hi[qp]) st[kt][qp][i] = -1e30f; } }
        float mx = st[0][qp][0];
#pragma unroll
        for (int kt = 0; kt < 4; ++kt)
#pragma unroll
            for (int i = 0; i < 4; ++i) mx = fmaxf(mx, st[kt][qp][i]);
        mx = fmaxf(mx, __shfl_xor(mx, 16)); mx = fmaxf(mx, __shfl_xor(mx, 32));
        const float mn = fmaxf(m[qp], mx); const float corr = __builtin_amdgcn_exp2f((m[qp] - mn) * NSA_SC); m[qp] = mn; l[qp] *= corr;
#pragma unroll
        for (int dt = 0; dt < 4; ++dt) ot[dt][qp] *= corr;
        const float msc = mn * NSA_SC; float ps = 0.f;
#pragma unroll
        for (int kt = 0; kt < 4; ++kt)
#pragma unroll
            for (int i = 0; i < 4; ++i) { const float p = __builtin_amdgcn_exp2f(st[kt][qp][i] * NSA_SC - msc); st[kt][qp][i] = p; ps += p; }
        l[qp] += ps;
#pragma unroll
        for (int ksp = 0; ksp < 2; ++ksp) { u4 w; w.x = pkbf(st[2 * ksp][qp][0], st[2 * ksp][qp][1]); w.y = pkbf(st[2 * ksp][qp][2], st[2 * ksp][qp][3]);
            w.z = pkbf(st[2 * ksp + 1][qp][0], st[2 * ksp + 1][qp][1]); w.w = pkbf(st[2 * ksp + 1][qp][2], st[2 * ksp + 1][qp][3]); Pf[qp][ksp] = __builtin_bit_cast(bf16x8, w); }
    }
#pragma unroll
    for (int dt = 0; dt < 4; ++dt)
#pragma unroll
        for (int ksp = 0; ksp < 2; ++ksp) { const LAS bf16* vp = Vt + (16 * dt + r) * NSA_VST + 32 * ksp + 4 * kq;
            const s16x4 va = *(const LAS s16x4*)vp, vb = *(const LAS s16x4*)(vp + 16);
            const bf16x8 vf = __builtin_shufflevector(va, vb, 0, 1, 2, 3, 4, 5, 6, 7);
#pragma unroll
            for (int qp = 0; qp < 2; ++qp) ot[dt][qp] = MFMA16(vf, Pf[qp][ksp], ot[dt][qp]); }
}
__device__ __forceinline__ void nsa_accum(f4 (&tot)[4][2], const f4 (&ot)[4][2], const float (&l)[2], const float (&gate)[2]) {
#pragma unroll
    for (int qp = 0; qp < 2; ++qp) { float lt = l[qp]; lt += __shfl_xor(lt, 16); lt += __shfl_xor(lt, 32); const float sc = (lt > 0.f) ? gate[qp] / lt : 0.f;
#pragma unroll
        for (int dt = 0; dt < 4; ++dt) tot[dt][qp] += ot[dt][qp] * sc; }
}
__device__ __forceinline__ void nsa_kv_prefetch(const bf16* __restrict__ Hb, int tokbase, int colK, int colV, int tid, u4& kreg, u4& vreg) {
    kreg = *(const u4*)(Hb + (size_t)(tokbase + (tid >> 3)) * INWP + colK + (tid & 7) * 8);
    vreg = *(const u4*)(Hb + (size_t)(tokbase + (tid & 63)) * INWP + colV + (tid >> 6) * 8);
}
__device__ __forceinline__ void nsa_kv_store(LAS bf16* Kl, LAS bf16* Vt, int tid, const u4& kreg, const u4& vreg) {
    *(LAS u4*)(Kl + (tid >> 3) * NSA_KST + (tid & 7) * 8) = kreg;
    LAS bf16* vp = Vt + ((tid >> 6) * 8) * NSA_VST + (tid & 63);
    vp[0 * NSA_VST] = (bf16)(vreg.x & 0xffffu); vp[1 * NSA_VST] = (bf16)(vreg.x >> 16); vp[2 * NSA_VST] = (bf16)(vreg.y & 0xffffu); vp[3 * NSA_VST] = (bf16)(vreg.y >> 16);
    vp[4 * NSA_VST] = (bf16)(vreg.z & 0xffffu); vp[5 * NSA_VST] = (bf16)(vreg.z >> 16); vp[6 * NSA_VST] = (bf16)(vreg.w & 0xffffu); vp[7 * NSA_VST] = (bf16)(vreg.w >> 16);
}
__device__ __forceinline__ void unit_nsa(const Params& P, unsigned char* ws, int l_, LAS unsigned char* lds, int u, int tid) {
    const int b = u >> 7, g = (u >> 5) & 3, qt = u & 31;
    const bf16* Hb = (const bf16*)(ws + WS_H);
    LAS bf16* Kl = (LAS bf16*)lds;
    LAS bf16* Vt = (LAS bf16*)(lds + 18432);
    LAS float* impG = (LAS float*)(lds + 36864);
    LAS float* impE = (LAS float*)(lds + 69632);
    LAS unsigned* selm = (LAS unsigned*)(lds + 102400);
    const int lane = tid & 63, wv = __builtin_amdgcn_readfirstlane(tid >> 6), h = wv >> 1, qh = wv & 1;
    const int c = lane & 15, kq = lane >> 4;
    const int t0 = qt * 64;
    int tq[2]; size_t tok[2];
#pragma unroll
    for (int qp = 0; qp < 2; ++qp) { tq[qp] = 32 * qh + 16 * qp + c; tok[qp] = (size_t)b * T + t0 + tq[qp]; }
    bf16x8 Yq[2][2];
#pragma unroll
    for (int qp = 0; qp < 2; ++qp)
#pragma unroll
        for (int ks = 0; ks < 2; ++ks) Yq[qp][ks] = *(const bf16x8*)(Hb + tok[qp] * INWP + C_NQ + g * 256 + h * 64 + 32 * ks + 8 * kq);
    float gate[3][2];
#pragma unroll
    for (int k = 0; k < 3; ++k)
#pragma unroll
        for (int qp = 0; qp < 2; ++qp) { const float gv = bf2f(Hb[tok[qp] * INWP + C_NG + g * 12 + h * 3 + k]); gate[k][qp] = __builtin_amdgcn_rcpf(1.f + __expf(-gv)); }
    if (tid == 0) selm[64] = 0u;
    f4 tot[4][2], ot[4][2], st[4][2]; float m[2], l[2]; int lo[2], hi[2];
#pragma unroll
    for (int dt = 0; dt < 4; ++dt)
#pragma unroll
        for (int qp = 0; qp < 2; ++qp) { tot[dt][qp] = mk_f4(0.f, 0.f, 0.f, 0.f); ot[dt][qp] = mk_f4(0.f, 0.f, 0.f, 0.f); }
    int cmax[2];
#pragma unroll
    for (int qp = 0; qp < 2; ++qp) { const int t = t0 + tq[qp]; cmax[qp] = (t >= 31) ? (((t - 31) >> 4) < 126 ? ((t - 31) >> 4) : 126) : -1; }
    __syncthreads();
    { const float* KCk = (const float*)(ws + WS_KC) + (size_t)((0 * 4 + b) * 4 + g) * 8192;
        const float* KCv = (const float*)(ws + WS_KC) + (size_t)((1 * 4 + b) * 4 + g) * 8192;
        { const int key = tid >> 2, q4 = tid & 3; const f4* sp = (const f4*)(KCk + key * 64 + q4 * 16); const f4 a0 = sp[0], a1 = sp[1], a2 = sp[2], a3 = sp[3];
            u4 w0, w1; w0.x = pkbf(a0.x, a0.y); w0.y = pkbf(a0.z, a0.w); w0.z = pkbf(a1.x, a1.y); w0.w = pkbf(a1.z, a1.w); w1.x = pkbf(a2.x, a2.y); w1.y = pkbf(a2.z, a2.w); w1.z = pkbf(a3.x, a3.y); w1.w = pkbf(a3.z, a3.w);
            LAS u4* dp = (LAS u4*)(Kl + key * NSA_KST + q4 * 16); dp[0] = w0; dp[1] = w1; }
        { const int key = tid & 127, dq = tid >> 7; const f4* sp = (const f4*)(KCv + key * 64 + dq * 16); LAS bf16* vp = Vt + (dq * 16) * NSA_VST + key;
#pragma unroll
            for (int q = 0; q < 4; ++q) { const f4 a = sp[q]; vp[(4 * q) * NSA_VST] = (bf16)f2bf(a.x); vp[(4 * q + 1) * NSA_VST] = (bf16)f2bf(a.y); vp[(4 * q + 2) * NSA_VST] = (bf16)f2bf(a.z); vp[(4 * q + 3) * NSA_VST] = (bf16)f2bf(a.w); } } }
    __syncthreads();
    m[0] = m[1] = -1e4f; l[0] = l[1] = 0.f;
#pragma unroll 1
    for (int cc = 0; cc < 2; ++cc) {
        if (cc * 64 * 16 + 31 > t0 + 63) break;
#pragma unroll
        for (int qp = 0; qp < 2; ++qp) { lo[qp] = 0; hi[qp] = cmax[qp] - 64 * cc; }
        nsa_scores(st, Kl + cc * 64 * NSA_KST, Yq, lane);
        nsa_softmax_pv(st, m, l, ot, Vt + cc * 64, lo, hi, true, lane);
    }
    { const float g2[2] = {gate[0][0], gate[0][1]}; nsa_accum(tot, ot, l, g2); }
    { float invl[2], msc[2];
#pragma unroll
        for (int qp = 0; qp < 2; ++qp) { float lt = l[qp]; lt += __shfl_xor(lt, 16); lt += __shfl_xor(lt, 32); invl[qp] = (lt > 0.f) ? 1.f / lt : 0.f; msc[qp] = m[qp] * NSA_SC; }
#pragma unroll 1
        for (int cc = 0; cc < 2; ++cc) {
            nsa_scores(st, Kl + cc * 64 * NSA_KST, Yq, lane);
#pragma unroll
            for (int kt = 0; kt < 4; ++kt)
#pragma unroll
                for (int qp = 0; qp < 2; ++qp) { float p[4];
#pragma unroll
                    for (int i = 0; i < 4; ++i) { const int ci = 64 * cc + 16 * kt + 4 * kq + i; p[i] = (ci <= cmax[qp]) ? __builtin_amdgcn_exp2f(st[kt][qp][i] * NSA_SC - msc[qp]) * invl[qp] : 0.f; }
                    const int j = 16 * cc + 4 * kt + kq;
                    impG[(h * 32 + j) * 64 + tq[qp]] = (p[0] + p[1]) + (p[2] + p[3]);
                    if (j < 31) impE[(h * 32 + j + 1) * 64 + tq[qp]] = p[3]; }
        } }
    __syncthreads();
    if (tid < 64) { const int tqs = tid; float tv[8]; int ti[8];
#pragma unroll
        for (int k = 0; k < 8; ++k) { tv[k] = -3e38f; ti[k] = 0; }
#pragma unroll 1
        for (int j = 0; j < 32; ++j) { float v;
            if (j <= qt) { const bool forced = (j == 0) || (j == qt) || (j == qt - 1);
                float s4 = (impG[(0 * 32 + j) * 64 + tqs] + impG[(1 * 32 + j) * 64 + tqs]) + (impG[(2 * 32 + j) * 64 + tqs] + impG[(3 * 32 + j) * 64 + tqs]);
                if (j > 0) s4 += (impE[(0 * 32 + j) * 64 + tqs] + impE[(1 * 32 + j) * 64 + tqs]) + (impE[(2 * 32 + j) * 64 + tqs] + impE[(3 * 32 + j) * 64 + tqs]);
                v = forced ? 1e6f : s4; }
            else v = -1e9f;
            int vi = j;
#pragma unroll
            for (int k = 0; k < 8; ++k) { const bool gt = v > tv[k]; const float nv = gt ? tv[k] : v; const int ni = gt ? ti[k] : vi; tv[k] = gt ? v : tv[k]; ti[k] = gt ? vi : ti[k]; v = nv; vi = ni; } }
        unsigned msk = 0u;
#pragma unroll
        for (int k = 0; k < 8; ++k) if (ti[k] <= qt) msk |= (1u << ti[k]);
        selm[tqs] = msk; atomicOr((unsigned*)&selm[64], msk); }
    __syncthreads();
    unsigned mymask[2];
#pragma unroll
    for (int qp = 0; qp < 2; ++qp) mymask[qp] = selm[tq[qp]];
    const unsigned umask = selm[64];
#pragma unroll
    for (int dt = 0; dt < 4; ++dt)
#pragma unroll
        for (int qp = 0; qp < 2; ++qp) ot[dt][qp] = mk_f4(0.f, 0.f, 0.f, 0.f);
    m[0] = m[1] = -1e4f; l[0] = l[1] = 0.f;
    { u4 kreg, vreg; unsigned rem = umask;
        int j = __builtin_ctz(rem); rem &= rem - 1u;
        nsa_kv_prefetch(Hb, b * T + 64 * j, C_KS + g * 64, C_VS + g * 64, tid, kreg, vreg);
#pragma unroll 1
        for (;;) {
            __syncthreads();
            nsa_kv_store(Kl, Vt, tid, kreg, vreg);
            __syncthreads();
            const int jc = j; const bool more = (rem != 0u);
            if (more) { j = __builtin_ctz(rem); rem &= rem - 1u; nsa_kv_prefetch(Hb, b * T + 64 * j, C_KS + g * 64, C_VS + g * 64, tid, kreg, vreg); }
            bool anyv = false, full = true;
#pragma unroll
            for (int qp = 0; qp < 2; ++qp) { const bool sel = (mymask[qp] >> jc) & 1u; lo[qp] = sel ? 0 : 64; hi[qp] = sel ? ((jc == qt) ? tq[qp] : 63) : -1; anyv |= sel; full &= (sel && jc != qt); }
            if (__builtin_amdgcn_ballot_w64(anyv) != 0ull) {
                const bool need_mask = __builtin_amdgcn_ballot_w64(!full) != 0ull;
                nsa_scores(st, Kl, Yq, lane);
                nsa_softmax_pv(st, m, l, ot, Vt, lo, hi, need_mask, lane); }
            if (!more) break;
        } }
    { const float g2[2] = {gate[1][0], gate[1][1]}; nsa_accum(tot, ot, l, g2); }
#pragma unroll
    for (int dt = 0; dt < 4; ++dt)
#pragma unroll
        for (int qp = 0; qp < 2; ++qp) ot[dt][qp] = mk_f4(0.f, 0.f, 0.f, 0.f);
    m[0] = m[1] = -1e4f; l[0] = l[1] = 0.f;
    { u4 kreg, vreg; int jw = (qt >= 8 ? qt - 8 : 0);
        nsa_kv_prefetch(Hb, b * T + 64 * jw, C_KW + g * 64, C_VW + g * 64, tid, kreg, vreg);
#pragma unroll 1
        for (;;) {
            __syncthreads();
            nsa_kv_store(Kl, Vt, tid, kreg, vreg);
            __syncthreads();
            const int jc = jw; const bool more = (jw < qt);
            if (more) { ++jw; nsa_kv_prefetch(Hb, b * T + 64 * jw, C_KW + g * 64, C_VW + g * 64, tid, kreg, vreg); }
#pragma unroll
            for (int qp = 0; qp < 2; ++qp) { lo[qp] = (jc == qt - 8) ? tq[qp] + 1 : 0; hi[qp] = (jc == qt) ? tq[qp] : 63; }
            const bool need_mask = (jc == qt) || (jc == qt - 8);
            nsa_scores(st, Kl, Yq, lane);
            nsa_softmax_pv(st, m, l, ot, Vt, lo, hi, need_mask, lane);
            if (!more) break;
        } }
    { const float g2[2] = {gate[2][0], gate[2][1]}; nsa_accum(tot, ot, l, g2); }
    float* ymix = (float*)(ws + WS_YMIX);
#pragma unroll
    for (int qp = 0; qp < 2; ++qp)
#pragma unroll
        for (int dt = 0; dt < 4; ++dt) *(f4*)(ymix + tok[qp] * D + 1024 + g * 256 + h * 64 + 16 * dt + 4 * kq) = tot[dt][qp];
    __syncthreads();
}

__device__ __forceinline__ bf16x8 cmp_afrag(const bf16* __restrict__ p, const float* __restrict__ pe) {
    const u4 a = *(const u4*)p; float f[8]; unpack8(a, f);
    const f4 p0 = *(const f4*)pe, p1 = *(const f4*)(pe + 4);
    u4 w; w.x = pkbf(f[0] + p0.x, f[1] + p0.y); w.y = pkbf(f[2] + p0.z, f[3] + p0.w); w.z = pkbf(f[4] + p1.x, f[5] + p1.y); w.w = pkbf(f[6] + p1.z, f[7] + p1.w);
    return __builtin_bit_cast(bf16x8, w);
}
__device__ __forceinline__ void unit_compress_mfma(const Params& P, unsigned char* ws, int l, LAS unsigned char* lds, int u, int tid) {
    const int kv = u >> 6, b = (u >> 4) & 3, g = (u >> 2) & 3, r4 = u & 3, i0 = 32 * r4;
    const bf16* Hb = (const bf16*)(ws + WS_H);
    const bf16* W1T = (const bf16*)(ws + WS_W1T) + (size_t)(l * 2 + kv) * 256 * 2048;
    const bf16* W2T = (const bf16*)(ws + WS_W2T) + (size_t)(l * 2 + kv) * 64 * 256;
    const float* pe = P.in[kv ? 11 : 8] + (size_t)l * 2048;
    LAS bf16* hidL = (LAS bf16*)lds;
    const int lane = tid & 63, wv = __builtin_amdgcn_readfirstlane(tid >> 6), c = lane & 15, kq = lane >> 4;
    const int col0 = (kv ? C_VC : C_KC) + g * 64;
    int tb[2];
#pragma unroll
    for (int rt = 0; rt < 2; ++rt) tb[rt] = 16 * (i0 + 16 * rt + c);
    f4 acc[2][2];
#pragma unroll
    for (int nt = 0; nt < 2; ++nt)
#pragma unroll
        for (int rt = 0; rt < 2; ++rt) acc[nt][rt] = mk_f4(0.f, 0.f, 0.f, 0.f);
    const bf16* wrow[2];
#pragma unroll
    for (int nt = 0; nt < 2; ++nt) wrow[nt] = W1T + (size_t)(32 * wv + 16 * nt + c) * 2048 + 8 * kq;
#pragma unroll 2
    for (int pos = 0; pos < 32; ++pos) {
        bf16x8 xf[2][2], yf[2][2];
#pragma unroll
        for (int nt = 0; nt < 2; ++nt)
#pragma unroll
            for (int ks = 0; ks < 2; ++ks) xf[nt][ks] = *(const bf16x8*)(wrow[nt] + pos * 64 + 32 * ks);
#pragma unroll
        for (int rt = 0; rt < 2; ++rt) { int t = tb[rt] + pos; t = t < T ? t : T - 1;
            const bf16* ap = Hb + (size_t)(b * T + t) * INWP + col0 + 8 * kq;
#pragma unroll
            for (int ks = 0; ks < 2; ++ks) yf[rt][ks] = cmp_afrag(ap + 32 * ks, pe + pos * 64 + 32 * ks + 8 * kq); }
#pragma unroll
        for (int nt = 0; nt < 2; ++nt)
#pragma unroll
            for (int rt = 0; rt < 2; ++rt)
#pragma unroll
                for (int ks = 0; ks < 2; ++ks) acc[nt][rt] = MFMA16(xf[nt][ks], yf[rt][ks], acc[nt][rt]);
    }
#pragma unroll
    for (int nt = 0; nt < 2; ++nt)
#pragma unroll
        for (int rt = 0; rt < 2; ++rt) { const f4 a = acc[nt][rt]; u2 w; w.x = pkbf(gelu_tanh(a.x), gelu_tanh(a.y)); w.y = pkbf(gelu_tanh(a.z), gelu_tanh(a.w));
            *(LAS u2*)(hidL + (16 * rt + c) * 264 + 32 * wv + 16 * nt + 4 * kq) = w; }
    __syncthreads();
    { const int ot = wv & 3, rt = wv >> 2; f4 o = mk_f4(0.f, 0.f, 0.f, 0.f);
        const bf16* w2p = W2T + (size_t)(16 * ot + c) * 256 + 8 * kq; const LAS bf16* hp = hidL + (16 * rt + c) * 264 + 8 * kq;
#pragma unroll
        for (int ks = 0; ks < 8; ++ks) { const bf16x8 xw = *(const bf16x8*)(w2p + 32 * ks); const bf16x8 yh = *(const LAS bf16x8*)(hp + 32 * ks); o = MFMA16(xw, yh, o); }
        const int ci = i0 + 16 * rt + c;
        if (ci <= 126) *(f4*)((float*)(ws + WS_KC) + ((size_t)((kv * 4 + b) * 4 + g) * 128 + ci) * 64 + 16 * ot + 4 * kq) = o; }
    __syncthreads();
}

__device__ __forceinline__ void row_mixnorm(const Params& P, unsigned char* ws, int l, int rowi, int lane) {
    const f4* yp = (const f4*)((const float*)(ws + WS_YMIX) + (size_t)rowi * D) + lane;
    const f4* gp = (const f4*)(P.in[14] + (size_t)l * D) + lane;
    f4 v[8]; float ss[8];
#pragma unroll
    for (int j = 0; j < 8; ++j) { v[j] = yp[64 * j]; ss[j] = v[j].x * v[j].x + v[j].y * v[j].y + v[j].z * v[j].z + v[j].w * v[j].w; }
    const float r0 = rsqrtf(wave_sum(ss[0] + ss[1]) * (1.f / 512.f) + LN_EPS);
    const float r1 = rsqrtf(wave_sum(ss[2] + ss[3]) * (1.f / 512.f) + LN_EPS);
    const float r2 = rsqrtf(wave_sum((ss[4] + ss[5]) + (ss[6] + ss[7])) * (1.f / 1024.f) + LN_EPS);
    u2* op = (u2*)((bf16*)(ws + WS_MIXED) + (size_t)rowi * D) + lane;
#pragma unroll
    for (int j = 0; j < 8; ++j) { const float r = (j < 2) ? r0 : ((j < 4) ? r1 : r2); const f4 g4 = gp[64 * j];
        op[64 * j] = mk_u2(pk2(v[j].x * r * g4.x, v[j].y * r * g4.y), pk2(v[j].z * r * g4.z, v[j].w * r * g4.w)); }
}
__device__ __forceinline__ void row_ln(const float* __restrict__ zin, const float* __restrict__ gam, const float* __restrict__ bet, float* __restrict__ of32, bf16* __restrict__ obf, int rowi, int lane) {
    const f4* zp = (const f4*)(zin + (size_t)rowi * D) + lane;
    f4 v[8]; float s = 0.f;
#pragma unroll
    for (int j = 0; j < 8; ++j) { v[j] = zp[64 * j]; s += (v[j].x + v[j].y) + (v[j].z + v[j].w); }
    const float mu = wave_sum(s) * (1.f / D); float s2 = 0.f;
#pragma unroll
    for (int j = 0; j < 8; ++j) { v[j].x -= mu; v[j].y -= mu; v[j].z -= mu; v[j].w -= mu; s2 += (v[j].x * v[j].x + v[j].y * v[j].y) + (v[j].z * v[j].z + v[j].w * v[j].w); }
    const float rstd = rsqrtf(wave_sum(s2) * (1.f / D) + LN_EPS);
    f4* o4 = (f4*)(of32 + (size_t)rowi * D) + lane; u2* o2 = (u2*)(obf + (size_t)rowi * D) + lane;
    const f4* gp = (const f4*)gam + lane; const f4* bp = (const f4*)bet + lane;
#pragma unroll
    for (int j = 0; j < 8; ++j) { const f4 g4 = gp[64 * j], b4 = bp[64 * j];
        const f4 o = mk_f4(v[j].x * rstd * g4.x + b4.x, v[j].y * rstd * g4.y + b4.y, v[j].z * rstd * g4.z + b4.z, v[j].w * rstd * g4.w + b4.w);
        o4[64 * j] = o; o2[64 * j] = mk_u2(pk2(o.x, o.y), pk2(o.z, o.w)); }
}

__device__ __forceinline__ float dot8_bf16(const u4& w, const float* x) {
    float f[8]; unpack8(w, f);
    return ((f[0] * x[0] + f[1] * x[1]) + (f[2] * x[2] + f[3] * x[3])) + ((f[4] * x[4] + f[5] * x[5]) + (f[6] * x[6] + f[7] * x[7]));
}
__device__ __forceinline__ void peer_load4(u4 (&R)[4][2], const unsigned char* __restrict__ TAB, const LAS int* pe, int grp, int lane) {
#pragma unroll
    for (int k = 0; k < 4; ++k) { const int e = __builtin_amdgcn_readfirstlane(pe[grp * 4 + k]); const u4* p = (const u4*)(TAB + (size_t)e * 2048) + lane; R[k][0] = p[0]; R[k][1] = p[64]; }
}
__device__ __forceinline__ float dot16_fp8(const u4& w, const float* x) {
    float s = 0.f;
#pragma unroll
    for (int q = 0; q < 4; ++q) { const f2 lo = __builtin_amdgcn_cvt_pk_f32_fp8((int)w[q], false), hi = __builtin_amdgcn_cvt_pk_f32_fp8((int)w[q], true);
        s += (lo.x * x[4 * q] + lo.y * x[4 * q + 1]) + (hi.x * x[4 * q + 2] + hi.y * x[4 * q + 3]); }
    return s;
}
__device__ __forceinline__ void peer_dot4(const u4 (&R)[4][2], const float (&xr)[32], const float* __restrict__ USC, const LAS int* pe, const LAS float* pw, const float* __restrict__ VSC, LAS float* hwp, int grp, int lane) {
    float d[4];
#pragma unroll
    for (int k = 0; k < 4; ++k) d[k] = dot16_fp8(R[k][0], xr) + dot16_fp8(R[k][1], xr + 16);
#pragma unroll
    for (int o = 1; o < 64; o <<= 1) {
#pragma unroll
        for (int k = 0; k < 4; ++k) d[k] += __shfl_xor(d[k], o); }
#pragma unroll
    for (int k = 0; k < 4; ++k) { const int e = __builtin_amdgcn_readfirstlane(pe[grp * 4 + k]);
        const float hv = pw[grp * 4 + k] * gelu_tanh(d[k] * USC[e]) * VSC[e];
        if (lane == 0) hwp[grp * 4 + k] = hv; }
}
__device__ __forceinline__ void peer_axpy4(const u4 (&R)[4][2], float (&acc)[32], const LAS float* hwp, int grp) {
#pragma unroll
    for (int k = 0; k < 4; ++k) { const float hw = hwp[grp * 4 + k];
#pragma unroll
        for (int j = 0; j < 2; ++j)
#pragma unroll
            for (int q = 0; q < 4; ++q) { const f2 lo = __builtin_amdgcn_cvt_pk_f32_fp8((int)R[k][j][q], false), hi = __builtin_amdgcn_cvt_pk_f32_fp8((int)R[k][j][q], true);
                acc[16 * j + 4 * q] += hw * lo.x; acc[16 * j + 4 * q + 1] += hw * lo.y; acc[16 * j + 4 * q + 2] += hw * hi.x; acc[16 * j + 4 * q + 3] += hw * hi.y; } }
}
__device__ __forceinline__ void unit_peer(const Params& P, unsigned char* ws, int l, LAS unsigned char* lds, int u, int tid_in, int lane_in, int wave, float* __restrict__ xout) {
    int tid = tid_in; asm volatile("" : "+v"(tid)); int lane = tid & 63;
    const int n0 = u * 32;
    const bf16* QPB = (const bf16*)(ws + WS_QP); int* SC = (int*)(ws + WS_SC);
    { const int h = wave, c = lane & 15, kq = lane >> 4;
#pragma unroll 1
        for (int half = 0; half < 2; ++half) {
            const bf16* kb = (const bf16*)(ws + WS_PKB) + ((size_t)(half * DEPTH + l) * 8 + h) * 16384;
            bf16x8 yq[2][4];
#pragma unroll
            for (int tt = 0; tt < 2; ++tt)
#pragma unroll
                for (int ks = 0; ks < 4; ++ks) yq[tt][ks] = *(const bf16x8*)(QPB + (size_t)(n0 + 16 * tt + c) * D + h * 256 + half * 128 + 32 * ks + 8 * kq);
#pragma unroll 1
            for (int kt = 0; kt < 8; ++kt) { bf16x8 xk[4];
#pragma unroll
                for (int ks = 0; ks < 4; ++ks) xk[ks] = *(const bf16x8*)(kb + (size_t)(16 * kt + c) * 128 + 32 * ks + 8 * kq);
#pragma unroll
                for (int tt = 0; tt < 2; ++tt) { f4 a = mk_f4(0.f, 0.f, 0.f, 0.f);
#pragma unroll
                    for (int ks = 0; ks < 4; ++ks) a = MFMA16(xk[ks], yq[tt][ks], a);
                    int kk[4];
#pragma unroll
                    for (int i = 0; i < 4; ++i) { const int bits = __float_as_int(a[i]); const int sk = bits ^ ((bits >> 31) & 0x7fffffff); kk[i] = (sk & ~127) | (127 - (16 * kt + 4 * kq + i)); }
                    u4 w; w.x = (unsigned)kk[0]; w.y = (unsigned)kk[1]; w.z = (unsigned)kk[2]; w.w = (unsigned)kk[3];
                    *(u4*)(SC + ((size_t)(n0 + 16 * tt + c) * 16 + 2 * h + half) * 128 + 16 * kt + 4 * kq) = w; } }
        } }
    VM_WAIT();
    __syncthreads();
    tid = tid_in; asm volatile("" : "+v"(tid)); lane = tid & 63;
    LAS int* TK = (LAS int*)lds;
    { const int tk = tid >> 4, hh = tid & 15;
        const u4* sp = (const u4*)(SC + ((size_t)(n0 + tk) * 16 + hh) * 128);
        int t[16];
#pragma unroll
        for (int k = 0; k < 16; ++k) t[k] = (int)0x80000000;
#pragma unroll 1
        for (int c4 = 0; c4 < 32; ++c4) { const u4 s4 = sp[c4];
#pragma unroll
            for (int e = 0; e < 4; ++e) { int x = (int)s4[e];
#pragma unroll
                for (int k = 0; k < 16; ++k) { const int hi_ = max(t[k], x); x = min(t[k], x); t[k] = hi_; } } }
#pragma unroll
        for (int k = 0; k < 16; ++k) TK[tid * 17 + k] = t[k]; }
    __syncthreads();
    tid = tid_in; asm volatile("" : "+v"(tid)); lane = tid & 63;
    LAS int* PE = (LAS int*)(lds + 69632);
    LAS float* PW = (LAS float*)(lds + 86016);
    if (tid < 256) { const int tk = tid >> 3, h = tid & 7; const int r1 = tk * 16 + 2 * h, r2 = r1 + 1;
        float v1[16], v2[16];
#pragma unroll
        for (int k = 0; k < 16; ++k) { const int k1 = TK[r1 * 17 + k] & ~127, k2 = TK[r2 * 17 + k] & ~127;
            v1[k] = __int_as_float(k1 ^ ((k1 >> 31) & 0x7fffffff)); v2[k] = __int_as_float(k2 ^ ((k2 >> 31) & 0x7fffffff)); }
        int t[16];
#pragma unroll
        for (int k = 0; k < 16; ++k) t[k] = (int)0x80000000;
#pragma unroll
        for (int a = 0; a < 16; ++a)
#pragma unroll
            for (int bq = 0; bq < 16; ++bq) if ((a + 1) * (bq + 1) <= 16) { const int bits = __float_as_int(v1[a] + v2[bq]); const int sk = bits ^ ((bits >> 31) & 0x7fffffff);
                int x = (sk & ~255) | (255 - (a * 16 + bq));
#pragma unroll
                for (int k = 0; k < 16; ++k) { const int hi_ = max(t[k], x); x = min(t[k], x); t[k] = hi_; } }
        float w[16], wsum = 0.f; const int kt0 = t[0] & ~255; const float top = __int_as_float(kt0 ^ ((kt0 >> 31) & 0x7fffffff));
#pragma unroll
        for (int k = 0; k < 16; ++k) { const int kk = t[k] & ~255; const float sv = __int_as_float(kk ^ ((kk >> 31) & 0x7fffffff)); w[k] = __expf(sv - top); wsum += w[k]; }
        const float inv = 1.f / wsum;
#pragma unroll
        for (int k = 0; k < 16; ++k) { const int ab = 255 - (t[k] & 255); const int a = ab >> 4, bq = ab & 15;
            const int i1 = 127 - (TK[r1 * 17 + a] & 127), i2 = 127 - (TK[r2 * 17 + bq] & 127);
            PE[tk * 128 + h * 16 + k] = i1 * 128 + i2; PW[tk * 128 + h * 16 + k] = w[k] * inv; } }
    __syncthreads();
    tid = tid_in; asm volatile("" : "+v"(tid)); lane = tid & 63;
    LAS float* HW = (LAS float*)(lds + 102400);
    const unsigned char* PU = ws + WS_PU + (size_t)l * 16384 * 2048; const unsigned char* PV = ws + WS_PV + (size_t)l * 16384 * 2048;
    const float* USC = (const float*)(ws + WS_PSC) + (size_t)l * 16384; const float* VSC = (const float*)(ws + WS_PSC) + (size_t)(DEPTH + l) * 16384;
    const float* X1 = (const float*)(ws + WS_X1);
        REP(9)
#pragma unroll 1
    for (int it = 0; it < 4; ++it) { const int tk = wave * 4 + it; const size_t n = (size_t)n0 + tk;
        float xr[32];
#pragma unroll
        for (int j = 0; j < 2; ++j)
#pragma unroll
            for (int q = 0; q < 4; ++q) { const f4 a = *(const f4*)(X1 + n * D + 1024 * j + 16 * lane + 4 * q); xr[16 * j + 4 * q] = a.x; xr[16 * j + 4 * q + 1] = a.y; xr[16 * j + 4 * q + 2] = a.z; xr[16 * j + 4 * q + 3] = a.w; }
        const LAS int* pe = PE + tk * 128; const LAS float* pw = PW + tk * 128; LAS float* hwp = HW + tk * 128;
        { u4 A[4][2], B[4][2];
            peer_load4(A, PU, pe, 0, lane);
#pragma unroll 1
            for (int g2 = 0; g2 < 16; ++g2) {
                peer_load4(B, PU, pe, 2 * g2 + 1, lane);
                peer_dot4(A, xr, USC, pe, pw, VSC, hwp, 2 * g2, lane);
                if (g2 < 15) peer_load4(A, PU, pe, 2 * g2 + 2, lane);
                peer_dot4(B, xr, USC, pe, pw, VSC, hwp, 2 * g2 + 1, lane);
            } }
        LDS_WAIT();
        float acc[32];
#pragma unroll
        for (int i = 0; i < 32; ++i) acc[i] = 0.f;
        { u4 A[4][2], B[4][2];
            peer_load4(A, PV, pe, 0, lane);
#pragma unroll 1
            for (int g2 = 0; g2 < 16; ++g2) {
                peer_load4(B, PV, pe, 2 * g2 + 1, lane);
                peer_axpy4(A, acc, hwp, 2 * g2);
                if (g2 < 15) peer_load4(A, PV, pe, 2 * g2 + 2, lane);
                peer_axpy4(B, acc, hwp, 2 * g2 + 1);
            } }
        float s = 0.f;
#pragma unroll
        for (int i = 0; i < 32; ++i) { acc[i] += ALPHA * xr[i]; s += acc[i]; }
        const float mu = wave_sum(s) * (1.f / D); float s2 = 0.f;
#pragma unroll
        for (int i = 0; i < 32; ++i) { acc[i] -= mu; s2 += acc[i] * acc[i]; }
        const float rstd = rsqrtf(wave_sum(s2) * (1.f / D) + LN_EPS);
        const float* gam = P.in[23] + (size_t)l * D; const float* bet = P.in[24] + (size_t)l * D;
        bf16* xb = (bf16*)(ws + WS_XB);
#pragma unroll
        for (int j = 0; j < 2; ++j) { const int col = 1024 * j + 16 * lane; float o[16];
#pragma unroll
            for (int q = 0; q < 4; ++q) { const f4 g4 = *(const f4*)(gam + col + 4 * q), b4 = *(const f4*)(bet + col + 4 * q);
                o[4 * q] = acc[16 * j + 4 * q] * rstd * g4.x + b4.x; o[4 * q + 1] = acc[16 * j + 4 * q + 1] * rstd * g4.y + b4.y; o[4 * q + 2] = acc[16 * j + 4 * q + 2] * rstd * g4.z + b4.z; o[4 * q + 3] = acc[16 * j + 4 * q + 3] * rstd * g4.w + b4.w;
                *(f4*)(xout + n * D + col + 4 * q) = mk_f4(o[4 * q], o[4 * q + 1], o[4 * q + 2], o[4 * q + 3]); }
            u4 p0, p1; p0.x = pk2(o[0], o[1]); p0.y = pk2(o[2], o[3]); p0.z = pk2(o[4], o[5]); p0.w = pk2(o[6], o[7]); p1.x = pk2(o[8], o[9]); p1.y = pk2(o[10], o[11]); p1.z = pk2(o[12], o[13]); p1.w = pk2(o[14], o[15]);
            *(u4*)(xb + n * D + col) = p0; *(u4*)(xb + n * D + col + 8) = p1; }
    }
    __syncthreads();
}

template <class T> __device__ __forceinline__ T* uniform_ptr(T* p) { const unsigned long long v = (unsigned long long)p; const unsigned lo = __builtin_amdgcn_readfirstlane((unsigned)v), hi = __builtin_amdgcn_readfirstlane((unsigned)(v >> 32)); return (T*)(((unsigned long long)hi << 32) | lo); }
constexpr int PH_PER_LAYER = 8, N_PHASES = 1 + DEPTH * PH_PER_LAYER;
#ifndef ONLY_PHASE
#define ONLY_PHASE -1
#endif
#define EN(i) (ONLY_PHASE < 0 || ONLY_PHASE == (i))
__global__ void __launch_bounds__(512, 2) mk_fwd(Params P) {
    extern __shared__ __attribute__((aligned(16))) unsigned char lds_raw[];
    LAS unsigned char* lds = (LAS unsigned char*)lds_raw;
    volatile LAS unsigned* MISC = (volatile LAS unsigned*)(lds + MISC_OFF);
    const int tid = threadIdx.x, lane = tid & 63, wave = __builtin_amdgcn_readfirstlane(tid >> 6);
    const int G = gridDim.x, bid = blockIdx.x;
    if (tid < 64) MISC[tid] = 0u;
    __syncthreads();
    unsigned char* const ws = uniform_ptr(P.ws);
    unsigned* ctl = (unsigned*)(ws + WS_CTL);
    const XcdBarrier bar = xcd_barrier_post(ctl + CW_BAR, MISC + 8);
    const int lo = P.ph_lo, hi = P.ph_hi;
#define IN(k) (lo <= (k) && (k) < hi)
#define LAUNDER() int tl = (wave << 6) | (int)__builtin_amdgcn_mbcnt_hi(0xffffffffu, __builtin_amdgcn_mbcnt_lo(0xffffffffu, 0u)); asm volatile("" : "+v"(tl)); const int ll = tl & 63; const int wl = __builtin_amdgcn_readfirstlane(tl >> 6); (void)ll; (void)wl
#define SEAM(k) do { if (IN((k) + 1)) xcd_barrier(bar); } while (0)
    if (IN(0) && EN(8)) { LAUNDER(); phase_prologue(P, ws, lds, tl, ll, wl); SEAM(0); }
    for (int l = 0; l < DEPTH; ++l) {
        const int pb = 1 + l * PH_PER_LAYER;
        const float* xres = (l == 0) ? P.in[0] : (const float*)(ws + WS_XC);
        float* xout = (l == DEPTH - 1) ? P.out : (float*)(ws + WS_XC);
        if (IN(pb + 0) && EN(0)) { LAUNDER();
            pg8::Gemm g{(const pg8::bf16_t*)(ws + WS_XB), (const pg8::bf16_t*)(ws + WS_WIN) + (size_t)l * INWP * D, NTOK, INWP, D};
            pg8::StaticOrder S; S.init(NTOK, INWP, G, bid);
            pg8::EpiH E{(pg8::bf16_t*)(ws + WS_H), INWP, 6, 10};
            pg8::gemm_phase<pg8::EpiH, pg8::StaticOrder, true, true>(lds, g, S, E, tl);
            SEAM(pb + 0);
        }
        if (IN(pb + 1) && EN(1)) { LAUNDER();
            REP(1) for (int u = bid; u < 240; u += G) unit_kvstate(P, ws, lds, u, tl);
            REP(1) for (int u = bid; u < 256; u += G) unit_sgu(P, ws, l, lds, u, tl, ll, wl);
            REP(1) for (int u = bid; u < 128; u += G) unit_compress_mfma(P, ws, l, lds, u, tl);
            SEAM(pb + 1);
        }
        if (IN(pb + 2) && EN(2)) { LAUNDER();
            REP(2) for (int u = bid; u < 256; u += G) unit_retention(P, ws, l, lds, u, tl);
            REP(2) for (int u = bid; u < 512; u += G) unit_nsa(P, ws, l, lds, u, tl);
            SEAM(pb + 2);
        }
        if (IN(pb + 3) && EN(3)) { LAUNDER();
            for (int r = bid * 8 + wl; r < NTOK; r += G * 8) row_mixnorm(P, ws, l, r, ll);
            SEAM(pb + 3);
        }
        if (IN(pb + 4) && EN(4)) { LAUNDER();
            pg8::Gemm g{(const pg8::bf16_t*)(ws + WS_MIXED), (const pg8::bf16_t*)(ws + WS_WOUT) + (size_t)l * D * D, NTOK, D, D};
            pg8::StaticOrder S; S.init(NTOK, D, G, bid);
            pg8::EpiRes E{(float*)(ws + WS_Z), xres, D, ALPHA};
            pg8::gemm_phase<pg8::EpiRes, pg8::StaticOrder, true, true>(lds, g, S, E, tl);
            SEAM(pb + 4);
        }
        if (IN(pb + 5) && EN(5)) { LAUNDER();
            for (int r = bid * 8 + wl; r < NTOK; r += G * 8) row_ln((const float*)(ws + WS_Z), P.in[16] + (size_t)l * D, P.in[17] + (size_t)l * D, (float*)(ws + WS_X1), (bf16*)(ws + WS_X1B), r, ll);
            SEAM(pb + 5);
        }
        if (IN(pb + 6) && EN(6)) { LAUNDER();
            pg8::Gemm g{(const pg8::bf16_t*)(ws + WS_X1B), (const pg8::bf16_t*)(ws + WS_WQ) + (size_t)l * D * D, NTOK, D, D};
            pg8::StaticOrder S; S.init(NTOK, D, G, bid);
            pg8::EpiH E{(pg8::bf16_t*)(ws + WS_QP), D, 0, 0};
            pg8::gemm_phase<pg8::EpiH, pg8::StaticOrder, true, true>(lds, g, S, E, tl);
            SEAM(pb + 6);
        }
        if (IN(pb + 7) && EN(7)) { LAUNDER();
            REP(7) for (int u = bid; u < NTOK / 32; u += G) unit_peer(P, ws, l, lds, u, tl, ll, wl, xout);
            SEAM(pb + 7);
        }
    }
#undef IN
#undef SEAM
}

#ifndef MK_ONE_LAUNCH
#define MK_ONE_LAUNCH 1
#endif
extern "C" void kernel_launch(void* const* d_in, const int* in_sizes, int n_in, void* d_out, int out_size, void* d_ws, size_t ws_size, hipStream_t stream) {
    static int grid = 0;
    if (grid == 0) {
        if (n_in != 25 || out_size != NTOK * D || ws_size < WS_END) { fprintf(stderr, "kernel_launch: unexpected shapes: n_in %d out %d ws %zu (need %zu)\n", n_in, out_size, ws_size, (size_t)WS_END); grid = -1; return; }
        int dev = 0, cus = 0, per_cu = 0;
        if (hipGetDevice(&dev) != hipSuccess || hipDeviceGetAttribute(&cus, hipDeviceAttributeMultiprocessorCount, dev) != hipSuccess) { grid = -1; return; }
        if (hipFuncSetAttribute((const void*)mk_fwd, hipFuncAttributeMaxDynamicSharedMemorySize, LDS_BYTES) != hipSuccess) { fprintf(stderr, "kernel_launch: hipFuncSetAttribute failed\n"); grid = -1; return; }
        if (hipOccupancyMaxActiveBlocksPerMultiprocessor(&per_cu, (const void*)mk_fwd, 512, LDS_BYTES) != hipSuccess || per_cu < 1) fprintf(stderr, "kernel_launch: occupancy query says %d\n", per_cu);
        (void)hipGetLastError();
        grid = cus;
    }
    if (grid < 0) return;
    (void)hipMemsetAsync((char*)d_ws + WS_CTL, 0, CTL_ZERO_BYTES, stream);
    Params p{};
    for (int i = 0; i < 25; ++i) p.in[i] = (const float*)d_in[i];
    p.out = (float*)d_out; p.ws = (unsigned char*)d_ws;
    for (int i = 0; i < 32; ++i) p.inv_rev[i] = pow(10000.0, -(double)i / 32.0) / (2.0 * 3.14159265358979323846);
    for (int h = 0; h < 4; ++h) p.lg2[h] = (float)log2(1.0 - pow(2.0, -5.0 - (double)h));
#if MK_ONE_LAUNCH
    p.ph_lo = 0; p.ph_hi = N_PHASES; p.use_bar = 1;
    hipLaunchKernelGGL(mk_fwd, dim3(grid), dim3(512), LDS_BYTES, stream, p);
#else
    for (int k = 0; k < N_PHASES; ++k) { p.ph_lo = k; p.ph_hi = k + 1; p.use_bar = 0;
        hipLaunchKernelGGL(mk_fwd, dim3(grid), dim3(512), LDS_BYTES, stream, p); }
#endif
}
```

```cpp
#include <hip/hip_runtime.h>
#include <cstdio>
#include <cstdint>
#include <cmath>
#define LAS __attribute__((address_space(3)))
namespace pg8 {
#define PG8_LAS __attribute__((address_space(3)))
typedef unsigned short bf16_t;
typedef short bf16x8 __attribute__((ext_vector_type(8)));
typedef float f32x4 __attribute__((ext_vector_type(4)));
typedef unsigned u32x4 __attribute__((ext_vector_type(4)));
constexpr int BM = 256, BK = 64, HALF = 128, HTB = HALF * BK * 2  , STAGE_BYTES = 8 * HTB, NXCD = 8, WGM = 8;

__host__ __device__ __forceinline__ int lds_byte(int r, int c) { const int st = (r >> 4) * 2 + (c >> 5), rr = r & 15, cc = c & 31, ob = rr * 64 + cc * 2; return st * 1024 + (ob ^ (((ob >> 9) & 1) << 5)); }
__host__ __device__ __forceinline__ void stage_rc(int b, int& R, int& C) { const int st = b / 1024, sb = b % 1024, swz = sb ^ (((sb >> 9) & 1) << 5); R = (st >> 1) * 16 + swz / 64; C = (st & 1) * 32 + (swz % 64) / 2; }
__host__ __device__ __forceinline__ int perm32(int rho) { const int n = rho >> 4, i = rho & 15; return 8 * (i >> 2) + 4 * n + (i & 3); }

struct Unit { int pm, pn; };
struct Gemm { const bf16_t* A; const bf16_t* Bt; int M, N, K; };

struct StaticOrder {
    int nM, nN, nwg, G, c;
    __host__ __device__ void init(int M, int N, int G_, int c_) { nM = M / BM; nN = N / BM; nwg = nM * nN; G = G_; c = c_; }
    __host__ __device__ bool next(int i, Unit& u) const {
        const long L = (long)i * G + c; if (L >= nwg) return false;
        int wgid = (int)L; { const int q = nwg / NXCD, r = nwg % NXCD, xcd = wgid % NXCD, off = wgid / NXCD; wgid = (xcd < r ? xcd * (q + 1) : r * (q + 1) + (xcd - r) * q) + off; }
        const int nig = WGM * nN, gid = wgid / nig, fm = gid * WGM, gsz = (nM - fm) < WGM ? (nM - fm) : WGM;
        u.pm = fm + ((wgid % nig) % gsz); u.pn = (wgid % nig) / gsz; return true;
    }
    __device__ __forceinline__ void a_ready(const Unit&) const {}
    __device__ __forceinline__ void done(const Unit&) const {}
};
__device__ __forceinline__ unsigned cvt_pk_bf16(float lo, float hi) { unsigned r; asm volatile("v_cvt_pk_bf16_f32 %0, %1, %2" : "=v"(r) : "v"(lo), "v"(hi)); return r; }
typedef float f32x2 __attribute__((ext_vector_type(2)));
__device__ __forceinline__ float gelu_tanh_f(float x) {
    const float u = 1.5957691216057308f * (x + 0.044715f * x * x * x);
    return x * __builtin_amdgcn_rcpf(1.0f + __expf(-u));
}
struct EpiH {
    static constexpr bool PERM = true, AFTER_DRAIN = false;
    bf16_t* O; int ldc; int act_lo, act_hi;
    __device__ __forceinline__ void operator()(const f32x4 (&acc)[2][2][4][2], const Unit& u, int wr, int wc, int fr, int fq) const {
        const int row0 = u.pm * BM + wr * 64 + fr; const int col0 = u.pn * BM + wc * 32 + 8 * fq;
        const bool act = (u.pn >= act_lo) && (u.pn < act_hi);
#pragma unroll
        for (int ai = 0; ai < 2; ++ai)
#pragma unroll
            for (int m = 0; m < 4; ++m) { bf16_t* rowp = O + (size_t)(row0 + ai * HALF + m * 16) * ldc + col0;
#pragma unroll
                for (int bj = 0; bj < 2; ++bj) { f32x4 v0 = acc[ai][bj][m][0], v1 = acc[ai][bj][m][1];
                    if (act) {
#pragma unroll
                        for (int j = 0; j < 4; ++j) { v0[j] = gelu_tanh_f(v0[j]); v1[j] = gelu_tanh_f(v1[j]); } }
                    u32x4 w; w.x = cvt_pk_bf16(v0[0], v0[1]); w.y = cvt_pk_bf16(v0[2], v0[3]); w.z = cvt_pk_bf16(v1[0], v1[1]); w.w = cvt_pk_bf16(v1[2], v1[3]);
                    *(u32x4*)(rowp + bj * HALF) = w; } }
    }
};
struct EpiRes {
    static constexpr bool PERM = false, AFTER_DRAIN = false;
    float* C; const float* X; int ldc; float alpha;
    __device__ __forceinline__ void operator()(const f32x4 (&acc)[2][2][4][2], const Unit& u, int wr, int wc, int fr, int fq) const {
        const int row0 = u.pm * BM + wr * 64 + fr, col0 = u.pn * BM + wc * 32 + 4 * fq;
#pragma unroll
        for (int ai = 0; ai < 2; ++ai)
#pragma unroll
            for (int m = 0; m < 4; ++m) { const size_t off = (size_t)(row0 + ai * HALF + m * 16) * ldc + col0;
#pragma unroll
                for (int bj = 0; bj < 2; ++bj)
#pragma unroll
                    for (int n = 0; n < 2; ++n) { const size_t o2 = off + bj * HALF + n * 16; const f32x4 xv = *(const f32x4*)(X + o2); *(f32x4*)(C + o2) = acc[ai][bj][m][n] + xv * alpha; } }
    }
};
struct EpiF32 {
    static constexpr bool PERM = false, AFTER_DRAIN = false;
    float* C; int ldc;
    __device__ __forceinline__ void operator()(const f32x4 (&acc)[2][2][4][2], const Unit& u, int wr, int wc, int fr, int fq) const {
        const int row0 = u.pm * BM + wr * 64 + fr, col0 = u.pn * BM + wc * 32 + 4 * fq;
#pragma unroll
        for (int ai = 0; ai < 2; ++ai)
#pragma unroll
            for (int m = 0; m < 4; ++m) { float* rowp = C + (size_t)(row0 + ai * HALF + m * 16) * ldc + col0;
#pragma unroll
                for (int bj = 0; bj < 2; ++bj)
#pragma unroll
                    for (int n = 0; n < 2; ++n) *(f32x4*)(rowp + bj * HALF + n * 16) = acc[ai][bj][m][n]; }
    }
};
template <class Epi, class Sched, bool ALIGN_EPI = false, bool SP2 = false>
__device__ __forceinline__ void gemm_phase(PG8_LAS unsigned char* lds, const Gemm g, const Sched& S, const Epi& E, const int tid) {
    const int wid = __builtin_amdgcn_readfirstlane(tid >> 6), lane = tid & 63, wr = wid >> 2, wc = wid & 3, fr = lane & 15, fq = lane >> 4;
    const int K = g.K, nt = K / BK;
    unsigned voffA[2], voffB[2];
#pragma unroll
    for (int i = 0; i < 2; ++i) { int R, C; stage_rc(tid * 16 + i * 8192, R, C); const int Rb = Epi::PERM ? ((R & ~31) + perm32(R & 31)) : R;
        voffA[i] = (unsigned)(R * K + C) * 2u; voffB[i] = (unsigned)(Rb * K + C) * 2u; }
    const size_t kstep = (size_t)(BK * 2);
    const size_t hstep = (size_t)HALF * K * 2;
    const size_t tstep = 2 * hstep;
    const unsigned ldsw = (unsigned)wid * 1024u;
    const int aoff = lds_byte(wr * 64 + fr, fq * 8), boff = lds_byte(wc * 32 + fr, fq * 8);
#define PG8_SA(b, h) (((b) * 2 + (h)) * HTB)
#define PG8_SB(b, h) ((4 + (b) * 2 + (h)) * HTB)
#define PG8_STAGE(bufoff, gbase, voff) do { _Pragma("unroll") for (int _i = 0; _i < 2; ++_i) \
        __builtin_amdgcn_global_load_lds((const unsigned*)((const char*)(gbase) + (voff)[_i]), (PG8_LAS unsigned*)(lds + (bufoff) + ldsw + _i * 8192), 16, 0, 0); } while (0)
#define PG8_LDA(dst, b, h) do { _Pragma("unroll") for (int m = 0; m < 4; ++m) _Pragma("unroll") for (int k = 0; k < 2; ++k) dst[m][k] = *(const PG8_LAS bf16x8*)(lds + PG8_SA(b, h) + aoff + m * 2048 + k * 1024); } while (0)
#define PG8_LDB(dst, b, h) do { _Pragma("unroll") for (int n = 0; n < 2; ++n) _Pragma("unroll") for (int k = 0; k < 2; ++k) dst[n][k] = *(const PG8_LAS bf16x8*)(lds + PG8_SB(b, h) + boff + n * 2048 + k * 1024); } while (0)
#define PG8_MMA(ai, bj, At, Bt) do { __builtin_amdgcn_s_setprio(1); _Pragma("unroll") for (int m = 0; m < 4; ++m) _Pragma("unroll") for (int n = 0; n < 2; ++n) _Pragma("unroll") for (int k = 0; k < 2; ++k) \
        acc[ai][bj][m][n] = __builtin_amdgcn_mfma_f32_16x16x32_bf16(Bt[n][k], At[m][k], acc[ai][bj][m][n], 0, 0, 0); __builtin_amdgcn_s_setprio(0); } while (0)
#define PG8_WAIT_V(n) asm volatile("s_waitcnt vmcnt(" #n ")" ::: "memory")
#define PG8_WAIT_L(n) asm volatile("s_waitcnt lgkmcnt(" #n ")" ::: "memory")
#define PG8_BAR __builtin_amdgcn_s_barrier()
#define PG8_SCHED __builtin_amdgcn_sched_barrier(0)
    Unit cur, nxt; int ui = 0;
    if (!S.next(0, cur)) return;
    f32x4 acc[2][2][4][2];
#pragma unroll
    for (int a = 0; a < 2; ++a)
#pragma unroll
        for (int b = 0; b < 2; ++b)
#pragma unroll
            for (int m = 0; m < 4; ++m)
#pragma unroll
                for (int n = 0; n < 2; ++n) acc[a][b][m][n] = (f32x4){0.f, 0.f, 0.f, 0.f};
    bf16x8 At[4][2], B0[2][2], B1[2][2];
    const char* cA = (const char*)g.A + (size_t)cur.pm * tstep; const char* cB = (const char*)g.Bt + (size_t)cur.pn * tstep;
    S.a_ready(cur);
    if constexpr (SP2) {
        PG8_STAGE(PG8_SB(0, 0), cB, voffB); PG8_STAGE(PG8_SB(0, 1), cB + hstep, voffB); PG8_STAGE(PG8_SA(0, 0), cA, voffA); PG8_STAGE(PG8_SA(0, 1), cA + hstep, voffA);
        if (wr == 1) PG8_BAR;
        PG8_WAIT_V(2); PG8_BAR;
        PG8_STAGE(PG8_SB(1, 0), cB + kstep, voffB); PG8_STAGE(PG8_SA(1, 0), cA + kstep, voffA); PG8_STAGE(PG8_SB(1, 1), cB + hstep + kstep, voffB);
        PG8_WAIT_V(6); PG8_BAR;
    } else {
        PG8_STAGE(PG8_SB(0, 0), cB, voffB); PG8_STAGE(PG8_SA(0, 0), cA, voffA); PG8_STAGE(PG8_SB(0, 1), cB + hstep, voffB); PG8_STAGE(PG8_SA(0, 1), cA + hstep, voffA);
        if (wr == 1) PG8_BAR;
        PG8_WAIT_V(4); PG8_BAR;
        PG8_STAGE(PG8_SB(1, 0), cB + kstep, voffB); PG8_STAGE(PG8_SA(1, 0), cA + kstep, voffA); PG8_STAGE(PG8_SB(1, 1), cB + hstep + kstep, voffB);
        PG8_WAIT_V(6); PG8_BAR;
    }
    for (;;) {
        const bool has_next = S.next(ui + 1, nxt);
        const char* nA = has_next ? (const char*)g.A + (size_t)nxt.pm * tstep : cA; const char* nB = has_next ? (const char*)g.Bt + (size_t)nxt.pn * tstep : cB;
        for (int t = 0; t < nt; t += 2) {
            const bool last = (t == nt - 2);
            const char* a1 = cA + (size_t)(t + 1) * kstep;
            const char* a2 = last ? nA : cA + (size_t)(t + 2) * kstep; const char* b2 = last ? nB : cB + (size_t)(t + 2) * kstep;
            const char* a3 = a2 + kstep; const char* b3 = b2 + kstep;
            if (last && has_next) S.a_ready(nxt);
            if constexpr (SP2) {
            PG8_LDB(B0, 0, 0); PG8_LDB(B1, 0, 1); PG8_SCHED; PG8_LDA(At, 0, 0); PG8_STAGE(PG8_SA(1, 1), a1 + hstep, voffA);
            PG8_WAIT_V(8); PG8_WAIT_L(0); PG8_BAR; PG8_MMA(0, 0, At, B0); PG8_MMA(0, 1, At, B1); PG8_BAR; PG8_SCHED;
            PG8_LDA(At, 0, 1); PG8_STAGE(PG8_SB(0, 0), b2, voffB); PG8_STAGE(PG8_SB(0, 1), b2 + hstep, voffB); PG8_STAGE(PG8_SA(0, 0), a2, voffA);
            PG8_WAIT_V(8); PG8_WAIT_L(0); PG8_BAR; PG8_MMA(1, 0, At, B0); PG8_MMA(1, 1, At, B1); PG8_BAR; PG8_SCHED;
            PG8_LDB(B0, 1, 0); PG8_LDB(B1, 1, 1); PG8_SCHED; PG8_LDA(At, 1, 0); PG8_STAGE(PG8_SA(0, 1), a2 + hstep, voffA);
            PG8_WAIT_V(8); PG8_WAIT_L(0); PG8_BAR; PG8_MMA(0, 0, At, B0); PG8_MMA(0, 1, At, B1); PG8_BAR; PG8_SCHED;
            PG8_LDA(At, 1, 1); PG8_STAGE(PG8_SB(1, 0), b3, voffB); PG8_STAGE(PG8_SB(1, 1), b3 + hstep, voffB); PG8_STAGE(PG8_SA(1, 0), a3, voffA);
            PG8_WAIT_V(8); PG8_WAIT_L(0); PG8_BAR; PG8_MMA(1, 0, At, B0); PG8_MMA(1, 1, At, B1); PG8_BAR; PG8_SCHED;
            } else {
            PG8_LDB(B0, 0, 0); PG8_SCHED; PG8_LDA(At, 0, 0); PG8_STAGE(PG8_SA(1, 1), a1 + hstep, voffA);
            PG8_WAIT_L(8); PG8_BAR; PG8_WAIT_L(0); PG8_MMA(0, 0, At, B0); PG8_BAR; PG8_SCHED;
            PG8_LDB(B1, 0, 1); PG8_STAGE(PG8_SB(0, 0), b2, voffB);
            PG8_BAR; PG8_WAIT_L(0); PG8_MMA(0, 1, At, B1); PG8_BAR;
            PG8_LDA(At, 0, 1); PG8_STAGE(PG8_SA(0, 0), a2, voffA);
            PG8_BAR; PG8_WAIT_L(0); PG8_MMA(1, 0, At, B0); PG8_BAR; PG8_SCHED;
            PG8_STAGE(PG8_SB(0, 1), b2 + hstep, voffB);
            PG8_WAIT_V(6); PG8_BAR; PG8_MMA(1, 1, At, B1); PG8_BAR;
            PG8_LDB(B0, 1, 0); PG8_SCHED; PG8_LDA(At, 1, 0); PG8_STAGE(PG8_SA(0, 1), a2 + hstep, voffA);
            PG8_WAIT_L(8); PG8_BAR; PG8_WAIT_L(0); PG8_MMA(0, 0, At, B0); PG8_BAR; PG8_SCHED;
            PG8_LDB(B1, 1, 1); PG8_STAGE(PG8_SB(1, 0), b3, voffB);
            PG8_BAR; PG8_WAIT_L(0); PG8_MMA(0, 1, At, B1); PG8_BAR;
            PG8_LDA(At, 1, 1); PG8_STAGE(PG8_SA(1, 0), a3, voffA);
            PG8_BAR; PG8_WAIT_L(0); PG8_MMA(1, 0, At, B0); PG8_BAR; PG8_SCHED;
            PG8_STAGE(PG8_SB(1, 1), b3 + hstep, voffB);
            PG8_WAIT_V(6); PG8_BAR; PG8_MMA(1, 1, At, B1); PG8_BAR;
            }
        }
        if constexpr (ALIGN_EPI) { if (wr == 0) PG8_BAR; }
        if constexpr (!Epi::AFTER_DRAIN) { E(acc, cur, wr, wc, fr, fq); S.done(cur); }
        if (!has_next) break;
#pragma unroll
        for (int a = 0; a < 2; ++a)
#pragma unroll
            for (int b = 0; b < 2; ++b)
#pragma unroll
                for (int m = 0; m < 4; ++m)
#pragma unroll
                    for (int n = 0; n < 2; ++n) acc[a][b][m][n] = (f32x4){0.f, 0.f, 0.f, 0.f};
        cur = nxt; cA = nA; cB = nB; ++ui;
        if constexpr (ALIGN_EPI) { if (wr == 1) PG8_BAR; }
    }
    PG8_WAIT_V(0);
    if constexpr (!ALIGN_EPI) { if (wr == 0) PG8_BAR; }
    PG8_BAR;
    if constexpr (Epi::AFTER_DRAIN) { E.fused(acc, cur, wr, wc, fr, fq, lds, wid, lane); S.done(cur); }
#undef PG8_SA
#undef PG8_SB
#undef PG8_STAGE
#undef PG8_LDA
#undef PG8_LDB
#undef PG8_MMA
#undef PG8_WAIT_V
#undef PG8_WAIT_L
#undef PG8_BAR
#undef PG8_SCHED
}
}
#define XB_TMO      128
#define XB_XCNT(j)  (256  + 64 * (j))
#define XB_XSUB(j)  (1280 + 64 * (j))
#define XB_XGEN(j)  (2304 + 64 * (j))
#define XB_TOP      3328
#define XB_TOPGEN   3392
#define XCD_BAR_WORDS 3456
#define XB_SPIN_CAP (1u << 18)

__device__ __forceinline__ unsigned xb_ld(unsigned* p)              { return __hip_atomic_load(p, __ATOMIC_RELAXED, __HIP_MEMORY_SCOPE_AGENT); }
__device__ __forceinline__ unsigned xb_add(unsigned* p, unsigned v) { return __hip_atomic_fetch_add(p, v, __ATOMIC_RELAXED, __HIP_MEMORY_SCOPE_AGENT); }
__device__ __forceinline__ unsigned xb_xcc_id() { return (unsigned)__builtin_amdgcn_s_getreg((3 << 11) | 20) & 0xFu; }
#define XB_SPIN(cond, bar) do { unsigned _sp = 0; while (cond) { __builtin_amdgcn_s_sleep(1); \
    if ((++_sp & 255u) == 0u) { if (xb_ld(&(bar)[XB_TMO])) break; if (_sp > XB_SPIN_CAP) { atomicAdd(&(bar)[XB_TMO], 1u); break; } } } } while (0)

struct XcdBarrier {
    unsigned* bar; unsigned x;
    volatile LAS unsigned* st;
};

__device__ __forceinline__ XcdBarrier xcd_barrier_post(unsigned* bar, volatile LAS unsigned* st) {
    XcdBarrier b; b.bar = bar; b.x = xb_xcc_id(); b.st = st;
    if (threadIdx.x == 0) (void)xb_add(&bar[XB_XCNT(b.x)], 1u);
    return b;
}
__device__ __forceinline__ void xcd_barrier_complete(unsigned* bar, unsigned x, unsigned& nloc, unsigned& nx) {
    const unsigned G = gridDim.x * gridDim.y * gridDim.z;
    unsigned sum, cnt, mine, sp = 0u;
    for (;;) {
        sum = 0u; cnt = 0u; mine = 0u;
#pragma unroll
        for (unsigned j = 0; j < 16; ++j) { const unsigned c = xb_ld(&bar[XB_XCNT(j)]); sum += c; cnt += (c > 0u) ? 1u : 0u; mine = (j == x) ? c : mine; }
        if (sum == G) break;
        __builtin_amdgcn_s_sleep(1);
        if ((++sp & 255u) == 0u) { if (xb_ld(&bar[XB_TMO])) break; if (sp > XB_SPIN_CAP) { atomicAdd(&bar[XB_TMO], 1u); break; } }
    }
    nloc = mine > 0u ? mine : 1u; nx = cnt > 0u ? cnt : 1u;
}

__device__ __forceinline__ void xcd_barrier(const XcdBarrier& b) {
    asm volatile("s_waitcnt vmcnt(0)" ::: "memory");
    __syncthreads();
    if (threadIdx.x == 0) {
        unsigned* bar = b.bar;
        __builtin_amdgcn_s_waitcnt(0);
        unsigned nloc = b.st[0], nx = b.st[1];
        if (nloc == 0u) { xcd_barrier_complete(bar, b.x, nloc, nx); b.st[0] = nloc; b.st[1] = nx; }
        const unsigned old = xb_add(&bar[XB_XSUB(b.x)], 1u);
        const unsigned gen = old / nloc;
        if (old + 1u == (gen + 1u) * nloc) {
            __builtin_amdgcn_fence(__ATOMIC_RELEASE, "agent");
            asm volatile("s_waitcnt vmcnt(0)" ::: "memory");
            const unsigned og = xb_add(&bar[XB_TOP], 1u);
            const unsigned tg = og / nx;
            if (og + 1u == (tg + 1u) * nx) xb_add(&bar[XB_TOPGEN], 1u);
            else XB_SPIN(xb_ld(&bar[XB_TOPGEN]) == tg, bar);
            __builtin_amdgcn_fence(__ATOMIC_ACQUIRE, "agent");
            xb_add(&bar[XB_XGEN(b.x)], 1u);
            asm volatile("s_waitcnt vmcnt(0)" ::: "memory");
        } else {
            XB_SPIN(xb_ld(&bar[XB_XGEN(b.x)]) == gen, bar);
            __builtin_amdgcn_fence(__ATOMIC_ACQUIRE, "agent");
            asm volatile("s_waitcnt vmcnt(0)" ::: "memory");
        }
    }
    __syncthreads();
}

#ifndef PROBE_DUP
#define PROBE_DUP -1
#endif
#define REP(i) for (int rep_ = 0; rep_ < ((PROBE_DUP == (i)) ? 2 : 1); ++rep_)
constexpr int NB = 4, T = 2048, D = 2048, NTOK = NB * T, DEPTH = 4;
constexpr int INW = 5168, INWP = 5376;
constexpr int C_RQ = 0, C_RK = 256, C_RV = 512, C_RG = 1024, C_SU = 1536, C_SV = 2048, C_NQ = 2560, C_KC = 3584, C_VC = 3840, C_KS = 4096, C_VS = 4352, C_KW = 4608, C_VW = 4864, C_NG = 5120;
constexpr float ALPHA = 1.6817928305074290f;
constexpr float LN_EPS = 1e-5f;
constexpr float LOG2E = 1.4426950408889634f;

constexpr size_t MiB = (size_t)1 << 20;
constexpr size_t WS_CTL = 0, CTL_ZERO_BYTES = 1 * MiB;
constexpr size_t WS_ROPE = 1 * MiB;
constexpr size_t WS_WIN = 2 * MiB;
constexpr size_t WS_WOUT = 86 * MiB;
constexpr size_t WS_WQ = 118 * MiB;
constexpr size_t WS_PU = 160 * MiB;
constexpr size_t WS_PV = 416 * MiB;
constexpr size_t WS_H = 672 * MiB;
constexpr size_t WS_YMIX = 756 * MiB;
constexpr size_t WS_MIXED = 820 * MiB;
constexpr size_t WS_Z = 852 * MiB;
constexpr size_t WS_X1 = 916 * MiB;
constexpr size_t WS_X1B = 980 * MiB;
constexpr size_t WS_QP = 1012 * MiB;
constexpr size_t WS_XC = 1076 * MiB;
constexpr size_t WS_XB = 1140 * MiB;
constexpr size_t WS_KC = 1172 * MiB;
constexpr size_t WS_KVST = 1174 * MiB;
constexpr size_t WS_SC = 1184 * MiB;
constexpr size_t WS_PSC = 1248 * MiB;
constexpr size_t WS_W1T = 1250 * MiB;
constexpr size_t WS_W2T = 1258 * MiB;
constexpr size_t WS_PKB = 1260 * MiB;
constexpr size_t WS_END = 1262 * MiB;
constexpr int CW_BAR = 4096;

constexpr int LDS_BYTES = 147456;
constexpr int MISC_OFF = 143360;

#define GAS __attribute__((address_space(1)))
typedef float f4 __attribute__((ext_vector_type(4)));
typedef float f2 __attribute__((ext_vector_type(2)));
typedef unsigned u4 __attribute__((ext_vector_type(4)));
typedef unsigned u2 __attribute__((ext_vector_type(2)));
__device__ __forceinline__ f4 mk_f4(float a, float b, float c, float d) { f4 r; r.x = a; r.y = b; r.z = c; r.w = d; return r; }
__device__ __forceinline__ f2 mk_f2(float a, float b) { f2 r; r.x = a; r.y = b; return r; }
__device__ __forceinline__ u2 mk_u2(unsigned a, unsigned b) { u2 r; r.x = a; r.y = b; return r; }
typedef unsigned short bf16;
#define LDS_WAIT() asm volatile("s_waitcnt lgkmcnt(0)" ::: "memory")
#define VM_WAIT() asm volatile("s_waitcnt vmcnt(0)" ::: "memory")

struct Params {
    const float* in[25];
    float* out;
    unsigned char* ws;
    double inv_rev[32];
    float lg2[4];
    int ph_lo, ph_hi, use_bar, pad0;
};

__device__ __forceinline__ float bf2f(unsigned short b) { return __uint_as_float(((unsigned)b) << 16); }
__device__ __forceinline__ unsigned f2bf(float f) { unsigned u = __float_as_uint(f); return (u + 0x7fffu + ((u >> 16) & 1u)) >> 16; }
__device__ __forceinline__ unsigned pk2(float lo, float hi) { return f2bf(lo) | (f2bf(hi) << 16); }
__device__ __forceinline__ float wave_sum(float v) {
#pragma unroll
    for (int o = 1; o < 64; o <<= 1) v += __shfl_xor(v, o);
    return v;
}
__device__ __forceinline__ void unpack8(const u4& v, float* f) {
    f[0] = __uint_as_float(v.x << 16); f[1] = __uint_as_float(v.x & 0xffff0000u);
    f[2] = __uint_as_float(v.y << 16); f[3] = __uint_as_float(v.y & 0xffff0000u);
    f[4] = __uint_as_float(v.z << 16); f[5] = __uint_as_float(v.z & 0xffff0000u);
    f[6] = __uint_as_float(v.w << 16); f[7] = __uint_as_float(v.w & 0xffff0000u);
}
__device__ __forceinline__ float gelu_tanh(float x) { return pg8::gelu_tanh_f(x); }

__device__ __forceinline__ void transpose_tile(const float* __restrict__ W, int K, int N, bf16* __restrict__ WT, LAS float* scr, int kb, int nb, int lane) {
    const int k0 = kb * 64, n0 = nb * 32, nn = lane & 31; const bool ok = (n0 + nn) < N;
#pragma unroll 8
    for (int i = 0; i < 32; ++i) { const int kk = 2 * i + (lane >> 5); scr[kk * 33 + nn] = ok ? W[(size_t)(k0 + kk) * N + n0 + nn] : 0.f; }
    LDS_WAIT();
    const int c = lane & 7;
#pragma unroll
    for (int j = 0; j < 4; ++j) { const int n = (lane >> 3) + 8 * j; const LAS float* s = scr + (8 * c) * 33 + n;
        u4 o; o.x = pk2(s[0 * 33], s[1 * 33]); o.y = pk2(s[2 * 33], s[3 * 33]); o.z = pk2(s[4 * 33], s[5 * 33]); o.w = pk2(s[6 * 33], s[7 * 33]);
        *(u4*)(WT + (size_t)(n0 + n) * K + k0 + 8 * c) = o; }
    LDS_WAIT();
}
__device__ __forceinline__ void cvt_bf16_stream(const float* __restrict__ src, bf16* __restrict__ dst, size_t nchunks, size_t gt, size_t GT) {
    for (size_t c = gt; c < nchunks; c += GT) { const f4 a = ((const f4*)src)[2 * c], b = ((const f4*)src)[2 * c + 1];
        u4 o; o.x = pk2(a.x, a.y); o.y = pk2(a.z, a.w); o.z = pk2(b.x, b.y); o.w = pk2(b.z, b.w); ((u4*)dst)[c] = o; }
}
__device__ __forceinline__ void phase_prologue(const Params& P, unsigned char* ws, LAS unsigned char* lds, int tid, int lane, int wave) {
    LAS float* scr = (LAS float*)(lds + wave * 8704);
    const int gw = blockIdx.x * 8 + wave, NGW = gridDim.x * 8;
    constexpr int I_IN = 32 * 168, I_SQ = 32 * 64, I_L = I_IN + 2 * I_SQ;
    for (int it = gw; it < DEPTH * I_L; it += NGW) {
        const int l = it / I_L; int r = it % I_L;
        if (r < I_IN) transpose_tile(P.in[1] + (size_t)l * D * INW, D, INW, (bf16*)(ws + WS_WIN) + (size_t)l * INWP * D, scr, r / 168, r % 168, lane);
        else { r -= I_IN;
            if (r < I_SQ) transpose_tile(P.in[15] + (size_t)l * D * D, D, D, (bf16*)(ws + WS_WOUT) + (size_t)l * D * D, scr, r / 64, r % 64, lane);
            else { r -= I_SQ; transpose_tile(P.in[18] + (size_t)l * D * D, D, D, (bf16*)(ws + WS_WQ) + (size_t)l * D * D, scr, r / 64, r % 64, lane); } }
    }
    for (int it = gw; it < DEPTH * 2 * (32 * 8 + 4 * 2); it += NGW) {
        const int lk = it / 264, r = it % 264, l = lk >> 1, kv = lk & 1;
        if (r < 256) transpose_tile(P.in[kv ? 12 : 9] + (size_t)l * 2048 * 256, 2048, 256, (bf16*)(ws + WS_W1T) + (size_t)lk * 256 * 2048, scr, r >> 3, r & 7, lane);
        else transpose_tile(P.in[kv ? 13 : 10] + (size_t)l * 256 * 64, 256, 64, (bf16*)(ws + WS_W2T) + (size_t)lk * 64 * 256, scr, (r - 256) >> 1, (r - 256) & 1, lane);
    }
    const size_t gt = (size_t)blockIdx.x * 512 + tid, GT = (size_t)gridDim.x * 512;
    for (int row = gw; row < 2 * DEPTH * 16384; row += NGW) {
        const int tab = row / (DEPTH * 16384), rr = row % (DEPTH * 16384);
        const float* src = P.in[21 + tab] + (size_t)rr * 2048;
        f4 v[8]; float am = 0.f;
#pragma unroll
        for (int j = 0; j < 2; ++j)
#pragma unroll
            for (int q = 0; q < 4; ++q) { const f4 a = *(const f4*)(src + 1024 * j + 16 * lane + 4 * q); v[4 * j + q] = a; am = fmaxf(am, fmaxf(fmaxf(fabsf(a.x), fabsf(a.y)), fmaxf(fabsf(a.z), fabsf(a.w)))); }
#pragma unroll
        for (int o = 1; o < 64; o <<= 1) am = fmaxf(am, __shfl_xor(am, o));
        const float sc = (am > 0.f) ? 448.f / am : 1.f;
        if (lane == 0) ((float*)(ws + WS_PSC))[row] = (am > 0.f) ? am * (1.f / 448.f) : 1.f;
        unsigned char* dst = ws + (tab ? WS_PV : WS_PU) + (size_t)rr * 2048;
#pragma unroll
        for (int j = 0; j < 2; ++j) { u4 w;
#pragma unroll
            for (int q = 0; q < 4; ++q) { const f4 a = v[4 * j + q]; int r = __builtin_amdgcn_cvt_pk_fp8_f32(a.x * sc, a.y * sc, 0, false); r = __builtin_amdgcn_cvt_pk_fp8_f32(a.z * sc, a.w * sc, r, true); w[q] = (unsigned)r; }
            *(u4*)(dst + 1024 * j + 16 * lane) = w; }
    }
    cvt_bf16_stream(P.in[0], (bf16*)(ws + WS_XB), (size_t)NTOK * D / 8, gt, GT);
    cvt_bf16_stream(P.in[19], (bf16*)(ws + WS_PKB), (size_t)DEPTH * 8 * 128 * 128 / 8, gt, GT);
    cvt_bf16_stream(P.in[20], (bf16*)(ws + WS_PKB) + (size_t)DEPTH * 8 * 128 * 128, (size_t)DEPTH * 8 * 128 * 128 / 8, gt, GT);
    f2* rope = (f2*)(ws + WS_ROPE);
    for (size_t idx = gt; idx < (size_t)T * 32; idx += GT) { const int t = (int)(idx >> 5), i = (int)(idx & 31);
        double a = (double)t * P.inv_rev[i]; a -= floor(a); const float fr = (float)a;
        rope[idx] = mk_f2(__builtin_amdgcn_cosf(fr), __builtin_amdgcn_sinf(fr)); }
}

__device__ __forceinline__ void stage_rot_k(const bf16* __restrict__ Hb, const f2* __restrict__ rope, LAS float* ks, int tok0, int tpos0, int colK, float lg2h, bool zeta, int tid) {
    const int m = tid >> 2, p = tid & 3;
    const bf16* src = Hb + (size_t)(tok0 + m) * INWP + colK + p * 8;
    const u4 a = *(const u4*)src, b = *(const u4*)(src + 32);
    float x1[8], x2[8]; unpack8(a, x1); unpack8(b, x2);
    const f4* rp = (const f4*)(rope + (size_t)(tpos0 + m) * 32 + p * 8);
    const f4 r0 = rp[0], r1 = rp[1], r2 = rp[2], r3 = rp[3];
    const float cs[8] = {r0.x, r0.z, r1.x, r1.z, r2.x, r2.z, r3.x, r3.z}, sn[8] = {r0.y, r0.w, r1.y, r1.w, r2.y, r2.w, r3.y, r3.w};
    const float sc = 0.125f * (zeta ? exp2f(lg2h * (float)(127 - m)) : 1.0f);
    float o1[8], o2[8];
#pragma unroll
    for (int i = 0; i < 8; ++i) { o1[i] = (x1[i] * cs[i] - x2[i] * sn[i]) * sc; o2[i] = (x1[i] * sn[i] + x2[i] * cs[i]) * sc; }
    LAS f4* d1 = (LAS f4*)(ks + m * 64 + p * 8); LAS f4* d2 = (LAS f4*)(ks + m * 64 + 32 + p * 8);
    d1[0] = mk_f4(o1[0], o1[1], o1[2], o1[3]); d1[1] = mk_f4(o1[4], o1[5], o1[6], o1[7]);
    d2[0] = mk_f4(o2[0], o2[1], o2[2], o2[3]); d2[1] = mk_f4(o2[4], o2[5], o2[6], o2[7]);
}
__device__ __forceinline__ void stage_v128(const bf16* __restrict__ Hb, LAS float* vs, int tok0, int colV, int tid) {
    const int m = tid >> 2, p = tid & 3;
    const u4* src = (const u4*)(Hb + (size_t)(tok0 + m) * INWP + colV + p * 32);
    LAS f4* dst = (LAS f4*)(vs + m * 128 + p * 32);
#pragma unroll
    for (int j = 0; j < 4; ++j) { const u4 a = src[j]; float f[8]; unpack8(a, f); dst[2 * j] = mk_f4(f[0], f[1], f[2], f[3]); dst[2 * j + 1] = mk_f4(f[4], f[5], f[6], f[7]); }
}

__device__ __forceinline__ void unit_kvstate(const Params& P, unsigned char* ws, LAS unsigned char* lds, int u, int tid) {
    const int b = u / 60, r = u % 60, h = r / 15, j = r % 15;
    const bf16* Hb = (const bf16*)(ws + WS_H); const f2* rope = (const f2*)(ws + WS_ROPE);
    LAS float* ks = (LAS float*)lds; LAS float* vs = (LAS float*)(lds + 32768);
    const int tok0 = b * T + j * 128;
    stage_rot_k(Hb, rope, ks, tok0, j * 128, C_RK + h * 64, P.lg2[h], true, tid);
    stage_v128(Hb, vs, tok0, C_RV + h * 128, tid);
    __syncthreads();
    const int d = tid >> 3, e0 = (tid & 7) * 16;
    float acc[16];
#pragma unroll
    for (int i = 0; i < 16; ++i) acc[i] = 0.f;
    #pragma unroll 1
    for (int m = 0; m < 128; ++m) { const float kd = ks[m * 64 + d]; const LAS f4* vp = (const LAS f4*)(vs + m * 128 + e0);
#pragma unroll
        for (int q = 0; q < 4; ++q) { const f4 v = vp[q]; acc[4 * q] += kd * v.x; acc[4 * q + 1] += kd * v.y; acc[4 * q + 2] += kd * v.z; acc[4 * q + 3] += kd * v.w; } }
    f4* dst = (f4*)((float*)(ws + WS_KVST) + ((size_t)((b * 4 + h) * 16 + j) * 64 + d) * 128 + e0);
#pragma unroll
    for (int q = 0; q < 4; ++q) dst[q] = mk_f4(acc[4 * q], acc[4 * q + 1], acc[4 * q + 2], acc[4 * q + 3]);
    __syncthreads();
}

__device__ __forceinline__ void unit_sgu(const Params& P, unsigned char* ws, int l, LAS unsigned char* lds, int u, int tid, int lane, int wave) {
    const int b = u >> 6, c = (u >> 2) & 15, g = u & 3;
    const bf16* Hb = (const bf16*)(ws + WS_H);
    LAS float* vn = (LAS float*)lds;
    LAS float* wsm = (LAS float*)(lds + 65536);
    const int tok0 = b * T + c * 128;
    const float* lng = P.in[4] + l * 512 + g * 128; const float* lnb = P.in[5] + l * 512 + g * 128;
    const float g0 = lng[2 * lane], g1 = lng[2 * lane + 1], b0 = lnb[2 * lane], b1 = lnb[2 * lane + 1];
    for (int i = 0; i < 16; ++i) { const int s = wave * 16 + i;
        const unsigned pr = *(const unsigned*)(Hb + (size_t)(tok0 + s) * INWP + C_SV + g * 128 + 2 * lane);
        const float v0 = __uint_as_float(pr << 16), v1 = __uint_as_float(pr & 0xffff0000u);
        const float mu = wave_sum(v0 + v1) * (1.f / 128.f); const float d0 = v0 - mu, d1 = v1 - mu;
        const float var = wave_sum(d0 * d0 + d1 * d1) * (1.f / 128.f); const float rstd = rsqrtf(var + LN_EPS);
        *(LAS f2*)(vn + s * 128 + 2 * lane) = mk_f2(d0 * rstd * g0 + b0, d1 * rstd * g1 + b1); }
    const float* wg = P.in[6] + ((size_t)l * 4 + g) * 16384;
    for (int i = 0; i < 32; ++i) { const int idx = tid + 512 * i; wsm[(idx >> 7) * 129 + (idx & 127)] = wg[idx]; }
    __syncthreads();
    const int t = tid >> 2, dg = tid & 3; const int smax = (t | 15);
    float acc[32];
#pragma unroll
    for (int i = 0; i < 32; ++i) acc[i] = 0.f;
    #pragma unroll 1
    for (int s = 0; s <= smax; ++s) { const float wv = (s <= t) ? wsm[t * 129 + s] : 0.f; const LAS f4* vp = (const LAS f4*)(vn + s * 128 + dg * 32);
#pragma unroll
        for (int q = 0; q < 8; ++q) { const f4 v = vp[q]; acc[4 * q] += wv * v.x; acc[4 * q + 1] += wv * v.y; acc[4 * q + 2] += wv * v.z; acc[4 * q + 3] += wv * v.w; } }
    const float bs = P.in[7][(l * 4 + g) * 128 + t];
    const u4* up = (const u4*)(Hb + (size_t)(tok0 + t) * INWP + C_SU + g * 128 + dg * 32);
    f4* yo = (f4*)((float*)(ws + WS_YMIX) + (size_t)(tok0 + t) * D + 512 + g * 128 + dg * 32);
#pragma unroll
    for (int j = 0; j < 4; ++j) { const u4 a = up[j]; float f[8]; unpack8(a, f);
        yo[2 * j] = mk_f4(f[0] * (acc[8 * j] + bs), f[1] * (acc[8 * j + 1] + bs), f[2] * (acc[8 * j + 2] + bs), f[3] * (acc[8 * j + 3] + bs));
        yo[2 * j + 1] = mk_f4(f[4] * (acc[8 * j + 4] + bs), f[5] * (acc[8 * j + 5] + bs), f[6] * (acc[8 * j + 6] + bs), f[7] * (acc[8 * j + 7] + bs)); }
    __syncthreads();
}

__device__ __forceinline__ void unit_compress(const Params& P, unsigned char* ws, int l, LAS unsigned char* lds, int u, int tid) {
    const int kv = u >> 7, b = (u >> 5) & 3, g = (u >> 3) & 3, r = u & 7;
    const bf16* Hb = (const bf16*)(ws + WS_H);
    LAS float* seg = (LAS float*)lds;
    LAS float* hid = (LAS float*)(lds + 69632);
    const int col0 = (kv ? C_VC : C_KC) + g * 64;
    const float* pe = P.in[kv ? 11 : 8] + (size_t)l * 2048;
    const float* w1 = P.in[kv ? 12 : 9] + (size_t)l * 2048 * 256;
    const float* w2 = P.in[kv ? 13 : 10] + (size_t)l * 256 * 64;
    for (int idx = tid; idx < 272 * 8; idx += 512) { const int tt = idx >> 3, d8 = (idx & 7) * 8; const int t = 256 * r + tt;
        float f[8];
        if (t < T) { const u4 a = *(const u4*)(Hb + (size_t)(b * T + t) * INWP + col0 + d8); unpack8(a, f); }
        else {
#pragma unroll
            for (int i = 0; i < 8; ++i) f[i] = 0.f; }
        LAS f4* dp = (LAS f4*)(seg + tt * 64 + d8); dp[0] = mk_f4(f[0], f[1], f[2], f[3]); dp[1] = mk_f4(f[4], f[5], f[6], f[7]); }
    __syncthreads();
    const int j = tid & 255, hb = tid >> 8;
    float acc[8], accpe = 0.f;
#pragma unroll
    for (int i = 0; i < 8; ++i) acc[i] = 0.f;
    for (int pos = 0; pos < 32; ++pos) {
#pragma unroll 2
        for (int d4 = 0; d4 < 16; ++d4) { const int kk = pos * 64 + d4 * 4;
            const float w0 = w1[(size_t)(kk + 0) * 256 + j], w1v = w1[(size_t)(kk + 1) * 256 + j], w2v = w1[(size_t)(kk + 2) * 256 + j], w3 = w1[(size_t)(kk + 3) * 256 + j];
            const f4 p4 = *(const f4*)(pe + kk);
            accpe += w0 * p4.x + w1v * p4.y + w2v * p4.z + w3 * p4.w;
#pragma unroll
            for (int ib = 0; ib < 8; ++ib) { const f4 s4 = *(const LAS f4*)(seg + (16 * (hb * 8 + ib) + pos) * 64 + d4 * 4);
                acc[ib] += w0 * s4.x + w1v * s4.y + w2v * s4.z + w3 * s4.w; } } }
#pragma unroll
    for (int ib = 0; ib < 8; ++ib) hid[(hb * 8 + ib) * 256 + j] = gelu_tanh(acc[ib] + accpe);
    __syncthreads();
    { const int i = tid >> 5, o2 = (tid & 31) * 2; float a0 = 0.f, a1 = 0.f;
        for (int jj = 0; jj < 256; ++jj) { const float hv = hid[i * 256 + jj]; const f2 w = *(const f2*)(w2 + jj * 64 + o2); a0 += hv * w.x; a1 += hv * w.y; }
        const int ci = 16 * r + i;
        if (ci <= 126) *(f2*)((float*)(ws + WS_KC) + ((size_t)((kv * 4 + b) * 4 + g) * 128 + ci) * 64 + o2) = mk_f2(a0, a1); }
    __syncthreads();
}

__device__ __forceinline__ void unit_retention(const Params& P, unsigned char* ws, int l, LAS unsigned char* lds, int u, int tid) {
    const int b = u >> 6, h = (u >> 4) & 3, c = u & 15;
    const bf16* Hb = (const bf16*)(ws + WS_H); const f2* rope = (const f2*)(ws + WS_ROPE);
    LAS float* regB = (LAS float*)lds;
    LAS float* vs = (LAS float*)(lds + 32768);
    LAS float* Qs = (LAS float*)(lds + 98304);
    const float lg2h = P.lg2[h];
    const int tok0 = b * T + c * 128;
    { float a[16];
#pragma unroll
        for (int i = 0; i < 16; ++i) a[i] = 0.f;
        const float* kvb = (const float*)(ws + WS_KVST) + (size_t)((b * 4 + h) * 16) * 8192 + tid * 16;
#pragma unroll 1
        for (int j = 0; j < c; ++j) { const float w = exp2f(lg2h * 128.f * (float)(c - 1 - j)); const f4* sp = (const f4*)(kvb + (size_t)j * 8192);
#pragma unroll
            for (int q = 0; q < 4; ++q) { const f4 v = sp[q]; a[4 * q] += w * v.x; a[4 * q + 1] += w * v.y; a[4 * q + 2] += w * v.z; a[4 * q + 3] += w * v.w; } }
        LAS f4* dp = (LAS f4*)(regB + tid * 16);
#pragma unroll
        for (int q = 0; q < 4; ++q) dp[q] = mk_f4(a[4 * q], a[4 * q + 1], a[4 * q + 2], a[4 * q + 3]); }
    const int n = tid >> 2, eg = tid & 3;
    float qa[8], qb[8];
    { const bf16* src = Hb + (size_t)(tok0 + n) * INWP + C_RQ + h * 64 + eg * 8;
        const u4 a = *(const u4*)src, bb = *(const u4*)(src + 32);
        float x1[8], x2[8]; unpack8(a, x1); unpack8(bb, x2);
        const f4* rp = (const f4*)(rope + (size_t)(c * 128 + n) * 32 + eg * 8);
        const f4 r0 = rp[0], r1 = rp[1], r2 = rp[2], r3 = rp[3];
        const float cs[8] = {r0.x, r0.z, r1.x, r1.z, r2.x, r2.z, r3.x, r3.z}, sn[8] = {r0.y, r0.w, r1.y, r1.w, r2.y, r2.w, r3.y, r3.w};
#pragma unroll
        for (int i = 0; i < 8; ++i) { qa[i] = x1[i] * cs[i] - x2[i] * sn[i]; qb[i] = x1[i] * sn[i] + x2[i] * cs[i]; Qs[n * 65 + eg * 8 + i] = qa[i]; Qs[n * 65 + 32 + eg * 8 + i] = qb[i]; } }
    __syncthreads();
    float acc[32];
#pragma unroll
    for (int i = 0; i < 32; ++i) acc[i] = 0.f;
#pragma unroll 2
    for (int d = 0; d < 64; ++d) { const float qd = Qs[n * 65 + d]; const LAS f4* sp = (const LAS f4*)(regB + d * 128 + eg * 32);
#pragma unroll
        for (int qq = 0; qq < 8; ++qq) { const f4 v = sp[qq]; acc[4 * qq] += qd * v.x; acc[4 * qq + 1] += qd * v.y; acc[4 * qq + 2] += qd * v.z; acc[4 * qq + 3] += qd * v.w; } }
    { const float xi = exp2f(lg2h * (float)(n + 1));
#pragma unroll
        for (int i = 0; i < 32; ++i) acc[i] *= xi; }
    __syncthreads();
    stage_rot_k(Hb, rope, regB, tok0, c * 128, C_RK + h * 64, lg2h, false, tid);
    stage_v128(Hb, vs, tok0, C_RV + h * 128, tid);
    __syncthreads();
    const int mmax = n | 15;
#pragma unroll 1
    for (int m = 0; m <= mmax; ++m) { const LAS f4* kp = (const LAS f4*)(regB + m * 64 + eg * 8); const LAS f4* kp2 = (const LAS f4*)(regB + m * 64 + 32 + eg * 8);
        const f4 k0 = kp[0], k1 = kp[1], k2 = kp2[0], k3 = kp2[1];
        float s = ((qa[0] * k0.x + qa[1] * k0.y) + (qa[2] * k0.z + qa[3] * k0.w)) + ((qa[4] * k1.x + qa[5] * k1.y) + (qa[6] * k1.z + qa[7] * k1.w))
                + ((qb[0] * k2.x + qb[1] * k2.y) + (qb[2] * k2.z + qb[3] * k2.w)) + ((qb[4] * k3.x + qb[5] * k3.y) + (qb[6] * k3.z + qb[7] * k3.w));
        s += __shfl_xor(s, 1); s += __shfl_xor(s, 2);
        const float a = (m <= n) ? s * exp2f(lg2h * (float)(n - m)) : 0.f;
        const LAS f4* vp = (const LAS f4*)(vs + m * 128 + eg * 32);
#pragma unroll
        for (int qq = 0; qq < 8; ++qq) { const f4 v = vp[qq]; acc[4 * qq] += a * v.x; acc[4 * qq + 1] += a * v.y; acc[4 * qq + 2] += a * v.z; acc[4 * qq + 3] += a * v.w; } }
    float s1 = 0.f;
#pragma unroll
    for (int i = 0; i < 32; ++i) s1 += acc[i];
    s1 += __shfl_xor(s1, 1); s1 += __shfl_xor(s1, 2);
    const float mu = s1 * (1.f / 128.f); float s2 = 0.f;
#pragma unroll
    for (int i = 0; i < 32; ++i) { const float dd = acc[i] - mu; s2 += dd * dd; }
    s2 += __shfl_xor(s2, 1); s2 += __shfl_xor(s2, 2);
    const float rstd = rsqrtf(s2 * (1.f / 128.f) + LN_EPS);
    const float* gg = P.in[2] + l * 512 + h * 128 + eg * 32; const float* gb = P.in[3] + l * 512 + h * 128 + eg * 32;
    const u4* gp = (const u4*)(Hb + (size_t)(tok0 + n) * INWP + C_RG + h * 128 + eg * 32);
    f4* yo = (f4*)((float*)(ws + WS_YMIX) + (size_t)(tok0 + n) * D + h * 128 + eg * 32);
#pragma unroll
    for (int j = 0; j < 4; ++j) { const u4 a = gp[j]; float f[8]; unpack8(a, f); float o[8];
#pragma unroll
        for (int i = 0; i < 8; ++i) { const float y = (acc[8 * j + i] - mu) * rstd * gg[8 * j + i] + gb[8 * j + i]; const float gv = f[i]; o[i] = y * gv * __builtin_amdgcn_rcpf(1.f + __expf(-gv)); }
        yo[2 * j] = mk_f4(o[0], o[1], o[2], o[3]); yo[2 * j + 1] = mk_f4(o[4], o[5], o[6], o[7]); }
    __syncthreads();
}

typedef pg8::bf16x8 bf16x8;
typedef short s16x4 __attribute__((ext_vector_type(4)));
typedef __bf16 bf16x2_t __attribute__((ext_vector_type(2)));
__device__ __forceinline__ unsigned pkbf(float a, float b) { f2 v; v.x = a; v.y = b; return __builtin_bit_cast(unsigned, __builtin_convertvector(v, bf16x2_t)); }
#define MFMA16(a, b, c) __builtin_amdgcn_mfma_f32_16x16x32_bf16((a), (b), (c), 0, 0, 0)
constexpr int NS = 80;
constexpr float NSA_SC = 0.125f * LOG2E;
__device__ __forceinline__ void nsa_scores(f4 (&st)[4][2], const LAS bf16* Kl, const bf16x8 (&Yq)[2][2], int lane) {
    const int r = lane & 15, kq = lane >> 4;
#pragma unroll
    for (int kt = 0; kt < 4; ++kt) { const LAS bf16* kp = Kl + (16 * kt + r) * NS + 8 * kq;
        const bf16x8 k0 = *(const LAS bf16x8*)kp, k1 = *(const LAS bf16x8*)(kp + 32);
#pragma unroll
        for (int qp = 0; qp < 2; ++qp) { f4 a = mk_f4(0.f, 0.f, 0.f, 0.f); a = MFMA16(k0, Yq[qp][0], a); a = MFMA16(k1, Yq[qp][1], a); st[kt][qp] = a; } }
}
__device__ __forceinline__ void nsa_softmax_pv(f4 (&st)[4][2], float (&m)[2], float (&l)[2], f4 (&ot)[4][2], const LAS bf16* Vl, const int (&lo)[2], const int (&hi)[2], bool need_mask, int lane) {
    const int kq = lane >> 4, q = (lane & 15) >> 2, p = lane & 3;
    bf16x8 Pf[2][2];
#pragma unroll
    for (int qp = 0; qp < 2; ++qp) {
        if (need_mask) {
#pragma unroll
            for (int kt = 0; kt < 4; ++kt)
#pragma unroll
                for (int i = 0; i < 4; ++i) { const int kl = 16 * kt + 4 * kq + i; if (kl < lo[qp] || kl > hi[qp]) st[kt][qp][i] = -1e30f; } }
        float mx = st[0][qp][0];
#pragma unroll
        for (int kt = 0; kt < 4; ++kt)
#pragma unroll
            for (int i = 0; i < 4; ++i) mx = fmaxf(mx, st[kt][qp][i]);
        mx = fmaxf(mx, __shfl_xor(mx, 16)); mx = fmaxf(mx, __shfl_xor(mx, 32));
        const float mn = fmaxf(m[qp], mx); const float corr = __builtin_amdgcn_exp2f((m[qp] - mn) * NSA_SC); m[qp] = mn; l[qp] *= corr;
#pragma unroll
        for (int dt = 0; dt < 4; ++dt) ot[dt][qp] *= corr;
        const float msc = mn * NSA_SC; float ps = 0.f;
#pragma unroll
        for (int kt = 0; kt < 4; ++kt)
#pragma unroll
            for (int i = 0; i < 4; ++i) { const float pv = __builtin_amdgcn_exp2f(st[kt][qp][i] * NSA_SC - msc); st[kt][qp][i] = pv; ps += pv; }
        l[qp] += ps;
#pragma unroll
        for (int ksp = 0; ksp < 2; ++ksp) { u4 w; w.x = pkbf(st[2 * ksp][qp][0], st[2 * ksp][qp][1]); w.y = pkbf(st[2 * ksp][qp][2], st[2 * ksp][qp][3]);
            w.z = pkbf(st[2 * ksp + 1][qp][0], st[2 * ksp + 1][qp][1]); w.w = pkbf(st[2 * ksp + 1][qp][2], st[2 * ksp + 1][qp][3]); Pf[qp][ksp] = __builtin_bit_cast(bf16x8, w); }
    }
#pragma unroll
    for (int dt = 0; dt < 4; ++dt)
#pragma unroll
        for (int ksp = 0; ksp < 2; ++ksp) { const LAS bf16* vp = Vl + (32 * ksp + 4 * kq + q) * NS + 16 * dt + 4 * p;
            const s16x4 va = __builtin_amdgcn_ds_read_tr16_b64_v4i16((LAS s16x4*)vp), vb = __builtin_amdgcn_ds_read_tr16_b64_v4i16((LAS s16x4*)(vp + 16 * NS));
            const bf16x8 vf = __builtin_shufflevector(va, vb, 0, 1, 2, 3, 4, 5, 6, 7);
#pragma unroll
            for (int qp = 0; qp < 2; ++qp) ot[dt][qp] = MFMA16(vf, Pf[qp][ksp], ot[dt][qp]); }
}
__device__ __forceinline__ void nsa_flush(float* __restrict__ y0, float* __restrict__ y1, const f4 (&ot)[4][2], const float (&l)[2], const float (&gate)[2], bool add, int kq) {
#pragma unroll
    for (int qp = 0; qp < 2; ++qp) { float lt = l[qp]; lt += __shfl_xor(lt, 16); lt += __shfl_xor(lt, 32); const float sc = (lt > 0.f) ? gate[qp] / lt : 0.f;
        float* yp = (qp ? y1 : y0) + 4 * kq;
#pragma unroll
        for (int dt = 0; dt < 4; ++dt) { f4 o = ot[dt][qp] * sc; if (add) o += *(const f4*)(yp + 16 * dt); *(f4*)(yp + 16 * dt) = o; } }
}
__device__ __forceinline__ void nsa_pair_next(unsigned& rem, int& ja, int& jb) { ja = __builtin_ctz(rem); rem &= rem - 1u; if (rem) { jb = __builtin_ctz(rem); rem &= rem - 1u; } else jb = -1; }
__device__ __forceinline__ void nsa_pair_prefetch(const bf16* __restrict__ Hb, int tok0, int ja, int jb, int colK, int colV, int tid, u4 (&R)[4]) {
    const int key = tid >> 3, d8 = (tid & 7) * 8; const int j1 = jb < 0 ? ja : jb;
    const bf16* pa = Hb + (size_t)(tok0 + 64 * ja + key) * INWP + d8; const bf16* pb = Hb + (size_t)(tok0 + 64 * j1 + key) * INWP + d8;
    R[0] = *(const u4*)(pa + colK); R[1] = *(const u4*)(pa + colV); R[2] = *(const u4*)(pb + colK); R[3] = *(const u4*)(pb + colV);
}
__device__ __forceinline__ void nsa_pair_store(LAS bf16* buf, int tid, const u4 (&R)[4]) {
    LAS bf16* p = buf + (tid >> 3) * NS + (tid & 7) * 8;
    *(LAS u4*)p = R[0]; *(LAS u4*)(p + 128 * NS) = R[1]; *(LAS u4*)(p + 64 * NS) = R[2]; *(LAS u4*)(p + 192 * NS) = R[3];
}
template <int MODE>
__device__ __forceinline__ void nsa_branch(unsigned chunks, const bf16* __restrict__ Hb, int tok0, int colK, int colV, LAS bf16* buf0, LAS bf16* buf1, int tid, int lane, int qt, const int (&tq)[2], const unsigned (&mym)[2],
                                           const bf16x8 (&Yq)[2][2], f4 (&ot)[4][2], float (&m)[2], float (&l)[2]) {
    u4 R[4]; unsigned rem = chunks; int ja, jb, na = 0, nb = -1; f4 st[4][2]; int lo[2], hi[2];
    nsa_pair_next(rem, ja, jb);
    nsa_pair_prefetch(Hb, tok0, ja, jb, colK, colV, tid, R);
    __syncthreads();
    nsa_pair_store(buf0, tid, R);
    bool more = (rem != 0u);
    if (more) { nsa_pair_next(rem, na, nb); nsa_pair_prefetch(Hb, tok0, na, nb, colK, colV, tid, R); }
    __syncthreads();
    int it = 0;
#pragma unroll 1
    for (;;) {
        LAS bf16* cur = (it & 1) ? buf1 : buf0;
#pragma unroll 1
        for (int sub = 0; sub < 2; ++sub) { const int j = sub ? jb : ja;
            if (j < 0) break;
            bool anyv = false, full = true;
#pragma unroll
            for (int qp = 0; qp < 2; ++qp) {
                if (MODE == 0) { const bool sel = (mym[qp] >> j) & 1u; lo[qp] = sel ? 0 : 64; hi[qp] = sel ? ((j == qt) ? tq[qp] : 63) : -1; anyv |= sel; full &= (sel && j != qt); }
                else { lo[qp] = (j == qt - 8) ? tq[qp] + 1 : 0; hi[qp] = (j == qt) ? tq[qp] : 63; anyv = true; full &= (j != qt && j != qt - 8); } }
            if (__builtin_amdgcn_ballot_w64(anyv) != 0ull) {
                const bool need_mask = __builtin_amdgcn_ballot_w64(!full) != 0ull;
                nsa_scores(st, cur + sub * 64 * NS, Yq, lane);
                nsa_softmax_pv(st, m, l, ot, cur + 128 * NS + sub * 64 * NS, lo, hi, need_mask, lane); } }
        if (!more) break;
        nsa_pair_store((it & 1) ? buf0 : buf1, tid, R);
        ja = na; jb = nb; more = (rem != 0u);
        if (more) { nsa_pair_next(rem, na, nb); nsa_pair_prefetch(Hb, tok0, na, nb, colK, colV, tid, R); }
        __syncthreads(); ++it;
    }
}
__device__ __forceinline__ void unit_nsa(const Params& P, unsigned char* ws, int l_, LAS unsigned char* lds, int u, int tid) {
    const int b = (u >> 7) & 3, g = (u >> 5) & 3, qt = (u & 256) ? 31 - (u & 31) : (u & 31);
    const bf16* Hb = (const bf16*)(ws + WS_H);
    LAS bf16* buf0 = (LAS bf16*)lds;
    LAS bf16* buf1 = (LAS bf16*)(lds + 40960);
    LAS float* impG = (LAS float*)(lds + 40960);
    LAS float* impE = (LAS float*)(lds + 73728);
    LAS unsigned* selm = (LAS unsigned*)(lds + 106496);
    const int lane = tid & 63, wv = __builtin_amdgcn_readfirstlane(tid >> 6), h = wv >> 1, qh = wv & 1;
    const int c = lane & 15, kq = lane >> 4;
    const int t0 = qt * 64;
    int tq[2]; size_t tok[2];
#pragma unroll
    for (int qp = 0; qp < 2; ++qp) { tq[qp] = 32 * qh + 16 * qp + c; tok[qp] = (size_t)b * T + t0 + tq[qp]; }
    bf16x8 Yq[2][2];
#pragma unroll
    for (int qp = 0; qp < 2; ++qp)
#pragma unroll
        for (int ks = 0; ks < 2; ++ks) Yq[qp][ks] = *(const bf16x8*)(Hb + tok[qp] * INWP + C_NQ + g * 256 + h * 64 + 32 * ks + 8 * kq);
    float gate[3][2];
#pragma unroll
    for (int k = 0; k < 3; ++k)
#pragma unroll
        for (int qp = 0; qp < 2; ++qp) { const float gv = bf2f(Hb[tok[qp] * INWP + C_NG + g * 12 + h * 3 + k]); gate[k][qp] = __builtin_amdgcn_rcpf(1.f + __expf(-gv)); }
    float* y0 = (float*)(ws + WS_YMIX) + tok[0] * D + 1024 + g * 256 + h * 64; float* y1 = (float*)(ws + WS_YMIX) + tok[1] * D + 1024 + g * 256 + h * 64;
    if (tid == 0) selm[64] = 0u;
    f4 ot[4][2]; float m[2], l[2];
#pragma unroll
    for (int dt = 0; dt < 4; ++dt)
#pragma unroll
        for (int qp = 0; qp < 2; ++qp) ot[dt][qp] = mk_f4(0.f, 0.f, 0.f, 0.f);
    int cmax[2];
#pragma unroll
    for (int qp = 0; qp < 2; ++qp) { const int t = t0 + tq[qp]; cmax[qp] = (t >= 31) ? (((t - 31) >> 4) < 126 ? ((t - 31) >> 4) : 126) : -1; }
    __syncthreads();
    { const bf16* KCk = (const bf16*)(ws + WS_KC) + (size_t)((0 * 4 + b) * 4 + g) * 8192; const bf16* KCv = (const bf16*)(ws + WS_KC) + (size_t)((1 * 4 + b) * 4 + g) * 8192;
#pragma unroll
        for (int i = 0; i < 2; ++i) { const int idx = tid + 512 * i, key = idx >> 3, d8 = (idx & 7) * 8;
            *(LAS u4*)(buf0 + key * NS + d8) = *(const u4*)(KCk + key * 64 + d8); *(LAS u4*)(buf0 + (128 + key) * NS + d8) = *(const u4*)(KCv + key * 64 + d8); } }
    __syncthreads();
    m[0] = m[1] = -1e4f; l[0] = l[1] = 0.f;
    { f4 st[4][2]; int lo[2], hi[2];
#pragma unroll 1
        for (int cc = 0; cc < 2; ++cc) {
            if (cc * 64 * 16 + 31 > t0 + 63) break;
#pragma unroll
            for (int qp = 0; qp < 2; ++qp) { lo[qp] = 0; hi[qp] = cmax[qp] - 64 * cc; }
            nsa_scores(st, buf0 + cc * 64 * NS, Yq, lane);
            nsa_softmax_pv(st, m, l, ot, buf0 + 128 * NS + cc * 64 * NS, lo, hi, true, lane);
        }
        { const float g2[2] = {gate[0][0], gate[0][1]}; nsa_flush(y0, y1, ot, l, g2, false, kq); }
        float invl[2], msc[2];
#pragma unroll
        for (int qp = 0; qp < 2; ++qp) { float lt = l[qp]; lt += __shfl_xor(lt, 16); lt += __shfl_xor(lt, 32); invl[qp] = (lt > 0.f) ? 1.f / lt : 0.f; msc[qp] = m[qp] * NSA_SC; }
#pragma unroll 1
        for (int cc = 0; cc < 2; ++cc) {
            nsa_scores(st, buf0 + cc * 64 * NS, Yq, lane);
#pragma unroll
            for (int kt = 0; kt < 4; ++kt)
#pragma unroll
                for (int qp = 0; qp < 2; ++qp) { float pp[4];
#pragma unroll
                    for (int i = 0; i < 4; ++i) { const int ci = 64 * cc + 16 * kt + 4 * kq + i; pp[i] = (ci <= cmax[qp]) ? __builtin_amdgcn_exp2f(st[kt][qp][i] * NSA_SC - msc[qp]) * invl[qp] : 0.f; }
                    const int j = 16 * cc + 4 * kt + kq;
                    impG[(h * 32 + j) * 64 + tq[qp]] = (pp[0] + pp[1]) + (pp[2] + pp[3]);
                    if (j < 31) impE[(h * 32 + j + 1) * 64 + tq[qp]] = pp[3]; }
        } }
    __syncthreads();
    if (tid < 64) { const int tqs = tid; float tv[8]; int ti[8];
#pragma unroll
        for (int k = 0; k < 8; ++k) { tv[k] = -3e38f; ti[k] = 0; }
#pragma unroll 1
        for (int j = 0; j < 32; ++j) { float v;
            if (j <= qt) { const bool forced = (j == 0) || (j == qt) || (j == qt - 1);
                float s4 = (impG[(0 * 32 + j) * 64 + tqs] + impG[(1 * 32 + j) * 64 + tqs]) + (impG[(2 * 32 + j) * 64 + tqs] + impG[(3 * 32 + j) * 64 + tqs]);
                if (j > 0) s4 += (impE[(0 * 32 + j) * 64 + tqs] + impE[(1 * 32 + j) * 64 + tqs]) + (impE[(2 * 32 + j) * 64 + tqs] + impE[(3 * 32 + j) * 64 + tqs]);
                v = forced ? 1e6f : s4; }
            else v = -1e9f;
            int vi = j;
#pragma unroll
            for (int k = 0; k < 8; ++k) { const bool gt = v > tv[k]; const float nv = gt ? tv[k] : v; const int ni = gt ? ti[k] : vi; tv[k] = gt ? v : tv[k]; ti[k] = gt ? vi : ti[k]; v = nv; vi = ni; } }
        unsigned msk = 0u;
#pragma unroll
        for (int k = 0; k < 8; ++k) if (ti[k] <= qt) msk |= (1u << ti[k]);
        selm[tqs] = msk; atomicOr((unsigned*)&selm[64], msk); }
    __syncthreads();
    unsigned mymask[2];
#pragma unroll
    for (int qp = 0; qp < 2; ++qp) mymask[qp] = selm[tq[qp]];
    const unsigned umask = selm[64];
#pragma unroll
    for (int dt = 0; dt < 4; ++dt)
#pragma unroll
        for (int qp = 0; qp < 2; ++qp) ot[dt][qp] = mk_f4(0.f, 0.f, 0.f, 0.f);
    m[0] = m[1] = -1e4f; l[0] = l[1] = 0.f;
    nsa_branch<0>(umask, Hb, b * T, C_KS + g * 64, C_VS + g * 64, buf0, buf1, tid, lane, qt, tq, mymask, Yq, ot, m, l);
    { const float g2[2] = {gate[1][0], gate[1][1]}; nsa_flush(y0, y1, ot, l, g2, true, kq); }
#pragma unroll
    for (int dt = 0; dt < 4; ++dt)
#pragma unroll
        for (int qp = 0; qp < 2; ++qp) ot[dt][qp] = mk_f4(0.f, 0.f, 0.f, 0.f);
    m[0] = m[1] = -1e4f; l[0] = l[1] = 0.f;
    { const int jw0 = qt >= 8 ? qt - 8 : 0; const unsigned wmask = ((qt == 31) ? 0xffffffffu : ((1u << (qt + 1)) - 1u)) & ~((1u << jw0) - 1u);
        nsa_branch<1>(wmask, Hb, b * T, C_KW + g * 64, C_VW + g * 64, buf0, buf1, tid, lane, qt, tq, mymask, Yq, ot, m, l); }
    { const float g2[2] = {gate[2][0], gate[2][1]}; nsa_flush(y0, y1, ot, l, g2, true, kq); }
    __syncthreads();
}

__device__ __forceinline__ bf16x8 cmp_afrag(const bf16* __restrict__ p, const float* __restrict__ pe) {
    const u4 a = *(const u4*)p; float f[8]; unpack8(a, f);
    const f4 p0 = *(const f4*)pe, p1 = *(const f4*)(pe + 4);
    u4 w; w.x = pkbf(f[0] + p0.x, f[1] + p0.y); w.y = pkbf(f[2] + p0.z, f[3] + p0.w); w.z = pkbf(f[4] + p1.x, f[5] + p1.y); w.w = pkbf(f[6] + p1.z, f[7] + p1.w);
    return __builtin_bit_cast(bf16x8, w);
}
__device__ __forceinline__ void unit_compress_mfma(const Params& P, unsigned char* ws, int l, LAS unsigned char* lds, int u, int tid) {
    const int kv = u >> 6, b = (u >> 4) & 3, g = (u >> 2) & 3, r4 = u & 3, i0 = 32 * r4;
    const bf16* Hb = (const bf16*)(ws + WS_H);
    const bf16* W1T = (const bf16*)(ws + WS_W1T) + (size_t)(l * 2 + kv) * 256 * 2048;
    const bf16* W2T = (const bf16*)(ws + WS_W2T) + (size_t)(l * 2 + kv) * 64 * 256;
    const float* pe = P.in[kv ? 11 : 8] + (size_t)l * 2048;
    LAS bf16* hidL = (LAS bf16*)lds;
    const int lane = tid & 63, wv = __builtin_amdgcn_readfirstlane(tid >> 6), c = lane & 15, kq = lane >> 4;
    const int col0 = (kv ? C_VC : C_KC) + g * 64;
    int tb[2];
#pragma unroll
    for (int rt = 0; rt < 2; ++rt) tb[rt] = 16 * (i0 + 16 * rt + c);
    f4 acc[2][2];
#pragma unroll
    for (int nt = 0; nt < 2; ++nt)
#pragma unroll
        for (int rt = 0; rt < 2; ++rt) acc[nt][rt] = mk_f4(0.f, 0.f, 0.f, 0.f);
    const bf16* wrow[2];
#pragma unroll
    for (int nt = 0; nt < 2; ++nt) wrow[nt] = W1T + (size_t)(32 * wv + 16 * nt + c) * 2048 + 8 * kq;
    bf16x8 xfA[2][2], xfB[2][2]; u4 arA[2][2], arB[2][2]; f4 peA[2][2], peB[2][2];
#define CMP_LOAD(XF, AR, PE, pos_) do { \
        _Pragma("unroll") for (int nt = 0; nt < 2; ++nt) _Pragma("unroll") for (int ks = 0; ks < 2; ++ks) XF[nt][ks] = *(const bf16x8*)(wrow[nt] + (pos_) * 64 + 32 * ks); \
        _Pragma("unroll") for (int rt = 0; rt < 2; ++rt) { int t_ = tb[rt] + (pos_); t_ = t_ < T ? t_ : T - 1; const bf16* ap_ = Hb + (size_t)(b * T + t_) * INWP + col0 + 8 * kq; \
            _Pragma("unroll") for (int ks = 0; ks < 2; ++ks) AR[rt][ks] = *(const u4*)(ap_ + 32 * ks); } \
        _Pragma("unroll") for (int ks = 0; ks < 2; ++ks) { PE[ks][0] = *(const f4*)(pe + (pos_) * 64 + 32 * ks + 8 * kq); PE[ks][1] = *(const f4*)(pe + (pos_) * 64 + 32 * ks + 8 * kq + 4); } } while (0)
#define CMP_MMA(XF, AR, PE) do { \
        _Pragma("unroll") for (int rt = 0; rt < 2; ++rt) _Pragma("unroll") for (int ks = 0; ks < 2; ++ks) { float f_[8]; unpack8(AR[rt][ks], f_); const f4 p0_ = PE[ks][0], p1_ = PE[ks][1]; \
            u4 w_; w_.x = pkbf(f_[0] + p0_.x, f_[1] + p0_.y); w_.y = pkbf(f_[2] + p0_.z, f_[3] + p0_.w); w_.z = pkbf(f_[4] + p1_.x, f_[5] + p1_.y); w_.w = pkbf(f_[6] + p1_.z, f_[7] + p1_.w); \
            const bf16x8 yf_ = __builtin_bit_cast(bf16x8, w_); \
            _Pragma("unroll") for (int nt = 0; nt < 2; ++nt) acc[nt][rt] = MFMA16(XF[nt][ks], yf_, acc[nt][rt]); } } while (0)
    CMP_LOAD(xfA, arA, peA, 0);
#pragma unroll 1
    for (int pos = 0; pos < 32; pos += 2) {
        CMP_LOAD(xfB, arB, peB, pos + 1);
        CMP_MMA(xfA, arA, peA);
        if (pos + 2 < 32) CMP_LOAD(xfA, arA, peA, pos + 2);
        CMP_MMA(xfB, arB, peB);
    }
#undef CMP_LOAD
#undef CMP_MMA
#pragma unroll
    for (int nt = 0; nt < 2; ++nt)
#pragma unroll
        for (int rt = 0; rt < 2; ++rt) { const f4 a = acc[nt][rt]; u2 w; w.x = pkbf(gelu_tanh(a.x), gelu_tanh(a.y)); w.y = pkbf(gelu_tanh(a.z), gelu_tanh(a.w));
            *(LAS u2*)(hidL + (16 * rt + c) * 264 + 32 * wv + 16 * nt + 4 * kq) = w; }
    __syncthreads();
    { const int ot = wv & 3, rt = wv >> 2; f4 o = mk_f4(0.f, 0.f, 0.f, 0.f);
        const bf16* w2p = W2T + (size_t)(16 * ot + c) * 256 + 8 * kq; const LAS bf16* hp = hidL + (16 * rt + c) * 264 + 8 * kq;
#pragma unroll
        for (int ks = 0; ks < 8; ++ks) { const bf16x8 xw = *(const bf16x8*)(w2p + 32 * ks); const bf16x8 yh = *(const LAS bf16x8*)(hp + 32 * ks); o = MFMA16(xw, yh, o); }
        const int ci = i0 + 16 * rt + c;
        if (ci <= 126) { u2 w; w.x = pkbf(o.x, o.y); w.y = pkbf(o.z, o.w); *(u2*)((bf16*)(ws + WS_KC) + ((size_t)((kv * 4 + b) * 4 + g) * 128 + ci) * 64 + 16 * ot + 4 * kq) = w; } }
    __syncthreads();
}

__device__ __forceinline__ void unit_retention_mfma(const Params& P, unsigned char* ws, int l, LAS unsigned char* lds, int u, int tid) {
    const int b = u >> 6, h = (u >> 4) & 3, c = u & 15;
    const bf16* Hb = (const bf16*)(ws + WS_H); const f2* rope = (const f2*)(ws + WS_ROPE);
    LAS bf16* Ql = (LAS bf16*)lds;
    LAS bf16* Kl = (LAS bf16*)(lds + 18432);
    LAS bf16* Vt = (LAS bf16*)(lds + 36864);
    LAS bf16* St = (LAS bf16*)(lds + 71680);
    const float lg2h = P.lg2[h];
    const int tok0 = b * T + c * 128;
    { const int m = tid >> 2, p = tid & 3;
        const f4* rp = (const f4*)(rope + (size_t)(c * 128 + m) * 32 + p * 8);
        const f4 r0 = rp[0], r1 = rp[1], r2 = rp[2], r3 = rp[3];
        const float cs[8] = {r0.x, r0.z, r1.x, r1.z, r2.x, r2.z, r3.x, r3.z}, sn[8] = {r0.y, r0.w, r1.y, r1.w, r2.y, r2.w, r3.y, r3.w};
#pragma unroll
        for (int which = 0; which < 2; ++which) { const bf16* src = Hb + (size_t)(tok0 + m) * INWP + (which ? C_RK : C_RQ) + h * 64 + p * 8;
            const u4 a = *(const u4*)src, bb = *(const u4*)(src + 32); float x1[8], x2[8]; unpack8(a, x1); unpack8(bb, x2);
            const float sc = which ? 0.125f : 1.0f; float o1[8], o2[8];
#pragma unroll
            for (int i = 0; i < 8; ++i) { o1[i] = (x1[i] * cs[i] - x2[i] * sn[i]) * sc; o2[i] = (x1[i] * sn[i] + x2[i] * cs[i]) * sc; }
            LAS bf16* dst = (which ? Kl : Ql) + m * 72 + p * 8;
            u4 w1, w2; w1.x = pkbf(o1[0], o1[1]); w1.y = pkbf(o1[2], o1[3]); w1.z = pkbf(o1[4], o1[5]); w1.w = pkbf(o1[6], o1[7]); w2.x = pkbf(o2[0], o2[1]); w2.y = pkbf(o2[2], o2[3]); w2.z = pkbf(o2[4], o2[5]); w2.w = pkbf(o2[6], o2[7]);
            *(LAS u4*)dst = w1; *(LAS u4*)(dst + 32) = w2; } }
    { const int m = tid & 127, eq = tid >> 7;
        const u4* src = (const u4*)(Hb + (size_t)(tok0 + m) * INWP + C_RV + h * 128 + eq * 32); LAS bf16* vp = Vt + (eq * 32) * 136 + m;
#pragma unroll
        for (int j = 0; j < 4; ++j) { const u4 a = src[j];
            vp[(8 * j + 0) * 136] = (bf16)(a.x & 0xffffu); vp[(8 * j + 1) * 136] = (bf16)(a.x >> 16); vp[(8 * j + 2) * 136] = (bf16)(a.y & 0xffffu); vp[(8 * j + 3) * 136] = (bf16)(a.y >> 16);
            vp[(8 * j + 4) * 136] = (bf16)(a.z & 0xffffu); vp[(8 * j + 5) * 136] = (bf16)(a.z >> 16); vp[(8 * j + 6) * 136] = (bf16)(a.w & 0xffffu); vp[(8 * j + 7) * 136] = (bf16)(a.w >> 16); } }
    { float a[16];
#pragma unroll
        for (int i = 0; i < 16; ++i) a[i] = 0.f;
        const float* kvb = (const float*)(ws + WS_KVST) + (size_t)((b * 4 + h) * 16) * 8192 + tid * 16;
#pragma unroll 1
        for (int j = 0; j < c; ++j) { const float w = exp2f(lg2h * 128.f * (float)(c - 1 - j)); const f4* sp = (const f4*)(kvb + (size_t)j * 8192);
#pragma unroll
            for (int q = 0; q < 4; ++q) { const f4 v = sp[q]; a[4 * q] += w * v.x; a[4 * q + 1] += w * v.y; a[4 * q + 2] += w * v.z; a[4 * q + 3] += w * v.w; } }
        const int d = tid >> 3, e0 = (tid & 7) * 16;
#pragma unroll
        for (int i = 0; i < 16; ++i) St[(e0 + i) * 72 + d] = (bf16)f2bf(a[i]); }
    __syncthreads();
    const int lane = tid & 63, wv = __builtin_amdgcn_readfirstlane(tid >> 6), cc = lane & 15, kq = lane >> 4;
    const int nn = 16 * wv + cc;
    bf16x8 yq[2];
#pragma unroll
    for (int ks = 0; ks < 2; ++ks) yq[ks] = *(const LAS bf16x8*)(Ql + nn * 72 + 32 * ks + 8 * kq);
    f4 ot[8];
#pragma unroll
    for (int et = 0; et < 8; ++et) { f4 a = mk_f4(0.f, 0.f, 0.f, 0.f); const LAS bf16* sp = St + (16 * et + cc) * 72 + 8 * kq;
        a = MFMA16(*(const LAS bf16x8*)sp, yq[0], a); a = MFMA16(*(const LAS bf16x8*)(sp + 32), yq[1], a); ot[et] = a; }
    { const float xi = exp2f(lg2h * (float)(nn + 1));
#pragma unroll
        for (int et = 0; et < 8; ++et) ot[et] *= xi; }
    const int nks = (wv >> 1) + 1;
#pragma unroll 1
    for (int ksp = 0; ksp < nks; ++ksp) { f4 st[2];
#pragma unroll
        for (int j = 0; j < 2; ++j) { const int mt = 2 * ksp + j; const LAS bf16* kp = Kl + (16 * mt + cc) * 72 + 8 * kq;
            f4 a = mk_f4(0.f, 0.f, 0.f, 0.f); a = MFMA16(*(const LAS bf16x8*)kp, yq[0], a); a = MFMA16(*(const LAS bf16x8*)(kp + 32), yq[1], a);
#pragma unroll
            for (int i = 0; i < 4; ++i) { const int mm = 16 * mt + 4 * kq + i; a[i] = (mm <= nn) ? a[i] * exp2f(lg2h * (float)(nn - mm)) : 0.f; }
            st[j] = a; }
        u4 w; w.x = pkbf(st[0].x, st[0].y); w.y = pkbf(st[0].z, st[0].w); w.z = pkbf(st[1].x, st[1].y); w.w = pkbf(st[1].z, st[1].w);
        const bf16x8 pf = __builtin_bit_cast(bf16x8, w);
#pragma unroll
        for (int et = 0; et < 8; ++et) { const LAS bf16* vp = Vt + (16 * et + cc) * 136 + 32 * ksp + 4 * kq;
            const s16x4 va = *(const LAS s16x4*)vp, vb = *(const LAS s16x4*)(vp + 16);
            ot[et] = MFMA16(__builtin_shufflevector(va, vb, 0, 1, 2, 3, 4, 5, 6, 7), pf, ot[et]); }
    }
    float s1 = 0.f;
#pragma unroll
    for (int et = 0; et < 8; ++et) s1 += (ot[et].x + ot[et].y) + (ot[et].z + ot[et].w);
    s1 += __shfl_xor(s1, 16); s1 += __shfl_xor(s1, 32);
    const float mu = s1 * (1.f / 128.f); float s2 = 0.f;
#pragma unroll
    for (int et = 0; et < 8; ++et) { const f4 dd = ot[et] - mu; s2 += (dd.x * dd.x + dd.y * dd.y) + (dd.z * dd.z + dd.w * dd.w); }
    s2 += __shfl_xor(s2, 16); s2 += __shfl_xor(s2, 32);
    const float rstd = rsqrtf(s2 * (1.f / 128.f) + LN_EPS);
    const float* gg = P.in[2] + l * 512 + h * 128; const float* gb = P.in[3] + l * 512 + h * 128;
    const bf16* gp = Hb + (size_t)(tok0 + nn) * INWP + C_RG + h * 128;
    float* yo = (float*)(ws + WS_YMIX) + (size_t)(tok0 + nn) * D + h * 128;
#pragma unroll
    for (int et = 0; et < 8; ++et) { const int e = 16 * et + 4 * kq; const f4 g4 = *(const f4*)(gg + e), b4 = *(const f4*)(gb + e); const u2 gr = *(const u2*)(gp + e);
        const float gv[4] = {__uint_as_float(gr.x << 16), __uint_as_float(gr.x & 0xffff0000u), __uint_as_float(gr.y << 16), __uint_as_float(gr.y & 0xffff0000u)};
        f4 o;
#pragma unroll
        for (int i = 0; i < 4; ++i) { const float y = (ot[et][i] - mu) * rstd * g4[i] + b4[i]; o[i] = y * gv[i] * __builtin_amdgcn_rcpf(1.f + __expf(-gv[i])); }
        *(f4*)(yo + e) = o; }
    __syncthreads();
}

__device__ __forceinline__ bf16x8 tr_frag(const LAS bf16* p, int rowstride4) {
    const s16x4 a = __builtin_amdgcn_ds_read_tr16_b64_v4i16((LAS s16x4*)p), b = __builtin_amdgcn_ds_read_tr16_b64_v4i16((LAS s16x4*)(p + rowstride4));
    return __builtin_shufflevector(a, b, 0, 1, 2, 3, 4, 5, 6, 7);
}
__device__ __forceinline__ void unit_kvstate_mfma(const Params& P, unsigned char* ws, LAS unsigned char* lds, int u, int tid) {
    const int b = u / 60, r = u % 60, h = r / 15, j = r % 15;
    const bf16* Hb = (const bf16*)(ws + WS_H); const f2* rope = (const f2*)(ws + WS_ROPE);
    LAS bf16* Kz = (LAS bf16*)lds;
    LAS bf16* Vl = (LAS bf16*)(lds + 20480);
    const int tok0 = b * T + j * 128; const float lg2h = P.lg2[h];
    { const int m = tid >> 2, p = tid & 3;
        const f4* rp = (const f4*)(rope + (size_t)(j * 128 + m) * 32 + p * 8);
        const f4 r0 = rp[0], r1 = rp[1], r2 = rp[2], r3 = rp[3];
        const float cs[8] = {r0.x, r0.z, r1.x, r1.z, r2.x, r2.z, r3.x, r3.z}, sn[8] = {r0.y, r0.w, r1.y, r1.w, r2.y, r2.w, r3.y, r3.w};
        const bf16* src = Hb + (size_t)(tok0 + m) * INWP + C_RK + h * 64 + p * 8;
        const u4 a = *(const u4*)src, bb = *(const u4*)(src + 32); float x1[8], x2[8]; unpack8(a, x1); unpack8(bb, x2);
        const float sc = 0.125f * exp2f(lg2h * (float)(127 - m)); float o1[8], o2[8];
#pragma unroll
        for (int i = 0; i < 8; ++i) { o1[i] = (x1[i] * cs[i] - x2[i] * sn[i]) * sc; o2[i] = (x1[i] * sn[i] + x2[i] * cs[i]) * sc; }
        u4 w1, w2; w1.x = pkbf(o1[0], o1[1]); w1.y = pkbf(o1[2], o1[3]); w1.z = pkbf(o1[4], o1[5]); w1.w = pkbf(o1[6], o1[7]); w2.x = pkbf(o2[0], o2[1]); w2.y = pkbf(o2[2], o2[3]); w2.z = pkbf(o2[4], o2[5]); w2.w = pkbf(o2[6], o2[7]);
        *(LAS u4*)(Kz + m * 80 + p * 8) = w1; *(LAS u4*)(Kz + m * 80 + 32 + p * 8) = w2;
        const u4* vs = (const u4*)(Hb + (size_t)(tok0 + m) * INWP + C_RV + h * 128 + p * 32); LAS u4* vd = (LAS u4*)(Vl + m * 144 + p * 32);
#pragma unroll
        for (int q = 0; q < 4; ++q) vd[q] = vs[q]; }
    __syncthreads();
    { const int lane = tid & 63, et = __builtin_amdgcn_readfirstlane(tid >> 6), c = lane & 15, kq = lane >> 4, q = (lane & 15) >> 2, p4 = lane & 3;
        bf16x8 yv[4];
#pragma unroll
        for (int ks = 0; ks < 4; ++ks) yv[ks] = tr_frag(Vl + (32 * ks + 8 * kq + q) * 144 + 16 * et + 4 * p4, 4 * 144);
        float* dst = (float*)(ws + WS_KVST) + (size_t)((b * 4 + h) * 16 + j) * 8192 + 16 * et + c;
#pragma unroll
        for (int dt = 0; dt < 4; ++dt) { f4 acc = mk_f4(0.f, 0.f, 0.f, 0.f);
#pragma unroll
            for (int ks = 0; ks < 4; ++ks) acc = MFMA16(tr_frag(Kz + (32 * ks + 8 * kq + q) * 80 + 16 * dt + 4 * p4, 4 * 80), yv[ks], acc);
#pragma unroll
            for (int i = 0; i < 4; ++i) dst[(16 * dt + 4 * kq + i) * 128] = acc[i]; } }
    __syncthreads();
}
__device__ __forceinline__ void unit_sgu_mfma(const Params& P, unsigned char* ws, int l, LAS unsigned char* lds, int u, int tid, int lane, int wave) {
    const int b = u >> 6, c = (u >> 2) & 15, g = u & 3;
    const bf16* Hb = (const bf16*)(ws + WS_H);
    LAS bf16* vn = (LAS bf16*)lds;
    const int tok0 = b * T + c * 128;
    const float* lng = P.in[4] + l * 512 + g * 128; const float* lnb = P.in[5] + l * 512 + g * 128;
    const float g0 = lng[2 * lane], g1 = lng[2 * lane + 1], b0 = lnb[2 * lane], b1 = lnb[2 * lane + 1];
#pragma unroll 4
    for (int i = 0; i < 16; ++i) { const int s = wave * 16 + i;
        const unsigned pr = *(const unsigned*)(Hb + (size_t)(tok0 + s) * INWP + C_SV + g * 128 + 2 * lane);
        const float v0 = __uint_as_float(pr << 16), v1 = __uint_as_float(pr & 0xffff0000u);
        const float mu = wave_sum(v0 + v1) * (1.f / 128.f); const float d0 = v0 - mu, d1 = v1 - mu;
        const float var = wave_sum(d0 * d0 + d1 * d1) * (1.f / 128.f); const float rstd = rsqrtf(var + LN_EPS);
        *(LAS unsigned*)(vn + s * 144 + 2 * lane) = pkbf(d0 * rstd * g0 + b0, d1 * rstd * g1 + b1); }
    __syncthreads();
    { const int cc = lane & 15, kq = lane >> 4, q = (lane & 15) >> 2, p4 = lane & 3, t = 16 * wave + cc, nks = (wave >> 1) + 1;
        const float* wrow = P.in[6] + ((size_t)l * 4 + g) * 16384 + (size_t)t * 128 + 8 * kq;
        bf16x8 xw[4];
#pragma unroll
        for (int ks = 0; ks < 4; ++ks) { u4 w = {0u, 0u, 0u, 0u};
            if (ks < nks) { const f4 a0 = *(const f4*)(wrow + 32 * ks), a1 = *(const f4*)(wrow + 32 * ks + 4); const int s0 = 32 * ks + 8 * kq;
                w.x = pkbf(s0 + 0 <= t ? a0.x : 0.f, s0 + 1 <= t ? a0.y : 0.f); w.y = pkbf(s0 + 2 <= t ? a0.z : 0.f, s0 + 3 <= t ? a0.w : 0.f);
                w.z = pkbf(s0 + 4 <= t ? a1.x : 0.f, s0 + 5 <= t ? a1.y : 0.f); w.w = pkbf(s0 + 6 <= t ? a1.z : 0.f, s0 + 7 <= t ? a1.w : 0.f); }
            xw[ks] = __builtin_bit_cast(bf16x8, w); }
        f4 bs4; { const float* bsp = P.in[7] + (l * 4 + g) * 128 + 16 * wave + 4 * kq; bs4 = *(const f4*)bsp; }
#pragma unroll 2
        for (int dt = 0; dt < 8; ++dt) { f4 acc = mk_f4(0.f, 0.f, 0.f, 0.f);
#pragma unroll
            for (int ks = 0; ks < 4; ++ks) if (ks < nks) acc = MFMA16(xw[ks], tr_frag(vn + (32 * ks + 8 * kq + q) * 144 + 16 * dt + 4 * p4, 4 * 144), acc);
            const int d = 16 * dt + cc;
#pragma unroll
            for (int i = 0; i < 4; ++i) { const int tt = 16 * wave + 4 * kq + i; const float uu = bf2f(Hb[(size_t)(tok0 + tt) * INWP + C_SU + g * 128 + d]);
                ((float*)(ws + WS_YMIX))[(size_t)(tok0 + tt) * D + 512 + g * 128 + d] = uu * (acc[i] + bs4[i]); } } }
    __syncthreads();
}

__device__ __forceinline__ void row_mixnorm(const Params& P, unsigned char* ws, int l, int rowi, int lane) {
    const f4* yp = (const f4*)((const float*)(ws + WS_YMIX) + (size_t)rowi * D) + lane;
    const f4* gp = (const f4*)(P.in[14] + (size_t)l * D) + lane;
    f4 v[8]; float ss[8];
#pragma unroll
    for (int j = 0; j < 8; ++j) { v[j] = yp[64 * j]; ss[j] = v[j].x * v[j].x + v[j].y * v[j].y + v[j].z * v[j].z + v[j].w * v[j].w; }
    const float r0 = rsqrtf(wave_sum(ss[0] + ss[1]) * (1.f / 512.f) + LN_EPS);
    const float r1 = rsqrtf(wave_sum(ss[2] + ss[3]) * (1.f / 512.f) + LN_EPS);
    const float r2 = rsqrtf(wave_sum((ss[4] + ss[5]) + (ss[6] + ss[7])) * (1.f / 1024.f) + LN_EPS);
    u2* op = (u2*)((bf16*)(ws + WS_MIXED) + (size_t)rowi * D) + lane;
#pragma unroll
    for (int j = 0; j < 8; ++j) { const float r = (j < 2) ? r0 : ((j < 4) ? r1 : r2); const f4 g4 = gp[64 * j];
        op[64 * j] = mk_u2(pk2(v[j].x * r * g4.x, v[j].y * r * g4.y), pk2(v[j].z * r * g4.z, v[j].w * r * g4.w)); }
}
__device__ __forceinline__ void row_ln(const float* __restrict__ zin, const float* __restrict__ gam, const float* __restrict__ bet, float* __restrict__ of32, bf16* __restrict__ obf, int rowi, int lane) {
    const f4* zp = (const f4*)(zin + (size_t)rowi * D) + lane;
    f4 v[8]; float s = 0.f;
#pragma unroll
    for (int j = 0; j < 8; ++j) { v[j] = zp[64 * j]; s += (v[j].x + v[j].y) + (v[j].z + v[j].w); }
    const float mu = wave_sum(s) * (1.f / D); float s2 = 0.f;
#pragma unroll
    for (int j = 0; j < 8; ++j) { v[j].x -= mu; v[j].y -= mu; v[j].z -= mu; v[j].w -= mu; s2 += (v[j].x * v[j].x + v[j].y * v[j].y) + (v[j].z * v[j].z + v[j].w * v[j].w); }
    const float rstd = rsqrtf(wave_sum(s2) * (1.f / D) + LN_EPS);
    f4* o4 = (f4*)(of32 + (size_t)rowi * D) + lane; u2* o2 = (u2*)(obf + (size_t)rowi * D) + lane;
    const f4* gp = (const f4*)gam + lane; const f4* bp = (const f4*)bet + lane;
#pragma unroll
    for (int j = 0; j < 8; ++j) { const f4 g4 = gp[64 * j], b4 = bp[64 * j];
        const f4 o = mk_f4(v[j].x * rstd * g4.x + b4.x, v[j].y * rstd * g4.y + b4.y, v[j].z * rstd * g4.z + b4.z, v[j].w * rstd * g4.w + b4.w);
        o4[64 * j] = o; o2[64 * j] = mk_u2(pk2(o.x, o.y), pk2(o.z, o.w)); }
}

__device__ __forceinline__ float dot8_bf16(const u4& w, const float* x) {
    float f[8]; unpack8(w, f);
    return ((f[0] * x[0] + f[1] * x[1]) + (f[2] * x[2] + f[3] * x[3])) + ((f[4] * x[4] + f[5] * x[5]) + (f[6] * x[6] + f[7] * x[7]));
}
__device__ __forceinline__ void peer_load4(u4 (&R)[4][2], const unsigned char* __restrict__ TAB, const LAS int* pe, int grp, int lane) {
#pragma unroll
    for (int k = 0; k < 4; ++k) { const int e = __builtin_amdgcn_readfirstlane(pe[grp * 4 + k]); const u4* p = (const u4*)(TAB + (size_t)e * 2048) + lane; R[k][0] = p[0]; R[k][1] = p[64]; }
}
__device__ __forceinline__ float dot16_fp8(const u4& w, const float* x) {
    float s = 0.f;
#pragma unroll
    for (int q = 0; q < 4; ++q) { const f2 lo = __builtin_amdgcn_cvt_pk_f32_fp8((int)w[q], false), hi = __builtin_amdgcn_cvt_pk_f32_fp8((int)w[q], true);
        s += (lo.x * x[4 * q] + lo.y * x[4 * q + 1]) + (hi.x * x[4 * q + 2] + hi.y * x[4 * q + 3]); }
    return s;
}
__device__ __forceinline__ void peer_dot4(const u4 (&R)[4][2], const float (&xr)[32], const float* __restrict__ USC, const LAS int* pe, const LAS float* pw, const float* __restrict__ VSC, LAS float* hwp, int grp, int lane) {
    float d[4];
#pragma unroll
    for (int k = 0; k < 4; ++k) d[k] = dot16_fp8(R[k][0], xr) + dot16_fp8(R[k][1], xr + 16);
#pragma unroll
    for (int o = 1; o < 64; o <<= 1) {
#pragma unroll
        for (int k = 0; k < 4; ++k) d[k] += __shfl_xor(d[k], o); }
#pragma unroll
    for (int k = 0; k < 4; ++k) { const int e = __builtin_amdgcn_readfirstlane(pe[grp * 4 + k]);
        const float hv = pw[grp * 4 + k] * gelu_tanh(d[k] * USC[e]) * VSC[e];
        if (lane == 0) hwp[grp * 4 + k] = hv; }
}
__device__ __forceinline__ void peer_axpy4(const u4 (&R)[4][2], float (&acc)[32], const LAS float* hwp, int grp) {
#pragma unroll
    for (int k = 0; k < 4; ++k) { const float hw = hwp[grp * 4 + k];
#pragma unroll
        for (int j = 0; j < 2; ++j)
#pragma unroll
            for (int q = 0; q < 4; ++q) { const f2 lo = __builtin_amdgcn_cvt_pk_f32_fp8((int)R[k][j][q], false), hi = __builtin_amdgcn_cvt_pk_f32_fp8((int)R[k][j][q], true);
                acc[16 * j + 4 * q] += hw * lo.x; acc[16 * j + 4 * q + 1] += hw * lo.y; acc[16 * j + 4 * q + 2] += hw * hi.x; acc[16 * j + 4 * q + 3] += hw * hi.y; } }
}
__device__ __forceinline__ void unit_peer(const Params& P, unsigned char* ws, int l, LAS unsigned char* lds, int u, int tid_in, int lane_in, int wave, float* __restrict__ xout) {
    int tid = tid_in; asm volatile("" : "+v"(tid)); int lane = tid & 63;
    const int n0 = u * 32;
    const bf16* QPB = (const bf16*)(ws + WS_QP); int* SC = (int*)(ws + WS_SC);
    { const int h = wave, c = lane & 15, kq = lane >> 4;
#pragma unroll 1
        for (int half = 0; half < 2; ++half) {
            const bf16* kb = (const bf16*)(ws + WS_PKB) + ((size_t)(half * DEPTH + l) * 8 + h) * 16384;
            bf16x8 yq[2][4];
#pragma unroll
            for (int tt = 0; tt < 2; ++tt)
#pragma unroll
                for (int ks = 0; ks < 4; ++ks) yq[tt][ks] = *(const bf16x8*)(QPB + (size_t)(n0 + 16 * tt + c) * D + h * 256 + half * 128 + 32 * ks + 8 * kq);
#pragma unroll 1
            for (int kt = 0; kt < 8; ++kt) { bf16x8 xk[4];
#pragma unroll
                for (int ks = 0; ks < 4; ++ks) xk[ks] = *(const bf16x8*)(kb + (size_t)(16 * kt + c) * 128 + 32 * ks + 8 * kq);
#pragma unroll
                for (int tt = 0; tt < 2; ++tt) { f4 a = mk_f4(0.f, 0.f, 0.f, 0.f);
#pragma unroll
                    for (int ks = 0; ks < 4; ++ks) a = MFMA16(xk[ks], yq[tt][ks], a);
                    int kk[4];
#pragma unroll
                    for (int i = 0; i < 4; ++i) { const int bits = __float_as_int(a[i]); const int sk = bits ^ ((bits >> 31) & 0x7fffffff); kk[i] = (sk & ~127) | (127 - (16 * kt + 4 * kq + i)); }
                    u4 w; w.x = (unsigned)kk[0]; w.y = (unsigned)kk[1]; w.z = (unsigned)kk[2]; w.w = (unsigned)kk[3];
                    *(u4*)(SC + ((size_t)(n0 + 16 * tt + c) * 16 + 2 * h + half) * 128 + 16 * kt + 4 * kq) = w; } }
        } }
    VM_WAIT();
    __syncthreads();
    tid = tid_in; asm volatile("" : "+v"(tid)); lane = tid & 63;
    LAS int* TK = (LAS int*)lds;
    { const int tk = tid >> 4, hh = tid & 15;
        const u4* sp = (const u4*)(SC + ((size_t)(n0 + tk) * 16 + hh) * 128);
        int t[16];
#pragma unroll
        for (int k = 0; k < 16; ++k) t[k] = (int)0x80000000;
#pragma unroll 1
        for (int c4 = 0; c4 < 32; ++c4) { const u4 s4 = sp[c4];
#pragma unroll
            for (int e = 0; e < 4; ++e) { int x = (int)s4[e];
#pragma unroll
                for (int k = 0; k < 16; ++k) { const int hi_ = max(t[k], x); x = min(t[k], x); t[k] = hi_; } } }
#pragma unroll
        for (int k = 0; k < 16; ++k) TK[tid * 17 + k] = t[k]; }
    __syncthreads();
    tid = tid_in; asm volatile("" : "+v"(tid)); lane = tid & 63;
    LAS int* PE = (LAS int*)(lds + 69632);
    LAS float* PW = (LAS float*)(lds + 86016);
    if (tid < 256) { const int tk = tid >> 3, h = tid & 7; const int r1 = tk * 16 + 2 * h, r2 = r1 + 1;
        float v1[16], v2[16];
#pragma unroll
        for (int k = 0; k < 16; ++k) { const int k1 = TK[r1 * 17 + k] & ~127, k2 = TK[r2 * 17 + k] & ~127;
            v1[k] = __int_as_float(k1 ^ ((k1 >> 31) & 0x7fffffff)); v2[k] = __int_as_float(k2 ^ ((k2 >> 31) & 0x7fffffff)); }
        int t[16];
#pragma unroll
        for (int k = 0; k < 16; ++k) t[k] = (int)0x80000000;
#pragma unroll
        for (int a = 0; a < 16; ++a)
#pragma unroll
            for (int bq = 0; bq < 16; ++bq) if ((a + 1) * (bq + 1) <= 16) { const int bits = __float_as_int(v1[a] + v2[bq]); const int sk = bits ^ ((bits >> 31) & 0x7fffffff);
                int x = (sk & ~255) | (255 - (a * 16 + bq));
#pragma unroll
                for (int k = 0; k < 16; ++k) { const int hi_ = max(t[k], x); x = min(t[k], x); t[k] = hi_; } }
        float w[16], wsum = 0.f; const int kt0 = t[0] & ~255; const float top = __int_as_float(kt0 ^ ((kt0 >> 31) & 0x7fffffff));
#pragma unroll
        for (int k = 0; k < 16; ++k) { const int kk = t[k] & ~255; const float sv = __int_as_float(kk ^ ((kk >> 31) & 0x7fffffff)); w[k] = __expf(sv - top); wsum += w[k]; }
        const float inv = 1.f / wsum;
#pragma unroll
        for (int k = 0; k < 16; ++k) { const int ab = 255 - (t[k] & 255); const int a = ab >> 4, bq = ab & 15;
            const int i1 = 127 - (TK[r1 * 17 + a] & 127), i2 = 127 - (TK[r2 * 17 + bq] & 127);
            PE[tk * 128 + h * 16 + k] = i1 * 128 + i2; PW[tk * 128 + h * 16 + k] = w[k] * inv; } }
    __syncthreads();
    tid = tid_in; asm volatile("" : "+v"(tid)); lane = tid & 63;
    LAS float* HW = (LAS float*)(lds + 102400);
    const unsigned char* PU = ws + WS_PU + (size_t)l * 16384 * 2048; const unsigned char* PV = ws + WS_PV + (size_t)l * 16384 * 2048;
    const float* USC = (const float*)(ws + WS_PSC) + (size_t)l * 16384; const float* VSC = (const float*)(ws + WS_PSC) + (size_t)(DEPTH + l) * 16384;
    const float* X1 = (const float*)(ws + WS_X1);
        REP(9)
#pragma unroll 1
    for (int it = 0; it < 4; ++it) { const int tk = wave * 4 + it; const size_t n = (size_t)n0 + tk;
        float xr[32];
#pragma unroll
        for (int j = 0; j < 2; ++j)
#pragma unroll
            for (int q = 0; q < 4; ++q) { const f4 a = *(const f4*)(X1 + n * D + 1024 * j + 16 * lane + 4 * q); xr[16 * j + 4 * q] = a.x; xr[16 * j + 4 * q + 1] = a.y; xr[16 * j + 4 * q + 2] = a.z; xr[16 * j + 4 * q + 3] = a.w; }
        const LAS int* pe = PE + tk * 128; const LAS float* pw = PW + tk * 128; LAS float* hwp = HW + tk * 128;
        { u4 A[4][2], B[4][2];
            peer_load4(A, PU, pe, 0, lane);
#pragma unroll 1
            for (int g2 = 0; g2 < 16; ++g2) {
                peer_load4(B, PU, pe, 2 * g2 + 1, lane);
                peer_dot4(A, xr, USC, pe, pw, VSC, hwp, 2 * g2, lane);
                if (g2 < 15) peer_load4(A, PU, pe, 2 * g2 + 2, lane);
                peer_dot4(B, xr, USC, pe, pw, VSC, hwp, 2 * g2 + 1, lane);
            } }
        LDS_WAIT();
        float acc[32];
#pragma unroll
        for (int i = 0; i < 32; ++i) acc[i] = 0.f;
        { u4 A[4][2], B[4][2];
            peer_load4(A, PV, pe, 0, lane);
#pragma unroll 1
            for (int g2 = 0; g2 < 16; ++g2) {
                peer_load4(B, PV, pe, 2 * g2 + 1, lane);
                peer_axpy4(A, acc, hwp, 2 * g2);
                if (g2 < 15) peer_load4(A, PV, pe, 2 * g2 + 2, lane);
                peer_axpy4(B, acc, hwp, 2 * g2 + 1);
            } }
        float s = 0.f;
#pragma unroll
        for (int i = 0; i < 32; ++i) { acc[i] += ALPHA * xr[i]; s += acc[i]; }
        const float mu = wave_sum(s) * (1.f / D); float s2 = 0.f;
#pragma unroll
        for (int i = 0; i < 32; ++i) { acc[i] -= mu; s2 += acc[i] * acc[i]; }
        const float rstd = rsqrtf(wave_sum(s2) * (1.f / D) + LN_EPS);
        const float* gam = P.in[23] + (size_t)l * D; const float* bet = P.in[24] + (size_t)l * D;
        bf16* xb = (bf16*)(ws + WS_XB);
#pragma unroll
        for (int j = 0; j < 2; ++j) { const int col = 1024 * j + 16 * lane; float o[16];
#pragma unroll
            for (int q = 0; q < 4; ++q) { const f4 g4 = *(const f4*)(gam + col + 4 * q), b4 = *(const f4*)(bet + col + 4 * q);
                o[4 * q] = acc[16 * j + 4 * q] * rstd * g4.x + b4.x; o[4 * q + 1] = acc[16 * j + 4 * q + 1] * rstd * g4.y + b4.y; o[4 * q + 2] = acc[16 * j + 4 * q + 2] * rstd * g4.z + b4.z; o[4 * q + 3] = acc[16 * j + 4 * q + 3] * rstd * g4.w + b4.w;
                *(f4*)(xout + n * D + col + 4 * q) = mk_f4(o[4 * q], o[4 * q + 1], o[4 * q + 2], o[4 * q + 3]); }
            u4 p0, p1; p0.x = pk2(o[0], o[1]); p0.y = pk2(o[2], o[3]); p0.z = pk2(o[4], o[5]); p0.w = pk2(o[6], o[7]); p1.x = pk2(o[8], o[9]); p1.y = pk2(o[10], o[11]); p1.z = pk2(o[12], o[13]); p1.w = pk2(o[14], o[15]);
            *(u4*)(xb + n * D + col) = p0; *(u4*)(xb + n * D + col + 8) = p1; }
    }
    __syncthreads();
}

template <class T> __device__ __forceinline__ T* uniform_ptr(T* p) { const unsigned long long v = (unsigned long long)p; const unsigned lo = __builtin_amdgcn_readfirstlane((unsigned)v), hi = __builtin_amdgcn_readfirstlane((unsigned)(v >> 32)); return (T*)(((unsigned long long)hi << 32) | lo); }
constexpr int PH_PER_LAYER = 8, N_PHASES = 1 + DEPTH * PH_PER_LAYER;
#ifndef ONLY_PHASE
#define ONLY_PHASE -1
#endif
#define EN(i) (ONLY_PHASE < 0 || ONLY_PHASE == (i))
__global__ void __launch_bounds__(512, 2) mk_fwd(Params P) {
    extern __shared__ __attribute__((aligned(16))) unsigned char lds_raw[];
    LAS unsigned char* lds = (LAS unsigned char*)lds_raw;
    volatile LAS unsigned* MISC = (volatile LAS unsigned*)(lds + MISC_OFF);
    const int tid = threadIdx.x, lane = tid & 63, wave = __builtin_amdgcn_readfirstlane(tid >> 6);
    const int G = gridDim.x, bid = blockIdx.x;
    if (tid < 64) MISC[tid] = 0u;
    __syncthreads();
    unsigned char* const ws = uniform_ptr(P.ws);
    unsigned* ctl = (unsigned*)(ws + WS_CTL);
    const XcdBarrier bar = xcd_barrier_post(ctl + CW_BAR, MISC + 8);
    const int lo = P.ph_lo, hi = P.ph_hi;
#define IN(k) (lo <= (k) && (k) < hi)
#define LAUNDER() int tl = (wave << 6) | (int)__builtin_amdgcn_mbcnt_hi(0xffffffffu, __builtin_amdgcn_mbcnt_lo(0xffffffffu, 0u)); asm volatile("" : "+v"(tl)); const int ll = tl & 63; const int wl = __builtin_amdgcn_readfirstlane(tl >> 6); (void)ll; (void)wl
#define SEAM(k) do { if (IN((k) + 1)) xcd_barrier(bar); } while (0)
    if (IN(0) && EN(8)) { LAUNDER(); REP(8) phase_prologue(P, ws, lds, tl, ll, wl); SEAM(0); }
    for (int l = 0; l < DEPTH; ++l) {
        const int pb = 1 + l * PH_PER_LAYER;
        const float* xres = (l == 0) ? P.in[0] : (const float*)(ws + WS_XC);
        float* xout = (l == DEPTH - 1) ? P.out : (float*)(ws + WS_XC);
        if (IN(pb + 0) && EN(0)) { LAUNDER();
            pg8::Gemm g{(const pg8::bf16_t*)(ws + WS_XB), (const pg8::bf16_t*)(ws + WS_WIN) + (size_t)l * INWP * D, NTOK, INWP, D};
            pg8::StaticOrder S; S.init(NTOK, INWP, G, bid);
            pg8::EpiH E{(pg8::bf16_t*)(ws + WS_H), INWP, 6, 10};
            REP(0) pg8::gemm_phase<pg8::EpiH, pg8::StaticOrder, true, true>(lds, g, S, E, tl);
            SEAM(pb + 0);
        }
        if (IN(pb + 1) && EN(1)) { LAUNDER();
            REP(1) for (int u = bid; u < 240; u += G) unit_kvstate_mfma(P, ws, lds, u, tl);
            REP(13) for (int u = bid; u < 256; u += G) unit_sgu_mfma(P, ws, l, lds, u, tl, ll, wl);
            REP(12) for (int u = bid; u < 128; u += G) unit_compress_mfma(P, ws, l, lds, u, tl);
            SEAM(pb + 1);
        }
        if (IN(pb + 2) && EN(2)) { LAUNDER();
            REP(10) for (int u = bid; u < 256; u += G) unit_retention_mfma(P, ws, l, lds, u, tl);
            REP(11) for (int u = bid; u < 512; u += G) unit_nsa(P, ws, l, lds, u, tl);
            SEAM(pb + 2);
        }
        if (IN(pb + 3) && EN(3)) { LAUNDER();
            REP(3) for (int r = bid * 8 + wl; r < NTOK; r += G * 8) row_mixnorm(P, ws, l, r, ll);
            SEAM(pb + 3);
        }
        if (IN(pb + 4) && EN(4)) { LAUNDER();
            pg8::Gemm g{(const pg8::bf16_t*)(ws + WS_MIXED), (const pg8::bf16_t*)(ws + WS_WOUT) + (size_t)l * D * D, NTOK, D, D};
            pg8::StaticOrder S; S.init(NTOK, D, G, bid);
            pg8::EpiRes E{(float*)(ws + WS_Z), xres, D, ALPHA};
            REP(4) pg8::gemm_phase<pg8::EpiRes, pg8::StaticOrder, true, true>(lds, g, S, E, tl);
            SEAM(pb + 4);
        }
        if (IN(pb + 5) && EN(5)) { LAUNDER();
            for (int r = bid * 8 + wl; r < NTOK; r += G * 8) row_ln((const float*)(ws + WS_Z), P.in[16] + (size_t)l * D, P.in[17] + (size_t)l * D, (float*)(ws + WS_X1), (bf16*)(ws + WS_X1B), r, ll);
            SEAM(pb + 5);
        }
        if (IN(pb + 6) && EN(6)) { LAUNDER();
            pg8::Gemm g{(const pg8::bf16_t*)(ws + WS_X1B), (const pg8::bf16_t*)(ws + WS_WQ) + (size_t)l * D * D, NTOK, D, D};
            pg8::StaticOrder S; S.init(NTOK, D, G, bid);
            pg8::EpiH E{(pg8::bf16_t*)(ws + WS_QP), D, 0, 0};
            pg8::gemm_phase<pg8::EpiH, pg8::StaticOrder, true, true>(lds, g, S, E, tl);
            SEAM(pb + 6);
        }
        if (IN(pb + 7) && EN(7)) { LAUNDER();
            REP(7) for (int u = bid; u < NTOK / 32; u += G) unit_peer(P, ws, l, lds, u, tl, ll, wl, xout);
            SEAM(pb + 7);
        }
    }
#undef IN
#undef SEAM
}

#ifndef MK_ONE_LAUNCH
#define MK_ONE_LAUNCH 1
#endif
extern "C" void kernel_launch(void* const* d_in, const int* in_sizes, int n_in, void* d_out, int out_size, void* d_ws, size_t ws_size, hipStream_t stream) {
    static int grid = 0;
    if (grid == 0) {
        if (n_in != 25 || out_size != NTOK * D || ws_size < WS_END) { fprintf(stderr, "kernel_launch: unexpected shapes: n_in %d out %d ws %zu (need %zu)\n", n_in, out_size, ws_size, (size_t)WS_END); grid = -1; return; }
        int dev = 0, cus = 0, per_cu = 0;
        if (hipGetDevice(&dev) != hipSuccess || hipDeviceGetAttribute(&cus, hipDeviceAttributeMultiprocessorCount, dev) != hipSuccess) { grid = -1; return; }
        if (hipFuncSetAttribute((const void*)mk_fwd, hipFuncAttributeMaxDynamicSharedMemorySize, LDS_BYTES) != hipSuccess) { fprintf(stderr, "kernel_launch: hipFuncSetAttribute failed\n"); grid = -1; return; }
        if (hipOccupancyMaxActiveBlocksPerMultiprocessor(&per_cu, (const void*)mk_fwd, 512, LDS_BYTES) != hipSuccess || per_cu < 1) fprintf(stderr, "kernel_launch: occupancy query says %d\n", per_cu);
        (void)hipGetLastError();
        grid = cus;
    }
    if (grid < 0) return;
    (void)hipMemsetAsync((char*)d_ws + WS_CTL, 0, CTL_ZERO_BYTES, stream);
    Params p{};
    for (int i = 0; i < 25; ++i) p.in[i] = (const float*)d_in[i];
    p.out = (float*)d_out; p.ws = (unsigned char*)d_ws;
    for (int i = 0; i < 32; ++i) p.inv_rev[i] = pow(10000.0, -(double)i / 32.0) / (2.0 * 3.14159265358979323846);
    for (int h = 0; h < 4; ++h) p.lg2[h] = (float)log2(1.0 - pow(2.0, -5.0 - (double)h));
#if MK_ONE_LAUNCH
    p.ph_lo = 0; p.ph_hi = N_PHASES; p.use_bar = 1;
    hipLaunchKernelGGL(mk_fwd, dim3(grid), dim3(512), LDS_BYTES, stream, p);
#else
    for (int k = 0; k < N_PHASES; ++k) { p.ph_lo = k; p.ph_hi = k + 1; p.use_bar = 0;
        hipLaunchKernelGGL(mk_fwd, dim3(grid), dim3(512), LDS_BYTES, stream, p); }
#endif
}
```

```cpp
#include <hip/hip_runtime.h>
#include <cstdio>
#include <cstdint>
#include <cmath>
#define LAS __attribute__((address_space(3)))
namespace pg8 {
#define PG8_LAS __attribute__((address_space(3)))
typedef unsigned short bf16_t;
typedef short bf16x8 __attribute__((ext_vector_type(8)));
typedef float f32x4 __attribute__((ext_vector_type(4)));
typedef unsigned u32x4 __attribute__((ext_vector_type(4)));
constexpr int BM = 256, BK = 64, HALF = 128, HTB = HALF * BK * 2  , STAGE_BYTES = 8 * HTB, NXCD = 8, WGM = 8;

__host__ __device__ __forceinline__ int lds_byte(int r, int c) { const int st = (r >> 4) * 2 + (c >> 5), rr = r & 15, cc = c & 31, ob = rr * 64 + cc * 2; return st * 1024 + (ob ^ (((ob >> 9) & 1) << 5)); }
__host__ __device__ __forceinline__ void stage_rc(int b, int& R, int& C) { const int st = b / 1024, sb = b % 1024, swz = sb ^ (((sb >> 9) & 1) << 5); R = (st >> 1) * 16 + swz / 64; C = (st & 1) * 32 + (swz % 64) / 2; }
__host__ __device__ __forceinline__ int perm32(int rho) { const int n = rho >> 4, i = rho & 15; return 8 * (i >> 2) + 4 * n + (i & 3); }

struct Unit { int pm, pn; };
struct Gemm { const bf16_t* A; const bf16_t* Bt; int M, N, K; };

struct StaticOrder {
    int nM, nN, nwg, G, c;
    __host__ __device__ void init(int M, int N, int G_, int c_) { nM = M / BM; nN = N / BM; nwg = nM * nN; G = G_; c = c_; }
    __host__ __device__ bool next(int i, Unit& u) const {
        const long L = (long)i * G + c; if (L >= nwg) return false;
        int wgid = (int)L; { const int q = nwg / NXCD, r = nwg % NXCD, xcd = wgid % NXCD, off = wgid / NXCD; wgid = (xcd < r ? xcd * (q + 1) : r * (q + 1) + (xcd - r) * q) + off; }
        const int nig = WGM * nN, gid = wgid / nig, fm = gid * WGM, gsz = (nM - fm) < WGM ? (nM - fm) : WGM;
        u.pm = fm + ((wgid % nig) % gsz); u.pn = (wgid % nig) / gsz; return true;
    }
    __device__ __forceinline__ void a_ready(const Unit&) const {}
    __device__ __forceinline__ void done(const Unit&) const {}
};
__device__ __forceinline__ unsigned cvt_pk_bf16(float lo, float hi) { unsigned r; asm volatile("v_cvt_pk_bf16_f32 %0, %1, %2" : "=v"(r) : "v"(lo), "v"(hi)); return r; }
typedef float f32x2 __attribute__((ext_vector_type(2)));
__device__ __forceinline__ float gelu_tanh_f(float x) {
    const float u = 1.5957691216057308f * (x + 0.044715f * x * x * x);
    return x * __builtin_amdgcn_rcpf(1.0f + __expf(-u));
}
struct EpiH {
    static constexpr bool PERM = true, AFTER_DRAIN = false;
    bf16_t* O; int ldc; int act_lo, act_hi;
    __device__ __forceinline__ void operator()(const f32x4 (&acc)[2][2][4][2], const Unit& u, int wr, int wc, int fr, int fq) const {
        const int row0 = u.pm * BM + wr * 64 + fr; const int col0 = u.pn * BM + wc * 32 + 8 * fq;
        const bool act = (u.pn >= act_lo) && (u.pn < act_hi);
#pragma unroll
        for (int ai = 0; ai < 2; ++ai)
#pragma unroll
            for (int m = 0; m < 4; ++m) { bf16_t* rowp = O + (size_t)(row0 + ai * HALF + m * 16) * ldc + col0;
#pragma unroll
                for (int bj = 0; bj < 2; ++bj) { f32x4 v0 = acc[ai][bj][m][0], v1 = acc[ai][bj][m][1];
                    if (act) {
#pragma unroll
                        for (int j = 0; j < 4; ++j) { v0[j] = gelu_tanh_f(v0[j]); v1[j] = gelu_tanh_f(v1[j]); } }
                    u32x4 w; w.x = cvt_pk_bf16(v0[0], v0[1]); w.y = cvt_pk_bf16(v0[2], v0[3]); w.z = cvt_pk_bf16(v1[0], v1[1]); w.w = cvt_pk_bf16(v1[2], v1[3]);
                    *(u32x4*)(rowp + bj * HALF) = w; } }
    }
};
struct EpiRes {
    static constexpr bool PERM = false, AFTER_DRAIN = false;
    float* C; const float* X; int ldc; float alpha;
    __device__ __forceinline__ void operator()(const f32x4 (&acc)[2][2][4][2], const Unit& u, int wr, int wc, int fr, int fq) const {
        const int row0 = u.pm * BM + wr * 64 + fr, col0 = u.pn * BM + wc * 32 + 4 * fq;
#pragma unroll
        for (int ai = 0; ai < 2; ++ai)
#pragma unroll
            for (int m = 0; m < 4; ++m) { const size_t off = (size_t)(row0 + ai * HALF + m * 16) * ldc + col0;
#pragma unroll
                for (int bj = 0; bj < 2; ++bj)
#pragma unroll
                    for (int n = 0; n < 2; ++n) { const size_t o2 = off + bj * HALF + n * 16; const f32x4 xv = *(const f32x4*)(X + o2); *(f32x4*)(C + o2) = acc[ai][bj][m][n] + xv * alpha; } }
    }
};
struct EpiF32 {
    static constexpr bool PERM = false, AFTER_DRAIN = false;
    float* C; int ldc;
    __device__ __forceinline__ void operator()(const f32x4 (&acc)[2][2][4][2], const Unit& u, int wr, int wc, int fr, int fq) const {
        const int row0 = u.pm * BM + wr * 64 + fr, col0 = u.pn * BM + wc * 32 + 4 * fq;
#pragma unroll
        for (int ai = 0; ai < 2; ++ai)
#pragma unroll
            for (int m = 0; m < 4; ++m) { float* rowp = C + (size_t)(row0 + ai * HALF + m * 16) * ldc + col0;
#pragma unroll
                for (int bj = 0; bj < 2; ++bj)
#pragma unroll
                    for (int n = 0; n < 2; ++n) *(f32x4*)(rowp + bj * HALF + n * 16) = acc[ai][bj][m][n]; }
    }
};
template <class Epi, class Sched, bool ALIGN_EPI = false, bool SP2 = false>
__device__ __forceinline__ void gemm_phase(PG8_LAS unsigned char* lds, const Gemm g, const Sched& S, const Epi& E, const int tid) {
    const int wid = __builtin_amdgcn_readfirstlane(tid >> 6), lane = tid & 63, wr = wid >> 2, wc = wid & 3, fr = lane & 15, fq = lane >> 4;
    const int K = g.K, nt = K / BK;
    unsigned voffA[2], voffB[2];
#pragma unroll
    for (int i = 0; i < 2; ++i) { int R, C; stage_rc(tid * 16 + i * 8192, R, C); const int Rb = Epi::PERM ? ((R & ~31) + perm32(R & 31)) : R;
        voffA[i] = (unsigned)(R * K + C) * 2u; voffB[i] = (unsigned)(Rb * K + C) * 2u; }
    const size_t kstep = (size_t)(BK * 2);
    const size_t hstep = (size_t)HALF * K * 2;
    const size_t tstep = 2 * hstep;
    const unsigned ldsw = (unsigned)wid * 1024u;
    const int aoff = lds_byte(wr * 64 + fr, fq * 8), boff = lds_byte(wc * 32 + fr, fq * 8);
#define PG8_SA(b, h) (((b) * 2 + (h)) * HTB)
#define PG8_SB(b, h) ((4 + (b) * 2 + (h)) * HTB)
#define PG8_STAGE(bufoff, gbase, voff) do { _Pragma("unroll") for (int _i = 0; _i < 2; ++_i) \
        __builtin_amdgcn_global_load_lds((const unsigned*)((const char*)(gbase) + (voff)[_i]), (PG8_LAS unsigned*)(lds + (bufoff) + ldsw + _i * 8192), 16, 0, 0); } while (0)
#define PG8_LDA(dst, b, h) do { _Pragma("unroll") for (int m = 0; m < 4; ++m) _Pragma("unroll") for (int k = 0; k < 2; ++k) dst[m][k] = *(const PG8_LAS bf16x8*)(lds + PG8_SA(b, h) + aoff + m * 2048 + k * 1024); } while (0)
#define PG8_LDB(dst, b, h) do { _Pragma("unroll") for (int n = 0; n < 2; ++n) _Pragma("unroll") for (int k = 0; k < 2; ++k) dst[n][k] = *(const PG8_LAS bf16x8*)(lds + PG8_SB(b, h) + boff + n * 2048 + k * 1024); } while (0)
#define PG8_MMA(ai, bj, At, Bt) do { __builtin_amdgcn_s_setprio(1); _Pragma("unroll") for (int m = 0; m < 4; ++m) _Pragma("unroll") for (int n = 0; n < 2; ++n) _Pragma("unroll") for (int k = 0; k < 2; ++k) \
        acc[ai][bj][m][n] = __builtin_amdgcn_mfma_f32_16x16x32_bf16(Bt[n][k], At[m][k], acc[ai][bj][m][n], 0, 0, 0); __builtin_amdgcn_s_setprio(0); } while (0)
#define PG8_WAIT_V(n) asm volatile("s_waitcnt vmcnt(" #n ")" ::: "memory")
#define PG8_WAIT_L(n) asm volatile("s_waitcnt lgkmcnt(" #n ")" ::: "memory")
#define PG8_BAR __builtin_amdgcn_s_barrier()
#define PG8_SCHED __builtin_amdgcn_sched_barrier(0)
    Unit cur, nxt; int ui = 0;
    if (!S.next(0, cur)) return;
    f32x4 acc[2][2][4][2];
#pragma unroll
    for (int a = 0; a < 2; ++a)
#pragma unroll
        for (int b = 0; b < 2; ++b)
#pragma unroll
            for (int m = 0; m < 4; ++m)
#pragma unroll
                for (int n = 0; n < 2; ++n) acc[a][b][m][n] = (f32x4){0.f, 0.f, 0.f, 0.f};
    bf16x8 At[4][2], B0[2][2], B1[2][2];
    const char* cA = (const char*)g.A + (size_t)cur.pm * tstep; const char* cB = (const char*)g.Bt + (size_t)cur.pn * tstep;
    S.a_ready(cur);
    if constexpr (SP2) {
        PG8_STAGE(PG8_SB(0, 0), cB, voffB); PG8_STAGE(PG8_SB(0, 1), cB + hstep, voffB); PG8_STAGE(PG8_SA(0, 0), cA, voffA); PG8_STAGE(PG8_SA(0, 1), cA + hstep, voffA);
        if (wr == 1) PG8_BAR;
        PG8_WAIT_V(2); PG8_BAR;
        PG8_STAGE(PG8_SB(1, 0), cB + kstep, voffB); PG8_STAGE(PG8_SA(1, 0), cA + kstep, voffA); PG8_STAGE(PG8_SB(1, 1), cB + hstep + kstep, voffB);
        PG8_WAIT_V(6); PG8_BAR;
    } else {
        PG8_STAGE(PG8_SB(0, 0), cB, voffB); PG8_STAGE(PG8_SA(0, 0), cA, voffA); PG8_STAGE(PG8_SB(0, 1), cB + hstep, voffB); PG8_STAGE(PG8_SA(0, 1), cA + hstep, voffA);
        if (wr == 1) PG8_BAR;
        PG8_WAIT_V(4); PG8_BAR;
        PG8_STAGE(PG8_SB(1, 0), cB + kstep, voffB); PG8_STAGE(PG8_SA(1, 0), cA + kstep, voffA); PG8_STAGE(PG8_SB(1, 1), cB + hstep + kstep, voffB);
        PG8_WAIT_V(6); PG8_BAR;
    }
    for (;;) {
        const bool has_next = S.next(ui + 1, nxt);
        const char* nA = has_next ? (const char*)g.A + (size_t)nxt.pm * tstep : cA; const char* nB = has_next ? (const char*)g.Bt + (size_t)nxt.pn * tstep : cB;
        for (int t = 0; t < nt; t += 2) {
            const bool last = (t == nt - 2);
            const char* a1 = cA + (size_t)(t + 1) * kstep;
            const char* a2 = last ? nA : cA + (size_t)(t + 2) * kstep; const char* b2 = last ? nB : cB + (size_t)(t + 2) * kstep;
            const char* a3 = a2 + kstep; const char* b3 = b2 + kstep;
            if (last && has_next) S.a_ready(nxt);
            if constexpr (SP2) {
            PG8_LDB(B0, 0, 0); PG8_LDB(B1, 0, 1); PG8_SCHED; PG8_LDA(At, 0, 0); PG8_STAGE(PG8_SA(1, 1), a1 + hstep, voffA);
            PG8_WAIT_V(8); PG8_WAIT_L(0); PG8_BAR; PG8_MMA(0, 0, At, B0); PG8_MMA(0, 1, At, B1); PG8_BAR; PG8_SCHED;
            PG8_LDA(At, 0, 1); PG8_STAGE(PG8_SB(0, 0), b2, voffB); PG8_STAGE(PG8_SB(0, 1), b2 + hstep, voffB); PG8_STAGE(PG8_SA(0, 0), a2, voffA);
            PG8_WAIT_V(8); PG8_WAIT_L(0); PG8_BAR; PG8_MMA(1, 0, At, B0); PG8_MMA(1, 1, At, B1); PG8_BAR; PG8_SCHED;
            PG8_LDB(B0, 1, 0); PG8_LDB(B1, 1, 1); PG8_SCHED; PG8_LDA(At, 1, 0); PG8_STAGE(PG8_SA(0, 1), a2 + hstep, voffA);
            PG8_WAIT_V(8); PG8_WAIT_L(0); PG8_BAR; PG8_MMA(0, 0, At, B0); PG8_MMA(0, 1, At, B1); PG8_BAR; PG8_SCHED;
            PG8_LDA(At, 1, 1); PG8_STAGE(PG8_SB(1, 0), b3, voffB); PG8_STAGE(PG8_SB(1, 1), b3 + hstep, voffB); PG8_STAGE(PG8_SA(1, 0), a3, voffA);
            PG8_WAIT_V(8); PG8_WAIT_L(0); PG8_BAR; PG8_MMA(1, 0, At, B0); PG8_MMA(1, 1, At, B1); PG8_BAR; PG8_SCHED;
            } else {
            PG8_LDB(B0, 0, 0); PG8_SCHED; PG8_LDA(At, 0, 0); PG8_STAGE(PG8_SA(1, 1), a1 + hstep, voffA);
            PG8_WAIT_L(8); PG8_BAR; PG8_WAIT_L(0); PG8_MMA(0, 0, At, B0); PG8_BAR; PG8_SCHED;
            PG8_LDB(B1, 0, 1); PG8_STAGE(PG8_SB(0, 0), b2, voffB);
            PG8_BAR; PG8_WAIT_L(0); PG8_MMA(0, 1, At, B1); PG8_BAR;
            PG8_LDA(At, 0, 1); PG8_STAGE(PG8_SA(0, 0), a2, voffA);
            PG8_BAR; PG8_WAIT_L(0); PG8_MMA(1, 0, At, B0); PG8_BAR; PG8_SCHED;
            PG8_STAGE(PG8_SB(0, 1), b2 + hstep, voffB);
            PG8_WAIT_V(6); PG8_BAR; PG8_MMA(1, 1, At, B1); PG8_BAR;
            PG8_LDB(B0, 1, 0); PG8_SCHED; PG8_LDA(At, 1, 0); PG8_STAGE(PG8_SA(0, 1), a2 + hstep, voffA);
            PG8_WAIT_L(8); PG8_BAR; PG8_WAIT_L(0); PG8_MMA(0, 0, At, B0); PG8_BAR; PG8_SCHED;
            PG8_LDB(B1, 1, 1); PG8_STAGE(PG8_SB(1, 0), b3, voffB);
            PG8_BAR; PG8_WAIT_L(0); PG8_MMA(0, 1, At, B1); PG8_BAR;
            PG8_LDA(At, 1, 1); PG8_STAGE(PG8_SA(1, 0), a3, voffA);
            PG8_BAR; PG8_WAIT_L(0); PG8_MMA(1, 0, At, B0); PG8_BAR; PG8_SCHED;
            PG8_STAGE(PG8_SB(1, 1), b3 + hstep, voffB);
            PG8_WAIT_V(6); PG8_BAR; PG8_MMA(1, 1, At, B1); PG8_BAR;
            }
        }
        if constexpr (ALIGN_EPI) { if (wr == 0) PG8_BAR; }
        if constexpr (!Epi::AFTER_DRAIN) { E(acc, cur, wr, wc, fr, fq); S.done(cur); }
        if (!has_next) break;
#pragma unroll
        for (int a = 0; a < 2; ++a)
#pragma unroll
            for (int b = 0; b < 2; ++b)
#pragma unroll
                for (int m = 0; m < 4; ++m)
#pragma unroll
                    for (int n = 0; n < 2; ++n) acc[a][b][m][n] = (f32x4){0.f, 0.f, 0.f, 0.f};
        cur = nxt; cA = nA; cB = nB; ++ui;
        if constexpr (ALIGN_EPI) { if (wr == 1) PG8_BAR; }
    }
    PG8_WAIT_V(0);
    if constexpr (!ALIGN_EPI) { if (wr == 0) PG8_BAR; }
    PG8_BAR;
    if constexpr (Epi::AFTER_DRAIN) { E.fused(acc, cur, wr, wc, fr, fq, lds, wid, lane); S.done(cur); }
#undef PG8_SA
#undef PG8_SB
#undef PG8_STAGE
#undef PG8_LDA
#undef PG8_LDB
#undef PG8_MMA
#undef PG8_WAIT_V
#undef PG8_WAIT_L
#undef PG8_BAR
#undef PG8_SCHED
}
}
#define XB_TMO      128
#define XB_XCNT(j)  (256  + 64 * (j))
#define XB_XSUB(j)  (1280 + 64 * (j))
#define XB_XGEN(j)  (2304 + 64 * (j))
#define XB_TOP      3328
#define XB_TOPGEN   3392
#define XCD_BAR_WORDS 3456
#define XB_SPIN_CAP (1u << 18)

__device__ __forceinline__ unsigned xb_ld(unsigned* p)              { return __hip_atomic_load(p, __ATOMIC_RELAXED, __HIP_MEMORY_SCOPE_AGENT); }
__device__ __forceinline__ unsigned xb_add(unsigned* p, unsigned v) { return __hip_atomic_fetch_add(p, v, __ATOMIC_RELAXED, __HIP_MEMORY_SCOPE_AGENT); }
__device__ __forceinline__ unsigned xb_xcc_id() { return (unsigned)__builtin_amdgcn_s_getreg((3 << 11) | 20) & 0xFu; }
#define XB_SPIN(cond, bar) do { unsigned _sp = 0; while (cond) { __builtin_amdgcn_s_sleep(1); \
    if ((++_sp & 255u) == 0u) { if (xb_ld(&(bar)[XB_TMO])) break; if (_sp > XB_SPIN_CAP) { atomicAdd(&(bar)[XB_TMO], 1u); break; } } } } while (0)

struct XcdBarrier {
    unsigned* bar; unsigned x; unsigned w0;
    volatile LAS unsigned* st;
};

__device__ __forceinline__ bool xb_tid0(unsigned w0) { return w0 != 0u && __builtin_amdgcn_mbcnt_hi(0xffffffffu, __builtin_amdgcn_mbcnt_lo(0xffffffffu, 0u)) == 0u; }
__device__ __forceinline__ XcdBarrier xcd_barrier_post(unsigned* bar, volatile LAS unsigned* st) {
    XcdBarrier b; b.bar = bar; b.x = xb_xcc_id(); b.st = st; b.w0 = (__builtin_amdgcn_readfirstlane(threadIdx.x >> 6) == 0) ? 1u : 0u;
    if (threadIdx.x == 0) (void)xb_add(&bar[XB_XCNT(b.x)], 1u);
    return b;
}
__device__ __forceinline__ void xcd_barrier_complete(unsigned* bar, unsigned x, unsigned& nloc, unsigned& nx) {
    const unsigned G = gridDim.x * gridDim.y * gridDim.z;
    unsigned sum, cnt, mine, sp = 0u;
    for (;;) {
        sum = 0u; cnt = 0u; mine = 0u;
#pragma unroll
        for (unsigned j = 0; j < 16; ++j) { const unsigned c = xb_ld(&bar[XB_XCNT(j)]); sum += c; cnt += (c > 0u) ? 1u : 0u; mine = (j == x) ? c : mine; }
        if (sum == G) break;
        __builtin_amdgcn_s_sleep(1);
        if ((++sp & 255u) == 0u) { if (xb_ld(&bar[XB_TMO])) break; if (sp > XB_SPIN_CAP) { atomicAdd(&bar[XB_TMO], 1u); break; } }
    }
    nloc = mine > 0u ? mine : 1u; nx = cnt > 0u ? cnt : 1u;
}

__device__ __forceinline__ void xcd_barrier(const XcdBarrier& b) {
    asm volatile("s_waitcnt vmcnt(0)" ::: "memory");
    __syncthreads();
    if (xb_tid0(b.w0)) {
        unsigned* bar = b.bar;
        __builtin_amdgcn_s_waitcnt(0);
        unsigned nloc = b.st[0], nx = b.st[1];
        if (nloc == 0u) { xcd_barrier_complete(bar, b.x, nloc, nx); b.st[0] = nloc; b.st[1] = nx; }
        const unsigned old = xb_add(&bar[XB_XSUB(b.x)], 1u);
        const unsigned gen = old / nloc;
        if (old + 1u == (gen + 1u) * nloc) {
            __builtin_amdgcn_fence(__ATOMIC_RELEASE, "agent");
            asm volatile("s_waitcnt vmcnt(0)" ::: "memory");
            const unsigned og = xb_add(&bar[XB_TOP], 1u);
            const unsigned tg = og / nx;
            if (og + 1u == (tg + 1u) * nx) xb_add(&bar[XB_TOPGEN], 1u);
            else XB_SPIN(xb_ld(&bar[XB_TOPGEN]) == tg, bar);
            __builtin_amdgcn_fence(__ATOMIC_ACQUIRE, "agent");
            xb_add(&bar[XB_XGEN(b.x)], 1u);
            asm volatile("s_waitcnt vmcnt(0)" ::: "memory");
        } else {
            XB_SPIN(xb_ld(&bar[XB_XGEN(b.x)]) == gen, bar);
            __builtin_amdgcn_fence(__ATOMIC_ACQUIRE, "agent");
            asm volatile("s_waitcnt vmcnt(0)" ::: "memory");
        }
    }
    __syncthreads();
}

#ifndef PROBE_DUP
#define PROBE_DUP -1
#endif
#define REP(i) for (int rep_ = 0; rep_ < ((PROBE_DUP == (i)) ? 2 : 1); ++rep_)
constexpr int NB = 4, T = 2048, D = 2048, NTOK = NB * T, DEPTH = 4;
constexpr int INW = 5168, INWP = 5376;
constexpr int C_RQ = 0, C_RK = 256, C_RV = 512, C_RG = 1024, C_SU = 1536, C_SV = 2048, C_NQ = 2560, C_KC = 3584, C_VC = 3840, C_KS = 4096, C_VS = 4352, C_KW = 4608, C_VW = 4864, C_NG = 5120;
constexpr float ALPHA = 1.6817928305074290f;
constexpr float LN_EPS = 1e-5f;
constexpr float LOG2E = 1.4426950408889634f;

constexpr size_t MiB = (size_t)1 << 20;
constexpr size_t WS_CTL = 0, CTL_ZERO_BYTES = 1 * MiB;
constexpr size_t WS_ROPE = 1 * MiB;
constexpr size_t WS_WIN = 2 * MiB;
constexpr size_t WS_WOUT = 86 * MiB;
constexpr size_t WS_WQ = 118 * MiB;
constexpr size_t WS_PU = 160 * MiB;
constexpr size_t WS_PV = 416 * MiB;
constexpr size_t WS_H = 672 * MiB;
constexpr size_t WS_YMIX = 756 * MiB;
constexpr size_t WS_MIXED = 820 * MiB;
constexpr size_t WS_Z = 852 * MiB;
constexpr size_t WS_X1 = 916 * MiB;
constexpr size_t WS_X1B = 980 * MiB;
constexpr size_t WS_QP = 1012 * MiB;
constexpr size_t WS_XC = 1076 * MiB;
constexpr size_t WS_XB = 1140 * MiB;
constexpr size_t WS_KC = 1172 * MiB;
constexpr size_t WS_KVST = 1174 * MiB;
constexpr size_t WS_SC = 1184 * MiB;
constexpr size_t WS_PSC = 1248 * MiB;
constexpr size_t WS_W1T = 1250 * MiB;
constexpr size_t WS_W2T = 1258 * MiB;
constexpr size_t WS_PKB = 1260 * MiB;
#ifndef PEER_NBKT
#define PEER_NBKT 8
#endif
constexpr int NBKT = PEER_NBKT, NRND = NBKT / 8, FCAP = 4096, BSH = (NBKT == 16) ? 10 : 11;
constexpr size_t WS_FE = 1262 * MiB;
constexpr size_t WS_FW = 1326 * MiB;
constexpr size_t WS_FHW = 1390 * MiB;
constexpr size_t WS_GST = 1454 * MiB;
constexpr size_t WS_PART = 1456 * MiB;
constexpr size_t WS_END = 1712 * MiB;
constexpr int CW_BAR = 4096;

constexpr int LDS_BYTES = 147456;
constexpr int MISC_OFF = 143360;

#define GAS __attribute__((address_space(1)))
typedef float f4 __attribute__((ext_vector_type(4)));
typedef float f2 __attribute__((ext_vector_type(2)));
typedef unsigned u4 __attribute__((ext_vector_type(4)));
typedef unsigned u2 __attribute__((ext_vector_type(2)));
__device__ __forceinline__ f4 mk_f4(float a, float b, float c, float d) { f4 r; r.x = a; r.y = b; r.z = c; r.w = d; return r; }
__device__ __forceinline__ f2 mk_f2(float a, float b) { f2 r; r.x = a; r.y = b; return r; }
__device__ __forceinline__ u2 mk_u2(unsigned a, unsigned b) { u2 r; r.x = a; r.y = b; return r; }
typedef unsigned short bf16;
#define LDS_WAIT() asm volatile("s_waitcnt lgkmcnt(0)" ::: "memory")
#define VM_WAIT() asm volatile("s_waitcnt vmcnt(0)" ::: "memory")

struct Params {
    const float* in[25];
    float* out;
    unsigned char* ws;
    double inv_rev[32];
    float lg2[4];
    int ph_lo, ph_hi, use_bar, pad0;
};

__device__ __forceinline__ float bf2f(unsigned short b) { return __uint_as_float(((unsigned)b) << 16); }
__device__ __forceinline__ unsigned f2bf(float f) { unsigned u = __float_as_uint(f); return (u + 0x7fffu + ((u >> 16) & 1u)) >> 16; }
__device__ __forceinline__ unsigned pk2(float lo, float hi) { return f2bf(lo) | (f2bf(hi) << 16); }
__device__ __forceinline__ float wave_sum(float v) {
#pragma unroll
    for (int o = 1; o < 64; o <<= 1) v += __shfl_xor(v, o);
    return v;
}
__device__ __forceinline__ void unpack8(const u4& v, float* f) {
    f[0] = __uint_as_float(v.x << 16); f[1] = __uint_as_float(v.x & 0xffff0000u);
    f[2] = __uint_as_float(v.y << 16); f[3] = __uint_as_float(v.y & 0xffff0000u);
    f[4] = __uint_as_float(v.z << 16); f[5] = __uint_as_float(v.z & 0xffff0000u);
    f[6] = __uint_as_float(v.w << 16); f[7] = __uint_as_float(v.w & 0xffff0000u);
}
__device__ __forceinline__ float gelu_tanh(float x) { return pg8::gelu_tanh_f(x); }

__device__ __forceinline__ void transpose_tile(const float* __restrict__ W, int K, int N, bf16* __restrict__ WT, LAS float* scr, int kb, int nb, int lane) {
    const int k0 = kb * 64, n0 = nb * 32, nn = lane & 31; const bool ok = (n0 + nn) < N;
#pragma unroll 8
    for (int i = 0; i < 32; ++i) { const int kk = 2 * i + (lane >> 5); scr[kk * 33 + nn] = ok ? W[(size_t)(k0 + kk) * N + n0 + nn] : 0.f; }
    LDS_WAIT();
    const int c = lane & 7;
#pragma unroll
    for (int j = 0; j < 4; ++j) { const int n = (lane >> 3) + 8 * j; const LAS float* s = scr + (8 * c) * 33 + n;
        u4 o; o.x = pk2(s[0 * 33], s[1 * 33]); o.y = pk2(s[2 * 33], s[3 * 33]); o.z = pk2(s[4 * 33], s[5 * 33]); o.w = pk2(s[6 * 33], s[7 * 33]);
        *(u4*)(WT + (size_t)(n0 + n) * K + k0 + 8 * c) = o; }
    LDS_WAIT();
}
__device__ __forceinline__ void cvt_bf16_stream(const float* __restrict__ src, bf16* __restrict__ dst, size_t nchunks, size_t gt, size_t GT) {
    for (size_t c = gt; c < nchunks; c += GT) { const f4 a = ((const f4*)src)[2 * c], b = ((const f4*)src)[2 * c + 1];
        u4 o; o.x = pk2(a.x, a.y); o.y = pk2(a.z, a.w); o.z = pk2(b.x, b.y); o.w = pk2(b.z, b.w); ((u4*)dst)[c] = o; }
}
__device__ __forceinline__ void phase_prologue(const Params& P, unsigned char* ws, LAS unsigned char* lds, int tid, int lane, int wave) {
    LAS float* scr = (LAS float*)(lds + wave * 8704);
    const int gw = blockIdx.x * 8 + wave, NGW = gridDim.x * 8;
    constexpr int I_IN = 32 * 168, I_SQ = 32 * 64, I_L = I_IN + 2 * I_SQ;
    for (int it = gw; it < DEPTH * I_L; it += NGW) {
        const int l = it / I_L; int r = it % I_L;
        if (r < I_IN) transpose_tile(P.in[1] + (size_t)l * D * INW, D, INW, (bf16*)(ws + WS_WIN) + (size_t)l * INWP * D, scr, r / 168, r % 168, lane);
        else { r -= I_IN;
            if (r < I_SQ) transpose_tile(P.in[15] + (size_t)l * D * D, D, D, (bf16*)(ws + WS_WOUT) + (size_t)l * D * D, scr, r / 64, r % 64, lane);
            else { r -= I_SQ; transpose_tile(P.in[18] + (size_t)l * D * D, D, D, (bf16*)(ws + WS_WQ) + (size_t)l * D * D, scr, r / 64, r % 64, lane); } }
    }
    for (int it = gw; it < DEPTH * 2 * (32 * 8 + 4 * 2); it += NGW) {
        const int lk = it / 264, r = it % 264, l = lk >> 1, kv = lk & 1;
        if (r < 256) transpose_tile(P.in[kv ? 12 : 9] + (size_t)l * 2048 * 256, 2048, 256, (bf16*)(ws + WS_W1T) + (size_t)lk * 256 * 2048, scr, r >> 3, r & 7, lane);
        else transpose_tile(P.in[kv ? 13 : 10] + (size_t)l * 256 * 64, 256, 64, (bf16*)(ws + WS_W2T) + (size_t)lk * 64 * 256, scr, (r - 256) >> 1, (r - 256) & 1, lane);
    }
    const size_t gt = (size_t)blockIdx.x * 512 + tid, GT = (size_t)gridDim.x * 512;
    for (int row = gw; row < 2 * DEPTH * 16384; row += NGW) {
        const int tab = row / (DEPTH * 16384), rr = row % (DEPTH * 16384);
        const float* src = P.in[21 + tab] + (size_t)rr * 2048;
        f4 v[8]; float am = 0.f;
#pragma unroll
        for (int j = 0; j < 2; ++j)
#pragma unroll
            for (int q = 0; q < 4; ++q) { const f4 a = *(const f4*)(src + 1024 * j + 16 * lane + 4 * q); v[4 * j + q] = a; am = fmaxf(am, fmaxf(fmaxf(fabsf(a.x), fabsf(a.y)), fmaxf(fabsf(a.z), fabsf(a.w)))); }
#pragma unroll
        for (int o = 1; o < 64; o <<= 1) am = fmaxf(am, __shfl_xor(am, o));
        const float sc = (am > 0.f) ? 448.f / am : 1.f;
        if (lane == 0) ((float*)(ws + WS_PSC))[row] = (am > 0.f) ? am * (1.f / 448.f) : 1.f;
        unsigned char* dst = ws + (tab ? WS_PV : WS_PU) + (size_t)rr * 2048;
#pragma unroll
        for (int j = 0; j < 2; ++j) { u4 w;
#pragma unroll
            for (int q = 0; q < 4; ++q) { const f4 a = v[4 * j + q]; int r = __builtin_amdgcn_cvt_pk_fp8_f32(a.x * sc, a.y * sc, 0, false); r = __builtin_amdgcn_cvt_pk_fp8_f32(a.z * sc, a.w * sc, r, true); w[q] = (unsigned)r; }
            *(u4*)(dst + 1024 * j + 16 * lane) = w; }
    }
    cvt_bf16_stream(P.in[0], (bf16*)(ws + WS_XB), (size_t)NTOK * D / 8, gt, GT);
    cvt_bf16_stream(P.in[19], (bf16*)(ws + WS_PKB), (size_t)DEPTH * 8 * 128 * 128 / 8, gt, GT);
    cvt_bf16_stream(P.in[20], (bf16*)(ws + WS_PKB) + (size_t)DEPTH * 8 * 128 * 128, (size_t)DEPTH * 8 * 128 * 128 / 8, gt, GT);
    f2* rope = (f2*)(ws + WS_ROPE);
    for (size_t idx = gt; idx < (size_t)T * 32; idx += GT) { const int t = (int)(idx >> 5), i = (int)(idx & 31);
        double a = (double)t * P.inv_rev[i]; a -= floor(a); const float fr = (float)a;
        rope[idx] = mk_f2(__builtin_amdgcn_cosf(fr), __builtin_amdgcn_sinf(fr)); }
}

__device__ __forceinline__ void stage_rot_k(const bf16* __restrict__ Hb, const f2* __restrict__ rope, LAS float* ks, int tok0, int tpos0, int colK, float lg2h, bool zeta, int tid) {
    const int m = tid >> 2, p = tid & 3;
    const bf16* src = Hb + (size_t)(tok0 + m) * INWP + colK + p * 8;
    const u4 a = *(const u4*)src, b = *(const u4*)(src + 32);
    float x1[8], x2[8]; unpack8(a, x1); unpack8(b, x2);
    const f4* rp = (const f4*)(rope + (size_t)(tpos0 + m) * 32 + p * 8);
    const f4 r0 = rp[0], r1 = rp[1], r2 = rp[2], r3 = rp[3];
    const float cs[8] = {r0.x, r0.z, r1.x, r1.z, r2.x, r2.z, r3.x, r3.z}, sn[8] = {r0.y, r0.w, r1.y, r1.w, r2.y, r2.w, r3.y, r3.w};
    const float sc = 0.125f * (zeta ? exp2f(lg2h * (float)(127 - m)) : 1.0f);
    float o1[8], o2[8];
#pragma unroll
    for (int i = 0; i < 8; ++i) { o1[i] = (x1[i] * cs[i] - x2[i] * sn[i]) * sc; o2[i] = (x1[i] * sn[i] + x2[i] * cs[i]) * sc; }
    LAS f4* d1 = (LAS f4*)(ks + m * 64 + p * 8); LAS f4* d2 = (LAS f4*)(ks + m * 64 + 32 + p * 8);
    d1[0] = mk_f4(o1[0], o1[1], o1[2], o1[3]); d1[1] = mk_f4(o1[4], o1[5], o1[6], o1[7]);
    d2[0] = mk_f4(o2[0], o2[1], o2[2], o2[3]); d2[1] = mk_f4(o2[4], o2[5], o2[6], o2[7]);
}
__device__ __forceinline__ void stage_v128(const bf16* __restrict__ Hb, LAS float* vs, int tok0, int colV, int tid) {
    const int m = tid >> 2, p = tid & 3;
    const u4* src = (const u4*)(Hb + (size_t)(tok0 + m) * INWP + colV + p * 32);
    LAS f4* dst = (LAS f4*)(vs + m * 128 + p * 32);
#pragma unroll
    for (int j = 0; j < 4; ++j) { const u4 a = src[j]; float f[8]; unpack8(a, f); dst[2 * j] = mk_f4(f[0], f[1], f[2], f[3]); dst[2 * j + 1] = mk_f4(f[4], f[5], f[6], f[7]); }
}

__device__ __forceinline__ void unit_kvstate(const Params& P, unsigned char* ws, LAS unsigned char* lds, int u, int tid) {
    const int b = u / 60, r = u % 60, h = r / 15, j = r % 15;
    const bf16* Hb = (const bf16*)(ws + WS_H); const f2* rope = (const f2*)(ws + WS_ROPE);
    LAS float* ks = (LAS float*)lds; LAS float* vs = (LAS float*)(lds + 32768);
    const int tok0 = b * T + j * 128;
    stage_rot_k(Hb, rope, ks, tok0, j * 128, C_RK + h * 64, P.lg2[h], true, tid);
    stage_v128(Hb, vs, tok0, C_RV + h * 128, tid);
    __syncthreads();
    const int d = tid >> 3, e0 = (tid & 7) * 16;
    float acc[16];
#pragma unroll
    for (int i = 0; i < 16; ++i) acc[i] = 0.f;
    #pragma unroll 1
    for (int m = 0; m < 128; ++m) { const float kd = ks[m * 64 + d]; const LAS f4* vp = (const LAS f4*)(vs + m * 128 + e0);
#pragma unroll
        for (int q = 0; q < 4; ++q) { const f4 v = vp[q]; acc[4 * q] += kd * v.x; acc[4 * q + 1] += kd * v.y; acc[4 * q + 2] += kd * v.z; acc[4 * q + 3] += kd * v.w; } }
    f4* dst = (f4*)((float*)(ws + WS_KVST) + ((size_t)((b * 4 + h) * 16 + j) * 64 + d) * 128 + e0);
#pragma unroll
    for (int q = 0; q < 4; ++q) dst[q] = mk_f4(acc[4 * q], acc[4 * q + 1], acc[4 * q + 2], acc[4 * q + 3]);
    __syncthreads();
}

__device__ __forceinline__ void unit_sgu(const Params& P, unsigned char* ws, int l, LAS unsigned char* lds, int u, int tid, int lane, int wave) {
    const int b = u >> 6, c = (u >> 2) & 15, g = u & 3;
    const bf16* Hb = (const bf16*)(ws + WS_H);
    LAS float* vn = (LAS float*)lds;
    LAS float* wsm = (LAS float*)(lds + 65536);
    const int tok0 = b * T + c * 128;
    const float* lng = P.in[4] + l * 512 + g * 128; const float* lnb = P.in[5] + l * 512 + g * 128;
    const float g0 = lng[2 * lane], g1 = lng[2 * lane + 1], b0 = lnb[2 * lane], b1 = lnb[2 * lane + 1];
    for (int i = 0; i < 16; ++i) { const int s = wave * 16 + i;
        const unsigned pr = *(const unsigned*)(Hb + (size_t)(tok0 + s) * INWP + C_SV + g * 128 + 2 * lane);
        const float v0 = __uint_as_float(pr << 16), v1 = __uint_as_float(pr & 0xffff0000u);
        const float mu = wave_sum(v0 + v1) * (1.f / 128.f); const float d0 = v0 - mu, d1 = v1 - mu;
        const float var = wave_sum(d0 * d0 + d1 * d1) * (1.f / 128.f); const float rstd = rsqrtf(var + LN_EPS);
        *(LAS f2*)(vn + s * 128 + 2 * lane) = mk_f2(d0 * rstd * g0 + b0, d1 * rstd * g1 + b1); }
    const float* wg = P.in[6] + ((size_t)l * 4 + g) * 16384;
    for (int i = 0; i < 32; ++i) { const int idx = tid + 512 * i; wsm[(idx >> 7) * 129 + (idx & 127)] = wg[idx]; }
    __syncthreads();
    const int t = tid >> 2, dg = tid & 3; const int smax = (t | 15);
    float acc[32];
#pragma unroll
    for (int i = 0; i < 32; ++i) acc[i] = 0.f;
    #pragma unroll 1
    for (int s = 0; s <= smax; ++s) { const float wv = (s <= t) ? wsm[t * 129 + s] : 0.f; const LAS f4* vp = (const LAS f4*)(vn + s * 128 + dg * 32);
#pragma unroll
        for (int q = 0; q < 8; ++q) { const f4 v = vp[q]; acc[4 * q] += wv * v.x; acc[4 * q + 1] += wv * v.y; acc[4 * q + 2] += wv * v.z; acc[4 * q + 3] += wv * v.w; } }
    const float bs = P.in[7][(l * 4 + g) * 128 + t];
    const u4* up = (const u4*)(Hb + (size_t)(tok0 + t) * INWP + C_SU + g * 128 + dg * 32);
    f4* yo = (f4*)((float*)(ws + WS_YMIX) + (size_t)(tok0 + t) * D + 512 + g * 128 + dg * 32);
#pragma unroll
    for (int j = 0; j < 4; ++j) { const u4 a = up[j]; float f[8]; unpack8(a, f);
        yo[2 * j] = mk_f4(f[0] * (acc[8 * j] + bs), f[1] * (acc[8 * j + 1] + bs), f[2] * (acc[8 * j + 2] + bs), f[3] * (acc[8 * j + 3] + bs));
        yo[2 * j + 1] = mk_f4(f[4] * (acc[8 * j + 4] + bs), f[5] * (acc[8 * j + 5] + bs), f[6] * (acc[8 * j + 6] + bs), f[7] * (acc[8 * j + 7] + bs)); }
    __syncthreads();
}

__device__ __forceinline__ void unit_compress(const Params& P, unsigned char* ws, int l, LAS unsigned char* lds, int u, int tid) {
    const int kv = u >> 7, b = (u >> 5) & 3, g = (u >> 3) & 3, r = u & 7;
    const bf16* Hb = (const bf16*)(ws + WS_H);
    LAS float* seg = (LAS float*)lds;
    LAS float* hid = (LAS float*)(lds + 69632);
    const int col0 = (kv ? C_VC : C_KC) + g * 64;
    const float* pe = P.in[kv ? 11 : 8] + (size_t)l * 2048;
    const float* w1 = P.in[kv ? 12 : 9] + (size_t)l * 2048 * 256;
    const float* w2 = P.in[kv ? 13 : 10] + (size_t)l * 256 * 64;
    for (int idx = tid; idx < 272 * 8; idx += 512) { const int tt = idx >> 3, d8 = (idx & 7) * 8; const int t = 256 * r + tt;
        float f[8];
        if (t < T) { const u4 a = *(const u4*)(Hb + (size_t)(b * T + t) * INWP + col0 + d8); unpack8(a, f); }
        else {
#pragma unroll
            for (int i = 0; i < 8; ++i) f[i] = 0.f; }
        LAS f4* dp = (LAS f4*)(seg + tt * 64 + d8); dp[0] = mk_f4(f[0], f[1], f[2], f[3]); dp[1] = mk_f4(f[4], f[5], f[6], f[7]); }
    __syncthreads();
    const int j = tid & 255, hb = tid >> 8;
    float acc[8], accpe = 0.f;
#pragma unroll
    for (int i = 0; i < 8; ++i) acc[i] = 0.f;
    for (int pos = 0; pos < 32; ++pos) {
#pragma unroll 2
        for (int d4 = 0; d4 < 16; ++d4) { const int kk = pos * 64 + d4 * 4;
            const float w0 = w1[(size_t)(kk + 0) * 256 + j], w1v = w1[(size_t)(kk + 1) * 256 + j], w2v = w1[(size_t)(kk + 2) * 256 + j], w3 = w1[(size_t)(kk + 3) * 256 + j];
            const f4 p4 = *(const f4*)(pe + kk);
            accpe += w0 * p4.x + w1v * p4.y + w2v * p4.z + w3 * p4.w;
#pragma unroll
            for (int ib = 0; ib < 8; ++ib) { const f4 s4 = *(const LAS f4*)(seg + (16 * (hb * 8 + ib) + pos) * 64 + d4 * 4);
                acc[ib] += w0 * s4.x + w1v * s4.y + w2v * s4.z + w3 * s4.w; } } }
#pragma unroll
    for (int ib = 0; ib < 8; ++ib) hid[(hb * 8 + ib) * 256 + j] = gelu_tanh(acc[ib] + accpe);
    __syncthreads();
    { const int i = tid >> 5, o2 = (tid & 31) * 2; float a0 = 0.f, a1 = 0.f;
        for (int jj = 0; jj < 256; ++jj) { const float hv = hid[i * 256 + jj]; const f2 w = *(const f2*)(w2 + jj * 64 + o2); a0 += hv * w.x; a1 += hv * w.y; }
        const int ci = 16 * r + i;
        if (ci <= 126) *(f2*)((float*)(ws + WS_KC) + ((size_t)((kv * 4 + b) * 4 + g) * 128 + ci) * 64 + o2) = mk_f2(a0, a1); }
    __syncthreads();
}

__device__ __forceinline__ void unit_retention(const Params& P, unsigned char* ws, int l, LAS unsigned char* lds, int u, int tid) {
    const int b = u >> 6, h = (u >> 4) & 3, c = u & 15;
    const bf16* Hb = (const bf16*)(ws + WS_H); const f2* rope = (const f2*)(ws + WS_ROPE);
    LAS float* regB = (LAS float*)lds;
    LAS float* vs = (LAS float*)(lds + 32768);
    LAS float* Qs = (LAS float*)(lds + 98304);
    const float lg2h = P.lg2[h];
    const int tok0 = b * T + c * 128;
    { float a[16];
#pragma unroll
        for (int i = 0; i < 16; ++i) a[i] = 0.f;
        const float* kvb = (const float*)(ws + WS_KVST) + (size_t)((b * 4 + h) * 16) * 8192 + tid * 16;
#pragma unroll 1
        for (int j = 0; j < c; ++j) { const float w = exp2f(lg2h * 128.f * (float)(c - 1 - j)); const f4* sp = (const f4*)(kvb + (size_t)j * 8192);
#pragma unroll
            for (int q = 0; q < 4; ++q) { const f4 v = sp[q]; a[4 * q] += w * v.x; a[4 * q + 1] += w * v.y; a[4 * q + 2] += w * v.z; a[4 * q + 3] += w * v.w; } }
        LAS f4* dp = (LAS f4*)(regB + tid * 16);
#pragma unroll
        for (int q = 0; q < 4; ++q) dp[q] = mk_f4(a[4 * q], a[4 * q + 1], a[4 * q + 2], a[4 * q + 3]); }
    const int n = tid >> 2, eg = tid & 3;
    float qa[8], qb[8];
    { const bf16* src = Hb + (size_t)(tok0 + n) * INWP + C_RQ + h * 64 + eg * 8;
        const u4 a = *(const u4*)src, bb = *(const u4*)(src + 32);
        float x1[8], x2[8]; unpack8(a, x1); unpack8(bb, x2);
        const f4* rp = (const f4*)(rope + (size_t)(c * 128 + n) * 32 + eg * 8);
        const f4 r0 = rp[0], r1 = rp[1], r2 = rp[2], r3 = rp[3];
        const float cs[8] = {r0.x, r0.z, r1.x, r1.z, r2.x, r2.z, r3.x, r3.z}, sn[8] = {r0.y, r0.w, r1.y, r1.w, r2.y, r2.w, r3.y, r3.w};
#pragma unroll
        for (int i = 0; i < 8; ++i) { qa[i] = x1[i] * cs[i] - x2[i] * sn[i]; qb[i] = x1[i] * sn[i] + x2[i] * cs[i]; Qs[n * 65 + eg * 8 + i] = qa[i]; Qs[n * 65 + 32 + eg * 8 + i] = qb[i]; } }
    __syncthreads();
    float acc[32];
#pragma unroll
    for (int i = 0; i < 32; ++i) acc[i] = 0.f;
#pragma unroll 2
    for (int d = 0; d < 64; ++d) { const float qd = Qs[n * 65 + d]; const LAS f4* sp = (const LAS f4*)(regB + d * 128 + eg * 32);
#pragma unroll
        for (int qq = 0; qq < 8; ++qq) { const f4 v = sp[qq]; acc[4 * qq] += qd * v.x; acc[4 * qq + 1] += qd * v.y; acc[4 * qq + 2] += qd * v.z; acc[4 * qq + 3] += qd * v.w; } }
    { const float xi = exp2f(lg2h * (float)(n + 1));
#pragma unroll
        for (int i = 0; i < 32; ++i) acc[i] *= xi; }
    __syncthreads();
    stage_rot_k(Hb, rope, regB, tok0, c * 128, C_RK + h * 64, lg2h, false, tid);
    stage_v128(Hb, vs, tok0, C_RV + h * 128, tid);
    __syncthreads();
    const int mmax = n | 15;
#pragma unroll 1
    for (int m = 0; m <= mmax; ++m) { const LAS f4* kp = (const LAS f4*)(regB + m * 64 + eg * 8); const LAS f4* kp2 = (const LAS f4*)(regB + m * 64 + 32 + eg * 8);
        const f4 k0 = kp[0], k1 = kp[1], k2 = kp2[0], k3 = kp2[1];
        float s = ((qa[0] * k0.x + qa[1] * k0.y) + (qa[2] * k0.z + qa[3] * k0.w)) + ((qa[4] * k1.x + qa[5] * k1.y) + (qa[6] * k1.z + qa[7] * k1.w))
                + ((qb[0] * k2.x + qb[1] * k2.y) + (qb[2] * k2.z + qb[3] * k2.w)) + ((qb[4] * k3.x + qb[5] * k3.y) + (qb[6] * k3.z + qb[7] * k3.w));
        s += __shfl_xor(s, 1); s += __shfl_xor(s, 2);
        const float a = (m <= n) ? s * exp2f(lg2h * (float)(n - m)) : 0.f;
        const LAS f4* vp = (const LAS f4*)(vs + m * 128 + eg * 32);
#pragma unroll
        for (int qq = 0; qq < 8; ++qq) { const f4 v = vp[qq]; acc[4 * qq] += a * v.x; acc[4 * qq + 1] += a * v.y; acc[4 * qq + 2] += a * v.z; acc[4 * qq + 3] += a * v.w; } }
    float s1 = 0.f;
#pragma unroll
    for (int i = 0; i < 32; ++i) s1 += acc[i];
    s1 += __shfl_xor(s1, 1); s1 += __shfl_xor(s1, 2);
    const float mu = s1 * (1.f / 128.f); float s2 = 0.f;
#pragma unroll
    for (int i = 0; i < 32; ++i) { const float dd = acc[i] - mu; s2 += dd * dd; }
    s2 += __shfl_xor(s2, 1); s2 += __shfl_xor(s2, 2);
    const float rstd = rsqrtf(s2 * (1.f / 128.f) + LN_EPS);
    const float* gg = P.in[2] + l * 512 + h * 128 + eg * 32; const float* gb = P.in[3] + l * 512 + h * 128 + eg * 32;
    const u4* gp = (const u4*)(Hb + (size_t)(tok0 + n) * INWP + C_RG + h * 128 + eg * 32);
    f4* yo = (f4*)((float*)(ws + WS_YMIX) + (size_t)(tok0 + n) * D + h * 128 + eg * 32);
#pragma unroll
    for (int j = 0; j < 4; ++j) { const u4 a = gp[j]; float f[8]; unpack8(a, f); float o[8];
#pragma unroll
        for (int i = 0; i < 8; ++i) { const float y = (acc[8 * j + i] - mu) * rstd * gg[8 * j + i] + gb[8 * j + i]; const float gv = f[i]; o[i] = y * gv * __builtin_amdgcn_rcpf(1.f + __expf(-gv)); }
        yo[2 * j] = mk_f4(o[0], o[1], o[2], o[3]); yo[2 * j + 1] = mk_f4(o[4], o[5], o[6], o[7]); }
    __syncthreads();
}

typedef pg8::bf16x8 bf16x8;
typedef short s16x4 __attribute__((ext_vector_type(4)));
typedef __bf16 bf16x2_t __attribute__((ext_vector_type(2)));
__device__ __forceinline__ unsigned pkbf(float a, float b) { f2 v; v.x = a; v.y = b; return __builtin_bit_cast(unsigned, __builtin_convertvector(v, bf16x2_t)); }
#define MFMA16(a, b, c) __builtin_amdgcn_mfma_f32_16x16x32_bf16((a), (b), (c), 0, 0, 0)
constexpr int NS = 80;
constexpr float NSA_SC = 0.125f * LOG2E;
__device__ __forceinline__ void nsa_scores(f4 (&st)[4][2], const LAS bf16* Kl, const bf16x8 (&Yq)[2][2], int lane) {
    const int r = lane & 15, kq = lane >> 4;
#pragma unroll
    for (int kt = 0; kt < 4; ++kt) { const LAS bf16* kp = Kl + (16 * kt + r) * NS + 8 * kq;
        const bf16x8 k0 = *(const LAS bf16x8*)kp, k1 = *(const LAS bf16x8*)(kp + 32);
#pragma unroll
        for (int qp = 0; qp < 2; ++qp) { f4 a = mk_f4(0.f, 0.f, 0.f, 0.f); a = MFMA16(k0, Yq[qp][0], a); a = MFMA16(k1, Yq[qp][1], a); st[kt][qp] = a; } }
}
__device__ __forceinline__ void nsa_softmax_pv(f4 (&st)[4][2], float (&m)[2], float (&l)[2], f4 (&ot)[4][2], const LAS bf16* Vl, const int (&lo)[2], const int (&hi)[2], bool need_mask, int lane) {
    const int kq = lane >> 4, q = (lane & 15) >> 2, p = lane & 3;
    bf16x8 Pf[2][2];
#pragma unroll
    for (int qp = 0; qp < 2; ++qp) {
        if (need_mask) {
#pragma unroll
            for (int kt = 0; kt < 4; ++kt)
#pragma unroll
                for (int i = 0; i < 4; ++i) { const int kl = 16 * kt + 4 * kq + i; if (kl < lo[qp] || kl > hi[qp]) st[kt][qp][i] = -1e30f; } }
        float mx = st[0][qp][0];
#pragma unroll
        for (int kt = 0; kt < 4; ++kt)
#pragma unroll
            for (int i = 0; i < 4; ++i) mx = fmaxf(mx, st[kt][qp][i]);
        mx = fmaxf(mx, __shfl_xor(mx, 16)); mx = fmaxf(mx, __shfl_xor(mx, 32));
        const float mn = fmaxf(m[qp], mx); const float corr = __builtin_amdgcn_exp2f((m[qp] - mn) * NSA_SC); m[qp] = mn; l[qp] *= corr;
#pragma unroll
        for (int dt = 0; dt < 4; ++dt) ot[dt][qp] *= corr;
        const float msc = mn * NSA_SC; float ps = 0.f;
#pragma unroll
        for (int kt = 0; kt < 4; ++kt)
#pragma unroll
            for (int i = 0; i < 4; ++i) { const float pv = __builtin_amdgcn_exp2f(st[kt][qp][i] * NSA_SC - msc); st[kt][qp][i] = pv; ps += pv; }
        l[qp] += ps;
#pragma unroll
        for (int ksp = 0; ksp < 2; ++ksp) { u4 w; w.x = pkbf(st[2 * ksp][qp][0], st[2 * ksp][qp][1]); w.y = pkbf(st[2 * ksp][qp][2], st[2 * ksp][qp][3]);
            w.z = pkbf(st[2 * ksp + 1][qp][0], st[2 * ksp + 1][qp][1]); w.w = pkbf(st[2 * ksp + 1][qp][2], st[2 * ksp + 1][qp][3]); Pf[qp][ksp] = __builtin_bit_cast(bf16x8, w); }
    }
#pragma unroll
    for (int dt = 0; dt < 4; ++dt)
#pragma unroll
        for (int ksp = 0; ksp < 2; ++ksp) { const LAS bf16* vp = Vl + (32 * ksp + 4 * kq + q) * NS + 16 * dt + 4 * p;
            const s16x4 va = __builtin_amdgcn_ds_read_tr16_b64_v4i16((LAS s16x4*)vp), vb = __builtin_amdgcn_ds_read_tr16_b64_v4i16((LAS s16x4*)(vp + 16 * NS));
            const bf16x8 vf = __builtin_shufflevector(va, vb, 0, 1, 2, 3, 4, 5, 6, 7);
#pragma unroll
            for (int qp = 0; qp < 2; ++qp) ot[dt][qp] = MFMA16(vf, Pf[qp][ksp], ot[dt][qp]); }
}
__device__ __forceinline__ void nsa_flush(float* __restrict__ y0, float* __restrict__ y1, const f4 (&ot)[4][2], const float (&l)[2], const float (&gate)[2], bool add, int kq) {
#pragma unroll
    for (int qp = 0; qp < 2; ++qp) { float lt = l[qp]; lt += __shfl_xor(lt, 16); lt += __shfl_xor(lt, 32); const float sc = (lt > 0.f) ? gate[qp] / lt : 0.f;
        float* yp = (qp ? y1 : y0) + 4 * kq;
#pragma unroll
        for (int dt = 0; dt < 4; ++dt) { f4 o = ot[dt][qp] * sc; if (add) o += *(const f4*)(yp + 16 * dt); *(f4*)(yp + 16 * dt) = o; } }
}
__device__ __forceinline__ void nsa_pair_next(unsigned& rem, int& ja, int& jb) { ja = __builtin_ctz(rem); rem &= rem - 1u; if (rem) { jb = __builtin_ctz(rem); rem &= rem - 1u; } else jb = -1; }
__device__ __forceinline__ void nsa_pair_prefetch(const bf16* __restrict__ Hb, int tok0, int ja, int jb, int colK, int colV, int tid, u4 (&R)[4]) {
    const int key = tid >> 3, d8 = (tid & 7) * 8; const int j1 = jb < 0 ? ja : jb;
    const bf16* pa = Hb + (size_t)(tok0 + 64 * ja + key) * INWP + d8; const bf16* pb = Hb + (size_t)(tok0 + 64 * j1 + key) * INWP + d8;
    R[0] = *(const u4*)(pa + colK); R[1] = *(const u4*)(pa + colV); R[2] = *(const u4*)(pb + colK); R[3] = *(const u4*)(pb + colV);
}
__device__ __forceinline__ void nsa_pair_store(LAS bf16* buf, int tid, const u4 (&R)[4]) {
    LAS bf16* p = buf + (tid >> 3) * NS + (tid & 7) * 8;
    *(LAS u4*)p = R[0]; *(LAS u4*)(p + 128 * NS) = R[1]; *(LAS u4*)(p + 64 * NS) = R[2]; *(LAS u4*)(p + 192 * NS) = R[3];
}
template <int MODE>
__device__ __forceinline__ void nsa_branch(unsigned chunks, const bf16* __restrict__ Hb, int tok0, int colK, int colV, LAS bf16* buf0, LAS bf16* buf1, int tid, int lane, int qt, const int (&tq)[2], const unsigned (&mym)[2],
                                           const bf16x8 (&Yq)[2][2], f4 (&ot)[4][2], float (&m)[2], float (&l)[2]) {
    u4 R[4]; unsigned rem = chunks; int ja, jb, na = 0, nb = -1; f4 st[4][2]; int lo[2], hi[2];
    nsa_pair_next(rem, ja, jb);
    nsa_pair_prefetch(Hb, tok0, ja, jb, colK, colV, tid, R);
    __syncthreads();
    nsa_pair_store(buf0, tid, R);
    bool more = (rem != 0u);
    if (more) { nsa_pair_next(rem, na, nb); nsa_pair_prefetch(Hb, tok0, na, nb, colK, colV, tid, R); }
    __syncthreads();
    int it = 0;
#pragma unroll 1
    for (;;) {
        LAS bf16* cur = (it & 1) ? buf1 : buf0;
#pragma unroll 1
        for (int sub = 0; sub < 2; ++sub) { const int j = sub ? jb : ja;
            if (j < 0) break;
            bool anyv = false, full = true;
#pragma unroll
            for (int qp = 0; qp < 2; ++qp) {
                if (MODE == 0) { const bool sel = (mym[qp] >> j) & 1u; lo[qp] = sel ? 0 : 64; hi[qp] = sel ? ((j == qt) ? tq[qp] : 63) : -1; anyv |= sel; full &= (sel && j != qt); }
                else { lo[qp] = (j == qt - 8) ? tq[qp] + 1 : 0; hi[qp] = (j == qt) ? tq[qp] : 63; anyv = true; full &= (j != qt && j != qt - 8); } }
            if (__builtin_amdgcn_ballot_w64(anyv) != 0ull) {
                const bool need_mask = __builtin_amdgcn_ballot_w64(!full) != 0ull;
                nsa_scores(st, cur + sub * 64 * NS, Yq, lane);
                nsa_softmax_pv(st, m, l, ot, cur + 128 * NS + sub * 64 * NS, lo, hi, need_mask, lane); } }
        if (!more) break;
        nsa_pair_store((it & 1) ? buf0 : buf1, tid, R);
        ja = na; jb = nb; more = (rem != 0u);
        if (more) { nsa_pair_next(rem, na, nb); nsa_pair_prefetch(Hb, tok0, na, nb, colK, colV, tid, R); }
        __syncthreads(); ++it;
    }
}
__device__ __forceinline__ void unit_nsa(const Params& P, unsigned char* ws, int l_, LAS unsigned char* lds, int u, int tid) {
    const int b = (u >> 7) & 3, g = (u >> 5) & 3, qt = (u & 256) ? 31 - (u & 31) : (u & 31);
    const bf16* Hb = (const bf16*)(ws + WS_H);
    LAS bf16* buf0 = (LAS bf16*)lds;
    LAS bf16* buf1 = (LAS bf16*)(lds + 40960);
    LAS float* impG = (LAS float*)(lds + 40960);
    LAS float* impE = (LAS float*)(lds + 73728);
    LAS unsigned* selm = (LAS unsigned*)(lds + 106496);
    const int lane = tid & 63, wv = __builtin_amdgcn_readfirstlane(tid >> 6), h = wv >> 1, qh = wv & 1;
    const int c = lane & 15, kq = lane >> 4;
    const int t0 = qt * 64;
    int tq[2]; size_t tok[2];
#pragma unroll
    for (int qp = 0; qp < 2; ++qp) { tq[qp] = 32 * qh + 16 * qp + c; tok[qp] = (size_t)b * T + t0 + tq[qp]; }
    bf16x8 Yq[2][2];
#pragma unroll
    for (int qp = 0; qp < 2; ++qp)
#pragma unroll
        for (int ks = 0; ks < 2; ++ks) Yq[qp][ks] = *(const bf16x8*)(Hb + tok[qp] * INWP + C_NQ + g * 256 + h * 64 + 32 * ks + 8 * kq);
    float gate[3][2];
#pragma unroll
    for (int k = 0; k < 3; ++k)
#pragma unroll
        for (int qp = 0; qp < 2; ++qp) { const float gv = bf2f(Hb[tok[qp] * INWP + C_NG + g * 12 + h * 3 + k]); gate[k][qp] = __builtin_amdgcn_rcpf(1.f + __expf(-gv)); }
    float* y0 = (float*)(ws + WS_YMIX) + tok[0] * D + 1024 + g * 256 + h * 64; float* y1 = (float*)(ws + WS_YMIX) + tok[1] * D + 1024 + g * 256 + h * 64;
    if (tid == 0) selm[64] = 0u;
    f4 ot[4][2]; float m[2], l[2];
#pragma unroll
    for (int dt = 0; dt < 4; ++dt)
#pragma unroll
        for (int qp = 0; qp < 2; ++qp) ot[dt][qp] = mk_f4(0.f, 0.f, 0.f, 0.f);
    int cmax[2];
#pragma unroll
    for (int qp = 0; qp < 2; ++qp) { const int t = t0 + tq[qp]; cmax[qp] = (t >= 31) ? (((t - 31) >> 4) < 126 ? ((t - 31) >> 4) : 126) : -1; }
    __syncthreads();
    { const bf16* KCk = (const bf16*)(ws + WS_KC) + (size_t)((0 * 4 + b) * 4 + g) * 8192; const bf16* KCv = (const bf16*)(ws + WS_KC) + (size_t)((1 * 4 + b) * 4 + g) * 8192;
#pragma unroll
        for (int i = 0; i < 2; ++i) { const int idx = tid + 512 * i, key = idx >> 3, d8 = (idx & 7) * 8;
            *(LAS u4*)(buf0 + key * NS + d8) = *(const u4*)(KCk + key * 64 + d8); *(LAS u4*)(buf0 + (128 + key) * NS + d8) = *(const u4*)(KCv + key * 64 + d8); } }
    __syncthreads();
    m[0] = m[1] = -1e4f; l[0] = l[1] = 0.f;
    { f4 st[4][2]; int lo[2], hi[2];
#pragma unroll 1
        for (int cc = 0; cc < 2; ++cc) {
            if (cc * 64 * 16 + 31 > t0 + 63) break;
#pragma unroll
            for (int qp = 0; qp < 2; ++qp) { lo[qp] = 0; hi[qp] = cmax[qp] - 64 * cc; }
            nsa_scores(st, buf0 + cc * 64 * NS, Yq, lane);
            nsa_softmax_pv(st, m, l, ot, buf0 + 128 * NS + cc * 64 * NS, lo, hi, true, lane);
        }
        { const float g2[2] = {gate[0][0], gate[0][1]}; nsa_flush(y0, y1, ot, l, g2, false, kq); }
        float invl[2], msc[2];
#pragma unroll
        for (int qp = 0; qp < 2; ++qp) { float lt = l[qp]; lt += __shfl_xor(lt, 16); lt += __shfl_xor(lt, 32); invl[qp] = (lt > 0.f) ? 1.f / lt : 0.f; msc[qp] = m[qp] * NSA_SC; }
#pragma unroll 1
        for (int cc = 0; cc < 2; ++cc) {
            nsa_scores(st, buf0 + cc * 64 * NS, Yq, lane);
#pragma unroll
            for (int kt = 0; kt < 4; ++kt)
#pragma unroll
                for (int qp = 0; qp < 2; ++qp) { float pp[4];
#pragma unroll
                    for (int i = 0; i < 4; ++i) { const int ci = 64 * cc + 16 * kt + 4 * kq + i; pp[i] = (ci <= cmax[qp]) ? __builtin_amdgcn_exp2f(st[kt][qp][i] * NSA_SC - msc[qp]) * invl[qp] : 0.f; }
                    const int j = 16 * cc + 4 * kt + kq;
                    impG[(h * 32 + j) * 64 + tq[qp]] = (pp[0] + pp[1]) + (pp[2] + pp[3]);
                    if (j < 31) impE[(h * 32 + j + 1) * 64 + tq[qp]] = pp[3]; }
        } }
    __syncthreads();
    if (tid < 64) { const int tqs = tid; float tv[8]; int ti[8];
#pragma unroll
        for (int k = 0; k < 8; ++k) { tv[k] = -3e38f; ti[k] = 0; }
#pragma unroll 1
        for (int j = 0; j < 32; ++j) { float v;
            if (j <= qt) { const bool forced = (j == 0) || (j == qt) || (j == qt - 1);
                float s4 = (impG[(0 * 32 + j) * 64 + tqs] + impG[(1 * 32 + j) * 64 + tqs]) + (impG[(2 * 32 + j) * 64 + tqs] + impG[(3 * 32 + j) * 64 + tqs]);
                if (j > 0) s4 += (impE[(0 * 32 + j) * 64 + tqs] + impE[(1 * 32 + j) * 64 + tqs]) + (impE[(2 * 32 + j) * 64 + tqs] + impE[(3 * 32 + j) * 64 + tqs]);
                v = forced ? 1e6f : s4; }
            else v = -1e9f;
            int vi = j;
#pragma unroll
            for (int k = 0; k < 8; ++k) { const bool gt = v > tv[k]; const float nv = gt ? tv[k] : v; const int ni = gt ? ti[k] : vi; tv[k] = gt ? v : tv[k]; ti[k] = gt ? vi : ti[k]; v = nv; vi = ni; } }
        unsigned msk = 0u;
#pragma unroll
        for (int k = 0; k < 8; ++k) if (ti[k] <= qt) msk |= (1u << ti[k]);
        selm[tqs] = msk; atomicOr((unsigned*)&selm[64], msk); }
    __syncthreads();
    unsigned mymask[2];
#pragma unroll
    for (int qp = 0; qp < 2; ++qp) mymask[qp] = selm[tq[qp]];
    const unsigned umask = selm[64];
#pragma unroll
    for (int dt = 0; dt < 4; ++dt)
#pragma unroll
        for (int qp = 0; qp < 2; ++qp) ot[dt][qp] = mk_f4(0.f, 0.f, 0.f, 0.f);
    m[0] = m[1] = -1e4f; l[0] = l[1] = 0.f;
    nsa_branch<0>(umask, Hb, b * T, C_KS + g * 64, C_VS + g * 64, buf0, buf1, tid, lane, qt, tq, mymask, Yq, ot, m, l);
    { const float g2[2] = {gate[1][0], gate[1][1]}; nsa_flush(y0, y1, ot, l, g2, true, kq); }
#pragma unroll
    for (int dt = 0; dt < 4; ++dt)
#pragma unroll
        for (int qp = 0; qp < 2; ++qp) ot[dt][qp] = mk_f4(0.f, 0.f, 0.f, 0.f);
    m[0] = m[1] = -1e4f; l[0] = l[1] = 0.f;
    { const int jw0 = qt >= 8 ? qt - 8 : 0; const unsigned wmask = ((qt == 31) ? 0xffffffffu : ((1u << (qt + 1)) - 1u)) & ~((1u << jw0) - 1u);
        nsa_branch<1>(wmask, Hb, b * T, C_KW + g * 64, C_VW + g * 64, buf0, buf1, tid, lane, qt, tq, mymask, Yq, ot, m, l); }
    { const float g2[2] = {gate[2][0], gate[2][1]}; nsa_flush(y0, y1, ot, l, g2, true, kq); }
    __syncthreads();
}

__device__ __forceinline__ bf16x8 cmp_afrag(const bf16* __restrict__ p, const float* __restrict__ pe) {
    const u4 a = *(const u4*)p; float f[8]; unpack8(a, f);
    const f4 p0 = *(const f4*)pe, p1 = *(const f4*)(pe + 4);
    u4 w; w.x = pkbf(f[0] + p0.x, f[1] + p0.y); w.y = pkbf(f[2] + p0.z, f[3] + p0.w); w.z = pkbf(f[4] + p1.x, f[5] + p1.y); w.w = pkbf(f[6] + p1.z, f[7] + p1.w);
    return __builtin_bit_cast(bf16x8, w);
}
__device__ __forceinline__ void unit_compress_mfma(const Params& P, unsigned char* ws, int l, LAS unsigned char* lds, int u, int tid) {
    const int kv = u >> 6, b = (u >> 4) & 3, g = (u >> 2) & 3, r4 = u & 3, i0 = 32 * r4;
    const bf16* Hb = (const bf16*)(ws + WS_H);
    const bf16* W1T = (const bf16*)(ws + WS_W1T) + (size_t)(l * 2 + kv) * 256 * 2048;
    const bf16* W2T = (const bf16*)(ws + WS_W2T) + (size_t)(l * 2 + kv) * 64 * 256;
    const float* pe = P.in[kv ? 11 : 8] + (size_t)l * 2048;
    LAS bf16* hidL = (LAS bf16*)lds;
    const int lane = tid & 63, wv = __builtin_amdgcn_readfirstlane(tid >> 6), c = lane & 15, kq = lane >> 4;
    const int col0 = (kv ? C_VC : C_KC) + g * 64;
    int tb[2];
#pragma unroll
    for (int rt = 0; rt < 2; ++rt) tb[rt] = 16 * (i0 + 16 * rt + c);
    f4 acc[2][2];
#pragma unroll
    for (int nt = 0; nt < 2; ++nt)
#pragma unroll
        for (int rt = 0; rt < 2; ++rt) acc[nt][rt] = mk_f4(0.f, 0.f, 0.f, 0.f);
    const bf16* wrow[2];
#pragma unroll
    for (int nt = 0; nt < 2; ++nt) wrow[nt] = W1T + (size_t)(32 * wv + 16 * nt + c) * 2048 + 8 * kq;
    bf16x8 xfA[2][2], xfB[2][2]; u4 arA[2][2], arB[2][2]; f4 peA[2][2], peB[2][2];
#define CMP_LOAD(XF, AR, PE, pos_) do { \
        _Pragma("unroll") for (int nt = 0; nt < 2; ++nt) _Pragma("unroll") for (int ks = 0; ks < 2; ++ks) XF[nt][ks] = *(const bf16x8*)(wrow[nt] + (pos_) * 64 + 32 * ks); \
        _Pragma("unroll") for (int rt = 0; rt < 2; ++rt) { int t_ = tb[rt] + (pos_); t_ = t_ < T ? t_ : T - 1; const bf16* ap_ = Hb + (size_t)(b * T + t_) * INWP + col0 + 8 * kq; \
            _Pragma("unroll") for (int ks = 0; ks < 2; ++ks) AR[rt][ks] = *(const u4*)(ap_ + 32 * ks); } \
        _Pragma("unroll") for (int ks = 0; ks < 2; ++ks) { PE[ks][0] = *(const f4*)(pe + (pos_) * 64 + 32 * ks + 8 * kq); PE[ks][1] = *(const f4*)(pe + (pos_) * 64 + 32 * ks + 8 * kq + 4); } } while (0)
#define CMP_MMA(XF, AR, PE) do { \
        _Pragma("unroll") for (int rt = 0; rt < 2; ++rt) _Pragma("unroll") for (int ks = 0; ks < 2; ++ks) { float f_[8]; unpack8(AR[rt][ks], f_); const f4 p0_ = PE[ks][0], p1_ = PE[ks][1]; \
            u4 w_; w_.x = pkbf(f_[0] + p0_.x, f_[1] + p0_.y); w_.y = pkbf(f_[2] + p0_.z, f_[3] + p0_.w); w_.z = pkbf(f_[4] + p1_.x, f_[5] + p1_.y); w_.w = pkbf(f_[6] + p1_.z, f_[7] + p1_.w); \
            const bf16x8 yf_ = __builtin_bit_cast(bf16x8, w_); \
            _Pragma("unroll") for (int nt = 0; nt < 2; ++nt) acc[nt][rt] = MFMA16(XF[nt][ks], yf_, acc[nt][rt]); } } while (0)
    CMP_LOAD(xfA, arA, peA, 0);
#pragma unroll 1
    for (int pos = 0; pos < 32; pos += 2) {
        CMP_LOAD(xfB, arB, peB, pos + 1);
        CMP_MMA(xfA, arA, peA);
        if (pos + 2 < 32) CMP_LOAD(xfA, arA, peA, pos + 2);
        CMP_MMA(xfB, arB, peB);
    }
#undef CMP_LOAD
#undef CMP_MMA
#pragma unroll
    for (int nt = 0; nt < 2; ++nt)
#pragma unroll
        for (int rt = 0; rt < 2; ++rt) { const f4 a = acc[nt][rt]; u2 w; w.x = pkbf(gelu_tanh(a.x), gelu_tanh(a.y)); w.y = pkbf(gelu_tanh(a.z), gelu_tanh(a.w));
            *(LAS u2*)(hidL + (16 * rt + c) * 264 + 32 * wv + 16 * nt + 4 * kq) = w; }
    __syncthreads();
    { const int ot = wv & 3, rt = wv >> 2; f4 o = mk_f4(0.f, 0.f, 0.f, 0.f);
        const bf16* w2p = W2T + (size_t)(16 * ot + c) * 256 + 8 * kq; const LAS bf16* hp = hidL + (16 * rt + c) * 264 + 8 * kq;
#pragma unroll
        for (int ks = 0; ks < 8; ++ks) { const bf16x8 xw = *(const bf16x8*)(w2p + 32 * ks); const bf16x8 yh = *(const LAS bf16x8*)(hp + 32 * ks); o = MFMA16(xw, yh, o); }
        const int ci = i0 + 16 * rt + c;
        if (ci <= 126) { u2 w; w.x = pkbf(o.x, o.y); w.y = pkbf(o.z, o.w); *(u2*)((bf16*)(ws + WS_KC) + ((size_t)((kv * 4 + b) * 4 + g) * 128 + ci) * 64 + 16 * ot + 4 * kq) = w; } }
    __syncthreads();
}

__device__ __forceinline__ void unit_retention_mfma(const Params& P, unsigned char* ws, int l, LAS unsigned char* lds, int u, int tid) {
    const int b = u >> 6, h = (u >> 4) & 3, c = u & 15;
    const bf16* Hb = (const bf16*)(ws + WS_H); const f2* rope = (const f2*)(ws + WS_ROPE);
    LAS bf16* Ql = (LAS bf16*)lds;
    LAS bf16* Kl = (LAS bf16*)(lds + 18432);
    LAS bf16* Vt = (LAS bf16*)(lds + 36864);
    LAS bf16* St = (LAS bf16*)(lds + 71680);
    const float lg2h = P.lg2[h];
    const int tok0 = b * T + c * 128;
    { const int m = tid >> 2, p = tid & 3;
        const f4* rp = (const f4*)(rope + (size_t)(c * 128 + m) * 32 + p * 8);
        const f4 r0 = rp[0], r1 = rp[1], r2 = rp[2], r3 = rp[3];
        const float cs[8] = {r0.x, r0.z, r1.x, r1.z, r2.x, r2.z, r3.x, r3.z}, sn[8] = {r0.y, r0.w, r1.y, r1.w, r2.y, r2.w, r3.y, r3.w};
#pragma unroll
        for (int which = 0; which < 2; ++which) { const bf16* src = Hb + (size_t)(tok0 + m) * INWP + (which ? C_RK : C_RQ) + h * 64 + p * 8;
            const u4 a = *(const u4*)src, bb = *(const u4*)(src + 32); float x1[8], x2[8]; unpack8(a, x1); unpack8(bb, x2);
            const float sc = which ? 0.125f : 1.0f; float o1[8], o2[8];
#pragma unroll
            for (int i = 0; i < 8; ++i) { o1[i] = (x1[i] * cs[i] - x2[i] * sn[i]) * sc; o2[i] = (x1[i] * sn[i] + x2[i] * cs[i]) * sc; }
            LAS bf16* dst = (which ? Kl : Ql) + m * 72 + p * 8;
            u4 w1, w2; w1.x = pkbf(o1[0], o1[1]); w1.y = pkbf(o1[2], o1[3]); w1.z = pkbf(o1[4], o1[5]); w1.w = pkbf(o1[6], o1[7]); w2.x = pkbf(o2[0], o2[1]); w2.y = pkbf(o2[2], o2[3]); w2.z = pkbf(o2[4], o2[5]); w2.w = pkbf(o2[6], o2[7]);
            *(LAS u4*)dst = w1; *(LAS u4*)(dst + 32) = w2; } }
    { const int m = tid & 127, eq = tid >> 7;
        const u4* src = (const u4*)(Hb + (size_t)(tok0 + m) * INWP + C_RV + h * 128 + eq * 32); LAS bf16* vp = Vt + (eq * 32) * 136 + m;
#pragma unroll
        for (int j = 0; j < 4; ++j) { const u4 a = src[j];
            vp[(8 * j + 0) * 136] = (bf16)(a.x & 0xffffu); vp[(8 * j + 1) * 136] = (bf16)(a.x >> 16); vp[(8 * j + 2) * 136] = (bf16)(a.y & 0xffffu); vp[(8 * j + 3) * 136] = (bf16)(a.y >> 16);
            vp[(8 * j + 4) * 136] = (bf16)(a.z & 0xffffu); vp[(8 * j + 5) * 136] = (bf16)(a.z >> 16); vp[(8 * j + 6) * 136] = (bf16)(a.w & 0xffffu); vp[(8 * j + 7) * 136] = (bf16)(a.w >> 16); } }
    { float a[16];
#pragma unroll
        for (int i = 0; i < 16; ++i) a[i] = 0.f;
        const float* kvb = (const float*)(ws + WS_KVST) + (size_t)((b * 4 + h) * 16) * 8192 + tid * 16;
#pragma unroll 1
        for (int j = 0; j < c; ++j) { const float w = exp2f(lg2h * 128.f * (float)(c - 1 - j)); const f4* sp = (const f4*)(kvb + (size_t)j * 8192);
#pragma unroll
            for (int q = 0; q < 4; ++q) { const f4 v = sp[q]; a[4 * q] += w * v.x; a[4 * q + 1] += w * v.y; a[4 * q + 2] += w * v.z; a[4 * q + 3] += w * v.w; } }
        const int d = tid >> 3, e0 = (tid & 7) * 16;
#pragma unroll
        for (int i = 0; i < 16; ++i) St[(e0 + i) * 72 + d] = (bf16)f2bf(a[i]); }
    __syncthreads();
    const int lane = tid & 63, wv = __builtin_amdgcn_readfirstlane(tid >> 6), cc = lane & 15, kq = lane >> 4;
    const int nn = 16 * wv + cc;
    bf16x8 yq[2];
#pragma unroll
    for (int ks = 0; ks < 2; ++ks) yq[ks] = *(const LAS bf16x8*)(Ql + nn * 72 + 32 * ks + 8 * kq);
    f4 ot[8];
#pragma unroll
    for (int et = 0; et < 8; ++et) { f4 a = mk_f4(0.f, 0.f, 0.f, 0.f); const LAS bf16* sp = St + (16 * et + cc) * 72 + 8 * kq;
        a = MFMA16(*(const LAS bf16x8*)sp, yq[0], a); a = MFMA16(*(const LAS bf16x8*)(sp + 32), yq[1], a); ot[et] = a; }
    { const float xi = exp2f(lg2h * (float)(nn + 1));
#pragma unroll
        for (int et = 0; et < 8; ++et) ot[et] *= xi; }
    const int nks = (wv >> 1) + 1;
#pragma unroll 1
    for (int ksp = 0; ksp < nks; ++ksp) { f4 st[2];
#pragma unroll
        for (int j = 0; j < 2; ++j) { const int mt = 2 * ksp + j; const LAS bf16* kp = Kl + (16 * mt + cc) * 72 + 8 * kq;
            f4 a = mk_f4(0.f, 0.f, 0.f, 0.f); a = MFMA16(*(const LAS bf16x8*)kp, yq[0], a); a = MFMA16(*(const LAS bf16x8*)(kp + 32), yq[1], a);
#pragma unroll
            for (int i = 0; i < 4; ++i) { const int mm = 16 * mt + 4 * kq + i; a[i] = (mm <= nn) ? a[i] * exp2f(lg2h * (float)(nn - mm)) : 0.f; }
            st[j] = a; }
        u4 w; w.x = pkbf(st[0].x, st[0].y); w.y = pkbf(st[0].z, st[0].w); w.z = pkbf(st[1].x, st[1].y); w.w = pkbf(st[1].z, st[1].w);
        const bf16x8 pf = __builtin_bit_cast(bf16x8, w);
#pragma unroll
        for (int et = 0; et < 8; ++et) { const LAS bf16* vp = Vt + (16 * et + cc) * 136 + 32 * ksp + 4 * kq;
            const s16x4 va = *(const LAS s16x4*)vp, vb = *(const LAS s16x4*)(vp + 16);
            ot[et] = MFMA16(__builtin_shufflevector(va, vb, 0, 1, 2, 3, 4, 5, 6, 7), pf, ot[et]); }
    }
    float s1 = 0.f;
#pragma unroll
    for (int et = 0; et < 8; ++et) s1 += (ot[et].x + ot[et].y) + (ot[et].z + ot[et].w);
    s1 += __shfl_xor(s1, 16); s1 += __shfl_xor(s1, 32);
    const float mu = s1 * (1.f / 128.f); float s2 = 0.f;
#pragma unroll
    for (int et = 0; et < 8; ++et) { const f4 dd = ot[et] - mu; s2 += (dd.x * dd.x + dd.y * dd.y) + (dd.z * dd.z + dd.w * dd.w); }
    s2 += __shfl_xor(s2, 16); s2 += __shfl_xor(s2, 32);
    const float rstd = rsqrtf(s2 * (1.f / 128.f) + LN_EPS);
    const float* gg = P.in[2] + l * 512 + h * 128; const float* gb = P.in[3] + l * 512 + h * 128;
    const bf16* gp = Hb + (size_t)(tok0 + nn) * INWP + C_RG + h * 128;
    float* yo = (float*)(ws + WS_YMIX) + (size_t)(tok0 + nn) * D + h * 128;
#pragma unroll
    for (int et = 0; et < 8; ++et) { const int e = 16 * et + 4 * kq; const f4 g4 = *(const f4*)(gg + e), b4 = *(const f4*)(gb + e); const u2 gr = *(const u2*)(gp + e);
        const float gv[4] = {__uint_as_float(gr.x << 16), __uint_as_float(gr.x & 0xffff0000u), __uint_as_float(gr.y << 16), __uint_as_float(gr.y & 0xffff0000u)};
        f4 o;
#pragma unroll
        for (int i = 0; i < 4; ++i) { const float y = (ot[et][i] - mu) * rstd * g4[i] + b4[i]; o[i] = y * gv[i] * __builtin_amdgcn_rcpf(1.f + __expf(-gv[i])); }
        *(f4*)(yo + e) = o; }
    __syncthreads();
}

__device__ __forceinline__ bf16x8 tr_frag(const LAS bf16* p, int rowstride4) {
    const s16x4 a = __builtin_amdgcn_ds_read_tr16_b64_v4i16((LAS s16x4*)p), b = __builtin_amdgcn_ds_read_tr16_b64_v4i16((LAS s16x4*)(p + rowstride4));
    return __builtin_shufflevector(a, b, 0, 1, 2, 3, 4, 5, 6, 7);
}
__device__ __forceinline__ void unit_kvstate_mfma(const Params& P, unsigned char* ws, LAS unsigned char* lds, int u, int tid) {
    const int b = u / 60, r = u % 60, h = r / 15, j = r % 15;
    const bf16* Hb = (const bf16*)(ws + WS_H); const f2* rope = (const f2*)(ws + WS_ROPE);
    LAS bf16* Kz = (LAS bf16*)lds;
    LAS bf16* Vl = (LAS bf16*)(lds + 20480);
    const int tok0 = b * T + j * 128; const float lg2h = P.lg2[h];
    { const int m = tid >> 2, p = tid & 3;
        const f4* rp = (const f4*)(rope + (size_t)(j * 128 + m) * 32 + p * 8);
        const f4 r0 = rp[0], r1 = rp[1], r2 = rp[2], r3 = rp[3];
        const float cs[8] = {r0.x, r0.z, r1.x, r1.z, r2.x, r2.z, r3.x, r3.z}, sn[8] = {r0.y, r0.w, r1.y, r1.w, r2.y, r2.w, r3.y, r3.w};
        const bf16* src = Hb + (size_t)(tok0 + m) * INWP + C_RK + h * 64 + p * 8;
        const u4 a = *(const u4*)src, bb = *(const u4*)(src + 32); float x1[8], x2[8]; unpack8(a, x1); unpack8(bb, x2);
        const float sc = 0.125f * exp2f(lg2h * (float)(127 - m)); float o1[8], o2[8];
#pragma unroll
        for (int i = 0; i < 8; ++i) { o1[i] = (x1[i] * cs[i] - x2[i] * sn[i]) * sc; o2[i] = (x1[i] * sn[i] + x2[i] * cs[i]) * sc; }
        u4 w1, w2; w1.x = pkbf(o1[0], o1[1]); w1.y = pkbf(o1[2], o1[3]); w1.z = pkbf(o1[4], o1[5]); w1.w = pkbf(o1[6], o1[7]); w2.x = pkbf(o2[0], o2[1]); w2.y = pkbf(o2[2], o2[3]); w2.z = pkbf(o2[4], o2[5]); w2.w = pkbf(o2[6], o2[7]);
        *(LAS u4*)(Kz + m * 80 + p * 8) = w1; *(LAS u4*)(Kz + m * 80 + 32 + p * 8) = w2;
        const u4* vs = (const u4*)(Hb + (size_t)(tok0 + m) * INWP + C_RV + h * 128 + p * 32); LAS u4* vd = (LAS u4*)(Vl + m * 144 + p * 32);
#pragma unroll
        for (int q = 0; q < 4; ++q) vd[q] = vs[q]; }
    __syncthreads();
    { const int lane = tid & 63, et = __builtin_amdgcn_readfirstlane(tid >> 6), c = lane & 15, kq = lane >> 4, q = (lane & 15) >> 2, p4 = lane & 3;
        bf16x8 yv[4];
#pragma unroll
        for (int ks = 0; ks < 4; ++ks) yv[ks] = tr_frag(Vl + (32 * ks + 8 * kq + q) * 144 + 16 * et + 4 * p4, 4 * 144);
        float* dst = (float*)(ws + WS_KVST) + (size_t)((b * 4 + h) * 16 + j) * 8192 + 16 * et + c;
#pragma unroll
        for (int dt = 0; dt < 4; ++dt) { f4 acc = mk_f4(0.f, 0.f, 0.f, 0.f);
#pragma unroll
            for (int ks = 0; ks < 4; ++ks) acc = MFMA16(tr_frag(Kz + (32 * ks + 8 * kq + q) * 80 + 16 * dt + 4 * p4, 4 * 80), yv[ks], acc);
#pragma unroll
            for (int i = 0; i < 4; ++i) dst[(16 * dt + 4 * kq + i) * 128] = acc[i]; } }
    __syncthreads();
}
__device__ __forceinline__ void unit_sgu_mfma(const Params& P, unsigned char* ws, int l, LAS unsigned char* lds, int u, int tid, int lane, int wave) {
    const int b = u >> 6, c = (u >> 2) & 15, g = u & 3;
    const bf16* Hb = (const bf16*)(ws + WS_H);
    LAS bf16* vn = (LAS bf16*)lds;
    const int tok0 = b * T + c * 128;
    const float* lng = P.in[4] + l * 512 + g * 128; const float* lnb = P.in[5] + l * 512 + g * 128;
    const float g0 = lng[2 * lane], g1 = lng[2 * lane + 1], b0 = lnb[2 * lane], b1 = lnb[2 * lane + 1];
#pragma unroll 4
    for (int i = 0; i < 16; ++i) { const int s = wave * 16 + i;
        const unsigned pr = *(const unsigned*)(Hb + (size_t)(tok0 + s) * INWP + C_SV + g * 128 + 2 * lane);
        const float v0 = __uint_as_float(pr << 16), v1 = __uint_as_float(pr & 0xffff0000u);
        const float mu = wave_sum(v0 + v1) * (1.f / 128.f); const float d0 = v0 - mu, d1 = v1 - mu;
        const float var = wave_sum(d0 * d0 + d1 * d1) * (1.f / 128.f); const float rstd = rsqrtf(var + LN_EPS);
        *(LAS unsigned*)(vn + s * 144 + 2 * lane) = pkbf(d0 * rstd * g0 + b0, d1 * rstd * g1 + b1); }
    __syncthreads();
    { const int cc = lane & 15, kq = lane >> 4, q = (lane & 15) >> 2, p4 = lane & 3, t = 16 * wave + cc, nks = (wave >> 1) + 1;
        const float* wrow = P.in[6] + ((size_t)l * 4 + g) * 16384 + (size_t)t * 128 + 8 * kq;
        bf16x8 xw[4];
#pragma unroll
        for (int ks = 0; ks < 4; ++ks) { u4 w = {0u, 0u, 0u, 0u};
            if (ks < nks) { const f4 a0 = *(const f4*)(wrow + 32 * ks), a1 = *(const f4*)(wrow + 32 * ks + 4); const int s0 = 32 * ks + 8 * kq;
                w.x = pkbf(s0 + 0 <= t ? a0.x : 0.f, s0 + 1 <= t ? a0.y : 0.f); w.y = pkbf(s0 + 2 <= t ? a0.z : 0.f, s0 + 3 <= t ? a0.w : 0.f);
                w.z = pkbf(s0 + 4 <= t ? a1.x : 0.f, s0 + 5 <= t ? a1.y : 0.f); w.w = pkbf(s0 + 6 <= t ? a1.z : 0.f, s0 + 7 <= t ? a1.w : 0.f); }
            xw[ks] = __builtin_bit_cast(bf16x8, w); }
        f4 bs4; { const float* bsp = P.in[7] + (l * 4 + g) * 128 + 16 * wave + 4 * kq; bs4 = *(const f4*)bsp; }
#pragma unroll 2
        for (int dt = 0; dt < 8; ++dt) { f4 acc = mk_f4(0.f, 0.f, 0.f, 0.f);
#pragma unroll
            for (int ks = 0; ks < 4; ++ks) if (ks < nks) acc = MFMA16(xw[ks], tr_frag(vn + (32 * ks + 8 * kq + q) * 144 + 16 * dt + 4 * p4, 4 * 144), acc);
            const int d = 16 * dt + cc;
#pragma unroll
            for (int i = 0; i < 4; ++i) { const int tt = 16 * wave + 4 * kq + i; const float uu = bf2f(Hb[(size_t)(tok0 + tt) * INWP + C_SU + g * 128 + d]);
                ((float*)(ws + WS_YMIX))[(size_t)(tok0 + tt) * D + 512 + g * 128 + d] = uu * (acc[i] + bs4[i]); } } }
    __syncthreads();
}

__device__ __forceinline__ void row_mixnorm(const Params& P, unsigned char* ws, int l, int rowi, int lane) {
    const f4* yp = (const f4*)((const float*)(ws + WS_YMIX) + (size_t)rowi * D) + lane;
    const f4* gp = (const f4*)(P.in[14] + (size_t)l * D) + lane;
    f4 v[8]; float ss[8];
#pragma unroll
    for (int j = 0; j < 8; ++j) { v[j] = yp[64 * j]; ss[j] = v[j].x * v[j].x + v[j].y * v[j].y + v[j].z * v[j].z + v[j].w * v[j].w; }
    const float r0 = rsqrtf(wave_sum(ss[0] + ss[1]) * (1.f / 512.f) + LN_EPS);
    const float r1 = rsqrtf(wave_sum(ss[2] + ss[3]) * (1.f / 512.f) + LN_EPS);
    const float r2 = rsqrtf(wave_sum((ss[4] + ss[5]) + (ss[6] + ss[7])) * (1.f / 1024.f) + LN_EPS);
    u2* op = (u2*)((bf16*)(ws + WS_MIXED) + (size_t)rowi * D) + lane;
#pragma unroll
    for (int j = 0; j < 8; ++j) { const float r = (j < 2) ? r0 : ((j < 4) ? r1 : r2); const f4 g4 = gp[64 * j];
        op[64 * j] = mk_u2(pk2(v[j].x * r * g4.x, v[j].y * r * g4.y), pk2(v[j].z * r * g4.z, v[j].w * r * g4.w)); }
}
__device__ __forceinline__ void row_ln(const float* __restrict__ zin, const float* __restrict__ gam, const float* __restrict__ bet, float* __restrict__ of32, bf16* __restrict__ obf, int rowi, int lane) {
    const f4* zp = (const f4*)(zin + (size_t)rowi * D) + lane;
    f4 v[8]; float s = 0.f;
#pragma unroll
    for (int j = 0; j < 8; ++j) { v[j] = zp[64 * j]; s += (v[j].x + v[j].y) + (v[j].z + v[j].w); }
    const float mu = wave_sum(s) * (1.f / D); float s2 = 0.f;
#pragma unroll
    for (int j = 0; j < 8; ++j) { v[j].x -= mu; v[j].y -= mu; v[j].z -= mu; v[j].w -= mu; s2 += (v[j].x * v[j].x + v[j].y * v[j].y) + (v[j].z * v[j].z + v[j].w * v[j].w); }
    const float rstd = rsqrtf(wave_sum(s2) * (1.f / D) + LN_EPS);
    f4* o4 = (f4*)(of32 + (size_t)rowi * D) + lane; u2* o2 = (u2*)(obf + (size_t)rowi * D) + lane;
    const f4* gp = (const f4*)gam + lane; const f4* bp = (const f4*)bet + lane;
#pragma unroll
    for (int j = 0; j < 8; ++j) { const f4 g4 = gp[64 * j], b4 = bp[64 * j];
        const f4 o = mk_f4(v[j].x * rstd * g4.x + b4.x, v[j].y * rstd * g4.y + b4.y, v[j].z * rstd * g4.z + b4.z, v[j].w * rstd * g4.w + b4.w);
        o4[64 * j] = o; o2[64 * j] = mk_u2(pk2(o.x, o.y), pk2(o.z, o.w)); }
}

__device__ __forceinline__ float dot8_bf16(const u4& w, const float* x) {
    float f[8]; unpack8(w, f);
    return ((f[0] * x[0] + f[1] * x[1]) + (f[2] * x[2] + f[3] * x[3])) + ((f[4] * x[4] + f[5] * x[5]) + (f[6] * x[6] + f[7] * x[7]));
}
__device__ __forceinline__ void peer_load4(u4 (&R)[4][2], const unsigned char* __restrict__ TAB, const LAS int* pe, int grp, int lane) {
#pragma unroll
    for (int k = 0; k < 4; ++k) { const int e = __builtin_amdgcn_readfirstlane(pe[grp * 4 + k]); const u4* p = (const u4*)(TAB + (size_t)e * 2048) + lane; R[k][0] = p[0]; R[k][1] = p[64]; }
}
__device__ __forceinline__ float dot16_fp8(const u4& w, const float* x) {
    float s = 0.f;
#pragma unroll
    for (int q = 0; q < 4; ++q) { const f2 lo = __builtin_amdgcn_cvt_pk_f32_fp8((int)w[q], false), hi = __builtin_amdgcn_cvt_pk_f32_fp8((int)w[q], true);
        s += (lo.x * x[4 * q] + lo.y * x[4 * q + 1]) + (hi.x * x[4 * q + 2] + hi.y * x[4 * q + 3]); }
    return s;
}
__device__ __forceinline__ void peer_dot4(const u4 (&R)[4][2], const float (&xr)[32], const float* __restrict__ USC, const LAS int* pe, const LAS float* pw, const float* __restrict__ VSC, LAS float* hwp, int grp, int lane) {
    float d[4];
#pragma unroll
    for (int k = 0; k < 4; ++k) d[k] = dot16_fp8(R[k][0], xr) + dot16_fp8(R[k][1], xr + 16);
#pragma unroll
    for (int o = 1; o < 64; o <<= 1) {
#pragma unroll
        for (int k = 0; k < 4; ++k) d[k] += __shfl_xor(d[k], o); }
#pragma unroll
    for (int k = 0; k < 4; ++k) { const int e = __builtin_amdgcn_readfirstlane(pe[grp * 4 + k]);
        const float hv = pw[grp * 4 + k] * gelu_tanh(d[k] * USC[e]) * VSC[e];
        if (lane == 0) hwp[grp * 4 + k] = hv; }
}
__device__ __forceinline__ void peer_axpy4(const u4 (&R)[4][2], float (&acc)[32], const LAS float* hwp, int grp) {
#pragma unroll
    for (int k = 0; k < 4; ++k) { const float hw = hwp[grp * 4 + k];
#pragma unroll
        for (int j = 0; j < 2; ++j)
#pragma unroll
            for (int q = 0; q < 4; ++q) { const f2 lo = __builtin_amdgcn_cvt_pk_f32_fp8((int)R[k][j][q], false), hi = __builtin_amdgcn_cvt_pk_f32_fp8((int)R[k][j][q], true);
                acc[16 * j + 4 * q] += hw * lo.x; acc[16 * j + 4 * q + 1] += hw * lo.y; acc[16 * j + 4 * q + 2] += hw * hi.x; acc[16 * j + 4 * q + 3] += hw * hi.y; } }
}
__device__ __forceinline__ void unit_peer(const Params& P, unsigned char* ws, int l, LAS unsigned char* lds, int u, int tid_in, int lane_in, int wave, float* __restrict__ xout) {
    int tid = tid_in; asm volatile("" : "+v"(tid)); int lane = tid & 63;
    const int n0 = u * 32;
    const bf16* QPB = (const bf16*)(ws + WS_QP); int* SC = (int*)(ws + WS_SC);
    { const int h = wave, c = lane & 15, kq = lane >> 4;
#pragma unroll 1
        for (int half = 0; half < 2; ++half) {
            const bf16* kb = (const bf16*)(ws + WS_PKB) + ((size_t)(half * DEPTH + l) * 8 + h) * 16384;
            bf16x8 yq[2][4];
#pragma unroll
            for (int tt = 0; tt < 2; ++tt)
#pragma unroll
                for (int ks = 0; ks < 4; ++ks) yq[tt][ks] = *(const bf16x8*)(QPB + (size_t)(n0 + 16 * tt + c) * D + h * 256 + half * 128 + 32 * ks + 8 * kq);
#pragma unroll 1
            for (int kt = 0; kt < 8; ++kt) { bf16x8 xk[4];
#pragma unroll
                for (int ks = 0; ks < 4; ++ks) xk[ks] = *(const bf16x8*)(kb + (size_t)(16 * kt + c) * 128 + 32 * ks + 8 * kq);
#pragma unroll
                for (int tt = 0; tt < 2; ++tt) { f4 a = mk_f4(0.f, 0.f, 0.f, 0.f);
#pragma unroll
                    for (int ks = 0; ks < 4; ++ks) a = MFMA16(xk[ks], yq[tt][ks], a);
                    int kk[4];
#pragma unroll
                    for (int i = 0; i < 4; ++i) { const int bits = __float_as_int(a[i]); const int sk = bits ^ ((bits >> 31) & 0x7fffffff); kk[i] = (sk & ~127) | (127 - (16 * kt + 4 * kq + i)); }
                    u4 w; w.x = (unsigned)kk[0]; w.y = (unsigned)kk[1]; w.z = (unsigned)kk[2]; w.w = (unsigned)kk[3];
                    *(u4*)(SC + ((size_t)(n0 + 16 * tt + c) * 16 + 2 * h + half) * 128 + 16 * kt + 4 * kq) = w; } }
        } }
    VM_WAIT();
    __syncthreads();
    tid = tid_in; asm volatile("" : "+v"(tid)); lane = tid & 63;
    LAS int* TK = (LAS int*)lds;
    { const int tk = tid >> 4, hh = tid & 15;
        const u4* sp = (const u4*)(SC + ((size_t)(n0 + tk) * 16 + hh) * 128);
        int t[16];
#pragma unroll
        for (int k = 0; k < 16; ++k) t[k] = (int)0x80000000;
#pragma unroll 1
        for (int c4 = 0; c4 < 32; ++c4) { const u4 s4 = sp[c4];
#pragma unroll
            for (int e = 0; e < 4; ++e) { int x = (int)s4[e];
#pragma unroll
                for (int k = 0; k < 16; ++k) { const int hi_ = max(t[k], x); x = min(t[k], x); t[k] = hi_; } } }
#pragma unroll
        for (int k = 0; k < 16; ++k) TK[tid * 17 + k] = t[k]; }
    __syncthreads();
    tid = tid_in; asm volatile("" : "+v"(tid)); lane = tid & 63;
    LAS int* PE = (LAS int*)(lds + 69632);
    LAS float* PW = (LAS float*)(lds + 86016);
    if (tid < 256) { const int tk = tid >> 3, h = tid & 7; const int r1 = tk * 16 + 2 * h, r2 = r1 + 1;
        float v1[16], v2[16];
#pragma unroll
        for (int k = 0; k < 16; ++k) { const int k1 = TK[r1 * 17 + k] & ~127, k2 = TK[r2 * 17 + k] & ~127;
            v1[k] = __int_as_float(k1 ^ ((k1 >> 31) & 0x7fffffff)); v2[k] = __int_as_float(k2 ^ ((k2 >> 31) & 0x7fffffff)); }
        int t[16];
#pragma unroll
        for (int k = 0; k < 16; ++k) t[k] = (int)0x80000000;
#pragma unroll
        for (int a = 0; a < 16; ++a)
#pragma unroll
            for (int bq = 0; bq < 16; ++bq) if ((a + 1) * (bq + 1) <= 16) { const int bits = __float_as_int(v1[a] + v2[bq]); const int sk = bits ^ ((bits >> 31) & 0x7fffffff);
                int x = (sk & ~255) | (255 - (a * 16 + bq));
#pragma unroll
                for (int k = 0; k < 16; ++k) { const int hi_ = max(t[k], x); x = min(t[k], x); t[k] = hi_; } }
        float w[16], wsum = 0.f; const int kt0 = t[0] & ~255; const float top = __int_as_float(kt0 ^ ((kt0 >> 31) & 0x7fffffff));
#pragma unroll
        for (int k = 0; k < 16; ++k) { const int kk = t[k] & ~255; const float sv = __int_as_float(kk ^ ((kk >> 31) & 0x7fffffff)); w[k] = __expf(sv - top); wsum += w[k]; }
        const float inv = 1.f / wsum;
#pragma unroll
        for (int k = 0; k < 16; ++k) { const int ab = 255 - (t[k] & 255); const int a = ab >> 4, bq = ab & 15;
            const int i1 = 127 - (TK[r1 * 17 + a] & 127), i2 = 127 - (TK[r2 * 17 + bq] & 127);
            PE[tk * 128 + h * 16 + k] = i1 * 128 + i2; PW[tk * 128 + h * 16 + k] = w[k] * inv; } }
    __syncthreads();
    tid = tid_in; asm volatile("" : "+v"(tid)); lane = tid & 63;
    { int* FE = (int*)(ws + WS_FE) + (size_t)u * 16 * FCAP; float* FW = (float*)(ws + WS_FW) + (size_t)u * 16 * FCAP; int* GST = (int*)(ws + WS_GST) + (size_t)u * 16 * 64;
        LAS int* CNT = (LAS int*)(lds + 118784);
        LAS int* STA = (LAS int*)(lds + 120832);
#pragma unroll 1
        for (int it = 0; it < 4; ++it) { const int tk = wave * 4 + it;
            const int k0 = PE[tk * 128 + lane] >> BSH, k1 = PE[tk * 128 + 64 + lane] >> BSH; int mycnt = 0;
#pragma unroll
            for (int v = 0; v < NBKT; ++v) { const int c = __builtin_popcountll(__builtin_amdgcn_ballot_w64(k0 == v)) + __builtin_popcountll(__builtin_amdgcn_ballot_w64(k1 == v)); if (lane == v) mycnt = (c + 3) & ~3; }
            if (lane < NBKT) CNT[tk * 16 + lane] = mycnt; }
        __syncthreads();
        if (tid < NBKT) { int run = 0;
#pragma unroll 1
            for (int t = 0; t < 32; ++t) { STA[t * 16 + tid] = run; run += CNT[t * 16 + tid]; }
            STA[32 * 16 + tid] = run; }
        __syncthreads();
        for (int i = tid; i < NBKT * 33; i += 512) { const int bb = i / 33, t = i % 33; GST[bb * 64 + t] = STA[t * 16 + bb]; }
#pragma unroll 1
        for (int it = 0; it < 4; ++it) { const int tk = wave * 4 + it;
            const int e0 = PE[tk * 128 + lane], e1 = PE[tk * 128 + 64 + lane]; const float w0 = PW[tk * 128 + lane], w1 = PW[tk * 128 + 64 + lane];
            const int k0 = e0 >> BSH, k1 = e1 >> BSH; int pos0 = 0, pos1 = 0;
#pragma unroll
            for (int v = 0; v < NBKT; ++v) { const unsigned long long b0 = __builtin_amdgcn_ballot_w64(k0 == v), b1 = __builtin_amdgcn_ballot_w64(k1 == v);
                const int c0 = __builtin_popcountll(b0), c = c0 + __builtin_popcountll(b1), pc = (c + 3) & ~3; const int base = STA[tk * 16 + v];
                const int r0 = (int)__builtin_amdgcn_mbcnt_hi((unsigned)(b0 >> 32), __builtin_amdgcn_mbcnt_lo((unsigned)b0, 0u));
                const int r1 = c0 + (int)__builtin_amdgcn_mbcnt_hi((unsigned)(b1 >> 32), __builtin_amdgcn_mbcnt_lo((unsigned)b1, 0u));
                if (k0 == v) pos0 = v * FCAP + base + r0;
                if (k1 == v) pos1 = v * FCAP + base + r1;
                if (lane < pc - c) { FE[v * FCAP + base + c + lane] = v << BSH; FW[v * FCAP + base + c + lane] = 0.f; } }
            FE[pos0] = e0; FW[pos0] = w0; FE[pos1] = e1; FW[pos1] = w1; } }
    __syncthreads();
}

constexpr int PG = 4;
__device__ __forceinline__ void peer3_rows(u4 (&R)[PG][2], const unsigned char* __restrict__ TAB, int ev, int g, int lane) {
#pragma unroll
    for (int k = 0; k < PG; ++k) { const int e = __builtin_amdgcn_readlane(ev, PG * g + k); const unsigned char* rowp = TAB + (size_t)(unsigned)e * 2048u; R[k][0] = *(const u4*)(rowp + (unsigned)lane * 16u); R[k][1] = *(const u4*)(rowp + 1024u + (unsigned)lane * 16u); }
}
#define DPP_F(v, ctrl) __int_as_float(__builtin_amdgcn_update_dpp(0, __float_as_int(v), (ctrl), 0xf, 0xf, true))
__device__ __forceinline__ float wave_sum_dpp(float v) {
    v += DPP_F(v, 0xB1); v += DPP_F(v, 0x4E); v += DPP_F(v, 0x141); v += DPP_F(v, 0x140);
    const int iv = __float_as_int(v);
    return (__int_as_float(__builtin_amdgcn_readlane(iv, 0)) + __int_as_float(__builtin_amdgcn_readlane(iv, 16))) + (__int_as_float(__builtin_amdgcn_readlane(iv, 32)) + __int_as_float(__builtin_amdgcn_readlane(iv, 48)));
}
__device__ __forceinline__ float dot16_pk(const u4& w, const f2* x) {
    f2 a = {0.f, 0.f};
#pragma unroll
    for (int q = 0; q < 4; ++q) { const f2 lo = __builtin_amdgcn_cvt_pk_f32_fp8((int)w[q], false), hi = __builtin_amdgcn_cvt_pk_f32_fp8((int)w[q], true);
        a = __builtin_elementwise_fma(lo, x[2 * q], a); a = __builtin_elementwise_fma(hi, x[2 * q + 1], a); }
    return a.x + a.y;
}
__device__ __forceinline__ void peer3_dots(const u4 (&R)[PG][2], const f2 (&xr)[16], float& dv, int g, int lane) {
    float d[PG];
#pragma unroll
    for (int k = 0; k < PG; ++k) { d[k] = dot16_pk(R[k][0], xr) + dot16_pk(R[k][1], xr + 8); __builtin_amdgcn_sched_barrier(0); }
#pragma unroll
    for (int k = 0; k < PG; ++k) { const float sd = wave_sum_dpp(d[k]); dv = (lane == PG * g + k) ? sd : dv; }
}
__device__ __forceinline__ void peer3_axpy(const u4 (&R)[PG][2], f2 (&acc)[16], int hwv, int g) {
#pragma unroll
    for (int k = 0; k < PG; ++k) { const float hw = __int_as_float(__builtin_amdgcn_readlane(hwv, PG * g + k)); const f2 hw2 = {hw, hw};
#pragma unroll
        for (int j = 0; j < 2; ++j)
#pragma unroll
            for (int q = 0; q < 4; ++q) { const f2 lo = __builtin_amdgcn_cvt_pk_f32_fp8((int)R[k][j][q], false), hi = __builtin_amdgcn_cvt_pk_f32_fp8((int)R[k][j][q], true);
                acc[8 * j + 2 * q] = __builtin_elementwise_fma(lo, hw2, acc[8 * j + 2 * q]); acc[8 * j + 2 * q + 1] = __builtin_elementwise_fma(hi, hw2, acc[8 * j + 2 * q + 1]); }
        __builtin_amdgcn_sched_barrier(0); }
}
__device__ __forceinline__ void unpack_row(const u4 (&X)[4], f2 (&o)[16]) {
#pragma unroll
    for (int i = 0; i < 4; ++i) { o[4 * i].x = __uint_as_float(X[i].x << 16); o[4 * i].y = __uint_as_float(X[i].x & 0xffff0000u); o[4 * i + 1].x = __uint_as_float(X[i].y << 16); o[4 * i + 1].y = __uint_as_float(X[i].y & 0xffff0000u);
        o[4 * i + 2].x = __uint_as_float(X[i].z << 16); o[4 * i + 2].y = __uint_as_float(X[i].z & 0xffff0000u); o[4 * i + 3].x = __uint_as_float(X[i].w << 16); o[4 * i + 3].y = __uint_as_float(X[i].w & 0xffff0000u); }
}
__device__ __forceinline__ void peer3_rowload(u4 (&X)[4], const bf16* __restrict__ base, unsigned n, int lane) {
    const bf16* p = base + (n * (unsigned)D + (unsigned)(16 * lane));
    X[0] = *(const u4*)p; X[1] = *(const u4*)(p + 8); X[2] = *(const u4*)(p + 1024); X[3] = *(const u4*)(p + 1032);
}
__device__ __forceinline__ void peer3_rowstore(bf16* __restrict__ base, unsigned n, int lane, const f2 (&acc)[16]) {
    bf16* p = base + (n * (unsigned)D + (unsigned)(16 * lane));
#pragma unroll
    for (int j = 0; j < 2; ++j) { u4 p0, p1; p0.x = pkbf(acc[8 * j].x, acc[8 * j].y); p0.y = pkbf(acc[8 * j + 1].x, acc[8 * j + 1].y); p0.z = pkbf(acc[8 * j + 2].x, acc[8 * j + 2].y); p0.w = pkbf(acc[8 * j + 3].x, acc[8 * j + 3].y);
        p1.x = pkbf(acc[8 * j + 4].x, acc[8 * j + 4].y); p1.y = pkbf(acc[8 * j + 5].x, acc[8 * j + 5].y); p1.z = pkbf(acc[8 * j + 6].x, acc[8 * j + 6].y); p1.w = pkbf(acc[8 * j + 7].x, acc[8 * j + 7].y);
        *(u4*)(p + 1024 * j) = p0; *(u4*)(p + 1024 * j + 8) = p1; }
}
__device__ __forceinline__ int peer3_next_nonempty(int gstv, int t) {
    while (t < 32 && __builtin_amdgcn_readlane(gstv, t + 1) == __builtin_amdgcn_readlane(gstv, t)) ++t;
    return t;
}
__device__ __forceinline__ void phase_peer_bucket(const Params& P, unsigned char* ws, int l, int bid, int G, int lane, int wave) {
    const int x = bid & 7, r = bid >> 3;
    const int u = r * 8 + wave; const unsigned nbase = (unsigned)u * 32u;
    const unsigned char* PU = ws + WS_PU + (size_t)l * 16384 * 2048; const unsigned char* PV = ws + WS_PV + (size_t)l * 16384 * 2048;
    const float* USC = (const float*)(ws + WS_PSC) + (size_t)l * 16384; const float* VSC = (const float*)(ws + WS_PSC) + (size_t)(DEPTH + l) * 16384;
    const bf16* X1B = (const bf16*)(ws + WS_X1B);
    bf16* PART = (bf16*)(ws + WS_PART) + (size_t)x * NTOK * D;
#pragma unroll 1
    for (int rnd = 0; rnd < NRND; ++rnd) { const int xb = x + 8 * rnd;
        const int* FE = (const int*)(ws + WS_FE) + ((size_t)u * 16 + xb) * FCAP; const float* FW = (const float*)(ws + WS_FW) + ((size_t)u * 16 + xb) * FCAP; float* FHW = (float*)(ws + WS_FHW) + ((size_t)u * 16 + xb) * FCAP;
        int gstv = 0; if (lane <= 32) gstv = ((const int*)(ws + WS_GST))[((size_t)u * 16 + xb) * 64 + lane];
        const int total = __builtin_amdgcn_readlane(gstv, 32);
        if (total > 0) {
            int tcur = peer3_next_nonempty(gstv, 0); int tnx = peer3_next_nonempty(gstv, tcur + 1); int tend = __builtin_amdgcn_readlane(gstv, tcur + 1);
            u4 xq[4], xn[4]; peer3_rowload(xq, X1B, nbase + tcur, lane); if (tnx < 32) peer3_rowload(xn, X1B, nbase + tnx, lane);
            f2 xr[16]; unpack_row(xq, xr);
#pragma unroll 1
            for (int blk = 0; blk < total; blk += 64) { const int blen = (total - blk) < 64 ? (total - blk) : 64, ng = blen / PG;
                int ev = 0; float wv = 0.f;
                if (lane < blen) { ev = FE[blk + lane]; wv = FW[blk + lane]; }
                const float us = USC[ev], vs = VSC[ev];
                float dv = 0.f; u4 A[PG][2], B[PG][2];
                peer3_rows(A, PU, ev, 0, lane);
#pragma unroll 1
                for (int g = 0; g < ng; g += 2) {
                    if (g + 1 < ng) peer3_rows(B, PU, ev, g + 1, lane);
                    if (blk + PG * g >= tend) { tcur = tnx; unpack_row(xn, xr); tend = __builtin_amdgcn_readlane(gstv, tcur + 1);
                        tnx = peer3_next_nonempty(gstv, tcur + 1); if (tnx < 32) peer3_rowload(xn, X1B, nbase + tnx, lane); }
                    peer3_dots(A, xr, dv, g, lane);
                    __builtin_amdgcn_sched_barrier(0);
                    if (g + 2 < ng) peer3_rows(A, PU, ev, g + 2, lane);
                    if (g + 1 < ng) {
                        if (blk + PG * (g + 1) >= tend) { tcur = tnx; unpack_row(xn, xr); tend = __builtin_amdgcn_readlane(gstv, tcur + 1);
                            tnx = peer3_next_nonempty(gstv, tcur + 1); if (tnx < 32) peer3_rowload(xn, X1B, nbase + tnx, lane); }
                        peer3_dots(B, xr, dv, g + 1, lane); }
                    __builtin_amdgcn_sched_barrier(0);
                }
                if (lane < blen) FHW[blk + lane] = wv * gelu_tanh(dv * us) * vs;
            } }
        VM_WAIT();
        { f2 acc[16];
            if (rnd == 0) {
#pragma unroll
                for (int i = 0; i < 16; ++i) acc[i] = (f2){0.f, 0.f};
#pragma unroll 1
                for (int t = 0; t < 32; ++t) if (__builtin_amdgcn_readlane(gstv, t + 1) == __builtin_amdgcn_readlane(gstv, t)) peer3_rowstore(PART, nbase + t, lane, acc); }
            if (total > 0) {
                int tcur = peer3_next_nonempty(gstv, 0); int tnx = peer3_next_nonempty(gstv, tcur + 1); int tend = __builtin_amdgcn_readlane(gstv, tcur + 1);
                u4 xn[4];
                if (rnd > 0) { u4 xq[4]; peer3_rowload(xq, PART, nbase + tcur, lane); if (tnx < 32) peer3_rowload(xn, PART, nbase + tnx, lane); unpack_row(xq, acc); }
                else {
#pragma unroll
                    for (int i = 0; i < 16; ++i) acc[i] = (f2){0.f, 0.f}; }
#pragma unroll 1
                for (int blk = 0; blk < total; blk += 64) { const int blen = (total - blk) < 64 ? (total - blk) : 64, ng = blen / PG;
                    int ev = 0, hwv = 0;
                    if (lane < blen) { ev = FE[blk + lane]; hwv = (int)__hip_atomic_load((const unsigned*)(FHW + blk + lane), __ATOMIC_RELAXED, __HIP_MEMORY_SCOPE_AGENT); }
                    u4 A[PG][2], B[PG][2];
                    peer3_rows(A, PV, ev, 0, lane);
#pragma unroll 1
                    for (int g = 0; g < ng; g += 2) {
                        if (g + 1 < ng) peer3_rows(B, PV, ev, g + 1, lane);
                        if (blk + PG * g >= tend) { peer3_rowstore(PART, nbase + tcur, lane, acc); tcur = tnx; tend = __builtin_amdgcn_readlane(gstv, tcur + 1);
                            if (rnd > 0) { unpack_row(xn, acc); }
                            else {
#pragma unroll
                                for (int i = 0; i < 16; ++i) acc[i] = (f2){0.f, 0.f}; }
                            tnx = peer3_next_nonempty(gstv, tcur + 1); if (rnd > 0 && tnx < 32) peer3_rowload(xn, PART, nbase + tnx, lane); }
                        peer3_axpy(A, acc, hwv, g);
                        __builtin_amdgcn_sched_barrier(0);
                        if (g + 2 < ng) peer3_rows(A, PV, ev, g + 2, lane);
                        if (g + 1 < ng) {
                            if (blk + PG * (g + 1) >= tend) { peer3_rowstore(PART, nbase + tcur, lane, acc); tcur = tnx; tend = __builtin_amdgcn_readlane(gstv, tcur + 1);
                                if (rnd > 0) { unpack_row(xn, acc); }
                                else {
#pragma unroll
                                    for (int i = 0; i < 16; ++i) acc[i] = (f2){0.f, 0.f}; }
                                tnx = peer3_next_nonempty(gstv, tcur + 1); if (rnd > 0 && tnx < 32) peer3_rowload(xn, PART, nbase + tnx, lane); }
                            peer3_axpy(B, acc, hwv, g + 1); }
                        __builtin_amdgcn_sched_barrier(0);
                    } }
                peer3_rowstore(PART, nbase + tcur, lane, acc);
            } }
        VM_WAIT();
    }
}
__device__ __forceinline__ void row_peer_reduce(const Params& P, unsigned char* ws, int l, int rowi, int lane, float* __restrict__ xout) {
    const size_t n = (size_t)rowi; const float* X1 = (const float*)(ws + WS_X1); const bf16* PART = (const bf16*)(ws + WS_PART);
    float acc[32];
#pragma unroll
    for (int j = 0; j < 2; ++j)
#pragma unroll
        for (int q = 0; q < 4; ++q) { const f4 a = *(const f4*)(X1 + n * D + 1024 * j + 16 * lane + 4 * q); acc[16 * j + 4 * q] = ALPHA * a.x; acc[16 * j + 4 * q + 1] = ALPHA * a.y; acc[16 * j + 4 * q + 2] = ALPHA * a.z; acc[16 * j + 4 * q + 3] = ALPHA * a.w; }
#pragma unroll 2
    for (int xb_ = 0; xb_ < 8; ++xb_) { const bf16* pp = PART + ((size_t)xb_ * NTOK + n) * D;
#pragma unroll
        for (int j = 0; j < 2; ++j) { const u4 a = *(const u4*)(pp + 1024 * j + 16 * lane), bq = *(const u4*)(pp + 1024 * j + 16 * lane + 8); float f[16]; unpack8(a, f); unpack8(bq, f + 8);
#pragma unroll
            for (int i = 0; i < 16; ++i) acc[16 * j + i] += f[i]; } }
    float s = 0.f;
#pragma unroll
    for (int i = 0; i < 32; ++i) s += acc[i];
    const float mu = wave_sum(s) * (1.f / D); float s2 = 0.f;
#pragma unroll
    for (int i = 0; i < 32; ++i) { acc[i] -= mu; s2 += acc[i] * acc[i]; }
    const float rstd = rsqrtf(wave_sum(s2) * (1.f / D) + LN_EPS);
    const float* gam = P.in[23] + (size_t)l * D; const float* bet = P.in[24] + (size_t)l * D;
    bf16* xb = (bf16*)(ws + WS_XB);
#pragma unroll
    for (int j = 0; j < 2; ++j) { const int col = 1024 * j + 16 * lane; float o[16];
#pragma unroll
        for (int q = 0; q < 4; ++q) { const f4 g4 = *(const f4*)(gam + col + 4 * q), b4 = *(const f4*)(bet + col + 4 * q);
            o[4 * q] = acc[16 * j + 4 * q] * rstd * g4.x + b4.x; o[4 * q + 1] = acc[16 * j + 4 * q + 1] * rstd * g4.y + b4.y; o[4 * q + 2] = acc[16 * j + 4 * q + 2] * rstd * g4.z + b4.z; o[4 * q + 3] = acc[16 * j + 4 * q + 3] * rstd * g4.w + b4.w;
            *(f4*)(xout + n * D + col + 4 * q) = mk_f4(o[4 * q], o[4 * q + 1], o[4 * q + 2], o[4 * q + 3]); }
        u4 p0, p1; p0.x = pk2(o[0], o[1]); p0.y = pk2(o[2], o[3]); p0.z = pk2(o[4], o[5]); p0.w = pk2(o[6], o[7]); p1.x = pk2(o[8], o[9]); p1.y = pk2(o[10], o[11]); p1.z = pk2(o[12], o[13]); p1.w = pk2(o[14], o[15]);
        *(u4*)(xb + n * D + col) = p0; *(u4*)(xb + n * D + col + 8) = p1; }
}

template <class T> __device__ __forceinline__ T* uniform_ptr(T* p) { const unsigned long long v = (unsigned long long)p; const unsigned lo = __builtin_amdgcn_readfirstlane((unsigned)v), hi = __builtin_amdgcn_readfirstlane((unsigned)(v >> 32)); return (T*)(__attribute__((address_space(1))) T*)(((unsigned long long)hi << 32) | lo); }
constexpr int PH_PER_LAYER = 10, N_PHASES = 1 + DEPTH * PH_PER_LAYER;
#ifndef ONLY_PHASE
#define ONLY_PHASE -1
#endif
#define EN(i) (ONLY_PHASE < 0 || ONLY_PHASE == (i))
__global__ void __launch_bounds__(512, 2) mk_fwd(Params P) {
    extern __shared__ __attribute__((aligned(16))) unsigned char lds_raw[];
    LAS unsigned char* lds = (LAS unsigned char*)lds_raw;
    volatile LAS unsigned* MISC = (volatile LAS unsigned*)(lds + MISC_OFF);
    const int tid = threadIdx.x, lane = tid & 63, wave = __builtin_amdgcn_readfirstlane(tid >> 6);
    const int G = gridDim.x, bid = blockIdx.x;
    if (tid < 64) MISC[tid] = 0u;
    __syncthreads();
    unsigned char* const ws = uniform_ptr(P.ws);
    unsigned* ctl = (unsigned*)(ws + WS_CTL);
    const XcdBarrier bar = xcd_barrier_post(ctl + CW_BAR, MISC + 8);
    const int lo = P.ph_lo, hi = P.ph_hi;
#define IN(k) (lo <= (k) && (k) < hi)
#define LAUNDER() int tl; asm volatile("v_mbcnt_lo_u32_b32 %0, -1, 0\n\tv_mbcnt_hi_u32_b32 %0, -1, %0" : "=v"(tl)); tl |= (wave << 6); const int ll = tl & 63; const int wl = __builtin_amdgcn_readfirstlane(tl >> 6); (void)ll; (void)wl
#define SEAM(k) do { if (IN((k) + 1)) xcd_barrier(bar); } while (0)
    if (IN(0) && EN(20)) { LAUNDER(); REP(20) phase_prologue(P, ws, lds, tl, ll, wl); SEAM(0); }
    for (int l = 0; l < DEPTH; ++l) {
        const int pb = 1 + l * PH_PER_LAYER;
        const float* xres = (l == 0) ? P.in[0] : (const float*)(ws + WS_XC);
        float* xout = (l == DEPTH - 1) ? P.out : (float*)(ws + WS_XC);
        if (IN(pb + 0) && EN(0)) { LAUNDER();
            pg8::Gemm g{(const pg8::bf16_t*)(ws + WS_XB), (const pg8::bf16_t*)(ws + WS_WIN) + (size_t)l * INWP * D, NTOK, INWP, D};
            pg8::StaticOrder S; S.init(NTOK, INWP, G, bid);
            pg8::EpiH E{(pg8::bf16_t*)(ws + WS_H), INWP, 6, 10};
            REP(0) pg8::gemm_phase<pg8::EpiH, pg8::StaticOrder, true, true>(lds, g, S, E, tl);
            SEAM(pb + 0);
        }
        if (IN(pb + 1) && EN(1)) { LAUNDER();
            REP(1) for (int u = bid; u < 240; u += G) unit_kvstate_mfma(P, ws, lds, u, tl);
            REP(13) for (int u = bid; u < 256; u += G) unit_sgu_mfma(P, ws, l, lds, u, tl, ll, wl);
            REP(12) for (int u = bid; u < 128; u += G) unit_compress_mfma(P, ws, l, lds, u, tl);
            SEAM(pb + 1);
        }
        if (IN(pb + 2) && EN(2)) { LAUNDER();
            REP(10) for (int u = bid; u < 256; u += G) unit_retention_mfma(P, ws, l, lds, u, tl);
            REP(11) for (int u = bid; u < 512; u += G) unit_nsa(P, ws, l, lds, u, tl);
            SEAM(pb + 2);
        }
        if (IN(pb + 3) && EN(3)) { LAUNDER();
            REP(3) for (int r = bid * 8 + wl; r < NTOK; r += G * 8) row_mixnorm(P, ws, l, r, ll);
            SEAM(pb + 3);
        }
        if (IN(pb + 4) && EN(4)) { LAUNDER();
            pg8::Gemm g{(const pg8::bf16_t*)(ws + WS_MIXED), (const pg8::bf16_t*)(ws + WS_WOUT) + (size_t)l * D * D, NTOK, D, D};
            pg8::StaticOrder S; S.init(NTOK, D, G, bid);
            pg8::EpiRes E{(float*)(ws + WS_Z), xres, D, ALPHA};
            REP(4) pg8::gemm_phase<pg8::EpiRes, pg8::StaticOrder, true, true>(lds, g, S, E, tl);
            SEAM(pb + 4);
        }
        if (IN(pb + 5) && EN(5)) { LAUNDER();
            for (int r = bid * 8 + wl; r < NTOK; r += G * 8) row_ln((const float*)(ws + WS_Z), P.in[16] + (size_t)l * D, P.in[17] + (size_t)l * D, (float*)(ws + WS_X1), (bf16*)(ws + WS_X1B), r, ll);
            SEAM(pb + 5);
        }
        if (IN(pb + 6) && EN(6)) { LAUNDER();
            pg8::Gemm g{(const pg8::bf16_t*)(ws + WS_X1B), (const pg8::bf16_t*)(ws + WS_WQ) + (size_t)l * D * D, NTOK, D, D};
            pg8::StaticOrder S; S.init(NTOK, D, G, bid);
            pg8::EpiH E{(pg8::bf16_t*)(ws + WS_QP), D, 0, 0};
            pg8::gemm_phase<pg8::EpiH, pg8::StaticOrder, true, true>(lds, g, S, E, tl);
            SEAM(pb + 6);
        }
        if (IN(pb + 7) && EN(7)) { LAUNDER();
            REP(7) for (int u = bid; u < NTOK / 32; u += G) unit_peer(P, ws, l, lds, u, tl, ll, wl, xout);
            SEAM(pb + 7);
        }
        if (IN(pb + 8) && EN(8)) { LAUNDER();
            REP(8) phase_peer_bucket(P, ws, l, bid, G, ll, wl);
            SEAM(pb + 8);
        }
        if (IN(pb + 9) && EN(9)) { LAUNDER();
            REP(9) for (int r = bid * 8 + wl; r < NTOK; r += G * 8) row_peer_reduce(P, ws, l, r, ll, xout);
            SEAM(pb + 9);
        }
    }
#undef IN
#undef SEAM
}

#ifndef MK_ONE_LAUNCH
#define MK_ONE_LAUNCH 1
#endif
extern "C" void kernel_launch(void* const* d_in, const int* in_sizes, int n_in, void* d_out, int out_size, void* d_ws, size_t ws_size, hipStream_t stream) {
    static int grid = 0;
    if (grid == 0) {
        if (n_in != 25 || out_size != NTOK * D || ws_size < WS_END) { fprintf(stderr, "kernel_launch: unexpected shapes: n_in %d out %d ws %zu (need %zu)\n", n_in, out_size, ws_size, (size_t)WS_END); grid = -1; return; }
        int dev = 0, cus = 0, per_cu = 0;
        if (hipGetDevice(&dev) != hipSuccess || hipDeviceGetAttribute(&cus, hipDeviceAttributeMultiprocessorCount, dev) != hipSuccess) { grid = -1; return; }
        if (hipFuncSetAttribute((const void*)mk_fwd, hipFuncAttributeMaxDynamicSharedMemorySize, LDS_BYTES) != hipSuccess) { fprintf(stderr, "kernel_launch: hipFuncSetAttribute failed\n"); grid = -1; return; }
        if (hipOccupancyMaxActiveBlocksPerMultiprocessor(&per_cu, (const void*)mk_fwd, 512, LDS_BYTES) != hipSuccess || per_cu < 1) fprintf(stderr, "kernel_launch: occupancy query says %d\n", per_cu);
        (void)hipGetLastError();
        grid = cus;
    }
    if (grid < 0) return;
    (void)hipMemsetAsync((char*)d_ws + WS_CTL, 0, CTL_ZERO_BYTES, stream);
    Params p{};
    for (int i = 0; i < 25; ++i) p.in[i] = (const float*)d_in[i];
    p.out = (float*)d_out; p.ws = (unsigned char*)d_ws;
    for (int i = 0; i < 32; ++i) p.inv_rev[i] = pow(10000.0, -(double)i / 32.0) / (2.0 * 3.14159265358979323846);
    for (int h = 0; h < 4; ++h) p.lg2[h] = (float)log2(1.0 - pow(2.0, -5.0 - (double)h));
#if MK_ONE_LAUNCH
    p.ph_lo = 0; p.ph_hi = N_PHASES; p.use_bar = 1;
    hipLaunchKernelGGL(mk_fwd, dim3(grid), dim3(512), LDS_BYTES, stream, p);
#else
    for (int k = 0; k < N_PHASES; ++k) { p.ph_lo = k; p.ph_hi = k + 1; p.use_bar = 0;
        hipLaunchKernelGGL(mk_fwd, dim3(grid), dim3(512), LDS_BYTES, stream, p); }
#endif
}
```

```cpp
#include <hip/hip_runtime.h>
#include <cstdio>
#include <cstdint>
#include <cmath>
#define LAS __attribute__((address_space(3)))
namespace pg8 {
#define PG8_LAS __attribute__((address_space(3)))
typedef unsigned short bf16_t;
typedef short bf16x8 __attribute__((ext_vector_type(8)));
typedef float f32x4 __attribute__((ext_vector_type(4)));
typedef unsigned u32x4 __attribute__((ext_vector_type(4)));
constexpr int BM = 256, BK = 64, HALF = 128, HTB = HALF * BK * 2  , STAGE_BYTES = 8 * HTB, NXCD = 8, WGM = 8;

__host__ __device__ __forceinline__ int lds_byte(int r, int c) { const int st = (r >> 4) * 2 + (c >> 5), rr = r & 15, cc = c & 31, ob = rr * 64 + cc * 2; return st * 1024 + (ob ^ (((ob >> 9) & 1) << 5)); }
__host__ __device__ __forceinline__ void stage_rc(int b, int& R, int& C) { const int st = b / 1024, sb = b % 1024, swz = sb ^ (((sb >> 9) & 1) << 5); R = (st >> 1) * 16 + swz / 64; C = (st & 1) * 32 + (swz % 64) / 2; }
__host__ __device__ __forceinline__ int perm32(int rho) { const int n = rho >> 4, i = rho & 15; return 8 * (i >> 2) + 4 * n + (i & 3); }

struct Unit { int pm, pn; };
struct Gemm { const bf16_t* A; const bf16_t* Bt; int M, N, K; };

struct StaticOrder {
    int nM, nN, nwg, G, c;
    __host__ __device__ void init(int M, int N, int G_, int c_) { nM = M / BM; nN = N / BM; nwg = nM * nN; G = G_; c = c_; }
    __host__ __device__ bool next(int i, Unit& u) const {
        const long L = (long)i * G + c; if (L >= nwg) return false;
        int wgid = (int)L; { const int q = nwg / NXCD, r = nwg % NXCD, xcd = wgid % NXCD, off = wgid / NXCD; wgid = (xcd < r ? xcd * (q + 1) : r * (q + 1) + (xcd - r) * q) + off; }
        const int nig = WGM * nN, gid = wgid / nig, fm = gid * WGM, gsz = (nM - fm) < WGM ? (nM - fm) : WGM;
        u.pm = fm + ((wgid % nig) % gsz); u.pn = (wgid % nig) / gsz; return true;
    }
    __device__ __forceinline__ void a_ready(const Unit&) const {}
    __device__ __forceinline__ void done(const Unit&) const {}
};
__device__ __forceinline__ unsigned cvt_pk_bf16(float lo, float hi) { unsigned r; asm volatile("v_cvt_pk_bf16_f32 %0, %1, %2" : "=v"(r) : "v"(lo), "v"(hi)); return r; }
typedef float f32x2 __attribute__((ext_vector_type(2)));
__device__ __forceinline__ float gelu_tanh_f(float x) {
    const float u = 1.5957691216057308f * (x + 0.044715f * x * x * x);
    return x * __builtin_amdgcn_rcpf(1.0f + __expf(-u));
}
struct EpiH {
    static constexpr bool PERM = true, AFTER_DRAIN = false;
    bf16_t* O; int ldc; int act_lo, act_hi;
    __device__ __forceinline__ void operator()(const f32x4 (&acc)[2][2][4][2], const Unit& u, int wr, int wc, int fr, int fq) const {
        const int row0 = u.pm * BM + wr * 64 + fr; const int col0 = u.pn * BM + wc * 32 + 8 * fq;
        const bool act = (u.pn >= act_lo) && (u.pn < act_hi);
#pragma unroll
        for (int ai = 0; ai < 2; ++ai)
#pragma unroll
            for (int m = 0; m < 4; ++m) { bf16_t* rowp = O + (size_t)(row0 + ai * HALF + m * 16) * ldc + col0;
#pragma unroll
                for (int bj = 0; bj < 2; ++bj) { f32x4 v0 = acc[ai][bj][m][0], v1 = acc[ai][bj][m][1];
                    if (act) {
#pragma unroll
                        for (int j = 0; j < 4; ++j) { v0[j] = gelu_tanh_f(v0[j]); v1[j] = gelu_tanh_f(v1[j]); } }
                    u32x4 w; w.x = cvt_pk_bf16(v0[0], v0[1]); w.y = cvt_pk_bf16(v0[2], v0[3]); w.z = cvt_pk_bf16(v1[0], v1[1]); w.w = cvt_pk_bf16(v1[2], v1[3]);
                    *(u32x4*)(rowp + bj * HALF) = w; } }
    }
};
struct EpiRes {
    static constexpr bool PERM = false, AFTER_DRAIN = false;
    float* C; const float* X; int ldc; float alpha;
    __device__ __forceinline__ void operator()(const f32x4 (&acc)[2][2][4][2], const Unit& u, int wr, int wc, int fr, int fq) const {
        const int row0 = u.pm * BM + wr * 64 + fr, col0 = u.pn * BM + wc * 32 + 4 * fq;
#pragma unroll
        for (int ai = 0; ai < 2; ++ai)
#pragma unroll
            for (int m = 0; m < 4; ++m) { const size_t off = (size_t)(row0 + ai * HALF + m * 16) * ldc + col0;
#pragma unroll
                for (int bj = 0; bj < 2; ++bj)
#pragma unroll
                    for (int n = 0; n < 2; ++n) { const size_t o2 = off + bj * HALF + n * 16; const f32x4 xv = *(const f32x4*)(X + o2); *(f32x4*)(C + o2) = acc[ai][bj][m][n] + xv * alpha; } }
    }
};
struct EpiF32 {
    static constexpr bool PERM = false, AFTER_DRAIN = false;
    float* C; int ldc;
    __device__ __forceinline__ void operator()(const f32x4 (&acc)[2][2][4][2], const Unit& u, int wr, int wc, int fr, int fq) const {
        const int row0 = u.pm * BM + wr * 64 + fr, col0 = u.pn * BM + wc * 32 + 4 * fq;
#pragma unroll
        for (int ai = 0; ai < 2; ++ai)
#pragma unroll
            for (int m = 0; m < 4; ++m) { float* rowp = C + (size_t)(row0 + ai * HALF + m * 16) * ldc + col0;
#pragma unroll
                for (int bj = 0; bj < 2; ++bj)
#pragma unroll
                    for (int n = 0; n < 2; ++n) *(f32x4*)(rowp + bj * HALF + n * 16) = acc[ai][bj][m][n]; }
    }
};
template <class Epi, class Sched, bool ALIGN_EPI = false, bool SP2 = false>
__device__ __forceinline__ void gemm_phase(PG8_LAS unsigned char* lds, const Gemm g, const Sched& S, const Epi& E, const int tid) {
    const int wid = __builtin_amdgcn_readfirstlane(tid >> 6), lane = tid & 63, wr = wid >> 2, wc = wid & 3, fr = lane & 15, fq = lane >> 4;
    const int K = g.K, nt = K / BK;
    unsigned voffA[2], voffB[2];
#pragma unroll
    for (int i = 0; i < 2; ++i) { int R, C; stage_rc(tid * 16 + i * 8192, R, C); const int Rb = Epi::PERM ? ((R & ~31) + perm32(R & 31)) : R;
        voffA[i] = (unsigned)(R * K + C) * 2u; voffB[i] = (unsigned)(Rb * K + C) * 2u; }
    const size_t kstep = (size_t)(BK * 2);
    const size_t hstep = (size_t)HALF * K * 2;
    const size_t tstep = 2 * hstep;
    const unsigned ldsw = (unsigned)wid * 1024u;
    const int aoff = lds_byte(wr * 64 + fr, fq * 8), boff = lds_byte(wc * 32 + fr, fq * 8);
#define PG8_SA(b, h) (((b) * 2 + (h)) * HTB)
#define PG8_SB(b, h) ((4 + (b) * 2 + (h)) * HTB)
#define PG8_STAGE(bufoff, gbase, voff) do { _Pragma("unroll") for (int _i = 0; _i < 2; ++_i) \
        __builtin_amdgcn_global_load_lds((const unsigned*)((const char*)(gbase) + (voff)[_i]), (PG8_LAS unsigned*)(lds + (bufoff) + ldsw + _i * 8192), 16, 0, 0); } while (0)
#define PG8_LDA(dst, b, h) do { _Pragma("unroll") for (int m = 0; m < 4; ++m) _Pragma("unroll") for (int k = 0; k < 2; ++k) dst[m][k] = *(const PG8_LAS bf16x8*)(lds + PG8_SA(b, h) + aoff + m * 2048 + k * 1024); } while (0)
#define PG8_LDB(dst, b, h) do { _Pragma("unroll") for (int n = 0; n < 2; ++n) _Pragma("unroll") for (int k = 0; k < 2; ++k) dst[n][k] = *(const PG8_LAS bf16x8*)(lds + PG8_SB(b, h) + boff + n * 2048 + k * 1024); } while (0)
#define PG8_MMA(ai, bj, At, Bt) do { __builtin_amdgcn_s_setprio(1); _Pragma("unroll") for (int m = 0; m < 4; ++m) _Pragma("unroll") for (int n = 0; n < 2; ++n) _Pragma("unroll") for (int k = 0; k < 2; ++k) \
        acc[ai][bj][m][n] = __builtin_amdgcn_mfma_f32_16x16x32_bf16(Bt[n][k], At[m][k], acc[ai][bj][m][n], 0, 0, 0); __builtin_amdgcn_s_setprio(0); } while (0)
#define PG8_WAIT_V(n) asm volatile("s_waitcnt vmcnt(" #n ")" ::: "memory")
#define PG8_WAIT_L(n) asm volatile("s_waitcnt lgkmcnt(" #n ")" ::: "memory")
#define PG8_BAR __builtin_amdgcn_s_barrier()
#define PG8_SCHED __builtin_amdgcn_sched_barrier(0)
    Unit cur, nxt; int ui = 0;
    if (!S.next(0, cur)) return;
    f32x4 acc[2][2][4][2];
#pragma unroll
    for (int a = 0; a < 2; ++a)
#pragma unroll
        for (int b = 0; b < 2; ++b)
#pragma unroll
            for (int m = 0; m < 4; ++m)
#pragma unroll
                for (int n = 0; n < 2; ++n) acc[a][b][m][n] = (f32x4){0.f, 0.f, 0.f, 0.f};
    bf16x8 At[4][2], B0[2][2], B1[2][2];
    const char* cA = (const char*)g.A + (size_t)cur.pm * tstep; const char* cB = (const char*)g.Bt + (size_t)cur.pn * tstep;
    S.a_ready(cur);
    if constexpr (SP2) {
        PG8_STAGE(PG8_SB(0, 0), cB, voffB); PG8_STAGE(PG8_SB(0, 1), cB + hstep, voffB); PG8_STAGE(PG8_SA(0, 0), cA, voffA); PG8_STAGE(PG8_SA(0, 1), cA + hstep, voffA);
        if (wr == 1) PG8_BAR;
        PG8_WAIT_V(2); PG8_BAR;
        PG8_STAGE(PG8_SB(1, 0), cB + kstep, voffB); PG8_STAGE(PG8_SA(1, 0), cA + kstep, voffA); PG8_STAGE(PG8_SB(1, 1), cB + hstep + kstep, voffB);
        PG8_WAIT_V(6); PG8_BAR;
    } else {
        PG8_STAGE(PG8_SB(0, 0), cB, voffB); PG8_STAGE(PG8_SA(0, 0), cA, voffA); PG8_STAGE(PG8_SB(0, 1), cB + hstep, voffB); PG8_STAGE(PG8_SA(0, 1), cA + hstep, voffA);
        if (wr == 1) PG8_BAR;
        PG8_WAIT_V(4); PG8_BAR;
        PG8_STAGE(PG8_SB(1, 0), cB + kstep, voffB); PG8_STAGE(PG8_SA(1, 0), cA + kstep, voffA); PG8_STAGE(PG8_SB(1, 1), cB + hstep + kstep, voffB);
        PG8_WAIT_V(6); PG8_BAR;
    }
    for (;;) {
        const bool has_next = S.next(ui + 1, nxt);
        const char* nA = has_next ? (const char*)g.A + (size_t)nxt.pm * tstep : cA; const char* nB = has_next ? (const char*)g.Bt + (size_t)nxt.pn * tstep : cB;
        for (int t = 0; t < nt; t += 2) {
            const bool last = (t == nt - 2);
            const char* a1 = cA + (size_t)(t + 1) * kstep;
            const char* a2 = last ? nA : cA + (size_t)(t + 2) * kstep; const char* b2 = last ? nB : cB + (size_t)(t + 2) * kstep;
            const char* a3 = a2 + kstep; const char* b3 = b2 + kstep;
            if (last && has_next) S.a_ready(nxt);
            if constexpr (SP2) {
            PG8_LDB(B0, 0, 0); PG8_LDB(B1, 0, 1); PG8_SCHED; PG8_LDA(At, 0, 0); PG8_STAGE(PG8_SA(1, 1), a1 + hstep, voffA);
            PG8_WAIT_V(8); PG8_WAIT_L(0); PG8_BAR; PG8_MMA(0, 0, At, B0); PG8_MMA(0, 1, At, B1); PG8_BAR; PG8_SCHED;
            PG8_LDA(At, 0, 1); PG8_STAGE(PG8_SB(0, 0), b2, voffB); PG8_STAGE(PG8_SB(0, 1), b2 + hstep, voffB); PG8_STAGE(PG8_SA(0, 0), a2, voffA);
            PG8_WAIT_V(8); PG8_WAIT_L(0); PG8_BAR; PG8_MMA(1, 0, At, B0); PG8_MMA(1, 1, At, B1); PG8_BAR; PG8_SCHED;
            PG8_LDB(B0, 1, 0); PG8_LDB(B1, 1, 1); PG8_SCHED; PG8_LDA(At, 1, 0); PG8_STAGE(PG8_SA(0, 1), a2 + hstep, voffA);
            PG8_WAIT_V(8); PG8_WAIT_L(0); PG8_BAR; PG8_MMA(0, 0, At, B0); PG8_MMA(0, 1, At, B1); PG8_BAR; PG8_SCHED;
            PG8_LDA(At, 1, 1); PG8_STAGE(PG8_SB(1, 0), b3, voffB); PG8_STAGE(PG8_SB(1, 1), b3 + hstep, voffB); PG8_STAGE(PG8_SA(1, 0), a3, voffA);
            PG8_WAIT_V(8); PG8_WAIT_L(0); PG8_BAR; PG8_MMA(1, 0, At, B0); PG8_MMA(1, 1, At, B1); PG8_BAR; PG8_SCHED;
            } else {
            PG8_LDB(B0, 0, 0); PG8_SCHED; PG8_LDA(At, 0, 0); PG8_STAGE(PG8_SA(1, 1), a1 + hstep, voffA);
            PG8_WAIT_L(8); PG8_BAR; PG8_WAIT_L(0); PG8_MMA(0, 0, At, B0); PG8_BAR; PG8_SCHED;
            PG8_LDB(B1, 0, 1); PG8_STAGE(PG8_SB(0, 0), b2, voffB);
            PG8_BAR; PG8_WAIT_L(0); PG8_MMA(0, 1, At, B1); PG8_BAR;
            PG8_LDA(At, 0, 1); PG8_STAGE(PG8_SA(0, 0), a2, voffA);
            PG8_BAR; PG8_WAIT_L(0); PG8_MMA(1, 0, At, B0); PG8_BAR; PG8_SCHED;
            PG8_STAGE(PG8_SB(0, 1), b2 + hstep, voffB);
            PG8_WAIT_V(6); PG8_BAR; PG8_MMA(1, 1, At, B1); PG8_BAR;
            PG8_LDB(B0, 1, 0); PG8_SCHED; PG8_LDA(At, 1, 0); PG8_STAGE(PG8_SA(0, 1), a2 + hstep, voffA);
            PG8_WAIT_L(8); PG8_BAR; PG8_WAIT_L(0); PG8_MMA(0, 0, At, B0); PG8_BAR; PG8_SCHED;
            PG8_LDB(B1, 1, 1); PG8_STAGE(PG8_SB(1, 0), b3, voffB);
            PG8_BAR; PG8_WAIT_L(0); PG8_MMA(0, 1, At, B1); PG8_BAR;
            PG8_LDA(At, 1, 1); PG8_STAGE(PG8_SA(1, 0), a3, voffA);
            PG8_BAR; PG8_WAIT_L(0); PG8_MMA(1, 0, At, B0); PG8_BAR; PG8_SCHED;
            PG8_STAGE(PG8_SB(1, 1), b3 + hstep, voffB);
            PG8_WAIT_V(6); PG8_BAR; PG8_MMA(1, 1, At, B1); PG8_BAR;
            }
        }
        if constexpr (ALIGN_EPI) { if (wr == 0) PG8_BAR; }
        if constexpr (!Epi::AFTER_DRAIN) { E(acc, cur, wr, wc, fr, fq); S.done(cur); }
        if (!has_next) break;
#pragma unroll
        for (int a = 0; a < 2; ++a)
#pragma unroll
            for (int b = 0; b < 2; ++b)
#pragma unroll
                for (int m = 0; m < 4; ++m)
#pragma unroll
                    for (int n = 0; n < 2; ++n) acc[a][b][m][n] = (f32x4){0.f, 0.f, 0.f, 0.f};
        cur = nxt; cA = nA; cB = nB; ++ui;
        if constexpr (ALIGN_EPI) { if (wr == 1) PG8_BAR; }
    }
    PG8_WAIT_V(0);
    if constexpr (!ALIGN_EPI) { if (wr == 0) PG8_BAR; }
    PG8_BAR;
    if constexpr (Epi::AFTER_DRAIN) { E.fused(acc, cur, wr, wc, fr, fq, lds, wid, lane); S.done(cur); }
#undef PG8_SA
#undef PG8_SB
#undef PG8_STAGE
#undef PG8_LDA
#undef PG8_LDB
#undef PG8_MMA
#undef PG8_WAIT_V
#undef PG8_WAIT_L
#undef PG8_BAR
#undef PG8_SCHED
}
}
#define XB_TMO      128
#define XB_XCNT(j)  (256  + 64 * (j))
#define XB_XSUB(j)  (1280 + 64 * (j))
#define XB_XGEN(j)  (2304 + 64 * (j))
#define XB_TOP      3328
#define XB_TOPGEN   3392
#define XCD_BAR_WORDS 3456
#define XB_SPIN_CAP (1u << 18)

__device__ __forceinline__ unsigned xb_ld(unsigned* p)              { return __hip_atomic_load(p, __ATOMIC_RELAXED, __HIP_MEMORY_SCOPE_AGENT); }
__device__ __forceinline__ unsigned xb_add(unsigned* p, unsigned v) { return __hip_atomic_fetch_add(p, v, __ATOMIC_RELAXED, __HIP_MEMORY_SCOPE_AGENT); }
__device__ __forceinline__ unsigned xb_xcc_id() { return (unsigned)__builtin_amdgcn_s_getreg((3 << 11) | 20) & 0xFu; }
#define XB_SPIN(cond, bar) do { unsigned _sp = 0; while (cond) { __builtin_amdgcn_s_sleep(1); \
    if ((++_sp & 255u) == 0u) { if (xb_ld(&(bar)[XB_TMO])) break; if (_sp > XB_SPIN_CAP) { atomicAdd(&(bar)[XB_TMO], 1u); break; } } } } while (0)

struct XcdBarrier {
    unsigned* bar; unsigned x; unsigned w0;
    volatile LAS unsigned* st;
};

__device__ __forceinline__ bool xb_tid0(unsigned w0) { return w0 != 0u && __builtin_amdgcn_mbcnt_hi(0xffffffffu, __builtin_amdgcn_mbcnt_lo(0xffffffffu, 0u)) == 0u; }
__device__ __forceinline__ XcdBarrier xcd_barrier_post(unsigned* bar, volatile LAS unsigned* st) {
    XcdBarrier b; b.bar = bar; b.x = xb_xcc_id(); b.st = st; b.w0 = (__builtin_amdgcn_readfirstlane(threadIdx.x >> 6) == 0) ? 1u : 0u;
    if (threadIdx.x == 0) (void)xb_add(&bar[XB_XCNT(b.x)], 1u);
    return b;
}
__device__ __forceinline__ void xcd_barrier_complete(unsigned* bar, unsigned x, unsigned& nloc, unsigned& nx) {
    const unsigned G = gridDim.x * gridDim.y * gridDim.z;
    unsigned sum, cnt, mine, sp = 0u;
    for (;;) {
        sum = 0u; cnt = 0u; mine = 0u;
#pragma unroll
        for (unsigned j = 0; j < 16; ++j) { const unsigned c = xb_ld(&bar[XB_XCNT(j)]); sum += c; cnt += (c > 0u) ? 1u : 0u; mine = (j == x) ? c : mine; }
        if (sum == G) break;
        __builtin_amdgcn_s_sleep(1);
        if ((++sp & 255u) == 0u) { if (xb_ld(&bar[XB_TMO])) break; if (sp > XB_SPIN_CAP) { atomicAdd(&bar[XB_TMO], 1u); break; } }
    }
    nloc = mine > 0u ? mine : 1u; nx = cnt > 0u ? cnt : 1u;
}

__device__ __forceinline__ void xcd_barrier(const XcdBarrier& b) {
    asm volatile("s_waitcnt vmcnt(0)" ::: "memory");
    __syncthreads();
    if (xb_tid0(b.w0)) {
        unsigned* bar = b.bar;
        __builtin_amdgcn_s_waitcnt(0);
        unsigned nloc = b.st[0], nx = b.st[1];
        if (nloc == 0u) { xcd_barrier_complete(bar, b.x, nloc, nx); b.st[0] = nloc; b.st[1] = nx; }
        const unsigned old = xb_add(&bar[XB_XSUB(b.x)], 1u);
        const unsigned gen = old / nloc;
        if (old + 1u == (gen + 1u) * nloc) {
            __builtin_amdgcn_fence(__ATOMIC_RELEASE, "agent");
            asm volatile("s_waitcnt vmcnt(0)" ::: "memory");
            const unsigned og = xb_add(&bar[XB_TOP], 1u);
            const unsigned tg = og / nx;
            if (og + 1u == (tg + 1u) * nx) xb_add(&bar[XB_TOPGEN], 1u);
            else XB_SPIN(xb_ld(&bar[XB_TOPGEN]) == tg, bar);
            __builtin_amdgcn_fence(__ATOMIC_ACQUIRE, "agent");
            xb_add(&bar[XB_XGEN(b.x)], 1u);
            asm volatile("s_waitcnt vmcnt(0)" ::: "memory");
        } else {
            XB_SPIN(xb_ld(&bar[XB_XGEN(b.x)]) == gen, bar);
            __builtin_amdgcn_fence(__ATOMIC_ACQUIRE, "agent");
            asm volatile("s_waitcnt vmcnt(0)" ::: "memory");
        }
    }
    __syncthreads();
}

#ifndef PROBE_DUP
#define PROBE_DUP -1
#endif
#define REP(i) for (int rep_ = 0; rep_ < ((PROBE_DUP == (i)) ? 2 : 1); ++rep_)
constexpr int NB = 4, T = 2048, D = 2048, NTOK = NB * T, DEPTH = 4;
constexpr int INW = 5168, INWP = 5376;
constexpr int C_RQ = 0, C_RK = 256, C_RV = 512, C_RG = 1024, C_SU = 1536, C_SV = 2048, C_NQ = 2560, C_KC = 3584, C_VC = 3840, C_KS = 4096, C_VS = 4352, C_KW = 4608, C_VW = 4864, C_NG = 5120;
constexpr float ALPHA = 1.6817928305074290f;
constexpr float LN_EPS = 1e-5f;
constexpr float LOG2E = 1.4426950408889634f;

constexpr size_t MiB = (size_t)1 << 20;
constexpr size_t WS_CTL = 0, CTL_ZERO_BYTES = 1 * MiB;
constexpr size_t WS_ROPE = 1 * MiB;
constexpr size_t WS_WIN = 2 * MiB;
constexpr size_t WS_WOUT = 86 * MiB;
constexpr size_t WS_WQ = 118 * MiB;
constexpr size_t WS_PU = 160 * MiB;
constexpr size_t WS_PV = 416 * MiB;
constexpr size_t WS_H = 672 * MiB;
constexpr size_t WS_YMIX = 756 * MiB;
constexpr size_t WS_MIXED = 820 * MiB;
constexpr size_t WS_Z = 852 * MiB;
constexpr size_t WS_X1 = 916 * MiB;
constexpr size_t WS_X1B = 980 * MiB;
constexpr size_t WS_QP = 1012 * MiB;
constexpr size_t WS_XC = 1076 * MiB;
constexpr size_t WS_XB = 1140 * MiB;
constexpr size_t WS_KC = 1172 * MiB;
constexpr size_t WS_KVST = 1174 * MiB;
constexpr size_t WS_SC = 1184 * MiB;
constexpr size_t WS_PSC = 1248 * MiB;
constexpr size_t WS_W1T = 1250 * MiB;
constexpr size_t WS_W2T = 1258 * MiB;
constexpr size_t WS_PKB = 1260 * MiB;
#ifndef PEER_NBKT
#define PEER_NBKT 8
#endif
#ifndef PEER_PG
#define PEER_PG 4
#endif
constexpr int PG = PEER_PG;
constexpr int NBKT = PEER_NBKT, NRND = NBKT / 8, FCAP = 4096, BSH = (NBKT == 16) ? 10 : 11;
constexpr size_t WS_FE = 1262 * MiB;
constexpr size_t WS_FW = 1326 * MiB;
constexpr size_t WS_FHW = 1390 * MiB;
constexpr size_t WS_GST = 1454 * MiB;
constexpr size_t WS_PART = 1456 * MiB;
constexpr size_t WS_X1Q = 1712 * MiB;
constexpr size_t WS_XSC = 1728 * MiB;
constexpr size_t WS_END = 1730 * MiB;
constexpr int CW_BAR = 4096;

constexpr int LDS_BYTES = 147456;
constexpr int MISC_OFF = 143360;

#define GAS __attribute__((address_space(1)))
typedef float f4 __attribute__((ext_vector_type(4)));
typedef float f2 __attribute__((ext_vector_type(2)));
typedef unsigned u4 __attribute__((ext_vector_type(4)));
typedef unsigned u2 __attribute__((ext_vector_type(2)));
__device__ __forceinline__ f4 mk_f4(float a, float b, float c, float d) { f4 r; r.x = a; r.y = b; r.z = c; r.w = d; return r; }
__device__ __forceinline__ f2 mk_f2(float a, float b) { f2 r; r.x = a; r.y = b; return r; }
__device__ __forceinline__ u2 mk_u2(unsigned a, unsigned b) { u2 r; r.x = a; r.y = b; return r; }
typedef unsigned short bf16;
#define LDS_WAIT() asm volatile("s_waitcnt lgkmcnt(0)" ::: "memory")
#define VM_WAIT() asm volatile("s_waitcnt vmcnt(0)" ::: "memory")

struct Params {
    const float* in[25];
    float* out;
    unsigned char* ws;
    double inv_rev[32];
    float lg2[4];
    int ph_lo, ph_hi, use_bar, pad0;
};

__device__ __forceinline__ float bf2f(unsigned short b) { return __uint_as_float(((unsigned)b) << 16); }
__device__ __forceinline__ unsigned f2bf(float f) { unsigned u = __float_as_uint(f); return (u + 0x7fffu + ((u >> 16) & 1u)) >> 16; }
__device__ __forceinline__ unsigned pk2(float lo, float hi) { return f2bf(lo) | (f2bf(hi) << 16); }
__device__ __forceinline__ float wave_sum(float v) {
#pragma unroll
    for (int o = 1; o < 64; o <<= 1) v += __shfl_xor(v, o);
    return v;
}
__device__ __forceinline__ void unpack8(const u4& v, float* f) {
    f[0] = __uint_as_float(v.x << 16); f[1] = __uint_as_float(v.x & 0xffff0000u);
    f[2] = __uint_as_float(v.y << 16); f[3] = __uint_as_float(v.y & 0xffff0000u);
    f[4] = __uint_as_float(v.z << 16); f[5] = __uint_as_float(v.z & 0xffff0000u);
    f[6] = __uint_as_float(v.w << 16); f[7] = __uint_as_float(v.w & 0xffff0000u);
}
__device__ __forceinline__ float gelu_tanh(float x) { return pg8::gelu_tanh_f(x); }

__device__ __forceinline__ void transpose_tile(const float* __restrict__ W, int K, int N, bf16* __restrict__ WT, LAS float* scr, int kb, int nb, int lane) {
    const int k0 = kb * 64, n0 = nb * 32, rsub = lane >> 3, c4 = (lane & 7) * 4; const bool ok = (n0 + c4) < N;
    f4 v[8];
#pragma unroll
    for (int i = 0; i < 8; ++i) v[i] = ok ? *(const f4*)(W + (size_t)(k0 + 8 * i + rsub) * N + n0 + c4) : mk_f4(0.f, 0.f, 0.f, 0.f);
#pragma unroll
    for (int i = 0; i < 8; ++i) { LAS float* d = scr + (8 * i + rsub) * 33 + c4; d[0] = v[i].x; d[1] = v[i].y; d[2] = v[i].z; d[3] = v[i].w; }
    LDS_WAIT();
    const int c = lane & 7;
#pragma unroll
    for (int j = 0; j < 4; ++j) { const int n = (lane >> 3) + 8 * j; const LAS float* s = scr + (8 * c) * 33 + n;
        u4 o; o.x = pk2(s[0 * 33], s[1 * 33]); o.y = pk2(s[2 * 33], s[3 * 33]); o.z = pk2(s[4 * 33], s[5 * 33]); o.w = pk2(s[6 * 33], s[7 * 33]);
        *(u4*)(WT + (size_t)(n0 + n) * K + k0 + 8 * c) = o; }
    LDS_WAIT();
}
__device__ __forceinline__ void cvt_bf16_stream(const float* __restrict__ src, bf16* __restrict__ dst, size_t nchunks, size_t gt, size_t GT) {
    for (size_t c = gt; c < nchunks; c += GT) { const f4 a = ((const f4*)src)[2 * c], b = ((const f4*)src)[2 * c + 1];
        u4 o; o.x = pk2(a.x, a.y); o.y = pk2(a.z, a.w); o.z = pk2(b.x, b.y); o.w = pk2(b.z, b.w); ((u4*)dst)[c] = o; }
}
__device__ __forceinline__ void phase_prologue(const Params& P, unsigned char* ws, LAS unsigned char* lds, int tid, int lane, int wave) {
    LAS float* scr = (LAS float*)(lds + wave * 8704);
    const int gw = blockIdx.x * 8 + wave, NGW = gridDim.x * 8;
    constexpr int I_IN = 32 * 168, I_SQ = 32 * 64, I_L = I_IN + 2 * I_SQ;
    REP(21) for (int it = gw; it < DEPTH * I_L; it += NGW) {
        const int l = it / I_L; int r = it % I_L;
        if (r < I_IN) transpose_tile(P.in[1] + (size_t)l * D * INW, D, INW, (bf16*)(ws + WS_WIN) + (size_t)l * INWP * D, scr, r / 168, r % 168, lane);
        else { r -= I_IN;
            if (r < I_SQ) transpose_tile(P.in[15] + (size_t)l * D * D, D, D, (bf16*)(ws + WS_WOUT) + (size_t)l * D * D, scr, r / 64, r % 64, lane);
            else { r -= I_SQ; transpose_tile(P.in[18] + (size_t)l * D * D, D, D, (bf16*)(ws + WS_WQ) + (size_t)l * D * D, scr, r / 64, r % 64, lane); } }
    }
    for (int it = gw; it < DEPTH * 2 * (32 * 8 + 4 * 2); it += NGW) {
        const int lk = it / 264, r = it % 264, l = lk >> 1, kv = lk & 1;
        if (r < 256) transpose_tile(P.in[kv ? 12 : 9] + (size_t)l * 2048 * 256, 2048, 256, (bf16*)(ws + WS_W1T) + (size_t)lk * 256 * 2048, scr, r >> 3, r & 7, lane);
        else transpose_tile(P.in[kv ? 13 : 10] + (size_t)l * 256 * 64, 256, 64, (bf16*)(ws + WS_W2T) + (size_t)lk * 64 * 256, scr, (r - 256) >> 1, (r - 256) & 1, lane);
    }
    const size_t gt = (size_t)blockIdx.x * 512 + tid, GT = (size_t)gridDim.x * 512;
    REP(22) for (int row = gw; row < 2 * DEPTH * 16384; row += NGW) {
        const int tab = row / (DEPTH * 16384), rr = row % (DEPTH * 16384);
        const float* src = P.in[21 + tab] + (size_t)rr * 2048;
        f4 v[8]; float am = 0.f;
#pragma unroll
        for (int j = 0; j < 2; ++j)
#pragma unroll
            for (int q = 0; q < 4; ++q) { const f4 a = *(const f4*)(src + 1024 * j + 16 * lane + 4 * q); v[4 * j + q] = a; am = fmaxf(am, fmaxf(fmaxf(fabsf(a.x), fabsf(a.y)), fmaxf(fabsf(a.z), fabsf(a.w)))); }
#pragma unroll
        for (int o = 1; o < 64; o <<= 1) am = fmaxf(am, __shfl_xor(am, o));
        unsigned char* dst = ws + (tab ? WS_PV : WS_PU) + (size_t)rr * 2048;
        if (tab) {
            const float sc = (am > 0.f) ? 448.f / am : 1.f;
            if (lane == 0) ((float*)(ws + WS_PSC))[row] = (am > 0.f) ? am * (1.f / 448.f) : 1.f;
#pragma unroll
            for (int j = 0; j < 2; ++j) { u4 w;
#pragma unroll
                for (int q = 0; q < 4; ++q) { const f4 a = v[4 * j + q]; int r = __builtin_amdgcn_cvt_pk_fp8_f32(a.x * sc, a.y * sc, 0, false); r = __builtin_amdgcn_cvt_pk_fp8_f32(a.z * sc, a.w * sc, r, true); w[q] = (unsigned)r; }
                *(u4*)(dst + 1024 * j + 16 * lane) = w; }
        } else {
            const float sc = (am > 0.f) ? 127.f / am : 1.f;
            if (lane == 0) ((float*)(ws + WS_PSC))[row] = (am > 0.f) ? am * (1.f / 127.f) : 1.f;
#pragma unroll
            for (int j = 0; j < 2; ++j) { u4 w;
#pragma unroll
                for (int q = 0; q < 4; ++q) { const f4 a = v[4 * j + q];
                    const int b0 = (int)rintf(a.x * sc), b1 = (int)rintf(a.y * sc), b2 = (int)rintf(a.z * sc), b3 = (int)rintf(a.w * sc);
                    w[q] = (unsigned)(b0 & 0xff) | ((unsigned)(b1 & 0xff) << 8) | ((unsigned)(b2 & 0xff) << 16) | ((unsigned)b3 << 24); }
                *(u4*)(dst + 1024 * j + 16 * lane) = w; }
        }
    }
    cvt_bf16_stream(P.in[0], (bf16*)(ws + WS_XB), (size_t)NTOK * D / 8, gt, GT);
    cvt_bf16_stream(P.in[19], (bf16*)(ws + WS_PKB), (size_t)DEPTH * 8 * 128 * 128 / 8, gt, GT);
    cvt_bf16_stream(P.in[20], (bf16*)(ws + WS_PKB) + (size_t)DEPTH * 8 * 128 * 128, (size_t)DEPTH * 8 * 128 * 128 / 8, gt, GT);
    f2* rope = (f2*)(ws + WS_ROPE);
    for (size_t idx = gt; idx < (size_t)T * 32; idx += GT) { const int t = (int)(idx >> 5), i = (int)(idx & 31);
        double a = (double)t * P.inv_rev[i]; a -= floor(a); const float fr = (float)a;
        rope[idx] = mk_f2(__builtin_amdgcn_cosf(fr), __builtin_amdgcn_sinf(fr)); }
}

__device__ __forceinline__ void stage_rot_k(const bf16* __restrict__ Hb, const f2* __restrict__ rope, LAS float* ks, int tok0, int tpos0, int colK, float lg2h, bool zeta, int tid) {
    const int m = tid >> 2, p = tid & 3;
    const bf16* src = Hb + (size_t)(tok0 + m) * INWP + colK + p * 8;
    const u4 a = *(const u4*)src, b = *(const u4*)(src + 32);
    float x1[8], x2[8]; unpack8(a, x1); unpack8(b, x2);
    const f4* rp = (const f4*)(rope + (size_t)(tpos0 + m) * 32 + p * 8);
    const f4 r0 = rp[0], r1 = rp[1], r2 = rp[2], r3 = rp[3];
    const float cs[8] = {r0.x, r0.z, r1.x, r1.z, r2.x, r2.z, r3.x, r3.z}, sn[8] = {r0.y, r0.w, r1.y, r1.w, r2.y, r2.w, r3.y, r3.w};
    const float sc = 0.125f * (zeta ? exp2f(lg2h * (float)(127 - m)) : 1.0f);
    float o1[8], o2[8];
#pragma unroll
    for (int i = 0; i < 8; ++i) { o1[i] = (x1[i] * cs[i] - x2[i] * sn[i]) * sc; o2[i] = (x1[i] * sn[i] + x2[i] * cs[i]) * sc; }
    LAS f4* d1 = (LAS f4*)(ks + m * 64 + p * 8); LAS f4* d2 = (LAS f4*)(ks + m * 64 + 32 + p * 8);
    d1[0] = mk_f4(o1[0], o1[1], o1[2], o1[3]); d1[1] = mk_f4(o1[4], o1[5], o1[6], o1[7]);
    d2[0] = mk_f4(o2[0], o2[1], o2[2], o2[3]); d2[1] = mk_f4(o2[4], o2[5], o2[6], o2[7]);
}
__device__ __forceinline__ void stage_v128(const bf16* __restrict__ Hb, LAS float* vs, int tok0, int colV, int tid) {
    const int m = tid >> 2, p = tid & 3;
    const u4* src = (const u4*)(Hb + (size_t)(tok0 + m) * INWP + colV + p * 32);
    LAS f4* dst = (LAS f4*)(vs + m * 128 + p * 32);
#pragma unroll
    for (int j = 0; j < 4; ++j) { const u4 a = src[j]; float f[8]; unpack8(a, f); dst[2 * j] = mk_f4(f[0], f[1], f[2], f[3]); dst[2 * j + 1] = mk_f4(f[4], f[5], f[6], f[7]); }
}

__device__ __forceinline__ void unit_kvstate(const Params& P, unsigned char* ws, LAS unsigned char* lds, int u, int tid) {
    const int b = u / 60, r = u % 60, h = r / 15, j = r % 15;
    const bf16* Hb = (const bf16*)(ws + WS_H); const f2* rope = (const f2*)(ws + WS_ROPE);
    LAS float* ks = (LAS float*)lds; LAS float* vs = (LAS float*)(lds + 32768);
    const int tok0 = b * T + j * 128;
    stage_rot_k(Hb, rope, ks, tok0, j * 128, C_RK + h * 64, P.lg2[h], true, tid);
    stage_v128(Hb, vs, tok0, C_RV + h * 128, tid);
    __syncthreads();
    const int d = tid >> 3, e0 = (tid & 7) * 16;
    float acc[16];
#pragma unroll
    for (int i = 0; i < 16; ++i) acc[i] = 0.f;
    #pragma unroll 1
    for (int m = 0; m < 128; ++m) { const float kd = ks[m * 64 + d]; const LAS f4* vp = (const LAS f4*)(vs + m * 128 + e0);
#pragma unroll
        for (int q = 0; q < 4; ++q) { const f4 v = vp[q]; acc[4 * q] += kd * v.x; acc[4 * q + 1] += kd * v.y; acc[4 * q + 2] += kd * v.z; acc[4 * q + 3] += kd * v.w; } }
    f4* dst = (f4*)((float*)(ws + WS_KVST) + ((size_t)((b * 4 + h) * 16 + j) * 64 + d) * 128 + e0);
#pragma unroll
    for (int q = 0; q < 4; ++q) dst[q] = mk_f4(acc[4 * q], acc[4 * q + 1], acc[4 * q + 2], acc[4 * q + 3]);
    __syncthreads();
}

__device__ __forceinline__ void unit_sgu(const Params& P, unsigned char* ws, int l, LAS unsigned char* lds, int u, int tid, int lane, int wave) {
    const int b = u >> 6, c = (u >> 2) & 15, g = u & 3;
    const bf16* Hb = (const bf16*)(ws + WS_H);
    LAS float* vn = (LAS float*)lds;
    LAS float* wsm = (LAS float*)(lds + 65536);
    const int tok0 = b * T + c * 128;
    const float* lng = P.in[4] + l * 512 + g * 128; const float* lnb = P.in[5] + l * 512 + g * 128;
    const float g0 = lng[2 * lane], g1 = lng[2 * lane + 1], b0 = lnb[2 * lane], b1 = lnb[2 * lane + 1];
    for (int i = 0; i < 16; ++i) { const int s = wave * 16 + i;
        const unsigned pr = *(const unsigned*)(Hb + (size_t)(tok0 + s) * INWP + C_SV + g * 128 + 2 * lane);
        const float v0 = __uint_as_float(pr << 16), v1 = __uint_as_float(pr & 0xffff0000u);
        const float mu = wave_sum(v0 + v1) * (1.f / 128.f); const float d0 = v0 - mu, d1 = v1 - mu;
        const float var = wave_sum(d0 * d0 + d1 * d1) * (1.f / 128.f); const float rstd = rsqrtf(var + LN_EPS);
        *(LAS f2*)(vn + s * 128 + 2 * lane) = mk_f2(d0 * rstd * g0 + b0, d1 * rstd * g1 + b1); }
    const float* wg = P.in[6] + ((size_t)l * 4 + g) * 16384;
    for (int i = 0; i < 32; ++i) { const int idx = tid + 512 * i; wsm[(idx >> 7) * 129 + (idx & 127)] = wg[idx]; }
    __syncthreads();
    const int t = tid >> 2, dg = tid & 3; const int smax = (t | 15);
    float acc[32];
#pragma unroll
    for (int i = 0; i < 32; ++i) acc[i] = 0.f;
    #pragma unroll 1
    for (int s = 0; s <= smax; ++s) { const float wv = (s <= t) ? wsm[t * 129 + s] : 0.f; const LAS f4* vp = (const LAS f4*)(vn + s * 128 + dg * 32);
#pragma unroll
        for (int q = 0; q < 8; ++q) { const f4 v = vp[q]; acc[4 * q] += wv * v.x; acc[4 * q + 1] += wv * v.y; acc[4 * q + 2] += wv * v.z; acc[4 * q + 3] += wv * v.w; } }
    const float bs = P.in[7][(l * 4 + g) * 128 + t];
    const u4* up = (const u4*)(Hb + (size_t)(tok0 + t) * INWP + C_SU + g * 128 + dg * 32);
    f4* yo = (f4*)((float*)(ws + WS_YMIX) + (size_t)(tok0 + t) * D + 512 + g * 128 + dg * 32);
#pragma unroll
    for (int j = 0; j < 4; ++j) { const u4 a = up[j]; float f[8]; unpack8(a, f);
        yo[2 * j] = mk_f4(f[0] * (acc[8 * j] + bs), f[1] * (acc[8 * j + 1] + bs), f[2] * (acc[8 * j + 2] + bs), f[3] * (acc[8 * j + 3] + bs));
        yo[2 * j + 1] = mk_f4(f[4] * (acc[8 * j + 4] + bs), f[5] * (acc[8 * j + 5] + bs), f[6] * (acc[8 * j + 6] + bs), f[7] * (acc[8 * j + 7] + bs)); }
    __syncthreads();
}

__device__ __forceinline__ void unit_compress(const Params& P, unsigned char* ws, int l, LAS unsigned char* lds, int u, int tid) {
    const int kv = u >> 7, b = (u >> 5) & 3, g = (u >> 3) & 3, r = u & 7;
    const bf16* Hb = (const bf16*)(ws + WS_H);
    LAS float* seg = (LAS float*)lds;
    LAS float* hid = (LAS float*)(lds + 69632);
    const int col0 = (kv ? C_VC : C_KC) + g * 64;
    const float* pe = P.in[kv ? 11 : 8] + (size_t)l * 2048;
    const float* w1 = P.in[kv ? 12 : 9] + (size_t)l * 2048 * 256;
    const float* w2 = P.in[kv ? 13 : 10] + (size_t)l * 256 * 64;
    for (int idx = tid; idx < 272 * 8; idx += 512) { const int tt = idx >> 3, d8 = (idx & 7) * 8; const int t = 256 * r + tt;
        float f[8];
        if (t < T) { const u4 a = *(const u4*)(Hb + (size_t)(b * T + t) * INWP + col0 + d8); unpack8(a, f); }
        else {
#pragma unroll
            for (int i = 0; i < 8; ++i) f[i] = 0.f; }
        LAS f4* dp = (LAS f4*)(seg + tt * 64 + d8); dp[0] = mk_f4(f[0], f[1], f[2], f[3]); dp[1] = mk_f4(f[4], f[5], f[6], f[7]); }
    __syncthreads();
    const int j = tid & 255, hb = tid >> 8;
    float acc[8], accpe = 0.f;
#pragma unroll
    for (int i = 0; i < 8; ++i) acc[i] = 0.f;
    for (int pos = 0; pos < 32; ++pos) {
#pragma unroll 2
        for (int d4 = 0; d4 < 16; ++d4) { const int kk = pos * 64 + d4 * 4;
            const float w0 = w1[(size_t)(kk + 0) * 256 + j], w1v = w1[(size_t)(kk + 1) * 256 + j], w2v = w1[(size_t)(kk + 2) * 256 + j], w3 = w1[(size_t)(kk + 3) * 256 + j];
            const f4 p4 = *(const f4*)(pe + kk);
            accpe += w0 * p4.x + w1v * p4.y + w2v * p4.z + w3 * p4.w;
#pragma unroll
            for (int ib = 0; ib < 8; ++ib) { const f4 s4 = *(const LAS f4*)(seg + (16 * (hb * 8 + ib) + pos) * 64 + d4 * 4);
                acc[ib] += w0 * s4.x + w1v * s4.y + w2v * s4.z + w3 * s4.w; } } }
#pragma unroll
    for (int ib = 0; ib < 8; ++ib) hid[(hb * 8 + ib) * 256 + j] = gelu_tanh(acc[ib] + accpe);
    __syncthreads();
    { const int i = tid >> 5, o2 = (tid & 31) * 2; float a0 = 0.f, a1 = 0.f;
        for (int jj = 0; jj < 256; ++jj) { const float hv = hid[i * 256 + jj]; const f2 w = *(const f2*)(w2 + jj * 64 + o2); a0 += hv * w.x; a1 += hv * w.y; }
        const int ci = 16 * r + i;
        if (ci <= 126) *(f2*)((float*)(ws + WS_KC) + ((size_t)((kv * 4 + b) * 4 + g) * 128 + ci) * 64 + o2) = mk_f2(a0, a1); }
    __syncthreads();
}

__device__ __forceinline__ void unit_retention(const Params& P, unsigned char* ws, int l, LAS unsigned char* lds, int u, int tid) {
    const int b = u >> 6, h = (u >> 4) & 3, c = u & 15;
    const bf16* Hb = (const bf16*)(ws + WS_H); const f2* rope = (const f2*)(ws + WS_ROPE);
    LAS float* regB = (LAS float*)lds;
    LAS float* vs = (LAS float*)(lds + 32768);
    LAS float* Qs = (LAS float*)(lds + 98304);
    const float lg2h = P.lg2[h];
    const int tok0 = b * T + c * 128;
    { float a[16];
#pragma unroll
        for (int i = 0; i < 16; ++i) a[i] = 0.f;
        const float* kvb = (const float*)(ws + WS_KVST) + (size_t)((b * 4 + h) * 16) * 8192 + tid * 16;
#pragma unroll 1
        for (int j = 0; j < c; ++j) { const float w = exp2f(lg2h * 128.f * (float)(c - 1 - j)); const f4* sp = (const f4*)(kvb + (size_t)j * 8192);
#pragma unroll
            for (int q = 0; q < 4; ++q) { const f4 v = sp[q]; a[4 * q] += w * v.x; a[4 * q + 1] += w * v.y; a[4 * q + 2] += w * v.z; a[4 * q + 3] += w * v.w; } }
        LAS f4* dp = (LAS f4*)(regB + tid * 16);
#pragma unroll
        for (int q = 0; q < 4; ++q) dp[q] = mk_f4(a[4 * q], a[4 * q + 1], a[4 * q + 2], a[4 * q + 3]); }
    const int n = tid >> 2, eg = tid & 3;
    float qa[8], qb[8];
    { const bf16* src = Hb + (size_t)(tok0 + n) * INWP + C_RQ + h * 64 + eg * 8;
        const u4 a = *(const u4*)src, bb = *(const u4*)(src + 32);
        float x1[8], x2[8]; unpack8(a, x1); unpack8(bb, x2);
        const f4* rp = (const f4*)(rope + (size_t)(c * 128 + n) * 32 + eg * 8);
        const f4 r0 = rp[0], r1 = rp[1], r2 = rp[2], r3 = rp[3];
        const float cs[8] = {r0.x, r0.z, r1.x, r1.z, r2.x, r2.z, r3.x, r3.z}, sn[8] = {r0.y, r0.w, r1.y, r1.w, r2.y, r2.w, r3.y, r3.w};
#pragma unroll
        for (int i = 0; i < 8; ++i) { qa[i] = x1[i] * cs[i] - x2[i] * sn[i]; qb[i] = x1[i] * sn[i] + x2[i] * cs[i]; Qs[n * 65 + eg * 8 + i] = qa[i]; Qs[n * 65 + 32 + eg * 8 + i] = qb[i]; } }
    __syncthreads();
    float acc[32];
#pragma unroll
    for (int i = 0; i < 32; ++i) acc[i] = 0.f;
#pragma unroll 2
    for (int d = 0; d < 64; ++d) { const float qd = Qs[n * 65 + d]; const LAS f4* sp = (const LAS f4*)(regB + d * 128 + eg * 32);
#pragma unroll
        for (int qq = 0; qq < 8; ++qq) { const f4 v = sp[qq]; acc[4 * qq] += qd * v.x; acc[4 * qq + 1] += qd * v.y; acc[4 * qq + 2] += qd * v.z; acc[4 * qq + 3] += qd * v.w; } }
    { const float xi = exp2f(lg2h * (float)(n + 1));
#pragma unroll
        for (int i = 0; i < 32; ++i) acc[i] *= xi; }
    __syncthreads();
    stage_rot_k(Hb, rope, regB, tok0, c * 128, C_RK + h * 64, lg2h, false, tid);
    stage_v128(Hb, vs, tok0, C_RV + h * 128, tid);
    __syncthreads();
    const int mmax = n | 15;
#pragma unroll 1
    for (int m = 0; m <= mmax; ++m) { const LAS f4* kp = (const LAS f4*)(regB + m * 64 + eg * 8); const LAS f4* kp2 = (const LAS f4*)(regB + m * 64 + 32 + eg * 8);
        const f4 k0 = kp[0], k1 = kp[1], k2 = kp2[0], k3 = kp2[1];
        float s = ((qa[0] * k0.x + qa[1] * k0.y) + (qa[2] * k0.z + qa[3] * k0.w)) + ((qa[4] * k1.x + qa[5] * k1.y) + (qa[6] * k1.z + qa[7] * k1.w))
                + ((qb[0] * k2.x + qb[1] * k2.y) + (qb[2] * k2.z + qb[3] * k2.w)) + ((qb[4] * k3.x + qb[5] * k3.y) + (qb[6] * k3.z + qb[7] * k3.w));
        s += __shfl_xor(s, 1); s += __shfl_xor(s, 2);
        const float a = (m <= n) ? s * exp2f(lg2h * (float)(n - m)) : 0.f;
        const LAS f4* vp = (const LAS f4*)(vs + m * 128 + eg * 32);
#pragma unroll
        for (int qq = 0; qq < 8; ++qq) { const f4 v = vp[qq]; acc[4 * qq] += a * v.x; acc[4 * qq + 1] += a * v.y; acc[4 * qq + 2] += a * v.z; acc[4 * qq + 3] += a * v.w; } }
    float s1 = 0.f;
#pragma unroll
    for (int i = 0; i < 32; ++i) s1 += acc[i];
    s1 += __shfl_xor(s1, 1); s1 += __shfl_xor(s1, 2);
    const float mu = s1 * (1.f / 128.f); float s2 = 0.f;
#pragma unroll
    for (int i = 0; i < 32; ++i) { const float dd = acc[i] - mu; s2 += dd * dd; }
    s2 += __shfl_xor(s2, 1); s2 += __shfl_xor(s2, 2);
    const float rstd = rsqrtf(s2 * (1.f / 128.f) + LN_EPS);
    const float* gg = P.in[2] + l * 512 + h * 128 + eg * 32; const float* gb = P.in[3] + l * 512 + h * 128 + eg * 32;
    const u4* gp = (const u4*)(Hb + (size_t)(tok0 + n) * INWP + C_RG + h * 128 + eg * 32);
    f4* yo = (f4*)((float*)(ws + WS_YMIX) + (size_t)(tok0 + n) * D + h * 128 + eg * 32);
#pragma unroll
    for (int j = 0; j < 4; ++j) { const u4 a = gp[j]; float f[8]; unpack8(a, f); float o[8];
#pragma unroll
        for (int i = 0; i < 8; ++i) { const float y = (acc[8 * j + i] - mu) * rstd * gg[8 * j + i] + gb[8 * j + i]; const float gv = f[i]; o[i] = y * gv * __builtin_amdgcn_rcpf(1.f + __expf(-gv)); }
        yo[2 * j] = mk_f4(o[0], o[1], o[2], o[3]); yo[2 * j + 1] = mk_f4(o[4], o[5], o[6], o[7]); }
    __syncthreads();
}

typedef pg8::bf16x8 bf16x8;
typedef short s16x4 __attribute__((ext_vector_type(4)));
typedef __bf16 bf16x2_t __attribute__((ext_vector_type(2)));
__device__ __forceinline__ unsigned pkbf(float a, float b) { f2 v; v.x = a; v.y = b; return __builtin_bit_cast(unsigned, __builtin_convertvector(v, bf16x2_t)); }
#define MFMA16(a, b, c) __builtin_amdgcn_mfma_f32_16x16x32_bf16((a), (b), (c), 0, 0, 0)
constexpr int NS = 80;
constexpr float NSA_SC = 0.125f * LOG2E;
__device__ __forceinline__ void nsa_scores(f4 (&st)[4][2], const LAS bf16* Kl, const bf16x8 (&Yq)[2][2], int lane) {
    const int r = lane & 15, kq = lane >> 4;
#pragma unroll
    for (int kt = 0; kt < 4; ++kt) { const LAS bf16* kp = Kl + (16 * kt + r) * NS + 8 * kq;
        const bf16x8 k0 = *(const LAS bf16x8*)kp, k1 = *(const LAS bf16x8*)(kp + 32);
#pragma unroll
        for (int qp = 0; qp < 2; ++qp) { f4 a = mk_f4(0.f, 0.f, 0.f, 0.f); a = MFMA16(k0, Yq[qp][0], a); a = MFMA16(k1, Yq[qp][1], a); st[kt][qp] = a; } }
}
__device__ __forceinline__ void nsa_softmax_pv(f4 (&st)[4][2], float (&m)[2], float (&l)[2], f4 (&ot)[4][2], const LAS bf16* Vl, const int (&lo)[2], const int (&hi)[2], bool need_mask, int lane) {
    const int kq = lane >> 4, q = (lane & 15) >> 2, p = lane & 3;
    bf16x8 Pf[2][2];
#pragma unroll
    for (int qp = 0; qp < 2; ++qp) {
        if (need_mask) {
#pragma unroll
            for (int kt = 0; kt < 4; ++kt)
#pragma unroll
                for (int i = 0; i < 4; ++i) { const int kl = 16 * kt + 4 * kq + i; if (kl < lo[qp] || kl > hi[qp]) st[kt][qp][i] = -1e30f; } }
        float mx = st[0][qp][0];
#pragma unroll
        for (int kt = 0; kt < 4; ++kt)
#pragma unroll
            for (int i = 0; i < 4; ++i) mx = fmaxf(mx, st[kt][qp][i]);
        mx = fmaxf(mx, __shfl_xor(mx, 16)); mx = fmaxf(mx, __shfl_xor(mx, 32));
        const float mn = fmaxf(m[qp], mx); const float corr = __builtin_amdgcn_exp2f((m[qp] - mn) * NSA_SC); m[qp] = mn; l[qp] *= corr;
#pragma unroll
        for (int dt = 0; dt < 4; ++dt) ot[dt][qp] *= corr;
        const float msc = mn * NSA_SC; float ps = 0.f;
#pragma unroll
        for (int kt = 0; kt < 4; ++kt)
#pragma unroll
            for (int i = 0; i < 4; ++i) { const float pv = __builtin_amdgcn_exp2f(st[kt][qp][i] * NSA_SC - msc); st[kt][qp][i] = pv; ps += pv; }
        l[qp] += ps;
#pragma unroll
        for (int ksp = 0; ksp < 2; ++ksp) { u4 w; w.x = pkbf(st[2 * ksp][qp][0], st[2 * ksp][qp][1]); w.y = pkbf(st[2 * ksp][qp][2], st[2 * ksp][qp][3]);
            w.z = pkbf(st[2 * ksp + 1][qp][0], st[2 * ksp + 1][qp][1]); w.w = pkbf(st[2 * ksp + 1][qp][2], st[2 * ksp + 1][qp][3]); Pf[qp][ksp] = __builtin_bit_cast(bf16x8, w); }
    }
#pragma unroll
    for (int dt = 0; dt < 4; ++dt)
#pragma unroll
        for (int ksp = 0; ksp < 2; ++ksp) { const LAS bf16* vp = Vl + (32 * ksp + 4 * kq + q) * NS + 16 * dt + 4 * p;
            const s16x4 va = __builtin_amdgcn_ds_read_tr16_b64_v4i16((LAS s16x4*)vp), vb = __builtin_amdgcn_ds_read_tr16_b64_v4i16((LAS s16x4*)(vp + 16 * NS));
            const bf16x8 vf = __builtin_shufflevector(va, vb, 0, 1, 2, 3, 4, 5, 6, 7);
#pragma unroll
            for (int qp = 0; qp < 2; ++qp) ot[dt][qp] = MFMA16(vf, Pf[qp][ksp], ot[dt][qp]); }
}
__device__ __forceinline__ void nsa_flush(float* __restrict__ y0, float* __restrict__ y1, const f4 (&ot)[4][2], const float (&l)[2], const float (&gate)[2], bool add, int kq) {
#pragma unroll
    for (int qp = 0; qp < 2; ++qp) { float lt = l[qp]; lt += __shfl_xor(lt, 16); lt += __shfl_xor(lt, 32); const float sc = (lt > 0.f) ? gate[qp] / lt : 0.f;
        float* yp = (qp ? y1 : y0) + 4 * kq;
#pragma unroll
        for (int dt = 0; dt < 4; ++dt) { f4 o = ot[dt][qp] * sc; if (add) o += *(const f4*)(yp + 16 * dt); *(f4*)(yp + 16 * dt) = o; } }
}
__device__ __forceinline__ void nsa_pair_next(unsigned& rem, int& ja, int& jb) { ja = __builtin_ctz(rem); rem &= rem - 1u; if (rem) { jb = __builtin_ctz(rem); rem &= rem - 1u; } else jb = -1; }
__device__ __forceinline__ void nsa_pair_prefetch(const bf16* __restrict__ Hb, int tok0, int ja, int jb, int colK, int colV, int tid, u4 (&R)[4]) {
    const int key = tid >> 3, d8 = (tid & 7) * 8; const int j1 = jb < 0 ? ja : jb;
    const bf16* pa = Hb + (size_t)(tok0 + 64 * ja + key) * INWP + d8; const bf16* pb = Hb + (size_t)(tok0 + 64 * j1 + key) * INWP + d8;
    R[0] = *(const u4*)(pa + colK); R[1] = *(const u4*)(pa + colV); R[2] = *(const u4*)(pb + colK); R[3] = *(const u4*)(pb + colV);
}
__device__ __forceinline__ void nsa_pair_store(LAS bf16* buf, int tid, const u4 (&R)[4]) {
    LAS bf16* p = buf + (tid >> 3) * NS + (tid & 7) * 8;
    *(LAS u4*)p = R[0]; *(LAS u4*)(p + 128 * NS) = R[1]; *(LAS u4*)(p + 64 * NS) = R[2]; *(LAS u4*)(p + 192 * NS) = R[3];
}
template <int MODE>
__device__ __forceinline__ void nsa_branch(unsigned chunks, const bf16* __restrict__ Hb, int tok0, int colK, int colV, LAS bf16* buf0, LAS bf16* buf1, int tid, int lane, int qt, const int (&tq)[2], const unsigned (&mym)[2],
                                           const bf16x8 (&Yq)[2][2], f4 (&ot)[4][2], float (&m)[2], float (&l)[2]) {
    u4 R[4]; unsigned rem = chunks; int ja, jb, na = 0, nb = -1; f4 st[4][2]; int lo[2], hi[2];
    nsa_pair_next(rem, ja, jb);
    nsa_pair_prefetch(Hb, tok0, ja, jb, colK, colV, tid, R);
    __syncthreads();
    nsa_pair_store(buf0, tid, R);
    bool more = (rem != 0u);
    if (more) { nsa_pair_next(rem, na, nb); nsa_pair_prefetch(Hb, tok0, na, nb, colK, colV, tid, R); }
    __syncthreads();
    int it = 0;
#pragma unroll 1
    for (;;) {
        LAS bf16* cur = (it & 1) ? buf1 : buf0;
#pragma unroll 1
        for (int sub = 0; sub < 2; ++sub) { const int j = sub ? jb : ja;
            if (j < 0) break;
            bool anyv = false, full = true;
#pragma unroll
            for (int qp = 0; qp < 2; ++qp) {
                if (MODE == 0) { const bool sel = (mym[qp] >> j) & 1u; lo[qp] = sel ? 0 : 64; hi[qp] = sel ? ((j == qt) ? tq[qp] : 63) : -1; anyv |= sel; full &= (sel && j != qt); }
                else { lo[qp] = (j == qt - 8) ? tq[qp] + 1 : 0; hi[qp] = (j == qt) ? tq[qp] : 63; anyv = true; full &= (j != qt && j != qt - 8); } }
            if (__builtin_amdgcn_ballot_w64(anyv) != 0ull) {
                const bool need_mask = __builtin_amdgcn_ballot_w64(!full) != 0ull;
                nsa_scores(st, cur + sub * 64 * NS, Yq, lane);
                nsa_softmax_pv(st, m, l, ot, cur + 128 * NS + sub * 64 * NS, lo, hi, need_mask, lane); } }
        if (!more) break;
        nsa_pair_store((it & 1) ? buf0 : buf1, tid, R);
        ja = na; jb = nb; more = (rem != 0u);
        if (more) { nsa_pair_next(rem, na, nb); nsa_pair_prefetch(Hb, tok0, na, nb, colK, colV, tid, R); }
        __syncthreads(); ++it;
    }
}
__device__ __forceinline__ void unit_nsa(const Params& P, unsigned char* ws, int l_, LAS unsigned char* lds, int u, int tid) {
    const int b = (u >> 7) & 3, g = (u >> 5) & 3, qt = (u & 256) ? 31 - (u & 31) : (u & 31);
    const bf16* Hb = (const bf16*)(ws + WS_H);
    LAS bf16* buf0 = (LAS bf16*)lds;
    LAS bf16* buf1 = (LAS bf16*)(lds + 40960);
    LAS float* impG = (LAS float*)(lds + 40960);
    LAS float* impE = (LAS float*)(lds + 73728);
    LAS unsigned* selm = (LAS unsigned*)(lds + 106496);
    const int lane = tid & 63, wv = __builtin_amdgcn_readfirstlane(tid >> 6), h = wv >> 1, qh = wv & 1;
    const int c = lane & 15, kq = lane >> 4;
    const int t0 = qt * 64;
    int tq[2]; size_t tok[2];
#pragma unroll
    for (int qp = 0; qp < 2; ++qp) { tq[qp] = 32 * qh + 16 * qp + c; tok[qp] = (size_t)b * T + t0 + tq[qp]; }
    bf16x8 Yq[2][2];
#pragma unroll
    for (int qp = 0; qp < 2; ++qp)
#pragma unroll
        for (int ks = 0; ks < 2; ++ks) Yq[qp][ks] = *(const bf16x8*)(Hb + tok[qp] * INWP + C_NQ + g * 256 + h * 64 + 32 * ks + 8 * kq);
    float gate[3][2];
#pragma unroll
    for (int k = 0; k < 3; ++k)
#pragma unroll
        for (int qp = 0; qp < 2; ++qp) { const float gv = bf2f(Hb[tok[qp] * INWP + C_NG + g * 12 + h * 3 + k]); gate[k][qp] = __builtin_amdgcn_rcpf(1.f + __expf(-gv)); }
    float* y0 = (float*)(ws + WS_YMIX) + tok[0] * D + 1024 + g * 256 + h * 64; float* y1 = (float*)(ws + WS_YMIX) + tok[1] * D + 1024 + g * 256 + h * 64;
    if (tid == 0) selm[64] = 0u;
    f4 ot[4][2]; float m[2], l[2];
#pragma unroll
    for (int dt = 0; dt < 4; ++dt)
#pragma unroll
        for (int qp = 0; qp < 2; ++qp) ot[dt][qp] = mk_f4(0.f, 0.f, 0.f, 0.f);
    int cmax[2];
#pragma unroll
    for (int qp = 0; qp < 2; ++qp) { const int t = t0 + tq[qp]; cmax[qp] = (t >= 31) ? (((t - 31) >> 4) < 126 ? ((t - 31) >> 4) : 126) : -1; }
    __syncthreads();
    { const bf16* KCk = (const bf16*)(ws + WS_KC) + (size_t)((0 * 4 + b) * 4 + g) * 8192; const bf16* KCv = (const bf16*)(ws + WS_KC) + (size_t)((1 * 4 + b) * 4 + g) * 8192;
#pragma unroll
        for (int i = 0; i < 2; ++i) { const int idx = tid + 512 * i, key = idx >> 3, d8 = (idx & 7) * 8;
            *(LAS u4*)(buf0 + key * NS + d8) = *(const u4*)(KCk + key * 64 + d8); *(LAS u4*)(buf0 + (128 + key) * NS + d8) = *(const u4*)(KCv + key * 64 + d8); } }
    __syncthreads();
    m[0] = m[1] = -1e4f; l[0] = l[1] = 0.f;
    { f4 st[4][2]; int lo[2], hi[2];
#pragma unroll 1
        for (int cc = 0; cc < 2; ++cc) {
            if (cc * 64 * 16 + 31 > t0 + 63) break;
#pragma unroll
            for (int qp = 0; qp < 2; ++qp) { lo[qp] = 0; hi[qp] = cmax[qp] - 64 * cc; }
            nsa_scores(st, buf0 + cc * 64 * NS, Yq, lane);
            nsa_softmax_pv(st, m, l, ot, buf0 + 128 * NS + cc * 64 * NS, lo, hi, true, lane);
        }
        { const float g2[2] = {gate[0][0], gate[0][1]}; nsa_flush(y0, y1, ot, l, g2, false, kq); }
        float invl[2], msc[2];
#pragma unroll
        for (int qp = 0; qp < 2; ++qp) { float lt = l[qp]; lt += __shfl_xor(lt, 16); lt += __shfl_xor(lt, 32); invl[qp] = (lt > 0.f) ? 1.f / lt : 0.f; msc[qp] = m[qp] * NSA_SC; }
#pragma unroll 1
        for (int cc = 0; cc < 2; ++cc) {
            nsa_scores(st, buf0 + cc * 64 * NS, Yq, lane);
#pragma unroll
            for (int kt = 0; kt < 4; ++kt)
#pragma unroll
                for (int qp = 0; qp < 2; ++qp) { float pp[4];
#pragma unroll
                    for (int i = 0; i < 4; ++i) { const int ci = 64 * cc + 16 * kt + 4 * kq + i; pp[i] = (ci <= cmax[qp]) ? __builtin_amdgcn_exp2f(st[kt][qp][i] * NSA_SC - msc[qp]) * invl[qp] : 0.f; }
                    const int j = 16 * cc + 4 * kt + kq;
                    impG[(h * 32 + j) * 64 + tq[qp]] = (pp[0] + pp[1]) + (pp[2] + pp[3]);
                    if (j < 31) impE[(h * 32 + j + 1) * 64 + tq[qp]] = pp[3]; }
        } }
    __syncthreads();
    if (tid < 64) { const int tqs = tid; float tv[8]; int ti[8];
#pragma unroll
        for (int k = 0; k < 8; ++k) { tv[k] = -3e38f; ti[k] = 0; }
#pragma unroll 1
        for (int j = 0; j < 32; ++j) { float v;
            if (j <= qt) { const bool forced = (j == 0) || (j == qt) || (j == qt - 1);
                float s4 = (impG[(0 * 32 + j) * 64 + tqs] + impG[(1 * 32 + j) * 64 + tqs]) + (impG[(2 * 32 + j) * 64 + tqs] + impG[(3 * 32 + j) * 64 + tqs]);
                if (j > 0) s4 += (impE[(0 * 32 + j) * 64 + tqs] + impE[(1 * 32 + j) * 64 + tqs]) + (impE[(2 * 32 + j) * 64 + tqs] + impE[(3 * 32 + j) * 64 + tqs]);
                v = forced ? 1e6f : s4; }
            else v = -1e9f;
            int vi = j;
#pragma unroll
            for (int k = 0; k < 8; ++k) { const bool gt = v > tv[k]; const float nv = gt ? tv[k] : v; const int ni = gt ? ti[k] : vi; tv[k] = gt ? v : tv[k]; ti[k] = gt ? vi : ti[k]; v = nv; vi = ni; } }
        unsigned msk = 0u;
#pragma unroll
        for (int k = 0; k < 8; ++k) if (ti[k] <= qt) msk |= (1u << ti[k]);
        selm[tqs] = msk; atomicOr((unsigned*)&selm[64], msk); }
    __syncthreads();
    unsigned mymask[2];
#pragma unroll
    for (int qp = 0; qp < 2; ++qp) mymask[qp] = selm[tq[qp]];
    const unsigned umask = selm[64];
#pragma unroll
    for (int dt = 0; dt < 4; ++dt)
#pragma unroll
        for (int qp = 0; qp < 2; ++qp) ot[dt][qp] = mk_f4(0.f, 0.f, 0.f, 0.f);
    m[0] = m[1] = -1e4f; l[0] = l[1] = 0.f;
    nsa_branch<0>(umask, Hb, b * T, C_KS + g * 64, C_VS + g * 64, buf0, buf1, tid, lane, qt, tq, mymask, Yq, ot, m, l);
    { const float g2[2] = {gate[1][0], gate[1][1]}; nsa_flush(y0, y1, ot, l, g2, true, kq); }
#pragma unroll
    for (int dt = 0; dt < 4; ++dt)
#pragma unroll
        for (int qp = 0; qp < 2; ++qp) ot[dt][qp] = mk_f4(0.f, 0.f, 0.f, 0.f);
    m[0] = m[1] = -1e4f; l[0] = l[1] = 0.f;
    { const int jw0 = qt >= 8 ? qt - 8 : 0; const unsigned wmask = ((qt == 31) ? 0xffffffffu : ((1u << (qt + 1)) - 1u)) & ~((1u << jw0) - 1u);
        nsa_branch<1>(wmask, Hb, b * T, C_KW + g * 64, C_VW + g * 64, buf0, buf1, tid, lane, qt, tq, mymask, Yq, ot, m, l); }
    { const float g2[2] = {gate[2][0], gate[2][1]}; nsa_flush(y0, y1, ot, l, g2, true, kq); }
    __syncthreads();
}

__device__ __forceinline__ bf16x8 cmp_afrag(const bf16* __restrict__ p, const float* __restrict__ pe) {
    const u4 a = *(const u4*)p; float f[8]; unpack8(a, f);
    const f4 p0 = *(const f4*)pe, p1 = *(const f4*)(pe + 4);
    u4 w; w.x = pkbf(f[0] + p0.x, f[1] + p0.y); w.y = pkbf(f[2] + p0.z, f[3] + p0.w); w.z = pkbf(f[4] + p1.x, f[5] + p1.y); w.w = pkbf(f[6] + p1.z, f[7] + p1.w);
    return __builtin_bit_cast(bf16x8, w);
}
__device__ __forceinline__ void unit_compress_mfma(const Params& P, unsigned char* ws, int l, LAS unsigned char* lds, int u, int tid) {
    const int kv = u >> 6, b = (u >> 4) & 3, g = (u >> 2) & 3, r4 = u & 3, i0 = 32 * r4;
    const bf16* Hb = (const bf16*)(ws + WS_H);
    const bf16* W1T = (const bf16*)(ws + WS_W1T) + (size_t)(l * 2 + kv) * 256 * 2048;
    const bf16* W2T = (const bf16*)(ws + WS_W2T) + (size_t)(l * 2 + kv) * 64 * 256;
    const float* pe = P.in[kv ? 11 : 8] + (size_t)l * 2048;
    LAS bf16* hidL = (LAS bf16*)lds;
    const int lane = tid & 63, wv = __builtin_amdgcn_readfirstlane(tid >> 6), c = lane & 15, kq = lane >> 4;
    const int col0 = (kv ? C_VC : C_KC) + g * 64;
    int tb[2];
#pragma unroll
    for (int rt = 0; rt < 2; ++rt) tb[rt] = 16 * (i0 + 16 * rt + c);
    f4 acc[2][2];
#pragma unroll
    for (int nt = 0; nt < 2; ++nt)
#pragma unroll
        for (int rt = 0; rt < 2; ++rt) acc[nt][rt] = mk_f4(0.f, 0.f, 0.f, 0.f);
    const bf16* wrow[2];
#pragma unroll
    for (int nt = 0; nt < 2; ++nt) wrow[nt] = W1T + (size_t)(32 * wv + 16 * nt + c) * 2048 + 8 * kq;
    bf16x8 xfA[2][2], xfB[2][2]; u4 arA[2][2], arB[2][2]; f4 peA[2][2], peB[2][2];
#define CMP_LOAD(XF, AR, PE, pos_) do { \
        _Pragma("unroll") for (int nt = 0; nt < 2; ++nt) _Pragma("unroll") for (int ks = 0; ks < 2; ++ks) XF[nt][ks] = *(const bf16x8*)(wrow[nt] + (pos_) * 64 + 32 * ks); \
        _Pragma("unroll") for (int rt = 0; rt < 2; ++rt) { int t_ = tb[rt] + (pos_); t_ = t_ < T ? t_ : T - 1; const bf16* ap_ = Hb + (size_t)(b * T + t_) * INWP + col0 + 8 * kq; \
            _Pragma("unroll") for (int ks = 0; ks < 2; ++ks) AR[rt][ks] = *(const u4*)(ap_ + 32 * ks); } \
        _Pragma("unroll") for (int ks = 0; ks < 2; ++ks) { PE[ks][0] = *(const f4*)(pe + (pos_) * 64 + 32 * ks + 8 * kq); PE[ks][1] = *(const f4*)(pe + (pos_) * 64 + 32 * ks + 8 * kq + 4); } } while (0)
#define CMP_MMA(XF, AR, PE) do { \
        _Pragma("unroll") for (int rt = 0; rt < 2; ++rt) _Pragma("unroll") for (int ks = 0; ks < 2; ++ks) { float f_[8]; unpack8(AR[rt][ks], f_); const f4 p0_ = PE[ks][0], p1_ = PE[ks][1]; \
            u4 w_; w_.x = pkbf(f_[0] + p0_.x, f_[1] + p0_.y); w_.y = pkbf(f_[2] + p0_.z, f_[3] + p0_.w); w_.z = pkbf(f_[4] + p1_.x, f_[5] + p1_.y); w_.w = pkbf(f_[6] + p1_.z, f_[7] + p1_.w); \
            const bf16x8 yf_ = __builtin_bit_cast(bf16x8, w_); \
            _Pragma("unroll") for (int nt = 0; nt < 2; ++nt) acc[nt][rt] = MFMA16(XF[nt][ks], yf_, acc[nt][rt]); } } while (0)
    CMP_LOAD(xfA, arA, peA, 0);
#pragma unroll 1
    for (int pos = 0; pos < 32; pos += 2) {
        CMP_LOAD(xfB, arB, peB, pos + 1);
        CMP_MMA(xfA, arA, peA);
        if (pos + 2 < 32) CMP_LOAD(xfA, arA, peA, pos + 2);
        CMP_MMA(xfB, arB, peB);
    }
#undef CMP_LOAD
#undef CMP_MMA
#pragma unroll
    for (int nt = 0; nt < 2; ++nt)
#pragma unroll
        for (int rt = 0; rt < 2; ++rt) { const f4 a = acc[nt][rt]; u2 w; w.x = pkbf(gelu_tanh(a.x), gelu_tanh(a.y)); w.y = pkbf(gelu_tanh(a.z), gelu_tanh(a.w));
            *(LAS u2*)(hidL + (16 * rt + c) * 264 + 32 * wv + 16 * nt + 4 * kq) = w; }
    __syncthreads();
    { const int ot = wv & 3, rt = wv >> 2; f4 o = mk_f4(0.f, 0.f, 0.f, 0.f);
        const bf16* w2p = W2T + (size_t)(16 * ot + c) * 256 + 8 * kq; const LAS bf16* hp = hidL + (16 * rt + c) * 264 + 8 * kq;
#pragma unroll
        for (int ks = 0; ks < 8; ++ks) { const bf16x8 xw = *(const bf16x8*)(w2p + 32 * ks); const bf16x8 yh = *(const LAS bf16x8*)(hp + 32 * ks); o = MFMA16(xw, yh, o); }
        const int ci = i0 + 16 * rt + c;
        if (ci <= 126) { u2 w; w.x = pkbf(o.x, o.y); w.y = pkbf(o.z, o.w); *(u2*)((bf16*)(ws + WS_KC) + ((size_t)((kv * 4 + b) * 4 + g) * 128 + ci) * 64 + 16 * ot + 4 * kq) = w; } }
    __syncthreads();
}

__device__ __forceinline__ void unit_retention_mfma(const Params& P, unsigned char* ws, int l, LAS unsigned char* lds, int u, int tid) {
    const int b = u >> 6, h = (u >> 4) & 3, c = u & 15;
    const bf16* Hb = (const bf16*)(ws + WS_H); const f2* rope = (const f2*)(ws + WS_ROPE);
    LAS bf16* Ql = (LAS bf16*)lds;
    LAS bf16* Kl = (LAS bf16*)(lds + 18432);
    LAS bf16* Vt = (LAS bf16*)(lds + 36864);
    LAS bf16* St = (LAS bf16*)(lds + 71680);
    const float lg2h = P.lg2[h];
    const int tok0 = b * T + c * 128;
    { const int m = tid >> 2, p = tid & 3;
        const f4* rp = (const f4*)(rope + (size_t)(c * 128 + m) * 32 + p * 8);
        const f4 r0 = rp[0], r1 = rp[1], r2 = rp[2], r3 = rp[3];
        const float cs[8] = {r0.x, r0.z, r1.x, r1.z, r2.x, r2.z, r3.x, r3.z}, sn[8] = {r0.y, r0.w, r1.y, r1.w, r2.y, r2.w, r3.y, r3.w};
#pragma unroll
        for (int which = 0; which < 2; ++which) { const bf16* src = Hb + (size_t)(tok0 + m) * INWP + (which ? C_RK : C_RQ) + h * 64 + p * 8;
            const u4 a = *(const u4*)src, bb = *(const u4*)(src + 32); float x1[8], x2[8]; unpack8(a, x1); unpack8(bb, x2);
            const float sc = which ? 0.125f : 1.0f; float o1[8], o2[8];
#pragma unroll
            for (int i = 0; i < 8; ++i) { o1[i] = (x1[i] * cs[i] - x2[i] * sn[i]) * sc; o2[i] = (x1[i] * sn[i] + x2[i] * cs[i]) * sc; }
            LAS bf16* dst = (which ? Kl : Ql) + m * 72 + p * 8;
            u4 w1, w2; w1.x = pkbf(o1[0], o1[1]); w1.y = pkbf(o1[2], o1[3]); w1.z = pkbf(o1[4], o1[5]); w1.w = pkbf(o1[6], o1[7]); w2.x = pkbf(o2[0], o2[1]); w2.y = pkbf(o2[2], o2[3]); w2.z = pkbf(o2[4], o2[5]); w2.w = pkbf(o2[6], o2[7]);
            *(LAS u4*)dst = w1; *(LAS u4*)(dst + 32) = w2; } }
    { const int m = tid & 127, eq = tid >> 7;
        const u4* src = (const u4*)(Hb + (size_t)(tok0 + m) * INWP + C_RV + h * 128 + eq * 32); LAS bf16* vp = Vt + (eq * 32) * 136 + m;
#pragma unroll
        for (int j = 0; j < 4; ++j) { const u4 a = src[j];
            vp[(8 * j + 0) * 136] = (bf16)(a.x & 0xffffu); vp[(8 * j + 1) * 136] = (bf16)(a.x >> 16); vp[(8 * j + 2) * 136] = (bf16)(a.y & 0xffffu); vp[(8 * j + 3) * 136] = (bf16)(a.y >> 16);
            vp[(8 * j + 4) * 136] = (bf16)(a.z & 0xffffu); vp[(8 * j + 5) * 136] = (bf16)(a.z >> 16); vp[(8 * j + 6) * 136] = (bf16)(a.w & 0xffffu); vp[(8 * j + 7) * 136] = (bf16)(a.w >> 16); } }
    { float a[16];
#pragma unroll
        for (int i = 0; i < 16; ++i) a[i] = 0.f;
        const float* kvb = (const float*)(ws + WS_KVST) + (size_t)((b * 4 + h) * 16) * 8192 + tid * 16;
#pragma unroll 1
        for (int j = 0; j < c; ++j) { const float w = exp2f(lg2h * 128.f * (float)(c - 1 - j)); const f4* sp = (const f4*)(kvb + (size_t)j * 8192);
#pragma unroll
            for (int q = 0; q < 4; ++q) { const f4 v = sp[q]; a[4 * q] += w * v.x; a[4 * q + 1] += w * v.y; a[4 * q + 2] += w * v.z; a[4 * q + 3] += w * v.w; } }
        const int d = tid >> 3, e0 = (tid & 7) * 16;
#pragma unroll
        for (int i = 0; i < 16; ++i) St[(e0 + i) * 72 + d] = (bf16)f2bf(a[i]); }
    __syncthreads();
    const int lane = tid & 63, wv = __builtin_amdgcn_readfirstlane(tid >> 6), cc = lane & 15, kq = lane >> 4;
    const int nn = 16 * wv + cc;
    bf16x8 yq[2];
#pragma unroll
    for (int ks = 0; ks < 2; ++ks) yq[ks] = *(const LAS bf16x8*)(Ql + nn * 72 + 32 * ks + 8 * kq);
    f4 ot[8];
#pragma unroll
    for (int et = 0; et < 8; ++et) { f4 a = mk_f4(0.f, 0.f, 0.f, 0.f); const LAS bf16* sp = St + (16 * et + cc) * 72 + 8 * kq;
        a = MFMA16(*(const LAS bf16x8*)sp, yq[0], a); a = MFMA16(*(const LAS bf16x8*)(sp + 32), yq[1], a); ot[et] = a; }
    { const float xi = exp2f(lg2h * (float)(nn + 1));
#pragma unroll
        for (int et = 0; et < 8; ++et) ot[et] *= xi; }
    const int nks = (wv >> 1) + 1;
#pragma unroll 1
    for (int ksp = 0; ksp < nks; ++ksp) { f4 st[2];
#pragma unroll
        for (int j = 0; j < 2; ++j) { const int mt = 2 * ksp + j; const LAS bf16* kp = Kl + (16 * mt + cc) * 72 + 8 * kq;
            f4 a = mk_f4(0.f, 0.f, 0.f, 0.f); a = MFMA16(*(const LAS bf16x8*)kp, yq[0], a); a = MFMA16(*(const LAS bf16x8*)(kp + 32), yq[1], a);
#pragma unroll
            for (int i = 0; i < 4; ++i) { const int mm = 16 * mt + 4 * kq + i; a[i] = (mm <= nn) ? a[i] * exp2f(lg2h * (float)(nn - mm)) : 0.f; }
            st[j] = a; }
        u4 w; w.x = pkbf(st[0].x, st[0].y); w.y = pkbf(st[0].z, st[0].w); w.z = pkbf(st[1].x, st[1].y); w.w = pkbf(st[1].z, st[1].w);
        const bf16x8 pf = __builtin_bit_cast(bf16x8, w);
#pragma unroll
        for (int et = 0; et < 8; ++et) { const LAS bf16* vp = Vt + (16 * et + cc) * 136 + 32 * ksp + 4 * kq;
            const s16x4 va = *(const LAS s16x4*)vp, vb = *(const LAS s16x4*)(vp + 16);
            ot[et] = MFMA16(__builtin_shufflevector(va, vb, 0, 1, 2, 3, 4, 5, 6, 7), pf, ot[et]); }
    }
    float s1 = 0.f;
#pragma unroll
    for (int et = 0; et < 8; ++et) s1 += (ot[et].x + ot[et].y) + (ot[et].z + ot[et].w);
    s1 += __shfl_xor(s1, 16); s1 += __shfl_xor(s1, 32);
    const float mu = s1 * (1.f / 128.f); float s2 = 0.f;
#pragma unroll
    for (int et = 0; et < 8; ++et) { const f4 dd = ot[et] - mu; s2 += (dd.x * dd.x + dd.y * dd.y) + (dd.z * dd.z + dd.w * dd.w); }
    s2 += __shfl_xor(s2, 16); s2 += __shfl_xor(s2, 32);
    const float rstd = rsqrtf(s2 * (1.f / 128.f) + LN_EPS);
    const float* gg = P.in[2] + l * 512 + h * 128; const float* gb = P.in[3] + l * 512 + h * 128;
    const bf16* gp = Hb + (size_t)(tok0 + nn) * INWP + C_RG + h * 128;
    float* yo = (float*)(ws + WS_YMIX) + (size_t)(tok0 + nn) * D + h * 128;
#pragma unroll
    for (int et = 0; et < 8; ++et) { const int e = 16 * et + 4 * kq; const f4 g4 = *(const f4*)(gg + e), b4 = *(const f4*)(gb + e); const u2 gr = *(const u2*)(gp + e);
        const float gv[4] = {__uint_as_float(gr.x << 16), __uint_as_float(gr.x & 0xffff0000u), __uint_as_float(gr.y << 16), __uint_as_float(gr.y & 0xffff0000u)};
        f4 o;
#pragma unroll
        for (int i = 0; i < 4; ++i) { const float y = (ot[et][i] - mu) * rstd * g4[i] + b4[i]; o[i] = y * gv[i] * __builtin_amdgcn_rcpf(1.f + __expf(-gv[i])); }
        *(f4*)(yo + e) = o; }
    __syncthreads();
}

__device__ __forceinline__ bf16x8 tr_frag(const LAS bf16* p, int rowstride4) {
    const s16x4 a = __builtin_amdgcn_ds_read_tr16_b64_v4i16((LAS s16x4*)p), b = __builtin_amdgcn_ds_read_tr16_b64_v4i16((LAS s16x4*)(p + rowstride4));
    return __builtin_shufflevector(a, b, 0, 1, 2, 3, 4, 5, 6, 7);
}
__device__ __forceinline__ void unit_kvstate_mfma(const Params& P, unsigned char* ws, LAS unsigned char* lds, int u, int tid) {
    const int b = u / 60, r = u % 60, h = r / 15, j = r % 15;
    const bf16* Hb = (const bf16*)(ws + WS_H); const f2* rope = (const f2*)(ws + WS_ROPE);
    LAS bf16* Kz = (LAS bf16*)lds;
    LAS bf16* Vl = (LAS bf16*)(lds + 20480);
    const int tok0 = b * T + j * 128; const float lg2h = P.lg2[h];
    { const int m = tid >> 2, p = tid & 3;
        const f4* rp = (const f4*)(rope + (size_t)(j * 128 + m) * 32 + p * 8);
        const f4 r0 = rp[0], r1 = rp[1], r2 = rp[2], r3 = rp[3];
        const float cs[8] = {r0.x, r0.z, r1.x, r1.z, r2.x, r2.z, r3.x, r3.z}, sn[8] = {r0.y, r0.w, r1.y, r1.w, r2.y, r2.w, r3.y, r3.w};
        const bf16* src = Hb + (size_t)(tok0 + m) * INWP + C_RK + h * 64 + p * 8;
        const u4 a = *(const u4*)src, bb = *(const u4*)(src + 32); float x1[8], x2[8]; unpack8(a, x1); unpack8(bb, x2);
        const float sc = 0.125f * exp2f(lg2h * (float)(127 - m)); float o1[8], o2[8];
#pragma unroll
        for (int i = 0; i < 8; ++i) { o1[i] = (x1[i] * cs[i] - x2[i] * sn[i]) * sc; o2[i] = (x1[i] * sn[i] + x2[i] * cs[i]) * sc; }
        u4 w1, w2; w1.x = pkbf(o1[0], o1[1]); w1.y = pkbf(o1[2], o1[3]); w1.z = pkbf(o1[4], o1[5]); w1.w = pkbf(o1[6], o1[7]); w2.x = pkbf(o2[0], o2[1]); w2.y = pkbf(o2[2], o2[3]); w2.z = pkbf(o2[4], o2[5]); w2.w = pkbf(o2[6], o2[7]);
        *(LAS u4*)(Kz + m * 80 + p * 8) = w1; *(LAS u4*)(Kz + m * 80 + 32 + p * 8) = w2;
        const u4* vs = (const u4*)(Hb + (size_t)(tok0 + m) * INWP + C_RV + h * 128 + p * 32); LAS u4* vd = (LAS u4*)(Vl + m * 144 + p * 32);
#pragma unroll
        for (int q = 0; q < 4; ++q) vd[q] = vs[q]; }
    __syncthreads();
    { const int lane = tid & 63, et = __builtin_amdgcn_readfirstlane(tid >> 6), c = lane & 15, kq = lane >> 4, q = (lane & 15) >> 2, p4 = lane & 3;
        bf16x8 yv[4];
#pragma unroll
        for (int ks = 0; ks < 4; ++ks) yv[ks] = tr_frag(Vl + (32 * ks + 8 * kq + q) * 144 + 16 * et + 4 * p4, 4 * 144);
        float* dst = (float*)(ws + WS_KVST) + (size_t)((b * 4 + h) * 16 + j) * 8192 + 16 * et + c;
#pragma unroll
        for (int dt = 0; dt < 4; ++dt) { f4 acc = mk_f4(0.f, 0.f, 0.f, 0.f);
#pragma unroll
            for (int ks = 0; ks < 4; ++ks) acc = MFMA16(tr_frag(Kz + (32 * ks + 8 * kq + q) * 80 + 16 * dt + 4 * p4, 4 * 80), yv[ks], acc);
#pragma unroll
            for (int i = 0; i < 4; ++i) dst[(16 * dt + 4 * kq + i) * 128] = acc[i]; } }
    __syncthreads();
}
__device__ __forceinline__ void unit_sgu_mfma(const Params& P, unsigned char* ws, int l, LAS unsigned char* lds, int u, int tid, int lane, int wave) {
    const int b = u >> 6, c = (u >> 2) & 15, g = u & 3;
    const bf16* Hb = (const bf16*)(ws + WS_H);
    LAS bf16* vn = (LAS bf16*)lds;
    const int tok0 = b * T + c * 128;
    const float* lng = P.in[4] + l * 512 + g * 128; const float* lnb = P.in[5] + l * 512 + g * 128;
    const float g0 = lng[2 * lane], g1 = lng[2 * lane + 1], b0 = lnb[2 * lane], b1 = lnb[2 * lane + 1];
#pragma unroll 4
    for (int i = 0; i < 16; ++i) { const int s = wave * 16 + i;
        const unsigned pr = *(const unsigned*)(Hb + (size_t)(tok0 + s) * INWP + C_SV + g * 128 + 2 * lane);
        const float v0 = __uint_as_float(pr << 16), v1 = __uint_as_float(pr & 0xffff0000u);
        const float mu = wave_sum(v0 + v1) * (1.f / 128.f); const float d0 = v0 - mu, d1 = v1 - mu;
        const float var = wave_sum(d0 * d0 + d1 * d1) * (1.f / 128.f); const float rstd = rsqrtf(var + LN_EPS);
        *(LAS unsigned*)(vn + s * 144 + 2 * lane) = pkbf(d0 * rstd * g0 + b0, d1 * rstd * g1 + b1); }
    __syncthreads();
    { const int cc = lane & 15, kq = lane >> 4, q = (lane & 15) >> 2, p4 = lane & 3, t = 16 * wave + cc, nks = (wave >> 1) + 1;
        const float* wrow = P.in[6] + ((size_t)l * 4 + g) * 16384 + (size_t)t * 128 + 8 * kq;
        bf16x8 xw[4];
#pragma unroll
        for (int ks = 0; ks < 4; ++ks) { u4 w = {0u, 0u, 0u, 0u};
            if (ks < nks) { const f4 a0 = *(const f4*)(wrow + 32 * ks), a1 = *(const f4*)(wrow + 32 * ks + 4); const int s0 = 32 * ks + 8 * kq;
                w.x = pkbf(s0 + 0 <= t ? a0.x : 0.f, s0 + 1 <= t ? a0.y : 0.f); w.y = pkbf(s0 + 2 <= t ? a0.z : 0.f, s0 + 3 <= t ? a0.w : 0.f);
                w.z = pkbf(s0 + 4 <= t ? a1.x : 0.f, s0 + 5 <= t ? a1.y : 0.f); w.w = pkbf(s0 + 6 <= t ? a1.z : 0.f, s0 + 7 <= t ? a1.w : 0.f); }
            xw[ks] = __builtin_bit_cast(bf16x8, w); }
        f4 bs4; { const float* bsp = P.in[7] + (l * 4 + g) * 128 + 16 * wave + 4 * kq; bs4 = *(const f4*)bsp; }
#pragma unroll 2
        for (int dt = 0; dt < 8; ++dt) { f4 acc = mk_f4(0.f, 0.f, 0.f, 0.f);
#pragma unroll
            for (int ks = 0; ks < 4; ++ks) if (ks < nks) acc = MFMA16(xw[ks], tr_frag(vn + (32 * ks + 8 * kq + q) * 144 + 16 * dt + 4 * p4, 4 * 144), acc);
            const int d = 16 * dt + cc;
#pragma unroll
            for (int i = 0; i < 4; ++i) { const int tt = 16 * wave + 4 * kq + i; const float uu = bf2f(Hb[(size_t)(tok0 + tt) * INWP + C_SU + g * 128 + d]);
                ((float*)(ws + WS_YMIX))[(size_t)(tok0 + tt) * D + 512 + g * 128 + d] = uu * (acc[i] + bs4[i]); } } }
    __syncthreads();
}

__device__ __forceinline__ void row_mixnorm(const Params& P, unsigned char* ws, int l, int rowi, int lane) {
    const f4* yp = (const f4*)((const float*)(ws + WS_YMIX) + (size_t)rowi * D) + lane;
    const f4* gp = (const f4*)(P.in[14] + (size_t)l * D) + lane;
    f4 v[8]; float ss[8];
#pragma unroll
    for (int j = 0; j < 8; ++j) { v[j] = yp[64 * j]; ss[j] = v[j].x * v[j].x + v[j].y * v[j].y + v[j].z * v[j].z + v[j].w * v[j].w; }
    const float r0 = rsqrtf(wave_sum(ss[0] + ss[1]) * (1.f / 512.f) + LN_EPS);
    const float r1 = rsqrtf(wave_sum(ss[2] + ss[3]) * (1.f / 512.f) + LN_EPS);
    const float r2 = rsqrtf(wave_sum((ss[4] + ss[5]) + (ss[6] + ss[7])) * (1.f / 1024.f) + LN_EPS);
    u2* op = (u2*)((bf16*)(ws + WS_MIXED) + (size_t)rowi * D) + lane;
#pragma unroll
    for (int j = 0; j < 8; ++j) { const float r = (j < 2) ? r0 : ((j < 4) ? r1 : r2); const f4 g4 = gp[64 * j];
        op[64 * j] = mk_u2(pk2(v[j].x * r * g4.x, v[j].y * r * g4.y), pk2(v[j].z * r * g4.z, v[j].w * r * g4.w)); }
}
__device__ __forceinline__ void row_ln(const float* __restrict__ zin, const float* __restrict__ gam, const float* __restrict__ bet, float* __restrict__ of32, bf16* __restrict__ obf, unsigned* __restrict__ oq, float* __restrict__ osc, int rowi, int lane) {
    const f4* zp = (const f4*)(zin + (size_t)rowi * D) + lane;
    f4 v[8]; float s = 0.f;
#pragma unroll
    for (int j = 0; j < 8; ++j) { v[j] = zp[64 * j]; s += (v[j].x + v[j].y) + (v[j].z + v[j].w); }
    const float mu = wave_sum(s) * (1.f / D); float s2 = 0.f;
#pragma unroll
    for (int j = 0; j < 8; ++j) { v[j].x -= mu; v[j].y -= mu; v[j].z -= mu; v[j].w -= mu; s2 += (v[j].x * v[j].x + v[j].y * v[j].y) + (v[j].z * v[j].z + v[j].w * v[j].w); }
    const float rstd = rsqrtf(wave_sum(s2) * (1.f / D) + LN_EPS);
    f4* o4 = (f4*)(of32 + (size_t)rowi * D) + lane; u2* o2 = (u2*)(obf + (size_t)rowi * D) + lane;
    const f4* gp = (const f4*)gam + lane; const f4* bp = (const f4*)bet + lane;
    float am = 0.f;
#pragma unroll
    for (int j = 0; j < 8; ++j) { const f4 g4 = gp[64 * j], b4 = bp[64 * j];
        const f4 o = mk_f4(v[j].x * rstd * g4.x + b4.x, v[j].y * rstd * g4.y + b4.y, v[j].z * rstd * g4.z + b4.z, v[j].w * rstd * g4.w + b4.w);
        o4[64 * j] = o; o2[64 * j] = mk_u2(pk2(o.x, o.y), pk2(o.z, o.w)); v[j] = o;
        am = fmaxf(am, fmaxf(fmaxf(fabsf(o.x), fabsf(o.y)), fmaxf(fabsf(o.z), fabsf(o.w)))); }
#pragma unroll
    for (int o = 1; o < 64; o <<= 1) am = fmaxf(am, __shfl_xor(am, o));
    const float sc = (am > 0.f) ? 127.f / am : 1.f;
    if (lane == 0) osc[rowi] = (am > 0.f) ? am * (1.f / 127.f) : 1.f;
    unsigned* qp = oq + (size_t)rowi * (D / 4) + lane;
#pragma unroll
    for (int j = 0; j < 8; ++j) { const int b0 = (int)rintf(v[j].x * sc), b1 = (int)rintf(v[j].y * sc), b2 = (int)rintf(v[j].z * sc), b3 = (int)rintf(v[j].w * sc);
        qp[64 * j] = (unsigned)(b0 & 0xff) | ((unsigned)(b1 & 0xff) << 8) | ((unsigned)(b2 & 0xff) << 16) | ((unsigned)b3 << 24); }
}

__device__ __forceinline__ float dot8_bf16(const u4& w, const float* x) {
    float f[8]; unpack8(w, f);
    return ((f[0] * x[0] + f[1] * x[1]) + (f[2] * x[2] + f[3] * x[3])) + ((f[4] * x[4] + f[5] * x[5]) + (f[6] * x[6] + f[7] * x[7]));
}
__device__ __forceinline__ void peer_load4(u4 (&R)[4][2], const unsigned char* __restrict__ TAB, const LAS int* pe, int grp, int lane) {
#pragma unroll
    for (int k = 0; k < 4; ++k) { const int e = __builtin_amdgcn_readfirstlane(pe[grp * 4 + k]); const u4* p = (const u4*)(TAB + (size_t)e * 2048) + lane; R[k][0] = p[0]; R[k][1] = p[64]; }
}
__device__ __forceinline__ float dot16_fp8(const u4& w, const float* x) {
    float s = 0.f;
#pragma unroll
    for (int q = 0; q < 4; ++q) { const f2 lo = __builtin_amdgcn_cvt_pk_f32_fp8((int)w[q], false), hi = __builtin_amdgcn_cvt_pk_f32_fp8((int)w[q], true);
        s += (lo.x * x[4 * q] + lo.y * x[4 * q + 1]) + (hi.x * x[4 * q + 2] + hi.y * x[4 * q + 3]); }
    return s;
}
__device__ __forceinline__ void peer_dot4(const u4 (&R)[4][2], const float (&xr)[32], const float* __restrict__ USC, const LAS int* pe, const LAS float* pw, const float* __restrict__ VSC, LAS float* hwp, int grp, int lane) {
    float d[4];
#pragma unroll
    for (int k = 0; k < 4; ++k) d[k] = dot16_fp8(R[k][0], xr) + dot16_fp8(R[k][1], xr + 16);
#pragma unroll
    for (int o = 1; o < 64; o <<= 1) {
#pragma unroll
        for (int k = 0; k < 4; ++k) d[k] += __shfl_xor(d[k], o); }
#pragma unroll
    for (int k = 0; k < 4; ++k) { const int e = __builtin_amdgcn_readfirstlane(pe[grp * 4 + k]);
        const float hv = pw[grp * 4 + k] * gelu_tanh(d[k] * USC[e]) * VSC[e];
        if (lane == 0) hwp[grp * 4 + k] = hv; }
}
__device__ __forceinline__ void peer_axpy4(const u4 (&R)[4][2], float (&acc)[32], const LAS float* hwp, int grp) {
#pragma unroll
    for (int k = 0; k < 4; ++k) { const float hw = hwp[grp * 4 + k];
#pragma unroll
        for (int j = 0; j < 2; ++j)
#pragma unroll
            for (int q = 0; q < 4; ++q) { const f2 lo = __builtin_amdgcn_cvt_pk_f32_fp8((int)R[k][j][q], false), hi = __builtin_amdgcn_cvt_pk_f32_fp8((int)R[k][j][q], true);
                acc[16 * j + 4 * q] += hw * lo.x; acc[16 * j + 4 * q + 1] += hw * lo.y; acc[16 * j + 4 * q + 2] += hw * hi.x; acc[16 * j + 4 * q + 3] += hw * hi.y; } }
}
__device__ __forceinline__ void unit_peer(const Params& P, unsigned char* ws, int l, LAS unsigned char* lds, int u, int tid_in, int lane_in, int wave, float* __restrict__ xout) {
    int tid = tid_in; asm volatile("" : "+v"(tid)); int lane = tid & 63;
    const int n0 = u * 32;
    const bf16* QPB = (const bf16*)(ws + WS_QP); int* SC = (int*)(ws + WS_SC);
    { const int h = wave, c = lane & 15, kq = lane >> 4;
#pragma unroll 1
        for (int half = 0; half < 2; ++half) {
            const bf16* kb = (const bf16*)(ws + WS_PKB) + ((size_t)(half * DEPTH + l) * 8 + h) * 16384;
            bf16x8 yq[2][4];
#pragma unroll
            for (int tt = 0; tt < 2; ++tt)
#pragma unroll
                for (int ks = 0; ks < 4; ++ks) yq[tt][ks] = *(const bf16x8*)(QPB + (size_t)(n0 + 16 * tt + c) * D + h * 256 + half * 128 + 32 * ks + 8 * kq);
#pragma unroll 1
            for (int kt = 0; kt < 8; ++kt) { bf16x8 xk[4];
#pragma unroll
                for (int ks = 0; ks < 4; ++ks) xk[ks] = *(const bf16x8*)(kb + (size_t)(16 * kt + c) * 128 + 32 * ks + 8 * kq);
#pragma unroll
                for (int tt = 0; tt < 2; ++tt) { f4 a = mk_f4(0.f, 0.f, 0.f, 0.f);
#pragma unroll
                    for (int ks = 0; ks < 4; ++ks) a = MFMA16(xk[ks], yq[tt][ks], a);
                    int kk[4];
#pragma unroll
                    for (int i = 0; i < 4; ++i) { const int bits = __float_as_int(a[i]); const int sk = bits ^ ((bits >> 31) & 0x7fffffff); kk[i] = (sk & ~127) | (127 - (16 * kt + 4 * kq + i)); }
                    u4 w; w.x = (unsigned)kk[0]; w.y = (unsigned)kk[1]; w.z = (unsigned)kk[2]; w.w = (unsigned)kk[3];
                    *(u4*)(SC + ((size_t)(n0 + 16 * tt + c) * 16 + 2 * h + half) * 128 + 16 * kt + 4 * kq) = w; } }
        } }
    VM_WAIT();
    __syncthreads();
    tid = tid_in; asm volatile("" : "+v"(tid)); lane = tid & 63;
    LAS int* TK = (LAS int*)lds;
    { const int tk = tid >> 4, hh = tid & 15;
        const u4* sp = (const u4*)(SC + ((size_t)(n0 + tk) * 16 + hh) * 128);
        int t[16];
#pragma unroll
        for (int k = 0; k < 16; ++k) t[k] = (int)0x80000000;
#pragma unroll 1
        for (int c4 = 0; c4 < 32; ++c4) { const u4 s4 = sp[c4];
#pragma unroll
            for (int e = 0; e < 4; ++e) { int x = (int)s4[e];
#pragma unroll
                for (int k = 0; k < 16; ++k) { const int hi_ = max(t[k], x); x = min(t[k], x); t[k] = hi_; } } }
#pragma unroll
        for (int k = 0; k < 16; ++k) TK[tid * 17 + k] = t[k]; }
    __syncthreads();
    tid = tid_in; asm volatile("" : "+v"(tid)); lane = tid & 63;
    LAS int* PE = (LAS int*)(lds + 69632);
    LAS float* PW = (LAS float*)(lds + 86016);
    if (tid < 256) { const int tk = tid >> 3, h = tid & 7; const int r1 = tk * 16 + 2 * h, r2 = r1 + 1;
        float v1[16], v2[16];
#pragma unroll
        for (int k = 0; k < 16; ++k) { const int k1 = TK[r1 * 17 + k] & ~127, k2 = TK[r2 * 17 + k] & ~127;
            v1[k] = __int_as_float(k1 ^ ((k1 >> 31) & 0x7fffffff)); v2[k] = __int_as_float(k2 ^ ((k2 >> 31) & 0x7fffffff)); }
        int t[16];
#pragma unroll
        for (int k = 0; k < 16; ++k) t[k] = (int)0x80000000;
#pragma unroll
        for (int a = 0; a < 16; ++a)
#pragma unroll
            for (int bq = 0; bq < 16; ++bq) if ((a + 1) * (bq + 1) <= 16) { const int bits = __float_as_int(v1[a] + v2[bq]); const int sk = bits ^ ((bits >> 31) & 0x7fffffff);
                int x = (sk & ~255) | (255 - (a * 16 + bq));
#pragma unroll
                for (int k = 0; k < 16; ++k) { const int hi_ = max(t[k], x); x = min(t[k], x); t[k] = hi_; } }
        float w[16], wsum = 0.f; const int kt0 = t[0] & ~255; const float top = __int_as_float(kt0 ^ ((kt0 >> 31) & 0x7fffffff));
#pragma unroll
        for (int k = 0; k < 16; ++k) { const int kk = t[k] & ~255; const float sv = __int_as_float(kk ^ ((kk >> 31) & 0x7fffffff)); w[k] = __expf(sv - top); wsum += w[k]; }
        const float inv = 1.f / wsum;
#pragma unroll
        for (int k = 0; k < 16; ++k) { const int ab = 255 - (t[k] & 255); const int a = ab >> 4, bq = ab & 15;
            const int i1 = 127 - (TK[r1 * 17 + a] & 127), i2 = 127 - (TK[r2 * 17 + bq] & 127);
            PE[tk * 128 + h * 16 + k] = i1 * 128 + i2; PW[tk * 128 + h * 16 + k] = w[k] * inv; } }
    __syncthreads();
    tid = tid_in; asm volatile("" : "+v"(tid)); lane = tid & 63;
    { int* FE = (int*)(ws + WS_FE) + (size_t)u * 16 * FCAP; float* FW = (float*)(ws + WS_FW) + (size_t)u * 16 * FCAP; int* GST = (int*)(ws + WS_GST) + (size_t)u * 16 * 64;
        LAS int* CNT = (LAS int*)(lds + 118784);
        LAS int* STA = (LAS int*)(lds + 120832);
#pragma unroll 1
        for (int it = 0; it < 4; ++it) { const int tk = wave * 4 + it;
            const int k0 = PE[tk * 128 + lane] >> BSH, k1 = PE[tk * 128 + 64 + lane] >> BSH; int mycnt = 0;
#pragma unroll
            for (int v = 0; v < NBKT; ++v) { const int c = __builtin_popcountll(__builtin_amdgcn_ballot_w64(k0 == v)) + __builtin_popcountll(__builtin_amdgcn_ballot_w64(k1 == v)); if (lane == v) mycnt = (c + PG - 1) & ~(PG - 1); }
            if (lane < NBKT) CNT[tk * 16 + lane] = mycnt; }
        __syncthreads();
        if (tid < NBKT) { int run = 0;
#pragma unroll 1
            for (int t = 0; t < 32; ++t) { STA[t * 16 + tid] = run; run += CNT[t * 16 + tid]; }
            STA[32 * 16 + tid] = run; }
        __syncthreads();
        for (int i = tid; i < NBKT * 33; i += 512) { const int bb = i / 33, t = i % 33; GST[bb * 64 + t] = STA[t * 16 + bb]; }
#pragma unroll 1
        for (int it = 0; it < 4; ++it) { const int tk = wave * 4 + it;
            const int e0 = PE[tk * 128 + lane], e1 = PE[tk * 128 + 64 + lane]; const float w0 = PW[tk * 128 + lane], w1 = PW[tk * 128 + 64 + lane];
            const int k0 = e0 >> BSH, k1 = e1 >> BSH; int pos0 = 0, pos1 = 0;
#pragma unroll
            for (int v = 0; v < NBKT; ++v) { const unsigned long long b0 = __builtin_amdgcn_ballot_w64(k0 == v), b1 = __builtin_amdgcn_ballot_w64(k1 == v);
                const int c0 = __builtin_popcountll(b0), c = c0 + __builtin_popcountll(b1), pc = (c + PG - 1) & ~(PG - 1); const int base = STA[tk * 16 + v];
                const int r0 = (int)__builtin_amdgcn_mbcnt_hi((unsigned)(b0 >> 32), __builtin_amdgcn_mbcnt_lo((unsigned)b0, 0u));
                const int r1 = c0 + (int)__builtin_amdgcn_mbcnt_hi((unsigned)(b1 >> 32), __builtin_amdgcn_mbcnt_lo((unsigned)b1, 0u));
                if (k0 == v) pos0 = v * FCAP + base + r0;
                if (k1 == v) pos1 = v * FCAP + base + r1;
                if (lane < pc - c) { FE[v * FCAP + base + c + lane] = v << BSH; FW[v * FCAP + base + c + lane] = 0.f; } }
            FE[pos0] = e0; FW[pos0] = w0; FE[pos1] = e1; FW[pos1] = w1; } }
    __syncthreads();
}

__device__ __forceinline__ void peer3_rows(u4 (&R)[PG][2], const unsigned char* __restrict__ TAB, int ev, int g, int lane) {
#pragma unroll
    for (int k = 0; k < PG; ++k) { const int e = __builtin_amdgcn_readlane(ev, PG * g + k); const unsigned char* rowp = TAB + (size_t)(unsigned)e * 2048u; R[k][0] = *(const u4*)(rowp + (unsigned)lane * 16u); R[k][1] = *(const u4*)(rowp + 1024u + (unsigned)lane * 16u); }
}
#define DPP_F(v, ctrl) __int_as_float(__builtin_amdgcn_update_dpp(0, __float_as_int(v), (ctrl), 0xf, 0xf, true))
__device__ __forceinline__ float wave_sum_dpp(float v) {
    v += DPP_F(v, 0xB1); v += DPP_F(v, 0x4E); v += DPP_F(v, 0x141); v += DPP_F(v, 0x140);
    const int iv = __float_as_int(v);
    return (__int_as_float(__builtin_amdgcn_readlane(iv, 0)) + __int_as_float(__builtin_amdgcn_readlane(iv, 16))) + (__int_as_float(__builtin_amdgcn_readlane(iv, 32)) + __int_as_float(__builtin_amdgcn_readlane(iv, 48)));
}
__device__ __forceinline__ float dot16_pk(const u4& w, const f2* x) {
    f2 a = {0.f, 0.f};
#pragma unroll
    for (int q = 0; q < 4; ++q) { const f2 lo = __builtin_amdgcn_cvt_pk_f32_fp8((int)w[q], false), hi = __builtin_amdgcn_cvt_pk_f32_fp8((int)w[q], true);
        a = __builtin_elementwise_fma(lo, x[2 * q], a); a = __builtin_elementwise_fma(hi, x[2 * q + 1], a); }
    return a.x + a.y;
}
__device__ __forceinline__ int wave_isum_dpp(int v) {
    v += __builtin_amdgcn_update_dpp(0, v, 0xB1, 0xf, 0xf, true); v += __builtin_amdgcn_update_dpp(0, v, 0x4E, 0xf, 0xf, true);
    v += __builtin_amdgcn_update_dpp(0, v, 0x141, 0xf, 0xf, true); v += __builtin_amdgcn_update_dpp(0, v, 0x140, 0xf, 0xf, true);
    return (__builtin_amdgcn_readlane(v, 0) + __builtin_amdgcn_readlane(v, 16)) + (__builtin_amdgcn_readlane(v, 32) + __builtin_amdgcn_readlane(v, 48));
}
__device__ __forceinline__ int wave_isum4_t(const int (&d)[4], int lane) {
    const bool o1 = lane & 1, o2 = lane & 2;
    int a = o1 ? d[1] : d[0], b = o1 ? d[0] : d[1], c = o1 ? d[3] : d[2], e = o1 ? d[2] : d[3];
    a += __builtin_amdgcn_update_dpp(0, b, 0xB1, 0xf, 0xf, true);
    c += __builtin_amdgcn_update_dpp(0, e, 0xB1, 0xf, 0xf, true);
    int f = o2 ? c : a, g = o2 ? a : c;
    f += __builtin_amdgcn_update_dpp(0, g, 0x4E, 0xf, 0xf, true);
    f += __builtin_amdgcn_update_dpp(0, f, 0x124, 0xf, 0xf, true);
    f += __builtin_amdgcn_update_dpp(0, f, 0x128, 0xf, 0xf, true);
    f += __shfl_xor(f, 16); f += __shfl_xor(f, 32);
    return f;
}
__device__ __forceinline__ void peer3_dots(const u4 (&R)[PG][2], const u4 (&xq)[2], int& dv, int g, int lane) {
    static_assert(PG == 4, "peer3_dots reduces four rows at a time");
    int d[4];
#pragma unroll
    for (int k = 0; k < 4; ++k) { int a = 0;
#pragma unroll
        for (int j = 0; j < 2; ++j)
#pragma unroll
            for (int q = 0; q < 4; ++q) a = __builtin_amdgcn_sdot4((int)R[k][j][q], (int)xq[j][q], a, false);
        d[k] = a; }
    const int t = wave_isum4_t(d, lane);
    dv = (lane >= 4 * g && lane < 4 * g + 4) ? t : dv;
}
__device__ __forceinline__ void peer3_axpy(const u4 (&R)[PG][2], f2 (&acc)[16], int hwv, int g) {
#pragma unroll
    for (int k = 0; k < PG; ++k) { const float hw = __int_as_float(__builtin_amdgcn_readlane(hwv, PG * g + k)); const f2 hw2 = {hw, hw};
#pragma unroll
        for (int j = 0; j < 2; ++j)
#pragma unroll
            for (int q = 0; q < 4; ++q) { const f2 lo = __builtin_amdgcn_cvt_pk_f32_fp8((int)R[k][j][q], false), hi = __builtin_amdgcn_cvt_pk_f32_fp8((int)R[k][j][q], true);
                acc[8 * j + 2 * q] = __builtin_elementwise_fma(lo, hw2, acc[8 * j + 2 * q]); acc[8 * j + 2 * q + 1] = __builtin_elementwise_fma(hi, hw2, acc[8 * j + 2 * q + 1]); }
        __builtin_amdgcn_sched_barrier(0); }
}
__device__ __forceinline__ void unpack_row(const u4 (&X)[4], f2 (&o)[16]) {
#pragma unroll
    for (int i = 0; i < 4; ++i) { o[4 * i].x = __uint_as_float(X[i].x << 16); o[4 * i].y = __uint_as_float(X[i].x & 0xffff0000u); o[4 * i + 1].x = __uint_as_float(X[i].y << 16); o[4 * i + 1].y = __uint_as_float(X[i].y & 0xffff0000u);
        o[4 * i + 2].x = __uint_as_float(X[i].z << 16); o[4 * i + 2].y = __uint_as_float(X[i].z & 0xffff0000u); o[4 * i + 3].x = __uint_as_float(X[i].w << 16); o[4 * i + 3].y = __uint_as_float(X[i].w & 0xffff0000u); }
}
__device__ __forceinline__ void peer3_rowload(u4 (&X)[4], const bf16* __restrict__ base, unsigned n, int lane) {
    const bf16* p = base + (n * (unsigned)D + (unsigned)(16 * lane));
    X[0] = *(const u4*)p; X[1] = *(const u4*)(p + 8); X[2] = *(const u4*)(p + 1024); X[3] = *(const u4*)(p + 1032);
}
__device__ __forceinline__ void peer3_rowstore(bf16* __restrict__ base, unsigned n, int lane, const f2 (&acc)[16]) {
    bf16* p = base + (n * (unsigned)D + (unsigned)(16 * lane));
#pragma unroll
    for (int j = 0; j < 2; ++j) { u4 p0, p1; p0.x = pkbf(acc[8 * j].x, acc[8 * j].y); p0.y = pkbf(acc[8 * j + 1].x, acc[8 * j + 1].y); p0.z = pkbf(acc[8 * j + 2].x, acc[8 * j + 2].y); p0.w = pkbf(acc[8 * j + 3].x, acc[8 * j + 3].y);
        p1.x = pkbf(acc[8 * j + 4].x, acc[8 * j + 4].y); p1.y = pkbf(acc[8 * j + 5].x, acc[8 * j + 5].y); p1.z = pkbf(acc[8 * j + 6].x, acc[8 * j + 6].y); p1.w = pkbf(acc[8 * j + 7].x, acc[8 * j + 7].y);
        __builtin_nontemporal_store(p0, (u4*)(p + 1024 * j)); __builtin_nontemporal_store(p1, (u4*)(p + 1024 * j + 8)); }
}
__device__ __forceinline__ int peer3_next_nonempty(int gstv, int t) {
    while (t < 32 && __builtin_amdgcn_readlane(gstv, t + 1) == __builtin_amdgcn_readlane(gstv, t)) ++t;
    return t;
}
__device__ __forceinline__ void phase_peer_bucket(const Params& P, unsigned char* ws, int l, int bid, int G, int lane, int wave) {
    const int x = bid & 7, r = bid >> 3;
    const int u = r * 8 + wave; const unsigned nbase = (unsigned)u * 32u;
    const unsigned char* PU = ws + WS_PU + (size_t)l * 16384 * 2048; const unsigned char* PV = ws + WS_PV + (size_t)l * 16384 * 2048;
    const float* USC = (const float*)(ws + WS_PSC) + (size_t)l * 16384; const float* VSC = (const float*)(ws + WS_PSC) + (size_t)(DEPTH + l) * 16384;
    const bf16* X1B = (const bf16*)(ws + WS_X1B);
    bf16* PART = (bf16*)(ws + WS_PART) + (size_t)x * NTOK * D;
#pragma unroll 1
    for (int rnd = 0; rnd < NRND; ++rnd) { const int xb = x + 8 * rnd;
        const int* FE = (const int*)(ws + WS_FE) + ((size_t)u * 16 + xb) * FCAP; const float* FW = (const float*)(ws + WS_FW) + ((size_t)u * 16 + xb) * FCAP; float* FHW = (float*)(ws + WS_FHW) + ((size_t)u * 16 + xb) * FCAP;
        int gstv = 0; if (lane <= 32) gstv = ((const int*)(ws + WS_GST))[((size_t)u * 16 + xb) * 64 + lane];
        const int total = __builtin_amdgcn_readlane(gstv, 32);
        if (total > 0) {
            const unsigned char* X1Q = ws + WS_X1Q; const float* XSC = (const float*)(ws + WS_XSC);
            int tcur = peer3_next_nonempty(gstv, 0); int tnx = peer3_next_nonempty(gstv, tcur + 1); int tend = __builtin_amdgcn_readlane(gstv, tcur + 1);
            u4 xq[2], xn[2];
            { const unsigned char* p = X1Q + (size_t)(nbase + tcur) * 2048u + (unsigned)lane * 16u; xq[0] = __builtin_nontemporal_load((const u4*)p); xq[1] = __builtin_nontemporal_load((const u4*)(p + 1024)); }
            if (tnx < 32) { const unsigned char* p = X1Q + (size_t)(nbase + tnx) * 2048u + (unsigned)lane * 16u; xn[0] = __builtin_nontemporal_load((const u4*)p); xn[1] = __builtin_nontemporal_load((const u4*)(p + 1024)); }
            float xs = XSC[nbase + tcur];
#pragma unroll 1
            for (int blk = 0; blk < total; blk += 64) { const int blen = (total - blk) < 64 ? (total - blk) : 64, ng = blen / PG;
                int ev = 0; float wv = 0.f;
                if (lane < blen) { ev = __builtin_nontemporal_load(FE + blk + lane); wv = __builtin_nontemporal_load(FW + blk + lane); }
                const float us = USC[ev], vs = VSC[ev];
                int dv = 0; float xsv = 0.f; u4 A[PG][2], B[PG][2];
                peer3_rows(A, PU, ev, 0, lane);
#pragma unroll 1
                for (int g = 0; g < ng; g += 2) {
                    if (g + 1 < ng) peer3_rows(B, PU, ev, g + 1, lane);
                    if (blk + PG * g >= tend) { tcur = tnx; xq[0] = xn[0]; xq[1] = xn[1]; xs = XSC[nbase + tcur]; tend = __builtin_amdgcn_readlane(gstv, tcur + 1);
                        tnx = peer3_next_nonempty(gstv, tcur + 1); if (tnx < 32) { const unsigned char* p = X1Q + (size_t)(nbase + tnx) * 2048u + (unsigned)lane * 16u; xn[0] = __builtin_nontemporal_load((const u4*)p); xn[1] = __builtin_nontemporal_load((const u4*)(p + 1024)); } }
                    peer3_dots(A, xq, dv, g, lane);
                    xsv = (lane >= PG * g && lane < PG * g + PG) ? xs : xsv;
                    __builtin_amdgcn_sched_barrier(0);
                    if (g + 2 < ng) peer3_rows(A, PU, ev, g + 2, lane);
                    if (g + 1 < ng) {
                        if (blk + PG * (g + 1) >= tend) { tcur = tnx; xq[0] = xn[0]; xq[1] = xn[1]; xs = XSC[nbase + tcur]; tend = __builtin_amdgcn_readlane(gstv, tcur + 1);
                            tnx = peer3_next_nonempty(gstv, tcur + 1); if (tnx < 32) { const unsigned char* p = X1Q + (size_t)(nbase + tnx) * 2048u + (unsigned)lane * 16u; xn[0] = __builtin_nontemporal_load((const u4*)p); xn[1] = __builtin_nontemporal_load((const u4*)(p + 1024)); } }
                        peer3_dots(B, xq, dv, g + 1, lane);
                        xsv = (lane >= PG * (g + 1) && lane < PG * (g + 1) + PG) ? xs : xsv; }
                    __builtin_amdgcn_sched_barrier(0);
                }
                if (lane < blen) FHW[blk + lane] = wv * gelu_tanh((float)dv * us * xsv) * vs;
            } }
        VM_WAIT();
        { f2 acc[16];
            if (rnd == 0) {
#pragma unroll
                for (int i = 0; i < 16; ++i) acc[i] = (f2){0.f, 0.f};
#pragma unroll 1
                for (int t = 0; t < 32; ++t) if (__builtin_amdgcn_readlane(gstv, t + 1) == __builtin_amdgcn_readlane(gstv, t)) peer3_rowstore(PART, nbase + t, lane, acc); }
            if (total > 0) {
                int tcur = peer3_next_nonempty(gstv, 0); int tnx = peer3_next_nonempty(gstv, tcur + 1); int tend = __builtin_amdgcn_readlane(gstv, tcur + 1);
                u4 xn[4];
                if (rnd > 0) { u4 xq[4]; peer3_rowload(xq, PART, nbase + tcur, lane); if (tnx < 32) peer3_rowload(xn, PART, nbase + tnx, lane); unpack_row(xq, acc); }
                else {
#pragma unroll
                    for (int i = 0; i < 16; ++i) acc[i] = (f2){0.f, 0.f}; }
#pragma unroll 1
                for (int blk = 0; blk < total; blk += 64) { const int blen = (total - blk) < 64 ? (total - blk) : 64, ng = blen / PG;
                    int ev = 0, hwv = 0;
                    if (lane < blen) { ev = __builtin_nontemporal_load(FE + blk + lane); hwv = (int)__hip_atomic_load((const unsigned*)(FHW + blk + lane), __ATOMIC_RELAXED, __HIP_MEMORY_SCOPE_AGENT); }
                    u4 A[PG][2], B[PG][2];
                    peer3_rows(A, PV, ev, 0, lane);
#pragma unroll 1
                    for (int g = 0; g < ng; g += 2) {
                        if (g + 1 < ng) peer3_rows(B, PV, ev, g + 1, lane);
                        if (blk + PG * g >= tend) { peer3_rowstore(PART, nbase + tcur, lane, acc); tcur = tnx; tend = __builtin_amdgcn_readlane(gstv, tcur + 1);
                            if (rnd > 0) { unpack_row(xn, acc); }
                            else {
#pragma unroll
                                for (int i = 0; i < 16; ++i) acc[i] = (f2){0.f, 0.f}; }
                            tnx = peer3_next_nonempty(gstv, tcur + 1); if (rnd > 0 && tnx < 32) peer3_rowload(xn, PART, nbase + tnx, lane); }
                        peer3_axpy(A, acc, hwv, g);
                        __builtin_amdgcn_sched_barrier(0);
                        if (g + 2 < ng) peer3_rows(A, PV, ev, g + 2, lane);
                        if (g + 1 < ng) {
                            if (blk + PG * (g + 1) >= tend) { peer3_rowstore(PART, nbase + tcur, lane, acc); tcur = tnx; tend = __builtin_amdgcn_readlane(gstv, tcur + 1);
                                if (rnd > 0) { unpack_row(xn, acc); }
                                else {
#pragma unroll
                                    for (int i = 0; i < 16; ++i) acc[i] = (f2){0.f, 0.f}; }
                                tnx = peer3_next_nonempty(gstv, tcur + 1); if (rnd > 0 && tnx < 32) peer3_rowload(xn, PART, nbase + tnx, lane); }
                            peer3_axpy(B, acc, hwv, g + 1); }
                        __builtin_amdgcn_sched_barrier(0);
                    } }
                peer3_rowstore(PART, nbase + tcur, lane, acc);
            } }
        VM_WAIT();
    }
}
__device__ __forceinline__ void row_peer_reduce(const Params& P, unsigned char* ws, int l, int rowi, int lane, float* __restrict__ xout) {
    const size_t n = (size_t)rowi; const float* X1 = (const float*)(ws + WS_X1); const bf16* PART = (const bf16*)(ws + WS_PART);
    float acc[32];
#pragma unroll
    for (int j = 0; j < 2; ++j)
#pragma unroll
        for (int q = 0; q < 4; ++q) { const f4 a = *(const f4*)(X1 + n * D + 1024 * j + 16 * lane + 4 * q); acc[16 * j + 4 * q] = ALPHA * a.x; acc[16 * j + 4 * q + 1] = ALPHA * a.y; acc[16 * j + 4 * q + 2] = ALPHA * a.z; acc[16 * j + 4 * q + 3] = ALPHA * a.w; }
#pragma unroll 2
    for (int xb_ = 0; xb_ < 8; ++xb_) { const bf16* pp = PART + ((size_t)xb_ * NTOK + n) * D;
#pragma unroll
        for (int j = 0; j < 2; ++j) { const u4 a = *(const u4*)(pp + 1024 * j + 16 * lane), bq = *(const u4*)(pp + 1024 * j + 16 * lane + 8); float f[16]; unpack8(a, f); unpack8(bq, f + 8);
#pragma unroll
            for (int i = 0; i < 16; ++i) acc[16 * j + i] += f[i]; } }
    float s = 0.f;
#pragma unroll
    for (int i = 0; i < 32; ++i) s += acc[i];
    const float mu = wave_sum(s) * (1.f / D); float s2 = 0.f;
#pragma unroll
    for (int i = 0; i < 32; ++i) { acc[i] -= mu; s2 += acc[i] * acc[i]; }
    const float rstd = rsqrtf(wave_sum(s2) * (1.f / D) + LN_EPS);
    const float* gam = P.in[23] + (size_t)l * D; const float* bet = P.in[24] + (size_t)l * D;
    bf16* xb = (bf16*)(ws + WS_XB);
#pragma unroll
    for (int j = 0; j < 2; ++j) { const int col = 1024 * j + 16 * lane; float o[16];
#pragma unroll
        for (int q = 0; q < 4; ++q) { const f4 g4 = *(const f4*)(gam + col + 4 * q), b4 = *(const f4*)(bet + col + 4 * q);
            o[4 * q] = acc[16 * j + 4 * q] * rstd * g4.x + b4.x; o[4 * q + 1] = acc[16 * j + 4 * q + 1] * rstd * g4.y + b4.y; o[4 * q + 2] = acc[16 * j + 4 * q + 2] * rstd * g4.z + b4.z; o[4 * q + 3] = acc[16 * j + 4 * q + 3] * rstd * g4.w + b4.w;
            *(f4*)(xout + n * D + col + 4 * q) = mk_f4(o[4 * q], o[4 * q + 1], o[4 * q + 2], o[4 * q + 3]); }
        u4 p0, p1; p0.x = pk2(o[0], o[1]); p0.y = pk2(o[2], o[3]); p0.z = pk2(o[4], o[5]); p0.w = pk2(o[6], o[7]); p1.x = pk2(o[8], o[9]); p1.y = pk2(o[10], o[11]); p1.z = pk2(o[12], o[13]); p1.w = pk2(o[14], o[15]);
        *(u4*)(xb + n * D + col) = p0; *(u4*)(xb + n * D + col + 8) = p1; }
}

template <class T> __device__ __forceinline__ T* uniform_ptr(T* p) { const unsigned long long v = (unsigned long long)p; const unsigned lo = __builtin_amdgcn_readfirstlane((unsigned)v), hi = __builtin_amdgcn_readfirstlane((unsigned)(v >> 32)); return (T*)(__attribute__((address_space(1))) T*)(((unsigned long long)hi << 32) | lo); }
constexpr int PH_PER_LAYER = 10, N_PHASES = 1 + DEPTH * PH_PER_LAYER;
#ifndef ONLY_PHASE
#define ONLY_PHASE -1
#endif
#define EN(i) (ONLY_PHASE < 0 || ONLY_PHASE == (i))
__global__ void __launch_bounds__(512, 2) mk_fwd(Params P) {
    extern __shared__ __attribute__((aligned(16))) unsigned char lds_raw[];
    LAS unsigned char* lds = (LAS unsigned char*)lds_raw;
    volatile LAS unsigned* MISC = (volatile LAS unsigned*)(lds + MISC_OFF);
    const int tid = threadIdx.x, lane = tid & 63, wave = __builtin_amdgcn_readfirstlane(tid >> 6);
    const int G = gridDim.x, bid = blockIdx.x;
    if (tid < 64) MISC[tid] = 0u;
    __syncthreads();
    unsigned char* const ws = uniform_ptr(P.ws);
    unsigned* ctl = (unsigned*)(ws + WS_CTL);
    const XcdBarrier bar = xcd_barrier_post(ctl + CW_BAR, MISC + 8);
    const int lo = P.ph_lo, hi = P.ph_hi;
#define IN(k) (lo <= (k) && (k) < hi)
#define LAUNDER() int tl; asm volatile("v_mbcnt_lo_u32_b32 %0, -1, 0\n\tv_mbcnt_hi_u32_b32 %0, -1, %0" : "=v"(tl)); tl |= (wave << 6); const int ll = tl & 63; const int wl = __builtin_amdgcn_readfirstlane(tl >> 6); (void)ll; (void)wl
#define SEAM(k) do { if (IN((k) + 1)) xcd_barrier(bar); } while (0)
    if (IN(0) && EN(20)) { LAUNDER(); REP(20) phase_prologue(P, ws, lds, tl, ll, wl); SEAM(0); }
    for (int l = 0; l < DEPTH; ++l) {
        const int pb = 1 + l * PH_PER_LAYER;
        const float* xres = (l == 0) ? P.in[0] : (const float*)(ws + WS_XC);
        float* xout = (l == DEPTH - 1) ? P.out : (float*)(ws + WS_XC);
        if (IN(pb + 0) && EN(0)) { LAUNDER();
            pg8::Gemm g{(const pg8::bf16_t*)(ws + WS_XB), (const pg8::bf16_t*)(ws + WS_WIN) + (size_t)l * INWP * D, NTOK, INWP, D};
            pg8::StaticOrder S; S.init(NTOK, INWP, G, bid);
            pg8::EpiH E{(pg8::bf16_t*)(ws + WS_H), INWP, 6, 10};
            REP(0) pg8::gemm_phase<pg8::EpiH, pg8::StaticOrder, true, true>(lds, g, S, E, tl);
            SEAM(pb + 0);
        }
        if (IN(pb + 1) && EN(1)) { LAUNDER();
            REP(1) for (int u = bid; u < 240; u += G) unit_kvstate_mfma(P, ws, lds, u, tl);
            REP(13) for (int u = bid; u < 256; u += G) unit_sgu_mfma(P, ws, l, lds, u, tl, ll, wl);
            REP(12) for (int u = bid; u < 128; u += G) unit_compress_mfma(P, ws, l, lds, u, tl);
            SEAM(pb + 1);
        }
        if (IN(pb + 2) && EN(2)) { LAUNDER();
            REP(10) for (int u = bid; u < 256; u += G) unit_retention_mfma(P, ws, l, lds, u, tl);
            REP(11) for (int u = bid; u < 512; u += G) unit_nsa(P, ws, l, lds, u, tl);
            SEAM(pb + 2);
        }
        if (IN(pb + 3) && EN(3)) { LAUNDER();
            REP(3) for (int r = bid * 8 + wl; r < NTOK; r += G * 8) row_mixnorm(P, ws, l, r, ll);
            SEAM(pb + 3);
        }
        if (IN(pb + 4) && EN(4)) { LAUNDER();
            pg8::Gemm g{(const pg8::bf16_t*)(ws + WS_MIXED), (const pg8::bf16_t*)(ws + WS_WOUT) + (size_t)l * D * D, NTOK, D, D};
            pg8::StaticOrder S; S.init(NTOK, D, G, bid);
            pg8::EpiRes E{(float*)(ws + WS_Z), xres, D, ALPHA};
            REP(4) pg8::gemm_phase<pg8::EpiRes, pg8::StaticOrder, true, true>(lds, g, S, E, tl);
            SEAM(pb + 4);
        }
        if (IN(pb + 5) && EN(5)) { LAUNDER();
            for (int r = bid * 8 + wl; r < NTOK; r += G * 8) row_ln((const float*)(ws + WS_Z), P.in[16] + (size_t)l * D, P.in[17] + (size_t)l * D, (float*)(ws + WS_X1), (bf16*)(ws + WS_X1B), (unsigned*)(ws + WS_X1Q), (float*)(ws + WS_XSC), r, ll);
            SEAM(pb + 5);
        }
        if (IN(pb + 6) && EN(6)) { LAUNDER();
            pg8::Gemm g{(const pg8::bf16_t*)(ws + WS_X1B), (const pg8::bf16_t*)(ws + WS_WQ) + (size_t)l * D * D, NTOK, D, D};
            pg8::StaticOrder S; S.init(NTOK, D, G, bid);
            pg8::EpiH E{(pg8::bf16_t*)(ws + WS_QP), D, 0, 0};
            pg8::gemm_phase<pg8::EpiH, pg8::StaticOrder, true, true>(lds, g, S, E, tl);
            SEAM(pb + 6);
        }
        if (IN(pb + 7) && EN(7)) { LAUNDER();
            REP(7) for (int u = bid; u < NTOK / 32; u += G) unit_peer(P, ws, l, lds, u, tl, ll, wl, xout);
            SEAM(pb + 7);
        }
        if (IN(pb + 8) && EN(8)) { LAUNDER();
            REP(8) phase_peer_bucket(P, ws, l, bid, G, ll, wl);
            SEAM(pb + 8);
        }
        if (IN(pb + 9) && EN(9)) { LAUNDER();
            REP(9) for (int r = bid * 8 + wl; r < NTOK; r += G * 8) row_peer_reduce(P, ws, l, r, ll, xout);
            SEAM(pb + 9);
        }
    }
#undef IN
#undef SEAM
}

#ifndef MK_ONE_LAUNCH
#define MK_ONE_LAUNCH 1
#endif
extern "C" void kernel_launch(void* const* d_in, const int* in_sizes, int n_in, void* d_out, int out_size, void* d_ws, size_t ws_size, hipStream_t stream) {
    static int grid = 0;
    if (grid == 0) {
        if (n_in != 25 || out_size != NTOK * D || ws_size < WS_END) { fprintf(stderr, "kernel_launch: unexpected shapes: n_in %d out %d ws %zu (need %zu)\n", n_in, out_size, ws_size, (size_t)WS_END); grid = -1; return; }
        int dev = 0, cus = 0, per_cu = 0;
        if (hipGetDevice(&dev) != hipSuccess || hipDeviceGetAttribute(&cus, hipDeviceAttributeMultiprocessorCount, dev) != hipSuccess) { grid = -1; return; }
        if (hipFuncSetAttribute((const void*)mk_fwd, hipFuncAttributeMaxDynamicSharedMemorySize, LDS_BYTES) != hipSuccess) { fprintf(stderr, "kernel_launch: hipFuncSetAttribute failed\n"); grid = -1; return; }
        if (hipOccupancyMaxActiveBlocksPerMultiprocessor(&per_cu, (const void*)mk_fwd, 512, LDS_BYTES) != hipSuccess || per_cu < 1) fprintf(stderr, "kernel_launch: occupancy query says %d\n", per_cu);
        (void)hipGetLastError();
        grid = cus;
    }
    if (grid < 0) return;
    (void)hipMemsetAsync((char*)d_ws + WS_CTL, 0, CTL_ZERO_BYTES, stream);
    Params p{};
    for (int i = 0; i < 25; ++i) p.in[i] = (const float*)d_in[i];
    p.out = (float*)d_out; p.ws = (unsigned char*)d_ws;
    for (int i = 0; i < 32; ++i) p.inv_rev[i] = pow(10000.0, -(double)i / 32.0) / (2.0 * 3.14159265358979323846);
    for (int h = 0; h < 4; ++h) p.lg2[h] = (float)log2(1.0 - pow(2.0, -5.0 - (double)h));
#if MK_ONE_LAUNCH
    p.ph_lo = 0; p.ph_hi = N_PHASES; p.use_bar = 1;
    hipLaunchKernelGGL(mk_fwd, dim3(grid), dim3(512), LDS_BYTES, stream, p);
#else
    for (int k = 0; k < N_PHASES; ++k) { p.ph_lo = k; p.ph_hi = k + 1; p.use_bar = 0;
        hipLaunchKernelGGL(mk_fwd, dim3(grid), dim3(512), LDS_BYTES, stream, p); }
#endif
}
```

```cpp
#include <hip/hip_runtime.h>
#include <cstdio>
#include <cstdint>
#include <cmath>
#define LAS __attribute__((address_space(3)))
namespace pg8 {
#define PG8_LAS __attribute__((address_space(3)))
typedef unsigned short bf16_t;
typedef short bf16x8 __attribute__((ext_vector_type(8)));
typedef float f32x4 __attribute__((ext_vector_type(4)));
typedef unsigned u32x4 __attribute__((ext_vector_type(4)));
constexpr int BM = 256, BK = 64, HALF = 128, HTB = HALF * BK * 2  , STAGE_BYTES = 8 * HTB, NXCD = 8, WGM = 8;

__host__ __device__ __forceinline__ int lds_byte(int r, int c) { const int st = (r >> 4) * 2 + (c >> 5), rr = r & 15, cc = c & 31, ob = rr * 64 + cc * 2; return st * 1024 + (ob ^ (((ob >> 9) & 1) << 5)); }
__host__ __device__ __forceinline__ void stage_rc(int b, int& R, int& C) { const int st = b / 1024, sb = b % 1024, swz = sb ^ (((sb >> 9) & 1) << 5); R = (st >> 1) * 16 + swz / 64; C = (st & 1) * 32 + (swz % 64) / 2; }
__host__ __device__ __forceinline__ int perm32(int rho) { const int n = rho >> 4, i = rho & 15; return 8 * (i >> 2) + 4 * n + (i & 3); }

struct Unit { int pm, pn; };
struct Gemm { const bf16_t* A; const bf16_t* Bt; int M, N, K; };

struct StaticOrder {
    int nM, nN, nwg, G, c;
    __host__ __device__ void init(int M, int N, int G_, int c_) { nM = M / BM; nN = N / BM; nwg = nM * nN; G = G_; c = c_; }
    __host__ __device__ bool next(int i, Unit& u) const {
        const long L = (long)i * G + c; if (L >= nwg) return false;
        int wgid = (int)L; { const int q = nwg / NXCD, r = nwg % NXCD, xcd = wgid % NXCD, off = wgid / NXCD; wgid = (xcd < r ? xcd * (q + 1) : r * (q + 1) + (xcd - r) * q) + off; }
        const int nig = WGM * nN, gid = wgid / nig, fm = gid * WGM, gsz = (nM - fm) < WGM ? (nM - fm) : WGM;
        u.pm = fm + ((wgid % nig) % gsz); u.pn = (wgid % nig) / gsz; return true;
    }
    __device__ __forceinline__ void a_ready(const Unit&) const {}
    __device__ __forceinline__ void done(const Unit&) const {}
};
__device__ __forceinline__ unsigned cvt_pk_bf16(float lo, float hi) { unsigned r; asm volatile("v_cvt_pk_bf16_f32 %0, %1, %2" : "=v"(r) : "v"(lo), "v"(hi)); return r; }
typedef float f32x2 __attribute__((ext_vector_type(2)));
__device__ __forceinline__ float gelu_tanh_f(float x) {
    const float u = 1.5957691216057308f * (x + 0.044715f * x * x * x);
    return x * __builtin_amdgcn_rcpf(1.0f + __expf(-u));
}
struct EpiH {
    static constexpr bool PERM = true, AFTER_DRAIN = false;
    bf16_t* O; int ldc; int act_lo, act_hi;
    __device__ __forceinline__ void operator()(const f32x4 (&acc)[2][2][4][2], const Unit& u, int wr, int wc, int fr, int fq) const {
        const int row0 = u.pm * BM + wr * 64 + fr; const int col0 = u.pn * BM + wc * 32 + 8 * fq;
        const bool act = (u.pn >= act_lo) && (u.pn < act_hi);
#pragma unroll
        for (int ai = 0; ai < 2; ++ai)
#pragma unroll
            for (int m = 0; m < 4; ++m) { bf16_t* rowp = O + (size_t)(row0 + ai * HALF + m * 16) * ldc + col0;
#pragma unroll
                for (int bj = 0; bj < 2; ++bj) { f32x4 v0 = acc[ai][bj][m][0], v1 = acc[ai][bj][m][1];
                    if (act) {
#pragma unroll
                        for (int j = 0; j < 4; ++j) { v0[j] = gelu_tanh_f(v0[j]); v1[j] = gelu_tanh_f(v1[j]); } }
                    u32x4 w; w.x = cvt_pk_bf16(v0[0], v0[1]); w.y = cvt_pk_bf16(v0[2], v0[3]); w.z = cvt_pk_bf16(v1[0], v1[1]); w.w = cvt_pk_bf16(v1[2], v1[3]);
                    *(u32x4*)(rowp + bj * HALF) = w; } }
    }
};
struct EpiRes {
    static constexpr bool PERM = false, AFTER_DRAIN = false;
    float* C; const float* X; int ldc; float alpha;
    __device__ __forceinline__ void operator()(const f32x4 (&acc)[2][2][4][2], const Unit& u, int wr, int wc, int fr, int fq) const {
        const int row0 = u.pm * BM + wr * 64 + fr, col0 = u.pn * BM + wc * 32 + 4 * fq;
#pragma unroll
        for (int ai = 0; ai < 2; ++ai)
#pragma unroll
            for (int m = 0; m < 4; ++m) { const size_t off = (size_t)(row0 + ai * HALF + m * 16) * ldc + col0;
#pragma unroll
                for (int bj = 0; bj < 2; ++bj)
#pragma unroll
                    for (int n = 0; n < 2; ++n) { const size_t o2 = off + bj * HALF + n * 16; const f32x4 xv = *(const f32x4*)(X + o2); *(f32x4*)(C + o2) = acc[ai][bj][m][n] + xv * alpha; } }
    }
};
struct EpiF32 {
    static constexpr bool PERM = false, AFTER_DRAIN = false;
    float* C; int ldc;
    __device__ __forceinline__ void operator()(const f32x4 (&acc)[2][2][4][2], const Unit& u, int wr, int wc, int fr, int fq) const {
        const int row0 = u.pm * BM + wr * 64 + fr, col0 = u.pn * BM + wc * 32 + 4 * fq;
#pragma unroll
        for (int ai = 0; ai < 2; ++ai)
#pragma unroll
            for (int m = 0; m < 4; ++m) { float* rowp = C + (size_t)(row0 + ai * HALF + m * 16) * ldc + col0;
#pragma unroll
                for (int bj = 0; bj < 2; ++bj)
#pragma unroll
                    for (int n = 0; n < 2; ++n) *(f32x4*)(rowp + bj * HALF + n * 16) = acc[ai][bj][m][n]; }
    }
};
template <class Epi, class Sched, bool ALIGN_EPI = false, bool SP2 = false>
__device__ __forceinline__ void gemm_phase(PG8_LAS unsigned char* lds, const Gemm g, const Sched& S, const Epi& E, const int tid) {
    const int wid = __builtin_amdgcn_readfirstlane(tid >> 6), lane = tid & 63, wr = wid >> 2, wc = wid & 3, fr = lane & 15, fq = lane >> 4;
    const int K = g.K, nt = K / BK;
    unsigned voffA[2], voffB[2];
#pragma unroll
    for (int i = 0; i < 2; ++i) { int R, C; stage_rc(tid * 16 + i * 8192, R, C); const int Rb = Epi::PERM ? ((R & ~31) + perm32(R & 31)) : R;
        voffA[i] = (unsigned)(R * K + C) * 2u; voffB[i] = (unsigned)(Rb * K + C) * 2u; }
    const size_t kstep = (size_t)(BK * 2);
    const size_t hstep = (size_t)HALF * K * 2;
    const size_t tstep = 2 * hstep;
    const unsigned ldsw = (unsigned)wid * 1024u;
    const int aoff = lds_byte(wr * 64 + fr, fq * 8), boff = lds_byte(wc * 32 + fr, fq * 8);
#define PG8_SA(b, h) (((b) * 2 + (h)) * HTB)
#define PG8_SB(b, h) ((4 + (b) * 2 + (h)) * HTB)
#define PG8_STAGE(bufoff, gbase, voff) do { _Pragma("unroll") for (int _i = 0; _i < 2; ++_i) \
        __builtin_amdgcn_global_load_lds((const unsigned*)((const char*)(gbase) + (voff)[_i]), (PG8_LAS unsigned*)(lds + (bufoff) + ldsw + _i * 8192), 16, 0, 0); } while (0)
#define PG8_LDA(dst, b, h) do { _Pragma("unroll") for (int m = 0; m < 4; ++m) _Pragma("unroll") for (int k = 0; k < 2; ++k) dst[m][k] = *(const PG8_LAS bf16x8*)(lds + PG8_SA(b, h) + aoff + m * 2048 + k * 1024); } while (0)
#define PG8_LDB(dst, b, h) do { _Pragma("unroll") for (int n = 0; n < 2; ++n) _Pragma("unroll") for (int k = 0; k < 2; ++k) dst[n][k] = *(const PG8_LAS bf16x8*)(lds + PG8_SB(b, h) + boff + n * 2048 + k * 1024); } while (0)
#define PG8_MMA(ai, bj, At, Bt) do { __builtin_amdgcn_s_setprio(1); _Pragma("unroll") for (int m = 0; m < 4; ++m) _Pragma("unroll") for (int n = 0; n < 2; ++n) _Pragma("unroll") for (int k = 0; k < 2; ++k) \
        acc[ai][bj][m][n] = __builtin_amdgcn_mfma_f32_16x16x32_bf16(Bt[n][k], At[m][k], acc[ai][bj][m][n], 0, 0, 0); __builtin_amdgcn_s_setprio(0); } while (0)
#define PG8_WAIT_V(n) asm volatile("s_waitcnt vmcnt(" #n ")" ::: "memory")
#define PG8_WAIT_L(n) asm volatile("s_waitcnt lgkmcnt(" #n ")" ::: "memory")
#define PG8_BAR __builtin_amdgcn_s_barrier()
#define PG8_SCHED __builtin_amdgcn_sched_barrier(0)
    Unit cur, nxt; int ui = 0;
    if (!S.next(0, cur)) return;
    f32x4 acc[2][2][4][2];
#pragma unroll
    for (int a = 0; a < 2; ++a)
#pragma unroll
        for (int b = 0; b < 2; ++b)
#pragma unroll
            for (int m = 0; m < 4; ++m)
#pragma unroll
                for (int n = 0; n < 2; ++n) acc[a][b][m][n] = (f32x4){0.f, 0.f, 0.f, 0.f};
    bf16x8 At[4][2], B0[2][2], B1[2][2];
    const char* cA = (const char*)g.A + (size_t)cur.pm * tstep; const char* cB = (const char*)g.Bt + (size_t)cur.pn * tstep;
    S.a_ready(cur);
    if constexpr (SP2) {
        PG8_STAGE(PG8_SB(0, 0), cB, voffB); PG8_STAGE(PG8_SB(0, 1), cB + hstep, voffB); PG8_STAGE(PG8_SA(0, 0), cA, voffA); PG8_STAGE(PG8_SA(0, 1), cA + hstep, voffA);
        if (wr == 1) PG8_BAR;
        PG8_WAIT_V(2); PG8_BAR;
        PG8_STAGE(PG8_SB(1, 0), cB + kstep, voffB); PG8_STAGE(PG8_SA(1, 0), cA + kstep, voffA); PG8_STAGE(PG8_SB(1, 1), cB + hstep + kstep, voffB);
        PG8_WAIT_V(6); PG8_BAR;
    } else {
        PG8_STAGE(PG8_SB(0, 0), cB, voffB); PG8_STAGE(PG8_SA(0, 0), cA, voffA); PG8_STAGE(PG8_SB(0, 1), cB + hstep, voffB); PG8_STAGE(PG8_SA(0, 1), cA + hstep, voffA);
        if (wr == 1) PG8_BAR;
        PG8_WAIT_V(4); PG8_BAR;
        PG8_STAGE(PG8_SB(1, 0), cB + kstep, voffB); PG8_STAGE(PG8_SA(1, 0), cA + kstep, voffA); PG8_STAGE(PG8_SB(1, 1), cB + hstep + kstep, voffB);
        PG8_WAIT_V(6); PG8_BAR;
    }
    for (;;) {
        const bool has_next = S.next(ui + 1, nxt);
        const char* nA = has_next ? (const char*)g.A + (size_t)nxt.pm * tstep : cA; const char* nB = has_next ? (const char*)g.Bt + (size_t)nxt.pn * tstep : cB;
        for (int t = 0; t < nt; t += 2) {
            const bool last = (t == nt - 2);
            const char* a1 = cA + (size_t)(t + 1) * kstep;
            const char* a2 = last ? nA : cA + (size_t)(t + 2) * kstep; const char* b2 = last ? nB : cB + (size_t)(t + 2) * kstep;
            const char* a3 = a2 + kstep; const char* b3 = b2 + kstep;
            if (last && has_next) S.a_ready(nxt);
            if constexpr (SP2) {
            PG8_LDB(B0, 0, 0); PG8_LDB(B1, 0, 1); PG8_SCHED; PG8_LDA(At, 0, 0); PG8_STAGE(PG8_SA(1, 1), a1 + hstep, voffA);
            PG8_WAIT_V(8); PG8_WAIT_L(0); PG8_BAR; PG8_MMA(0, 0, At, B0); PG8_MMA(0, 1, At, B1); PG8_BAR; PG8_SCHED;
            PG8_LDA(At, 0, 1); PG8_STAGE(PG8_SB(0, 0), b2, voffB); PG8_STAGE(PG8_SB(0, 1), b2 + hstep, voffB); PG8_STAGE(PG8_SA(0, 0), a2, voffA);
            PG8_WAIT_V(8); PG8_WAIT_L(0); PG8_BAR; PG8_MMA(1, 0, At, B0); PG8_MMA(1, 1, At, B1); PG8_BAR; PG8_SCHED;
            PG8_LDB(B0, 1, 0); PG8_LDB(B1, 1, 1); PG8_SCHED; PG8_LDA(At, 1, 0); PG8_STAGE(PG8_SA(0, 1), a2 + hstep, voffA);
            PG8_WAIT_V(8); PG8_WAIT_L(0); PG8_BAR; PG8_MMA(0, 0, At, B0); PG8_MMA(0, 1, At, B1); PG8_BAR; PG8_SCHED;
            PG8_LDA(At, 1, 1); PG8_STAGE(PG8_SB(1, 0), b3, voffB); PG8_STAGE(PG8_SB(1, 1), b3 + hstep, voffB); PG8_STAGE(PG8_SA(1, 0), a3, voffA);
            PG8_WAIT_V(8); PG8_WAIT_L(0); PG8_BAR; PG8_MMA(1, 0, At, B0); PG8_MMA(1, 1, At, B1); PG8_BAR; PG8_SCHED;
            } else {
            PG8_LDB(B0, 0, 0); PG8_SCHED; PG8_LDA(At, 0, 0); PG8_STAGE(PG8_SA(1, 1), a1 + hstep, voffA);
            PG8_WAIT_L(8); PG8_BAR; PG8_WAIT_L(0); PG8_MMA(0, 0, At, B0); PG8_BAR; PG8_SCHED;
            PG8_LDB(B1, 0, 1); PG8_STAGE(PG8_SB(0, 0), b2, voffB);
            PG8_BAR; PG8_WAIT_L(0); PG8_MMA(0, 1, At, B1); PG8_BAR;
            PG8_LDA(At, 0, 1); PG8_STAGE(PG8_SA(0, 0), a2, voffA);
            PG8_BAR; PG8_WAIT_L(0); PG8_MMA(1, 0, At, B0); PG8_BAR; PG8_SCHED;
            PG8_STAGE(PG8_SB(0, 1), b2 + hstep, voffB);
            PG8_WAIT_V(6); PG8_BAR; PG8_MMA(1, 1, At, B1); PG8_BAR;
            PG8_LDB(B0, 1, 0); PG8_SCHED; PG8_LDA(At, 1, 0); PG8_STAGE(PG8_SA(0, 1), a2 + hstep, voffA);
            PG8_WAIT_L(8); PG8_BAR; PG8_WAIT_L(0); PG8_MMA(0, 0, At, B0); PG8_BAR; PG8_SCHED;
            PG8_LDB(B1, 1, 1); PG8_STAGE(PG8_SB(1, 0), b3, voffB);
            PG8_BAR; PG8_WAIT_L(0); PG8_MMA(0, 1, At, B1); PG8_BAR;
            PG8_LDA(At, 1, 1); PG8_STAGE(PG8_SA(1, 0), a3, voffA);
            PG8_BAR; PG8_WAIT_L(0); PG8_MMA(1, 0, At, B0); PG8_BAR; PG8_SCHED;
            PG8_STAGE(PG8_SB(1, 1), b3 + hstep, voffB);
            PG8_WAIT_V(6); PG8_BAR; PG8_MMA(1, 1, At, B1); PG8_BAR;
            }
        }
        if constexpr (ALIGN_EPI) { if (wr == 0) PG8_BAR; }
        if constexpr (!Epi::AFTER_DRAIN) { E(acc, cur, wr, wc, fr, fq); S.done(cur); }
        if (!has_next) break;
#pragma unroll
        for (int a = 0; a < 2; ++a)
#pragma unroll
            for (int b = 0; b < 2; ++b)
#pragma unroll
                for (int m = 0; m < 4; ++m)
#pragma unroll
                    for (int n = 0; n < 2; ++n) acc[a][b][m][n] = (f32x4){0.f, 0.f, 0.f, 0.f};
        cur = nxt; cA = nA; cB = nB; ++ui;
        if constexpr (ALIGN_EPI) { if (wr == 1) PG8_BAR; }
    }
    PG8_WAIT_V(0);
    if constexpr (!ALIGN_EPI) { if (wr == 0) PG8_BAR; }
    PG8_BAR;
    if constexpr (Epi::AFTER_DRAIN) { E.fused(acc, cur, wr, wc, fr, fq, lds, wid, lane); S.done(cur); }
#undef PG8_SA
#undef PG8_SB
#undef PG8_STAGE
#undef PG8_LDA
#undef PG8_LDB
#undef PG8_MMA
#undef PG8_WAIT_V
#undef PG8_WAIT_L
#undef PG8_BAR
#undef PG8_SCHED
}
}
#define XB_TMO      128
#define XB_XCNT(j)  (256  + 64 * (j))
#define XB_XSUB(j)  (1280 + 64 * (j))
#define XB_XGEN(j)  (2304 + 64 * (j))
#define XB_TOP      3328
#define XB_TOPGEN   3392
#define XCD_BAR_WORDS 3456
#define XB_SPIN_CAP (1u << 18)

__device__ __forceinline__ unsigned xb_ld(unsigned* p)              { return __hip_atomic_load(p, __ATOMIC_RELAXED, __HIP_MEMORY_SCOPE_AGENT); }
__device__ __forceinline__ unsigned xb_add(unsigned* p, unsigned v) { return __hip_atomic_fetch_add(p, v, __ATOMIC_RELAXED, __HIP_MEMORY_SCOPE_AGENT); }
__device__ __forceinline__ unsigned xb_xcc_id() { return (unsigned)__builtin_amdgcn_s_getreg((3 << 11) | 20) & 0xFu; }
#define XB_SPIN(cond, bar) do { unsigned _sp = 0; while (cond) { __builtin_amdgcn_s_sleep(1); \
    if ((++_sp & 255u) == 0u) { if (xb_ld(&(bar)[XB_TMO])) break; if (_sp > XB_SPIN_CAP) { atomicAdd(&(bar)[XB_TMO], 1u); break; } } } } while (0)

struct XcdBarrier {
    unsigned* bar; unsigned x; unsigned w0;
    volatile LAS unsigned* st;
};

__device__ __forceinline__ bool xb_tid0(unsigned w0) { return w0 != 0u && __builtin_amdgcn_mbcnt_hi(0xffffffffu, __builtin_amdgcn_mbcnt_lo(0xffffffffu, 0u)) == 0u; }
__device__ __forceinline__ XcdBarrier xcd_barrier_post(unsigned* bar, volatile LAS unsigned* st) {
    XcdBarrier b; b.bar = bar; b.x = xb_xcc_id(); b.st = st; b.w0 = (__builtin_amdgcn_readfirstlane(threadIdx.x >> 6) == 0) ? 1u : 0u;
    if (threadIdx.x == 0) (void)xb_add(&bar[XB_XCNT(b.x)], 1u);
    return b;
}
__device__ __forceinline__ void xcd_barrier_complete(unsigned* bar, unsigned x, unsigned& nloc, unsigned& nx) {
    const unsigned G = gridDim.x * gridDim.y * gridDim.z;
    unsigned sum, cnt, mine, sp = 0u;
    for (;;) {
        sum = 0u; cnt = 0u; mine = 0u;
#pragma unroll
        for (unsigned j = 0; j < 16; ++j) { const unsigned c = xb_ld(&bar[XB_XCNT(j)]); sum += c; cnt += (c > 0u) ? 1u : 0u; mine = (j == x) ? c : mine; }
        if (sum == G) break;
        __builtin_amdgcn_s_sleep(1);
        if ((++sp & 255u) == 0u) { if (xb_ld(&bar[XB_TMO])) break; if (sp > XB_SPIN_CAP) { atomicAdd(&bar[XB_TMO], 1u); break; } }
    }
    nloc = mine > 0u ? mine : 1u; nx = cnt > 0u ? cnt : 1u;
}

__device__ __forceinline__ void xcd_barrier(const XcdBarrier& b) {
    asm volatile("s_waitcnt vmcnt(0)" ::: "memory");
    __syncthreads();
    if (xb_tid0(b.w0)) {
        unsigned* bar = b.bar;
        __builtin_amdgcn_s_waitcnt(0);
        unsigned nloc = b.st[0], nx = b.st[1];
        if (nloc == 0u) { xcd_barrier_complete(bar, b.x, nloc, nx); b.st[0] = nloc; b.st[1] = nx; }
        const unsigned old = xb_add(&bar[XB_XSUB(b.x)], 1u);
        const unsigned gen = old / nloc;
        if (old + 1u == (gen + 1u) * nloc) {
            __builtin_amdgcn_fence(__ATOMIC_RELEASE, "agent");
            asm volatile("s_waitcnt vmcnt(0)" ::: "memory");
            const unsigned og = xb_add(&bar[XB_TOP], 1u);
            const unsigned tg = og / nx;
            if (og + 1u == (tg + 1u) * nx) xb_add(&bar[XB_TOPGEN], 1u);
            else XB_SPIN(xb_ld(&bar[XB_TOPGEN]) == tg, bar);
            __builtin_amdgcn_fence(__ATOMIC_ACQUIRE, "agent");
            xb_add(&bar[XB_XGEN(b.x)], 1u);
            asm volatile("s_waitcnt vmcnt(0)" ::: "memory");
        } else {
            XB_SPIN(xb_ld(&bar[XB_XGEN(b.x)]) == gen, bar);
            __builtin_amdgcn_fence(__ATOMIC_ACQUIRE, "agent");
            asm volatile("s_waitcnt vmcnt(0)" ::: "memory");
        }
    }
    __syncthreads();
}

#ifndef PROBE_DUP
#define PROBE_DUP -1
#endif
#define REP(i) for (int rep_ = 0; rep_ < ((PROBE_DUP == (i)) ? 2 : 1); ++rep_)
constexpr int NB = 4, T = 2048, D = 2048, NTOK = NB * T, DEPTH = 4;
constexpr int INW = 5168, INWP = 5376;
constexpr int C_RQ = 0, C_RK = 256, C_RV = 512, C_RG = 1024, C_SU = 1536, C_SV = 2048, C_NQ = 2560, C_KC = 3584, C_VC = 3840, C_KS = 4096, C_VS = 4352, C_KW = 4608, C_VW = 4864, C_NG = 5120;
constexpr float ALPHA = 1.6817928305074290f;
constexpr float LN_EPS = 1e-5f;
constexpr float LOG2E = 1.4426950408889634f;

constexpr size_t MiB = (size_t)1 << 20;
constexpr size_t WS_CTL = 0, CTL_ZERO_BYTES = 1 * MiB;
constexpr size_t WS_ROPE = 1 * MiB;
constexpr size_t WS_WIN = 2 * MiB;
constexpr size_t WS_WOUT = 86 * MiB;
constexpr size_t WS_WQ = 118 * MiB;
constexpr size_t WS_PU = 160 * MiB;
constexpr size_t WS_PV = 416 * MiB;
constexpr size_t WS_H = 672 * MiB;
constexpr size_t WS_YMIX = 756 * MiB;
constexpr size_t WS_MIXED = 820 * MiB;
constexpr size_t WS_Z = 852 * MiB;
constexpr size_t WS_X1 = 916 * MiB;
constexpr size_t WS_X1B = 980 * MiB;
constexpr size_t WS_QP = 1012 * MiB;
constexpr size_t WS_XC = 1076 * MiB;
constexpr size_t WS_XB = 1140 * MiB;
constexpr size_t WS_KC = 1172 * MiB;
constexpr size_t WS_KVST = 1174 * MiB;
constexpr size_t WS_SC = 1184 * MiB;
constexpr size_t WS_PSC = 1248 * MiB;
constexpr size_t WS_W1T = 1250 * MiB;
constexpr size_t WS_W2T = 1258 * MiB;
constexpr size_t WS_PKB = 1260 * MiB;
#ifndef PEER_NBKT
#define PEER_NBKT 8
#endif
#ifndef PEER_PG
#define PEER_PG 4
#endif
constexpr int PG = PEER_PG;
constexpr int NBKT = PEER_NBKT, NRND = NBKT / 8, FCAP = 4096, BSH = (NBKT == 16) ? 10 : 11;
constexpr size_t WS_FE = 1262 * MiB;
constexpr size_t WS_FW = 1326 * MiB;
constexpr size_t WS_FHW = 1390 * MiB;
constexpr size_t WS_GST = 1454 * MiB;
constexpr size_t WS_PART = 1456 * MiB;
constexpr size_t WS_X1Q = 1712 * MiB;
constexpr size_t WS_XSC = 1728 * MiB;
constexpr size_t WS_END = 1730 * MiB;
constexpr int CW_BAR = 4096;

constexpr int LDS_BYTES = 147456;
constexpr int MISC_OFF = 143360;

#define GAS __attribute__((address_space(1)))
typedef float f4 __attribute__((ext_vector_type(4)));
typedef float f2 __attribute__((ext_vector_type(2)));
typedef unsigned u4 __attribute__((ext_vector_type(4)));
typedef unsigned u2 __attribute__((ext_vector_type(2)));
__device__ __forceinline__ f4 mk_f4(float a, float b, float c, float d) { f4 r; r.x = a; r.y = b; r.z = c; r.w = d; return r; }
__device__ __forceinline__ f2 mk_f2(float a, float b) { f2 r; r.x = a; r.y = b; return r; }
__device__ __forceinline__ u2 mk_u2(unsigned a, unsigned b) { u2 r; r.x = a; r.y = b; return r; }
typedef unsigned short bf16;
#define LDS_WAIT() asm volatile("s_waitcnt lgkmcnt(0)" ::: "memory")
#define VM_WAIT() asm volatile("s_waitcnt vmcnt(0)" ::: "memory")

struct Params {
    const float* in[25];
    float* out;
    unsigned char* ws;
    double inv_rev[32];
    float lg2[4];
    int ph_lo, ph_hi, use_bar, pad0;
};

__device__ __forceinline__ float bf2f(unsigned short b) { return __uint_as_float(((unsigned)b) << 16); }
__device__ __forceinline__ unsigned f2bf(float f) { unsigned u = __float_as_uint(f); return (u + 0x7fffu + ((u >> 16) & 1u)) >> 16; }
__device__ __forceinline__ unsigned pk2(float lo, float hi) { return f2bf(lo) | (f2bf(hi) << 16); }
__device__ __forceinline__ float wave_sum(float v) {
#pragma unroll
    for (int o = 1; o < 64; o <<= 1) v += __shfl_xor(v, o);
    return v;
}
__device__ __forceinline__ void unpack8(const u4& v, float* f) {
    f[0] = __uint_as_float(v.x << 16); f[1] = __uint_as_float(v.x & 0xffff0000u);
    f[2] = __uint_as_float(v.y << 16); f[3] = __uint_as_float(v.y & 0xffff0000u);
    f[4] = __uint_as_float(v.z << 16); f[5] = __uint_as_float(v.z & 0xffff0000u);
    f[6] = __uint_as_float(v.w << 16); f[7] = __uint_as_float(v.w & 0xffff0000u);
}
__device__ __forceinline__ float gelu_tanh(float x) { return pg8::gelu_tanh_f(x); }

__device__ __forceinline__ void transpose_tile(const float* __restrict__ W, int K, int N, bf16* __restrict__ WT, LAS float* scr, int kb, int nb, int lane) {
    const int k0 = kb * 64, n0 = nb * 32, rsub = lane >> 3, c4 = (lane & 7) * 4; const bool ok = (n0 + c4) < N;
    f4 v[8];
#pragma unroll
    for (int i = 0; i < 8; ++i) v[i] = ok ? *(const f4*)(W + (size_t)(k0 + 8 * i + rsub) * N + n0 + c4) : mk_f4(0.f, 0.f, 0.f, 0.f);
#pragma unroll
    for (int i = 0; i < 8; ++i) { LAS float* d = scr + (8 * i + rsub) * 33 + c4; d[0] = v[i].x; d[1] = v[i].y; d[2] = v[i].z; d[3] = v[i].w; }
    LDS_WAIT();
    const int c = lane & 7;
#pragma unroll
    for (int j = 0; j < 4; ++j) { const int n = (lane >> 3) + 8 * j; const LAS float* s = scr + (8 * c) * 33 + n;
        u4 o; o.x = pk2(s[0 * 33], s[1 * 33]); o.y = pk2(s[2 * 33], s[3 * 33]); o.z = pk2(s[4 * 33], s[5 * 33]); o.w = pk2(s[6 * 33], s[7 * 33]);
        *(u4*)(WT + (size_t)(n0 + n) * K + k0 + 8 * c) = o; }
    LDS_WAIT();
}
__device__ __forceinline__ void cvt_bf16_stream(const float* __restrict__ src, bf16* __restrict__ dst, size_t nchunks, size_t gt, size_t GT) {
    for (size_t c = gt; c < nchunks; c += GT) { const f4 a = ((const f4*)src)[2 * c], b = ((const f4*)src)[2 * c + 1];
        u4 o; o.x = pk2(a.x, a.y); o.y = pk2(a.z, a.w); o.z = pk2(b.x, b.y); o.w = pk2(b.z, b.w); ((u4*)dst)[c] = o; }
}
__device__ __forceinline__ void phase_prologue(const Params& P, unsigned char* ws, LAS unsigned char* lds, int tid, int lane, int wave) {
    LAS float* scr = (LAS float*)(lds + wave * 8704);
    const int gw = blockIdx.x * 8 + wave, NGW = gridDim.x * 8;
    constexpr int I_IN = 32 * 168, I_SQ = 32 * 64, I_L = I_IN + 2 * I_SQ;
    REP(21) for (int it = gw; it < DEPTH * I_L; it += NGW) {
        const int l = it / I_L; int r = it % I_L;
        if (r < I_IN) transpose_tile(P.in[1] + (size_t)l * D * INW, D, INW, (bf16*)(ws + WS_WIN) + (size_t)l * INWP * D, scr, r / 168, r % 168, lane);
        else { r -= I_IN;
            if (r < I_SQ) transpose_tile(P.in[15] + (size_t)l * D * D, D, D, (bf16*)(ws + WS_WOUT) + (size_t)l * D * D, scr, r / 64, r % 64, lane);
            else { r -= I_SQ; transpose_tile(P.in[18] + (size_t)l * D * D, D, D, (bf16*)(ws + WS_WQ) + (size_t)l * D * D, scr, r / 64, r % 64, lane); } }
    }
    for (int it = gw; it < DEPTH * 2 * (32 * 8 + 4 * 2); it += NGW) {
        const int lk = it / 264, r = it % 264, l = lk >> 1, kv = lk & 1;
        if (r < 256) transpose_tile(P.in[kv ? 12 : 9] + (size_t)l * 2048 * 256, 2048, 256, (bf16*)(ws + WS_W1T) + (size_t)lk * 256 * 2048, scr, r >> 3, r & 7, lane);
        else transpose_tile(P.in[kv ? 13 : 10] + (size_t)l * 256 * 64, 256, 64, (bf16*)(ws + WS_W2T) + (size_t)lk * 64 * 256, scr, (r - 256) >> 1, (r - 256) & 1, lane);
    }
    const size_t gt = (size_t)blockIdx.x * 512 + tid, GT = (size_t)gridDim.x * 512;
    REP(22) for (int row = gw; row < 2 * DEPTH * 16384; row += NGW) {
        const int tab = row / (DEPTH * 16384), rr = row % (DEPTH * 16384);
        const float* src = P.in[21 + tab] + (size_t)rr * 2048;
        f4 v[8]; float am = 0.f;
#pragma unroll
        for (int j = 0; j < 2; ++j)
#pragma unroll
            for (int q = 0; q < 4; ++q) { const f4 a = *(const f4*)(src + 1024 * j + 16 * lane + 4 * q); v[4 * j + q] = a; am = fmaxf(am, fmaxf(fmaxf(fabsf(a.x), fabsf(a.y)), fmaxf(fabsf(a.z), fabsf(a.w)))); }
#pragma unroll
        for (int o = 1; o < 64; o <<= 1) am = fmaxf(am, __shfl_xor(am, o));
        unsigned char* dst = ws + (tab ? WS_PV : WS_PU) + (size_t)rr * 2048;
        if (tab) {
            const float sc = (am > 0.f) ? 448.f / am : 1.f;
            if (lane == 0) ((float*)(ws + WS_PSC))[row] = (am > 0.f) ? am * (1.f / 448.f) : 1.f;
#pragma unroll
            for (int j = 0; j < 2; ++j) { u4 w;
#pragma unroll
                for (int q = 0; q < 4; ++q) { const f4 a = v[4 * j + q]; int r = __builtin_amdgcn_cvt_pk_fp8_f32(a.x * sc, a.y * sc, 0, false); r = __builtin_amdgcn_cvt_pk_fp8_f32(a.z * sc, a.w * sc, r, true); w[q] = (unsigned)r; }
                *(u4*)(dst + 1024 * j + 16 * lane) = w; }
        } else {
            const float sc = (am > 0.f) ? 127.f / am : 1.f;
            if (lane == 0) ((float*)(ws + WS_PSC))[row] = (am > 0.f) ? am * (1.f / 127.f) : 1.f;
#pragma unroll
            for (int j = 0; j < 2; ++j) { u4 w;
#pragma unroll
                for (int q = 0; q < 4; ++q) { const f4 a = v[4 * j + q];
                    const int b0 = (int)rintf(a.x * sc), b1 = (int)rintf(a.y * sc), b2 = (int)rintf(a.z * sc), b3 = (int)rintf(a.w * sc);
                    w[q] = (unsigned)(b0 & 0xff) | ((unsigned)(b1 & 0xff) << 8) | ((unsigned)(b2 & 0xff) << 16) | ((unsigned)b3 << 24); }
                *(u4*)(dst + 1024 * j + 16 * lane) = w; }
        }
    }
    cvt_bf16_stream(P.in[0], (bf16*)(ws + WS_XB), (size_t)NTOK * D / 8, gt, GT);
    cvt_bf16_stream(P.in[19], (bf16*)(ws + WS_PKB), (size_t)DEPTH * 8 * 128 * 128 / 8, gt, GT);
    cvt_bf16_stream(P.in[20], (bf16*)(ws + WS_PKB) + (size_t)DEPTH * 8 * 128 * 128, (size_t)DEPTH * 8 * 128 * 128 / 8, gt, GT);
    f2* rope = (f2*)(ws + WS_ROPE);
    for (size_t idx = gt; idx < (size_t)T * 32; idx += GT) { const int t = (int)(idx >> 5), i = (int)(idx & 31);
        double a = (double)t * P.inv_rev[i]; a -= floor(a); const float fr = (float)a;
        rope[idx] = mk_f2(__builtin_amdgcn_cosf(fr), __builtin_amdgcn_sinf(fr)); }
}

__device__ __forceinline__ void stage_rot_k(const bf16* __restrict__ Hb, const f2* __restrict__ rope, LAS float* ks, int tok0, int tpos0, int colK, float lg2h, bool zeta, int tid) {
    const int m = tid >> 2, p = tid & 3;
    const bf16* src = Hb + (size_t)(tok0 + m) * INWP + colK + p * 8;
    const u4 a = *(const u4*)src, b = *(const u4*)(src + 32);
    float x1[8], x2[8]; unpack8(a, x1); unpack8(b, x2);
    const f4* rp = (const f4*)(rope + (size_t)(tpos0 + m) * 32 + p * 8);
    const f4 r0 = rp[0], r1 = rp[1], r2 = rp[2], r3 = rp[3];
    const float cs[8] = {r0.x, r0.z, r1.x, r1.z, r2.x, r2.z, r3.x, r3.z}, sn[8] = {r0.y, r0.w, r1.y, r1.w, r2.y, r2.w, r3.y, r3.w};
    const float sc = 0.125f * (zeta ? exp2f(lg2h * (float)(127 - m)) : 1.0f);
    float o1[8], o2[8];
#pragma unroll
    for (int i = 0; i < 8; ++i) { o1[i] = (x1[i] * cs[i] - x2[i] * sn[i]) * sc; o2[i] = (x1[i] * sn[i] + x2[i] * cs[i]) * sc; }
    LAS f4* d1 = (LAS f4*)(ks + m * 64 + p * 8); LAS f4* d2 = (LAS f4*)(ks + m * 64 + 32 + p * 8);
    d1[0] = mk_f4(o1[0], o1[1], o1[2], o1[3]); d1[1] = mk_f4(o1[4], o1[5], o1[6], o1[7]);
    d2[0] = mk_f4(o2[0], o2[1], o2[2], o2[3]); d2[1] = mk_f4(o2[4], o2[5], o2[6], o2[7]);
}
__device__ __forceinline__ void stage_v128(const bf16* __restrict__ Hb, LAS float* vs, int tok0, int colV, int tid) {
    const int m = tid >> 2, p = tid & 3;
    const u4* src = (const u4*)(Hb + (size_t)(tok0 + m) * INWP + colV + p * 32);
    LAS f4* dst = (LAS f4*)(vs + m * 128 + p * 32);
#pragma unroll
    for (int j = 0; j < 4; ++j) { const u4 a = src[j]; float f[8]; unpack8(a, f); dst[2 * j] = mk_f4(f[0], f[1], f[2], f[3]); dst[2 * j + 1] = mk_f4(f[4], f[5], f[6], f[7]); }
}

__device__ __forceinline__ void unit_kvstate(const Params& P, unsigned char* ws, LAS unsigned char* lds, int u, int tid) {
    const int b = u / 60, r = u % 60, h = r / 15, j = r % 15;
    const bf16* Hb = (const bf16*)(ws + WS_H); const f2* rope = (const f2*)(ws + WS_ROPE);
    LAS float* ks = (LAS float*)lds; LAS float* vs = (LAS float*)(lds + 32768);
    const int tok0 = b * T + j * 128;
    stage_rot_k(Hb, rope, ks, tok0, j * 128, C_RK + h * 64, P.lg2[h], true, tid);
    stage_v128(Hb, vs, tok0, C_RV + h * 128, tid);
    __syncthreads();
    const int d = tid >> 3, e0 = (tid & 7) * 16;
    float acc[16];
#pragma unroll
    for (int i = 0; i < 16; ++i) acc[i] = 0.f;
    #pragma unroll 1
    for (int m = 0; m < 128; ++m) { const float kd = ks[m * 64 + d]; const LAS f4* vp = (const LAS f4*)(vs + m * 128 + e0);
#pragma unroll
        for (int q = 0; q < 4; ++q) { const f4 v = vp[q]; acc[4 * q] += kd * v.x; acc[4 * q + 1] += kd * v.y; acc[4 * q + 2] += kd * v.z; acc[4 * q + 3] += kd * v.w; } }
    f4* dst = (f4*)((float*)(ws + WS_KVST) + ((size_t)((b * 4 + h) * 16 + j) * 64 + d) * 128 + e0);
#pragma unroll
    for (int q = 0; q < 4; ++q) dst[q] = mk_f4(acc[4 * q], acc[4 * q + 1], acc[4 * q + 2], acc[4 * q + 3]);
    __syncthreads();
}

__device__ __forceinline__ void unit_sgu(const Params& P, unsigned char* ws, int l, LAS unsigned char* lds, int u, int tid, int lane, int wave) {
    const int b = u >> 6, c = (u >> 2) & 15, g = u & 3;
    const bf16* Hb = (const bf16*)(ws + WS_H);
    LAS float* vn = (LAS float*)lds;
    LAS float* wsm = (LAS float*)(lds + 65536);
    const int tok0 = b * T + c * 128;
    const float* lng = P.in[4] + l * 512 + g * 128; const float* lnb = P.in[5] + l * 512 + g * 128;
    const float g0 = lng[2 * lane], g1 = lng[2 * lane + 1], b0 = lnb[2 * lane], b1 = lnb[2 * lane + 1];
    for (int i = 0; i < 16; ++i) { const int s = wave * 16 + i;
        const unsigned pr = *(const unsigned*)(Hb + (size_t)(tok0 + s) * INWP + C_SV + g * 128 + 2 * lane);
        const float v0 = __uint_as_float(pr << 16), v1 = __uint_as_float(pr & 0xffff0000u);
        const float mu = wave_sum(v0 + v1) * (1.f / 128.f); const float d0 = v0 - mu, d1 = v1 - mu;
        const float var = wave_sum(d0 * d0 + d1 * d1) * (1.f / 128.f); const float rstd = rsqrtf(var + LN_EPS);
        *(LAS f2*)(vn + s * 128 + 2 * lane) = mk_f2(d0 * rstd * g0 + b0, d1 * rstd * g1 + b1); }
    const float* wg = P.in[6] + ((size_t)l * 4 + g) * 16384;
    for (int i = 0; i < 32; ++i) { const int idx = tid + 512 * i; wsm[(idx >> 7) * 129 + (idx & 127)] = wg[idx]; }
    __syncthreads();
    const int t = tid >> 2, dg = tid & 3; const int smax = (t | 15);
    float acc[32];
#pragma unroll
    for (int i = 0; i < 32; ++i) acc[i] = 0.f;
    #pragma unroll 1
    for (int s = 0; s <= smax; ++s) { const float wv = (s <= t) ? wsm[t * 129 + s] : 0.f; const LAS f4* vp = (const LAS f4*)(vn + s * 128 + dg * 32);
#pragma unroll
        for (int q = 0; q < 8; ++q) { const f4 v = vp[q]; acc[4 * q] += wv * v.x; acc[4 * q + 1] += wv * v.y; acc[4 * q + 2] += wv * v.z; acc[4 * q + 3] += wv * v.w; } }
    const float bs = P.in[7][(l * 4 + g) * 128 + t];
    const u4* up = (const u4*)(Hb + (size_t)(tok0 + t) * INWP + C_SU + g * 128 + dg * 32);
    f4* yo = (f4*)((float*)(ws + WS_YMIX) + (size_t)(tok0 + t) * D + 512 + g * 128 + dg * 32);
#pragma unroll
    for (int j = 0; j < 4; ++j) { const u4 a = up[j]; float f[8]; unpack8(a, f);
        yo[2 * j] = mk_f4(f[0] * (acc[8 * j] + bs), f[1] * (acc[8 * j + 1] + bs), f[2] * (acc[8 * j + 2] + bs), f[3] * (acc[8 * j + 3] + bs));
        yo[2 * j + 1] = mk_f4(f[4] * (acc[8 * j + 4] + bs), f[5] * (acc[8 * j + 5] + bs), f[6] * (acc[8 * j + 6] + bs), f[7] * (acc[8 * j + 7] + bs)); }
    __syncthreads();
}

__device__ __forceinline__ void unit_compress(const Params& P, unsigned char* ws, int l, LAS unsigned char* lds, int u, int tid) {
    const int kv = u >> 7, b = (u >> 5) & 3, g = (u >> 3) & 3, r = u & 7;
    const bf16* Hb = (const bf16*)(ws + WS_H);
    LAS float* seg = (LAS float*)lds;
    LAS float* hid = (LAS float*)(lds + 69632);
    const int col0 = (kv ? C_VC : C_KC) + g * 64;
    const float* pe = P.in[kv ? 11 : 8] + (size_t)l * 2048;
    const float* w1 = P.in[kv ? 12 : 9] + (size_t)l * 2048 * 256;
    const float* w2 = P.in[kv ? 13 : 10] + (size_t)l * 256 * 64;
    for (int idx = tid; idx < 272 * 8; idx += 512) { const int tt = idx >> 3, d8 = (idx & 7) * 8; const int t = 256 * r + tt;
        float f[8];
        if (t < T) { const u4 a = *(const u4*)(Hb + (size_t)(b * T + t) * INWP + col0 + d8); unpack8(a, f); }
        else {
#pragma unroll
            for (int i = 0; i < 8; ++i) f[i] = 0.f; }
        LAS f4* dp = (LAS f4*)(seg + tt * 64 + d8); dp[0] = mk_f4(f[0], f[1], f[2], f[3]); dp[1] = mk_f4(f[4], f[5], f[6], f[7]); }
    __syncthreads();
    const int j = tid & 255, hb = tid >> 8;
    float acc[8], accpe = 0.f;
#pragma unroll
    for (int i = 0; i < 8; ++i) acc[i] = 0.f;
    for (int pos = 0; pos < 32; ++pos) {
#pragma unroll 2
        for (int d4 = 0; d4 < 16; ++d4) { const int kk = pos * 64 + d4 * 4;
            const float w0 = w1[(size_t)(kk + 0) * 256 + j], w1v = w1[(size_t)(kk + 1) * 256 + j], w2v = w1[(size_t)(kk + 2) * 256 + j], w3 = w1[(size_t)(kk + 3) * 256 + j];
            const f4 p4 = *(const f4*)(pe + kk);
            accpe += w0 * p4.x + w1v * p4.y + w2v * p4.z + w3 * p4.w;
#pragma unroll
            for (int ib = 0; ib < 8; ++ib) { const f4 s4 = *(const LAS f4*)(seg + (16 * (hb * 8 + ib) + pos) * 64 + d4 * 4);
                acc[ib] += w0 * s4.x + w1v * s4.y + w2v * s4.z + w3 * s4.w; } } }
#pragma unroll
    for (int ib = 0; ib < 8; ++ib) hid[(hb * 8 + ib) * 256 + j] = gelu_tanh(acc[ib] + accpe);
    __syncthreads();
    { const int i = tid >> 5, o2 = (tid & 31) * 2; float a0 = 0.f, a1 = 0.f;
        for (int jj = 0; jj < 256; ++jj) { const float hv = hid[i * 256 + jj]; const f2 w = *(const f2*)(w2 + jj * 64 + o2); a0 += hv * w.x; a1 += hv * w.y; }
        const int ci = 16 * r + i;
        if (ci <= 126) *(f2*)((float*)(ws + WS_KC) + ((size_t)((kv * 4 + b) * 4 + g) * 128 + ci) * 64 + o2) = mk_f2(a0, a1); }
    __syncthreads();
}

__device__ __forceinline__ void unit_retention(const Params& P, unsigned char* ws, int l, LAS unsigned char* lds, int u, int tid) {
    const int b = u >> 6, h = (u >> 4) & 3, c = u & 15;
    const bf16* Hb = (const bf16*)(ws + WS_H); const f2* rope = (const f2*)(ws + WS_ROPE);
    LAS float* regB = (LAS float*)lds;
    LAS float* vs = (LAS float*)(lds + 32768);
    LAS float* Qs = (LAS float*)(lds + 98304);
    const float lg2h = P.lg2[h];
    const int tok0 = b * T + c * 128;
    { float a[16];
#pragma unroll
        for (int i = 0; i < 16; ++i) a[i] = 0.f;
        const float* kvb = (const float*)(ws + WS_KVST) + (size_t)((b * 4 + h) * 16) * 8192 + tid * 16;
#pragma unroll 1
        for (int j = 0; j < c; ++j) { const float w = exp2f(lg2h * 128.f * (float)(c - 1 - j)); const f4* sp = (const f4*)(kvb + (size_t)j * 8192);
#pragma unroll
            for (int q = 0; q < 4; ++q) { const f4 v = sp[q]; a[4 * q] += w * v.x; a[4 * q + 1] += w * v.y; a[4 * q + 2] += w * v.z; a[4 * q + 3] += w * v.w; } }
        LAS f4* dp = (LAS f4*)(regB + tid * 16);
#pragma unroll
        for (int q = 0; q < 4; ++q) dp[q] = mk_f4(a[4 * q], a[4 * q + 1], a[4 * q + 2], a[4 * q + 3]); }
    const int n = tid >> 2, eg = tid & 3;
    float qa[8], qb[8];
    { const bf16* src = Hb + (size_t)(tok0 + n) * INWP + C_RQ + h * 64 + eg * 8;
        const u4 a = *(const u4*)src, bb = *(const u4*)(src + 32);
        float x1[8], x2[8]; unpack8(a, x1); unpack8(bb, x2);
        const f4* rp = (const f4*)(rope + (size_t)(c * 128 + n) * 32 + eg * 8);
        const f4 r0 = rp[0], r1 = rp[1], r2 = rp[2], r3 = rp[3];
        const float cs[8] = {r0.x, r0.z, r1.x, r1.z, r2.x, r2.z, r3.x, r3.z}, sn[8] = {r0.y, r0.w, r1.y, r1.w, r2.y, r2.w, r3.y, r3.w};
#pragma unroll
        for (int i = 0; i < 8; ++i) { qa[i] = x1[i] * cs[i] - x2[i] * sn[i]; qb[i] = x1[i] * sn[i] + x2[i] * cs[i]; Qs[n * 65 + eg * 8 + i] = qa[i]; Qs[n * 65 + 32 + eg * 8 + i] = qb[i]; } }
    __syncthreads();
    float acc[32];
#pragma unroll
    for (int i = 0; i < 32; ++i) acc[i] = 0.f;
#pragma unroll 2
    for (int d = 0; d < 64; ++d) { const float qd = Qs[n * 65 + d]; const LAS f4* sp = (const LAS f4*)(regB + d * 128 + eg * 32);
#pragma unroll
        for (int qq = 0; qq < 8; ++qq) { const f4 v = sp[qq]; acc[4 * qq] += qd * v.x; acc[4 * qq + 1] += qd * v.y; acc[4 * qq + 2] += qd * v.z; acc[4 * qq + 3] += qd * v.w; } }
    { const float xi = exp2f(lg2h * (float)(n + 1));
#pragma unroll
        for (int i = 0; i < 32; ++i) acc[i] *= xi; }
    __syncthreads();
    stage_rot_k(Hb, rope, regB, tok0, c * 128, C_RK + h * 64, lg2h, false, tid);
    stage_v128(Hb, vs, tok0, C_RV + h * 128, tid);
    __syncthreads();
    const int mmax = n | 15;
#pragma unroll 1
    for (int m = 0; m <= mmax; ++m) { const LAS f4* kp = (const LAS f4*)(regB + m * 64 + eg * 8); const LAS f4* kp2 = (const LAS f4*)(regB + m * 64 + 32 + eg * 8);
        const f4 k0 = kp[0], k1 = kp[1], k2 = kp2[0], k3 = kp2[1];
        float s = ((qa[0] * k0.x + qa[1] * k0.y) + (qa[2] * k0.z + qa[3] * k0.w)) + ((qa[4] * k1.x + qa[5] * k1.y) + (qa[6] * k1.z + qa[7] * k1.w))
                + ((qb[0] * k2.x + qb[1] * k2.y) + (qb[2] * k2.z + qb[3] * k2.w)) + ((qb[4] * k3.x + qb[5] * k3.y) + (qb[6] * k3.z + qb[7] * k3.w));
        s += __shfl_xor(s, 1); s += __shfl_xor(s, 2);
        const float a = (m <= n) ? s * exp2f(lg2h * (float)(n - m)) : 0.f;
        const LAS f4* vp = (const LAS f4*)(vs + m * 128 + eg * 32);
#pragma unroll
        for (int qq = 0; qq < 8; ++qq) { const f4 v = vp[qq]; acc[4 * qq] += a * v.x; acc[4 * qq + 1] += a * v.y; acc[4 * qq + 2] += a * v.z; acc[4 * qq + 3] += a * v.w; } }
    float s1 = 0.f;
#pragma unroll
    for (int i = 0; i < 32; ++i) s1 += acc[i];
    s1 += __shfl_xor(s1, 1); s1 += __shfl_xor(s1, 2);
    const float mu = s1 * (1.f / 128.f); float s2 = 0.f;
#pragma unroll
    for (int i = 0; i < 32; ++i) { const float dd = acc[i] - mu; s2 += dd * dd; }
    s2 += __shfl_xor(s2, 1); s2 += __shfl_xor(s2, 2);
    const float rstd = rsqrtf(s2 * (1.f / 128.f) + LN_EPS);
    const float* gg = P.in[2] + l * 512 + h * 128 + eg * 32; const float* gb = P.in[3] + l * 512 + h * 128 + eg * 32;
    const u4* gp = (const u4*)(Hb + (size_t)(tok0 + n) * INWP + C_RG + h * 128 + eg * 32);
    f4* yo = (f4*)((float*)(ws + WS_YMIX) + (size_t)(tok0 + n) * D + h * 128 + eg * 32);
#pragma unroll
    for (int j = 0; j < 4; ++j) { const u4 a = gp[j]; float f[8]; unpack8(a, f); float o[8];
#pragma unroll
        for (int i = 0; i < 8; ++i) { const float y = (acc[8 * j + i] - mu) * rstd * gg[8 * j + i] + gb[8 * j + i]; const float gv = f[i]; o[i] = y * gv * __builtin_amdgcn_rcpf(1.f + __expf(-gv)); }
        yo[2 * j] = mk_f4(o[0], o[1], o[2], o[3]); yo[2 * j + 1] = mk_f4(o[4], o[5], o[6], o[7]); }
    __syncthreads();
}

typedef pg8::bf16x8 bf16x8;
typedef short s16x4 __attribute__((ext_vector_type(4)));
typedef __bf16 bf16x2_t __attribute__((ext_vector_type(2)));
__device__ __forceinline__ unsigned pkbf(float a, float b) { f2 v; v.x = a; v.y = b; return __builtin_bit_cast(unsigned, __builtin_convertvector(v, bf16x2_t)); }
#define MFMA16(a, b, c) __builtin_amdgcn_mfma_f32_16x16x32_bf16((a), (b), (c), 0, 0, 0)
constexpr int NS = 80;
constexpr float NSA_SC = 0.125f * LOG2E;
__device__ __forceinline__ void nsa_scores(f4 (&st)[4][2], const LAS bf16* Kl, const bf16x8 (&Yq)[2][2], int lane) {
    const int r = lane & 15, kq = lane >> 4;
#pragma unroll
    for (int kt = 0; kt < 4; ++kt) { const LAS bf16* kp = Kl + (16 * kt + r) * NS + 8 * kq;
        const bf16x8 k0 = *(const LAS bf16x8*)kp, k1 = *(const LAS bf16x8*)(kp + 32);
#pragma unroll
        for (int qp = 0; qp < 2; ++qp) { f4 a = mk_f4(0.f, 0.f, 0.f, 0.f); a = MFMA16(k0, Yq[qp][0], a); a = MFMA16(k1, Yq[qp][1], a); st[kt][qp] = a; } }
}
__device__ __forceinline__ void nsa_softmax_pv(f4 (&st)[4][2], float (&m)[2], float (&l)[2], f4 (&ot)[4][2], const LAS bf16* Vl, const int (&lo)[2], const int (&hi)[2], bool need_mask, int lane) {
    const int kq = lane >> 4, q = (lane & 15) >> 2, p = lane & 3;
    bf16x8 Pf[2][2];
#pragma unroll
    for (int qp = 0; qp < 2; ++qp) {
        if (need_mask) {
#pragma unroll
            for (int kt = 0; kt < 4; ++kt)
#pragma unroll
                for (int i = 0; i < 4; ++i) { const int kl = 16 * kt + 4 * kq + i; if (kl < lo[qp] || kl > hi[qp]) st[kt][qp][i] = -1e30f; } }
        float mx = st[0][qp][0];
#pragma unroll
        for (int kt = 0; kt < 4; ++kt)
#pragma unroll
            for (int i = 0; i < 4; ++i) mx = fmaxf(mx, st[kt][qp][i]);
        mx = fmaxf(mx, __shfl_xor(mx, 16)); mx = fmaxf(mx, __shfl_xor(mx, 32));
        const float mn = fmaxf(m[qp], mx); const float corr = __builtin_amdgcn_exp2f((m[qp] - mn) * NSA_SC); m[qp] = mn; l[qp] *= corr;
#pragma unroll
        for (int dt = 0; dt < 4; ++dt) ot[dt][qp] *= corr;
        const float msc = mn * NSA_SC; float ps = 0.f;
#pragma unroll
        for (int kt = 0; kt < 4; ++kt)
#pragma unroll
            for (int i = 0; i < 4; ++i) { const float pv = __builtin_amdgcn_exp2f(st[kt][qp][i] * NSA_SC - msc); st[kt][qp][i] = pv; ps += pv; }
        l[qp] += ps;
#pragma unroll
        for (int ksp = 0; ksp < 2; ++ksp) { u4 w; w.x = pkbf(st[2 * ksp][qp][0], st[2 * ksp][qp][1]); w.y = pkbf(st[2 * ksp][qp][2], st[2 * ksp][qp][3]);
            w.z = pkbf(st[2 * ksp + 1][qp][0], st[2 * ksp + 1][qp][1]); w.w = pkbf(st[2 * ksp + 1][qp][2], st[2 * ksp + 1][qp][3]); Pf[qp][ksp] = __builtin_bit_cast(bf16x8, w); }
    }
#pragma unroll
    for (int dt = 0; dt < 4; ++dt)
#pragma unroll
        for (int ksp = 0; ksp < 2; ++ksp) { const LAS bf16* vp = Vl + (32 * ksp + 4 * kq + q) * NS + 16 * dt + 4 * p;
            const s16x4 va = __builtin_amdgcn_ds_read_tr16_b64_v4i16((LAS s16x4*)vp), vb = __builtin_amdgcn_ds_read_tr16_b64_v4i16((LAS s16x4*)(vp + 16 * NS));
            const bf16x8 vf = __builtin_shufflevector(va, vb, 0, 1, 2, 3, 4, 5, 6, 7);
#pragma unroll
            for (int qp = 0; qp < 2; ++qp) ot[dt][qp] = MFMA16(vf, Pf[qp][ksp], ot[dt][qp]); }
}
__device__ __forceinline__ void nsa_flush(float* __restrict__ y0, float* __restrict__ y1, const f4 (&ot)[4][2], const float (&l)[2], const float (&gate)[2], bool add, int kq) {
#pragma unroll
    for (int qp = 0; qp < 2; ++qp) { float lt = l[qp]; lt += __shfl_xor(lt, 16); lt += __shfl_xor(lt, 32); const float sc = (lt > 0.f) ? gate[qp] / lt : 0.f;
        float* yp = (qp ? y1 : y0) + 4 * kq;
#pragma unroll
        for (int dt = 0; dt < 4; ++dt) { f4 o = ot[dt][qp] * sc; if (add) o += *(const f4*)(yp + 16 * dt); *(f4*)(yp + 16 * dt) = o; } }
}
__device__ __forceinline__ void nsa_pair_next(unsigned& rem, int& ja, int& jb) { ja = __builtin_ctz(rem); rem &= rem - 1u; if (rem) { jb = __builtin_ctz(rem); rem &= rem - 1u; } else jb = -1; }
__device__ __forceinline__ void nsa_pair_prefetch(const bf16* __restrict__ Hb, int tok0, int ja, int jb, int colK, int colV, int tid, u4 (&R)[4]) {
    const int key = tid >> 3, d8 = (tid & 7) * 8; const int j1 = jb < 0 ? ja : jb;
    const bf16* pa = Hb + (size_t)(tok0 + 64 * ja + key) * INWP + d8; const bf16* pb = Hb + (size_t)(tok0 + 64 * j1 + key) * INWP + d8;
    R[0] = *(const u4*)(pa + colK); R[1] = *(const u4*)(pa + colV); R[2] = *(const u4*)(pb + colK); R[3] = *(const u4*)(pb + colV);
}
__device__ __forceinline__ void nsa_pair_store(LAS bf16* buf, int tid, const u4 (&R)[4]) {
    LAS bf16* p = buf + (tid >> 3) * NS + (tid & 7) * 8;
    *(LAS u4*)p = R[0]; *(LAS u4*)(p + 128 * NS) = R[1]; *(LAS u4*)(p + 64 * NS) = R[2]; *(LAS u4*)(p + 192 * NS) = R[3];
}
template <int MODE>
__device__ __forceinline__ void nsa_branch(unsigned chunks, const bf16* __restrict__ Hb, int tok0, int colK, int colV, LAS bf16* buf0, LAS bf16* buf1, int tid, int lane, int qt, const int (&tq)[2], const unsigned (&mym)[2],
                                           const bf16x8 (&Yq)[2][2], f4 (&ot)[4][2], float (&m)[2], float (&l)[2]) {
    u4 R[4]; unsigned rem = chunks; int ja, jb, na = 0, nb = -1; f4 st[4][2]; int lo[2], hi[2];
    nsa_pair_next(rem, ja, jb);
    nsa_pair_prefetch(Hb, tok0, ja, jb, colK, colV, tid, R);
    __syncthreads();
    nsa_pair_store(buf0, tid, R);
    bool more = (rem != 0u);
    if (more) { nsa_pair_next(rem, na, nb); nsa_pair_prefetch(Hb, tok0, na, nb, colK, colV, tid, R); }
    __syncthreads();
    int it = 0;
#pragma unroll 1
    for (;;) {
        LAS bf16* cur = (it & 1) ? buf1 : buf0;
#pragma unroll 1
        for (int sub = 0; sub < 2; ++sub) { const int j = sub ? jb : ja;
            if (j < 0) break;
            bool anyv = false, full = true;
#pragma unroll
            for (int qp = 0; qp < 2; ++qp) {
                if (MODE == 0) { const bool sel = (mym[qp] >> j) & 1u; lo[qp] = sel ? 0 : 64; hi[qp] = sel ? ((j == qt) ? tq[qp] : 63) : -1; anyv |= sel; full &= (sel && j != qt); }
                else { lo[qp] = (j == qt - 8) ? tq[qp] + 1 : 0; hi[qp] = (j == qt) ? tq[qp] : 63; anyv = true; full &= (j != qt && j != qt - 8); } }
            if (__builtin_amdgcn_ballot_w64(anyv) != 0ull) {
                const bool need_mask = __builtin_amdgcn_ballot_w64(!full) != 0ull;
                nsa_scores(st, cur + sub * 64 * NS, Yq, lane);
                nsa_softmax_pv(st, m, l, ot, cur + 128 * NS + sub * 64 * NS, lo, hi, need_mask, lane); } }
        if (!more) break;
        nsa_pair_store((it & 1) ? buf0 : buf1, tid, R);
        ja = na; jb = nb; more = (rem != 0u);
        if (more) { nsa_pair_next(rem, na, nb); nsa_pair_prefetch(Hb, tok0, na, nb, colK, colV, tid, R); }
        __syncthreads(); ++it;
    }
}
__device__ __forceinline__ void unit_nsa(const Params& P, unsigned char* ws, int l_, LAS unsigned char* lds, int u, int tid) {
    const int b = (u >> 7) & 3, g = (u >> 5) & 3, qt = (u & 256) ? 31 - (u & 31) : (u & 31);
    const bf16* Hb = (const bf16*)(ws + WS_H);
    LAS bf16* buf0 = (LAS bf16*)lds;
    LAS bf16* buf1 = (LAS bf16*)(lds + 40960);
    LAS float* impG = (LAS float*)(lds + 40960);
    LAS float* impE = (LAS float*)(lds + 73728);
    LAS unsigned* selm = (LAS unsigned*)(lds + 106496);
    const int lane = tid & 63, wv = __builtin_amdgcn_readfirstlane(tid >> 6), h = wv >> 1, qh = wv & 1;
    const int c = lane & 15, kq = lane >> 4;
    const int t0 = qt * 64;
    int tq[2]; size_t tok[2];
#pragma unroll
    for (int qp = 0; qp < 2; ++qp) { tq[qp] = 32 * qh + 16 * qp + c; tok[qp] = (size_t)b * T + t0 + tq[qp]; }
    bf16x8 Yq[2][2];
#pragma unroll
    for (int qp = 0; qp < 2; ++qp)
#pragma unroll
        for (int ks = 0; ks < 2; ++ks) Yq[qp][ks] = *(const bf16x8*)(Hb + tok[qp] * INWP + C_NQ + g * 256 + h * 64 + 32 * ks + 8 * kq);
    float gate[3][2];
#pragma unroll
    for (int k = 0; k < 3; ++k)
#pragma unroll
        for (int qp = 0; qp < 2; ++qp) { const float gv = bf2f(Hb[tok[qp] * INWP + C_NG + g * 12 + h * 3 + k]); gate[k][qp] = __builtin_amdgcn_rcpf(1.f + __expf(-gv)); }
    float* y0 = (float*)(ws + WS_YMIX) + tok[0] * D + 1024 + g * 256 + h * 64; float* y1 = (float*)(ws + WS_YMIX) + tok[1] * D + 1024 + g * 256 + h * 64;
    if (tid == 0) selm[64] = 0u;
    f4 ot[4][2]; float m[2], l[2];
#pragma unroll
    for (int dt = 0; dt < 4; ++dt)
#pragma unroll
        for (int qp = 0; qp < 2; ++qp) ot[dt][qp] = mk_f4(0.f, 0.f, 0.f, 0.f);
    int cmax[2];
#pragma unroll
    for (int qp = 0; qp < 2; ++qp) { const int t = t0 + tq[qp]; cmax[qp] = (t >= 31) ? (((t - 31) >> 4) < 126 ? ((t - 31) >> 4) : 126) : -1; }
    __syncthreads();
    { const bf16* KCk = (const bf16*)(ws + WS_KC) + (size_t)((0 * 4 + b) * 4 + g) * 8192; const bf16* KCv = (const bf16*)(ws + WS_KC) + (size_t)((1 * 4 + b) * 4 + g) * 8192;
#pragma unroll
        for (int i = 0; i < 2; ++i) { const int idx = tid + 512 * i, key = idx >> 3, d8 = (idx & 7) * 8;
            *(LAS u4*)(buf0 + key * NS + d8) = *(const u4*)(KCk + key * 64 + d8); *(LAS u4*)(buf0 + (128 + key) * NS + d8) = *(const u4*)(KCv + key * 64 + d8); } }
    __syncthreads();
    m[0] = m[1] = -1e4f; l[0] = l[1] = 0.f;
    { f4 st[4][2]; int lo[2], hi[2];
#pragma unroll 1
        for (int cc = 0; cc < 2; ++cc) {
            if (cc * 64 * 16 + 31 > t0 + 63) break;
#pragma unroll
            for (int qp = 0; qp < 2; ++qp) { lo[qp] = 0; hi[qp] = cmax[qp] - 64 * cc; }
            nsa_scores(st, buf0 + cc * 64 * NS, Yq, lane);
            nsa_softmax_pv(st, m, l, ot, buf0 + 128 * NS + cc * 64 * NS, lo, hi, true, lane);
        }
        { const float g2[2] = {gate[0][0], gate[0][1]}; nsa_flush(y0, y1, ot, l, g2, false, kq); }
        float invl[2], msc[2];
#pragma unroll
        for (int qp = 0; qp < 2; ++qp) { float lt = l[qp]; lt += __shfl_xor(lt, 16); lt += __shfl_xor(lt, 32); invl[qp] = (lt > 0.f) ? 1.f / lt : 0.f; msc[qp] = m[qp] * NSA_SC; }
#pragma unroll 1
        for (int cc = 0; cc < 2; ++cc) {
            nsa_scores(st, buf0 + cc * 64 * NS, Yq, lane);
#pragma unroll
            for (int kt = 0; kt < 4; ++kt)
#pragma unroll
                for (int qp = 0; qp < 2; ++qp) { float pp[4];
#pragma unroll
                    for (int i = 0; i < 4; ++i) { const int ci = 64 * cc + 16 * kt + 4 * kq + i; pp[i] = (ci <= cmax[qp]) ? __builtin_amdgcn_exp2f(st[kt][qp][i] * NSA_SC - msc[qp]) * invl[qp] : 0.f; }
                    const int j = 16 * cc + 4 * kt + kq;
                    impG[(h * 32 + j) * 64 + tq[qp]] = (pp[0] + pp[1]) + (pp[2] + pp[3]);
                    if (j < 31) impE[(h * 32 + j + 1) * 64 + tq[qp]] = pp[3]; }
        } }
    __syncthreads();
    if (tid < 64) { const int tqs = tid; float tv[8]; int ti[8];
#pragma unroll
        for (int k = 0; k < 8; ++k) { tv[k] = -3e38f; ti[k] = 0; }
#pragma unroll 1
        for (int j = 0; j < 32; ++j) { float v;
            if (j <= qt) { const bool forced = (j == 0) || (j == qt) || (j == qt - 1);
                float s4 = (impG[(0 * 32 + j) * 64 + tqs] + impG[(1 * 32 + j) * 64 + tqs]) + (impG[(2 * 32 + j) * 64 + tqs] + impG[(3 * 32 + j) * 64 + tqs]);
                if (j > 0) s4 += (impE[(0 * 32 + j) * 64 + tqs] + impE[(1 * 32 + j) * 64 + tqs]) + (impE[(2 * 32 + j) * 64 + tqs] + impE[(3 * 32 + j) * 64 + tqs]);
                v = forced ? 1e6f : s4; }
            else v = -1e9f;
            int vi = j;
#pragma unroll
            for (int k = 0; k < 8; ++k) { const bool gt = v > tv[k]; const float nv = gt ? tv[k] : v; const int ni = gt ? ti[k] : vi; tv[k] = gt ? v : tv[k]; ti[k] = gt ? vi : ti[k]; v = nv; vi = ni; } }
        unsigned msk = 0u;
#pragma unroll
        for (int k = 0; k < 8; ++k) if (ti[k] <= qt) msk |= (1u << ti[k]);
        selm[tqs] = msk; atomicOr((unsigned*)&selm[64], msk); }
    __syncthreads();
    unsigned mymask[2];
#pragma unroll
    for (int qp = 0; qp < 2; ++qp) mymask[qp] = selm[tq[qp]];
    const unsigned umask = selm[64];
#pragma unroll
    for (int dt = 0; dt < 4; ++dt)
#pragma unroll
        for (int qp = 0; qp < 2; ++qp) ot[dt][qp] = mk_f4(0.f, 0.f, 0.f, 0.f);
    m[0] = m[1] = -1e4f; l[0] = l[1] = 0.f;
    nsa_branch<0>(umask, Hb, b * T, C_KS + g * 64, C_VS + g * 64, buf0, buf1, tid, lane, qt, tq, mymask, Yq, ot, m, l);
    { const float g2[2] = {gate[1][0], gate[1][1]}; nsa_flush(y0, y1, ot, l, g2, true, kq); }
#pragma unroll
    for (int dt = 0; dt < 4; ++dt)
#pragma unroll
        for (int qp = 0; qp < 2; ++qp) ot[dt][qp] = mk_f4(0.f, 0.f, 0.f, 0.f);
    m[0] = m[1] = -1e4f; l[0] = l[1] = 0.f;
    { const int jw0 = qt >= 8 ? qt - 8 : 0; const unsigned wmask = ((qt == 31) ? 0xffffffffu : ((1u << (qt + 1)) - 1u)) & ~((1u << jw0) - 1u);
        nsa_branch<1>(wmask, Hb, b * T, C_KW + g * 64, C_VW + g * 64, buf0, buf1, tid, lane, qt, tq, mymask, Yq, ot, m, l); }
    { const float g2[2] = {gate[2][0], gate[2][1]}; nsa_flush(y0, y1, ot, l, g2, true, kq); }
    __syncthreads();
}

__device__ __forceinline__ void unit_compress_mfma(const Params& P, unsigned char* ws, int l, LAS unsigned char* lds, int u, int tid) {
    const int kv = u >> 7, b = (u >> 5) & 3, g = (u >> 3) & 3, r8 = u & 7, i0 = 16 * r8;
    const bf16* Hb = (const bf16*)(ws + WS_H);
    const bf16* W1T = (const bf16*)(ws + WS_W1T) + (size_t)(l * 2 + kv) * 256 * 2048;
    const bf16* W2T = (const bf16*)(ws + WS_W2T) + (size_t)(l * 2 + kv) * 64 * 256;
    const float* pe = P.in[kv ? 11 : 8] + (size_t)l * 2048;
    constexpr int AS = 2056;
    LAS bf16* Al = (LAS bf16*)lds;
    LAS bf16* hidL = (LAS bf16*)(lds + 16 * AS * 2);
    const int lane = tid & 63, wv = __builtin_amdgcn_readfirstlane(tid >> 6), c = lane & 15, kq = lane >> 4;
    const int col0 = (kv ? C_VC : C_KC) + g * 64;
#pragma unroll 4
    for (int it = 0; it < 8; ++it) { const int idx = tid + 512 * it; const int r = idx >> 8, pos = (idx >> 3) & 31, d8 = (idx & 7) * 8;
        int t = 16 * (i0 + r) + pos; t = t < T ? t : T - 1;
        const u4 a = *(const u4*)(Hb + (size_t)(b * T + t) * INWP + col0 + d8); float f[8]; unpack8(a, f);
        const f4 p0 = *(const f4*)(pe + pos * 64 + d8), p1 = *(const f4*)(pe + pos * 64 + d8 + 4);
        u4 w; w.x = pkbf(f[0] + p0.x, f[1] + p0.y); w.y = pkbf(f[2] + p0.z, f[3] + p0.w); w.z = pkbf(f[4] + p1.x, f[5] + p1.y); w.w = pkbf(f[6] + p1.z, f[7] + p1.w);
        *(LAS u4*)(Al + r * AS + pos * 64 + d8) = w; }
    __syncthreads();
    f4 acc[2];
#pragma unroll
    for (int nt = 0; nt < 2; ++nt) acc[nt] = mk_f4(0.f, 0.f, 0.f, 0.f);
    const bf16* wrow[2];
#pragma unroll
    for (int nt = 0; nt < 2; ++nt) wrow[nt] = W1T + (size_t)(32 * wv + 16 * nt + c) * 2048 + 8 * kq;
    const LAS bf16* arow = Al + c * AS + 8 * kq;
    bf16x8 xfA[2][4], xfB[2][4];
#define CMP_LOADW(XF, p2_) do { _Pragma("unroll") for (int nt = 0; nt < 2; ++nt) _Pragma("unroll") for (int ks = 0; ks < 4; ++ks) XF[nt][ks] = *(const bf16x8*)(wrow[nt] + (p2_) * 128 + 32 * ks); } while (0)
#define CMP_MMAW(XF, p2_) do { _Pragma("unroll") for (int ks = 0; ks < 4; ++ks) { const bf16x8 yf_ = *(const LAS bf16x8*)(arow + (p2_) * 128 + 32 * ks); \
        _Pragma("unroll") for (int nt = 0; nt < 2; ++nt) acc[nt] = MFMA16(XF[nt][ks], yf_, acc[nt]); } } while (0)
    CMP_LOADW(xfA, 0);
#pragma unroll 1
    for (int p2 = 0; p2 < 16; p2 += 2) {
        CMP_LOADW(xfB, p2 + 1);
        CMP_MMAW(xfA, p2);
        if (p2 + 2 < 16) CMP_LOADW(xfA, p2 + 2);
        CMP_MMAW(xfB, p2 + 1);
    }
#undef CMP_LOADW
#undef CMP_MMAW
#pragma unroll
    for (int nt = 0; nt < 2; ++nt) { const f4 a = acc[nt]; u2 w; w.x = pkbf(gelu_tanh(a.x), gelu_tanh(a.y)); w.y = pkbf(gelu_tanh(a.z), gelu_tanh(a.w));
        *(LAS u2*)(hidL + c * 264 + 32 * wv + 16 * nt + 4 * kq) = w; }
    __syncthreads();
    if (wv < 4) { const int ot = wv; f4 o = mk_f4(0.f, 0.f, 0.f, 0.f);
        const bf16* w2p = W2T + (size_t)(16 * ot + c) * 256 + 8 * kq; const LAS bf16* hp = hidL + c * 264 + 8 * kq;
#pragma unroll
        for (int ks = 0; ks < 8; ++ks) { const bf16x8 xw = *(const bf16x8*)(w2p + 32 * ks); const bf16x8 yh = *(const LAS bf16x8*)(hp + 32 * ks); o = MFMA16(xw, yh, o); }
        const int ci = i0 + c;
        u2 w; w.x = pkbf(o.x, o.y); w.y = pkbf(o.z, o.w); if (ci > 126) { w.x = 0u; w.y = 0u; }
        *(u2*)((bf16*)(ws + WS_KC) + ((size_t)((kv * 4 + b) * 4 + g) * 128 + ci) * 64 + 16 * ot + 4 * kq) = w; }
    __syncthreads();
}

__device__ __forceinline__ void unit_retention_mfma(const Params& P, unsigned char* ws, int l, LAS unsigned char* lds, int u, int tid) {
    const int b = u >> 6, h = (u >> 4) & 3, c = u & 15;
    const bf16* Hb = (const bf16*)(ws + WS_H); const f2* rope = (const f2*)(ws + WS_ROPE);
    LAS bf16* Ql = (LAS bf16*)lds;
    LAS bf16* Kl = (LAS bf16*)(lds + 18432);
    LAS bf16* Vt = (LAS bf16*)(lds + 36864);
    LAS bf16* St = (LAS bf16*)(lds + 71680);
    const float lg2h = P.lg2[h];
    const int tok0 = b * T + c * 128;
    { const int m = tid >> 2, p = tid & 3;
        const f4* rp = (const f4*)(rope + (size_t)(c * 128 + m) * 32 + p * 8);
        const f4 r0 = rp[0], r1 = rp[1], r2 = rp[2], r3 = rp[3];
        const float cs[8] = {r0.x, r0.z, r1.x, r1.z, r2.x, r2.z, r3.x, r3.z}, sn[8] = {r0.y, r0.w, r1.y, r1.w, r2.y, r2.w, r3.y, r3.w};
#pragma unroll
        for (int which = 0; which < 2; ++which) { const bf16* src = Hb + (size_t)(tok0 + m) * INWP + (which ? C_RK : C_RQ) + h * 64 + p * 8;
            const u4 a = *(const u4*)src, bb = *(const u4*)(src + 32); float x1[8], x2[8]; unpack8(a, x1); unpack8(bb, x2);
            const float sc = which ? 0.125f : 1.0f; float o1[8], o2[8];
#pragma unroll
            for (int i = 0; i < 8; ++i) { o1[i] = (x1[i] * cs[i] - x2[i] * sn[i]) * sc; o2[i] = (x1[i] * sn[i] + x2[i] * cs[i]) * sc; }
            LAS bf16* dst = (which ? Kl : Ql) + m * 72 + p * 8;
            u4 w1, w2; w1.x = pkbf(o1[0], o1[1]); w1.y = pkbf(o1[2], o1[3]); w1.z = pkbf(o1[4], o1[5]); w1.w = pkbf(o1[6], o1[7]); w2.x = pkbf(o2[0], o2[1]); w2.y = pkbf(o2[2], o2[3]); w2.z = pkbf(o2[4], o2[5]); w2.w = pkbf(o2[6], o2[7]);
            *(LAS u4*)dst = w1; *(LAS u4*)(dst + 32) = w2; } }
    { const int m = tid & 127, eq = tid >> 7;
        const u4* src = (const u4*)(Hb + (size_t)(tok0 + m) * INWP + C_RV + h * 128 + eq * 32); LAS bf16* vp = Vt + (eq * 32) * 136 + m;
#pragma unroll
        for (int j = 0; j < 4; ++j) { const u4 a = src[j];
            vp[(8 * j + 0) * 136] = (bf16)(a.x & 0xffffu); vp[(8 * j + 1) * 136] = (bf16)(a.x >> 16); vp[(8 * j + 2) * 136] = (bf16)(a.y & 0xffffu); vp[(8 * j + 3) * 136] = (bf16)(a.y >> 16);
            vp[(8 * j + 4) * 136] = (bf16)(a.z & 0xffffu); vp[(8 * j + 5) * 136] = (bf16)(a.z >> 16); vp[(8 * j + 6) * 136] = (bf16)(a.w & 0xffffu); vp[(8 * j + 7) * 136] = (bf16)(a.w >> 16); } }
    { float a[16];
#pragma unroll
        for (int i = 0; i < 16; ++i) a[i] = 0.f;
        const float* kvb = (const float*)(ws + WS_KVST) + (size_t)((b * 4 + h) * 16) * 8192 + tid * 16;
#pragma unroll 1
        for (int j = 0; j < c; ++j) { const float w = exp2f(lg2h * 128.f * (float)(c - 1 - j)); const f4* sp = (const f4*)(kvb + (size_t)j * 8192);
#pragma unroll
            for (int q = 0; q < 4; ++q) { const f4 v = sp[q]; a[4 * q] += w * v.x; a[4 * q + 1] += w * v.y; a[4 * q + 2] += w * v.z; a[4 * q + 3] += w * v.w; } }
        const int d = tid >> 3, e0 = (tid & 7) * 16;
#pragma unroll
        for (int i = 0; i < 16; ++i) St[(e0 + i) * 72 + d] = (bf16)f2bf(a[i]); }
    __syncthreads();
    const int lane = tid & 63, wv = __builtin_amdgcn_readfirstlane(tid >> 6), cc = lane & 15, kq = lane >> 4;
    const int nn = 16 * wv + cc;
    bf16x8 yq[2];
#pragma unroll
    for (int ks = 0; ks < 2; ++ks) yq[ks] = *(const LAS bf16x8*)(Ql + nn * 72 + 32 * ks + 8 * kq);
    f4 ot[8];
#pragma unroll
    for (int et = 0; et < 8; ++et) { f4 a = mk_f4(0.f, 0.f, 0.f, 0.f); const LAS bf16* sp = St + (16 * et + cc) * 72 + 8 * kq;
        a = MFMA16(*(const LAS bf16x8*)sp, yq[0], a); a = MFMA16(*(const LAS bf16x8*)(sp + 32), yq[1], a); ot[et] = a; }
    { const float xi = exp2f(lg2h * (float)(nn + 1));
#pragma unroll
        for (int et = 0; et < 8; ++et) ot[et] *= xi; }
    const int nks = (wv >> 1) + 1;
#pragma unroll 1
    for (int ksp = 0; ksp < nks; ++ksp) { f4 st[2];
#pragma unroll
        for (int j = 0; j < 2; ++j) { const int mt = 2 * ksp + j; const LAS bf16* kp = Kl + (16 * mt + cc) * 72 + 8 * kq;
            f4 a = mk_f4(0.f, 0.f, 0.f, 0.f); a = MFMA16(*(const LAS bf16x8*)kp, yq[0], a); a = MFMA16(*(const LAS bf16x8*)(kp + 32), yq[1], a);
#pragma unroll
            for (int i = 0; i < 4; ++i) { const int mm = 16 * mt + 4 * kq + i; a[i] = (mm <= nn) ? a[i] * exp2f(lg2h * (float)(nn - mm)) : 0.f; }
            st[j] = a; }
        u4 w; w.x = pkbf(st[0].x, st[0].y); w.y = pkbf(st[0].z, st[0].w); w.z = pkbf(st[1].x, st[1].y); w.w = pkbf(st[1].z, st[1].w);
        const bf16x8 pf = __builtin_bit_cast(bf16x8, w);
#pragma unroll
        for (int et = 0; et < 8; ++et) { const LAS bf16* vp = Vt + (16 * et + cc) * 136 + 32 * ksp + 4 * kq;
            const s16x4 va = *(const LAS s16x4*)vp, vb = *(const LAS s16x4*)(vp + 16);
            ot[et] = MFMA16(__builtin_shufflevector(va, vb, 0, 1, 2, 3, 4, 5, 6, 7), pf, ot[et]); }
    }
    float s1 = 0.f;
#pragma unroll
    for (int et = 0; et < 8; ++et) s1 += (ot[et].x + ot[et].y) + (ot[et].z + ot[et].w);
    s1 += __shfl_xor(s1, 16); s1 += __shfl_xor(s1, 32);
    const float mu = s1 * (1.f / 128.f); float s2 = 0.f;
#pragma unroll
    for (int et = 0; et < 8; ++et) { const f4 dd = ot[et] - mu; s2 += (dd.x * dd.x + dd.y * dd.y) + (dd.z * dd.z + dd.w * dd.w); }
    s2 += __shfl_xor(s2, 16); s2 += __shfl_xor(s2, 32);
    const float rstd = rsqrtf(s2 * (1.f / 128.f) + LN_EPS);
    const float* gg = P.in[2] + l * 512 + h * 128; const float* gb = P.in[3] + l * 512 + h * 128;
    const bf16* gp = Hb + (size_t)(tok0 + nn) * INWP + C_RG + h * 128;
    float* yo = (float*)(ws + WS_YMIX) + (size_t)(tok0 + nn) * D + h * 128;
#pragma unroll
    for (int et = 0; et < 8; ++et) { const int e = 16 * et + 4 * kq; const f4 g4 = *(const f4*)(gg + e), b4 = *(const f4*)(gb + e); const u2 gr = *(const u2*)(gp + e);
        const float gv[4] = {__uint_as_float(gr.x << 16), __uint_as_float(gr.x & 0xffff0000u), __uint_as_float(gr.y << 16), __uint_as_float(gr.y & 0xffff0000u)};
        f4 o;
#pragma unroll
        for (int i = 0; i < 4; ++i) { const float y = (ot[et][i] - mu) * rstd * g4[i] + b4[i]; o[i] = y * gv[i] * __builtin_amdgcn_rcpf(1.f + __expf(-gv[i])); }
        *(f4*)(yo + e) = o; }
    __syncthreads();
}

__device__ __forceinline__ bf16x8 tr_frag(const LAS bf16* p, int rowstride4) {
    const s16x4 a = __builtin_amdgcn_ds_read_tr16_b64_v4i16((LAS s16x4*)p), b = __builtin_amdgcn_ds_read_tr16_b64_v4i16((LAS s16x4*)(p + rowstride4));
    return __builtin_shufflevector(a, b, 0, 1, 2, 3, 4, 5, 6, 7);
}
__device__ __forceinline__ void unit_kvstate_mfma(const Params& P, unsigned char* ws, LAS unsigned char* lds, int u, int tid) {
    const int b = u / 60, r = u % 60, h = r / 15, j = r % 15;
    const bf16* Hb = (const bf16*)(ws + WS_H); const f2* rope = (const f2*)(ws + WS_ROPE);
    LAS bf16* Kz = (LAS bf16*)lds;
    LAS bf16* Vl = (LAS bf16*)(lds + 20480);
    const int tok0 = b * T + j * 128; const float lg2h = P.lg2[h];
    { const int m = tid >> 2, p = tid & 3;
        const f4* rp = (const f4*)(rope + (size_t)(j * 128 + m) * 32 + p * 8);
        const f4 r0 = rp[0], r1 = rp[1], r2 = rp[2], r3 = rp[3];
        const float cs[8] = {r0.x, r0.z, r1.x, r1.z, r2.x, r2.z, r3.x, r3.z}, sn[8] = {r0.y, r0.w, r1.y, r1.w, r2.y, r2.w, r3.y, r3.w};
        const bf16* src = Hb + (size_t)(tok0 + m) * INWP + C_RK + h * 64 + p * 8;
        const u4 a = *(const u4*)src, bb = *(const u4*)(src + 32); float x1[8], x2[8]; unpack8(a, x1); unpack8(bb, x2);
        const float sc = 0.125f * exp2f(lg2h * (float)(127 - m)); float o1[8], o2[8];
#pragma unroll
        for (int i = 0; i < 8; ++i) { o1[i] = (x1[i] * cs[i] - x2[i] * sn[i]) * sc; o2[i] = (x1[i] * sn[i] + x2[i] * cs[i]) * sc; }
        u4 w1, w2; w1.x = pkbf(o1[0], o1[1]); w1.y = pkbf(o1[2], o1[3]); w1.z = pkbf(o1[4], o1[5]); w1.w = pkbf(o1[6], o1[7]); w2.x = pkbf(o2[0], o2[1]); w2.y = pkbf(o2[2], o2[3]); w2.z = pkbf(o2[4], o2[5]); w2.w = pkbf(o2[6], o2[7]);
        *(LAS u4*)(Kz + m * 80 + p * 8) = w1; *(LAS u4*)(Kz + m * 80 + 32 + p * 8) = w2;
        const u4* vs = (const u4*)(Hb + (size_t)(tok0 + m) * INWP + C_RV + h * 128 + p * 32); LAS u4* vd = (LAS u4*)(Vl + m * 144 + p * 32);
#pragma unroll
        for (int q = 0; q < 4; ++q) vd[q] = vs[q]; }
    __syncthreads();
    { const int lane = tid & 63, et = __builtin_amdgcn_readfirstlane(tid >> 6), c = lane & 15, kq = lane >> 4, q = (lane & 15) >> 2, p4 = lane & 3;
        bf16x8 yv[4];
#pragma unroll
        for (int ks = 0; ks < 4; ++ks) yv[ks] = tr_frag(Vl + (32 * ks + 8 * kq + q) * 144 + 16 * et + 4 * p4, 4 * 144);
        float* dst = (float*)(ws + WS_KVST) + (size_t)((b * 4 + h) * 16 + j) * 8192 + 16 * et + c;
#pragma unroll
        for (int dt = 0; dt < 4; ++dt) { f4 acc = mk_f4(0.f, 0.f, 0.f, 0.f);
#pragma unroll
            for (int ks = 0; ks < 4; ++ks) acc = MFMA16(tr_frag(Kz + (32 * ks + 8 * kq + q) * 80 + 16 * dt + 4 * p4, 4 * 80), yv[ks], acc);
#pragma unroll
            for (int i = 0; i < 4; ++i) dst[(16 * dt + 4 * kq + i) * 128] = acc[i]; } }
    __syncthreads();
}
__device__ __forceinline__ void unit_sgu_mfma(const Params& P, unsigned char* ws, int l, LAS unsigned char* lds, int u, int tid, int lane, int wave) {
    const int b = u >> 6, c = (u >> 2) & 15, g = u & 3;
    const bf16* Hb = (const bf16*)(ws + WS_H);
    LAS bf16* vn = (LAS bf16*)lds;
    const int tok0 = b * T + c * 128;
    const float* lng = P.in[4] + l * 512 + g * 128; const float* lnb = P.in[5] + l * 512 + g * 128;
    const float g0 = lng[2 * lane], g1 = lng[2 * lane + 1], b0 = lnb[2 * lane], b1 = lnb[2 * lane + 1];
#pragma unroll 4
    for (int i = 0; i < 16; ++i) { const int s = wave * 16 + i;
        const unsigned pr = *(const unsigned*)(Hb + (size_t)(tok0 + s) * INWP + C_SV + g * 128 + 2 * lane);
        const float v0 = __uint_as_float(pr << 16), v1 = __uint_as_float(pr & 0xffff0000u);
        const float mu = wave_sum(v0 + v1) * (1.f / 128.f); const float d0 = v0 - mu, d1 = v1 - mu;
        const float var = wave_sum(d0 * d0 + d1 * d1) * (1.f / 128.f); const float rstd = rsqrtf(var + LN_EPS);
        *(LAS unsigned*)(vn + s * 144 + 2 * lane) = pkbf(d0 * rstd * g0 + b0, d1 * rstd * g1 + b1); }
    __syncthreads();
    { const int cc = lane & 15, kq = lane >> 4, q = (lane & 15) >> 2, p4 = lane & 3, t = 16 * wave + cc, nks = (wave >> 1) + 1;
        const float* wrow = P.in[6] + ((size_t)l * 4 + g) * 16384 + (size_t)t * 128 + 8 * kq;
        bf16x8 xw[4];
#pragma unroll
        for (int ks = 0; ks < 4; ++ks) { u4 w = {0u, 0u, 0u, 0u};
            if (ks < nks) { const f4 a0 = *(const f4*)(wrow + 32 * ks), a1 = *(const f4*)(wrow + 32 * ks + 4); const int s0 = 32 * ks + 8 * kq;
                w.x = pkbf(s0 + 0 <= t ? a0.x : 0.f, s0 + 1 <= t ? a0.y : 0.f); w.y = pkbf(s0 + 2 <= t ? a0.z : 0.f, s0 + 3 <= t ? a0.w : 0.f);
                w.z = pkbf(s0 + 4 <= t ? a1.x : 0.f, s0 + 5 <= t ? a1.y : 0.f); w.w = pkbf(s0 + 6 <= t ? a1.z : 0.f, s0 + 7 <= t ? a1.w : 0.f); }
            xw[ks] = __builtin_bit_cast(bf16x8, w); }
        f4 bs4; { const float* bsp = P.in[7] + (l * 4 + g) * 128 + 16 * wave + 4 * kq; bs4 = *(const f4*)bsp; }
#pragma unroll 2
        for (int dt = 0; dt < 8; ++dt) { f4 acc = mk_f4(0.f, 0.f, 0.f, 0.f);
#pragma unroll
            for (int ks = 0; ks < 4; ++ks) if (ks < nks) acc = MFMA16(xw[ks], tr_frag(vn + (32 * ks + 8 * kq + q) * 144 + 16 * dt + 4 * p4, 4 * 144), acc);
            const int d = 16 * dt + cc;
#pragma unroll
            for (int i = 0; i < 4; ++i) { const int tt = 16 * wave + 4 * kq + i; const float uu = bf2f(Hb[(size_t)(tok0 + tt) * INWP + C_SU + g * 128 + d]);
                ((float*)(ws + WS_YMIX))[(size_t)(tok0 + tt) * D + 512 + g * 128 + d] = uu * (acc[i] + bs4[i]); } } }
    __syncthreads();
}

__device__ __forceinline__ void row_mixnorm(const Params& P, unsigned char* ws, int l, int rowi, int lane) {
    const f4* yp = (const f4*)((const float*)(ws + WS_YMIX) + (size_t)rowi * D) + lane;
    const f4* gp = (const f4*)(P.in[14] + (size_t)l * D) + lane;
    f4 v[8]; float ss[8];
#pragma unroll
    for (int j = 0; j < 8; ++j) { v[j] = yp[64 * j]; ss[j] = v[j].x * v[j].x + v[j].y * v[j].y + v[j].z * v[j].z + v[j].w * v[j].w; }
    const float r0 = rsqrtf(wave_sum(ss[0] + ss[1]) * (1.f / 512.f) + LN_EPS);
    const float r1 = rsqrtf(wave_sum(ss[2] + ss[3]) * (1.f / 512.f) + LN_EPS);
    const float r2 = rsqrtf(wave_sum((ss[4] + ss[5]) + (ss[6] + ss[7])) * (1.f / 1024.f) + LN_EPS);
    u2* op = (u2*)((bf16*)(ws + WS_MIXED) + (size_t)rowi * D) + lane;
#pragma unroll
    for (int j = 0; j < 8; ++j) { const float r = (j < 2) ? r0 : ((j < 4) ? r1 : r2); const f4 g4 = gp[64 * j];
        op[64 * j] = mk_u2(pk2(v[j].x * r * g4.x, v[j].y * r * g4.y), pk2(v[j].z * r * g4.z, v[j].w * r * g4.w)); }
}
__device__ __forceinline__ void row_ln(const float* __restrict__ zin, const float* __restrict__ gam, const float* __restrict__ bet, float* __restrict__ of32, bf16* __restrict__ obf, unsigned* __restrict__ oq, float* __restrict__ osc, int rowi, int lane) {
    const f4* zp = (const f4*)(zin + (size_t)rowi * D) + lane;
    f4 v[8]; float s = 0.f;
#pragma unroll
    for (int j = 0; j < 8; ++j) { v[j] = zp[64 * j]; s += (v[j].x + v[j].y) + (v[j].z + v[j].w); }
    const float mu = wave_sum(s) * (1.f / D); float s2 = 0.f;
#pragma unroll
    for (int j = 0; j < 8; ++j) { v[j].x -= mu; v[j].y -= mu; v[j].z -= mu; v[j].w -= mu; s2 += (v[j].x * v[j].x + v[j].y * v[j].y) + (v[j].z * v[j].z + v[j].w * v[j].w); }
    const float rstd = rsqrtf(wave_sum(s2) * (1.f / D) + LN_EPS);
    f4* o4 = (f4*)(of32 + (size_t)rowi * D) + lane; u2* o2 = (u2*)(obf + (size_t)rowi * D) + lane;
    const f4* gp = (const f4*)gam + lane; const f4* bp = (const f4*)bet + lane;
    float am = 0.f;
#pragma unroll
    for (int j = 0; j < 8; ++j) { const f4 g4 = gp[64 * j], b4 = bp[64 * j];
        const f4 o = mk_f4(v[j].x * rstd * g4.x + b4.x, v[j].y * rstd * g4.y + b4.y, v[j].z * rstd * g4.z + b4.z, v[j].w * rstd * g4.w + b4.w);
        o4[64 * j] = o; o2[64 * j] = mk_u2(pk2(o.x, o.y), pk2(o.z, o.w)); v[j] = o;
        am = fmaxf(am, fmaxf(fmaxf(fabsf(o.x), fabsf(o.y)), fmaxf(fabsf(o.z), fabsf(o.w)))); }
#pragma unroll
    for (int o = 1; o < 64; o <<= 1) am = fmaxf(am, __shfl_xor(am, o));
    const float sc = (am > 0.f) ? 127.f / am : 1.f;
    if (lane == 0) osc[rowi] = (am > 0.f) ? am * (1.f / 127.f) : 1.f;
    unsigned* qp = oq + (size_t)rowi * (D / 4) + lane;
#pragma unroll
    for (int j = 0; j < 8; ++j) { const int b0 = (int)rintf(v[j].x * sc), b1 = (int)rintf(v[j].y * sc), b2 = (int)rintf(v[j].z * sc), b3 = (int)rintf(v[j].w * sc);
        qp[64 * j] = (unsigned)(b0 & 0xff) | ((unsigned)(b1 & 0xff) << 8) | ((unsigned)(b2 & 0xff) << 16) | ((unsigned)b3 << 24); }
}

__device__ __forceinline__ float dot8_bf16(const u4& w, const float* x) {
    float f[8]; unpack8(w, f);
    return ((f[0] * x[0] + f[1] * x[1]) + (f[2] * x[2] + f[3] * x[3])) + ((f[4] * x[4] + f[5] * x[5]) + (f[6] * x[6] + f[7] * x[7]));
}
__device__ __forceinline__ void peer_load4(u4 (&R)[4][2], const unsigned char* __restrict__ TAB, const LAS int* pe, int grp, int lane) {
#pragma unroll
    for (int k = 0; k < 4; ++k) { const int e = __builtin_amdgcn_readfirstlane(pe[grp * 4 + k]); const u4* p = (const u4*)(TAB + (size_t)e * 2048) + lane; R[k][0] = p[0]; R[k][1] = p[64]; }
}
__device__ __forceinline__ float dot16_fp8(const u4& w, const float* x) {
    float s = 0.f;
#pragma unroll
    for (int q = 0; q < 4; ++q) { const f2 lo = __builtin_amdgcn_cvt_pk_f32_fp8((int)w[q], false), hi = __builtin_amdgcn_cvt_pk_f32_fp8((int)w[q], true);
        s += (lo.x * x[4 * q] + lo.y * x[4 * q + 1]) + (hi.x * x[4 * q + 2] + hi.y * x[4 * q + 3]); }
    return s;
}
__device__ __forceinline__ void peer_dot4(const u4 (&R)[4][2], const float (&xr)[32], const float* __restrict__ USC, const LAS int* pe, const LAS float* pw, const float* __restrict__ VSC, LAS float* hwp, int grp, int lane) {
    float d[4];
#pragma unroll
    for (int k = 0; k < 4; ++k) d[k] = dot16_fp8(R[k][0], xr) + dot16_fp8(R[k][1], xr + 16);
#pragma unroll
    for (int o = 1; o < 64; o <<= 1) {
#pragma unroll
        for (int k = 0; k < 4; ++k) d[k] += __shfl_xor(d[k], o); }
#pragma unroll
    for (int k = 0; k < 4; ++k) { const int e = __builtin_amdgcn_readfirstlane(pe[grp * 4 + k]);
        const float hv = pw[grp * 4 + k] * gelu_tanh(d[k] * USC[e]) * VSC[e];
        if (lane == 0) hwp[grp * 4 + k] = hv; }
}
__device__ __forceinline__ void peer_axpy4(const u4 (&R)[4][2], float (&acc)[32], const LAS float* hwp, int grp) {
#pragma unroll
    for (int k = 0; k < 4; ++k) { const float hw = hwp[grp * 4 + k];
#pragma unroll
        for (int j = 0; j < 2; ++j)
#pragma unroll
            for (int q = 0; q < 4; ++q) { const f2 lo = __builtin_amdgcn_cvt_pk_f32_fp8((int)R[k][j][q], false), hi = __builtin_amdgcn_cvt_pk_f32_fp8((int)R[k][j][q], true);
                acc[16 * j + 4 * q] += hw * lo.x; acc[16 * j + 4 * q + 1] += hw * lo.y; acc[16 * j + 4 * q + 2] += hw * hi.x; acc[16 * j + 4 * q + 3] += hw * hi.y; } }
}
__device__ __forceinline__ void unit_peer(const Params& P, unsigned char* ws, int l, LAS unsigned char* lds, int u, int tid_in, int lane_in, int wave, float* __restrict__ xout) {
    int tid = tid_in; asm volatile("" : "+v"(tid)); int lane = tid & 63;
    const int n0 = u * 32;
    const bf16* QPB = (const bf16*)(ws + WS_QP); int* SC = (int*)(ws + WS_SC);
    { const int h = wave, c = lane & 15, kq = lane >> 4;
#pragma unroll 1
        for (int half = 0; half < 2; ++half) {
            const bf16* kb = (const bf16*)(ws + WS_PKB) + ((size_t)(half * DEPTH + l) * 8 + h) * 16384;
            bf16x8 yq[2][4];
#pragma unroll
            for (int tt = 0; tt < 2; ++tt)
#pragma unroll
                for (int ks = 0; ks < 4; ++ks) yq[tt][ks] = *(const bf16x8*)(QPB + (size_t)(n0 + 16 * tt + c) * D + h * 256 + half * 128 + 32 * ks + 8 * kq);
#pragma unroll 1
            for (int kt = 0; kt < 8; ++kt) { bf16x8 xk[4];
#pragma unroll
                for (int ks = 0; ks < 4; ++ks) xk[ks] = *(const bf16x8*)(kb + (size_t)(16 * kt + c) * 128 + 32 * ks + 8 * kq);
#pragma unroll
                for (int tt = 0; tt < 2; ++tt) { f4 a = mk_f4(0.f, 0.f, 0.f, 0.f);
#pragma unroll
                    for (int ks = 0; ks < 4; ++ks) a = MFMA16(xk[ks], yq[tt][ks], a);
                    int kk[4];
#pragma unroll
                    for (int i = 0; i < 4; ++i) { const int bits = __float_as_int(a[i]); const int sk = bits ^ ((bits >> 31) & 0x7fffffff); kk[i] = (sk & ~127) | (127 - (16 * kt + 4 * kq + i)); }
                    u4 w; w.x = (unsigned)kk[0]; w.y = (unsigned)kk[1]; w.z = (unsigned)kk[2]; w.w = (unsigned)kk[3];
                    *(u4*)(SC + ((size_t)(n0 + 16 * tt + c) * 16 + 2 * h + half) * 128 + 16 * kt + 4 * kq) = w; } }
        } }
    VM_WAIT();
    __syncthreads();
    tid = tid_in; asm volatile("" : "+v"(tid)); lane = tid & 63;
    LAS int* TK = (LAS int*)lds;
    { const int tk = tid >> 4, hh = tid & 15;
        const u4* sp = (const u4*)(SC + ((size_t)(n0 + tk) * 16 + hh) * 128);
        int t[16];
#pragma unroll
        for (int k = 0; k < 16; ++k) t[k] = (int)0x80000000;
#pragma unroll 1
        for (int c4 = 0; c4 < 32; ++c4) { const u4 s4 = sp[c4];
#pragma unroll
            for (int e = 0; e < 4; ++e) { int x = (int)s4[e];
#pragma unroll
                for (int k = 0; k < 16; ++k) { const int hi_ = max(t[k], x); x = min(t[k], x); t[k] = hi_; } } }
#pragma unroll
        for (int k = 0; k < 16; ++k) TK[tid * 17 + k] = t[k]; }
    __syncthreads();
    tid = tid_in; asm volatile("" : "+v"(tid)); lane = tid & 63;
    LAS int* PE = (LAS int*)(lds + 69632);
    LAS float* PW = (LAS float*)(lds + 86016);
    if (tid < 256) { const int tk = tid >> 3, h = tid & 7; const int r1 = tk * 16 + 2 * h, r2 = r1 + 1;
        float v1[16], v2[16];
#pragma unroll
        for (int k = 0; k < 16; ++k) { const int k1 = TK[r1 * 17 + k] & ~127, k2 = TK[r2 * 17 + k] & ~127;
            v1[k] = __int_as_float(k1 ^ ((k1 >> 31) & 0x7fffffff)); v2[k] = __int_as_float(k2 ^ ((k2 >> 31) & 0x7fffffff)); }
        int t[16];
#pragma unroll
        for (int k = 0; k < 16; ++k) t[k] = (int)0x80000000;
#pragma unroll
        for (int a = 0; a < 16; ++a)
#pragma unroll
            for (int bq = 0; bq < 16; ++bq) if ((a + 1) * (bq + 1) <= 16) { const int bits = __float_as_int(v1[a] + v2[bq]); const int sk = bits ^ ((bits >> 31) & 0x7fffffff);
                int x = (sk & ~255) | (255 - (a * 16 + bq));
#pragma unroll
                for (int k = 0; k < 16; ++k) { const int hi_ = max(t[k], x); x = min(t[k], x); t[k] = hi_; } }
        float w[16], wsum = 0.f; const int kt0 = t[0] & ~255; const float top = __int_as_float(kt0 ^ ((kt0 >> 31) & 0x7fffffff));
#pragma unroll
        for (int k = 0; k < 16; ++k) { const int kk = t[k] & ~255; const float sv = __int_as_float(kk ^ ((kk >> 31) & 0x7fffffff)); w[k] = __expf(sv - top); wsum += w[k]; }
        const float inv = 1.f / wsum;
#pragma unroll
        for (int k = 0; k < 16; ++k) { const int ab = 255 - (t[k] & 255); const int a = ab >> 4, bq = ab & 15;
            const int i1 = 127 - (TK[r1 * 17 + a] & 127), i2 = 127 - (TK[r2 * 17 + bq] & 127);
            PE[tk * 128 + h * 16 + k] = i1 * 128 + i2; PW[tk * 128 + h * 16 + k] = w[k] * inv; } }
    __syncthreads();
    tid = tid_in; asm volatile("" : "+v"(tid)); lane = tid & 63;
    { int* FE = (int*)(ws + WS_FE) + (size_t)u * 16 * FCAP; float* FW = (float*)(ws + WS_FW) + (size_t)u * 16 * FCAP; int* GST = (int*)(ws + WS_GST) + (size_t)u * 16 * 64;
        LAS int* CNT = (LAS int*)(lds + 118784);
        LAS int* STA = (LAS int*)(lds + 120832);
#pragma unroll 1
        for (int it = 0; it < 4; ++it) { const int tk = wave * 4 + it;
            const int k0 = PE[tk * 128 + lane] >> BSH, k1 = PE[tk * 128 + 64 + lane] >> BSH; int mycnt = 0;
#pragma unroll
            for (int v = 0; v < NBKT; ++v) { const int c = __builtin_popcountll(__builtin_amdgcn_ballot_w64(k0 == v)) + __builtin_popcountll(__builtin_amdgcn_ballot_w64(k1 == v)); if (lane == v) mycnt = (c + PG - 1) & ~(PG - 1); }
            if (lane < NBKT) CNT[tk * 16 + lane] = mycnt; }
        __syncthreads();
        if (tid < NBKT) { int run = 0;
#pragma unroll 1
            for (int t = 0; t < 32; ++t) { STA[t * 16 + tid] = run; run += CNT[t * 16 + tid]; }
            STA[32 * 16 + tid] = run; }
        __syncthreads();
        for (int i = tid; i < NBKT * 33; i += 512) { const int bb = i / 33, t = i % 33; GST[bb * 64 + t] = STA[t * 16 + bb]; }
#pragma unroll 1
        for (int it = 0; it < 4; ++it) { const int tk = wave * 4 + it;
            const int e0 = PE[tk * 128 + lane], e1 = PE[tk * 128 + 64 + lane]; const float w0 = PW[tk * 128 + lane], w1 = PW[tk * 128 + 64 + lane];
            const int k0 = e0 >> BSH, k1 = e1 >> BSH; int pos0 = 0, pos1 = 0;
#pragma unroll
            for (int v = 0; v < NBKT; ++v) { const unsigned long long b0 = __builtin_amdgcn_ballot_w64(k0 == v), b1 = __builtin_amdgcn_ballot_w64(k1 == v);
                const int c0 = __builtin_popcountll(b0), c = c0 + __builtin_popcountll(b1), pc = (c + PG - 1) & ~(PG - 1); const int base = STA[tk * 16 + v];
                const int r0 = (int)__builtin_amdgcn_mbcnt_hi((unsigned)(b0 >> 32), __builtin_amdgcn_mbcnt_lo((unsigned)b0, 0u));
                const int r1 = c0 + (int)__builtin_amdgcn_mbcnt_hi((unsigned)(b1 >> 32), __builtin_amdgcn_mbcnt_lo((unsigned)b1, 0u));
                if (k0 == v) pos0 = v * FCAP + base + r0;
                if (k1 == v) pos1 = v * FCAP + base + r1;
                if (lane < pc - c) { FE[v * FCAP + base + c + lane] = v << BSH; FW[v * FCAP + base + c + lane] = 0.f; } }
            FE[pos0] = e0; FW[pos0] = w0; FE[pos1] = e1; FW[pos1] = w1; } }
    __syncthreads();
}

__device__ __forceinline__ void peer3_rows(u4 (&R)[PG][2], const unsigned char* __restrict__ TAB, int ev, int g, int lane) {
#pragma unroll
    for (int k = 0; k < PG; ++k) { const int e = __builtin_amdgcn_readlane(ev, PG * g + k); const unsigned char* rowp = TAB + (size_t)(unsigned)e * 2048u; R[k][0] = *(const u4*)(rowp + (unsigned)lane * 16u); R[k][1] = *(const u4*)(rowp + 1024u + (unsigned)lane * 16u); }
}
#define DPP_F(v, ctrl) __int_as_float(__builtin_amdgcn_update_dpp(0, __float_as_int(v), (ctrl), 0xf, 0xf, true))
__device__ __forceinline__ float wave_sum_dpp(float v) {
    v += DPP_F(v, 0xB1); v += DPP_F(v, 0x4E); v += DPP_F(v, 0x141); v += DPP_F(v, 0x140);
    const int iv = __float_as_int(v);
    return (__int_as_float(__builtin_amdgcn_readlane(iv, 0)) + __int_as_float(__builtin_amdgcn_readlane(iv, 16))) + (__int_as_float(__builtin_amdgcn_readlane(iv, 32)) + __int_as_float(__builtin_amdgcn_readlane(iv, 48)));
}
__device__ __forceinline__ float dot16_pk(const u4& w, const f2* x) {
    f2 a = {0.f, 0.f};
#pragma unroll
    for (int q = 0; q < 4; ++q) { const f2 lo = __builtin_amdgcn_cvt_pk_f32_fp8((int)w[q], false), hi = __builtin_amdgcn_cvt_pk_f32_fp8((int)w[q], true);
        a = __builtin_elementwise_fma(lo, x[2 * q], a); a = __builtin_elementwise_fma(hi, x[2 * q + 1], a); }
    return a.x + a.y;
}
__device__ __forceinline__ int wave_isum_dpp(int v) {
    v += __builtin_amdgcn_update_dpp(0, v, 0xB1, 0xf, 0xf, true); v += __builtin_amdgcn_update_dpp(0, v, 0x4E, 0xf, 0xf, true);
    v += __builtin_amdgcn_update_dpp(0, v, 0x141, 0xf, 0xf, true); v += __builtin_amdgcn_update_dpp(0, v, 0x140, 0xf, 0xf, true);
    return (__builtin_amdgcn_readlane(v, 0) + __builtin_amdgcn_readlane(v, 16)) + (__builtin_amdgcn_readlane(v, 32) + __builtin_amdgcn_readlane(v, 48));
}
__device__ __forceinline__ int wave_isum4_t(const int (&d)[4], int lane) {
    const bool o1 = lane & 1, o2 = lane & 2;
    int a = o1 ? d[1] : d[0], b = o1 ? d[0] : d[1], c = o1 ? d[3] : d[2], e = o1 ? d[2] : d[3];
    a += __builtin_amdgcn_update_dpp(0, b, 0xB1, 0xf, 0xf, true);
    c += __builtin_amdgcn_update_dpp(0, e, 0xB1, 0xf, 0xf, true);
    int f = o2 ? c : a, g = o2 ? a : c;
    f += __builtin_amdgcn_update_dpp(0, g, 0x4E, 0xf, 0xf, true);
    f += __builtin_amdgcn_update_dpp(0, f, 0x124, 0xf, 0xf, true);
    f += __builtin_amdgcn_update_dpp(0, f, 0x128, 0xf, 0xf, true);
    f += __shfl_xor(f, 16); f += __shfl_xor(f, 32);
    return f;
}
__device__ __forceinline__ void peer3_dots(const u4 (&R)[PG][2], const u4 (&xq)[2], int& dv, int g, int lane) {
    static_assert(PG == 4, "peer3_dots reduces four rows at a time");
    int d[4];
#pragma unroll
    for (int k = 0; k < 4; ++k) { int a = 0;
#pragma unroll
        for (int j = 0; j < 2; ++j)
#pragma unroll
            for (int q = 0; q < 4; ++q) a = __builtin_amdgcn_sdot4((int)R[k][j][q], (int)xq[j][q], a, false);
        d[k] = a; }
    const int t = wave_isum4_t(d, lane);
    dv = (lane >= 4 * g && lane < 4 * g + 4) ? t : dv;
}
__device__ __forceinline__ void peer3_axpy(const u4 (&R)[PG][2], f2 (&acc)[16], int hwv, int g) {
#pragma unroll
    for (int k = 0; k < PG; ++k) { const float hw = __int_as_float(__builtin_amdgcn_readlane(hwv, PG * g + k)); const f2 hw2 = {hw, hw};
#pragma unroll
        for (int j = 0; j < 2; ++j)
#pragma unroll
            for (int q = 0; q < 4; ++q) { const f2 lo = __builtin_amdgcn_cvt_pk_f32_fp8((int)R[k][j][q], false), hi = __builtin_amdgcn_cvt_pk_f32_fp8((int)R[k][j][q], true);
                acc[8 * j + 2 * q] = __builtin_elementwise_fma(lo, hw2, acc[8 * j + 2 * q]); acc[8 * j + 2 * q + 1] = __builtin_elementwise_fma(hi, hw2, acc[8 * j + 2 * q + 1]); }
        __builtin_amdgcn_sched_barrier(0); }
}
__device__ __forceinline__ void unpack_row(const u4 (&X)[4], f2 (&o)[16]) {
#pragma unroll
    for (int i = 0; i < 4; ++i) { o[4 * i].x = __uint_as_float(X[i].x << 16); o[4 * i].y = __uint_as_float(X[i].x & 0xffff0000u); o[4 * i + 1].x = __uint_as_float(X[i].y << 16); o[4 * i + 1].y = __uint_as_float(X[i].y & 0xffff0000u);
        o[4 * i + 2].x = __uint_as_float(X[i].z << 16); o[4 * i + 2].y = __uint_as_float(X[i].z & 0xffff0000u); o[4 * i + 3].x = __uint_as_float(X[i].w << 16); o[4 * i + 3].y = __uint_as_float(X[i].w & 0xffff0000u); }
}
__device__ __forceinline__ void peer3_rowload(u4 (&X)[4], const bf16* __restrict__ base, unsigned n, int lane) {
    const bf16* p = base + (n * (unsigned)D + (unsigned)(16 * lane));
    X[0] = *(const u4*)p; X[1] = *(const u4*)(p + 8); X[2] = *(const u4*)(p + 1024); X[3] = *(const u4*)(p + 1032);
}
__device__ __forceinline__ void peer3_rowstore(bf16* __restrict__ base, unsigned n, int lane, const f2 (&acc)[16]) {
    bf16* p = base + (n * (unsigned)D + (unsigned)(16 * lane));
#pragma unroll
    for (int j = 0; j < 2; ++j) { u4 p0, p1; p0.x = pkbf(acc[8 * j].x, acc[8 * j].y); p0.y = pkbf(acc[8 * j + 1].x, acc[8 * j + 1].y); p0.z = pkbf(acc[8 * j + 2].x, acc[8 * j + 2].y); p0.w = pkbf(acc[8 * j + 3].x, acc[8 * j + 3].y);
        p1.x = pkbf(acc[8 * j + 4].x, acc[8 * j + 4].y); p1.y = pkbf(acc[8 * j + 5].x, acc[8 * j + 5].y); p1.z = pkbf(acc[8 * j + 6].x, acc[8 * j + 6].y); p1.w = pkbf(acc[8 * j + 7].x, acc[8 * j + 7].y);
        __builtin_nontemporal_store(p0, (u4*)(p + 1024 * j)); __builtin_nontemporal_store(p1, (u4*)(p + 1024 * j + 8)); }
}
__device__ __forceinline__ int peer3_next_nonempty(int gstv, int t) {
    while (t < 32 && __builtin_amdgcn_readlane(gstv, t + 1) == __builtin_amdgcn_readlane(gstv, t)) ++t;
    return t;
}
__device__ __forceinline__ void phase_peer_bucket(const Params& P, unsigned char* ws, int l, int bid, int G, int lane, int wave) {
    const int x = bid & 7, r = bid >> 3;
    const int u = r * 8 + wave; const unsigned nbase = (unsigned)u * 32u;
    const unsigned char* PU = ws + WS_PU + (size_t)l * 16384 * 2048; const unsigned char* PV = ws + WS_PV + (size_t)l * 16384 * 2048;
    const float* USC = (const float*)(ws + WS_PSC) + (size_t)l * 16384; const float* VSC = (const float*)(ws + WS_PSC) + (size_t)(DEPTH + l) * 16384;
    const bf16* X1B = (const bf16*)(ws + WS_X1B);
    bf16* PART = (bf16*)(ws + WS_PART) + (size_t)x * NTOK * D;
#pragma unroll 1
    for (int rnd = 0; rnd < NRND; ++rnd) { const int xb = x + 8 * rnd;
        const int* FE = (const int*)(ws + WS_FE) + ((size_t)u * 16 + xb) * FCAP; const float* FW = (const float*)(ws + WS_FW) + ((size_t)u * 16 + xb) * FCAP; float* FHW = (float*)(ws + WS_FHW) + ((size_t)u * 16 + xb) * FCAP;
        int gstv = 0; if (lane <= 32) gstv = ((const int*)(ws + WS_GST))[((size_t)u * 16 + xb) * 64 + lane];
        const int total = __builtin_amdgcn_readlane(gstv, 32);
        if (total > 0) {
            const unsigned char* X1Q = ws + WS_X1Q; const float* XSC = (const float*)(ws + WS_XSC);
            int tcur = peer3_next_nonempty(gstv, 0); int tnx = peer3_next_nonempty(gstv, tcur + 1); int tend = __builtin_amdgcn_readlane(gstv, tcur + 1);
            u4 xq[2], xn[2];
            { const unsigned char* p = X1Q + (size_t)(nbase + tcur) * 2048u + (unsigned)lane * 16u; xq[0] = __builtin_nontemporal_load((const u4*)p); xq[1] = __builtin_nontemporal_load((const u4*)(p + 1024)); }
            if (tnx < 32) { const unsigned char* p = X1Q + (size_t)(nbase + tnx) * 2048u + (unsigned)lane * 16u; xn[0] = __builtin_nontemporal_load((const u4*)p); xn[1] = __builtin_nontemporal_load((const u4*)(p + 1024)); }
            float xs = XSC[nbase + tcur];
#pragma unroll 1
            for (int blk = 0; blk < total; blk += 64) { const int blen = (total - blk) < 64 ? (total - blk) : 64, ng = blen / PG;
                int ev = 0; float wv = 0.f;
                if (lane < blen) { ev = __builtin_nontemporal_load(FE + blk + lane); wv = __builtin_nontemporal_load(FW + blk + lane); }
                const float us = USC[ev], vs = VSC[ev];
                int dv = 0; float xsv = 0.f; u4 A[PG][2], B[PG][2];
                peer3_rows(A, PU, ev, 0, lane);
#pragma unroll 1
                for (int g = 0; g < ng; g += 2) {
                    if (g + 1 < ng) peer3_rows(B, PU, ev, g + 1, lane);
                    if (blk + PG * g >= tend) { tcur = tnx; xq[0] = xn[0]; xq[1] = xn[1]; xs = XSC[nbase + tcur]; tend = __builtin_amdgcn_readlane(gstv, tcur + 1);
                        tnx = peer3_next_nonempty(gstv, tcur + 1); if (tnx < 32) { const unsigned char* p = X1Q + (size_t)(nbase + tnx) * 2048u + (unsigned)lane * 16u; xn[0] = __builtin_nontemporal_load((const u4*)p); xn[1] = __builtin_nontemporal_load((const u4*)(p + 1024)); } }
                    peer3_dots(A, xq, dv, g, lane);
                    xsv = (lane >= PG * g && lane < PG * g + PG) ? xs : xsv;
                    __builtin_amdgcn_sched_barrier(0);
                    if (g + 2 < ng) peer3_rows(A, PU, ev, g + 2, lane);
                    if (g + 1 < ng) {
                        if (blk + PG * (g + 1) >= tend) { tcur = tnx; xq[0] = xn[0]; xq[1] = xn[1]; xs = XSC[nbase + tcur]; tend = __builtin_amdgcn_readlane(gstv, tcur + 1);
                            tnx = peer3_next_nonempty(gstv, tcur + 1); if (tnx < 32) { const unsigned char* p = X1Q + (size_t)(nbase + tnx) * 2048u + (unsigned)lane * 16u; xn[0] = __builtin_nontemporal_load((const u4*)p); xn[1] = __builtin_nontemporal_load((const u4*)(p + 1024)); } }
                        peer3_dots(B, xq, dv, g + 1, lane);
                        xsv = (lane >= PG * (g + 1) && lane < PG * (g + 1) + PG) ? xs : xsv; }
                    __builtin_amdgcn_sched_barrier(0);
                }
                if (lane < blen) FHW[blk + lane] = wv * gelu_tanh((float)dv * us * xsv) * vs;
            } }
        VM_WAIT();
        { f2 acc[16];
            if (rnd == 0) {
#pragma unroll
                for (int i = 0; i < 16; ++i) acc[i] = (f2){0.f, 0.f};
#pragma unroll 1
                for (int t = 0; t < 32; ++t) if (__builtin_amdgcn_readlane(gstv, t + 1) == __builtin_amdgcn_readlane(gstv, t)) peer3_rowstore(PART, nbase + t, lane, acc); }
            if (total > 0) {
                int tcur = peer3_next_nonempty(gstv, 0); int tnx = peer3_next_nonempty(gstv, tcur + 1); int tend = __builtin_amdgcn_readlane(gstv, tcur + 1);
                u4 xn[4];
                if (rnd > 0) { u4 xq[4]; peer3_rowload(xq, PART, nbase + tcur, lane); if (tnx < 32) peer3_rowload(xn, PART, nbase + tnx, lane); unpack_row(xq, acc); }
                else {
#pragma unroll
                    for (int i = 0; i < 16; ++i) acc[i] = (f2){0.f, 0.f}; }
#pragma unroll 1
                for (int blk = 0; blk < total; blk += 64) { const int blen = (total - blk) < 64 ? (total - blk) : 64, ng = blen / PG;
                    int ev = 0, hwv = 0;
                    if (lane < blen) { ev = __builtin_nontemporal_load(FE + blk + lane); hwv = (int)__hip_atomic_load((const unsigned*)(FHW + blk + lane), __ATOMIC_RELAXED, __HIP_MEMORY_SCOPE_AGENT); }
                    u4 A[PG][2], B[PG][2];
                    peer3_rows(A, PV, ev, 0, lane);
#pragma unroll 1
                    for (int g = 0; g < ng; g += 2) {
                        if (g + 1 < ng) peer3_rows(B, PV, ev, g + 1, lane);
                        if (blk + PG * g >= tend) { peer3_rowstore(PART, nbase + tcur, lane, acc); tcur = tnx; tend = __builtin_amdgcn_readlane(gstv, tcur + 1);
                            if (rnd > 0) { unpack_row(xn, acc); }
                            else {
#pragma unroll
                                for (int i = 0; i < 16; ++i) acc[i] = (f2){0.f, 0.f}; }
                            tnx = peer3_next_nonempty(gstv, tcur + 1); if (rnd > 0 && tnx < 32) peer3_rowload(xn, PART, nbase + tnx, lane); }
                        peer3_axpy(A, acc, hwv, g);
                        __builtin_amdgcn_sched_barrier(0);
                        if (g + 2 < ng) peer3_rows(A, PV, ev, g + 2, lane);
                        if (g + 1 < ng) {
                            if (blk + PG * (g + 1) >= tend) { peer3_rowstore(PART, nbase + tcur, lane, acc); tcur = tnx; tend = __builtin_amdgcn_readlane(gstv, tcur + 1);
                                if (rnd > 0) { unpack_row(xn, acc); }
                                else {
#pragma unroll
                                    for (int i = 0; i < 16; ++i) acc[i] = (f2){0.f, 0.f}; }
                                tnx = peer3_next_nonempty(gstv, tcur + 1); if (rnd > 0 && tnx < 32) peer3_rowload(xn, PART, nbase + tnx, lane); }
                            peer3_axpy(B, acc, hwv, g + 1); }
                        __builtin_amdgcn_sched_barrier(0);
                    } }
                peer3_rowstore(PART, nbase + tcur, lane, acc);
            } }
        VM_WAIT();
    }
}
__device__ __forceinline__ void row_peer_reduce(const Params& P, unsigned char* ws, int l, int rowi, int lane, float* __restrict__ xout) {
    const size_t n = (size_t)rowi; const float* X1 = (const float*)(ws + WS_X1); const bf16* PART = (const bf16*)(ws + WS_PART);
    float acc[32];
#pragma unroll
    for (int j = 0; j < 2; ++j)
#pragma unroll
        for (int q = 0; q < 4; ++q) { const f4 a = *(const f4*)(X1 + n * D + 1024 * j + 16 * lane + 4 * q); acc[16 * j + 4 * q] = ALPHA * a.x; acc[16 * j + 4 * q + 1] = ALPHA * a.y; acc[16 * j + 4 * q + 2] = ALPHA * a.z; acc[16 * j + 4 * q + 3] = ALPHA * a.w; }
#pragma unroll 2
    for (int xb_ = 0; xb_ < 8; ++xb_) { const bf16* pp = PART + ((size_t)xb_ * NTOK + n) * D;
#pragma unroll
        for (int j = 0; j < 2; ++j) { const u4 a = *(const u4*)(pp + 1024 * j + 16 * lane), bq = *(const u4*)(pp + 1024 * j + 16 * lane + 8); float f[16]; unpack8(a, f); unpack8(bq, f + 8);
#pragma unroll
            for (int i = 0; i < 16; ++i) acc[16 * j + i] += f[i]; } }
    float s = 0.f;
#pragma unroll
    for (int i = 0; i < 32; ++i) s += acc[i];
    const float mu = wave_sum(s) * (1.f / D); float s2 = 0.f;
#pragma unroll
    for (int i = 0; i < 32; ++i) { acc[i] -= mu; s2 += acc[i] * acc[i]; }
    const float rstd = rsqrtf(wave_sum(s2) * (1.f / D) + LN_EPS);
    const float* gam = P.in[23] + (size_t)l * D; const float* bet = P.in[24] + (size_t)l * D;
    bf16* xb = (bf16*)(ws + WS_XB);
#pragma unroll
    for (int j = 0; j < 2; ++j) { const int col = 1024 * j + 16 * lane; float o[16];
#pragma unroll
        for (int q = 0; q < 4; ++q) { const f4 g4 = *(const f4*)(gam + col + 4 * q), b4 = *(const f4*)(bet + col + 4 * q);
            o[4 * q] = acc[16 * j + 4 * q] * rstd * g4.x + b4.x; o[4 * q + 1] = acc[16 * j + 4 * q + 1] * rstd * g4.y + b4.y; o[4 * q + 2] = acc[16 * j + 4 * q + 2] * rstd * g4.z + b4.z; o[4 * q + 3] = acc[16 * j + 4 * q + 3] * rstd * g4.w + b4.w;
            *(f4*)(xout + n * D + col + 4 * q) = mk_f4(o[4 * q], o[4 * q + 1], o[4 * q + 2], o[4 * q + 3]); }
        u4 p0, p1; p0.x = pk2(o[0], o[1]); p0.y = pk2(o[2], o[3]); p0.z = pk2(o[4], o[5]); p0.w = pk2(o[6], o[7]); p1.x = pk2(o[8], o[9]); p1.y = pk2(o[10], o[11]); p1.z = pk2(o[12], o[13]); p1.w = pk2(o[14], o[15]);
        *(u4*)(xb + n * D + col) = p0; *(u4*)(xb + n * D + col + 8) = p1; }
}

template <class T> __device__ __forceinline__ T* uniform_ptr(T* p) { const unsigned long long v = (unsigned long long)p; const unsigned lo = __builtin_amdgcn_readfirstlane((unsigned)v), hi = __builtin_amdgcn_readfirstlane((unsigned)(v >> 32)); return (T*)(__attribute__((address_space(1))) T*)(((unsigned long long)hi << 32) | lo); }
constexpr int PH_PER_LAYER = 10, N_PHASES = 1 + DEPTH * PH_PER_LAYER;
#ifndef ONLY_PHASE
#define ONLY_PHASE -1
#endif
#define EN(i) (ONLY_PHASE < 0 || ONLY_PHASE == (i))
__global__ void __launch_bounds__(512, 2) mk_fwd(Params P) {
    extern __shared__ __attribute__((aligned(16))) unsigned char lds_raw[];
    LAS unsigned char* lds = (LAS unsigned char*)lds_raw;
    volatile LAS unsigned* MISC = (volatile LAS unsigned*)(lds + MISC_OFF);
    const int tid = threadIdx.x, lane = tid & 63, wave = __builtin_amdgcn_readfirstlane(tid >> 6);
    const int G = gridDim.x, bid = blockIdx.x;
    if (tid < 64) MISC[tid] = 0u;
    __syncthreads();
    unsigned char* const ws = uniform_ptr(P.ws);
    unsigned* ctl = (unsigned*)(ws + WS_CTL);
    const XcdBarrier bar = xcd_barrier_post(ctl + CW_BAR, MISC + 8);
    const int lo = P.ph_lo, hi = P.ph_hi;
#define IN(k) (lo <= (k) && (k) < hi)
#define LAUNDER() int tl; asm volatile("v_mbcnt_lo_u32_b32 %0, -1, 0\n\tv_mbcnt_hi_u32_b32 %0, -1, %0" : "=v"(tl)); tl |= (wave << 6); const int ll = tl & 63; const int wl = __builtin_amdgcn_readfirstlane(tl >> 6); (void)ll; (void)wl
#define SEAM(k) do { if (IN((k) + 1)) xcd_barrier(bar); } while (0)
    if (IN(0) && EN(20)) { LAUNDER(); REP(20) phase_prologue(P, ws, lds, tl, ll, wl); SEAM(0); }
    for (int l = 0; l < DEPTH; ++l) {
        const int pb = 1 + l * PH_PER_LAYER;
        const float* xres = (l == 0) ? P.in[0] : (const float*)(ws + WS_XC);
        float* xout = (l == DEPTH - 1) ? P.out : (float*)(ws + WS_XC);
        if (IN(pb + 0) && EN(0)) { LAUNDER();
            pg8::Gemm g{(const pg8::bf16_t*)(ws + WS_XB), (const pg8::bf16_t*)(ws + WS_WIN) + (size_t)l * INWP * D, NTOK, INWP, D};
            pg8::StaticOrder S; S.init(NTOK, INWP, G, bid);
            pg8::EpiH E{(pg8::bf16_t*)(ws + WS_H), INWP, 6, 10};
            REP(0) pg8::gemm_phase<pg8::EpiH, pg8::StaticOrder, true, true>(lds, g, S, E, tl);
            SEAM(pb + 0);
        }
        if (IN(pb + 1) && EN(1)) { LAUNDER();
            REP(1) for (int u = bid; u < 240; u += G) unit_kvstate_mfma(P, ws, lds, u, tl);
            REP(13) for (int u = bid; u < 256; u += G) unit_sgu_mfma(P, ws, l, lds, u, tl, ll, wl);
            REP(12) for (int u = bid; u < 256; u += G) unit_compress_mfma(P, ws, l, lds, u, tl);
            SEAM(pb + 1);
        }
        if (IN(pb + 2) && EN(2)) { LAUNDER();
            REP(10) for (int u = bid; u < 256; u += G) unit_retention_mfma(P, ws, l, lds, u, tl);
            REP(11) for (int u = bid; u < 512; u += G) unit_nsa(P, ws, l, lds, u, tl);
            SEAM(pb + 2);
        }
        if (IN(pb + 3) && EN(3)) { LAUNDER();
            REP(3) for (int r = bid * 8 + wl; r < NTOK; r += G * 8) row_mixnorm(P, ws, l, r, ll);
            SEAM(pb + 3);
        }
        if (IN(pb + 4) && EN(4)) { LAUNDER();
            pg8::Gemm g{(const pg8::bf16_t*)(ws + WS_MIXED), (const pg8::bf16_t*)(ws + WS_WOUT) + (size_t)l * D * D, NTOK, D, D};
            pg8::StaticOrder S; S.init(NTOK, D, G, bid);
            pg8::EpiRes E{(float*)(ws + WS_Z), xres, D, ALPHA};
            REP(4) pg8::gemm_phase<pg8::EpiRes, pg8::StaticOrder, true, true>(lds, g, S, E, tl);
            SEAM(pb + 4);
        }
        if (IN(pb + 5) && EN(5)) { LAUNDER();
            REP(5) for (int r = bid * 8 + wl; r < NTOK; r += G * 8) row_ln((const float*)(ws + WS_Z), P.in[16] + (size_t)l * D, P.in[17] + (size_t)l * D, (float*)(ws + WS_X1), (bf16*)(ws + WS_X1B), (unsigned*)(ws + WS_X1Q), (float*)(ws + WS_XSC), r, ll);
            SEAM(pb + 5);
        }
        if (IN(pb + 6) && EN(6)) { LAUNDER();
            pg8::Gemm g{(const pg8::bf16_t*)(ws + WS_X1B), (const pg8::bf16_t*)(ws + WS_WQ) + (size_t)l * D * D, NTOK, D, D};
            pg8::StaticOrder S; S.init(NTOK, D, G, bid);
            pg8::EpiH E{(pg8::bf16_t*)(ws + WS_QP), D, 0, 0};
            pg8::gemm_phase<pg8::EpiH, pg8::StaticOrder, true, true>(lds, g, S, E, tl);
            SEAM(pb + 6);
        }
        if (IN(pb + 7) && EN(7)) { LAUNDER();
            REP(7) for (int u = bid; u < NTOK / 32; u += G) unit_peer(P, ws, l, lds, u, tl, ll, wl, xout);
            SEAM(pb + 7);
        }
        if (IN(pb + 8) && EN(8)) { LAUNDER();
            REP(8) phase_peer_bucket(P, ws, l, bid, G, ll, wl);
            SEAM(pb + 8);
        }
        if (IN(pb + 9) && EN(9)) { LAUNDER();
            REP(9) for (int r = bid * 8 + wl; r < NTOK; r += G * 8) row_peer_reduce(P, ws, l, r, ll, xout);
            SEAM(pb + 9);
        }
    }
#undef IN
#undef SEAM
}

#ifndef MK_ONE_LAUNCH
#define MK_ONE_LAUNCH 1
#endif
extern "C" void kernel_launch(void* const* d_in, const int* in_sizes, int n_in, void* d_out, int out_size, void* d_ws, size_t ws_size, hipStream_t stream) {
    static int grid = 0;
    if (grid == 0) {
        if (n_in != 25 || out_size != NTOK * D || ws_size < WS_END) { fprintf(stderr, "kernel_launch: unexpected shapes: n_in %d out %d ws %zu (need %zu)\n", n_in, out_size, ws_size, (size_t)WS_END); grid = -1; return; }
        int dev = 0, cus = 0, per_cu = 0;
        if (hipGetDevice(&dev) != hipSuccess || hipDeviceGetAttribute(&cus, hipDeviceAttributeMultiprocessorCount, dev) != hipSuccess) { grid = -1; return; }
        if (hipFuncSetAttribute((const void*)mk_fwd, hipFuncAttributeMaxDynamicSharedMemorySize, LDS_BYTES) != hipSuccess) { fprintf(stderr, "kernel_launch: hipFuncSetAttribute failed\n"); grid = -1; return; }
        if (hipOccupancyMaxActiveBlocksPerMultiprocessor(&per_cu, (const void*)mk_fwd, 512, LDS_BYTES) != hipSuccess || per_cu < 1) fprintf(stderr, "kernel_launch: occupancy query says %d\n", per_cu);
        (void)hipGetLastError();
        grid = cus;
    }
    if (grid < 0) return;
    (void)hipMemsetAsync((char*)d_ws + WS_CTL, 0, CTL_ZERO_BYTES, stream);
    Params p{};
    for (int i = 0; i < 25; ++i) p.in[i] = (const float*)d_in[i];
    p.out = (float*)d_out; p.ws = (unsigned char*)d_ws;
    for (int i = 0; i < 32; ++i) p.inv_rev[i] = pow(10000.0, -(double)i / 32.0) / (2.0 * 3.14159265358979323846);
    for (int h = 0; h < 4; ++h) p.lg2[h] = (float)log2(1.0 - pow(2.0, -5.0 - (double)h));
#if MK_ONE_LAUNCH
    p.ph_lo = 0; p.ph_hi = N_PHASES; p.use_bar = 1;
    hipLaunchKernelGGL(mk_fwd, dim3(grid), dim3(512), LDS_BYTES, stream, p);
#else
    for (int k = 0; k < N_PHASES; ++k) { p.ph_lo = k; p.ph_hi = k + 1; p.use_bar = 0;
        hipLaunchKernelGGL(mk_fwd, dim3(grid), dim3(512), LDS_BYTES, stream, p); }
#endif
}
```

```cpp
#include <hip/hip_runtime.h>
#include <cstdio>
#include <cstdint>
#include <cmath>
#define LAS __attribute__((address_space(3)))
namespace pg8 {
#define PG8_LAS __attribute__((address_space(3)))
typedef unsigned short bf16_t;
typedef short bf16x8 __attribute__((ext_vector_type(8)));
typedef float f32x4 __attribute__((ext_vector_type(4)));
typedef unsigned u32x4 __attribute__((ext_vector_type(4)));
constexpr int BM = 256, BK = 64, HALF = 128, HTB = HALF * BK * 2  , STAGE_BYTES = 8 * HTB, NXCD = 8, WGM = 8;

__host__ __device__ __forceinline__ int lds_byte(int r, int c) { const int st = (r >> 4) * 2 + (c >> 5), rr = r & 15, cc = c & 31, ob = rr * 64 + cc * 2; return st * 1024 + (ob ^ (((ob >> 9) & 1) << 5)); }
__host__ __device__ __forceinline__ void stage_rc(int b, int& R, int& C) { const int st = b / 1024, sb = b % 1024, swz = sb ^ (((sb >> 9) & 1) << 5); R = (st >> 1) * 16 + swz / 64; C = (st & 1) * 32 + (swz % 64) / 2; }
__host__ __device__ __forceinline__ int perm32(int rho) { const int n = rho >> 4, i = rho & 15; return 8 * (i >> 2) + 4 * n + (i & 3); }

struct Unit { int pm, pn; };
struct Gemm { const bf16_t* A; const bf16_t* Bt; int M, N, K; };

struct StaticOrder {
    int nM, nN, nwg, G, c;
    __host__ __device__ void init(int M, int N, int G_, int c_) { nM = M / BM; nN = N / BM; nwg = nM * nN; G = G_; c = c_; }
    __host__ __device__ bool next(int i, Unit& u) const {
        const long L = (long)i * G + c; if (L >= nwg) return false;
        int wgid = (int)L; { const int q = nwg / NXCD, r = nwg % NXCD, xcd = wgid % NXCD, off = wgid / NXCD; wgid = (xcd < r ? xcd * (q + 1) : r * (q + 1) + (xcd - r) * q) + off; }
        const int nig = WGM * nN, gid = wgid / nig, fm = gid * WGM, gsz = (nM - fm) < WGM ? (nM - fm) : WGM;
        u.pm = fm + ((wgid % nig) % gsz); u.pn = (wgid % nig) / gsz; return true;
    }
    __device__ __forceinline__ void a_ready(const Unit&) const {}
    __device__ __forceinline__ void done(const Unit&) const {}
};
__device__ __forceinline__ unsigned cvt_pk_bf16(float lo, float hi) { unsigned r; asm volatile("v_cvt_pk_bf16_f32 %0, %1, %2" : "=v"(r) : "v"(lo), "v"(hi)); return r; }
typedef float f32x2 __attribute__((ext_vector_type(2)));
__device__ __forceinline__ float gelu_tanh_f(float x) {
    const float u = 1.5957691216057308f * (x + 0.044715f * x * x * x);
    return x * __builtin_amdgcn_rcpf(1.0f + __expf(-u));
}
struct EpiH {
    static constexpr bool PERM = true, AFTER_DRAIN = false;
    bf16_t* O; int ldc; int act_lo, act_hi;
    __device__ __forceinline__ void operator()(const f32x4 (&acc)[2][2][4][2], const Unit& u, int wr, int wc, int fr, int fq) const {
        const int row0 = u.pm * BM + wr * 64 + fr; const int col0 = u.pn * BM + wc * 32 + 8 * fq;
        const bool act = (u.pn >= act_lo) && (u.pn < act_hi);
#pragma unroll
        for (int ai = 0; ai < 2; ++ai)
#pragma unroll
            for (int m = 0; m < 4; ++m) { bf16_t* rowp = O + (size_t)(row0 + ai * HALF + m * 16) * ldc + col0;
#pragma unroll
                for (int bj = 0; bj < 2; ++bj) { f32x4 v0 = acc[ai][bj][m][0], v1 = acc[ai][bj][m][1];
                    if (act) {
#pragma unroll
                        for (int j = 0; j < 4; ++j) { v0[j] = gelu_tanh_f(v0[j]); v1[j] = gelu_tanh_f(v1[j]); } }
                    u32x4 w; w.x = cvt_pk_bf16(v0[0], v0[1]); w.y = cvt_pk_bf16(v0[2], v0[3]); w.z = cvt_pk_bf16(v1[0], v1[1]); w.w = cvt_pk_bf16(v1[2], v1[3]);
                    *(u32x4*)(rowp + bj * HALF) = w; } }
    }
};
struct EpiRes {
    static constexpr bool PERM = false, AFTER_DRAIN = false;
    float* C; const float* X; int ldc; float alpha;
    __device__ __forceinline__ void operator()(const f32x4 (&acc)[2][2][4][2], const Unit& u, int wr, int wc, int fr, int fq) const {
        const int row0 = u.pm * BM + wr * 64 + fr, col0 = u.pn * BM + wc * 32 + 4 * fq;
#pragma unroll
        for (int ai = 0; ai < 2; ++ai)
#pragma unroll
            for (int m = 0; m < 4; ++m) { const size_t off = (size_t)(row0 + ai * HALF + m * 16) * ldc + col0;
#pragma unroll
                for (int bj = 0; bj < 2; ++bj)
#pragma unroll
                    for (int n = 0; n < 2; ++n) { const size_t o2 = off + bj * HALF + n * 16; const f32x4 xv = *(const f32x4*)(X + o2); *(f32x4*)(C + o2) = acc[ai][bj][m][n] + xv * alpha; } }
    }
};
struct EpiF32 {
    static constexpr bool PERM = false, AFTER_DRAIN = false;
    float* C; int ldc;
    __device__ __forceinline__ void operator()(const f32x4 (&acc)[2][2][4][2], const Unit& u, int wr, int wc, int fr, int fq) const {
        const int row0 = u.pm * BM + wr * 64 + fr, col0 = u.pn * BM + wc * 32 + 4 * fq;
#pragma unroll
        for (int ai = 0; ai < 2; ++ai)
#pragma unroll
            for (int m = 0; m < 4; ++m) { float* rowp = C + (size_t)(row0 + ai * HALF + m * 16) * ldc + col0;
#pragma unroll
                for (int bj = 0; bj < 2; ++bj)
#pragma unroll
                    for (int n = 0; n < 2; ++n) *(f32x4*)(rowp + bj * HALF + n * 16) = acc[ai][bj][m][n]; }
    }
};
template <class Epi, class Sched, bool ALIGN_EPI = false, bool SP2 = false>
__device__ __forceinline__ void gemm_phase(PG8_LAS unsigned char* lds, const Gemm g, const Sched& S, const Epi& E, const int tid) {
    const int wid = __builtin_amdgcn_readfirstlane(tid >> 6), lane = tid & 63, wr = wid >> 2, wc = wid & 3, fr = lane & 15, fq = lane >> 4;
    const int K = g.K, nt = K / BK;
    unsigned voffA[2], voffB[2];
#pragma unroll
    for (int i = 0; i < 2; ++i) { int R, C; stage_rc(tid * 16 + i * 8192, R, C); const int Rb = Epi::PERM ? ((R & ~31) + perm32(R & 31)) : R;
        voffA[i] = (unsigned)(R * K + C) * 2u; voffB[i] = (unsigned)(Rb * K + C) * 2u; }
    const size_t kstep = (size_t)(BK * 2);
    const size_t hstep = (size_t)HALF * K * 2;
    const size_t tstep = 2 * hstep;
    const unsigned ldsw = (unsigned)wid * 1024u;
    const int aoff = lds_byte(wr * 64 + fr, fq * 8), boff = lds_byte(wc * 32 + fr, fq * 8);
#define PG8_SA(b, h) (((b) * 2 + (h)) * HTB)
#define PG8_SB(b, h) ((4 + (b) * 2 + (h)) * HTB)
#define PG8_STAGE(bufoff, gbase, voff) do { _Pragma("unroll") for (int _i = 0; _i < 2; ++_i) \
        __builtin_amdgcn_global_load_lds((const unsigned*)((const char*)(gbase) + (voff)[_i]), (PG8_LAS unsigned*)(lds + (bufoff) + ldsw + _i * 8192), 16, 0, 0); } while (0)
#define PG8_LDA(dst, b, h) do { _Pragma("unroll") for (int m = 0; m < 4; ++m) _Pragma("unroll") for (int k = 0; k < 2; ++k) dst[m][k] = *(const PG8_LAS bf16x8*)(lds + PG8_SA(b, h) + aoff + m * 2048 + k * 1024); } while (0)
#define PG8_LDB(dst, b, h) do { _Pragma("unroll") for (int n = 0; n < 2; ++n) _Pragma("unroll") for (int k = 0; k < 2; ++k) dst[n][k] = *(const PG8_LAS bf16x8*)(lds + PG8_SB(b, h) + boff + n * 2048 + k * 1024); } while (0)
#define PG8_MMA(ai, bj, At, Bt) do { __builtin_amdgcn_s_setprio(1); _Pragma("unroll") for (int m = 0; m < 4; ++m) _Pragma("unroll") for (int n = 0; n < 2; ++n) _Pragma("unroll") for (int k = 0; k < 2; ++k) \
        acc[ai][bj][m][n] = __builtin_amdgcn_mfma_f32_16x16x32_bf16(Bt[n][k], At[m][k], acc[ai][bj][m][n], 0, 0, 0); __builtin_amdgcn_s_setprio(0); } while (0)
#define PG8_WAIT_V(n) asm volatile("s_waitcnt vmcnt(" #n ")" ::: "memory")
#define PG8_WAIT_L(n) asm volatile("s_waitcnt lgkmcnt(" #n ")" ::: "memory")
#define PG8_BAR __builtin_amdgcn_s_barrier()
#define PG8_SCHED __builtin_amdgcn_sched_barrier(0)
    Unit cur, nxt; int ui = 0;
    if (!S.next(0, cur)) return;
    f32x4 acc[2][2][4][2];
#pragma unroll
    for (int a = 0; a < 2; ++a)
#pragma unroll
        for (int b = 0; b < 2; ++b)
#pragma unroll
            for (int m = 0; m < 4; ++m)
#pragma unroll
                for (int n = 0; n < 2; ++n) acc[a][b][m][n] = (f32x4){0.f, 0.f, 0.f, 0.f};
    bf16x8 At[4][2], B0[2][2], B1[2][2];
    const char* cA = (const char*)g.A + (size_t)cur.pm * tstep; const char* cB = (const char*)g.Bt + (size_t)cur.pn * tstep;
    S.a_ready(cur);
    if constexpr (SP2) {
        PG8_STAGE(PG8_SB(0, 0), cB, voffB); PG8_STAGE(PG8_SB(0, 1), cB + hstep, voffB); PG8_STAGE(PG8_SA(0, 0), cA, voffA); PG8_STAGE(PG8_SA(0, 1), cA + hstep, voffA);
        if (wr == 1) PG8_BAR;
        PG8_WAIT_V(2); PG8_BAR;
        PG8_STAGE(PG8_SB(1, 0), cB + kstep, voffB); PG8_STAGE(PG8_SA(1, 0), cA + kstep, voffA); PG8_STAGE(PG8_SB(1, 1), cB + hstep + kstep, voffB);
        PG8_WAIT_V(6); PG8_BAR;
    } else {
        PG8_STAGE(PG8_SB(0, 0), cB, voffB); PG8_STAGE(PG8_SA(0, 0), cA, voffA); PG8_STAGE(PG8_SB(0, 1), cB + hstep, voffB); PG8_STAGE(PG8_SA(0, 1), cA + hstep, voffA);
        if (wr == 1) PG8_BAR;
        PG8_WAIT_V(4); PG8_BAR;
        PG8_STAGE(PG8_SB(1, 0), cB + kstep, voffB); PG8_STAGE(PG8_SA(1, 0), cA + kstep, voffA); PG8_STAGE(PG8_SB(1, 1), cB + hstep + kstep, voffB);
        PG8_WAIT_V(6); PG8_BAR;
    }
    for (;;) {
        const bool has_next = S.next(ui + 1, nxt);
        const char* nA = has_next ? (const char*)g.A + (size_t)nxt.pm * tstep : cA; const char* nB = has_next ? (const char*)g.Bt + (size_t)nxt.pn * tstep : cB;
        for (int t = 0; t < nt; t += 2) {
            const bool last = (t == nt - 2);
            const char* a1 = cA + (size_t)(t + 1) * kstep;
            const char* a2 = last ? nA : cA + (size_t)(t + 2) * kstep; const char* b2 = last ? nB : cB + (size_t)(t + 2) * kstep;
            const char* a3 = a2 + kstep; const char* b3 = b2 + kstep;
            if (last && has_next) S.a_ready(nxt);
            if constexpr (SP2) {
            PG8_LDB(B0, 0, 0); PG8_LDB(B1, 0, 1); PG8_SCHED; PG8_LDA(At, 0, 0); PG8_STAGE(PG8_SA(1, 1), a1 + hstep, voffA);
            PG8_WAIT_V(8); PG8_WAIT_L(0); PG8_BAR; PG8_MMA(0, 0, At, B0); PG8_MMA(0, 1, At, B1); PG8_BAR; PG8_SCHED;
            PG8_LDA(At, 0, 1); PG8_STAGE(PG8_SB(0, 0), b2, voffB); PG8_STAGE(PG8_SB(0, 1), b2 + hstep, voffB); PG8_STAGE(PG8_SA(0, 0), a2, voffA);
            PG8_WAIT_V(8); PG8_WAIT_L(0); PG8_BAR; PG8_MMA(1, 0, At, B0); PG8_MMA(1, 1, At, B1); PG8_BAR; PG8_SCHED;
            PG8_LDB(B0, 1, 0); PG8_LDB(B1, 1, 1); PG8_SCHED; PG8_LDA(At, 1, 0); PG8_STAGE(PG8_SA(0, 1), a2 + hstep, voffA);
            PG8_WAIT_V(8); PG8_WAIT_L(0); PG8_BAR; PG8_MMA(0, 0, At, B0); PG8_MMA(0, 1, At, B1); PG8_BAR; PG8_SCHED;
            PG8_LDA(At, 1, 1); PG8_STAGE(PG8_SB(1, 0), b3, voffB); PG8_STAGE(PG8_SB(1, 1), b3 + hstep, voffB); PG8_STAGE(PG8_SA(1, 0), a3, voffA);
            PG8_WAIT_V(8); PG8_WAIT_L(0); PG8_BAR; PG8_MMA(1, 0, At, B0); PG8_MMA(1, 1, At, B1); PG8_BAR; PG8_SCHED;
            } else {
            PG8_LDB(B0, 0, 0); PG8_SCHED; PG8_LDA(At, 0, 0); PG8_STAGE(PG8_SA(1, 1), a1 + hstep, voffA);
            PG8_WAIT_L(8); PG8_BAR; PG8_WAIT_L(0); PG8_MMA(0, 0, At, B0); PG8_BAR; PG8_SCHED;
            PG8_LDB(B1, 0, 1); PG8_STAGE(PG8_SB(0, 0), b2, voffB);
            PG8_BAR; PG8_WAIT_L(0); PG8_MMA(0, 1, At, B1); PG8_BAR;
            PG8_LDA(At, 0, 1); PG8_STAGE(PG8_SA(0, 0), a2, voffA);
            PG8_BAR; PG8_WAIT_L(0); PG8_MMA(1, 0, At, B0); PG8_BAR; PG8_SCHED;
            PG8_STAGE(PG8_SB(0, 1), b2 + hstep, voffB);
            PG8_WAIT_V(6); PG8_BAR; PG8_MMA(1, 1, At, B1); PG8_BAR;
            PG8_LDB(B0, 1, 0); PG8_SCHED; PG8_LDA(At, 1, 0); PG8_STAGE(PG8_SA(0, 1), a2 + hstep, voffA);
            PG8_WAIT_L(8); PG8_BAR; PG8_WAIT_L(0); PG8_MMA(0, 0, At, B0); PG8_BAR; PG8_SCHED;
            PG8_LDB(B1, 1, 1); PG8_STAGE(PG8_SB(1, 0), b3, voffB);
            PG8_BAR; PG8_WAIT_L(0); PG8_MMA(0, 1, At, B1); PG8_BAR;
            PG8_LDA(At, 1, 1); PG8_STAGE(PG8_SA(1, 0), a3, voffA);
            PG8_BAR; PG8_WAIT_L(0); PG8_MMA(1, 0, At, B0); PG8_BAR; PG8_SCHED;
            PG8_STAGE(PG8_SB(1, 1), b3 + hstep, voffB);
            PG8_WAIT_V(6); PG8_BAR; PG8_MMA(1, 1, At, B1); PG8_BAR;
            }
        }
        if constexpr (ALIGN_EPI) { if (wr == 0) PG8_BAR; }
        if constexpr (!Epi::AFTER_DRAIN) { E(acc, cur, wr, wc, fr, fq); S.done(cur); }
        if (!has_next) break;
#pragma unroll
        for (int a = 0; a < 2; ++a)
#pragma unroll
            for (int b = 0; b < 2; ++b)
#pragma unroll
                for (int m = 0; m < 4; ++m)
#pragma unroll
                    for (int n = 0; n < 2; ++n) acc[a][b][m][n] = (f32x4){0.f, 0.f, 0.f, 0.f};
        cur = nxt; cA = nA; cB = nB; ++ui;
        if constexpr (ALIGN_EPI) { if (wr == 1) PG8_BAR; }
    }
    PG8_WAIT_V(0);
    if constexpr (!ALIGN_EPI) { if (wr == 0) PG8_BAR; }
    PG8_BAR;
    if constexpr (Epi::AFTER_DRAIN) { E.fused(acc, cur, wr, wc, fr, fq, lds, wid, lane); S.done(cur); }
#undef PG8_SA
#undef PG8_SB
#undef PG8_STAGE
#undef PG8_LDA
#undef PG8_LDB
#undef PG8_MMA
#undef PG8_WAIT_V
#undef PG8_WAIT_L
#undef PG8_BAR
#undef PG8_SCHED
}
}
#define XB_TMO      128
#define XB_XCNT(j)  (256  + 64 * (j))
#define XB_XSUB(j)  (1280 + 64 * (j))
#define XB_XGEN(j)  (2304 + 64 * (j))
#define XB_TOP      3328
#define XB_TOPGEN   3392
#define XCD_BAR_WORDS 3456
#define XB_SPIN_CAP (1u << 18)

__device__ __forceinline__ unsigned xb_ld(unsigned* p)              { return __hip_atomic_load(p, __ATOMIC_RELAXED, __HIP_MEMORY_SCOPE_AGENT); }
__device__ __forceinline__ unsigned xb_add(unsigned* p, unsigned v) { return __hip_atomic_fetch_add(p, v, __ATOMIC_RELAXED, __HIP_MEMORY_SCOPE_AGENT); }
__device__ __forceinline__ unsigned xb_xcc_id() { return (unsigned)__builtin_amdgcn_s_getreg((3 << 11) | 20) & 0xFu; }
#define XB_SPIN(cond, bar) do { unsigned _sp = 0; while (cond) { __builtin_amdgcn_s_sleep(1); \
    if ((++_sp & 255u) == 0u) { if (xb_ld(&(bar)[XB_TMO])) break; if (_sp > XB_SPIN_CAP) { atomicAdd(&(bar)[XB_TMO], 1u); break; } } } } while (0)

struct XcdBarrier {
    unsigned* bar; unsigned x; unsigned w0;
    volatile LAS unsigned* st;
};

__device__ __forceinline__ bool xb_tid0(unsigned w0) { return w0 != 0u && __builtin_amdgcn_mbcnt_hi(0xffffffffu, __builtin_amdgcn_mbcnt_lo(0xffffffffu, 0u)) == 0u; }
__device__ __forceinline__ XcdBarrier xcd_barrier_post(unsigned* bar, volatile LAS unsigned* st) {
    XcdBarrier b; b.bar = bar; b.x = xb_xcc_id(); b.st = st; b.w0 = (__builtin_amdgcn_readfirstlane(threadIdx.x >> 6) == 0) ? 1u : 0u;
    if (threadIdx.x == 0) (void)xb_add(&bar[XB_XCNT(b.x)], 1u);
    return b;
}
__device__ __forceinline__ void xcd_barrier_complete(unsigned* bar, unsigned x, unsigned& nloc, unsigned& nx) {
    const unsigned G = gridDim.x * gridDim.y * gridDim.z;
    unsigned sum, cnt, mine, sp = 0u;
    for (;;) {
        sum = 0u; cnt = 0u; mine = 0u;
#pragma unroll
        for (unsigned j = 0; j < 16; ++j) { const unsigned c = xb_ld(&bar[XB_XCNT(j)]); sum += c; cnt += (c > 0u) ? 1u : 0u; mine = (j == x) ? c : mine; }
        if (sum == G) break;
        __builtin_amdgcn_s_sleep(1);
        if ((++sp & 255u) == 0u) { if (xb_ld(&bar[XB_TMO])) break; if (sp > XB_SPIN_CAP) { atomicAdd(&bar[XB_TMO], 1u); break; } }
    }
    nloc = mine > 0u ? mine : 1u; nx = cnt > 0u ? cnt : 1u;
}

__device__ __forceinline__ void xcd_barrier(const XcdBarrier& b) {
    asm volatile("s_waitcnt vmcnt(0)" ::: "memory");
    __syncthreads();
    if (xb_tid0(b.w0)) {
        unsigned* bar = b.bar;
        __builtin_amdgcn_s_waitcnt(0);
        unsigned nloc = b.st[0], nx = b.st[1];
        if (nloc == 0u) { xcd_barrier_complete(bar, b.x, nloc, nx); b.st[0] = nloc; b.st[1] = nx; }
        const unsigned old = xb_add(&bar[XB_XSUB(b.x)], 1u);
        const unsigned gen = old / nloc;
        if (old + 1u == (gen + 1u) * nloc) {
            __builtin_amdgcn_fence(__ATOMIC_RELEASE, "agent");
            asm volatile("s_waitcnt vmcnt(0)" ::: "memory");
            const unsigned og = xb_add(&bar[XB_TOP], 1u);
            const unsigned tg = og / nx;
            if (og + 1u == (tg + 1u) * nx) xb_add(&bar[XB_TOPGEN], 1u);
            else XB_SPIN(xb_ld(&bar[XB_TOPGEN]) == tg, bar);
            __builtin_amdgcn_fence(__ATOMIC_ACQUIRE, "agent");
            xb_add(&bar[XB_XGEN(b.x)], 1u);
            asm volatile("s_waitcnt vmcnt(0)" ::: "memory");
        } else {
            XB_SPIN(xb_ld(&bar[XB_XGEN(b.x)]) == gen, bar);
            __builtin_amdgcn_fence(__ATOMIC_ACQUIRE, "agent");
            asm volatile("s_waitcnt vmcnt(0)" ::: "memory");
        }
    }
    __syncthreads();
}

#ifndef PROBE_DUP
#define PROBE_DUP -1
#endif
#define REP(i) for (int rep_ = 0; rep_ < ((PROBE_DUP == (i)) ? 2 : 1); ++rep_)
constexpr int NB = 4, T = 2048, D = 2048, NTOK = NB * T, DEPTH = 4;
constexpr int INW = 5168, INWP = 5376;
constexpr int C_RQ = 0, C_RK = 256, C_RV = 512, C_RG = 1024, C_SU = 1536, C_SV = 2048, C_NQ = 2560, C_KC = 3584, C_VC = 3840, C_KS = 4096, C_VS = 4352, C_KW = 4608, C_VW = 4864, C_NG = 5120;
constexpr float ALPHA = 1.6817928305074290f;
constexpr float LN_EPS = 1e-5f;
constexpr float LOG2E = 1.4426950408889634f;

constexpr size_t MiB = (size_t)1 << 20;
constexpr size_t WS_CTL = 0, CTL_ZERO_BYTES = 1 * MiB;
constexpr size_t WS_ROPE = 1 * MiB;
constexpr size_t WS_WIN = 2 * MiB;
constexpr size_t WS_WOUT = 86 * MiB;
constexpr size_t WS_WQ = 118 * MiB;
constexpr size_t WS_PU = 160 * MiB;
constexpr size_t WS_PV = 416 * MiB;
constexpr size_t WS_H = 672 * MiB;
constexpr size_t WS_YMIX = 756 * MiB;
constexpr size_t WS_MIXED = 820 * MiB;
constexpr size_t WS_Z = 852 * MiB;
constexpr size_t WS_X1 = 916 * MiB;
constexpr size_t WS_X1B = 980 * MiB;
constexpr size_t WS_QP = 1012 * MiB;
constexpr size_t WS_XC = 1076 * MiB;
constexpr size_t WS_XB = 1140 * MiB;
constexpr size_t WS_KC = 1172 * MiB;
constexpr size_t WS_KVST = 1174 * MiB;
constexpr size_t WS_SC = 1184 * MiB;
constexpr size_t WS_PSC = 1248 * MiB;
constexpr size_t WS_W1T = 1250 * MiB;
constexpr size_t WS_W2T = 1258 * MiB;
constexpr size_t WS_PKB = 1260 * MiB;
#ifndef PEER_NBKT
#define PEER_NBKT 8
#endif
#ifndef PEER_PG
#define PEER_PG 4
#endif
constexpr int PG = PEER_PG;
constexpr int NBKT = PEER_NBKT, NRND = NBKT / 8, FCAP = 4096, BSH = (NBKT == 16) ? 10 : 11;
constexpr size_t WS_FE = 1262 * MiB;
constexpr size_t WS_FW = 1326 * MiB;
constexpr size_t WS_FHW = 1390 * MiB;
constexpr size_t WS_GST = 1454 * MiB;
constexpr size_t WS_PART = 1456 * MiB;
constexpr size_t WS_X1Q = 1712 * MiB;
constexpr size_t WS_XSC = 1728 * MiB;
constexpr size_t WS_END = 1730 * MiB;
constexpr int CW_BAR = 4096;

constexpr int LDS_BYTES = 147456;
constexpr int MISC_OFF = 143360;

#define GAS __attribute__((address_space(1)))
typedef float f4 __attribute__((ext_vector_type(4)));
typedef float f2 __attribute__((ext_vector_type(2)));
typedef unsigned u4 __attribute__((ext_vector_type(4)));
typedef unsigned u2 __attribute__((ext_vector_type(2)));
__device__ __forceinline__ f4 mk_f4(float a, float b, float c, float d) { f4 r; r.x = a; r.y = b; r.z = c; r.w = d; return r; }
__device__ __forceinline__ f2 mk_f2(float a, float b) { f2 r; r.x = a; r.y = b; return r; }
__device__ __forceinline__ u2 mk_u2(unsigned a, unsigned b) { u2 r; r.x = a; r.y = b; return r; }
typedef unsigned short bf16;
#define LDS_WAIT() asm volatile("s_waitcnt lgkmcnt(0)" ::: "memory")
#define VM_WAIT() asm volatile("s_waitcnt vmcnt(0)" ::: "memory")

struct Params {
    const float* in[25];
    float* out;
    unsigned char* ws;
    double inv_rev[32];
    float lg2[4];
    int ph_lo, ph_hi, use_bar, pad0;
};

__device__ __forceinline__ float bf2f(unsigned short b) { return __uint_as_float(((unsigned)b) << 16); }
__device__ __forceinline__ unsigned f2bf(float f) { unsigned u = __float_as_uint(f); return (u + 0x7fffu + ((u >> 16) & 1u)) >> 16; }
__device__ __forceinline__ unsigned pk2(float lo, float hi) { return f2bf(lo) | (f2bf(hi) << 16); }
__device__ __forceinline__ float wave_sum(float v) {
#pragma unroll
    for (int o = 1; o < 64; o <<= 1) v += __shfl_xor(v, o);
    return v;
}
__device__ __forceinline__ void unpack8(const u4& v, float* f) {
    f[0] = __uint_as_float(v.x << 16); f[1] = __uint_as_float(v.x & 0xffff0000u);
    f[2] = __uint_as_float(v.y << 16); f[3] = __uint_as_float(v.y & 0xffff0000u);
    f[4] = __uint_as_float(v.z << 16); f[5] = __uint_as_float(v.z & 0xffff0000u);
    f[6] = __uint_as_float(v.w << 16); f[7] = __uint_as_float(v.w & 0xffff0000u);
}
__device__ __forceinline__ float gelu_tanh(float x) { return pg8::gelu_tanh_f(x); }

__device__ __forceinline__ void transpose_tile(const float* __restrict__ W, int K, int N, bf16* __restrict__ WT, LAS float* scr, int kb, int nb, int lane) {
    const int k0 = kb * 64, n0 = nb * 32, rsub = lane >> 3, c4 = (lane & 7) * 4; const bool ok = (n0 + c4) < N;
    f4 v[8];
#pragma unroll
    for (int i = 0; i < 8; ++i) v[i] = ok ? *(const f4*)(W + (size_t)(k0 + 8 * i + rsub) * N + n0 + c4) : mk_f4(0.f, 0.f, 0.f, 0.f);
#pragma unroll
    for (int i = 0; i < 8; ++i) { LAS float* d = scr + (8 * i + rsub) * 33 + c4; d[0] = v[i].x; d[1] = v[i].y; d[2] = v[i].z; d[3] = v[i].w; }
    LDS_WAIT();
    const int c = lane & 7;
#pragma unroll
    for (int j = 0; j < 4; ++j) { const int n = (lane >> 3) + 8 * j; const LAS float* s = scr + (8 * c) * 33 + n;
        u4 o; o.x = pk2(s[0 * 33], s[1 * 33]); o.y = pk2(s[2 * 33], s[3 * 33]); o.z = pk2(s[4 * 33], s[5 * 33]); o.w = pk2(s[6 * 33], s[7 * 33]);
        *(u4*)(WT + (size_t)(n0 + n) * K + k0 + 8 * c) = o; }
    LDS_WAIT();
}
__device__ __forceinline__ void cvt_bf16_stream(const float* __restrict__ src, bf16* __restrict__ dst, size_t nchunks, size_t gt, size_t GT) {
    for (size_t c = gt; c < nchunks; c += GT) { const f4 a = ((const f4*)src)[2 * c], b = ((const f4*)src)[2 * c + 1];
        u4 o; o.x = pk2(a.x, a.y); o.y = pk2(a.z, a.w); o.z = pk2(b.x, b.y); o.w = pk2(b.z, b.w); ((u4*)dst)[c] = o; }
}
__device__ __forceinline__ void phase_prologue(const Params& P, unsigned char* ws, LAS unsigned char* lds, int tid, int lane, int wave) {
    LAS float* scr = (LAS float*)(lds + wave * 8704);
    const int gw = blockIdx.x * 8 + wave, NGW = gridDim.x * 8;
    constexpr int I_IN = 32 * 168, I_SQ = 32 * 64, I_L = I_IN + 2 * I_SQ;
    REP(21) for (int it = gw; it < DEPTH * I_L; it += NGW) {
        const int l = it / I_L; int r = it % I_L;
        if (r < I_IN) transpose_tile(P.in[1] + (size_t)l * D * INW, D, INW, (bf16*)(ws + WS_WIN) + (size_t)l * INWP * D, scr, r / 168, r % 168, lane);
        else { r -= I_IN;
            if (r < I_SQ) transpose_tile(P.in[15] + (size_t)l * D * D, D, D, (bf16*)(ws + WS_WOUT) + (size_t)l * D * D, scr, r / 64, r % 64, lane);
            else { r -= I_SQ; transpose_tile(P.in[18] + (size_t)l * D * D, D, D, (bf16*)(ws + WS_WQ) + (size_t)l * D * D, scr, r / 64, r % 64, lane); } }
    }
    for (int it = gw; it < DEPTH * 2 * (32 * 8 + 4 * 2); it += NGW) {
        const int lk = it / 264, r = it % 264, l = lk >> 1, kv = lk & 1;
        if (r < 256) transpose_tile(P.in[kv ? 12 : 9] + (size_t)l * 2048 * 256, 2048, 256, (bf16*)(ws + WS_W1T) + (size_t)lk * 256 * 2048, scr, r >> 3, r & 7, lane);
        else transpose_tile(P.in[kv ? 13 : 10] + (size_t)l * 256 * 64, 256, 64, (bf16*)(ws + WS_W2T) + (size_t)lk * 64 * 256, scr, (r - 256) >> 1, (r - 256) & 1, lane);
    }
    const size_t gt = (size_t)blockIdx.x * 512 + tid, GT = (size_t)gridDim.x * 512;
    REP(22) for (int row = gw; row < 2 * DEPTH * 16384; row += NGW) {
        const int tab = row / (DEPTH * 16384), rr = row % (DEPTH * 16384);
        const float* src = P.in[21 + tab] + (size_t)rr * 2048;
        f4 v[8]; float am = 0.f;
#pragma unroll
        for (int j = 0; j < 2; ++j)
#pragma unroll
            for (int q = 0; q < 4; ++q) { const f4 a = *(const f4*)(src + 1024 * j + 16 * lane + 4 * q); v[4 * j + q] = a; am = fmaxf(am, fmaxf(fmaxf(fabsf(a.x), fabsf(a.y)), fmaxf(fabsf(a.z), fabsf(a.w)))); }
#pragma unroll
        for (int o = 1; o < 64; o <<= 1) am = fmaxf(am, __shfl_xor(am, o));
        unsigned char* dst = ws + (tab ? WS_PV : WS_PU) + (size_t)rr * 2048;
        if (tab) {
            const float sc = (am > 0.f) ? 448.f / am : 1.f;
            if (lane == 0) ((float*)(ws + WS_PSC))[row] = (am > 0.f) ? am * (1.f / 448.f) : 1.f;
#pragma unroll
            for (int j = 0; j < 2; ++j) { u4 w;
#pragma unroll
                for (int q = 0; q < 4; ++q) { const f4 a = v[4 * j + q]; int r = __builtin_amdgcn_cvt_pk_fp8_f32(a.x * sc, a.y * sc, 0, false); r = __builtin_amdgcn_cvt_pk_fp8_f32(a.z * sc, a.w * sc, r, true); w[q] = (unsigned)r; }
                *(u4*)(dst + 1024 * j + 16 * lane) = w; }
        } else {
            const float sc = (am > 0.f) ? 127.f / am : 1.f;
            if (lane == 0) ((float*)(ws + WS_PSC))[row] = (am > 0.f) ? am * (1.f / 127.f) : 1.f;
#pragma unroll
            for (int j = 0; j < 2; ++j) { u4 w;
#pragma unroll
                for (int q = 0; q < 4; ++q) { const f4 a = v[4 * j + q];
                    const int b0 = (int)rintf(a.x * sc), b1 = (int)rintf(a.y * sc), b2 = (int)rintf(a.z * sc), b3 = (int)rintf(a.w * sc);
                    w[q] = (unsigned)(b0 & 0xff) | ((unsigned)(b1 & 0xff) << 8) | ((unsigned)(b2 & 0xff) << 16) | ((unsigned)b3 << 24); }
                *(u4*)(dst + 1024 * j + 16 * lane) = w; }
        }
    }
    cvt_bf16_stream(P.in[0], (bf16*)(ws + WS_XB), (size_t)NTOK * D / 8, gt, GT);
    cvt_bf16_stream(P.in[19], (bf16*)(ws + WS_PKB), (size_t)DEPTH * 8 * 128 * 128 / 8, gt, GT);
    cvt_bf16_stream(P.in[20], (bf16*)(ws + WS_PKB) + (size_t)DEPTH * 8 * 128 * 128, (size_t)DEPTH * 8 * 128 * 128 / 8, gt, GT);
    f2* rope = (f2*)(ws + WS_ROPE);
    for (size_t idx = gt; idx < (size_t)T * 32; idx += GT) { const int t = (int)(idx >> 5), i = (int)(idx & 31);
        double a = (double)t * P.inv_rev[i]; a -= floor(a); const float fr = (float)a;
        rope[idx] = mk_f2(__builtin_amdgcn_cosf(fr), __builtin_amdgcn_sinf(fr)); }
}

__device__ __forceinline__ void stage_rot_k(const bf16* __restrict__ Hb, const f2* __restrict__ rope, LAS float* ks, int tok0, int tpos0, int colK, float lg2h, bool zeta, int tid) {
    const int m = tid >> 2, p = tid & 3;
    const bf16* src = Hb + (size_t)(tok0 + m) * INWP + colK + p * 8;
    const u4 a = *(const u4*)src, b = *(const u4*)(src + 32);
    float x1[8], x2[8]; unpack8(a, x1); unpack8(b, x2);
    const f4* rp = (const f4*)(rope + (size_t)(tpos0 + m) * 32 + p * 8);
    const f4 r0 = rp[0], r1 = rp[1], r2 = rp[2], r3 = rp[3];
    const float cs[8] = {r0.x, r0.z, r1.x, r1.z, r2.x, r2.z, r3.x, r3.z}, sn[8] = {r0.y, r0.w, r1.y, r1.w, r2.y, r2.w, r3.y, r3.w};
    const float sc = 0.125f * (zeta ? exp2f(lg2h * (float)(127 - m)) : 1.0f);
    float o1[8], o2[8];
#pragma unroll
    for (int i = 0; i < 8; ++i) { o1[i] = (x1[i] * cs[i] - x2[i] * sn[i]) * sc; o2[i] = (x1[i] * sn[i] + x2[i] * cs[i]) * sc; }
    LAS f4* d1 = (LAS f4*)(ks + m * 64 + p * 8); LAS f4* d2 = (LAS f4*)(ks + m * 64 + 32 + p * 8);
    d1[0] = mk_f4(o1[0], o1[1], o1[2], o1[3]); d1[1] = mk_f4(o1[4], o1[5], o1[6], o1[7]);
    d2[0] = mk_f4(o2[0], o2[1], o2[2], o2[3]); d2[1] = mk_f4(o2[4], o2[5], o2[6], o2[7]);
}
__device__ __forceinline__ void stage_v128(const bf16* __restrict__ Hb, LAS float* vs, int tok0, int colV, int tid) {
    const int m = tid >> 2, p = tid & 3;
    const u4* src = (const u4*)(Hb + (size_t)(tok0 + m) * INWP + colV + p * 32);
    LAS f4* dst = (LAS f4*)(vs + m * 128 + p * 32);
#pragma unroll
    for (int j = 0; j < 4; ++j) { const u4 a = src[j]; float f[8]; unpack8(a, f); dst[2 * j] = mk_f4(f[0], f[1], f[2], f[3]); dst[2 * j + 1] = mk_f4(f[4], f[5], f[6], f[7]); }
}

__device__ __forceinline__ void unit_kvstate(const Params& P, unsigned char* ws, LAS unsigned char* lds, int u, int tid) {
    const int b = u / 60, r = u % 60, h = r / 15, j = r % 15;
    const bf16* Hb = (const bf16*)(ws + WS_H); const f2* rope = (const f2*)(ws + WS_ROPE);
    LAS float* ks = (LAS float*)lds; LAS float* vs = (LAS float*)(lds + 32768);
    const int tok0 = b * T + j * 128;
    stage_rot_k(Hb, rope, ks, tok0, j * 128, C_RK + h * 64, P.lg2[h], true, tid);
    stage_v128(Hb, vs, tok0, C_RV + h * 128, tid);
    __syncthreads();
    const int d = tid >> 3, e0 = (tid & 7) * 16;
    float acc[16];
#pragma unroll
    for (int i = 0; i < 16; ++i) acc[i] = 0.f;
    #pragma unroll 1
    for (int m = 0; m < 128; ++m) { const float kd = ks[m * 64 + d]; const LAS f4* vp = (const LAS f4*)(vs + m * 128 + e0);
#pragma unroll
        for (int q = 0; q < 4; ++q) { const f4 v = vp[q]; acc[4 * q] += kd * v.x; acc[4 * q + 1] += kd * v.y; acc[4 * q + 2] += kd * v.z; acc[4 * q + 3] += kd * v.w; } }
    f4* dst = (f4*)((float*)(ws + WS_KVST) + ((size_t)((b * 4 + h) * 16 + j) * 64 + d) * 128 + e0);
#pragma unroll
    for (int q = 0; q < 4; ++q) dst[q] = mk_f4(acc[4 * q], acc[4 * q + 1], acc[4 * q + 2], acc[4 * q + 3]);
    __syncthreads();
}

__device__ __forceinline__ void unit_sgu(const Params& P, unsigned char* ws, int l, LAS unsigned char* lds, int u, int tid, int lane, int wave) {
    const int b = u >> 6, c = (u >> 2) & 15, g = u & 3;
    const bf16* Hb = (const bf16*)(ws + WS_H);
    LAS float* vn = (LAS float*)lds;
    LAS float* wsm = (LAS float*)(lds + 65536);
    const int tok0 = b * T + c * 128;
    const float* lng = P.in[4] + l * 512 + g * 128; const float* lnb = P.in[5] + l * 512 + g * 128;
    const float g0 = lng[2 * lane], g1 = lng[2 * lane + 1], b0 = lnb[2 * lane], b1 = lnb[2 * lane + 1];
    for (int i = 0; i < 16; ++i) { const int s = wave * 16 + i;
        const unsigned pr = *(const unsigned*)(Hb + (size_t)(tok0 + s) * INWP + C_SV + g * 128 + 2 * lane);
        const float v0 = __uint_as_float(pr << 16), v1 = __uint_as_float(pr & 0xffff0000u);
        const float mu = wave_sum(v0 + v1) * (1.f / 128.f); const float d0 = v0 - mu, d1 = v1 - mu;
        const float var = wave_sum(d0 * d0 + d1 * d1) * (1.f / 128.f); const float rstd = rsqrtf(var + LN_EPS);
        *(LAS f2*)(vn + s * 128 + 2 * lane) = mk_f2(d0 * rstd * g0 + b0, d1 * rstd * g1 + b1); }
    const float* wg = P.in[6] + ((size_t)l * 4 + g) * 16384;
    for (int i = 0; i < 32; ++i) { const int idx = tid + 512 * i; wsm[(idx >> 7) * 129 + (idx & 127)] = wg[idx]; }
    __syncthreads();
    const int t = tid >> 2, dg = tid & 3; const int smax = (t | 15);
    float acc[32];
#pragma unroll
    for (int i = 0; i < 32; ++i) acc[i] = 0.f;
    #pragma unroll 1
    for (int s = 0; s <= smax; ++s) { const float wv = (s <= t) ? wsm[t * 129 + s] : 0.f; const LAS f4* vp = (const LAS f4*)(vn + s * 128 + dg * 32);
#pragma unroll
        for (int q = 0; q < 8; ++q) { const f4 v = vp[q]; acc[4 * q] += wv * v.x; acc[4 * q + 1] += wv * v.y; acc[4 * q + 2] += wv * v.z; acc[4 * q + 3] += wv * v.w; } }
    const float bs = P.in[7][(l * 4 + g) * 128 + t];
    const u4* up = (const u4*)(Hb + (size_t)(tok0 + t) * INWP + C_SU + g * 128 + dg * 32);
    f4* yo = (f4*)((float*)(ws + WS_YMIX) + (size_t)(tok0 + t) * D + 512 + g * 128 + dg * 32);
#pragma unroll
    for (int j = 0; j < 4; ++j) { const u4 a = up[j]; float f[8]; unpack8(a, f);
        yo[2 * j] = mk_f4(f[0] * (acc[8 * j] + bs), f[1] * (acc[8 * j + 1] + bs), f[2] * (acc[8 * j + 2] + bs), f[3] * (acc[8 * j + 3] + bs));
        yo[2 * j + 1] = mk_f4(f[4] * (acc[8 * j + 4] + bs), f[5] * (acc[8 * j + 5] + bs), f[6] * (acc[8 * j + 6] + bs), f[7] * (acc[8 * j + 7] + bs)); }
    __syncthreads();
}

__device__ __forceinline__ void unit_compress(const Params& P, unsigned char* ws, int l, LAS unsigned char* lds, int u, int tid) {
    const int kv = u >> 7, b = (u >> 5) & 3, g = (u >> 3) & 3, r = u & 7;
    const bf16* Hb = (const bf16*)(ws + WS_H);
    LAS float* seg = (LAS float*)lds;
    LAS float* hid = (LAS float*)(lds + 69632);
    const int col0 = (kv ? C_VC : C_KC) + g * 64;
    const float* pe = P.in[kv ? 11 : 8] + (size_t)l * 2048;
    const float* w1 = P.in[kv ? 12 : 9] + (size_t)l * 2048 * 256;
    const float* w2 = P.in[kv ? 13 : 10] + (size_t)l * 256 * 64;
    for (int idx = tid; idx < 272 * 8; idx += 512) { const int tt = idx >> 3, d8 = (idx & 7) * 8; const int t = 256 * r + tt;
        float f[8];
        if (t < T) { const u4 a = *(const u4*)(Hb + (size_t)(b * T + t) * INWP + col0 + d8); unpack8(a, f); }
        else {
#pragma unroll
            for (int i = 0; i < 8; ++i) f[i] = 0.f; }
        LAS f4* dp = (LAS f4*)(seg + tt * 64 + d8); dp[0] = mk_f4(f[0], f[1], f[2], f[3]); dp[1] = mk_f4(f[4], f[5], f[6], f[7]); }
    __syncthreads();
    const int j = tid & 255, hb = tid >> 8;
    float acc[8], accpe = 0.f;
#pragma unroll
    for (int i = 0; i < 8; ++i) acc[i] = 0.f;
    for (int pos = 0; pos < 32; ++pos) {
#pragma unroll 2
        for (int d4 = 0; d4 < 16; ++d4) { const int kk = pos * 64 + d4 * 4;
            const float w0 = w1[(size_t)(kk + 0) * 256 + j], w1v = w1[(size_t)(kk + 1) * 256 + j], w2v = w1[(size_t)(kk + 2) * 256 + j], w3 = w1[(size_t)(kk + 3) * 256 + j];
            const f4 p4 = *(const f4*)(pe + kk);
            accpe += w0 * p4.x + w1v * p4.y + w2v * p4.z + w3 * p4.w;
#pragma unroll
            for (int ib = 0; ib < 8; ++ib) { const f4 s4 = *(const LAS f4*)(seg + (16 * (hb * 8 + ib) + pos) * 64 + d4 * 4);
                acc[ib] += w0 * s4.x + w1v * s4.y + w2v * s4.z + w3 * s4.w; } } }
#pragma unroll
    for (int ib = 0; ib < 8; ++ib) hid[(hb * 8 + ib) * 256 + j] = gelu_tanh(acc[ib] + accpe);
    __syncthreads();
    { const int i = tid >> 5, o2 = (tid & 31) * 2; float a0 = 0.f, a1 = 0.f;
        for (int jj = 0; jj < 256; ++jj) { const float hv = hid[i * 256 + jj]; const f2 w = *(const f2*)(w2 + jj * 64 + o2); a0 += hv * w.x; a1 += hv * w.y; }
        const int ci = 16 * r + i;
        if (ci <= 126) *(f2*)((float*)(ws + WS_KC) + ((size_t)((kv * 4 + b) * 4 + g) * 128 + ci) * 64 + o2) = mk_f2(a0, a1); }
    __syncthreads();
}

__device__ __forceinline__ void unit_retention(const Params& P, unsigned char* ws, int l, LAS unsigned char* lds, int u, int tid) {
    const int b = u >> 6, h = (u >> 4) & 3, c = u & 15;
    const bf16* Hb = (const bf16*)(ws + WS_H); const f2* rope = (const f2*)(ws + WS_ROPE);
    LAS float* regB = (LAS float*)lds;
    LAS float* vs = (LAS float*)(lds + 32768);
    LAS float* Qs = (LAS float*)(lds + 98304);
    const float lg2h = P.lg2[h];
    const int tok0 = b * T + c * 128;
    { float a[16];
#pragma unroll
        for (int i = 0; i < 16; ++i) a[i] = 0.f;
        const float* kvb = (const float*)(ws + WS_KVST) + (size_t)((b * 4 + h) * 16) * 8192 + tid * 16;
#pragma unroll 1
        for (int j = 0; j < c; ++j) { const float w = exp2f(lg2h * 128.f * (float)(c - 1 - j)); const f4* sp = (const f4*)(kvb + (size_t)j * 8192);
#pragma unroll
            for (int q = 0; q < 4; ++q) { const f4 v = sp[q]; a[4 * q] += w * v.x; a[4 * q + 1] += w * v.y; a[4 * q + 2] += w * v.z; a[4 * q + 3] += w * v.w; } }
        LAS f4* dp = (LAS f4*)(regB + tid * 16);
#pragma unroll
        for (int q = 0; q < 4; ++q) dp[q] = mk_f4(a[4 * q], a[4 * q + 1], a[4 * q + 2], a[4 * q + 3]); }
    const int n = tid >> 2, eg = tid & 3;
    float qa[8], qb[8];
    { const bf16* src = Hb + (size_t)(tok0 + n) * INWP + C_RQ + h * 64 + eg * 8;
        const u4 a = *(const u4*)src, bb = *(const u4*)(src + 32);
        float x1[8], x2[8]; unpack8(a, x1); unpack8(bb, x2);
        const f4* rp = (const f4*)(rope + (size_t)(c * 128 + n) * 32 + eg * 8);
        const f4 r0 = rp[0], r1 = rp[1], r2 = rp[2], r3 = rp[3];
        const float cs[8] = {r0.x, r0.z, r1.x, r1.z, r2.x, r2.z, r3.x, r3.z}, sn[8] = {r0.y, r0.w, r1.y, r1.w, r2.y, r2.w, r3.y, r3.w};
#pragma unroll
        for (int i = 0; i < 8; ++i) { qa[i] = x1[i] * cs[i] - x2[i] * sn[i]; qb[i] = x1[i] * sn[i] + x2[i] * cs[i]; Qs[n * 65 + eg * 8 + i] = qa[i]; Qs[n * 65 + 32 + eg * 8 + i] = qb[i]; } }
    __syncthreads();
    float acc[32];
#pragma unroll
    for (int i = 0; i < 32; ++i) acc[i] = 0.f;
#pragma unroll 2
    for (int d = 0; d < 64; ++d) { const float qd = Qs[n * 65 + d]; const LAS f4* sp = (const LAS f4*)(regB + d * 128 + eg * 32);
#pragma unroll
        for (int qq = 0; qq < 8; ++qq) { const f4 v = sp[qq]; acc[4 * qq] += qd * v.x; acc[4 * qq + 1] += qd * v.y; acc[4 * qq + 2] += qd * v.z; acc[4 * qq + 3] += qd * v.w; } }
    { const float xi = exp2f(lg2h * (float)(n + 1));
#pragma unroll
        for (int i = 0; i < 32; ++i) acc[i] *= xi; }
    __syncthreads();
    stage_rot_k(Hb, rope, regB, tok0, c * 128, C_RK + h * 64, lg2h, false, tid);
    stage_v128(Hb, vs, tok0, C_RV + h * 128, tid);
    __syncthreads();
    const int mmax = n | 15;
#pragma unroll 1
    for (int m = 0; m <= mmax; ++m) { const LAS f4* kp = (const LAS f4*)(regB + m * 64 + eg * 8); const LAS f4* kp2 = (const LAS f4*)(regB + m * 64 + 32 + eg * 8);
        const f4 k0 = kp[0], k1 = kp[1], k2 = kp2[0], k3 = kp2[1];
        float s = ((qa[0] * k0.x + qa[1] * k0.y) + (qa[2] * k0.z + qa[3] * k0.w)) + ((qa[4] * k1.x + qa[5] * k1.y) + (qa[6] * k1.z + qa[7] * k1.w))
                + ((qb[0] * k2.x + qb[1] * k2.y) + (qb[2] * k2.z + qb[3] * k2.w)) + ((qb[4] * k3.x + qb[5] * k3.y) + (qb[6] * k3.z + qb[7] * k3.w));
        s += __shfl_xor(s, 1); s += __shfl_xor(s, 2);
        const float a = (m <= n) ? s * exp2f(lg2h * (float)(n - m)) : 0.f;
        const LAS f4* vp = (const LAS f4*)(vs + m * 128 + eg * 32);
#pragma unroll
        for (int qq = 0; qq < 8; ++qq) { const f4 v = vp[qq]; acc[4 * qq] += a * v.x; acc[4 * qq + 1] += a * v.y; acc[4 * qq + 2] += a * v.z; acc[4 * qq + 3] += a * v.w; } }
    float s1 = 0.f;
#pragma unroll
    for (int i = 0; i < 32; ++i) s1 += acc[i];
    s1 += __shfl_xor(s1, 1); s1 += __shfl_xor(s1, 2);
    const float mu = s1 * (1.f / 128.f); float s2 = 0.f;
#pragma unroll
    for (int i = 0; i < 32; ++i) { const float dd = acc[i] - mu; s2 += dd * dd; }
    s2 += __shfl_xor(s2, 1); s2 += __shfl_xor(s2, 2);
    const float rstd = rsqrtf(s2 * (1.f / 128.f) + LN_EPS);
    const float* gg = P.in[2] + l * 512 + h * 128 + eg * 32; const float* gb = P.in[3] + l * 512 + h * 128 + eg * 32;
    const u4* gp = (const u4*)(Hb + (size_t)(tok0 + n) * INWP + C_RG + h * 128 + eg * 32);
    f4* yo = (f4*)((float*)(ws + WS_YMIX) + (size_t)(tok0 + n) * D + h * 128 + eg * 32);
#pragma unroll
    for (int j = 0; j < 4; ++j) { const u4 a = gp[j]; float f[8]; unpack8(a, f); float o[8];
#pragma unroll
        for (int i = 0; i < 8; ++i) { const float y = (acc[8 * j + i] - mu) * rstd * gg[8 * j + i] + gb[8 * j + i]; const float gv = f[i]; o[i] = y * gv * __builtin_amdgcn_rcpf(1.f + __expf(-gv)); }
        yo[2 * j] = mk_f4(o[0], o[1], o[2], o[3]); yo[2 * j + 1] = mk_f4(o[4], o[5], o[6], o[7]); }
    __syncthreads();
}

typedef pg8::bf16x8 bf16x8;
typedef short s16x4 __attribute__((ext_vector_type(4)));
typedef __bf16 bf16x2_t __attribute__((ext_vector_type(2)));
__device__ __forceinline__ unsigned pkbf(float a, float b) { f2 v; v.x = a; v.y = b; return __builtin_bit_cast(unsigned, __builtin_convertvector(v, bf16x2_t)); }
#define MFMA16(a, b, c) __builtin_amdgcn_mfma_f32_16x16x32_bf16((a), (b), (c), 0, 0, 0)
constexpr int NS = 80;
constexpr float NSA_SC = 0.125f * LOG2E;
__device__ __forceinline__ void nsa_scores(f4 (&st)[4][2], const LAS bf16* Kl, const bf16x8 (&Yq)[2][2], int lane) {
    const int r = lane & 15, kq = lane >> 4;
#pragma unroll
    for (int kt = 0; kt < 4; ++kt) { const LAS bf16* kp = Kl + (16 * kt + r) * NS + 8 * kq;
        const bf16x8 k0 = *(const LAS bf16x8*)kp, k1 = *(const LAS bf16x8*)(kp + 32);
#pragma unroll
        for (int qp = 0; qp < 2; ++qp) { f4 a = mk_f4(0.f, 0.f, 0.f, 0.f); a = MFMA16(k0, Yq[qp][0], a); a = MFMA16(k1, Yq[qp][1], a); st[kt][qp] = a; } }
}
__device__ __forceinline__ void nsa_softmax_pv(f4 (&st)[4][2], float (&m)[2], float (&l)[2], f4 (&ot)[4][2], const LAS bf16* Vl, const int (&lo)[2], const int (&hi)[2], bool need_mask, int lane) {
    const int kq = lane >> 4, q = (lane & 15) >> 2, p = lane & 3;
    bf16x8 Pf[2][2];
#pragma unroll
    for (int qp = 0; qp < 2; ++qp) {
        if (need_mask) {
#pragma unroll
            for (int kt = 0; kt < 4; ++kt)
#pragma unroll
                for (int i = 0; i < 4; ++i) { const int kl = 16 * kt + 4 * kq + i; if (kl < lo[qp] || kl > hi[qp]) st[kt][qp][i] = -1e30f; } }
        float mx = st[0][qp][0];
#pragma unroll
        for (int kt = 0; kt < 4; ++kt)
#pragma unroll
            for (int i = 0; i < 4; ++i) mx = fmaxf(mx, st[kt][qp][i]);
        mx = fmaxf(mx, __shfl_xor(mx, 16)); mx = fmaxf(mx, __shfl_xor(mx, 32));
        const float mn = fmaxf(m[qp], mx); const float corr = __builtin_amdgcn_exp2f((m[qp] - mn) * NSA_SC); m[qp] = mn; l[qp] *= corr;
#pragma unroll
        for (int dt = 0; dt < 4; ++dt) ot[dt][qp] *= corr;
        const float msc = mn * NSA_SC; float ps = 0.f;
#pragma unroll
        for (int kt = 0; kt < 4; ++kt)
#pragma unroll
            for (int i = 0; i < 4; ++i) { const float pv = __builtin_amdgcn_exp2f(st[kt][qp][i] * NSA_SC - msc); st[kt][qp][i] = pv; ps += pv; }
        l[qp] += ps;
#pragma unroll
        for (int ksp = 0; ksp < 2; ++ksp) { u4 w; w.x = pkbf(st[2 * ksp][qp][0], st[2 * ksp][qp][1]); w.y = pkbf(st[2 * ksp][qp][2], st[2 * ksp][qp][3]);
            w.z = pkbf(st[2 * ksp + 1][qp][0], st[2 * ksp + 1][qp][1]); w.w = pkbf(st[2 * ksp + 1][qp][2], st[2 * ksp + 1][qp][3]); Pf[qp][ksp] = __builtin_bit_cast(bf16x8, w); }
    }
#pragma unroll
    for (int dt = 0; dt < 4; ++dt)
#pragma unroll
        for (int ksp = 0; ksp < 2; ++ksp) { const LAS bf16* vp = Vl + (32 * ksp + 4 * kq + q) * NS + 16 * dt + 4 * p;
            const s16x4 va = __builtin_amdgcn_ds_read_tr16_b64_v4i16((LAS s16x4*)vp), vb = __builtin_amdgcn_ds_read_tr16_b64_v4i16((LAS s16x4*)(vp + 16 * NS));
            const bf16x8 vf = __builtin_shufflevector(va, vb, 0, 1, 2, 3, 4, 5, 6, 7);
#pragma unroll
            for (int qp = 0; qp < 2; ++qp) ot[dt][qp] = MFMA16(vf, Pf[qp][ksp], ot[dt][qp]); }
}
__device__ __forceinline__ void nsa_flush(float* __restrict__ y0, float* __restrict__ y1, const f4 (&ot)[4][2], const float (&l)[2], const float (&gate)[2], bool add, int kq) {
#pragma unroll
    for (int qp = 0; qp < 2; ++qp) { float lt = l[qp]; lt += __shfl_xor(lt, 16); lt += __shfl_xor(lt, 32); const float sc = (lt > 0.f) ? gate[qp] / lt : 0.f;
        float* yp = (qp ? y1 : y0) + 4 * kq;
#pragma unroll
        for (int dt = 0; dt < 4; ++dt) { f4 o = ot[dt][qp] * sc; if (add) o += *(const f4*)(yp + 16 * dt); *(f4*)(yp + 16 * dt) = o; } }
}
__device__ __forceinline__ void nsa_pair_next(unsigned& rem, int& ja, int& jb) { ja = __builtin_ctz(rem); rem &= rem - 1u; if (rem) { jb = __builtin_ctz(rem); rem &= rem - 1u; } else jb = -1; }
__device__ __forceinline__ void nsa_pair_prefetch(const bf16* __restrict__ Hb, int tok0, int ja, int jb, int colK, int colV, int tid, u4 (&R)[4]) {
    const int key = tid >> 3, d8 = (tid & 7) * 8; const int j1 = jb < 0 ? ja : jb;
    const bf16* pa = Hb + (size_t)(tok0 + 64 * ja + key) * INWP + d8; const bf16* pb = Hb + (size_t)(tok0 + 64 * j1 + key) * INWP + d8;
    R[0] = *(const u4*)(pa + colK); R[1] = *(const u4*)(pa + colV); R[2] = *(const u4*)(pb + colK); R[3] = *(const u4*)(pb + colV);
}
__device__ __forceinline__ void nsa_pair_store(LAS bf16* buf, int tid, const u4 (&R)[4]) {
    LAS bf16* p = buf + (tid >> 3) * NS + (tid & 7) * 8;
    *(LAS u4*)p = R[0]; *(LAS u4*)(p + 128 * NS) = R[1]; *(LAS u4*)(p + 64 * NS) = R[2]; *(LAS u4*)(p + 192 * NS) = R[3];
}
template <int MODE>
__device__ __forceinline__ void nsa_branch(unsigned chunks, const bf16* __restrict__ Hb, int tok0, int colK, int colV, LAS bf16* buf0, LAS bf16* buf1, int tid, int lane, int qt, const int (&tq)[2], const unsigned (&mym)[2],
                                           const bf16x8 (&Yq)[2][2], f4 (&ot)[4][2], float (&m)[2], float (&l)[2]) {
    u4 R[4]; unsigned rem = chunks; int ja, jb, na = 0, nb = -1; f4 st[4][2]; int lo[2], hi[2];
    nsa_pair_next(rem, ja, jb);
    nsa_pair_prefetch(Hb, tok0, ja, jb, colK, colV, tid, R);
    __syncthreads();
    nsa_pair_store(buf0, tid, R);
    bool more = (rem != 0u);
    if (more) { nsa_pair_next(rem, na, nb); nsa_pair_prefetch(Hb, tok0, na, nb, colK, colV, tid, R); }
    __syncthreads();
    int it = 0;
#pragma unroll 1
    for (;;) {
        LAS bf16* cur = (it & 1) ? buf1 : buf0;
#pragma unroll 1
        for (int sub = 0; sub < 2; ++sub) { const int j = sub ? jb : ja;
            if (j < 0) break;
            bool anyv = false, full = true;
#pragma unroll
            for (int qp = 0; qp < 2; ++qp) {
                if (MODE == 0) { const bool sel = (mym[qp] >> j) & 1u; lo[qp] = sel ? 0 : 64; hi[qp] = sel ? ((j == qt) ? tq[qp] : 63) : -1; anyv |= sel; full &= (sel && j != qt); }
                else { lo[qp] = (j == qt - 8) ? tq[qp] + 1 : 0; hi[qp] = (j == qt) ? tq[qp] : 63; anyv = true; full &= (j != qt && j != qt - 8); } }
            if (__builtin_amdgcn_ballot_w64(anyv) != 0ull) {
                const bool need_mask = __builtin_amdgcn_ballot_w64(!full) != 0ull;
                nsa_scores(st, cur + sub * 64 * NS, Yq, lane);
                nsa_softmax_pv(st, m, l, ot, cur + 128 * NS + sub * 64 * NS, lo, hi, need_mask, lane); } }
        if (!more) break;
        nsa_pair_store((it & 1) ? buf0 : buf1, tid, R);
        ja = na; jb = nb; more = (rem != 0u);
        if (more) { nsa_pair_next(rem, na, nb); nsa_pair_prefetch(Hb, tok0, na, nb, colK, colV, tid, R); }
        __syncthreads(); ++it;
    }
}
__device__ __forceinline__ void unit_nsa(const Params& P, unsigned char* ws, int l_, LAS unsigned char* lds, int u, int tid) {
    const int b = (u >> 7) & 3, g = (u >> 5) & 3, qt = (u & 256) ? 31 - (u & 31) : (u & 31);
    const bf16* Hb = (const bf16*)(ws + WS_H);
    LAS bf16* buf0 = (LAS bf16*)lds;
    LAS bf16* buf1 = (LAS bf16*)(lds + 40960);
    LAS float* impG = (LAS float*)(lds + 40960);
    LAS float* impE = (LAS float*)(lds + 73728);
    LAS unsigned* selm = (LAS unsigned*)(lds + 106496);
    const int lane = tid & 63, wv = __builtin_amdgcn_readfirstlane(tid >> 6), h = wv >> 1, qh = wv & 1;
    const int c = lane & 15, kq = lane >> 4;
    const int t0 = qt * 64;
    int tq[2]; size_t tok[2];
#pragma unroll
    for (int qp = 0; qp < 2; ++qp) { tq[qp] = 32 * qh + 16 * qp + c; tok[qp] = (size_t)b * T + t0 + tq[qp]; }
    bf16x8 Yq[2][2];
#pragma unroll
    for (int qp = 0; qp < 2; ++qp)
#pragma unroll
        for (int ks = 0; ks < 2; ++ks) Yq[qp][ks] = *(const bf16x8*)(Hb + tok[qp] * INWP + C_NQ + g * 256 + h * 64 + 32 * ks + 8 * kq);
    float gate[3][2];
#pragma unroll
    for (int k = 0; k < 3; ++k)
#pragma unroll
        for (int qp = 0; qp < 2; ++qp) { const float gv = bf2f(Hb[tok[qp] * INWP + C_NG + g * 12 + h * 3 + k]); gate[k][qp] = __builtin_amdgcn_rcpf(1.f + __expf(-gv)); }
    float* y0 = (float*)(ws + WS_YMIX) + tok[0] * D + 1024 + g * 256 + h * 64; float* y1 = (float*)(ws + WS_YMIX) + tok[1] * D + 1024 + g * 256 + h * 64;
    if (tid == 0) selm[64] = 0u;
    f4 ot[4][2]; float m[2], l[2];
#pragma unroll
    for (int dt = 0; dt < 4; ++dt)
#pragma unroll
        for (int qp = 0; qp < 2; ++qp) ot[dt][qp] = mk_f4(0.f, 0.f, 0.f, 0.f);
    int cmax[2];
#pragma unroll
    for (int qp = 0; qp < 2; ++qp) { const int t = t0 + tq[qp]; cmax[qp] = (t >= 31) ? (((t - 31) >> 4) < 126 ? ((t - 31) >> 4) : 126) : -1; }
    __syncthreads();
    { const bf16* KCk = (const bf16*)(ws + WS_KC) + (size_t)((0 * 4 + b) * 4 + g) * 8192; const bf16* KCv = (const bf16*)(ws + WS_KC) + (size_t)((1 * 4 + b) * 4 + g) * 8192;
#pragma unroll
        for (int i = 0; i < 2; ++i) { const int idx = tid + 512 * i, key = idx >> 3, d8 = (idx & 7) * 8;
            *(LAS u4*)(buf0 + key * NS + d8) = *(const u4*)(KCk + key * 64 + d8); *(LAS u4*)(buf0 + (128 + key) * NS + d8) = *(const u4*)(KCv + key * 64 + d8); } }
    __syncthreads();
    m[0] = m[1] = -1e4f; l[0] = l[1] = 0.f;
    { f4 st[4][2]; int lo[2], hi[2];
#pragma unroll 1
        for (int cc = 0; cc < 2; ++cc) {
            if (cc * 64 * 16 + 31 > t0 + 63) break;
#pragma unroll
            for (int qp = 0; qp < 2; ++qp) { lo[qp] = 0; hi[qp] = cmax[qp] - 64 * cc; }
            nsa_scores(st, buf0 + cc * 64 * NS, Yq, lane);
            nsa_softmax_pv(st, m, l, ot, buf0 + 128 * NS + cc * 64 * NS, lo, hi, true, lane);
        }
        { const float g2[2] = {gate[0][0], gate[0][1]}; nsa_flush(y0, y1, ot, l, g2, false, kq); }
        float invl[2], msc[2];
#pragma unroll
        for (int qp = 0; qp < 2; ++qp) { float lt = l[qp]; lt += __shfl_xor(lt, 16); lt += __shfl_xor(lt, 32); invl[qp] = (lt > 0.f) ? 1.f / lt : 0.f; msc[qp] = m[qp] * NSA_SC; }
#pragma unroll 1
        for (int cc = 0; cc < 2; ++cc) {
            nsa_scores(st, buf0 + cc * 64 * NS, Yq, lane);
#pragma unroll
            for (int kt = 0; kt < 4; ++kt)
#pragma unroll
                for (int qp = 0; qp < 2; ++qp) { float pp[4];
#pragma unroll
                    for (int i = 0; i < 4; ++i) { const int ci = 64 * cc + 16 * kt + 4 * kq + i; pp[i] = (ci <= cmax[qp]) ? __builtin_amdgcn_exp2f(st[kt][qp][i] * NSA_SC - msc[qp]) * invl[qp] : 0.f; }
                    const int j = 16 * cc + 4 * kt + kq;
                    impG[(h * 32 + j) * 64 + tq[qp]] = (pp[0] + pp[1]) + (pp[2] + pp[3]);
                    if (j < 31) impE[(h * 32 + j + 1) * 64 + tq[qp]] = pp[3]; }
        } }
    __syncthreads();
    if (tid < 64) { const int tqs = tid; float tv[8]; int ti[8];
#pragma unroll
        for (int k = 0; k < 8; ++k) { tv[k] = -3e38f; ti[k] = 0; }
#pragma unroll 1
        for (int j = 0; j < 32; ++j) { float v;
            if (j <= qt) { const bool forced = (j == 0) || (j == qt) || (j == qt - 1);
                float s4 = (impG[(0 * 32 + j) * 64 + tqs] + impG[(1 * 32 + j) * 64 + tqs]) + (impG[(2 * 32 + j) * 64 + tqs] + impG[(3 * 32 + j) * 64 + tqs]);
                if (j > 0) s4 += (impE[(0 * 32 + j) * 64 + tqs] + impE[(1 * 32 + j) * 64 + tqs]) + (impE[(2 * 32 + j) * 64 + tqs] + impE[(3 * 32 + j) * 64 + tqs]);
                v = forced ? 1e6f : s4; }
            else v = -1e9f;
            int vi = j;
#pragma unroll
            for (int k = 0; k < 8; ++k) { const bool gt = v > tv[k]; const float nv = gt ? tv[k] : v; const int ni = gt ? ti[k] : vi; tv[k] = gt ? v : tv[k]; ti[k] = gt ? vi : ti[k]; v = nv; vi = ni; } }
        unsigned msk = 0u;
#pragma unroll
        for (int k = 0; k < 8; ++k) if (ti[k] <= qt) msk |= (1u << ti[k]);
        selm[tqs] = msk; atomicOr((unsigned*)&selm[64], msk); }
    __syncthreads();
    unsigned mymask[2];
#pragma unroll
    for (int qp = 0; qp < 2; ++qp) mymask[qp] = selm[tq[qp]];
    const unsigned umask = selm[64];
#pragma unroll
    for (int dt = 0; dt < 4; ++dt)
#pragma unroll
        for (int qp = 0; qp < 2; ++qp) ot[dt][qp] = mk_f4(0.f, 0.f, 0.f, 0.f);
    m[0] = m[1] = -1e4f; l[0] = l[1] = 0.f;
    nsa_branch<0>(umask, Hb, b * T, C_KS + g * 64, C_VS + g * 64, buf0, buf1, tid, lane, qt, tq, mymask, Yq, ot, m, l);
    { const float g2[2] = {gate[1][0], gate[1][1]}; nsa_flush(y0, y1, ot, l, g2, true, kq); }
#pragma unroll
    for (int dt = 0; dt < 4; ++dt)
#pragma unroll
        for (int qp = 0; qp < 2; ++qp) ot[dt][qp] = mk_f4(0.f, 0.f, 0.f, 0.f);
    m[0] = m[1] = -1e4f; l[0] = l[1] = 0.f;
    { const int jw0 = qt >= 8 ? qt - 8 : 0; const unsigned wmask = ((qt == 31) ? 0xffffffffu : ((1u << (qt + 1)) - 1u)) & ~((1u << jw0) - 1u);
        nsa_branch<1>(wmask, Hb, b * T, C_KW + g * 64, C_VW + g * 64, buf0, buf1, tid, lane, qt, tq, mymask, Yq, ot, m, l); }
    { const float g2[2] = {gate[2][0], gate[2][1]}; nsa_flush(y0, y1, ot, l, g2, true, kq); }
    __syncthreads();
}

__device__ __forceinline__ void unit_compress_mfma(const Params& P, unsigned char* ws, int l, LAS unsigned char* lds, int u, int tid) {
    const int kv = u >> 7, b = (u >> 5) & 3, g = (u >> 3) & 3, r8 = u & 7, i0 = 16 * r8;
    const bf16* Hb = (const bf16*)(ws + WS_H);
    const bf16* W1T = (const bf16*)(ws + WS_W1T) + (size_t)(l * 2 + kv) * 256 * 2048;
    const bf16* W2T = (const bf16*)(ws + WS_W2T) + (size_t)(l * 2 + kv) * 64 * 256;
    const float* pe = P.in[kv ? 11 : 8] + (size_t)l * 2048;
    constexpr int AS = 2056;
    LAS bf16* Al = (LAS bf16*)lds;
    LAS bf16* hidL = (LAS bf16*)(lds + 16 * AS * 2);
    const int lane = tid & 63, wv = __builtin_amdgcn_readfirstlane(tid >> 6), c = lane & 15, kq = lane >> 4;
    const int col0 = (kv ? C_VC : C_KC) + g * 64;
#pragma unroll 4
    for (int it = 0; it < 8; ++it) { const int idx = tid + 512 * it; const int r = idx >> 8, pos = (idx >> 3) & 31, d8 = (idx & 7) * 8;
        int t = 16 * (i0 + r) + pos; t = t < T ? t : T - 1;
        const u4 a = *(const u4*)(Hb + (size_t)(b * T + t) * INWP + col0 + d8); float f[8]; unpack8(a, f);
        const f4 p0 = *(const f4*)(pe + pos * 64 + d8), p1 = *(const f4*)(pe + pos * 64 + d8 + 4);
        u4 w; w.x = pkbf(f[0] + p0.x, f[1] + p0.y); w.y = pkbf(f[2] + p0.z, f[3] + p0.w); w.z = pkbf(f[4] + p1.x, f[5] + p1.y); w.w = pkbf(f[6] + p1.z, f[7] + p1.w);
        *(LAS u4*)(Al + r * AS + pos * 64 + d8) = w; }
    __syncthreads();
    f4 acc[2];
#pragma unroll
    for (int nt = 0; nt < 2; ++nt) acc[nt] = mk_f4(0.f, 0.f, 0.f, 0.f);
    const bf16* wrow[2];
#pragma unroll
    for (int nt = 0; nt < 2; ++nt) wrow[nt] = W1T + (size_t)(32 * wv + 16 * nt + c) * 2048 + 8 * kq;
    const LAS bf16* arow = Al + c * AS + 8 * kq;
    bf16x8 xfA[2][4], xfB[2][4];
#define CMP_LOADW(XF, p2_) do { _Pragma("unroll") for (int nt = 0; nt < 2; ++nt) _Pragma("unroll") for (int ks = 0; ks < 4; ++ks) XF[nt][ks] = *(const bf16x8*)(wrow[nt] + (p2_) * 128 + 32 * ks); } while (0)
#define CMP_MMAW(XF, p2_) do { _Pragma("unroll") for (int ks = 0; ks < 4; ++ks) { const bf16x8 yf_ = *(const LAS bf16x8*)(arow + (p2_) * 128 + 32 * ks); \
        _Pragma("unroll") for (int nt = 0; nt < 2; ++nt) acc[nt] = MFMA16(XF[nt][ks], yf_, acc[nt]); } } while (0)
    CMP_LOADW(xfA, 0);
#pragma unroll 1
    for (int p2 = 0; p2 < 16; p2 += 2) {
        CMP_LOADW(xfB, p2 + 1);
        CMP_MMAW(xfA, p2);
        if (p2 + 2 < 16) CMP_LOADW(xfA, p2 + 2);
        CMP_MMAW(xfB, p2 + 1);
    }
#undef CMP_LOADW
#undef CMP_MMAW
#pragma unroll
    for (int nt = 0; nt < 2; ++nt) { const f4 a = acc[nt]; u2 w; w.x = pkbf(gelu_tanh(a.x), gelu_tanh(a.y)); w.y = pkbf(gelu_tanh(a.z), gelu_tanh(a.w));
        *(LAS u2*)(hidL + c * 264 + 32 * wv + 16 * nt + 4 * kq) = w; }
    __syncthreads();
    if (wv < 4) { const int ot = wv; f4 o = mk_f4(0.f, 0.f, 0.f, 0.f);
        const bf16* w2p = W2T + (size_t)(16 * ot + c) * 256 + 8 * kq; const LAS bf16* hp = hidL + c * 264 + 8 * kq;
#pragma unroll
        for (int ks = 0; ks < 8; ++ks) { const bf16x8 xw = *(const bf16x8*)(w2p + 32 * ks); const bf16x8 yh = *(const LAS bf16x8*)(hp + 32 * ks); o = MFMA16(xw, yh, o); }
        const int ci = i0 + c;
        u2 w; w.x = pkbf(o.x, o.y); w.y = pkbf(o.z, o.w); if (ci > 126) { w.x = 0u; w.y = 0u; }
        *(u2*)((bf16*)(ws + WS_KC) + ((size_t)((kv * 4 + b) * 4 + g) * 128 + ci) * 64 + 16 * ot + 4 * kq) = w; }
    __syncthreads();
}

__device__ __forceinline__ void unit_retention_mfma(const Params& P, unsigned char* ws, int l, LAS unsigned char* lds, int u, int tid) {
    const int b = u >> 6, h = (u >> 4) & 3, c = u & 15;
    const bf16* Hb = (const bf16*)(ws + WS_H); const f2* rope = (const f2*)(ws + WS_ROPE);
    LAS bf16* Ql = (LAS bf16*)lds;
    LAS bf16* Kl = (LAS bf16*)(lds + 18432);
    LAS bf16* Vt = (LAS bf16*)(lds + 36864);
    LAS bf16* St = (LAS bf16*)(lds + 71680);
    const float lg2h = P.lg2[h];
    const int tok0 = b * T + c * 128;
    { const int m = tid >> 2, p = tid & 3;
        const f4* rp = (const f4*)(rope + (size_t)(c * 128 + m) * 32 + p * 8);
        const f4 r0 = rp[0], r1 = rp[1], r2 = rp[2], r3 = rp[3];
        const float cs[8] = {r0.x, r0.z, r1.x, r1.z, r2.x, r2.z, r3.x, r3.z}, sn[8] = {r0.y, r0.w, r1.y, r1.w, r2.y, r2.w, r3.y, r3.w};
#pragma unroll
        for (int which = 0; which < 2; ++which) { const bf16* src = Hb + (size_t)(tok0 + m) * INWP + (which ? C_RK : C_RQ) + h * 64 + p * 8;
            const u4 a = *(const u4*)src, bb = *(const u4*)(src + 32); float x1[8], x2[8]; unpack8(a, x1); unpack8(bb, x2);
            const float sc = which ? 0.125f : 1.0f; float o1[8], o2[8];
#pragma unroll
            for (int i = 0; i < 8; ++i) { o1[i] = (x1[i] * cs[i] - x2[i] * sn[i]) * sc; o2[i] = (x1[i] * sn[i] + x2[i] * cs[i]) * sc; }
            LAS bf16* dst = (which ? Kl : Ql) + m * 72 + p * 8;
            u4 w1, w2; w1.x = pkbf(o1[0], o1[1]); w1.y = pkbf(o1[2], o1[3]); w1.z = pkbf(o1[4], o1[5]); w1.w = pkbf(o1[6], o1[7]); w2.x = pkbf(o2[0], o2[1]); w2.y = pkbf(o2[2], o2[3]); w2.z = pkbf(o2[4], o2[5]); w2.w = pkbf(o2[6], o2[7]);
            *(LAS u4*)dst = w1; *(LAS u4*)(dst + 32) = w2; } }
    { const int m = tid & 127, eq = tid >> 7;
        const u4* src = (const u4*)(Hb + (size_t)(tok0 + m) * INWP + C_RV + h * 128 + eq * 32); LAS bf16* vp = Vt + (eq * 32) * 136 + m;
#pragma unroll
        for (int j = 0; j < 4; ++j) { const u4 a = src[j];
            vp[(8 * j + 0) * 136] = (bf16)(a.x & 0xffffu); vp[(8 * j + 1) * 136] = (bf16)(a.x >> 16); vp[(8 * j + 2) * 136] = (bf16)(a.y & 0xffffu); vp[(8 * j + 3) * 136] = (bf16)(a.y >> 16);
            vp[(8 * j + 4) * 136] = (bf16)(a.z & 0xffffu); vp[(8 * j + 5) * 136] = (bf16)(a.z >> 16); vp[(8 * j + 6) * 136] = (bf16)(a.w & 0xffffu); vp[(8 * j + 7) * 136] = (bf16)(a.w >> 16); } }
    { float a[16];
#pragma unroll
        for (int i = 0; i < 16; ++i) a[i] = 0.f;
        const float* kvb = (const float*)(ws + WS_KVST) + (size_t)((b * 4 + h) * 16) * 8192 + tid * 16;
#pragma unroll 1
        for (int j = 0; j < c; ++j) { const float w = exp2f(lg2h * 128.f * (float)(c - 1 - j)); const f4* sp = (const f4*)(kvb + (size_t)j * 8192);
#pragma unroll
            for (int q = 0; q < 4; ++q) { const f4 v = sp[q]; a[4 * q] += w * v.x; a[4 * q + 1] += w * v.y; a[4 * q + 2] += w * v.z; a[4 * q + 3] += w * v.w; } }
        const int d = tid >> 3, e0 = (tid & 7) * 16;
#pragma unroll
        for (int i = 0; i < 16; ++i) St[(e0 + i) * 72 + d] = (bf16)f2bf(a[i]); }
    __syncthreads();
    const int lane = tid & 63, wv = __builtin_amdgcn_readfirstlane(tid >> 6), cc = lane & 15, kq = lane >> 4;
    const int nn = 16 * wv + cc;
    bf16x8 yq[2];
#pragma unroll
    for (int ks = 0; ks < 2; ++ks) yq[ks] = *(const LAS bf16x8*)(Ql + nn * 72 + 32 * ks + 8 * kq);
    f4 ot[8];
#pragma unroll
    for (int et = 0; et < 8; ++et) { f4 a = mk_f4(0.f, 0.f, 0.f, 0.f); const LAS bf16* sp = St + (16 * et + cc) * 72 + 8 * kq;
        a = MFMA16(*(const LAS bf16x8*)sp, yq[0], a); a = MFMA16(*(const LAS bf16x8*)(sp + 32), yq[1], a); ot[et] = a; }
    { const float xi = exp2f(lg2h * (float)(nn + 1));
#pragma unroll
        for (int et = 0; et < 8; ++et) ot[et] *= xi; }
    const int nks = (wv >> 1) + 1;
#pragma unroll 1
    for (int ksp = 0; ksp < nks; ++ksp) { f4 st[2];
#pragma unroll
        for (int j = 0; j < 2; ++j) { const int mt = 2 * ksp + j; const LAS bf16* kp = Kl + (16 * mt + cc) * 72 + 8 * kq;
            f4 a = mk_f4(0.f, 0.f, 0.f, 0.f); a = MFMA16(*(const LAS bf16x8*)kp, yq[0], a); a = MFMA16(*(const LAS bf16x8*)(kp + 32), yq[1], a);
#pragma unroll
            for (int i = 0; i < 4; ++i) { const int mm = 16 * mt + 4 * kq + i; a[i] = (mm <= nn) ? a[i] * exp2f(lg2h * (float)(nn - mm)) : 0.f; }
            st[j] = a; }
        u4 w; w.x = pkbf(st[0].x, st[0].y); w.y = pkbf(st[0].z, st[0].w); w.z = pkbf(st[1].x, st[1].y); w.w = pkbf(st[1].z, st[1].w);
        const bf16x8 pf = __builtin_bit_cast(bf16x8, w);
#pragma unroll
        for (int et = 0; et < 8; ++et) { const LAS bf16* vp = Vt + (16 * et + cc) * 136 + 32 * ksp + 4 * kq;
            const s16x4 va = *(const LAS s16x4*)vp, vb = *(const LAS s16x4*)(vp + 16);
            ot[et] = MFMA16(__builtin_shufflevector(va, vb, 0, 1, 2, 3, 4, 5, 6, 7), pf, ot[et]); }
    }
    float s1 = 0.f;
#pragma unroll
    for (int et = 0; et < 8; ++et) s1 += (ot[et].x + ot[et].y) + (ot[et].z + ot[et].w);
    s1 += __shfl_xor(s1, 16); s1 += __shfl_xor(s1, 32);
    const float mu = s1 * (1.f / 128.f); float s2 = 0.f;
#pragma unroll
    for (int et = 0; et < 8; ++et) { const f4 dd = ot[et] - mu; s2 += (dd.x * dd.x + dd.y * dd.y) + (dd.z * dd.z + dd.w * dd.w); }
    s2 += __shfl_xor(s2, 16); s2 += __shfl_xor(s2, 32);
    const float rstd = rsqrtf(s2 * (1.f / 128.f) + LN_EPS);
    const float* gg = P.in[2] + l * 512 + h * 128; const float* gb = P.in[3] + l * 512 + h * 128;
    const bf16* gp = Hb + (size_t)(tok0 + nn) * INWP + C_RG + h * 128;
    float* yo = (float*)(ws + WS_YMIX) + (size_t)(tok0 + nn) * D + h * 128;
#pragma unroll
    for (int et = 0; et < 8; ++et) { const int e = 16 * et + 4 * kq; const f4 g4 = *(const f4*)(gg + e), b4 = *(const f4*)(gb + e); const u2 gr = *(const u2*)(gp + e);
        const float gv[4] = {__uint_as_float(gr.x << 16), __uint_as_float(gr.x & 0xffff0000u), __uint_as_float(gr.y << 16), __uint_as_float(gr.y & 0xffff0000u)};
        f4 o;
#pragma unroll
        for (int i = 0; i < 4; ++i) { const float y = (ot[et][i] - mu) * rstd * g4[i] + b4[i]; o[i] = y * gv[i] * __builtin_amdgcn_rcpf(1.f + __expf(-gv[i])); }
        *(f4*)(yo + e) = o; }
    __syncthreads();
}

__device__ __forceinline__ bf16x8 tr_frag(const LAS bf16* p, int rowstride4) {
    const s16x4 a = __builtin_amdgcn_ds_read_tr16_b64_v4i16((LAS s16x4*)p), b = __builtin_amdgcn_ds_read_tr16_b64_v4i16((LAS s16x4*)(p + rowstride4));
    return __builtin_shufflevector(a, b, 0, 1, 2, 3, 4, 5, 6, 7);
}
__device__ __forceinline__ void unit_kvstate_mfma(const Params& P, unsigned char* ws, LAS unsigned char* lds, int u, int tid) {
    const int b = u / 60, r = u % 60, h = r / 15, j = r % 15;
    const bf16* Hb = (const bf16*)(ws + WS_H); const f2* rope = (const f2*)(ws + WS_ROPE);
    LAS bf16* Kz = (LAS bf16*)lds;
    LAS bf16* Vl = (LAS bf16*)(lds + 20480);
    const int tok0 = b * T + j * 128; const float lg2h = P.lg2[h];
    { const int m = tid >> 2, p = tid & 3;
        const f4* rp = (const f4*)(rope + (size_t)(j * 128 + m) * 32 + p * 8);
        const f4 r0 = rp[0], r1 = rp[1], r2 = rp[2], r3 = rp[3];
        const float cs[8] = {r0.x, r0.z, r1.x, r1.z, r2.x, r2.z, r3.x, r3.z}, sn[8] = {r0.y, r0.w, r1.y, r1.w, r2.y, r2.w, r3.y, r3.w};
        const bf16* src = Hb + (size_t)(tok0 + m) * INWP + C_RK + h * 64 + p * 8;
        const u4 a = *(const u4*)src, bb = *(const u4*)(src + 32); float x1[8], x2[8]; unpack8(a, x1); unpack8(bb, x2);
        const float sc = 0.125f * exp2f(lg2h * (float)(127 - m)); float o1[8], o2[8];
#pragma unroll
        for (int i = 0; i < 8; ++i) { o1[i] = (x1[i] * cs[i] - x2[i] * sn[i]) * sc; o2[i] = (x1[i] * sn[i] + x2[i] * cs[i]) * sc; }
        u4 w1, w2; w1.x = pkbf(o1[0], o1[1]); w1.y = pkbf(o1[2], o1[3]); w1.z = pkbf(o1[4], o1[5]); w1.w = pkbf(o1[6], o1[7]); w2.x = pkbf(o2[0], o2[1]); w2.y = pkbf(o2[2], o2[3]); w2.z = pkbf(o2[4], o2[5]); w2.w = pkbf(o2[6], o2[7]);
        *(LAS u4*)(Kz + m * 80 + p * 8) = w1; *(LAS u4*)(Kz + m * 80 + 32 + p * 8) = w2;
        const u4* vs = (const u4*)(Hb + (size_t)(tok0 + m) * INWP + C_RV + h * 128 + p * 32); LAS u4* vd = (LAS u4*)(Vl + m * 144 + p * 32);
#pragma unroll
        for (int q = 0; q < 4; ++q) vd[q] = vs[q]; }
    __syncthreads();
    { const int lane = tid & 63, et = __builtin_amdgcn_readfirstlane(tid >> 6), c = lane & 15, kq = lane >> 4, q = (lane & 15) >> 2, p4 = lane & 3;
        bf16x8 yv[4];
#pragma unroll
        for (int ks = 0; ks < 4; ++ks) yv[ks] = tr_frag(Vl + (32 * ks + 8 * kq + q) * 144 + 16 * et + 4 * p4, 4 * 144);
        float* dst = (float*)(ws + WS_KVST) + (size_t)((b * 4 + h) * 16 + j) * 8192 + 16 * et + c;
#pragma unroll
        for (int dt = 0; dt < 4; ++dt) { f4 acc = mk_f4(0.f, 0.f, 0.f, 0.f);
#pragma unroll
            for (int ks = 0; ks < 4; ++ks) acc = MFMA16(tr_frag(Kz + (32 * ks + 8 * kq + q) * 80 + 16 * dt + 4 * p4, 4 * 80), yv[ks], acc);
#pragma unroll
            for (int i = 0; i < 4; ++i) dst[(16 * dt + 4 * kq + i) * 128] = acc[i]; } }
    __syncthreads();
}
__device__ __forceinline__ void unit_sgu_mfma(const Params& P, unsigned char* ws, int l, LAS unsigned char* lds, int u, int tid, int lane, int wave) {
    const int b = u >> 6, c = (u >> 2) & 15, g = u & 3;
    const bf16* Hb = (const bf16*)(ws + WS_H);
    LAS bf16* vn = (LAS bf16*)lds;
    const int tok0 = b * T + c * 128;
    const float* lng = P.in[4] + l * 512 + g * 128; const float* lnb = P.in[5] + l * 512 + g * 128;
    const float g0 = lng[2 * lane], g1 = lng[2 * lane + 1], b0 = lnb[2 * lane], b1 = lnb[2 * lane + 1];
#pragma unroll 4
    for (int i = 0; i < 16; ++i) { const int s = wave * 16 + i;
        const unsigned pr = *(const unsigned*)(Hb + (size_t)(tok0 + s) * INWP + C_SV + g * 128 + 2 * lane);
        const float v0 = __uint_as_float(pr << 16), v1 = __uint_as_float(pr & 0xffff0000u);
        const float mu = wave_sum(v0 + v1) * (1.f / 128.f); const float d0 = v0 - mu, d1 = v1 - mu;
        const float var = wave_sum(d0 * d0 + d1 * d1) * (1.f / 128.f); const float rstd = rsqrtf(var + LN_EPS);
        *(LAS unsigned*)(vn + s * 144 + 2 * lane) = pkbf(d0 * rstd * g0 + b0, d1 * rstd * g1 + b1); }
    __syncthreads();
    { const int cc = lane & 15, kq = lane >> 4, q = (lane & 15) >> 2, p4 = lane & 3, t = 16 * wave + cc, nks = (wave >> 1) + 1;
        const float* wrow = P.in[6] + ((size_t)l * 4 + g) * 16384 + (size_t)t * 128 + 8 * kq;
        bf16x8 xw[4];
#pragma unroll
        for (int ks = 0; ks < 4; ++ks) { u4 w = {0u, 0u, 0u, 0u};
            if (ks < nks) { const f4 a0 = *(const f4*)(wrow + 32 * ks), a1 = *(const f4*)(wrow + 32 * ks + 4); const int s0 = 32 * ks + 8 * kq;
                w.x = pkbf(s0 + 0 <= t ? a0.x : 0.f, s0 + 1 <= t ? a0.y : 0.f); w.y = pkbf(s0 + 2 <= t ? a0.z : 0.f, s0 + 3 <= t ? a0.w : 0.f);
                w.z = pkbf(s0 + 4 <= t ? a1.x : 0.f, s0 + 5 <= t ? a1.y : 0.f); w.w = pkbf(s0 + 6 <= t ? a1.z : 0.f, s0 + 7 <= t ? a1.w : 0.f); }
            xw[ks] = __builtin_bit_cast(bf16x8, w); }
        f4 bs4; { const float* bsp = P.in[7] + (l * 4 + g) * 128 + 16 * wave + 4 * kq; bs4 = *(const f4*)bsp; }
#pragma unroll 2
        for (int dt = 0; dt < 8; ++dt) { f4 acc = mk_f4(0.f, 0.f, 0.f, 0.f);
#pragma unroll
            for (int ks = 0; ks < 4; ++ks) if (ks < nks) acc = MFMA16(xw[ks], tr_frag(vn + (32 * ks + 8 * kq + q) * 144 + 16 * dt + 4 * p4, 4 * 144), acc);
            const int d = 16 * dt + cc;
#pragma unroll
            for (int i = 0; i < 4; ++i) { const int tt = 16 * wave + 4 * kq + i; const float uu = bf2f(Hb[(size_t)(tok0 + tt) * INWP + C_SU + g * 128 + d]);
                ((float*)(ws + WS_YMIX))[(size_t)(tok0 + tt) * D + 512 + g * 128 + d] = uu * (acc[i] + bs4[i]); } } }
    __syncthreads();
}

__device__ __forceinline__ void row_mixnorm(const Params& P, unsigned char* ws, int l, int rowi, int lane) {
    const f4* yp = (const f4*)((const float*)(ws + WS_YMIX) + (size_t)rowi * D) + lane;
    const f4* gp = (const f4*)(P.in[14] + (size_t)l * D) + lane;
    f4 v[8]; float ss[8];
#pragma unroll
    for (int j = 0; j < 8; ++j) { v[j] = yp[64 * j]; ss[j] = v[j].x * v[j].x + v[j].y * v[j].y + v[j].z * v[j].z + v[j].w * v[j].w; }
    const float r0 = rsqrtf(wave_sum(ss[0] + ss[1]) * (1.f / 512.f) + LN_EPS);
    const float r1 = rsqrtf(wave_sum(ss[2] + ss[3]) * (1.f / 512.f) + LN_EPS);
    const float r2 = rsqrtf(wave_sum((ss[4] + ss[5]) + (ss[6] + ss[7])) * (1.f / 1024.f) + LN_EPS);
    u2* op = (u2*)((bf16*)(ws + WS_MIXED) + (size_t)rowi * D) + lane;
#pragma unroll
    for (int j = 0; j < 8; ++j) { const float r = (j < 2) ? r0 : ((j < 4) ? r1 : r2); const f4 g4 = gp[64 * j];
        op[64 * j] = mk_u2(pk2(v[j].x * r * g4.x, v[j].y * r * g4.y), pk2(v[j].z * r * g4.z, v[j].w * r * g4.w)); }
}
__device__ __forceinline__ void row_ln(const float* __restrict__ zin, const float* __restrict__ gam, const float* __restrict__ bet, float* __restrict__ of32, bf16* __restrict__ obf, unsigned* __restrict__ oq, float* __restrict__ osc, int rowi, int lane) {
    const f4* zp = (const f4*)(zin + (size_t)rowi * D) + lane;
    f4 v[8]; float s = 0.f;
#pragma unroll
    for (int j = 0; j < 8; ++j) { v[j] = zp[64 * j]; s += (v[j].x + v[j].y) + (v[j].z + v[j].w); }
    const float mu = wave_sum(s) * (1.f / D); float s2 = 0.f;
#pragma unroll
    for (int j = 0; j < 8; ++j) { v[j].x -= mu; v[j].y -= mu; v[j].z -= mu; v[j].w -= mu; s2 += (v[j].x * v[j].x + v[j].y * v[j].y) + (v[j].z * v[j].z + v[j].w * v[j].w); }
    const float rstd = rsqrtf(wave_sum(s2) * (1.f / D) + LN_EPS);
    f4* o4 = (f4*)(of32 + (size_t)rowi * D) + lane; u2* o2 = (u2*)(obf + (size_t)rowi * D) + lane;
    const f4* gp = (const f4*)gam + lane; const f4* bp = (const f4*)bet + lane;
    float am = 0.f;
#pragma unroll
    for (int j = 0; j < 8; ++j) { const f4 g4 = gp[64 * j], b4 = bp[64 * j];
        const f4 o = mk_f4(v[j].x * rstd * g4.x + b4.x, v[j].y * rstd * g4.y + b4.y, v[j].z * rstd * g4.z + b4.z, v[j].w * rstd * g4.w + b4.w);
        o4[64 * j] = o; o2[64 * j] = mk_u2(pk2(o.x, o.y), pk2(o.z, o.w)); v[j] = o;
        am = fmaxf(am, fmaxf(fmaxf(fabsf(o.x), fabsf(o.y)), fmaxf(fabsf(o.z), fabsf(o.w)))); }
#pragma unroll
    for (int o = 1; o < 64; o <<= 1) am = fmaxf(am, __shfl_xor(am, o));
    const float sc = (am > 0.f) ? 127.f / am : 1.f;
    if (lane == 0) osc[rowi] = (am > 0.f) ? am * (1.f / 127.f) : 1.f;
    unsigned* qp = oq + (size_t)rowi * (D / 4) + lane;
#pragma unroll
    for (int j = 0; j < 8; ++j) { const int b0 = (int)rintf(v[j].x * sc), b1 = (int)rintf(v[j].y * sc), b2 = (int)rintf(v[j].z * sc), b3 = (int)rintf(v[j].w * sc);
        qp[64 * j] = (unsigned)(b0 & 0xff) | ((unsigned)(b1 & 0xff) << 8) | ((unsigned)(b2 & 0xff) << 16) | ((unsigned)b3 << 24); }
}

__device__ __forceinline__ float dot8_bf16(const u4& w, const float* x) {
    float f[8]; unpack8(w, f);
    return ((f[0] * x[0] + f[1] * x[1]) + (f[2] * x[2] + f[3] * x[3])) + ((f[4] * x[4] + f[5] * x[5]) + (f[6] * x[6] + f[7] * x[7]));
}
__device__ __forceinline__ void peer_load4(u4 (&R)[4][2], const unsigned char* __restrict__ TAB, const LAS int* pe, int grp, int lane) {
#pragma unroll
    for (int k = 0; k < 4; ++k) { const int e = __builtin_amdgcn_readfirstlane(pe[grp * 4 + k]); const u4* p = (const u4*)(TAB + (size_t)e * 2048) + lane; R[k][0] = p[0]; R[k][1] = p[64]; }
}
__device__ __forceinline__ float dot16_fp8(const u4& w, const float* x) {
    float s = 0.f;
#pragma unroll
    for (int q = 0; q < 4; ++q) { const f2 lo = __builtin_amdgcn_cvt_pk_f32_fp8((int)w[q], false), hi = __builtin_amdgcn_cvt_pk_f32_fp8((int)w[q], true);
        s += (lo.x * x[4 * q] + lo.y * x[4 * q + 1]) + (hi.x * x[4 * q + 2] + hi.y * x[4 * q + 3]); }
    return s;
}
__device__ __forceinline__ void peer_dot4(const u4 (&R)[4][2], const float (&xr)[32], const float* __restrict__ USC, const LAS int* pe, const LAS float* pw, const float* __restrict__ VSC, LAS float* hwp, int grp, int lane) {
    float d[4];
#pragma unroll
    for (int k = 0; k < 4; ++k) d[k] = dot16_fp8(R[k][0], xr) + dot16_fp8(R[k][1], xr + 16);
#pragma unroll
    for (int o = 1; o < 64; o <<= 1) {
#pragma unroll
        for (int k = 0; k < 4; ++k) d[k] += __shfl_xor(d[k], o); }
#pragma unroll
    for (int k = 0; k < 4; ++k) { const int e = __builtin_amdgcn_readfirstlane(pe[grp * 4 + k]);
        const float hv = pw[grp * 4 + k] * gelu_tanh(d[k] * USC[e]) * VSC[e];
        if (lane == 0) hwp[grp * 4 + k] = hv; }
}
__device__ __forceinline__ void peer_axpy4(const u4 (&R)[4][2], float (&acc)[32], const LAS float* hwp, int grp) {
#pragma unroll
    for (int k = 0; k < 4; ++k) { const float hw = hwp[grp * 4 + k];
#pragma unroll
        for (int j = 0; j < 2; ++j)
#pragma unroll
            for (int q = 0; q < 4; ++q) { const f2 lo = __builtin_amdgcn_cvt_pk_f32_fp8((int)R[k][j][q], false), hi = __builtin_amdgcn_cvt_pk_f32_fp8((int)R[k][j][q], true);
                acc[16 * j + 4 * q] += hw * lo.x; acc[16 * j + 4 * q + 1] += hw * lo.y; acc[16 * j + 4 * q + 2] += hw * hi.x; acc[16 * j + 4 * q + 3] += hw * hi.y; } }
}
__device__ __forceinline__ void unit_peer(const Params& P, unsigned char* ws, int l, LAS unsigned char* lds, int u, int tid_in, int lane_in, int wave, float* __restrict__ xout) {
    int tid = tid_in; asm volatile("" : "+v"(tid)); int lane = tid & 63;
    const int n0 = u * 32;
    const bf16* QPB = (const bf16*)(ws + WS_QP); int* SC = (int*)(ws + WS_SC);
    { const int h = wave, c = lane & 15, kq = lane >> 4;
#pragma unroll 1
        for (int half = 0; half < 2; ++half) {
            const bf16* kb = (const bf16*)(ws + WS_PKB) + ((size_t)(half * DEPTH + l) * 8 + h) * 16384;
            bf16x8 yq[2][4];
#pragma unroll
            for (int tt = 0; tt < 2; ++tt)
#pragma unroll
                for (int ks = 0; ks < 4; ++ks) yq[tt][ks] = *(const bf16x8*)(QPB + (size_t)(n0 + 16 * tt + c) * D + h * 256 + half * 128 + 32 * ks + 8 * kq);
            bf16x8 xk[4], xn_[4];
#pragma unroll
            for (int ks = 0; ks < 4; ++ks) xk[ks] = *(const bf16x8*)(kb + (size_t)c * 128 + 32 * ks + 8 * kq);
#pragma unroll 1
            for (int kt = 0; kt < 8; ++kt) {
                if (kt + 1 < 8) {
#pragma unroll
                    for (int ks = 0; ks < 4; ++ks) xn_[ks] = *(const bf16x8*)(kb + (size_t)(16 * (kt + 1) + c) * 128 + 32 * ks + 8 * kq); }
#pragma unroll
                for (int tt = 0; tt < 2; ++tt) { f4 a = mk_f4(0.f, 0.f, 0.f, 0.f);
#pragma unroll
                    for (int ks = 0; ks < 4; ++ks) a = MFMA16(xk[ks], yq[tt][ks], a);
                    int kk[4];
#pragma unroll
                    for (int i = 0; i < 4; ++i) { const int bits = __float_as_int(a[i]); const int sk = bits ^ ((bits >> 31) & 0x7fffffff); kk[i] = (sk & ~127) | (127 - (16 * kt + 4 * kq + i)); }
                    u4 w; w.x = (unsigned)kk[0]; w.y = (unsigned)kk[1]; w.z = (unsigned)kk[2]; w.w = (unsigned)kk[3];
                    *(u4*)(SC + ((size_t)(n0 + 16 * tt + c) * 16 + 2 * h + half) * 128 + 16 * kt + 4 * kq) = w; }
#pragma unroll
                for (int ks = 0; ks < 4; ++ks) xk[ks] = xn_[ks]; }
        } }
    VM_WAIT();
    __syncthreads();
    tid = tid_in; asm volatile("" : "+v"(tid)); lane = tid & 63;
    LAS int* TK = (LAS int*)lds;
    { const int tk = tid >> 4, hh = tid & 15;
        const u4* sp = (const u4*)(SC + ((size_t)(n0 + tk) * 16 + hh) * 128);
        int t[16];
#pragma unroll
        for (int k = 0; k < 16; ++k) t[k] = (int)0x80000000;
#pragma unroll 1
        for (int c4 = 0; c4 < 32; ++c4) { const u4 s4 = sp[c4];
#pragma unroll
            for (int e = 0; e < 4; ++e) { int x = (int)s4[e];
#pragma unroll
                for (int k = 0; k < 16; ++k) { const int hi_ = max(t[k], x); x = min(t[k], x); t[k] = hi_; } } }
#pragma unroll
        for (int k = 0; k < 16; ++k) TK[tid * 17 + k] = t[k]; }
    __syncthreads();
    tid = tid_in; asm volatile("" : "+v"(tid)); lane = tid & 63;
    LAS int* PE = (LAS int*)(lds + 69632);
    LAS float* PW = (LAS float*)(lds + 86016);
    if (tid < 256) { const int tk = tid >> 3, h = tid & 7; const int r1 = tk * 16 + 2 * h, r2 = r1 + 1;
        float v1[16], v2[16];
#pragma unroll
        for (int k = 0; k < 16; ++k) { const int k1 = TK[r1 * 17 + k] & ~127, k2 = TK[r2 * 17 + k] & ~127;
            v1[k] = __int_as_float(k1 ^ ((k1 >> 31) & 0x7fffffff)); v2[k] = __int_as_float(k2 ^ ((k2 >> 31) & 0x7fffffff)); }
        int t[16];
#pragma unroll
        for (int k = 0; k < 16; ++k) t[k] = (int)0x80000000;
#pragma unroll
        for (int a = 0; a < 16; ++a)
#pragma unroll
            for (int bq = 0; bq < 16; ++bq) if ((a + 1) * (bq + 1) <= 16) { const int bits = __float_as_int(v1[a] + v2[bq]); const int sk = bits ^ ((bits >> 31) & 0x7fffffff);
                int x = (sk & ~255) | (255 - (a * 16 + bq));
#pragma unroll
                for (int k = 0; k < 16; ++k) { const int hi_ = max(t[k], x); x = min(t[k], x); t[k] = hi_; } }
        float w[16], wsum = 0.f; const int kt0 = t[0] & ~255; const float top = __int_as_float(kt0 ^ ((kt0 >> 31) & 0x7fffffff));
#pragma unroll
        for (int k = 0; k < 16; ++k) { const int kk = t[k] & ~255; const float sv = __int_as_float(kk ^ ((kk >> 31) & 0x7fffffff)); w[k] = __expf(sv - top); wsum += w[k]; }
        const float inv = 1.f / wsum;
#pragma unroll
        for (int k = 0; k < 16; ++k) { const int ab = 255 - (t[k] & 255); const int a = ab >> 4, bq = ab & 15;
            const int i1 = 127 - (TK[r1 * 17 + a] & 127), i2 = 127 - (TK[r2 * 17 + bq] & 127);
            PE[tk * 128 + h * 16 + k] = i1 * 128 + i2; PW[tk * 128 + h * 16 + k] = w[k] * inv; } }
    __syncthreads();
    tid = tid_in; asm volatile("" : "+v"(tid)); lane = tid & 63;
    { int* FE = (int*)(ws + WS_FE) + (size_t)u * 16 * FCAP; float* FW = (float*)(ws + WS_FW) + (size_t)u * 16 * FCAP; int* GST = (int*)(ws + WS_GST) + (size_t)u * 16 * 64;
        LAS int* CNT = (LAS int*)(lds + 118784);
        LAS int* STA = (LAS int*)(lds + 120832);
#pragma unroll 1
        for (int it = 0; it < 4; ++it) { const int tk = wave * 4 + it;
            const int k0 = PE[tk * 128 + lane] >> BSH, k1 = PE[tk * 128 + 64 + lane] >> BSH; int mycnt = 0;
#pragma unroll
            for (int v = 0; v < NBKT; ++v) { const int c = __builtin_popcountll(__builtin_amdgcn_ballot_w64(k0 == v)) + __builtin_popcountll(__builtin_amdgcn_ballot_w64(k1 == v)); if (lane == v) mycnt = (c + PG - 1) & ~(PG - 1); }
            if (lane < NBKT) CNT[tk * 16 + lane] = mycnt; }
        __syncthreads();
        if (tid < NBKT) { int run = 0;
#pragma unroll 1
            for (int t = 0; t < 32; ++t) { STA[t * 16 + tid] = run; run += CNT[t * 16 + tid]; }
            STA[32 * 16 + tid] = run; }
        __syncthreads();
        for (int i = tid; i < NBKT * 33; i += 512) { const int bb = i / 33, t = i % 33; GST[bb * 64 + t] = STA[t * 16 + bb]; }
#pragma unroll 1
        for (int it = 0; it < 4; ++it) { const int tk = wave * 4 + it;
            const int e0 = PE[tk * 128 + lane], e1 = PE[tk * 128 + 64 + lane]; const float w0 = PW[tk * 128 + lane], w1 = PW[tk * 128 + 64 + lane];
            const int k0 = e0 >> BSH, k1 = e1 >> BSH; int pos0 = 0, pos1 = 0;
#pragma unroll
            for (int v = 0; v < NBKT; ++v) { const unsigned long long b0 = __builtin_amdgcn_ballot_w64(k0 == v), b1 = __builtin_amdgcn_ballot_w64(k1 == v);
                const int c0 = __builtin_popcountll(b0), c = c0 + __builtin_popcountll(b1), pc = (c + PG - 1) & ~(PG - 1); const int base = STA[tk * 16 + v];
                const int r0 = (int)__builtin_amdgcn_mbcnt_hi((unsigned)(b0 >> 32), __builtin_amdgcn_mbcnt_lo((unsigned)b0, 0u));
                const int r1 = c0 + (int)__builtin_amdgcn_mbcnt_hi((unsigned)(b1 >> 32), __builtin_amdgcn_mbcnt_lo((unsigned)b1, 0u));
                if (k0 == v) pos0 = v * FCAP + base + r0;
                if (k1 == v) pos1 = v * FCAP + base + r1;
                if (lane < pc - c) { FE[v * FCAP + base + c + lane] = v << BSH; FW[v * FCAP + base + c + lane] = 0.f; } }
            FE[pos0] = e0; FW[pos0] = w0; FE[pos1] = e1; FW[pos1] = w1; } }
    __syncthreads();
}

__device__ __forceinline__ void peer3_rows(u4 (&R)[PG][2], const unsigned char* __restrict__ TAB, int ev, int g, int lane) {
#pragma unroll
    for (int k = 0; k < PG; ++k) { const int e = __builtin_amdgcn_readlane(ev, PG * g + k); const unsigned char* rowp = TAB + (size_t)(unsigned)e * 2048u; R[k][0] = *(const u4*)(rowp + (unsigned)lane * 16u); R[k][1] = *(const u4*)(rowp + 1024u + (unsigned)lane * 16u); }
}
#define DPP_F(v, ctrl) __int_as_float(__builtin_amdgcn_update_dpp(0, __float_as_int(v), (ctrl), 0xf, 0xf, true))
__device__ __forceinline__ float wave_sum_dpp(float v) {
    v += DPP_F(v, 0xB1); v += DPP_F(v, 0x4E); v += DPP_F(v, 0x141); v += DPP_F(v, 0x140);
    const int iv = __float_as_int(v);
    return (__int_as_float(__builtin_amdgcn_readlane(iv, 0)) + __int_as_float(__builtin_amdgcn_readlane(iv, 16))) + (__int_as_float(__builtin_amdgcn_readlane(iv, 32)) + __int_as_float(__builtin_amdgcn_readlane(iv, 48)));
}
__device__ __forceinline__ float dot16_pk(const u4& w, const f2* x) {
    f2 a = {0.f, 0.f};
#pragma unroll
    for (int q = 0; q < 4; ++q) { const f2 lo = __builtin_amdgcn_cvt_pk_f32_fp8((int)w[q], false), hi = __builtin_amdgcn_cvt_pk_f32_fp8((int)w[q], true);
        a = __builtin_elementwise_fma(lo, x[2 * q], a); a = __builtin_elementwise_fma(hi, x[2 * q + 1], a); }
    return a.x + a.y;
}
__device__ __forceinline__ int wave_isum_dpp(int v) {
    v += __builtin_amdgcn_update_dpp(0, v, 0xB1, 0xf, 0xf, true); v += __builtin_amdgcn_update_dpp(0, v, 0x4E, 0xf, 0xf, true);
    v += __builtin_amdgcn_update_dpp(0, v, 0x141, 0xf, 0xf, true); v += __builtin_amdgcn_update_dpp(0, v, 0x140, 0xf, 0xf, true);
    return (__builtin_amdgcn_readlane(v, 0) + __builtin_amdgcn_readlane(v, 16)) + (__builtin_amdgcn_readlane(v, 32) + __builtin_amdgcn_readlane(v, 48));
}
__device__ __forceinline__ int wave_isum4_t(const int (&d)[4], int lane) {
    const bool o1 = lane & 1, o2 = lane & 2;
    int a = o1 ? d[1] : d[0], b = o1 ? d[0] : d[1], c = o1 ? d[3] : d[2], e = o1 ? d[2] : d[3];
    a += __builtin_amdgcn_update_dpp(0, b, 0xB1, 0xf, 0xf, true);
    c += __builtin_amdgcn_update_dpp(0, e, 0xB1, 0xf, 0xf, true);
    int f = o2 ? c : a, g = o2 ? a : c;
    f += __builtin_amdgcn_update_dpp(0, g, 0x4E, 0xf, 0xf, true);
    f += __builtin_amdgcn_update_dpp(0, f, 0x124, 0xf, 0xf, true);
    f += __builtin_amdgcn_update_dpp(0, f, 0x128, 0xf, 0xf, true);
    f += __shfl_xor(f, 16); f += __shfl_xor(f, 32);
    return f;
}
__device__ __forceinline__ void peer3_dots(const u4 (&R)[PG][2], const u4 (&xq)[2], int& dv, int g, int lane) {
    static_assert(PG == 4, "peer3_dots reduces four rows at a time");
    int d[4];
#pragma unroll
    for (int k = 0; k < 4; ++k) { int a = 0;
#pragma unroll
        for (int j = 0; j < 2; ++j)
#pragma unroll
            for (int q = 0; q < 4; ++q) a = __builtin_amdgcn_sdot4((int)R[k][j][q], (int)xq[j][q], a, false);
        d[k] = a; }
    const int t = wave_isum4_t(d, lane);
    dv = (lane >= 4 * g && lane < 4 * g + 4) ? t : dv;
}
__device__ __forceinline__ void peer3_axpy(const u4 (&R)[PG][2], f2 (&acc)[16], int hwv, int g) {
#pragma unroll
    for (int k = 0; k < PG; ++k) { const float hw = __int_as_float(__builtin_amdgcn_readlane(hwv, PG * g + k)); const f2 hw2 = {hw, hw};
#pragma unroll
        for (int j = 0; j < 2; ++j)
#pragma unroll
            for (int q = 0; q < 4; ++q) { const f2 lo = __builtin_amdgcn_cvt_pk_f32_fp8((int)R[k][j][q], false), hi = __builtin_amdgcn_cvt_pk_f32_fp8((int)R[k][j][q], true);
                acc[8 * j + 2 * q] = __builtin_elementwise_fma(lo, hw2, acc[8 * j + 2 * q]); acc[8 * j + 2 * q + 1] = __builtin_elementwise_fma(hi, hw2, acc[8 * j + 2 * q + 1]); }
        __builtin_amdgcn_sched_barrier(0); }
}
__device__ __forceinline__ void unpack_row(const u4 (&X)[4], f2 (&o)[16]) {
#pragma unroll
    for (int i = 0; i < 4; ++i) { o[4 * i].x = __uint_as_float(X[i].x << 16); o[4 * i].y = __uint_as_float(X[i].x & 0xffff0000u); o[4 * i + 1].x = __uint_as_float(X[i].y << 16); o[4 * i + 1].y = __uint_as_float(X[i].y & 0xffff0000u);
        o[4 * i + 2].x = __uint_as_float(X[i].z << 16); o[4 * i + 2].y = __uint_as_float(X[i].z & 0xffff0000u); o[4 * i + 3].x = __uint_as_float(X[i].w << 16); o[4 * i + 3].y = __uint_as_float(X[i].w & 0xffff0000u); }
}
__device__ __forceinline__ void peer3_rowload(u4 (&X)[4], const bf16* __restrict__ base, unsigned n, int lane) {
    const bf16* p = base + (n * (unsigned)D + (unsigned)(16 * lane));
    X[0] = *(const u4*)p; X[1] = *(const u4*)(p + 8); X[2] = *(const u4*)(p + 1024); X[3] = *(const u4*)(p + 1032);
}
__device__ __forceinline__ void peer3_rowstore(bf16* __restrict__ base, unsigned n, int lane, const f2 (&acc)[16]) {
    bf16* p = base + (n * (unsigned)D + (unsigned)(16 * lane));
#pragma unroll
    for (int j = 0; j < 2; ++j) { u4 p0, p1; p0.x = pkbf(acc[8 * j].x, acc[8 * j].y); p0.y = pkbf(acc[8 * j + 1].x, acc[8 * j + 1].y); p0.z = pkbf(acc[8 * j + 2].x, acc[8 * j + 2].y); p0.w = pkbf(acc[8 * j + 3].x, acc[8 * j + 3].y);
        p1.x = pkbf(acc[8 * j + 4].x, acc[8 * j + 4].y); p1.y = pkbf(acc[8 * j + 5].x, acc[8 * j + 5].y); p1.z = pkbf(acc[8 * j + 6].x, acc[8 * j + 6].y); p1.w = pkbf(acc[8 * j + 7].x, acc[8 * j + 7].y);
        __builtin_nontemporal_store(p0, (u4*)(p + 1024 * j)); __builtin_nontemporal_store(p1, (u4*)(p + 1024 * j + 8)); }
}
__device__ __forceinline__ int peer3_next_nonempty(int gstv, int t) {
    while (t < 32 && __builtin_amdgcn_readlane(gstv, t + 1) == __builtin_amdgcn_readlane(gstv, t)) ++t;
    return t;
}
__device__ __forceinline__ void phase_peer_bucket(const Params& P, unsigned char* ws, int l, int bid, int G, int lane, int wave) {
    const int x = bid & 7, r = bid >> 3;
    const int u = r * 8 + wave; const unsigned nbase = (unsigned)u * 32u;
    const unsigned char* PU = ws + WS_PU + (size_t)l * 16384 * 2048; const unsigned char* PV = ws + WS_PV + (size_t)l * 16384 * 2048;
    const float* USC = (const float*)(ws + WS_PSC) + (size_t)l * 16384; const float* VSC = (const float*)(ws + WS_PSC) + (size_t)(DEPTH + l) * 16384;
    const bf16* X1B = (const bf16*)(ws + WS_X1B);
    bf16* PART = (bf16*)(ws + WS_PART) + (size_t)x * NTOK * D;
#pragma unroll 1
    for (int rnd = 0; rnd < NRND; ++rnd) { const int xb = x + 8 * rnd;
        const int* FE = (const int*)(ws + WS_FE) + ((size_t)u * 16 + xb) * FCAP; const float* FW = (const float*)(ws + WS_FW) + ((size_t)u * 16 + xb) * FCAP; float* FHW = (float*)(ws + WS_FHW) + ((size_t)u * 16 + xb) * FCAP;
        int gstv = 0; if (lane <= 32) gstv = ((const int*)(ws + WS_GST))[((size_t)u * 16 + xb) * 64 + lane];
        const int total = __builtin_amdgcn_readlane(gstv, 32);
        REP(30) if (total > 0) {
            const unsigned char* X1Q = ws + WS_X1Q; const float* XSC = (const float*)(ws + WS_XSC);
            int tcur = peer3_next_nonempty(gstv, 0); int tnx = peer3_next_nonempty(gstv, tcur + 1); int tend = __builtin_amdgcn_readlane(gstv, tcur + 1);
            u4 xq[2], xn[2];
            { const unsigned char* p = X1Q + (size_t)(nbase + tcur) * 2048u + (unsigned)lane * 16u; xq[0] = __builtin_nontemporal_load((const u4*)p); xq[1] = __builtin_nontemporal_load((const u4*)(p + 1024)); }
            if (tnx < 32) { const unsigned char* p = X1Q + (size_t)(nbase + tnx) * 2048u + (unsigned)lane * 16u; xn[0] = __builtin_nontemporal_load((const u4*)p); xn[1] = __builtin_nontemporal_load((const u4*)(p + 1024)); }
            float xs = XSC[nbase + tcur];
#pragma unroll 1
            for (int blk = 0; blk < total; blk += 64) { const int blen = (total - blk) < 64 ? (total - blk) : 64, ng = blen / PG;
                int ev = 0; float wv = 0.f;
                if (lane < blen) { ev = __builtin_nontemporal_load(FE + blk + lane); wv = __builtin_nontemporal_load(FW + blk + lane); }
                const float us = USC[ev], vs = VSC[ev];
                int dv = 0; float xsv = 0.f; u4 A[PG][2], B[PG][2];
                peer3_rows(A, PU, ev, 0, lane);
#pragma unroll 1
                for (int g = 0; g < ng; g += 2) {
                    if (g + 1 < ng) peer3_rows(B, PU, ev, g + 1, lane);
                    if (blk + PG * g >= tend) { tcur = tnx; xq[0] = xn[0]; xq[1] = xn[1]; xs = XSC[nbase + tcur]; tend = __builtin_amdgcn_readlane(gstv, tcur + 1);
                        tnx = peer3_next_nonempty(gstv, tcur + 1); if (tnx < 32) { const unsigned char* p = X1Q + (size_t)(nbase + tnx) * 2048u + (unsigned)lane * 16u; xn[0] = __builtin_nontemporal_load((const u4*)p); xn[1] = __builtin_nontemporal_load((const u4*)(p + 1024)); } }
                    peer3_dots(A, xq, dv, g, lane);
                    xsv = (lane >= PG * g && lane < PG * g + PG) ? xs : xsv;
                    __builtin_amdgcn_sched_barrier(0);
                    if (g + 2 < ng) peer3_rows(A, PU, ev, g + 2, lane);
                    if (g + 1 < ng) {
                        if (blk + PG * (g + 1) >= tend) { tcur = tnx; xq[0] = xn[0]; xq[1] = xn[1]; xs = XSC[nbase + tcur]; tend = __builtin_amdgcn_readlane(gstv, tcur + 1);
                            tnx = peer3_next_nonempty(gstv, tcur + 1); if (tnx < 32) { const unsigned char* p = X1Q + (size_t)(nbase + tnx) * 2048u + (unsigned)lane * 16u; xn[0] = __builtin_nontemporal_load((const u4*)p); xn[1] = __builtin_nontemporal_load((const u4*)(p + 1024)); } }
                        peer3_dots(B, xq, dv, g + 1, lane);
                        xsv = (lane >= PG * (g + 1) && lane < PG * (g + 1) + PG) ? xs : xsv; }
                    __builtin_amdgcn_sched_barrier(0);
                }
                if (lane < blen) FHW[blk + lane] = wv * gelu_tanh((float)dv * us * xsv) * vs;
            } }
        VM_WAIT();
        REP(31) { f2 acc[16];
            if (rnd == 0) {
#pragma unroll
                for (int i = 0; i < 16; ++i) acc[i] = (f2){0.f, 0.f};
#pragma unroll 1
                for (int t = 0; t < 32; ++t) if (__builtin_amdgcn_readlane(gstv, t + 1) == __builtin_amdgcn_readlane(gstv, t)) peer3_rowstore(PART, nbase + t, lane, acc); }
            if (total > 0) {
                int tcur = peer3_next_nonempty(gstv, 0); int tnx = peer3_next_nonempty(gstv, tcur + 1); int tend = __builtin_amdgcn_readlane(gstv, tcur + 1);
                u4 xn[4];
                if (rnd > 0) { u4 xq[4]; peer3_rowload(xq, PART, nbase + tcur, lane); if (tnx < 32) peer3_rowload(xn, PART, nbase + tnx, lane); unpack_row(xq, acc); }
                else {
#pragma unroll
                    for (int i = 0; i < 16; ++i) acc[i] = (f2){0.f, 0.f}; }
#pragma unroll 1
                for (int blk = 0; blk < total; blk += 64) { const int blen = (total - blk) < 64 ? (total - blk) : 64, ng = blen / PG;
                    int ev = 0, hwv = 0;
                    if (lane < blen) { ev = __builtin_nontemporal_load(FE + blk + lane); hwv = (int)__hip_atomic_load((const unsigned*)(FHW + blk + lane), __ATOMIC_RELAXED, __HIP_MEMORY_SCOPE_AGENT); }
                    u4 A[PG][2], B[PG][2];
                    peer3_rows(A, PV, ev, 0, lane);
#pragma unroll 1
                    for (int g = 0; g < ng; g += 2) {
                        if (g + 1 < ng) peer3_rows(B, PV, ev, g + 1, lane);
                        if (blk + PG * g >= tend) { peer3_rowstore(PART, nbase + tcur, lane, acc); tcur = tnx; tend = __builtin_amdgcn_readlane(gstv, tcur + 1);
                            if (rnd > 0) { unpack_row(xn, acc); }
                            else {
#pragma unroll
                                for (int i = 0; i < 16; ++i) acc[i] = (f2){0.f, 0.f}; }
                            tnx = peer3_next_nonempty(gstv, tcur + 1); if (rnd > 0 && tnx < 32) peer3_rowload(xn, PART, nbase + tnx, lane); }
                        peer3_axpy(A, acc, hwv, g);
                        __builtin_amdgcn_sched_barrier(0);
                        if (g + 2 < ng) peer3_rows(A, PV, ev, g + 2, lane);
                        if (g + 1 < ng) {
                            if (blk + PG * (g + 1) >= tend) { peer3_rowstore(PART, nbase + tcur, lane, acc); tcur = tnx; tend = __builtin_amdgcn_readlane(gstv, tcur + 1);
                                if (rnd > 0) { unpack_row(xn, acc); }
                                else {
#pragma unroll
                                    for (int i = 0; i < 16; ++i) acc[i] = (f2){0.f, 0.f}; }
                                tnx = peer3_next_nonempty(gstv, tcur + 1); if (rnd > 0 && tnx < 32) peer3_rowload(xn, PART, nbase + tnx, lane); }
                            peer3_axpy(B, acc, hwv, g + 1); }
                        __builtin_amdgcn_sched_barrier(0);
                    } }
                peer3_rowstore(PART, nbase + tcur, lane, acc);
            } }
        VM_WAIT();
    }
}
__device__ __forceinline__ void row_peer_reduce(const Params& P, unsigned char* ws, int l, int rowi, int lane, float* __restrict__ xout) {
    const size_t n = (size_t)rowi; const float* X1 = (const float*)(ws + WS_X1); const bf16* PART = (const bf16*)(ws + WS_PART);
    float acc[32];
#pragma unroll
    for (int j = 0; j < 2; ++j)
#pragma unroll
        for (int q = 0; q < 4; ++q) { const f4 a = *(const f4*)(X1 + n * D + 1024 * j + 16 * lane + 4 * q); acc[16 * j + 4 * q] = ALPHA * a.x; acc[16 * j + 4 * q + 1] = ALPHA * a.y; acc[16 * j + 4 * q + 2] = ALPHA * a.z; acc[16 * j + 4 * q + 3] = ALPHA * a.w; }
#pragma unroll 2
    for (int xb_ = 0; xb_ < 8; ++xb_) { const bf16* pp = PART + ((size_t)xb_ * NTOK + n) * D;
#pragma unroll
        for (int j = 0; j < 2; ++j) { const u4 a = *(const u4*)(pp + 1024 * j + 16 * lane), bq = *(const u4*)(pp + 1024 * j + 16 * lane + 8); float f[16]; unpack8(a, f); unpack8(bq, f + 8);
#pragma unroll
            for (int i = 0; i < 16; ++i) acc[16 * j + i] += f[i]; } }
    float s = 0.f;
#pragma unroll
    for (int i = 0; i < 32; ++i) s += acc[i];
    const float mu = wave_sum(s) * (1.f / D); float s2 = 0.f;
#pragma unroll
    for (int i = 0; i < 32; ++i) { acc[i] -= mu; s2 += acc[i] * acc[i]; }
    const float rstd = rsqrtf(wave_sum(s2) * (1.f / D) + LN_EPS);
    const float* gam = P.in[23] + (size_t)l * D; const float* bet = P.in[24] + (size_t)l * D;
    bf16* xb = (bf16*)(ws + WS_XB);
#pragma unroll
    for (int j = 0; j < 2; ++j) { const int col = 1024 * j + 16 * lane; float o[16];
#pragma unroll
        for (int q = 0; q < 4; ++q) { const f4 g4 = *(const f4*)(gam + col + 4 * q), b4 = *(const f4*)(bet + col + 4 * q);
            o[4 * q] = acc[16 * j + 4 * q] * rstd * g4.x + b4.x; o[4 * q + 1] = acc[16 * j + 4 * q + 1] * rstd * g4.y + b4.y; o[4 * q + 2] = acc[16 * j + 4 * q + 2] * rstd * g4.z + b4.z; o[4 * q + 3] = acc[16 * j + 4 * q + 3] * rstd * g4.w + b4.w;
            *(f4*)(xout + n * D + col + 4 * q) = mk_f4(o[4 * q], o[4 * q + 1], o[4 * q + 2], o[4 * q + 3]); }
        u4 p0, p1; p0.x = pk2(o[0], o[1]); p0.y = pk2(o[2], o[3]); p0.z = pk2(o[4], o[5]); p0.w = pk2(o[6], o[7]); p1.x = pk2(o[8], o[9]); p1.y = pk2(o[10], o[11]); p1.z = pk2(o[12], o[13]); p1.w = pk2(o[14], o[15]);
        *(u4*)(xb + n * D + col) = p0; *(u4*)(xb + n * D + col + 8) = p1; }
}

template <class T> __device__ __forceinline__ T* uniform_ptr(T* p) { const unsigned long long v = (unsigned long long)p; const unsigned lo = __builtin_amdgcn_readfirstlane((unsigned)v), hi = __builtin_amdgcn_readfirstlane((unsigned)(v >> 32)); return (T*)(__attribute__((address_space(1))) T*)(((unsigned long long)hi << 32) | lo); }
constexpr int PH_PER_LAYER = 10, N_PHASES = 1 + DEPTH * PH_PER_LAYER;
#ifndef ONLY_PHASE
#define ONLY_PHASE -1
#endif
#define EN(i) (ONLY_PHASE < 0 || ONLY_PHASE == (i))
__global__ void __launch_bounds__(512, 2) mk_fwd(Params P) {
    extern __shared__ __attribute__((aligned(16))) unsigned char lds_raw[];
    LAS unsigned char* lds = (LAS unsigned char*)lds_raw;
    volatile LAS unsigned* MISC = (volatile LAS unsigned*)(lds + MISC_OFF);
    const int tid = threadIdx.x, lane = tid & 63, wave = __builtin_amdgcn_readfirstlane(tid >> 6);
    const int G = gridDim.x, bid = blockIdx.x;
    if (tid < 64) MISC[tid] = 0u;
    __syncthreads();
    unsigned char* const ws = uniform_ptr(P.ws);
    unsigned* ctl = (unsigned*)(ws + WS_CTL);
    const XcdBarrier bar = xcd_barrier_post(ctl + CW_BAR, MISC + 8);
    const int lo = P.ph_lo, hi = P.ph_hi;
#define IN(k) (lo <= (k) && (k) < hi)
#define LAUNDER() int tl; asm volatile("v_mbcnt_lo_u32_b32 %0, -1, 0\n\tv_mbcnt_hi_u32_b32 %0, -1, %0" : "=v"(tl)); tl |= (wave << 6); const int ll = tl & 63; const int wl = __builtin_amdgcn_readfirstlane(tl >> 6); (void)ll; (void)wl
#define SEAM(k) do { if (IN((k) + 1)) xcd_barrier(bar); } while (0)
    if (IN(0) && EN(20)) { LAUNDER(); REP(20) phase_prologue(P, ws, lds, tl, ll, wl); SEAM(0); }
    for (int l = 0; l < DEPTH; ++l) {
        const int pb = 1 + l * PH_PER_LAYER;
        const float* xres = (l == 0) ? P.in[0] : (const float*)(ws + WS_XC);
        float* xout = (l == DEPTH - 1) ? P.out : (float*)(ws + WS_XC);
        if (IN(pb + 0) && EN(0)) { LAUNDER();
            pg8::Gemm g{(const pg8::bf16_t*)(ws + WS_XB), (const pg8::bf16_t*)(ws + WS_WIN) + (size_t)l * INWP * D, NTOK, INWP, D};
            pg8::StaticOrder S; S.init(NTOK, INWP, G, bid);
            pg8::EpiH E{(pg8::bf16_t*)(ws + WS_H), INWP, 6, 10};
            REP(0) pg8::gemm_phase<pg8::EpiH, pg8::StaticOrder, true, true>(lds, g, S, E, tl);
            SEAM(pb + 0);
        }
        if (IN(pb + 1) && EN(1)) { LAUNDER();
            REP(1) for (int u = bid; u < 240; u += G) unit_kvstate_mfma(P, ws, lds, u, tl);
            REP(13) for (int u = bid; u < 256; u += G) unit_sgu_mfma(P, ws, l, lds, u, tl, ll, wl);
            REP(12) for (int u = bid; u < 256; u += G) unit_compress_mfma(P, ws, l, lds, u, tl);
            SEAM(pb + 1);
        }
        if (IN(pb + 2) && EN(2)) { LAUNDER();
            REP(10) for (int u = bid; u < 256; u += G) unit_retention_mfma(P, ws, l, lds, u, tl);
            REP(11) for (int u = bid; u < 512; u += G) unit_nsa(P, ws, l, lds, u, tl);
            SEAM(pb + 2);
        }
        if (IN(pb + 3) && EN(3)) { LAUNDER();
            REP(3) for (int r = bid * 8 + wl; r < NTOK; r += G * 8) row_mixnorm(P, ws, l, r, ll);
            SEAM(pb + 3);
        }
        if (IN(pb + 4) && EN(4)) { LAUNDER();
            pg8::Gemm g{(const pg8::bf16_t*)(ws + WS_MIXED), (const pg8::bf16_t*)(ws + WS_WOUT) + (size_t)l * D * D, NTOK, D, D};
            pg8::StaticOrder S; S.init(NTOK, D, G, bid);
            pg8::EpiRes E{(float*)(ws + WS_Z), xres, D, ALPHA};
            REP(4) pg8::gemm_phase<pg8::EpiRes, pg8::StaticOrder, true, true>(lds, g, S, E, tl);
            SEAM(pb + 4);
        }
        if (IN(pb + 5) && EN(5)) { LAUNDER();
            REP(5) for (int r = bid * 8 + wl; r < NTOK; r += G * 8) row_ln((const float*)(ws + WS_Z), P.in[16] + (size_t)l * D, P.in[17] + (size_t)l * D, (float*)(ws + WS_X1), (bf16*)(ws + WS_X1B), (unsigned*)(ws + WS_X1Q), (float*)(ws + WS_XSC), r, ll);
            SEAM(pb + 5);
        }
        if (IN(pb + 6) && EN(6)) { LAUNDER();
            pg8::Gemm g{(const pg8::bf16_t*)(ws + WS_X1B), (const pg8::bf16_t*)(ws + WS_WQ) + (size_t)l * D * D, NTOK, D, D};
            pg8::StaticOrder S; S.init(NTOK, D, G, bid);
            pg8::EpiH E{(pg8::bf16_t*)(ws + WS_QP), D, 0, 0};
            pg8::gemm_phase<pg8::EpiH, pg8::StaticOrder, true, true>(lds, g, S, E, tl);
            SEAM(pb + 6);
        }
        if (IN(pb + 7) && EN(7)) { LAUNDER();
            REP(7) for (int u = bid; u < NTOK / 32; u += G) unit_peer(P, ws, l, lds, u, tl, ll, wl, xout);
            SEAM(pb + 7);
        }
        if (IN(pb + 8) && EN(8)) { LAUNDER();
            REP(8) phase_peer_bucket(P, ws, l, bid, G, ll, wl);
            SEAM(pb + 8);
        }
        if (IN(pb + 9) && EN(9)) { LAUNDER();
            REP(9) for (int r = bid * 8 + wl; r < NTOK; r += G * 8) row_peer_reduce(P, ws, l, r, ll, xout);
            SEAM(pb + 9);
        }
    }
#undef IN
#undef SEAM
}

#ifndef MK_ONE_LAUNCH
#define MK_ONE_LAUNCH 1
#endif
extern "C" void kernel_launch(void* const* d_in, const int* in_sizes, int n_in, void* d_out, int out_size, void* d_ws, size_t ws_size, hipStream_t stream) {
    static int grid = 0;
    if (grid == 0) {
        if (n_in != 25 || out_size != NTOK * D || ws_size < WS_END) { fprintf(stderr, "kernel_launch: unexpected shapes: n_in %d out %d ws %zu (need %zu)\n", n_in, out_size, ws_size, (size_t)WS_END); grid = -1; return; }
        int dev = 0, cus = 0, per_cu = 0;
        if (hipGetDevice(&dev) != hipSuccess || hipDeviceGetAttribute(&cus, hipDeviceAttributeMultiprocessorCount, dev) != hipSuccess) { grid = -1; return; }
        if (hipFuncSetAttribute((const void*)mk_fwd, hipFuncAttributeMaxDynamicSharedMemorySize, LDS_BYTES) != hipSuccess) { fprintf(stderr, "kernel_launch: hipFuncSetAttribute failed\n"); grid = -1; return; }
        if (hipOccupancyMaxActiveBlocksPerMultiprocessor(&per_cu, (const void*)mk_fwd, 512, LDS_BYTES) != hipSuccess || per_cu < 1) fprintf(stderr, "kernel_launch: occupancy query says %d\n", per_cu);
        (void)hipGetLastError();
        grid = cus;
    }
    if (grid < 0) return;
    (void)hipMemsetAsync((char*)d_ws + WS_CTL, 0, CTL_ZERO_BYTES, stream);
    Params p{};
    for (int i = 0; i < 25; ++i) p.in[i] = (const float*)d_in[i];
    p.out = (float*)d_out; p.ws = (unsigned char*)d_ws;
    for (int i = 0; i < 32; ++i) p.inv_rev[i] = pow(10000.0, -(double)i / 32.0) / (2.0 * 3.14159265358979323846);
    for (int h = 0; h < 4; ++h) p.lg2[h] = (float)log2(1.0 - pow(2.0, -5.0 - (double)h));
#if MK_ONE_LAUNCH
    p.ph_lo = 0; p.ph_hi = N_PHASES; p.use_bar = 1;
    hipLaunchKernelGGL(mk_fwd, dim3(grid), dim3(512), LDS_BYTES, stream, p);
#else
    for (int k = 0; k < N_PHASES; ++k) { p.ph_lo = k; p.ph_hi = k + 1; p.use_bar = 0;
        hipLaunchKernelGGL(mk_fwd, dim3(grid), dim3(512), LDS_BYTES, stream, p); }
#endif
}
```

```cpp
#include <hip/hip_runtime.h>
#include <cstdio>
#include <cstdint>
#include <cmath>
#define LAS __attribute__((address_space(3)))
namespace pg8 {
#define PG8_LAS __attribute__((address_space(3)))
typedef unsigned short bf16_t;
typedef short bf16x8 __attribute__((ext_vector_type(8)));
typedef float f32x4 __attribute__((ext_vector_type(4)));
typedef unsigned u32x4 __attribute__((ext_vector_type(4)));
constexpr int BM = 256, BK = 64, HALF = 128, HTB = HALF * BK * 2  , STAGE_BYTES = 8 * HTB, NXCD = 8, WGM = 8;

__host__ __device__ __forceinline__ int lds_byte(int r, int c) { const int st = (r >> 4) * 2 + (c >> 5), rr = r & 15, cc = c & 31, ob = rr * 64 + cc * 2; return st * 1024 + (ob ^ (((ob >> 9) & 1) << 5)); }
__host__ __device__ __forceinline__ void stage_rc(int b, int& R, int& C) { const int st = b / 1024, sb = b % 1024, swz = sb ^ (((sb >> 9) & 1) << 5); R = (st >> 1) * 16 + swz / 64; C = (st & 1) * 32 + (swz % 64) / 2; }
__host__ __device__ __forceinline__ int perm32(int rho) { const int n = rho >> 4, i = rho & 15; return 8 * (i >> 2) + 4 * n + (i & 3); }

struct Unit { int pm, pn; };
struct Gemm { const bf16_t* A; const bf16_t* Bt; int M, N, K; };

struct StaticOrder {
    int nM, nN, nwg, G, c;
    __host__ __device__ void init(int M, int N, int G_, int c_) { nM = M / BM; nN = N / BM; nwg = nM * nN; G = G_; c = c_; }
    __host__ __device__ bool next(int i, Unit& u) const {
        const long L = (long)i * G + c; if (L >= nwg) return false;
        int wgid = (int)L; { const int q = nwg / NXCD, r = nwg % NXCD, xcd = wgid % NXCD, off = wgid / NXCD; wgid = (xcd < r ? xcd * (q + 1) : r * (q + 1) + (xcd - r) * q) + off; }
        const int nig = WGM * nN, gid = wgid / nig, fm = gid * WGM, gsz = (nM - fm) < WGM ? (nM - fm) : WGM;
        u.pm = fm + ((wgid % nig) % gsz); u.pn = (wgid % nig) / gsz; return true;
    }
    __device__ __forceinline__ void a_ready(const Unit&) const {}
    __device__ __forceinline__ void done(const Unit&) const {}
};
__device__ __forceinline__ unsigned cvt_pk_bf16(float lo, float hi) { unsigned r; asm volatile("v_cvt_pk_bf16_f32 %0, %1, %2" : "=v"(r) : "v"(lo), "v"(hi)); return r; }
typedef float f32x2 __attribute__((ext_vector_type(2)));
__device__ __forceinline__ float gelu_tanh_f(float x) {
    const float u = 1.5957691216057308f * (x + 0.044715f * x * x * x);
    return x * __builtin_amdgcn_rcpf(1.0f + __expf(-u));
}
struct EpiH {
    static constexpr bool PERM = true, AFTER_DRAIN = false;
    bf16_t* O; int ldc; int act_lo, act_hi;
    __device__ __forceinline__ void operator()(const f32x4 (&acc)[2][2][4][2], const Unit& u, int wr, int wc, int fr, int fq) const {
        const int row0 = u.pm * BM + wr * 64 + fr; const int col0 = u.pn * BM + wc * 32 + 8 * fq;
        const bool act = (u.pn >= act_lo) && (u.pn < act_hi);
#pragma unroll
        for (int ai = 0; ai < 2; ++ai)
#pragma unroll
            for (int m = 0; m < 4; ++m) { bf16_t* rowp = O + (size_t)(row0 + ai * HALF + m * 16) * ldc + col0;
#pragma unroll
                for (int bj = 0; bj < 2; ++bj) { f32x4 v0 = acc[ai][bj][m][0], v1 = acc[ai][bj][m][1];
                    if (act) {
#pragma unroll
                        for (int j = 0; j < 4; ++j) { v0[j] = gelu_tanh_f(v0[j]); v1[j] = gelu_tanh_f(v1[j]); } }
                    u32x4 w; w.x = cvt_pk_bf16(v0[0], v0[1]); w.y = cvt_pk_bf16(v0[2], v0[3]); w.z = cvt_pk_bf16(v1[0], v1[1]); w.w = cvt_pk_bf16(v1[2], v1[3]);
                    *(u32x4*)(rowp + bj * HALF) = w; } }
    }
};
struct EpiRes {
    static constexpr bool PERM = false, AFTER_DRAIN = false;
    float* C; const float* X; int ldc; float alpha;
    __device__ __forceinline__ void operator()(const f32x4 (&acc)[2][2][4][2], const Unit& u, int wr, int wc, int fr, int fq) const {
        const int row0 = u.pm * BM + wr * 64 + fr, col0 = u.pn * BM + wc * 32 + 4 * fq;
#pragma unroll
        for (int ai = 0; ai < 2; ++ai)
#pragma unroll
            for (int m = 0; m < 4; ++m) { const size_t off = (size_t)(row0 + ai * HALF + m * 16) * ldc + col0;
#pragma unroll
                for (int bj = 0; bj < 2; ++bj)
#pragma unroll
                    for (int n = 0; n < 2; ++n) { const size_t o2 = off + bj * HALF + n * 16; const f32x4 xv = *(const f32x4*)(X + o2); *(f32x4*)(C + o2) = acc[ai][bj][m][n] + xv * alpha; } }
    }
};
struct EpiF32 {
    static constexpr bool PERM = false, AFTER_DRAIN = false;
    float* C; int ldc;
    __device__ __forceinline__ void operator()(const f32x4 (&acc)[2][2][4][2], const Unit& u, int wr, int wc, int fr, int fq) const {
        const int row0 = u.pm * BM + wr * 64 + fr, col0 = u.pn * BM + wc * 32 + 4 * fq;
#pragma unroll
        for (int ai = 0; ai < 2; ++ai)
#pragma unroll
            for (int m = 0; m < 4; ++m) { float* rowp = C + (size_t)(row0 + ai * HALF + m * 16) * ldc + col0;
#pragma unroll
                for (int bj = 0; bj < 2; ++bj)
#pragma unroll
                    for (int n = 0; n < 2; ++n) *(f32x4*)(rowp + bj * HALF + n * 16) = acc[ai][bj][m][n]; }
    }
};
template <class Epi, class Sched, bool ALIGN_EPI = false, bool SP2 = false>
__device__ __forceinline__ void gemm_phase(PG8_LAS unsigned char* lds, const Gemm g, const Sched& S, const Epi& E, const int tid) {
    const int wid = __builtin_amdgcn_readfirstlane(tid >> 6), lane = tid & 63, wr = wid >> 2, wc = wid & 3, fr = lane & 15, fq = lane >> 4;
    const int K = g.K, nt = K / BK;
    unsigned voffA[2], voffB[2];
#pragma unroll
    for (int i = 0; i < 2; ++i) { int R, C; stage_rc(tid * 16 + i * 8192, R, C); const int Rb = Epi::PERM ? ((R & ~31) + perm32(R & 31)) : R;
        voffA[i] = (unsigned)(R * K + C) * 2u; voffB[i] = (unsigned)(Rb * K + C) * 2u; }
    const size_t kstep = (size_t)(BK * 2);
    const size_t hstep = (size_t)HALF * K * 2;
    const size_t tstep = 2 * hstep;
    const unsigned ldsw = (unsigned)wid * 1024u;
    const int aoff = lds_byte(wr * 64 + fr, fq * 8), boff = lds_byte(wc * 32 + fr, fq * 8);
#define PG8_SA(b, h) (((b) * 2 + (h)) * HTB)
#define PG8_SB(b, h) ((4 + (b) * 2 + (h)) * HTB)
#define PG8_STAGE(bufoff, gbase, voff) do { _Pragma("unroll") for (int _i = 0; _i < 2; ++_i) \
        __builtin_amdgcn_global_load_lds((const unsigned*)((const char*)(gbase) + (voff)[_i]), (PG8_LAS unsigned*)(lds + (bufoff) + ldsw + _i * 8192), 16, 0, 0); } while (0)
#define PG8_LDA(dst, b, h) do { _Pragma("unroll") for (int m = 0; m < 4; ++m) _Pragma("unroll") for (int k = 0; k < 2; ++k) dst[m][k] = *(const PG8_LAS bf16x8*)(lds + PG8_SA(b, h) + aoff + m * 2048 + k * 1024); } while (0)
#define PG8_LDB(dst, b, h) do { _Pragma("unroll") for (int n = 0; n < 2; ++n) _Pragma("unroll") for (int k = 0; k < 2; ++k) dst[n][k] = *(const PG8_LAS bf16x8*)(lds + PG8_SB(b, h) + boff + n * 2048 + k * 1024); } while (0)
#define PG8_MMA(ai, bj, At, Bt) do { __builtin_amdgcn_s_setprio(1); _Pragma("unroll") for (int m = 0; m < 4; ++m) _Pragma("unroll") for (int n = 0; n < 2; ++n) _Pragma("unroll") for (int k = 0; k < 2; ++k) \
        acc[ai][bj][m][n] = __builtin_amdgcn_mfma_f32_16x16x32_bf16(Bt[n][k], At[m][k], acc[ai][bj][m][n], 0, 0, 0); __builtin_amdgcn_s_setprio(0); } while (0)
#define PG8_WAIT_V(n) asm volatile("s_waitcnt vmcnt(" #n ")" ::: "memory")
#define PG8_WAIT_L(n) asm volatile("s_waitcnt lgkmcnt(" #n ")" ::: "memory")
#define PG8_BAR __builtin_amdgcn_s_barrier()
#define PG8_SCHED __builtin_amdgcn_sched_barrier(0)
    Unit cur, nxt; int ui = 0;
    if (!S.next(0, cur)) return;
    f32x4 acc[2][2][4][2];
#pragma unroll
    for (int a = 0; a < 2; ++a)
#pragma unroll
        for (int b = 0; b < 2; ++b)
#pragma unroll
            for (int m = 0; m < 4; ++m)
#pragma unroll
                for (int n = 0; n < 2; ++n) acc[a][b][m][n] = (f32x4){0.f, 0.f, 0.f, 0.f};
    bf16x8 At[4][2], B0[2][2], B1[2][2];
    const char* cA = (const char*)g.A + (size_t)cur.pm * tstep; const char* cB = (const char*)g.Bt + (size_t)cur.pn * tstep;
    S.a_ready(cur);
    if constexpr (SP2) {
        PG8_STAGE(PG8_SB(0, 0), cB, voffB); PG8_STAGE(PG8_SB(0, 1), cB + hstep, voffB); PG8_STAGE(PG8_SA(0, 0), cA, voffA); PG8_STAGE(PG8_SA(0, 1), cA + hstep, voffA);
        if (wr == 1) PG8_BAR;
        PG8_WAIT_V(2); PG8_BAR;
        PG8_STAGE(PG8_SB(1, 0), cB + kstep, voffB); PG8_STAGE(PG8_SA(1, 0), cA + kstep, voffA); PG8_STAGE(PG8_SB(1, 1), cB + hstep + kstep, voffB);
        PG8_WAIT_V(6); PG8_BAR;
    } else {
        PG8_STAGE(PG8_SB(0, 0), cB, voffB); PG8_STAGE(PG8_SA(0, 0), cA, voffA); PG8_STAGE(PG8_SB(0, 1), cB + hstep, voffB); PG8_STAGE(PG8_SA(0, 1), cA + hstep, voffA);
        if (wr == 1) PG8_BAR;
        PG8_WAIT_V(4); PG8_BAR;
        PG8_STAGE(PG8_SB(1, 0), cB + kstep, voffB); PG8_STAGE(PG8_SA(1, 0), cA + kstep, voffA); PG8_STAGE(PG8_SB(1, 1), cB + hstep + kstep, voffB);
        PG8_WAIT_V(6); PG8_BAR;
    }
    for (;;) {
        const bool has_next = S.next(ui + 1, nxt);
        const char* nA = has_next ? (const char*)g.A + (size_t)nxt.pm * tstep : cA; const char* nB = has_next ? (const char*)g.Bt + (size_t)nxt.pn * tstep : cB;
        for (int t = 0; t < nt; t += 2) {
            const bool last = (t == nt - 2);
            const char* a1 = cA + (size_t)(t + 1) * kstep;
            const char* a2 = last ? nA : cA + (size_t)(t + 2) * kstep; const char* b2 = last ? nB : cB + (size_t)(t + 2) * kstep;
            const char* a3 = a2 + kstep; const char* b3 = b2 + kstep;
            if (last && has_next) S.a_ready(nxt);
            if constexpr (SP2) {
            PG8_LDB(B0, 0, 0); PG8_LDB(B1, 0, 1); PG8_SCHED; PG8_LDA(At, 0, 0); PG8_STAGE(PG8_SA(1, 1), a1 + hstep, voffA);
            PG8_WAIT_V(8); PG8_WAIT_L(0); PG8_BAR; PG8_MMA(0, 0, At, B0); PG8_MMA(0, 1, At, B1); PG8_BAR; PG8_SCHED;
            PG8_LDA(At, 0, 1); PG8_STAGE(PG8_SB(0, 0), b2, voffB); PG8_STAGE(PG8_SB(0, 1), b2 + hstep, voffB); PG8_STAGE(PG8_SA(0, 0), a2, voffA);
            PG8_WAIT_V(8); PG8_WAIT_L(0); PG8_BAR; PG8_MMA(1, 0, At, B0); PG8_MMA(1, 1, At, B1); PG8_BAR; PG8_SCHED;
            PG8_LDB(B0, 1, 0); PG8_LDB(B1, 1, 1); PG8_SCHED; PG8_LDA(At, 1, 0); PG8_STAGE(PG8_SA(0, 1), a2 + hstep, voffA);
            PG8_WAIT_V(8); PG8_WAIT_L(0); PG8_BAR; PG8_MMA(0, 0, At, B0); PG8_MMA(0, 1, At, B1); PG8_BAR; PG8_SCHED;
            PG8_LDA(At, 1, 1); PG8_STAGE(PG8_SB(1, 0), b3, voffB); PG8_STAGE(PG8_SB(1, 1), b3 + hstep, voffB); PG8_STAGE(PG8_SA(1, 0), a3, voffA);
            PG8_WAIT_V(8); PG8_WAIT_L(0); PG8_BAR; PG8_MMA(1, 0, At, B0); PG8_MMA(1, 1, At, B1); PG8_BAR; PG8_SCHED;
            } else {
            PG8_LDB(B0, 0, 0); PG8_SCHED; PG8_LDA(At, 0, 0); PG8_STAGE(PG8_SA(1, 1), a1 + hstep, voffA);
            PG8_WAIT_L(8); PG8_BAR; PG8_WAIT_L(0); PG8_MMA(0, 0, At, B0); PG8_BAR; PG8_SCHED;
            PG8_LDB(B1, 0, 1); PG8_STAGE(PG8_SB(0, 0), b2, voffB);
            PG8_BAR; PG8_WAIT_L(0); PG8_MMA(0, 1, At, B1); PG8_BAR;
            PG8_LDA(At, 0, 1); PG8_STAGE(PG8_SA(0, 0), a2, voffA);
            PG8_BAR; PG8_WAIT_L(0); PG8_MMA(1, 0, At, B0); PG8_BAR; PG8_SCHED;
            PG8_STAGE(PG8_SB(0, 1), b2 + hstep, voffB);
            PG8_WAIT_V(6); PG8_BAR; PG8_MMA(1, 1, At, B1); PG8_BAR;
            PG8_LDB(B0, 1, 0); PG8_SCHED; PG8_LDA(At, 1, 0); PG8_STAGE(PG8_SA(0, 1), a2 + hstep, voffA);
            PG8_WAIT_L(8); PG8_BAR; PG8_WAIT_L(0); PG8_MMA(0, 0, At, B0); PG8_BAR; PG8_SCHED;
            PG8_LDB(B1, 1, 1); PG8_STAGE(PG8_SB(1, 0), b3, voffB);
            PG8_BAR; PG8_WAIT_L(0); PG8_MMA(0, 1, At, B1); PG8_BAR;
            PG8_LDA(At, 1, 1); PG8_STAGE(PG8_SA(1, 0), a3, voffA);
            PG8_BAR; PG8_WAIT_L(0); PG8_MMA(1, 0, At, B0); PG8_BAR; PG8_SCHED;
            PG8_STAGE(PG8_SB(1, 1), b3 + hstep, voffB);
            PG8_WAIT_V(6); PG8_BAR; PG8_MMA(1, 1, At, B1); PG8_BAR;
            }
        }
        if constexpr (ALIGN_EPI) { if (wr == 0) PG8_BAR; }
        if constexpr (!Epi::AFTER_DRAIN) { E(acc, cur, wr, wc, fr, fq); S.done(cur); }
        if (!has_next) break;
#pragma unroll
        for (int a = 0; a < 2; ++a)
#pragma unroll
            for (int b = 0; b < 2; ++b)
#pragma unroll
                for (int m = 0; m < 4; ++m)
#pragma unroll
                    for (int n = 0; n < 2; ++n) acc[a][b][m][n] = (f32x4){0.f, 0.f, 0.f, 0.f};
        cur = nxt; cA = nA; cB = nB; ++ui;
        if constexpr (ALIGN_EPI) { if (wr == 1) PG8_BAR; }
    }
    PG8_WAIT_V(0);
    if constexpr (!ALIGN_EPI) { if (wr == 0) PG8_BAR; }
    PG8_BAR;
    if constexpr (Epi::AFTER_DRAIN) { E.fused(acc, cur, wr, wc, fr, fq, lds, wid, lane); S.done(cur); }
#undef PG8_SA
#undef PG8_SB
#undef PG8_STAGE
#undef PG8_LDA
#undef PG8_LDB
#undef PG8_MMA
#undef PG8_WAIT_V
#undef PG8_WAIT_L
#undef PG8_BAR
#undef PG8_SCHED
}
}
#define XB_TMO      128
#define XB_XCNT(j)  (256  + 64 * (j))
#define XB_XSUB(j)  (1280 + 64 * (j))
#define XB_XGEN(j)  (2304 + 64 * (j))
#define XB_TOP      3328
#define XB_TOPGEN   3392
#define XCD_BAR_WORDS 3456
#define XB_SPIN_CAP (1u << 18)

__device__ __forceinline__ unsigned xb_ld(unsigned* p)              { return __hip_atomic_load(p, __ATOMIC_RELAXED, __HIP_MEMORY_SCOPE_AGENT); }
__device__ __forceinline__ unsigned xb_add(unsigned* p, unsigned v) { return __hip_atomic_fetch_add(p, v, __ATOMIC_RELAXED, __HIP_MEMORY_SCOPE_AGENT); }
__device__ __forceinline__ unsigned xb_xcc_id() { return (unsigned)__builtin_amdgcn_s_getreg((3 << 11) | 20) & 0xFu; }
#define XB_SPIN(cond, bar) do { unsigned _sp = 0; while (cond) { __builtin_amdgcn_s_sleep(1); \
    if ((++_sp & 255u) == 0u) { if (xb_ld(&(bar)[XB_TMO])) break; if (_sp > XB_SPIN_CAP) { atomicAdd(&(bar)[XB_TMO], 1u); break; } } } } while (0)

struct XcdBarrier {
    unsigned* bar; unsigned x; unsigned w0;
    volatile LAS unsigned* st;
};

__device__ __forceinline__ bool xb_tid0(unsigned w0) { return w0 != 0u && __builtin_amdgcn_mbcnt_hi(0xffffffffu, __builtin_amdgcn_mbcnt_lo(0xffffffffu, 0u)) == 0u; }
__device__ __forceinline__ XcdBarrier xcd_barrier_post(unsigned* bar, volatile LAS unsigned* st) {
    XcdBarrier b; b.bar = bar; b.x = xb_xcc_id(); b.st = st; b.w0 = (__builtin_amdgcn_readfirstlane(threadIdx.x >> 6) == 0) ? 1u : 0u;
    if (threadIdx.x == 0) (void)xb_add(&bar[XB_XCNT(b.x)], 1u);
    return b;
}
__device__ __forceinline__ void xcd_barrier_complete(unsigned* bar, unsigned x, unsigned& nloc, unsigned& nx) {
    const unsigned G = gridDim.x * gridDim.y * gridDim.z;
    unsigned sum, cnt, mine, sp = 0u;
    for (;;) {
        sum = 0u; cnt = 0u; mine = 0u;
#pragma unroll
        for (unsigned j = 0; j < 16; ++j) { const unsigned c = xb_ld(&bar[XB_XCNT(j)]); sum += c; cnt += (c > 0u) ? 1u : 0u; mine = (j == x) ? c : mine; }
        if (sum == G) break;
        __builtin_amdgcn_s_sleep(1);
        if ((++sp & 255u) == 0u) { if (xb_ld(&bar[XB_TMO])) break; if (sp > XB_SPIN_CAP) { atomicAdd(&bar[XB_TMO], 1u); break; } }
    }
    nloc = mine > 0u ? mine : 1u; nx = cnt > 0u ? cnt : 1u;
}

__device__ __forceinline__ void xcd_barrier(const XcdBarrier& b) {
    asm volatile("s_waitcnt vmcnt(0)" ::: "memory");
    __syncthreads();
    if (xb_tid0(b.w0)) {
        unsigned* bar = b.bar;
        __builtin_amdgcn_s_waitcnt(0);
        unsigned nloc = b.st[0], nx = b.st[1];
        if (nloc == 0u) { xcd_barrier_complete(bar, b.x, nloc, nx); b.st[0] = nloc; b.st[1] = nx; }
        const unsigned old = xb_add(&bar[XB_XSUB(b.x)], 1u);
        const unsigned gen = old / nloc;
        if (old + 1u == (gen + 1u) * nloc) {
            __builtin_amdgcn_fence(__ATOMIC_RELEASE, "agent");
            asm volatile("s_waitcnt vmcnt(0)" ::: "memory");
            const unsigned og = xb_add(&bar[XB_TOP], 1u);
            const unsigned tg = og / nx;
            if (og + 1u == (tg + 1u) * nx) xb_add(&bar[XB_TOPGEN], 1u);
            else XB_SPIN(xb_ld(&bar[XB_TOPGEN]) == tg, bar);
            __builtin_amdgcn_fence(__ATOMIC_ACQUIRE, "agent");
            xb_add(&bar[XB_XGEN(b.x)], 1u);
            asm volatile("s_waitcnt vmcnt(0)" ::: "memory");
        } else {
            XB_SPIN(xb_ld(&bar[XB_XGEN(b.x)]) == gen, bar);
            __builtin_amdgcn_fence(__ATOMIC_ACQUIRE, "agent");
            asm volatile("s_waitcnt vmcnt(0)" ::: "memory");
        }
    }
    __syncthreads();
}

#ifndef PROBE_DUP
#define PROBE_DUP -1
#endif
#define REP(i) for (int rep_ = 0; rep_ < ((PROBE_DUP == (i)) ? 2 : 1); ++rep_)
constexpr int NB = 4, T = 2048, D = 2048, NTOK = NB * T, DEPTH = 4;
constexpr int INW = 5168, INWP = 5376;
constexpr int C_RQ = 0, C_RK = 256, C_RV = 512, C_RG = 1024, C_SU = 1536, C_SV = 2048, C_NQ = 2560, C_KC = 3584, C_VC = 3840, C_KS = 4096, C_VS = 4352, C_KW = 4608, C_VW = 4864, C_NG = 5120;
constexpr float ALPHA = 1.6817928305074290f;
constexpr float LN_EPS = 1e-5f;
constexpr float LOG2E = 1.4426950408889634f;

constexpr size_t MiB = (size_t)1 << 20;
constexpr size_t WS_CTL = 0, CTL_ZERO_BYTES = 1 * MiB;
constexpr size_t WS_ROPE = 1 * MiB;
constexpr size_t WS_WIN = 2 * MiB;
constexpr size_t WS_WOUT = 86 * MiB;
constexpr size_t WS_WQ = 118 * MiB;
constexpr size_t WS_PU = 160 * MiB;
constexpr size_t WS_PV = 416 * MiB;
constexpr size_t WS_H = 672 * MiB;
constexpr size_t WS_YMIX = 756 * MiB;
constexpr size_t WS_MIXED = 820 * MiB;
constexpr size_t WS_Z = 852 * MiB;
constexpr size_t WS_X1 = 916 * MiB;
constexpr size_t WS_X1B = 980 * MiB;
constexpr size_t WS_QP = 1012 * MiB;
constexpr size_t WS_XC = 1076 * MiB;
constexpr size_t WS_XB = 1140 * MiB;
constexpr size_t WS_KC = 1172 * MiB;
constexpr size_t WS_KVST = 1174 * MiB;
constexpr size_t WS_SC = 1184 * MiB;
constexpr size_t WS_PSC = 1248 * MiB;
constexpr size_t WS_W1T = 1250 * MiB;
constexpr size_t WS_W2T = 1258 * MiB;
constexpr size_t WS_PKB = 1260 * MiB;
#ifndef PEER_NBKT
#define PEER_NBKT 8
#endif
#ifndef PEER_PG
#define PEER_PG 4
#endif
constexpr int PG = PEER_PG;
constexpr int NBKT = PEER_NBKT, NRND = NBKT / 8, FCAP = 4096, BSH = (NBKT == 16) ? 10 : 11;
constexpr size_t WS_FE = 1262 * MiB;
constexpr size_t WS_FW = 1326 * MiB;
constexpr size_t WS_FHW = 1390 * MiB;
constexpr size_t WS_GST = 1454 * MiB;
constexpr size_t WS_PART = 1456 * MiB;
constexpr size_t WS_PSCL = 1600 * MiB;
constexpr size_t WS_X1Q = 1712 * MiB;
constexpr size_t WS_XSC = 1728 * MiB;
constexpr size_t WS_END = 1730 * MiB;
constexpr int CW_BAR = 4096;

constexpr int LDS_BYTES = 147456;
constexpr int MISC_OFF = 143360;

#define GAS __attribute__((address_space(1)))
typedef float f4 __attribute__((ext_vector_type(4)));
typedef float f2 __attribute__((ext_vector_type(2)));
typedef unsigned u4 __attribute__((ext_vector_type(4)));
typedef unsigned u2 __attribute__((ext_vector_type(2)));
__device__ __forceinline__ f4 mk_f4(float a, float b, float c, float d) { f4 r; r.x = a; r.y = b; r.z = c; r.w = d; return r; }
__device__ __forceinline__ f2 mk_f2(float a, float b) { f2 r; r.x = a; r.y = b; return r; }
__device__ __forceinline__ u2 mk_u2(unsigned a, unsigned b) { u2 r; r.x = a; r.y = b; return r; }
typedef unsigned short bf16;
#define LDS_WAIT() asm volatile("s_waitcnt lgkmcnt(0)" ::: "memory")
#define VM_WAIT() asm volatile("s_waitcnt vmcnt(0)" ::: "memory")

struct Params {
    const float* in[25];
    float* out;
    unsigned char* ws;
    double inv_rev[32];
    float lg2[4];
    int ph_lo, ph_hi, use_bar, pad0;
};

__device__ __forceinline__ float bf2f(unsigned short b) { return __uint_as_float(((unsigned)b) << 16); }
__device__ __forceinline__ unsigned f2bf(float f) { unsigned u = __float_as_uint(f); return (u + 0x7fffu + ((u >> 16) & 1u)) >> 16; }
__device__ __forceinline__ unsigned pk2(float lo, float hi) { return f2bf(lo) | (f2bf(hi) << 16); }
__device__ __forceinline__ float wave_sum(float v) {
#pragma unroll
    for (int o = 1; o < 64; o <<= 1) v += __shfl_xor(v, o);
    return v;
}
__device__ __forceinline__ void unpack8(const u4& v, float* f) {
    f[0] = __uint_as_float(v.x << 16); f[1] = __uint_as_float(v.x & 0xffff0000u);
    f[2] = __uint_as_float(v.y << 16); f[3] = __uint_as_float(v.y & 0xffff0000u);
    f[4] = __uint_as_float(v.z << 16); f[5] = __uint_as_float(v.z & 0xffff0000u);
    f[6] = __uint_as_float(v.w << 16); f[7] = __uint_as_float(v.w & 0xffff0000u);
}
__device__ __forceinline__ float gelu_tanh(float x) { return pg8::gelu_tanh_f(x); }

__device__ __forceinline__ void transpose_tile(const float* __restrict__ W, int K, int N, bf16* __restrict__ WT, LAS float* scr, int kb, int nb, int lane) {
    const int k0 = kb * 64, n0 = nb * 32, rsub = lane >> 3, c4 = (lane & 7) * 4; const bool ok = (n0 + c4) < N;
    f4 v[8];
#pragma unroll
    for (int i = 0; i < 8; ++i) v[i] = ok ? *(const f4*)(W + (size_t)(k0 + 8 * i + rsub) * N + n0 + c4) : mk_f4(0.f, 0.f, 0.f, 0.f);
#pragma unroll
    for (int i = 0; i < 8; ++i) { LAS float* d = scr + (8 * i + rsub) * 33 + c4; d[0] = v[i].x; d[1] = v[i].y; d[2] = v[i].z; d[3] = v[i].w; }
    LDS_WAIT();
    const int c = lane & 7;
#pragma unroll
    for (int j = 0; j < 4; ++j) { const int n = (lane >> 3) + 8 * j; const LAS float* s = scr + (8 * c) * 33 + n;
        u4 o; o.x = pk2(s[0 * 33], s[1 * 33]); o.y = pk2(s[2 * 33], s[3 * 33]); o.z = pk2(s[4 * 33], s[5 * 33]); o.w = pk2(s[6 * 33], s[7 * 33]);
        *(u4*)(WT + (size_t)(n0 + n) * K + k0 + 8 * c) = o; }
    LDS_WAIT();
}
__device__ __forceinline__ void cvt_bf16_stream(const float* __restrict__ src, bf16* __restrict__ dst, size_t nchunks, size_t gt, size_t GT) {
    for (size_t c = gt; c < nchunks; c += GT) { const f4 a = ((const f4*)src)[2 * c], b = ((const f4*)src)[2 * c + 1];
        u4 o; o.x = pk2(a.x, a.y); o.y = pk2(a.z, a.w); o.z = pk2(b.x, b.y); o.w = pk2(b.z, b.w); ((u4*)dst)[c] = o; }
}
__device__ __forceinline__ void phase_prologue(const Params& P, unsigned char* ws, LAS unsigned char* lds, int tid, int lane, int wave) {
    LAS float* scr = (LAS float*)(lds + wave * 8704);
    const int gw = blockIdx.x * 8 + wave, NGW = gridDim.x * 8;
    constexpr int I_IN = 32 * 168, I_SQ = 32 * 64, I_L = I_IN + 2 * I_SQ;
    REP(21) for (int it = gw; it < DEPTH * I_L; it += NGW) {
        const int l = it / I_L; int r = it % I_L;
        if (r < I_IN) transpose_tile(P.in[1] + (size_t)l * D * INW, D, INW, (bf16*)(ws + WS_WIN) + (size_t)l * INWP * D, scr, r / 168, r % 168, lane);
        else { r -= I_IN;
            if (r < I_SQ) transpose_tile(P.in[15] + (size_t)l * D * D, D, D, (bf16*)(ws + WS_WOUT) + (size_t)l * D * D, scr, r / 64, r % 64, lane);
            else { r -= I_SQ; transpose_tile(P.in[18] + (size_t)l * D * D, D, D, (bf16*)(ws + WS_WQ) + (size_t)l * D * D, scr, r / 64, r % 64, lane); } }
    }
    for (int it = gw; it < DEPTH * 2 * (32 * 8 + 4 * 2); it += NGW) {
        const int lk = it / 264, r = it % 264, l = lk >> 1, kv = lk & 1;
        if (r < 256) transpose_tile(P.in[kv ? 12 : 9] + (size_t)l * 2048 * 256, 2048, 256, (bf16*)(ws + WS_W1T) + (size_t)lk * 256 * 2048, scr, r >> 3, r & 7, lane);
        else transpose_tile(P.in[kv ? 13 : 10] + (size_t)l * 256 * 64, 256, 64, (bf16*)(ws + WS_W2T) + (size_t)lk * 64 * 256, scr, (r - 256) >> 1, (r - 256) & 1, lane);
    }
    const size_t gt = (size_t)blockIdx.x * 512 + tid, GT = (size_t)gridDim.x * 512;
    REP(22) for (int row = gw; row < 2 * DEPTH * 16384; row += NGW) {
        const int tab = row / (DEPTH * 16384), rr = row % (DEPTH * 16384);
        const float* src = P.in[21 + tab] + (size_t)rr * 2048;
        f4 v[8]; float am = 0.f;
#pragma unroll
        for (int j = 0; j < 2; ++j)
#pragma unroll
            for (int q = 0; q < 4; ++q) { const f4 a = *(const f4*)(src + 1024 * j + 16 * lane + 4 * q); v[4 * j + q] = a; am = fmaxf(am, fmaxf(fmaxf(fabsf(a.x), fabsf(a.y)), fmaxf(fabsf(a.z), fabsf(a.w)))); }
#pragma unroll
        for (int o = 1; o < 64; o <<= 1) am = fmaxf(am, __shfl_xor(am, o));
        unsigned char* dst = ws + (tab ? WS_PV : WS_PU) + (size_t)rr * 2048;
        if (tab) {
            const float sc = (am > 0.f) ? 448.f / am : 1.f;
            if (lane == 0) ((float*)(ws + WS_PSC))[row] = (am > 0.f) ? am * (1.f / 448.f) : 1.f;
#pragma unroll
            for (int j = 0; j < 2; ++j) { u4 w;
#pragma unroll
                for (int q = 0; q < 4; ++q) { const f4 a = v[4 * j + q]; int r = __builtin_amdgcn_cvt_pk_fp8_f32(a.x * sc, a.y * sc, 0, false); r = __builtin_amdgcn_cvt_pk_fp8_f32(a.z * sc, a.w * sc, r, true); w[q] = (unsigned)r; }
                *(u4*)(dst + 1024 * j + 16 * lane) = w; }
        } else {
            const float sc = (am > 0.f) ? 127.f / am : 1.f;
            if (lane == 0) ((float*)(ws + WS_PSC))[row] = (am > 0.f) ? am * (1.f / 127.f) : 1.f;
#pragma unroll
            for (int j = 0; j < 2; ++j) { u4 w;
#pragma unroll
                for (int q = 0; q < 4; ++q) { const f4 a = v[4 * j + q];
                    const int b0 = (int)rintf(a.x * sc), b1 = (int)rintf(a.y * sc), b2 = (int)rintf(a.z * sc), b3 = (int)rintf(a.w * sc);
                    w[q] = (unsigned)(b0 & 0xff) | ((unsigned)(b1 & 0xff) << 8) | ((unsigned)(b2 & 0xff) << 16) | ((unsigned)b3 << 24); }
                *(u4*)(dst + 1024 * j + 16 * lane) = w; }
        }
    }
    cvt_bf16_stream(P.in[0], (bf16*)(ws + WS_XB), (size_t)NTOK * D / 8, gt, GT);
    cvt_bf16_stream(P.in[19], (bf16*)(ws + WS_PKB), (size_t)DEPTH * 8 * 128 * 128 / 8, gt, GT);
    cvt_bf16_stream(P.in[20], (bf16*)(ws + WS_PKB) + (size_t)DEPTH * 8 * 128 * 128, (size_t)DEPTH * 8 * 128 * 128 / 8, gt, GT);
    f2* rope = (f2*)(ws + WS_ROPE);
    for (size_t idx = gt; idx < (size_t)T * 32; idx += GT) { const int t = (int)(idx >> 5), i = (int)(idx & 31);
        double a = (double)t * P.inv_rev[i]; a -= floor(a); const float fr = (float)a;
        rope[idx] = mk_f2(__builtin_amdgcn_cosf(fr), __builtin_amdgcn_sinf(fr)); }
}

__device__ __forceinline__ void stage_rot_k(const bf16* __restrict__ Hb, const f2* __restrict__ rope, LAS float* ks, int tok0, int tpos0, int colK, float lg2h, bool zeta, int tid) {
    const int m = tid >> 2, p = tid & 3;
    const bf16* src = Hb + (size_t)(tok0 + m) * INWP + colK + p * 8;
    const u4 a = *(const u4*)src, b = *(const u4*)(src + 32);
    float x1[8], x2[8]; unpack8(a, x1); unpack8(b, x2);
    const f4* rp = (const f4*)(rope + (size_t)(tpos0 + m) * 32 + p * 8);
    const f4 r0 = rp[0], r1 = rp[1], r2 = rp[2], r3 = rp[3];
    const float cs[8] = {r0.x, r0.z, r1.x, r1.z, r2.x, r2.z, r3.x, r3.z}, sn[8] = {r0.y, r0.w, r1.y, r1.w, r2.y, r2.w, r3.y, r3.w};
    const float sc = 0.125f * (zeta ? exp2f(lg2h * (float)(127 - m)) : 1.0f);
    float o1[8], o2[8];
#pragma unroll
    for (int i = 0; i < 8; ++i) { o1[i] = (x1[i] * cs[i] - x2[i] * sn[i]) * sc; o2[i] = (x1[i] * sn[i] + x2[i] * cs[i]) * sc; }
    LAS f4* d1 = (LAS f4*)(ks + m * 64 + p * 8); LAS f4* d2 = (LAS f4*)(ks + m * 64 + 32 + p * 8);
    d1[0] = mk_f4(o1[0], o1[1], o1[2], o1[3]); d1[1] = mk_f4(o1[4], o1[5], o1[6], o1[7]);
    d2[0] = mk_f4(o2[0], o2[1], o2[2], o2[3]); d2[1] = mk_f4(o2[4], o2[5], o2[6], o2[7]);
}
__device__ __forceinline__ void stage_v128(const bf16* __restrict__ Hb, LAS float* vs, int tok0, int colV, int tid) {
    const int m = tid >> 2, p = tid & 3;
    const u4* src = (const u4*)(Hb + (size_t)(tok0 + m) * INWP + colV + p * 32);
    LAS f4* dst = (LAS f4*)(vs + m * 128 + p * 32);
#pragma unroll
    for (int j = 0; j < 4; ++j) { const u4 a = src[j]; float f[8]; unpack8(a, f); dst[2 * j] = mk_f4(f[0], f[1], f[2], f[3]); dst[2 * j + 1] = mk_f4(f[4], f[5], f[6], f[7]); }
}

__device__ __forceinline__ void unit_kvstate(const Params& P, unsigned char* ws, LAS unsigned char* lds, int u, int tid) {
    const int b = u / 60, r = u % 60, h = r / 15, j = r % 15;
    const bf16* Hb = (const bf16*)(ws + WS_H); const f2* rope = (const f2*)(ws + WS_ROPE);
    LAS float* ks = (LAS float*)lds; LAS float* vs = (LAS float*)(lds + 32768);
    const int tok0 = b * T + j * 128;
    stage_rot_k(Hb, rope, ks, tok0, j * 128, C_RK + h * 64, P.lg2[h], true, tid);
    stage_v128(Hb, vs, tok0, C_RV + h * 128, tid);
    __syncthreads();
    const int d = tid >> 3, e0 = (tid & 7) * 16;
    float acc[16];
#pragma unroll
    for (int i = 0; i < 16; ++i) acc[i] = 0.f;
    #pragma unroll 1
    for (int m = 0; m < 128; ++m) { const float kd = ks[m * 64 + d]; const LAS f4* vp = (const LAS f4*)(vs + m * 128 + e0);
#pragma unroll
        for (int q = 0; q < 4; ++q) { const f4 v = vp[q]; acc[4 * q] += kd * v.x; acc[4 * q + 1] += kd * v.y; acc[4 * q + 2] += kd * v.z; acc[4 * q + 3] += kd * v.w; } }
    f4* dst = (f4*)((float*)(ws + WS_KVST) + ((size_t)((b * 4 + h) * 16 + j) * 64 + d) * 128 + e0);
#pragma unroll
    for (int q = 0; q < 4; ++q) dst[q] = mk_f4(acc[4 * q], acc[4 * q + 1], acc[4 * q + 2], acc[4 * q + 3]);
    __syncthreads();
}

__device__ __forceinline__ void unit_sgu(const Params& P, unsigned char* ws, int l, LAS unsigned char* lds, int u, int tid, int lane, int wave) {
    const int b = u >> 6, c = (u >> 2) & 15, g = u & 3;
    const bf16* Hb = (const bf16*)(ws + WS_H);
    LAS float* vn = (LAS float*)lds;
    LAS float* wsm = (LAS float*)(lds + 65536);
    const int tok0 = b * T + c * 128;
    const float* lng = P.in[4] + l * 512 + g * 128; const float* lnb = P.in[5] + l * 512 + g * 128;
    const float g0 = lng[2 * lane], g1 = lng[2 * lane + 1], b0 = lnb[2 * lane], b1 = lnb[2 * lane + 1];
    for (int i = 0; i < 16; ++i) { const int s = wave * 16 + i;
        const unsigned pr = *(const unsigned*)(Hb + (size_t)(tok0 + s) * INWP + C_SV + g * 128 + 2 * lane);
        const float v0 = __uint_as_float(pr << 16), v1 = __uint_as_float(pr & 0xffff0000u);
        const float mu = wave_sum(v0 + v1) * (1.f / 128.f); const float d0 = v0 - mu, d1 = v1 - mu;
        const float var = wave_sum(d0 * d0 + d1 * d1) * (1.f / 128.f); const float rstd = rsqrtf(var + LN_EPS);
        *(LAS f2*)(vn + s * 128 + 2 * lane) = mk_f2(d0 * rstd * g0 + b0, d1 * rstd * g1 + b1); }
    const float* wg = P.in[6] + ((size_t)l * 4 + g) * 16384;
    for (int i = 0; i < 32; ++i) { const int idx = tid + 512 * i; wsm[(idx >> 7) * 129 + (idx & 127)] = wg[idx]; }
    __syncthreads();
    const int t = tid >> 2, dg = tid & 3; const int smax = (t | 15);
    float acc[32];
#pragma unroll
    for (int i = 0; i < 32; ++i) acc[i] = 0.f;
    #pragma unroll 1
    for (int s = 0; s <= smax; ++s) { const float wv = (s <= t) ? wsm[t * 129 + s] : 0.f; const LAS f4* vp = (const LAS f4*)(vn + s * 128 + dg * 32);
#pragma unroll
        for (int q = 0; q < 8; ++q) { const f4 v = vp[q]; acc[4 * q] += wv * v.x; acc[4 * q + 1] += wv * v.y; acc[4 * q + 2] += wv * v.z; acc[4 * q + 3] += wv * v.w; } }
    const float bs = P.in[7][(l * 4 + g) * 128 + t];
    const u4* up = (const u4*)(Hb + (size_t)(tok0 + t) * INWP + C_SU + g * 128 + dg * 32);
    f4* yo = (f4*)((float*)(ws + WS_YMIX) + (size_t)(tok0 + t) * D + 512 + g * 128 + dg * 32);
#pragma unroll
    for (int j = 0; j < 4; ++j) { const u4 a = up[j]; float f[8]; unpack8(a, f);
        yo[2 * j] = mk_f4(f[0] * (acc[8 * j] + bs), f[1] * (acc[8 * j + 1] + bs), f[2] * (acc[8 * j + 2] + bs), f[3] * (acc[8 * j + 3] + bs));
        yo[2 * j + 1] = mk_f4(f[4] * (acc[8 * j + 4] + bs), f[5] * (acc[8 * j + 5] + bs), f[6] * (acc[8 * j + 6] + bs), f[7] * (acc[8 * j + 7] + bs)); }
    __syncthreads();
}

__device__ __forceinline__ void unit_compress(const Params& P, unsigned char* ws, int l, LAS unsigned char* lds, int u, int tid) {
    const int kv = u >> 7, b = (u >> 5) & 3, g = (u >> 3) & 3, r = u & 7;
    const bf16* Hb = (const bf16*)(ws + WS_H);
    LAS float* seg = (LAS float*)lds;
    LAS float* hid = (LAS float*)(lds + 69632);
    const int col0 = (kv ? C_VC : C_KC) + g * 64;
    const float* pe = P.in[kv ? 11 : 8] + (size_t)l * 2048;
    const float* w1 = P.in[kv ? 12 : 9] + (size_t)l * 2048 * 256;
    const float* w2 = P.in[kv ? 13 : 10] + (size_t)l * 256 * 64;
    for (int idx = tid; idx < 272 * 8; idx += 512) { const int tt = idx >> 3, d8 = (idx & 7) * 8; const int t = 256 * r + tt;
        float f[8];
        if (t < T) { const u4 a = *(const u4*)(Hb + (size_t)(b * T + t) * INWP + col0 + d8); unpack8(a, f); }
        else {
#pragma unroll
            for (int i = 0; i < 8; ++i) f[i] = 0.f; }
        LAS f4* dp = (LAS f4*)(seg + tt * 64 + d8); dp[0] = mk_f4(f[0], f[1], f[2], f[3]); dp[1] = mk_f4(f[4], f[5], f[6], f[7]); }
    __syncthreads();
    const int j = tid & 255, hb = tid >> 8;
    float acc[8], accpe = 0.f;
#pragma unroll
    for (int i = 0; i < 8; ++i) acc[i] = 0.f;
    for (int pos = 0; pos < 32; ++pos) {
#pragma unroll 2
        for (int d4 = 0; d4 < 16; ++d4) { const int kk = pos * 64 + d4 * 4;
            const float w0 = w1[(size_t)(kk + 0) * 256 + j], w1v = w1[(size_t)(kk + 1) * 256 + j], w2v = w1[(size_t)(kk + 2) * 256 + j], w3 = w1[(size_t)(kk + 3) * 256 + j];
            const f4 p4 = *(const f4*)(pe + kk);
            accpe += w0 * p4.x + w1v * p4.y + w2v * p4.z + w3 * p4.w;
#pragma unroll
            for (int ib = 0; ib < 8; ++ib) { const f4 s4 = *(const LAS f4*)(seg + (16 * (hb * 8 + ib) + pos) * 64 + d4 * 4);
                acc[ib] += w0 * s4.x + w1v * s4.y + w2v * s4.z + w3 * s4.w; } } }
#pragma unroll
    for (int ib = 0; ib < 8; ++ib) hid[(hb * 8 + ib) * 256 + j] = gelu_tanh(acc[ib] + accpe);
    __syncthreads();
    { const int i = tid >> 5, o2 = (tid & 31) * 2; float a0 = 0.f, a1 = 0.f;
        for (int jj = 0; jj < 256; ++jj) { const float hv = hid[i * 256 + jj]; const f2 w = *(const f2*)(w2 + jj * 64 + o2); a0 += hv * w.x; a1 += hv * w.y; }
        const int ci = 16 * r + i;
        if (ci <= 126) *(f2*)((float*)(ws + WS_KC) + ((size_t)((kv * 4 + b) * 4 + g) * 128 + ci) * 64 + o2) = mk_f2(a0, a1); }
    __syncthreads();
}

__device__ __forceinline__ void unit_retention(const Params& P, unsigned char* ws, int l, LAS unsigned char* lds, int u, int tid) {
    const int b = u >> 6, h = (u >> 4) & 3, c = u & 15;
    const bf16* Hb = (const bf16*)(ws + WS_H); const f2* rope = (const f2*)(ws + WS_ROPE);
    LAS float* regB = (LAS float*)lds;
    LAS float* vs = (LAS float*)(lds + 32768);
    LAS float* Qs = (LAS float*)(lds + 98304);
    const float lg2h = P.lg2[h];
    const int tok0 = b * T + c * 128;
    { float a[16];
#pragma unroll
        for (int i = 0; i < 16; ++i) a[i] = 0.f;
        const float* kvb = (const float*)(ws + WS_KVST) + (size_t)((b * 4 + h) * 16) * 8192 + tid * 16;
#pragma unroll 1
        for (int j = 0; j < c; ++j) { const float w = exp2f(lg2h * 128.f * (float)(c - 1 - j)); const f4* sp = (const f4*)(kvb + (size_t)j * 8192);
#pragma unroll
            for (int q = 0; q < 4; ++q) { const f4 v = sp[q]; a[4 * q] += w * v.x; a[4 * q + 1] += w * v.y; a[4 * q + 2] += w * v.z; a[4 * q + 3] += w * v.w; } }
        LAS f4* dp = (LAS f4*)(regB + tid * 16);
#pragma unroll
        for (int q = 0; q < 4; ++q) dp[q] = mk_f4(a[4 * q], a[4 * q + 1], a[4 * q + 2], a[4 * q + 3]); }
    const int n = tid >> 2, eg = tid & 3;
    float qa[8], qb[8];
    { const bf16* src = Hb + (size_t)(tok0 + n) * INWP + C_RQ + h * 64 + eg * 8;
        const u4 a = *(const u4*)src, bb = *(const u4*)(src + 32);
        float x1[8], x2[8]; unpack8(a, x1); unpack8(bb, x2);
        const f4* rp = (const f4*)(rope + (size_t)(c * 128 + n) * 32 + eg * 8);
        const f4 r0 = rp[0], r1 = rp[1], r2 = rp[2], r3 = rp[3];
        const float cs[8] = {r0.x, r0.z, r1.x, r1.z, r2.x, r2.z, r3.x, r3.z}, sn[8] = {r0.y, r0.w, r1.y, r1.w, r2.y, r2.w, r3.y, r3.w};
#pragma unroll
        for (int i = 0; i < 8; ++i) { qa[i] = x1[i] * cs[i] - x2[i] * sn[i]; qb[i] = x1[i] * sn[i] + x2[i] * cs[i]; Qs[n * 65 + eg * 8 + i] = qa[i]; Qs[n * 65 + 32 + eg * 8 + i] = qb[i]; } }
    __syncthreads();
    float acc[32];
#pragma unroll
    for (int i = 0; i < 32; ++i) acc[i] = 0.f;
#pragma unroll 2
    for (int d = 0; d < 64; ++d) { const float qd = Qs[n * 65 + d]; const LAS f4* sp = (const LAS f4*)(regB + d * 128 + eg * 32);
#pragma unroll
        for (int qq = 0; qq < 8; ++qq) { const f4 v = sp[qq]; acc[4 * qq] += qd * v.x; acc[4 * qq + 1] += qd * v.y; acc[4 * qq + 2] += qd * v.z; acc[4 * qq + 3] += qd * v.w; } }
    { const float xi = exp2f(lg2h * (float)(n + 1));
#pragma unroll
        for (int i = 0; i < 32; ++i) acc[i] *= xi; }
    __syncthreads();
    stage_rot_k(Hb, rope, regB, tok0, c * 128, C_RK + h * 64, lg2h, false, tid);
    stage_v128(Hb, vs, tok0, C_RV + h * 128, tid);
    __syncthreads();
    const int mmax = n | 15;
#pragma unroll 1
    for (int m = 0; m <= mmax; ++m) { const LAS f4* kp = (const LAS f4*)(regB + m * 64 + eg * 8); const LAS f4* kp2 = (const LAS f4*)(regB + m * 64 + 32 + eg * 8);
        const f4 k0 = kp[0], k1 = kp[1], k2 = kp2[0], k3 = kp2[1];
        float s = ((qa[0] * k0.x + qa[1] * k0.y) + (qa[2] * k0.z + qa[3] * k0.w)) + ((qa[4] * k1.x + qa[5] * k1.y) + (qa[6] * k1.z + qa[7] * k1.w))
                + ((qb[0] * k2.x + qb[1] * k2.y) + (qb[2] * k2.z + qb[3] * k2.w)) + ((qb[4] * k3.x + qb[5] * k3.y) + (qb[6] * k3.z + qb[7] * k3.w));
        s += __shfl_xor(s, 1); s += __shfl_xor(s, 2);
        const float a = (m <= n) ? s * exp2f(lg2h * (float)(n - m)) : 0.f;
        const LAS f4* vp = (const LAS f4*)(vs + m * 128 + eg * 32);
#pragma unroll
        for (int qq = 0; qq < 8; ++qq) { const f4 v = vp[qq]; acc[4 * qq] += a * v.x; acc[4 * qq + 1] += a * v.y; acc[4 * qq + 2] += a * v.z; acc[4 * qq + 3] += a * v.w; } }
    float s1 = 0.f;
#pragma unroll
    for (int i = 0; i < 32; ++i) s1 += acc[i];
    s1 += __shfl_xor(s1, 1); s1 += __shfl_xor(s1, 2);
    const float mu = s1 * (1.f / 128.f); float s2 = 0.f;
#pragma unroll
    for (int i = 0; i < 32; ++i) { const float dd = acc[i] - mu; s2 += dd * dd; }
    s2 += __shfl_xor(s2, 1); s2 += __shfl_xor(s2, 2);
    const float rstd = rsqrtf(s2 * (1.f / 128.f) + LN_EPS);
    const float* gg = P.in[2] + l * 512 + h * 128 + eg * 32; const float* gb = P.in[3] + l * 512 + h * 128 + eg * 32;
    const u4* gp = (const u4*)(Hb + (size_t)(tok0 + n) * INWP + C_RG + h * 128 + eg * 32);
    f4* yo = (f4*)((float*)(ws + WS_YMIX) + (size_t)(tok0 + n) * D + h * 128 + eg * 32);
#pragma unroll
    for (int j = 0; j < 4; ++j) { const u4 a = gp[j]; float f[8]; unpack8(a, f); float o[8];
#pragma unroll
        for (int i = 0; i < 8; ++i) { const float y = (acc[8 * j + i] - mu) * rstd * gg[8 * j + i] + gb[8 * j + i]; const float gv = f[i]; o[i] = y * gv * __builtin_amdgcn_rcpf(1.f + __expf(-gv)); }
        yo[2 * j] = mk_f4(o[0], o[1], o[2], o[3]); yo[2 * j + 1] = mk_f4(o[4], o[5], o[6], o[7]); }
    __syncthreads();
}

typedef pg8::bf16x8 bf16x8;
typedef short s16x4 __attribute__((ext_vector_type(4)));
typedef __bf16 bf16x2_t __attribute__((ext_vector_type(2)));
__device__ __forceinline__ unsigned pkbf(float a, float b) { f2 v; v.x = a; v.y = b; return __builtin_bit_cast(unsigned, __builtin_convertvector(v, bf16x2_t)); }
#define MFMA16(a, b, c) __builtin_amdgcn_mfma_f32_16x16x32_bf16((a), (b), (c), 0, 0, 0)
constexpr int NS = 80;
constexpr float NSA_SC = 0.125f * LOG2E;
__device__ __forceinline__ void nsa_scores(f4 (&st)[4][2], const LAS bf16* Kl, const bf16x8 (&Yq)[2][2], int lane) {
    const int r = lane & 15, kq = lane >> 4;
#pragma unroll
    for (int kt = 0; kt < 4; ++kt) { const LAS bf16* kp = Kl + (16 * kt + r) * NS + 8 * kq;
        const bf16x8 k0 = *(const LAS bf16x8*)kp, k1 = *(const LAS bf16x8*)(kp + 32);
#pragma unroll
        for (int qp = 0; qp < 2; ++qp) { f4 a = mk_f4(0.f, 0.f, 0.f, 0.f); a = MFMA16(k0, Yq[qp][0], a); a = MFMA16(k1, Yq[qp][1], a); st[kt][qp] = a; } }
}
__device__ __forceinline__ void nsa_softmax_pv(f4 (&st)[4][2], float (&m)[2], float (&l)[2], f4 (&ot)[4][2], const LAS bf16* Vl, const int (&lo)[2], const int (&hi)[2], bool need_mask, int lane) {
    const int kq = lane >> 4, q = (lane & 15) >> 2, p = lane & 3;
    bf16x8 Pf[2][2];
#pragma unroll
    for (int qp = 0; qp < 2; ++qp) {
        if (need_mask) {
#pragma unroll
            for (int kt = 0; kt < 4; ++kt)
#pragma unroll
                for (int i = 0; i < 4; ++i) { const int kl = 16 * kt + 4 * kq + i; if (kl < lo[qp] || kl > hi[qp]) st[kt][qp][i] = -1e30f; } }
        float mx = st[0][qp][0];
#pragma unroll
        for (int kt = 0; kt < 4; ++kt)
#pragma unroll
            for (int i = 0; i < 4; ++i) mx = fmaxf(mx, st[kt][qp][i]);
        mx = fmaxf(mx, __shfl_xor(mx, 16)); mx = fmaxf(mx, __shfl_xor(mx, 32));
        const float mn = fmaxf(m[qp], mx); const float corr = __builtin_amdgcn_exp2f((m[qp] - mn) * NSA_SC); m[qp] = mn; l[qp] *= corr;
#pragma unroll
        for (int dt = 0; dt < 4; ++dt) ot[dt][qp] *= corr;
        const float msc = mn * NSA_SC; float ps = 0.f;
#pragma unroll
        for (int kt = 0; kt < 4; ++kt)
#pragma unroll
            for (int i = 0; i < 4; ++i) { const float pv = __builtin_amdgcn_exp2f(st[kt][qp][i] * NSA_SC - msc); st[kt][qp][i] = pv; ps += pv; }
        l[qp] += ps;
#pragma unroll
        for (int ksp = 0; ksp < 2; ++ksp) { u4 w; w.x = pkbf(st[2 * ksp][qp][0], st[2 * ksp][qp][1]); w.y = pkbf(st[2 * ksp][qp][2], st[2 * ksp][qp][3]);
            w.z = pkbf(st[2 * ksp + 1][qp][0], st[2 * ksp + 1][qp][1]); w.w = pkbf(st[2 * ksp + 1][qp][2], st[2 * ksp + 1][qp][3]); Pf[qp][ksp] = __builtin_bit_cast(bf16x8, w); }
    }
#pragma unroll
    for (int dt = 0; dt < 4; ++dt)
#pragma unroll
        for (int ksp = 0; ksp < 2; ++ksp) { const LAS bf16* vp = Vl + (32 * ksp + 4 * kq + q) * NS + 16 * dt + 4 * p;
            const s16x4 va = __builtin_amdgcn_ds_read_tr16_b64_v4i16((LAS s16x4*)vp), vb = __builtin_amdgcn_ds_read_tr16_b64_v4i16((LAS s16x4*)(vp + 16 * NS));
            const bf16x8 vf = __builtin_shufflevector(va, vb, 0, 1, 2, 3, 4, 5, 6, 7);
#pragma unroll
            for (int qp = 0; qp < 2; ++qp) ot[dt][qp] = MFMA16(vf, Pf[qp][ksp], ot[dt][qp]); }
}
__device__ __forceinline__ void nsa_flush(float* __restrict__ y0, float* __restrict__ y1, const f4 (&ot)[4][2], const float (&l)[2], const float (&gate)[2], bool add, int kq) {
#pragma unroll
    for (int qp = 0; qp < 2; ++qp) { float lt = l[qp]; lt += __shfl_xor(lt, 16); lt += __shfl_xor(lt, 32); const float sc = (lt > 0.f) ? gate[qp] / lt : 0.f;
        float* yp = (qp ? y1 : y0) + 4 * kq;
#pragma unroll
        for (int dt = 0; dt < 4; ++dt) { f4 o = ot[dt][qp] * sc; if (add) o += *(const f4*)(yp + 16 * dt); *(f4*)(yp + 16 * dt) = o; } }
}
__device__ __forceinline__ void nsa_pair_next(unsigned& rem, int& ja, int& jb) { ja = __builtin_ctz(rem); rem &= rem - 1u; if (rem) { jb = __builtin_ctz(rem); rem &= rem - 1u; } else jb = -1; }
__device__ __forceinline__ void nsa_pair_prefetch(const bf16* __restrict__ Hb, int tok0, int ja, int jb, int colK, int colV, int tid, u4 (&R)[4]) {
    const int key = tid >> 3, d8 = (tid & 7) * 8; const int j1 = jb < 0 ? ja : jb;
    const bf16* pa = Hb + (size_t)(tok0 + 64 * ja + key) * INWP + d8; const bf16* pb = Hb + (size_t)(tok0 + 64 * j1 + key) * INWP + d8;
    R[0] = *(const u4*)(pa + colK); R[1] = *(const u4*)(pa + colV); R[2] = *(const u4*)(pb + colK); R[3] = *(const u4*)(pb + colV);
}
__device__ __forceinline__ void nsa_pair_store(LAS bf16* buf, int tid, const u4 (&R)[4]) {
    LAS bf16* p = buf + (tid >> 3) * NS + (tid & 7) * 8;
    *(LAS u4*)p = R[0]; *(LAS u4*)(p + 128 * NS) = R[1]; *(LAS u4*)(p + 64 * NS) = R[2]; *(LAS u4*)(p + 192 * NS) = R[3];
}
template <int MODE>
__device__ __forceinline__ void nsa_branch(unsigned chunks, const bf16* __restrict__ Hb, int tok0, int colK, int colV, LAS bf16* buf0, LAS bf16* buf1, int tid, int lane, int qt, const int (&tq)[2], const unsigned (&mym)[2],
                                           const bf16x8 (&Yq)[2][2], f4 (&ot)[4][2], float (&m)[2], float (&l)[2]) {
    u4 R[4]; unsigned rem = chunks; int ja, jb, na = 0, nb = -1; f4 st[4][2]; int lo[2], hi[2];
    nsa_pair_next(rem, ja, jb);
    nsa_pair_prefetch(Hb, tok0, ja, jb, colK, colV, tid, R);
    __syncthreads();
    nsa_pair_store(buf0, tid, R);
    bool more = (rem != 0u);
    if (more) { nsa_pair_next(rem, na, nb); nsa_pair_prefetch(Hb, tok0, na, nb, colK, colV, tid, R); }
    __syncthreads();
    int it = 0;
#pragma unroll 1
    for (;;) {
        LAS bf16* cur = (it & 1) ? buf1 : buf0;
#pragma unroll 1
        for (int sub = 0; sub < 2; ++sub) { const int j = sub ? jb : ja;
            if (j < 0) break;
            bool anyv = false, full = true;
#pragma unroll
            for (int qp = 0; qp < 2; ++qp) {
                if (MODE == 0) { const bool sel = (mym[qp] >> j) & 1u; lo[qp] = sel ? 0 : 64; hi[qp] = sel ? ((j == qt) ? tq[qp] : 63) : -1; anyv |= sel; full &= (sel && j != qt); }
                else { lo[qp] = (j == qt - 8) ? tq[qp] + 1 : 0; hi[qp] = (j == qt) ? tq[qp] : 63; anyv = true; full &= (j != qt && j != qt - 8); } }
            if (__builtin_amdgcn_ballot_w64(anyv) != 0ull) {
                const bool need_mask = __builtin_amdgcn_ballot_w64(!full) != 0ull;
                nsa_scores(st, cur + sub * 64 * NS, Yq, lane);
                nsa_softmax_pv(st, m, l, ot, cur + 128 * NS + sub * 64 * NS, lo, hi, need_mask, lane); } }
        if (!more) break;
        nsa_pair_store((it & 1) ? buf0 : buf1, tid, R);
        ja = na; jb = nb; more = (rem != 0u);
        if (more) { nsa_pair_next(rem, na, nb); nsa_pair_prefetch(Hb, tok0, na, nb, colK, colV, tid, R); }
        __syncthreads(); ++it;
    }
}
__device__ __forceinline__ void unit_nsa(const Params& P, unsigned char* ws, int l_, LAS unsigned char* lds, int u, int tid) {
    const int b = (u >> 7) & 3, g = (u >> 5) & 3, qt = (u & 256) ? 31 - (u & 31) : (u & 31);
    const bf16* Hb = (const bf16*)(ws + WS_H);
    LAS bf16* buf0 = (LAS bf16*)lds;
    LAS bf16* buf1 = (LAS bf16*)(lds + 40960);
    LAS float* impG = (LAS float*)(lds + 40960);
    LAS float* impE = (LAS float*)(lds + 73728);
    LAS unsigned* selm = (LAS unsigned*)(lds + 106496);
    const int lane = tid & 63, wv = __builtin_amdgcn_readfirstlane(tid >> 6), h = wv >> 1, qh = wv & 1;
    const int c = lane & 15, kq = lane >> 4;
    const int t0 = qt * 64;
    int tq[2]; size_t tok[2];
#pragma unroll
    for (int qp = 0; qp < 2; ++qp) { tq[qp] = 32 * qh + 16 * qp + c; tok[qp] = (size_t)b * T + t0 + tq[qp]; }
    bf16x8 Yq[2][2];
#pragma unroll
    for (int qp = 0; qp < 2; ++qp)
#pragma unroll
        for (int ks = 0; ks < 2; ++ks) Yq[qp][ks] = *(const bf16x8*)(Hb + tok[qp] * INWP + C_NQ + g * 256 + h * 64 + 32 * ks + 8 * kq);
    float gate[3][2];
#pragma unroll
    for (int k = 0; k < 3; ++k)
#pragma unroll
        for (int qp = 0; qp < 2; ++qp) { const float gv = bf2f(Hb[tok[qp] * INWP + C_NG + g * 12 + h * 3 + k]); gate[k][qp] = __builtin_amdgcn_rcpf(1.f + __expf(-gv)); }
    float* y0 = (float*)(ws + WS_YMIX) + tok[0] * D + 1024 + g * 256 + h * 64; float* y1 = (float*)(ws + WS_YMIX) + tok[1] * D + 1024 + g * 256 + h * 64;
    if (tid == 0) selm[64] = 0u;
    f4 ot[4][2]; float m[2], l[2];
#pragma unroll
    for (int dt = 0; dt < 4; ++dt)
#pragma unroll
        for (int qp = 0; qp < 2; ++qp) ot[dt][qp] = mk_f4(0.f, 0.f, 0.f, 0.f);
    int cmax[2];
#pragma unroll
    for (int qp = 0; qp < 2; ++qp) { const int t = t0 + tq[qp]; cmax[qp] = (t >= 31) ? (((t - 31) >> 4) < 126 ? ((t - 31) >> 4) : 126) : -1; }
    __syncthreads();
    { const bf16* KCk = (const bf16*)(ws + WS_KC) + (size_t)((0 * 4 + b) * 4 + g) * 8192; const bf16* KCv = (const bf16*)(ws + WS_KC) + (size_t)((1 * 4 + b) * 4 + g) * 8192;
#pragma unroll
        for (int i = 0; i < 2; ++i) { const int idx = tid + 512 * i, key = idx >> 3, d8 = (idx & 7) * 8;
            *(LAS u4*)(buf0 + key * NS + d8) = *(const u4*)(KCk + key * 64 + d8); *(LAS u4*)(buf0 + (128 + key) * NS + d8) = *(const u4*)(KCv + key * 64 + d8); } }
    __syncthreads();
    m[0] = m[1] = -1e4f; l[0] = l[1] = 0.f;
    { f4 st[4][2]; int lo[2], hi[2];
#pragma unroll 1
        for (int cc = 0; cc < 2; ++cc) {
            if (cc * 64 * 16 + 31 > t0 + 63) break;
#pragma unroll
            for (int qp = 0; qp < 2; ++qp) { lo[qp] = 0; hi[qp] = cmax[qp] - 64 * cc; }
            nsa_scores(st, buf0 + cc * 64 * NS, Yq, lane);
            nsa_softmax_pv(st, m, l, ot, buf0 + 128 * NS + cc * 64 * NS, lo, hi, true, lane);
        }
        { const float g2[2] = {gate[0][0], gate[0][1]}; nsa_flush(y0, y1, ot, l, g2, false, kq); }
        float invl[2], msc[2];
#pragma unroll
        for (int qp = 0; qp < 2; ++qp) { float lt = l[qp]; lt += __shfl_xor(lt, 16); lt += __shfl_xor(lt, 32); invl[qp] = (lt > 0.f) ? 1.f / lt : 0.f; msc[qp] = m[qp] * NSA_SC; }
#pragma unroll 1
        for (int cc = 0; cc < 2; ++cc) {
            nsa_scores(st, buf0 + cc * 64 * NS, Yq, lane);
#pragma unroll
            for (int kt = 0; kt < 4; ++kt)
#pragma unroll
                for (int qp = 0; qp < 2; ++qp) { float pp[4];
#pragma unroll
                    for (int i = 0; i < 4; ++i) { const int ci = 64 * cc + 16 * kt + 4 * kq + i; pp[i] = (ci <= cmax[qp]) ? __builtin_amdgcn_exp2f(st[kt][qp][i] * NSA_SC - msc[qp]) * invl[qp] : 0.f; }
                    const int j = 16 * cc + 4 * kt + kq;
                    impG[(h * 32 + j) * 64 + tq[qp]] = (pp[0] + pp[1]) + (pp[2] + pp[3]);
                    if (j < 31) impE[(h * 32 + j + 1) * 64 + tq[qp]] = pp[3]; }
        } }
    __syncthreads();
    if (tid < 64) { const int tqs = tid; float tv[8]; int ti[8];
#pragma unroll
        for (int k = 0; k < 8; ++k) { tv[k] = -3e38f; ti[k] = 0; }
#pragma unroll 1
        for (int j = 0; j < 32; ++j) { float v;
            if (j <= qt) { const bool forced = (j == 0) || (j == qt) || (j == qt - 1);
                float s4 = (impG[(0 * 32 + j) * 64 + tqs] + impG[(1 * 32 + j) * 64 + tqs]) + (impG[(2 * 32 + j) * 64 + tqs] + impG[(3 * 32 + j) * 64 + tqs]);
                if (j > 0) s4 += (impE[(0 * 32 + j) * 64 + tqs] + impE[(1 * 32 + j) * 64 + tqs]) + (impE[(2 * 32 + j) * 64 + tqs] + impE[(3 * 32 + j) * 64 + tqs]);
                v = forced ? 1e6f : s4; }
            else v = -1e9f;
            int vi = j;
#pragma unroll
            for (int k = 0; k < 8; ++k) { const bool gt = v > tv[k]; const float nv = gt ? tv[k] : v; const int ni = gt ? ti[k] : vi; tv[k] = gt ? v : tv[k]; ti[k] = gt ? vi : ti[k]; v = nv; vi = ni; } }
        unsigned msk = 0u;
#pragma unroll
        for (int k = 0; k < 8; ++k) if (ti[k] <= qt) msk |= (1u << ti[k]);
        selm[tqs] = msk; atomicOr((unsigned*)&selm[64], msk); }
    __syncthreads();
    unsigned mymask[2];
#pragma unroll
    for (int qp = 0; qp < 2; ++qp) mymask[qp] = selm[tq[qp]];
    const unsigned umask = selm[64];
#pragma unroll
    for (int dt = 0; dt < 4; ++dt)
#pragma unroll
        for (int qp = 0; qp < 2; ++qp) ot[dt][qp] = mk_f4(0.f, 0.f, 0.f, 0.f);
    m[0] = m[1] = -1e4f; l[0] = l[1] = 0.f;
    nsa_branch<0>(umask, Hb, b * T, C_KS + g * 64, C_VS + g * 64, buf0, buf1, tid, lane, qt, tq, mymask, Yq, ot, m, l);
    { const float g2[2] = {gate[1][0], gate[1][1]}; nsa_flush(y0, y1, ot, l, g2, true, kq); }
#pragma unroll
    for (int dt = 0; dt < 4; ++dt)
#pragma unroll
        for (int qp = 0; qp < 2; ++qp) ot[dt][qp] = mk_f4(0.f, 0.f, 0.f, 0.f);
    m[0] = m[1] = -1e4f; l[0] = l[1] = 0.f;
    { const int jw0 = qt >= 8 ? qt - 8 : 0; const unsigned wmask = ((qt == 31) ? 0xffffffffu : ((1u << (qt + 1)) - 1u)) & ~((1u << jw0) - 1u);
        nsa_branch<1>(wmask, Hb, b * T, C_KW + g * 64, C_VW + g * 64, buf0, buf1, tid, lane, qt, tq, mymask, Yq, ot, m, l); }
    { const float g2[2] = {gate[2][0], gate[2][1]}; nsa_flush(y0, y1, ot, l, g2, true, kq); }
    __syncthreads();
}

__device__ __forceinline__ void unit_compress_mfma(const Params& P, unsigned char* ws, int l, LAS unsigned char* lds, int u, int tid) {
    const int kv = u >> 7, b = (u >> 5) & 3, g = (u >> 3) & 3, r8 = u & 7, i0 = 16 * r8;
    const bf16* Hb = (const bf16*)(ws + WS_H);
    const bf16* W1T = (const bf16*)(ws + WS_W1T) + (size_t)(l * 2 + kv) * 256 * 2048;
    const bf16* W2T = (const bf16*)(ws + WS_W2T) + (size_t)(l * 2 + kv) * 64 * 256;
    const float* pe = P.in[kv ? 11 : 8] + (size_t)l * 2048;
    constexpr int AS = 2056;
    LAS bf16* Al = (LAS bf16*)lds;
    LAS bf16* hidL = (LAS bf16*)(lds + 16 * AS * 2);
    const int lane = tid & 63, wv = __builtin_amdgcn_readfirstlane(tid >> 6), c = lane & 15, kq = lane >> 4;
    const int col0 = (kv ? C_VC : C_KC) + g * 64;
#pragma unroll 4
    for (int it = 0; it < 8; ++it) { const int idx = tid + 512 * it; const int r = idx >> 8, pos = (idx >> 3) & 31, d8 = (idx & 7) * 8;
        int t = 16 * (i0 + r) + pos; t = t < T ? t : T - 1;
        const u4 a = *(const u4*)(Hb + (size_t)(b * T + t) * INWP + col0 + d8); float f[8]; unpack8(a, f);
        const f4 p0 = *(const f4*)(pe + pos * 64 + d8), p1 = *(const f4*)(pe + pos * 64 + d8 + 4);
        u4 w; w.x = pkbf(f[0] + p0.x, f[1] + p0.y); w.y = pkbf(f[2] + p0.z, f[3] + p0.w); w.z = pkbf(f[4] + p1.x, f[5] + p1.y); w.w = pkbf(f[6] + p1.z, f[7] + p1.w);
        *(LAS u4*)(Al + r * AS + pos * 64 + d8) = w; }
    __syncthreads();
    f4 acc[2];
#pragma unroll
    for (int nt = 0; nt < 2; ++nt) acc[nt] = mk_f4(0.f, 0.f, 0.f, 0.f);
    const bf16* wrow[2];
#pragma unroll
    for (int nt = 0; nt < 2; ++nt) wrow[nt] = W1T + (size_t)(32 * wv + 16 * nt + c) * 2048 + 8 * kq;
    const LAS bf16* arow = Al + c * AS + 8 * kq;
    bf16x8 xfA[2][4], xfB[2][4];
#define CMP_LOADW(XF, p2_) do { _Pragma("unroll") for (int nt = 0; nt < 2; ++nt) _Pragma("unroll") for (int ks = 0; ks < 4; ++ks) XF[nt][ks] = *(const bf16x8*)(wrow[nt] + (p2_) * 128 + 32 * ks); } while (0)
#define CMP_MMAW(XF, p2_) do { _Pragma("unroll") for (int ks = 0; ks < 4; ++ks) { const bf16x8 yf_ = *(const LAS bf16x8*)(arow + (p2_) * 128 + 32 * ks); \
        _Pragma("unroll") for (int nt = 0; nt < 2; ++nt) acc[nt] = MFMA16(XF[nt][ks], yf_, acc[nt]); } } while (0)
    CMP_LOADW(xfA, 0);
#pragma unroll 1
    for (int p2 = 0; p2 < 16; p2 += 2) {
        CMP_LOADW(xfB, p2 + 1);
        CMP_MMAW(xfA, p2);
        if (p2 + 2 < 16) CMP_LOADW(xfA, p2 + 2);
        CMP_MMAW(xfB, p2 + 1);
    }
#undef CMP_LOADW
#undef CMP_MMAW
#pragma unroll
    for (int nt = 0; nt < 2; ++nt) { const f4 a = acc[nt]; u2 w; w.x = pkbf(gelu_tanh(a.x), gelu_tanh(a.y)); w.y = pkbf(gelu_tanh(a.z), gelu_tanh(a.w));
        *(LAS u2*)(hidL + c * 264 + 32 * wv + 16 * nt + 4 * kq) = w; }
    __syncthreads();
    if (wv < 4) { const int ot = wv; f4 o = mk_f4(0.f, 0.f, 0.f, 0.f);
        const bf16* w2p = W2T + (size_t)(16 * ot + c) * 256 + 8 * kq; const LAS bf16* hp = hidL + c * 264 + 8 * kq;
#pragma unroll
        for (int ks = 0; ks < 8; ++ks) { const bf16x8 xw = *(const bf16x8*)(w2p + 32 * ks); const bf16x8 yh = *(const LAS bf16x8*)(hp + 32 * ks); o = MFMA16(xw, yh, o); }
        const int ci = i0 + c;
        u2 w; w.x = pkbf(o.x, o.y); w.y = pkbf(o.z, o.w); if (ci > 126) { w.x = 0u; w.y = 0u; }
        *(u2*)((bf16*)(ws + WS_KC) + ((size_t)((kv * 4 + b) * 4 + g) * 128 + ci) * 64 + 16 * ot + 4 * kq) = w; }
    __syncthreads();
}

__device__ __forceinline__ void unit_retention_mfma(const Params& P, unsigned char* ws, int l, LAS unsigned char* lds, int u, int tid) {
    const int b = u >> 6, h = (u >> 4) & 3, c = u & 15;
    const bf16* Hb = (const bf16*)(ws + WS_H); const f2* rope = (const f2*)(ws + WS_ROPE);
    LAS bf16* Ql = (LAS bf16*)lds;
    LAS bf16* Kl = (LAS bf16*)(lds + 18432);
    LAS bf16* Vt = (LAS bf16*)(lds + 36864);
    LAS bf16* St = (LAS bf16*)(lds + 71680);
    const float lg2h = P.lg2[h];
    const int tok0 = b * T + c * 128;
    { const int m = tid >> 2, p = tid & 3;
        const f4* rp = (const f4*)(rope + (size_t)(c * 128 + m) * 32 + p * 8);
        const f4 r0 = rp[0], r1 = rp[1], r2 = rp[2], r3 = rp[3];
        const float cs[8] = {r0.x, r0.z, r1.x, r1.z, r2.x, r2.z, r3.x, r3.z}, sn[8] = {r0.y, r0.w, r1.y, r1.w, r2.y, r2.w, r3.y, r3.w};
#pragma unroll
        for (int which = 0; which < 2; ++which) { const bf16* src = Hb + (size_t)(tok0 + m) * INWP + (which ? C_RK : C_RQ) + h * 64 + p * 8;
            const u4 a = *(const u4*)src, bb = *(const u4*)(src + 32); float x1[8], x2[8]; unpack8(a, x1); unpack8(bb, x2);
            const float sc = which ? 0.125f : 1.0f; float o1[8], o2[8];
#pragma unroll
            for (int i = 0; i < 8; ++i) { o1[i] = (x1[i] * cs[i] - x2[i] * sn[i]) * sc; o2[i] = (x1[i] * sn[i] + x2[i] * cs[i]) * sc; }
            LAS bf16* dst = (which ? Kl : Ql) + m * 72 + p * 8;
            u4 w1, w2; w1.x = pkbf(o1[0], o1[1]); w1.y = pkbf(o1[2], o1[3]); w1.z = pkbf(o1[4], o1[5]); w1.w = pkbf(o1[6], o1[7]); w2.x = pkbf(o2[0], o2[1]); w2.y = pkbf(o2[2], o2[3]); w2.z = pkbf(o2[4], o2[5]); w2.w = pkbf(o2[6], o2[7]);
            *(LAS u4*)dst = w1; *(LAS u4*)(dst + 32) = w2; } }
    { const int m = tid & 127, eq = tid >> 7;
        const u4* src = (const u4*)(Hb + (size_t)(tok0 + m) * INWP + C_RV + h * 128 + eq * 32); LAS bf16* vp = Vt + (eq * 32) * 136 + m;
#pragma unroll
        for (int j = 0; j < 4; ++j) { const u4 a = src[j];
            vp[(8 * j + 0) * 136] = (bf16)(a.x & 0xffffu); vp[(8 * j + 1) * 136] = (bf16)(a.x >> 16); vp[(8 * j + 2) * 136] = (bf16)(a.y & 0xffffu); vp[(8 * j + 3) * 136] = (bf16)(a.y >> 16);
            vp[(8 * j + 4) * 136] = (bf16)(a.z & 0xffffu); vp[(8 * j + 5) * 136] = (bf16)(a.z >> 16); vp[(8 * j + 6) * 136] = (bf16)(a.w & 0xffffu); vp[(8 * j + 7) * 136] = (bf16)(a.w >> 16); } }
    { float a[16];
#pragma unroll
        for (int i = 0; i < 16; ++i) a[i] = 0.f;
        const float* kvb = (const float*)(ws + WS_KVST) + (size_t)((b * 4 + h) * 16) * 8192 + tid * 16;
#pragma unroll 1
        for (int j = 0; j < c; ++j) { const float w = exp2f(lg2h * 128.f * (float)(c - 1 - j)); const f4* sp = (const f4*)(kvb + (size_t)j * 8192);
#pragma unroll
            for (int q = 0; q < 4; ++q) { const f4 v = sp[q]; a[4 * q] += w * v.x; a[4 * q + 1] += w * v.y; a[4 * q + 2] += w * v.z; a[4 * q + 3] += w * v.w; } }
        const int d = tid >> 3, e0 = (tid & 7) * 16;
#pragma unroll
        for (int i = 0; i < 16; ++i) St[(e0 + i) * 72 + d] = (bf16)f2bf(a[i]); }
    __syncthreads();
    const int lane = tid & 63, wv = __builtin_amdgcn_readfirstlane(tid >> 6), cc = lane & 15, kq = lane >> 4;
    const int nn = 16 * wv + cc;
    bf16x8 yq[2];
#pragma unroll
    for (int ks = 0; ks < 2; ++ks) yq[ks] = *(const LAS bf16x8*)(Ql + nn * 72 + 32 * ks + 8 * kq);
    f4 ot[8];
#pragma unroll
    for (int et = 0; et < 8; ++et) { f4 a = mk_f4(0.f, 0.f, 0.f, 0.f); const LAS bf16* sp = St + (16 * et + cc) * 72 + 8 * kq;
        a = MFMA16(*(const LAS bf16x8*)sp, yq[0], a); a = MFMA16(*(const LAS bf16x8*)(sp + 32), yq[1], a); ot[et] = a; }
    { const float xi = exp2f(lg2h * (float)(nn + 1));
#pragma unroll
        for (int et = 0; et < 8; ++et) ot[et] *= xi; }
    const int nks = (wv >> 1) + 1;
#pragma unroll 1
    for (int ksp = 0; ksp < nks; ++ksp) { f4 st[2];
#pragma unroll
        for (int j = 0; j < 2; ++j) { const int mt = 2 * ksp + j; const LAS bf16* kp = Kl + (16 * mt + cc) * 72 + 8 * kq;
            f4 a = mk_f4(0.f, 0.f, 0.f, 0.f); a = MFMA16(*(const LAS bf16x8*)kp, yq[0], a); a = MFMA16(*(const LAS bf16x8*)(kp + 32), yq[1], a);
#pragma unroll
            for (int i = 0; i < 4; ++i) { const int mm = 16 * mt + 4 * kq + i; a[i] = (mm <= nn) ? a[i] * exp2f(lg2h * (float)(nn - mm)) : 0.f; }
            st[j] = a; }
        u4 w; w.x = pkbf(st[0].x, st[0].y); w.y = pkbf(st[0].z, st[0].w); w.z = pkbf(st[1].x, st[1].y); w.w = pkbf(st[1].z, st[1].w);
        const bf16x8 pf = __builtin_bit_cast(bf16x8, w);
#pragma unroll
        for (int et = 0; et < 8; ++et) { const LAS bf16* vp = Vt + (16 * et + cc) * 136 + 32 * ksp + 4 * kq;
            const s16x4 va = *(const LAS s16x4*)vp, vb = *(const LAS s16x4*)(vp + 16);
            ot[et] = MFMA16(__builtin_shufflevector(va, vb, 0, 1, 2, 3, 4, 5, 6, 7), pf, ot[et]); }
    }
    float s1 = 0.f;
#pragma unroll
    for (int et = 0; et < 8; ++et) s1 += (ot[et].x + ot[et].y) + (ot[et].z + ot[et].w);
    s1 += __shfl_xor(s1, 16); s1 += __shfl_xor(s1, 32);
    const float mu = s1 * (1.f / 128.f); float s2 = 0.f;
#pragma unroll
    for (int et = 0; et < 8; ++et) { const f4 dd = ot[et] - mu; s2 += (dd.x * dd.x + dd.y * dd.y) + (dd.z * dd.z + dd.w * dd.w); }
    s2 += __shfl_xor(s2, 16); s2 += __shfl_xor(s2, 32);
    const float rstd = rsqrtf(s2 * (1.f / 128.f) + LN_EPS);
    const float* gg = P.in[2] + l * 512 + h * 128; const float* gb = P.in[3] + l * 512 + h * 128;
    const bf16* gp = Hb + (size_t)(tok0 + nn) * INWP + C_RG + h * 128;
    float* yo = (float*)(ws + WS_YMIX) + (size_t)(tok0 + nn) * D + h * 128;
#pragma unroll
    for (int et = 0; et < 8; ++et) { const int e = 16 * et + 4 * kq; const f4 g4 = *(const f4*)(gg + e), b4 = *(const f4*)(gb + e); const u2 gr = *(const u2*)(gp + e);
        const float gv[4] = {__uint_as_float(gr.x << 16), __uint_as_float(gr.x & 0xffff0000u), __uint_as_float(gr.y << 16), __uint_as_float(gr.y & 0xffff0000u)};
        f4 o;
#pragma unroll
        for (int i = 0; i < 4; ++i) { const float y = (ot[et][i] - mu) * rstd * g4[i] + b4[i]; o[i] = y * gv[i] * __builtin_amdgcn_rcpf(1.f + __expf(-gv[i])); }
        *(f4*)(yo + e) = o; }
    __syncthreads();
}

__device__ __forceinline__ bf16x8 tr_frag(const LAS bf16* p, int rowstride4) {
    const s16x4 a = __builtin_amdgcn_ds_read_tr16_b64_v4i16((LAS s16x4*)p), b = __builtin_amdgcn_ds_read_tr16_b64_v4i16((LAS s16x4*)(p + rowstride4));
    return __builtin_shufflevector(a, b, 0, 1, 2, 3, 4, 5, 6, 7);
}
__device__ __forceinline__ void unit_kvstate_mfma(const Params& P, unsigned char* ws, LAS unsigned char* lds, int u, int tid) {
    const int b = u / 60, r = u % 60, h = r / 15, j = r % 15;
    const bf16* Hb = (const bf16*)(ws + WS_H); const f2* rope = (const f2*)(ws + WS_ROPE);
    LAS bf16* Kz = (LAS bf16*)lds;
    LAS bf16* Vl = (LAS bf16*)(lds + 20480);
    const int tok0 = b * T + j * 128; const float lg2h = P.lg2[h];
    { const int m = tid >> 2, p = tid & 3;
        const f4* rp = (const f4*)(rope + (size_t)(j * 128 + m) * 32 + p * 8);
        const f4 r0 = rp[0], r1 = rp[1], r2 = rp[2], r3 = rp[3];
        const float cs[8] = {r0.x, r0.z, r1.x, r1.z, r2.x, r2.z, r3.x, r3.z}, sn[8] = {r0.y, r0.w, r1.y, r1.w, r2.y, r2.w, r3.y, r3.w};
        const bf16* src = Hb + (size_t)(tok0 + m) * INWP + C_RK + h * 64 + p * 8;
        const u4 a = *(const u4*)src, bb = *(const u4*)(src + 32); float x1[8], x2[8]; unpack8(a, x1); unpack8(bb, x2);
        const float sc = 0.125f * exp2f(lg2h * (float)(127 - m)); float o1[8], o2[8];
#pragma unroll
        for (int i = 0; i < 8; ++i) { o1[i] = (x1[i] * cs[i] - x2[i] * sn[i]) * sc; o2[i] = (x1[i] * sn[i] + x2[i] * cs[i]) * sc; }
        u4 w1, w2; w1.x = pkbf(o1[0], o1[1]); w1.y = pkbf(o1[2], o1[3]); w1.z = pkbf(o1[4], o1[5]); w1.w = pkbf(o1[6], o1[7]); w2.x = pkbf(o2[0], o2[1]); w2.y = pkbf(o2[2], o2[3]); w2.z = pkbf(o2[4], o2[5]); w2.w = pkbf(o2[6], o2[7]);
        *(LAS u4*)(Kz + m * 80 + p * 8) = w1; *(LAS u4*)(Kz + m * 80 + 32 + p * 8) = w2;
        const u4* vs = (const u4*)(Hb + (size_t)(tok0 + m) * INWP + C_RV + h * 128 + p * 32); LAS u4* vd = (LAS u4*)(Vl + m * 144 + p * 32);
#pragma unroll
        for (int q = 0; q < 4; ++q) vd[q] = vs[q]; }
    __syncthreads();
    { const int lane = tid & 63, et = __builtin_amdgcn_readfirstlane(tid >> 6), c = lane & 15, kq = lane >> 4, q = (lane & 15) >> 2, p4 = lane & 3;
        bf16x8 yv[4];
#pragma unroll
        for (int ks = 0; ks < 4; ++ks) yv[ks] = tr_frag(Vl + (32 * ks + 8 * kq + q) * 144 + 16 * et + 4 * p4, 4 * 144);
        float* dst = (float*)(ws + WS_KVST) + (size_t)((b * 4 + h) * 16 + j) * 8192 + 16 * et + c;
#pragma unroll
        for (int dt = 0; dt < 4; ++dt) { f4 acc = mk_f4(0.f, 0.f, 0.f, 0.f);
#pragma unroll
            for (int ks = 0; ks < 4; ++ks) acc = MFMA16(tr_frag(Kz + (32 * ks + 8 * kq + q) * 80 + 16 * dt + 4 * p4, 4 * 80), yv[ks], acc);
#pragma unroll
            for (int i = 0; i < 4; ++i) dst[(16 * dt + 4 * kq + i) * 128] = acc[i]; } }
    __syncthreads();
}
__device__ __forceinline__ void unit_sgu_mfma(const Params& P, unsigned char* ws, int l, LAS unsigned char* lds, int u, int tid, int lane, int wave) {
    const int b = u >> 6, c = (u >> 2) & 15, g = u & 3;
    const bf16* Hb = (const bf16*)(ws + WS_H);
    LAS bf16* vn = (LAS bf16*)lds;
    const int tok0 = b * T + c * 128;
    const float* lng = P.in[4] + l * 512 + g * 128; const float* lnb = P.in[5] + l * 512 + g * 128;
    const float g0 = lng[2 * lane], g1 = lng[2 * lane + 1], b0 = lnb[2 * lane], b1 = lnb[2 * lane + 1];
#pragma unroll 4
    for (int i = 0; i < 16; ++i) { const int s = wave * 16 + i;
        const unsigned pr = *(const unsigned*)(Hb + (size_t)(tok0 + s) * INWP + C_SV + g * 128 + 2 * lane);
        const float v0 = __uint_as_float(pr << 16), v1 = __uint_as_float(pr & 0xffff0000u);
        const float mu = wave_sum(v0 + v1) * (1.f / 128.f); const float d0 = v0 - mu, d1 = v1 - mu;
        const float var = wave_sum(d0 * d0 + d1 * d1) * (1.f / 128.f); const float rstd = rsqrtf(var + LN_EPS);
        *(LAS unsigned*)(vn + s * 144 + 2 * lane) = pkbf(d0 * rstd * g0 + b0, d1 * rstd * g1 + b1); }
    __syncthreads();
    { const int cc = lane & 15, kq = lane >> 4, q = (lane & 15) >> 2, p4 = lane & 3, t = 16 * wave + cc, nks = (wave >> 1) + 1;
        const float* wrow = P.in[6] + ((size_t)l * 4 + g) * 16384 + (size_t)t * 128 + 8 * kq;
        bf16x8 xw[4];
#pragma unroll
        for (int ks = 0; ks < 4; ++ks) { u4 w = {0u, 0u, 0u, 0u};
            if (ks < nks) { const f4 a0 = *(const f4*)(wrow + 32 * ks), a1 = *(const f4*)(wrow + 32 * ks + 4); const int s0 = 32 * ks + 8 * kq;
                w.x = pkbf(s0 + 0 <= t ? a0.x : 0.f, s0 + 1 <= t ? a0.y : 0.f); w.y = pkbf(s0 + 2 <= t ? a0.z : 0.f, s0 + 3 <= t ? a0.w : 0.f);
                w.z = pkbf(s0 + 4 <= t ? a1.x : 0.f, s0 + 5 <= t ? a1.y : 0.f); w.w = pkbf(s0 + 6 <= t ? a1.z : 0.f, s0 + 7 <= t ? a1.w : 0.f); }
            xw[ks] = __builtin_bit_cast(bf16x8, w); }
        f4 bs4; { const float* bsp = P.in[7] + (l * 4 + g) * 128 + 16 * wave + 4 * kq; bs4 = *(const f4*)bsp; }
#pragma unroll 2
        for (int dt = 0; dt < 8; ++dt) { f4 acc = mk_f4(0.f, 0.f, 0.f, 0.f);
#pragma unroll
            for (int ks = 0; ks < 4; ++ks) if (ks < nks) acc = MFMA16(xw[ks], tr_frag(vn + (32 * ks + 8 * kq + q) * 144 + 16 * dt + 4 * p4, 4 * 144), acc);
            const int d = 16 * dt + cc;
#pragma unroll
            for (int i = 0; i < 4; ++i) { const int tt = 16 * wave + 4 * kq + i; const float uu = bf2f(Hb[(size_t)(tok0 + tt) * INWP + C_SU + g * 128 + d]);
                ((float*)(ws + WS_YMIX))[(size_t)(tok0 + tt) * D + 512 + g * 128 + d] = uu * (acc[i] + bs4[i]); } } }
    __syncthreads();
}

__device__ __forceinline__ void row_mixnorm(const Params& P, unsigned char* ws, int l, int rowi, int lane) {
    const f4* yp = (const f4*)((const float*)(ws + WS_YMIX) + (size_t)rowi * D) + lane;
    const f4* gp = (const f4*)(P.in[14] + (size_t)l * D) + lane;
    f4 v[8]; float ss[8];
#pragma unroll
    for (int j = 0; j < 8; ++j) { v[j] = yp[64 * j]; ss[j] = v[j].x * v[j].x + v[j].y * v[j].y + v[j].z * v[j].z + v[j].w * v[j].w; }
    const float r0 = rsqrtf(wave_sum(ss[0] + ss[1]) * (1.f / 512.f) + LN_EPS);
    const float r1 = rsqrtf(wave_sum(ss[2] + ss[3]) * (1.f / 512.f) + LN_EPS);
    const float r2 = rsqrtf(wave_sum((ss[4] + ss[5]) + (ss[6] + ss[7])) * (1.f / 1024.f) + LN_EPS);
    u2* op = (u2*)((bf16*)(ws + WS_MIXED) + (size_t)rowi * D) + lane;
#pragma unroll
    for (int j = 0; j < 8; ++j) { const float r = (j < 2) ? r0 : ((j < 4) ? r1 : r2); const f4 g4 = gp[64 * j];
        op[64 * j] = mk_u2(pk2(v[j].x * r * g4.x, v[j].y * r * g4.y), pk2(v[j].z * r * g4.z, v[j].w * r * g4.w)); }
}
__device__ __forceinline__ void row_ln(const float* __restrict__ zin, const float* __restrict__ gam, const float* __restrict__ bet, float* __restrict__ of32, bf16* __restrict__ obf, unsigned* __restrict__ oq, float* __restrict__ osc, int rowi, int lane) {
    const f4* zp = (const f4*)(zin + (size_t)rowi * D) + lane;
    f4 v[8]; float s = 0.f;
#pragma unroll
    for (int j = 0; j < 8; ++j) { v[j] = zp[64 * j]; s += (v[j].x + v[j].y) + (v[j].z + v[j].w); }
    const float mu = wave_sum(s) * (1.f / D); float s2 = 0.f;
#pragma unroll
    for (int j = 0; j < 8; ++j) { v[j].x -= mu; v[j].y -= mu; v[j].z -= mu; v[j].w -= mu; s2 += (v[j].x * v[j].x + v[j].y * v[j].y) + (v[j].z * v[j].z + v[j].w * v[j].w); }
    const float rstd = rsqrtf(wave_sum(s2) * (1.f / D) + LN_EPS);
    f4* o4 = (f4*)(of32 + (size_t)rowi * D) + lane; u2* o2 = (u2*)(obf + (size_t)rowi * D) + lane;
    const f4* gp = (const f4*)gam + lane; const f4* bp = (const f4*)bet + lane;
    float am = 0.f;
#pragma unroll
    for (int j = 0; j < 8; ++j) { const f4 g4 = gp[64 * j], b4 = bp[64 * j];
        const f4 o = mk_f4(v[j].x * rstd * g4.x + b4.x, v[j].y * rstd * g4.y + b4.y, v[j].z * rstd * g4.z + b4.z, v[j].w * rstd * g4.w + b4.w);
        o4[64 * j] = o; o2[64 * j] = mk_u2(pk2(o.x, o.y), pk2(o.z, o.w)); v[j] = o;
        am = fmaxf(am, fmaxf(fmaxf(fabsf(o.x), fabsf(o.y)), fmaxf(fabsf(o.z), fabsf(o.w)))); }
#pragma unroll
    for (int o = 1; o < 64; o <<= 1) am = fmaxf(am, __shfl_xor(am, o));
    const float sc = (am > 0.f) ? 127.f / am : 1.f;
    if (lane == 0) osc[rowi] = (am > 0.f) ? am * (1.f / 127.f) : 1.f;
    unsigned* qp = oq + (size_t)rowi * (D / 4) + lane;
#pragma unroll
    for (int j = 0; j < 8; ++j) { const int b0 = (int)rintf(v[j].x * sc), b1 = (int)rintf(v[j].y * sc), b2 = (int)rintf(v[j].z * sc), b3 = (int)rintf(v[j].w * sc);
        qp[64 * j] = (unsigned)(b0 & 0xff) | ((unsigned)(b1 & 0xff) << 8) | ((unsigned)(b2 & 0xff) << 16) | ((unsigned)b3 << 24); }
}

__device__ __forceinline__ float dot8_bf16(const u4& w, const float* x) {
    float f[8]; unpack8(w, f);
    return ((f[0] * x[0] + f[1] * x[1]) + (f[2] * x[2] + f[3] * x[3])) + ((f[4] * x[4] + f[5] * x[5]) + (f[6] * x[6] + f[7] * x[7]));
}
__device__ __forceinline__ void peer_load4(u4 (&R)[4][2], const unsigned char* __restrict__ TAB, const LAS int* pe, int grp, int lane) {
#pragma unroll
    for (int k = 0; k < 4; ++k) { const int e = __builtin_amdgcn_readfirstlane(pe[grp * 4 + k]); const u4* p = (const u4*)(TAB + (size_t)e * 2048) + lane; R[k][0] = p[0]; R[k][1] = p[64]; }
}
__device__ __forceinline__ float dot16_fp8(const u4& w, const float* x) {
    float s = 0.f;
#pragma unroll
    for (int q = 0; q < 4; ++q) { const f2 lo = __builtin_amdgcn_cvt_pk_f32_fp8((int)w[q], false), hi = __builtin_amdgcn_cvt_pk_f32_fp8((int)w[q], true);
        s += (lo.x * x[4 * q] + lo.y * x[4 * q + 1]) + (hi.x * x[4 * q + 2] + hi.y * x[4 * q + 3]); }
    return s;
}
__device__ __forceinline__ void peer_dot4(const u4 (&R)[4][2], const float (&xr)[32], const float* __restrict__ USC, const LAS int* pe, const LAS float* pw, const float* __restrict__ VSC, LAS float* hwp, int grp, int lane) {
    float d[4];
#pragma unroll
    for (int k = 0; k < 4; ++k) d[k] = dot16_fp8(R[k][0], xr) + dot16_fp8(R[k][1], xr + 16);
#pragma unroll
    for (int o = 1; o < 64; o <<= 1) {
#pragma unroll
        for (int k = 0; k < 4; ++k) d[k] += __shfl_xor(d[k], o); }
#pragma unroll
    for (int k = 0; k < 4; ++k) { const int e = __builtin_amdgcn_readfirstlane(pe[grp * 4 + k]);
        const float hv = pw[grp * 4 + k] * gelu_tanh(d[k] * USC[e]) * VSC[e];
        if (lane == 0) hwp[grp * 4 + k] = hv; }
}
__device__ __forceinline__ void peer_axpy4(const u4 (&R)[4][2], float (&acc)[32], const LAS float* hwp, int grp) {
#pragma unroll
    for (int k = 0; k < 4; ++k) { const float hw = hwp[grp * 4 + k];
#pragma unroll
        for (int j = 0; j < 2; ++j)
#pragma unroll
            for (int q = 0; q < 4; ++q) { const f2 lo = __builtin_amdgcn_cvt_pk_f32_fp8((int)R[k][j][q], false), hi = __builtin_amdgcn_cvt_pk_f32_fp8((int)R[k][j][q], true);
                acc[16 * j + 4 * q] += hw * lo.x; acc[16 * j + 4 * q + 1] += hw * lo.y; acc[16 * j + 4 * q + 2] += hw * hi.x; acc[16 * j + 4 * q + 3] += hw * hi.y; } }
}
__device__ __forceinline__ void unit_peer(const Params& P, unsigned char* ws, int l, LAS unsigned char* lds, int u, int tid_in, int lane_in, int wave, float* __restrict__ xout) {
    int tid = tid_in; asm volatile("" : "+v"(tid)); int lane = tid & 63;
    const int n0 = u * 32;
    const bf16* QPB = (const bf16*)(ws + WS_QP); int* SC = (int*)(ws + WS_SC);
    { const int h = wave, c = lane & 15, kq = lane >> 4;
#pragma unroll 1
        for (int half = 0; half < 2; ++half) {
            const bf16* kb = (const bf16*)(ws + WS_PKB) + ((size_t)(half * DEPTH + l) * 8 + h) * 16384;
            bf16x8 yq[2][4];
#pragma unroll
            for (int tt = 0; tt < 2; ++tt)
#pragma unroll
                for (int ks = 0; ks < 4; ++ks) yq[tt][ks] = *(const bf16x8*)(QPB + (size_t)(n0 + 16 * tt + c) * D + h * 256 + half * 128 + 32 * ks + 8 * kq);
            bf16x8 xk[4], xn_[4];
#pragma unroll
            for (int ks = 0; ks < 4; ++ks) xk[ks] = *(const bf16x8*)(kb + (size_t)c * 128 + 32 * ks + 8 * kq);
#pragma unroll 1
            for (int kt = 0; kt < 8; ++kt) {
                if (kt + 1 < 8) {
#pragma unroll
                    for (int ks = 0; ks < 4; ++ks) xn_[ks] = *(const bf16x8*)(kb + (size_t)(16 * (kt + 1) + c) * 128 + 32 * ks + 8 * kq); }
#pragma unroll
                for (int tt = 0; tt < 2; ++tt) { f4 a = mk_f4(0.f, 0.f, 0.f, 0.f);
#pragma unroll
                    for (int ks = 0; ks < 4; ++ks) a = MFMA16(xk[ks], yq[tt][ks], a);
                    int kk[4];
#pragma unroll
                    for (int i = 0; i < 4; ++i) { const int bits = __float_as_int(a[i]); const int sk = bits ^ ((bits >> 31) & 0x7fffffff); kk[i] = (sk & ~127) | (127 - (16 * kt + 4 * kq + i)); }
                    u4 w; w.x = (unsigned)kk[0]; w.y = (unsigned)kk[1]; w.z = (unsigned)kk[2]; w.w = (unsigned)kk[3];
                    *(u4*)(SC + ((size_t)(n0 + 16 * tt + c) * 16 + 2 * h + half) * 128 + 16 * kt + 4 * kq) = w; }
#pragma unroll
                for (int ks = 0; ks < 4; ++ks) xk[ks] = xn_[ks]; }
        } }
    VM_WAIT();
    __syncthreads();
    tid = tid_in; asm volatile("" : "+v"(tid)); lane = tid & 63;
    LAS int* TK = (LAS int*)lds;
    { const int tk = tid >> 4, hh = tid & 15;
        const u4* sp = (const u4*)(SC + ((size_t)(n0 + tk) * 16 + hh) * 128);
        int t[16];
#pragma unroll
        for (int k = 0; k < 16; ++k) t[k] = (int)0x80000000;
#pragma unroll 1
        for (int c4 = 0; c4 < 32; ++c4) { const u4 s4 = sp[c4];
#pragma unroll
            for (int e = 0; e < 4; ++e) { int x = (int)s4[e];
#pragma unroll
                for (int k = 0; k < 16; ++k) { const int hi_ = max(t[k], x); x = min(t[k], x); t[k] = hi_; } } }
#pragma unroll
        for (int k = 0; k < 16; ++k) TK[tid * 17 + k] = t[k]; }
    __syncthreads();
    tid = tid_in; asm volatile("" : "+v"(tid)); lane = tid & 63;
    LAS int* PE = (LAS int*)(lds + 69632);
    LAS float* PW = (LAS float*)(lds + 86016);
    if (tid < 256) { const int tk = tid >> 3, h = tid & 7; const int r1 = tk * 16 + 2 * h, r2 = r1 + 1;
        float v1[16], v2[16];
#pragma unroll
        for (int k = 0; k < 16; ++k) { const int k1 = TK[r1 * 17 + k] & ~127, k2 = TK[r2 * 17 + k] & ~127;
            v1[k] = __int_as_float(k1 ^ ((k1 >> 31) & 0x7fffffff)); v2[k] = __int_as_float(k2 ^ ((k2 >> 31) & 0x7fffffff)); }
        int t[16];
#pragma unroll
        for (int k = 0; k < 16; ++k) t[k] = (int)0x80000000;
#pragma unroll
        for (int a = 0; a < 16; ++a)
#pragma unroll
            for (int bq = 0; bq < 16; ++bq) if ((a + 1) * (bq + 1) <= 16) { const int bits = __float_as_int(v1[a] + v2[bq]); const int sk = bits ^ ((bits >> 31) & 0x7fffffff);
                int x = (sk & ~255) | (255 - (a * 16 + bq));
#pragma unroll
                for (int k = 0; k < 16; ++k) { const int hi_ = max(t[k], x); x = min(t[k], x); t[k] = hi_; } }
        float w[16], wsum = 0.f; const int kt0 = t[0] & ~255; const float top = __int_as_float(kt0 ^ ((kt0 >> 31) & 0x7fffffff));
#pragma unroll
        for (int k = 0; k < 16; ++k) { const int kk = t[k] & ~255; const float sv = __int_as_float(kk ^ ((kk >> 31) & 0x7fffffff)); w[k] = __expf(sv - top); wsum += w[k]; }
        const float inv = 1.f / wsum;
#pragma unroll
        for (int k = 0; k < 16; ++k) { const int ab = 255 - (t[k] & 255); const int a = ab >> 4, bq = ab & 15;
            const int i1 = 127 - (TK[r1 * 17 + a] & 127), i2 = 127 - (TK[r2 * 17 + bq] & 127);
            PE[tk * 128 + h * 16 + k] = i1 * 128 + i2; PW[tk * 128 + h * 16 + k] = w[k] * inv; } }
    __syncthreads();
    tid = tid_in; asm volatile("" : "+v"(tid)); lane = tid & 63;
    { int* FE = (int*)(ws + WS_FE) + (size_t)u * 16 * FCAP; float* FW = (float*)(ws + WS_FW) + (size_t)u * 16 * FCAP; int* GST = (int*)(ws + WS_GST) + (size_t)u * 16 * 64;
        LAS int* CNT = (LAS int*)(lds + 118784);
        LAS int* STA = (LAS int*)(lds + 120832);
#pragma unroll 1
        for (int it = 0; it < 4; ++it) { const int tk = wave * 4 + it;
            const int k0 = PE[tk * 128 + lane] >> BSH, k1 = PE[tk * 128 + 64 + lane] >> BSH; int mycnt = 0;
#pragma unroll
            for (int v = 0; v < NBKT; ++v) { const int c = __builtin_popcountll(__builtin_amdgcn_ballot_w64(k0 == v)) + __builtin_popcountll(__builtin_amdgcn_ballot_w64(k1 == v)); if (lane == v) mycnt = (c + PG - 1) & ~(PG - 1); }
            if (lane < NBKT) CNT[tk * 16 + lane] = mycnt; }
        __syncthreads();
        if (tid < NBKT) { int run = 0;
#pragma unroll 1
            for (int t = 0; t < 32; ++t) { STA[t * 16 + tid] = run; run += CNT[t * 16 + tid]; }
            STA[32 * 16 + tid] = run; }
        __syncthreads();
        for (int i = tid; i < NBKT * 33; i += 512) { const int bb = i / 33, t = i % 33; GST[bb * 64 + t] = STA[t * 16 + bb]; }
#pragma unroll 1
        for (int it = 0; it < 4; ++it) { const int tk = wave * 4 + it;
            const int e0 = PE[tk * 128 + lane], e1 = PE[tk * 128 + 64 + lane]; const float w0 = PW[tk * 128 + lane], w1 = PW[tk * 128 + 64 + lane];
            const int k0 = e0 >> BSH, k1 = e1 >> BSH; int pos0 = 0, pos1 = 0;
#pragma unroll
            for (int v = 0; v < NBKT; ++v) { const unsigned long long b0 = __builtin_amdgcn_ballot_w64(k0 == v), b1 = __builtin_amdgcn_ballot_w64(k1 == v);
                const int c0 = __builtin_popcountll(b0), c = c0 + __builtin_popcountll(b1), pc = (c + PG - 1) & ~(PG - 1); const int base = STA[tk * 16 + v];
                const int r0 = (int)__builtin_amdgcn_mbcnt_hi((unsigned)(b0 >> 32), __builtin_amdgcn_mbcnt_lo((unsigned)b0, 0u));
                const int r1 = c0 + (int)__builtin_amdgcn_mbcnt_hi((unsigned)(b1 >> 32), __builtin_amdgcn_mbcnt_lo((unsigned)b1, 0u));
                if (k0 == v) pos0 = v * FCAP + base + r0;
                if (k1 == v) pos1 = v * FCAP + base + r1;
                if (lane < pc - c) { FE[v * FCAP + base + c + lane] = v << BSH; FW[v * FCAP + base + c + lane] = 0.f; } }
            FE[pos0] = e0; FW[pos0] = w0; FE[pos1] = e1; FW[pos1] = w1; } }
    __syncthreads();
}

__device__ __forceinline__ void peer3_rows(u4 (&R)[PG][2], const unsigned char* __restrict__ TAB, int ev, int g, int lane) {
#pragma unroll
    for (int k = 0; k < PG; ++k) { const int e = __builtin_amdgcn_readlane(ev, PG * g + k); const unsigned char* rowp = TAB + (size_t)(unsigned)e * 2048u; R[k][0] = *(const u4*)(rowp + (unsigned)lane * 16u); R[k][1] = *(const u4*)(rowp + 1024u + (unsigned)lane * 16u); }
}
#define DPP_F(v, ctrl) __int_as_float(__builtin_amdgcn_update_dpp(0, __float_as_int(v), (ctrl), 0xf, 0xf, true))
__device__ __forceinline__ float wave_sum_dpp(float v) {
    v += DPP_F(v, 0xB1); v += DPP_F(v, 0x4E); v += DPP_F(v, 0x141); v += DPP_F(v, 0x140);
    const int iv = __float_as_int(v);
    return (__int_as_float(__builtin_amdgcn_readlane(iv, 0)) + __int_as_float(__builtin_amdgcn_readlane(iv, 16))) + (__int_as_float(__builtin_amdgcn_readlane(iv, 32)) + __int_as_float(__builtin_amdgcn_readlane(iv, 48)));
}
__device__ __forceinline__ float dot16_pk(const u4& w, const f2* x) {
    f2 a = {0.f, 0.f};
#pragma unroll
    for (int q = 0; q < 4; ++q) { const f2 lo = __builtin_amdgcn_cvt_pk_f32_fp8((int)w[q], false), hi = __builtin_amdgcn_cvt_pk_f32_fp8((int)w[q], true);
        a = __builtin_elementwise_fma(lo, x[2 * q], a); a = __builtin_elementwise_fma(hi, x[2 * q + 1], a); }
    return a.x + a.y;
}
__device__ __forceinline__ int wave_isum_dpp(int v) {
    v += __builtin_amdgcn_update_dpp(0, v, 0xB1, 0xf, 0xf, true); v += __builtin_amdgcn_update_dpp(0, v, 0x4E, 0xf, 0xf, true);
    v += __builtin_amdgcn_update_dpp(0, v, 0x141, 0xf, 0xf, true); v += __builtin_amdgcn_update_dpp(0, v, 0x140, 0xf, 0xf, true);
    return (__builtin_amdgcn_readlane(v, 0) + __builtin_amdgcn_readlane(v, 16)) + (__builtin_amdgcn_readlane(v, 32) + __builtin_amdgcn_readlane(v, 48));
}
__device__ __forceinline__ int wave_isum4_t(const int (&d)[4], int lane) {
    const bool o1 = lane & 1, o2 = lane & 2;
    int a = o1 ? d[1] : d[0], b = o1 ? d[0] : d[1], c = o1 ? d[3] : d[2], e = o1 ? d[2] : d[3];
    a += __builtin_amdgcn_update_dpp(0, b, 0xB1, 0xf, 0xf, true);
    c += __builtin_amdgcn_update_dpp(0, e, 0xB1, 0xf, 0xf, true);
    int f = o2 ? c : a, g = o2 ? a : c;
    f += __builtin_amdgcn_update_dpp(0, g, 0x4E, 0xf, 0xf, true);
    f += __builtin_amdgcn_update_dpp(0, f, 0x124, 0xf, 0xf, true);
    f += __builtin_amdgcn_update_dpp(0, f, 0x128, 0xf, 0xf, true);
    f += __shfl_xor(f, 16); f += __shfl_xor(f, 32);
    return f;
}
__device__ __forceinline__ void peer3_dots(const u4 (&R)[PG][2], const u4 (&xq)[2], int& dv, int g, int lane) {
    static_assert(PG == 4, "peer3_dots reduces four rows at a time");
    int d[4];
#pragma unroll
    for (int k = 0; k < 4; ++k) { int a = 0;
#pragma unroll
        for (int j = 0; j < 2; ++j)
#pragma unroll
            for (int q = 0; q < 4; ++q) a = __builtin_amdgcn_sdot4((int)R[k][j][q], (int)xq[j][q], a, false);
        d[k] = a; }
    const int t = wave_isum4_t(d, lane);
    dv = (lane >= 4 * g && lane < 4 * g + 4) ? t : dv;
}
__device__ __forceinline__ void peer3_axpy(const u4 (&R)[PG][2], f2 (&acc)[16], int hwv, int g) {
#pragma unroll
    for (int k = 0; k < PG; ++k) { const float hw = __int_as_float(__builtin_amdgcn_readlane(hwv, PG * g + k)); const f2 hw2 = {hw, hw};
#pragma unroll
        for (int j = 0; j < 2; ++j)
#pragma unroll
            for (int q = 0; q < 4; ++q) { const f2 lo = __builtin_amdgcn_cvt_pk_f32_fp8((int)R[k][j][q], false), hi = __builtin_amdgcn_cvt_pk_f32_fp8((int)R[k][j][q], true);
                acc[8 * j + 2 * q] = __builtin_elementwise_fma(lo, hw2, acc[8 * j + 2 * q]); acc[8 * j + 2 * q + 1] = __builtin_elementwise_fma(hi, hw2, acc[8 * j + 2 * q + 1]); }
        __builtin_amdgcn_sched_barrier(0); }
}
__device__ __forceinline__ void unpack_row(const u4 (&X)[4], f2 (&o)[16]) {
#pragma unroll
    for (int i = 0; i < 4; ++i) { o[4 * i].x = __uint_as_float(X[i].x << 16); o[4 * i].y = __uint_as_float(X[i].x & 0xffff0000u); o[4 * i + 1].x = __uint_as_float(X[i].y << 16); o[4 * i + 1].y = __uint_as_float(X[i].y & 0xffff0000u);
        o[4 * i + 2].x = __uint_as_float(X[i].z << 16); o[4 * i + 2].y = __uint_as_float(X[i].z & 0xffff0000u); o[4 * i + 3].x = __uint_as_float(X[i].w << 16); o[4 * i + 3].y = __uint_as_float(X[i].w & 0xffff0000u); }
}
__device__ __forceinline__ void peer3_rowload(u4 (&X)[4], const bf16* __restrict__ base, unsigned n, int lane) {
    const bf16* p = base + (n * (unsigned)D + (unsigned)(16 * lane));
    X[0] = *(const u4*)p; X[1] = *(const u4*)(p + 8); X[2] = *(const u4*)(p + 1024); X[3] = *(const u4*)(p + 1032);
}
__device__ __forceinline__ float wave_max_dpp(float v) {
    v = fmaxf(v, DPP_F(v, 0xB1)); v = fmaxf(v, DPP_F(v, 0x4E)); v = fmaxf(v, DPP_F(v, 0x141)); v = fmaxf(v, DPP_F(v, 0x140));
    const int iv = __float_as_int(v);
    return fmaxf(fmaxf(__int_as_float(__builtin_amdgcn_readlane(iv, 0)), __int_as_float(__builtin_amdgcn_readlane(iv, 16))), fmaxf(__int_as_float(__builtin_amdgcn_readlane(iv, 32)), __int_as_float(__builtin_amdgcn_readlane(iv, 48))));
}
__device__ __forceinline__ void peer3_rowstore(unsigned char* __restrict__ base, float* __restrict__ scl, unsigned n, int lane, const f2 (&acc)[16]) {
    float am = 0.f;
#pragma unroll
    for (int i = 0; i < 16; ++i) am = fmaxf(am, fmaxf(fabsf(acc[i].x), fabsf(acc[i].y)));
    am = wave_max_dpp(am);
    const float sc = (am > 0.f) ? 448.f / am : 1.f;
    if (lane == 0) scl[n] = (am > 0.f) ? am * (1.f / 448.f) : 0.f;
    unsigned char* p = base + ((size_t)n * 2048u + (unsigned)(16 * lane));
#pragma unroll
    for (int j = 0; j < 2; ++j) { u4 w;
#pragma unroll
        for (int q = 0; q < 4; ++q) { const f2 a = acc[8 * j + 2 * q], b = acc[8 * j + 2 * q + 1]; int r = __builtin_amdgcn_cvt_pk_fp8_f32(a.x * sc, a.y * sc, 0, false); r = __builtin_amdgcn_cvt_pk_fp8_f32(b.x * sc, b.y * sc, r, true); w[q] = (unsigned)r; }
        __builtin_nontemporal_store(w, (u4*)(p + 1024 * j)); }
}
__device__ __forceinline__ int peer3_next_nonempty(int gstv, int t) {
    while (t < 32 && __builtin_amdgcn_readlane(gstv, t + 1) == __builtin_amdgcn_readlane(gstv, t)) ++t;
    return t;
}
__device__ __forceinline__ void phase_peer_bucket(const Params& P, unsigned char* ws, int l, int bid, int G, int lane, int wave) {
    const int x = bid & 7, r = bid >> 3;
    const int u = r * 8 + wave; const unsigned nbase = (unsigned)u * 32u;
    const unsigned char* PU = ws + WS_PU + (size_t)l * 16384 * 2048; const unsigned char* PV = ws + WS_PV + (size_t)l * 16384 * 2048;
    const float* USC = (const float*)(ws + WS_PSC) + (size_t)l * 16384; const float* VSC = (const float*)(ws + WS_PSC) + (size_t)(DEPTH + l) * 16384;
    const bf16* X1B = (const bf16*)(ws + WS_X1B);
    static_assert(NRND == 1, "fp8 partials are written once: one round per workgroup");
    unsigned char* PART = ws + WS_PART + (size_t)x * NTOK * D; float* PSCL = (float*)(ws + WS_PSCL) + (size_t)x * NTOK;
#pragma unroll 1
    for (int rnd = 0; rnd < NRND; ++rnd) { const int xb = x + 8 * rnd;
        const int* FE = (const int*)(ws + WS_FE) + ((size_t)u * 16 + xb) * FCAP; const float* FW = (const float*)(ws + WS_FW) + ((size_t)u * 16 + xb) * FCAP; float* FHW = (float*)(ws + WS_FHW) + ((size_t)u * 16 + xb) * FCAP;
        int gstv = 0; if (lane <= 32) gstv = ((const int*)(ws + WS_GST))[((size_t)u * 16 + xb) * 64 + lane];
        const int total = __builtin_amdgcn_readlane(gstv, 32);
        REP(30) if (total > 0) {
            const unsigned char* X1Q = ws + WS_X1Q; const float* XSC = (const float*)(ws + WS_XSC);
            int tcur = peer3_next_nonempty(gstv, 0); int tnx = peer3_next_nonempty(gstv, tcur + 1); int tend = __builtin_amdgcn_readlane(gstv, tcur + 1);
            u4 xq[2], xn[2];
            { const unsigned char* p = X1Q + (size_t)(nbase + tcur) * 2048u + (unsigned)lane * 16u; xq[0] = __builtin_nontemporal_load((const u4*)p); xq[1] = __builtin_nontemporal_load((const u4*)(p + 1024)); }
            if (tnx < 32) { const unsigned char* p = X1Q + (size_t)(nbase + tnx) * 2048u + (unsigned)lane * 16u; xn[0] = __builtin_nontemporal_load((const u4*)p); xn[1] = __builtin_nontemporal_load((const u4*)(p + 1024)); }
            float xs = XSC[nbase + tcur];
#pragma unroll 1
            for (int blk = 0; blk < total; blk += 64) { const int blen = (total - blk) < 64 ? (total - blk) : 64, ng = blen / PG;
                int ev = 0; float wv = 0.f;
                if (lane < blen) { ev = __builtin_nontemporal_load(FE + blk + lane); wv = __builtin_nontemporal_load(FW + blk + lane); }
                const float us = USC[ev], vs = VSC[ev];
                int dv = 0; float xsv = 0.f; u4 A[PG][2], B[PG][2];
                peer3_rows(A, PU, ev, 0, lane);
#pragma unroll 1
                for (int g = 0; g < ng; g += 2) {
                    if (g + 1 < ng) peer3_rows(B, PU, ev, g + 1, lane);
                    if (blk + PG * g >= tend) { tcur = tnx; xq[0] = xn[0]; xq[1] = xn[1]; xs = XSC[nbase + tcur]; tend = __builtin_amdgcn_readlane(gstv, tcur + 1);
                        tnx = peer3_next_nonempty(gstv, tcur + 1); if (tnx < 32) { const unsigned char* p = X1Q + (size_t)(nbase + tnx) * 2048u + (unsigned)lane * 16u; xn[0] = __builtin_nontemporal_load((const u4*)p); xn[1] = __builtin_nontemporal_load((const u4*)(p + 1024)); } }
                    peer3_dots(A, xq, dv, g, lane);
                    xsv = (lane >= PG * g && lane < PG * g + PG) ? xs : xsv;
                    __builtin_amdgcn_sched_barrier(0);
                    if (g + 2 < ng) peer3_rows(A, PU, ev, g + 2, lane);
                    if (g + 1 < ng) {
                        if (blk + PG * (g + 1) >= tend) { tcur = tnx; xq[0] = xn[0]; xq[1] = xn[1]; xs = XSC[nbase + tcur]; tend = __builtin_amdgcn_readlane(gstv, tcur + 1);
                            tnx = peer3_next_nonempty(gstv, tcur + 1); if (tnx < 32) { const unsigned char* p = X1Q + (size_t)(nbase + tnx) * 2048u + (unsigned)lane * 16u; xn[0] = __builtin_nontemporal_load((const u4*)p); xn[1] = __builtin_nontemporal_load((const u4*)(p + 1024)); } }
                        peer3_dots(B, xq, dv, g + 1, lane);
                        xsv = (lane >= PG * (g + 1) && lane < PG * (g + 1) + PG) ? xs : xsv; }
                    __builtin_amdgcn_sched_barrier(0);
                }
                if (lane < blen) FHW[blk + lane] = wv * gelu_tanh((float)dv * us * xsv) * vs;
            } }
        VM_WAIT();
        REP(31) { f2 acc[16];
            if (rnd == 0) {
#pragma unroll
                for (int i = 0; i < 16; ++i) acc[i] = (f2){0.f, 0.f};
#pragma unroll 1
                for (int t = 0; t < 32; ++t) if (__builtin_amdgcn_readlane(gstv, t + 1) == __builtin_amdgcn_readlane(gstv, t)) peer3_rowstore(PART, PSCL, nbase + t, lane, acc); }
            if (total > 0) {
                int tcur = peer3_next_nonempty(gstv, 0); int tnx = peer3_next_nonempty(gstv, tcur + 1); int tend = __builtin_amdgcn_readlane(gstv, tcur + 1);
                {
#pragma unroll
                    for (int i = 0; i < 16; ++i) acc[i] = (f2){0.f, 0.f}; }
#pragma unroll 1
                for (int blk = 0; blk < total; blk += 64) { const int blen = (total - blk) < 64 ? (total - blk) : 64, ng = blen / PG;
                    int ev = 0, hwv = 0;
                    if (lane < blen) { ev = __builtin_nontemporal_load(FE + blk + lane); hwv = (int)__hip_atomic_load((const unsigned*)(FHW + blk + lane), __ATOMIC_RELAXED, __HIP_MEMORY_SCOPE_AGENT); }
                    u4 A[PG][2], B[PG][2];
                    peer3_rows(A, PV, ev, 0, lane);
#pragma unroll 1
                    for (int g = 0; g < ng; g += 2) {
                        if (g + 1 < ng) peer3_rows(B, PV, ev, g + 1, lane);
                        if (blk + PG * g >= tend) { peer3_rowstore(PART, PSCL, nbase + tcur, lane, acc); tcur = tnx; tend = __builtin_amdgcn_readlane(gstv, tcur + 1);
#pragma unroll
                            for (int i = 0; i < 16; ++i) acc[i] = (f2){0.f, 0.f};
                            tnx = peer3_next_nonempty(gstv, tcur + 1); }
                        peer3_axpy(A, acc, hwv, g);
                        __builtin_amdgcn_sched_barrier(0);
                        if (g + 2 < ng) peer3_rows(A, PV, ev, g + 2, lane);
                        if (g + 1 < ng) {
                            if (blk + PG * (g + 1) >= tend) { peer3_rowstore(PART, PSCL, nbase + tcur, lane, acc); tcur = tnx; tend = __builtin_amdgcn_readlane(gstv, tcur + 1);
#pragma unroll
                                for (int i = 0; i < 16; ++i) acc[i] = (f2){0.f, 0.f};
                                tnx = peer3_next_nonempty(gstv, tcur + 1); }
                            peer3_axpy(B, acc, hwv, g + 1); }
                        __builtin_amdgcn_sched_barrier(0);
                    } }
                peer3_rowstore(PART, PSCL, nbase + tcur, lane, acc);
            } }
        VM_WAIT();
    }
}
__device__ __forceinline__ void row_peer_reduce(const Params& P, unsigned char* ws, int l, int rowi, int lane, float* __restrict__ xout) {
    const size_t n = (size_t)rowi; const float* X1 = (const float*)(ws + WS_X1); const unsigned char* PARTQ = ws + WS_PART; const float* PSCL = (const float*)(ws + WS_PSCL);
    float acc[32];
#pragma unroll
    for (int j = 0; j < 2; ++j)
#pragma unroll
        for (int q = 0; q < 4; ++q) { const f4 a = *(const f4*)(X1 + n * D + 1024 * j + 16 * lane + 4 * q); acc[16 * j + 4 * q] = ALPHA * a.x; acc[16 * j + 4 * q + 1] = ALPHA * a.y; acc[16 * j + 4 * q + 2] = ALPHA * a.z; acc[16 * j + 4 * q + 3] = ALPHA * a.w; }
#pragma unroll 2
    for (int xb_ = 0; xb_ < 8; ++xb_) { const unsigned char* pp = PARTQ + ((size_t)xb_ * NTOK + n) * 2048u + (unsigned)(16 * lane); const float psc = PSCL[(size_t)xb_ * NTOK + n];
#pragma unroll
        for (int j = 0; j < 2; ++j) { const u4 a = *(const u4*)(pp + 1024 * j);
#pragma unroll
            for (int q = 0; q < 4; ++q) { const f2 lo = __builtin_amdgcn_cvt_pk_f32_fp8((int)a[q], false), hi = __builtin_amdgcn_cvt_pk_f32_fp8((int)a[q], true);
                acc[16 * j + 4 * q] += psc * lo.x; acc[16 * j + 4 * q + 1] += psc * lo.y; acc[16 * j + 4 * q + 2] += psc * hi.x; acc[16 * j + 4 * q + 3] += psc * hi.y; } } }
    float s = 0.f;
#pragma unroll
    for (int i = 0; i < 32; ++i) s += acc[i];
    const float mu = wave_sum(s) * (1.f / D); float s2 = 0.f;
#pragma unroll
    for (int i = 0; i < 32; ++i) { acc[i] -= mu; s2 += acc[i] * acc[i]; }
    const float rstd = rsqrtf(wave_sum(s2) * (1.f / D) + LN_EPS);
    const float* gam = P.in[23] + (size_t)l * D; const float* bet = P.in[24] + (size_t)l * D;
    bf16* xb = (bf16*)(ws + WS_XB);
#pragma unroll
    for (int j = 0; j < 2; ++j) { const int col = 1024 * j + 16 * lane; float o[16];
#pragma unroll
        for (int q = 0; q < 4; ++q) { const f4 g4 = *(const f4*)(gam + col + 4 * q), b4 = *(const f4*)(bet + col + 4 * q);
            o[4 * q] = acc[16 * j + 4 * q] * rstd * g4.x + b4.x; o[4 * q + 1] = acc[16 * j + 4 * q + 1] * rstd * g4.y + b4.y; o[4 * q + 2] = acc[16 * j + 4 * q + 2] * rstd * g4.z + b4.z; o[4 * q + 3] = acc[16 * j + 4 * q + 3] * rstd * g4.w + b4.w;
            *(f4*)(xout + n * D + col + 4 * q) = mk_f4(o[4 * q], o[4 * q + 1], o[4 * q + 2], o[4 * q + 3]); }
        u4 p0, p1; p0.x = pk2(o[0], o[1]); p0.y = pk2(o[2], o[3]); p0.z = pk2(o[4], o[5]); p0.w = pk2(o[6], o[7]); p1.x = pk2(o[8], o[9]); p1.y = pk2(o[10], o[11]); p1.z = pk2(o[12], o[13]); p1.w = pk2(o[14], o[15]);
        *(u4*)(xb + n * D + col) = p0; *(u4*)(xb + n * D + col + 8) = p1; }
}

template <class T> __device__ __forceinline__ T* uniform_ptr(T* p) { const unsigned long long v = (unsigned long long)p; const unsigned lo = __builtin_amdgcn_readfirstlane((unsigned)v), hi = __builtin_amdgcn_readfirstlane((unsigned)(v >> 32)); return (T*)(__attribute__((address_space(1))) T*)(((unsigned long long)hi << 32) | lo); }
constexpr int PH_PER_LAYER = 10, N_PHASES = 1 + DEPTH * PH_PER_LAYER;
#ifndef ONLY_PHASE
#define ONLY_PHASE -1
#endif
#define EN(i) (ONLY_PHASE < 0 || ONLY_PHASE == (i))
__global__ void __launch_bounds__(512, 2) mk_fwd(Params P) {
    extern __shared__ __attribute__((aligned(16))) unsigned char lds_raw[];
    LAS unsigned char* lds = (LAS unsigned char*)lds_raw;
    volatile LAS unsigned* MISC = (volatile LAS unsigned*)(lds + MISC_OFF);
    const int tid = threadIdx.x, lane = tid & 63, wave = __builtin_amdgcn_readfirstlane(tid >> 6);
    const int G = gridDim.x, bid = blockIdx.x;
    if (tid < 64) MISC[tid] = 0u;
    __syncthreads();
    unsigned char* const ws = uniform_ptr(P.ws);
    unsigned* ctl = (unsigned*)(ws + WS_CTL);
    const XcdBarrier bar = xcd_barrier_post(ctl + CW_BAR, MISC + 8);
    const int lo = P.ph_lo, hi = P.ph_hi;
#define IN(k) (lo <= (k) && (k) < hi)
#define LAUNDER() int tl; asm volatile("v_mbcnt_lo_u32_b32 %0, -1, 0\n\tv_mbcnt_hi_u32_b32 %0, -1, %0" : "=v"(tl)); tl |= (wave << 6); const int ll = tl & 63; const int wl = __builtin_amdgcn_readfirstlane(tl >> 6); (void)ll; (void)wl
#define SEAM(k) do { if (IN((k) + 1)) xcd_barrier(bar); } while (0)
    if (IN(0) && EN(20)) { LAUNDER(); REP(20) phase_prologue(P, ws, lds, tl, ll, wl); SEAM(0); }
    for (int l = 0; l < DEPTH; ++l) {
        const int pb = 1 + l * PH_PER_LAYER;
        const float* xres = (l == 0) ? P.in[0] : (const float*)(ws + WS_XC);
        float* xout = (l == DEPTH - 1) ? P.out : (float*)(ws + WS_XC);
        if (IN(pb + 0) && EN(0)) { LAUNDER();
            pg8::Gemm g{(const pg8::bf16_t*)(ws + WS_XB), (const pg8::bf16_t*)(ws + WS_WIN) + (size_t)l * INWP * D, NTOK, INWP, D};
            pg8::StaticOrder S; S.init(NTOK, INWP, G, bid);
            pg8::EpiH E{(pg8::bf16_t*)(ws + WS_H), INWP, 6, 10};
            REP(0) pg8::gemm_phase<pg8::EpiH, pg8::StaticOrder, true, true>(lds, g, S, E, tl);
            SEAM(pb + 0);
        }
        if (IN(pb + 1) && EN(1)) { LAUNDER();
            REP(1) for (int u = bid; u < 240; u += G) unit_kvstate_mfma(P, ws, lds, u, tl);
            REP(13) for (int u = bid; u < 256; u += G) unit_sgu_mfma(P, ws, l, lds, u, tl, ll, wl);
            REP(12) for (int u = bid; u < 256; u += G) unit_compress_mfma(P, ws, l, lds, u, tl);
            SEAM(pb + 1);
        }
        if (IN(pb + 2) && EN(2)) { LAUNDER();
            REP(10) for (int u = bid; u < 256; u += G) unit_retention_mfma(P, ws, l, lds, u, tl);
            REP(11) for (int u = bid; u < 512; u += G) unit_nsa(P, ws, l, lds, u, tl);
            SEAM(pb + 2);
        }
        if (IN(pb + 3) && EN(3)) { LAUNDER();
            REP(3) for (int r = bid * 8 + wl; r < NTOK; r += G * 8) row_mixnorm(P, ws, l, r, ll);
            SEAM(pb + 3);
        }
        if (IN(pb + 4) && EN(4)) { LAUNDER();
            pg8::Gemm g{(const pg8::bf16_t*)(ws + WS_MIXED), (const pg8::bf16_t*)(ws + WS_WOUT) + (size_t)l * D * D, NTOK, D, D};
            pg8::StaticOrder S; S.init(NTOK, D, G, bid);
            pg8::EpiRes E{(float*)(ws + WS_Z), xres, D, ALPHA};
            REP(4) pg8::gemm_phase<pg8::EpiRes, pg8::StaticOrder, true, true>(lds, g, S, E, tl);
            SEAM(pb + 4);
        }
        if (IN(pb + 5) && EN(5)) { LAUNDER();
            REP(5) for (int r = bid * 8 + wl; r < NTOK; r += G * 8) row_ln((const float*)(ws + WS_Z), P.in[16] + (size_t)l * D, P.in[17] + (size_t)l * D, (float*)(ws + WS_X1), (bf16*)(ws + WS_X1B), (unsigned*)(ws + WS_X1Q), (float*)(ws + WS_XSC), r, ll);
            SEAM(pb + 5);
        }
        if (IN(pb + 6) && EN(6)) { LAUNDER();
            pg8::Gemm g{(const pg8::bf16_t*)(ws + WS_X1B), (const pg8::bf16_t*)(ws + WS_WQ) + (size_t)l * D * D, NTOK, D, D};
            pg8::StaticOrder S; S.init(NTOK, D, G, bid);
            pg8::EpiH E{(pg8::bf16_t*)(ws + WS_QP), D, 0, 0};
            pg8::gemm_phase<pg8::EpiH, pg8::StaticOrder, true, true>(lds, g, S, E, tl);
            SEAM(pb + 6);
        }
        if (IN(pb + 7) && EN(7)) { LAUNDER();
            REP(7) for (int u = bid; u < NTOK / 32; u += G) unit_peer(P, ws, l, lds, u, tl, ll, wl, xout);
            SEAM(pb + 7);
        }
        if (IN(pb + 8) && EN(8)) { LAUNDER();
            REP(8) phase_peer_bucket(P, ws, l, bid, G, ll, wl);
            SEAM(pb + 8);
        }
        if (IN(pb + 9) && EN(9)) { LAUNDER();
            REP(9) for (int r = bid * 8 + wl; r < NTOK; r += G * 8) row_peer_reduce(P, ws, l, r, ll, xout);
            SEAM(pb + 9);
        }
    }
#undef IN
#undef SEAM
}

#ifndef MK_ONE_LAUNCH
#define MK_ONE_LAUNCH 1
#endif
extern "C" void kernel_launch(void* const* d_in, const int* in_sizes, int n_in, void* d_out, int out_size, void* d_ws, size_t ws_size, hipStream_t stream) {
    static int grid = 0;
    if (grid == 0) {
        if (n_in != 25 || out_size != NTOK * D || ws_size < WS_END) { fprintf(stderr, "kernel_launch: unexpected shapes: n_in %d out %d ws %zu (need %zu)\n", n_in, out_size, ws_size, (size_t)WS_END); grid = -1; return; }
        int dev = 0, cus = 0, per_cu = 0;
        if (hipGetDevice(&dev) != hipSuccess || hipDeviceGetAttribute(&cus, hipDeviceAttributeMultiprocessorCount, dev) != hipSuccess) { grid = -1; return; }
        if (hipFuncSetAttribute((const void*)mk_fwd, hipFuncAttributeMaxDynamicSharedMemorySize, LDS_BYTES) != hipSuccess) { fprintf(stderr, "kernel_launch: hipFuncSetAttribute failed\n"); grid = -1; return; }
        if (hipOccupancyMaxActiveBlocksPerMultiprocessor(&per_cu, (const void*)mk_fwd, 512, LDS_BYTES) != hipSuccess || per_cu < 1) fprintf(stderr, "kernel_launch: occupancy query says %d\n", per_cu);
        (void)hipGetLastError();
        grid = cus;
    }
    if (grid < 0) return;
    (void)hipMemsetAsync((char*)d_ws + WS_CTL, 0, CTL_ZERO_BYTES, stream);
    Params p{};
    for (int i = 0; i < 25; ++i) p.in[i] = (const float*)d_in[i];
    p.out = (float*)d_out; p.ws = (unsigned char*)d_ws;
    for (int i = 0; i < 32; ++i) p.inv_rev[i] = pow(10000.0, -(double)i / 32.0) / (2.0 * 3.14159265358979323846);
    for (int h = 0; h < 4; ++h) p.lg2[h] = (float)log2(1.0 - pow(2.0, -5.0 - (double)h));
#if MK_ONE_LAUNCH
    p.ph_lo = 0; p.ph_hi = N_PHASES; p.use_bar = 1;
    hipLaunchKernelGGL(mk_fwd, dim3(grid), dim3(512), LDS_BYTES, stream, p);
#else
    for (int k = 0; k < N_PHASES; ++k) { p.ph_lo = k; p.ph_hi = k + 1; p.use_bar = 0;
        hipLaunchKernelGGL(mk_fwd, dim3(grid), dim3(512), LDS_BYTES, stream, p); }
#endif
}
```

```cpp
#include <hip/hip_runtime.h>
#include <cstdio>
#include <cstdint>
#include <cmath>
#define LAS __attribute__((address_space(3)))
namespace pg8 {
#define PG8_LAS __attribute__((address_space(3)))
typedef unsigned short bf16_t;
typedef short bf16x8 __attribute__((ext_vector_type(8)));
typedef float f32x4 __attribute__((ext_vector_type(4)));
typedef unsigned u32x4 __attribute__((ext_vector_type(4)));
constexpr int BM = 256, BK = 64, HALF = 128, HTB = HALF * BK * 2  , STAGE_BYTES = 8 * HTB, NXCD = 8, WGM = 8;

__host__ __device__ __forceinline__ int lds_byte(int r, int c) { const int st = (r >> 4) * 2 + (c >> 5), rr = r & 15, cc = c & 31, ob = rr * 64 + cc * 2; return st * 1024 + (ob ^ (((ob >> 9) & 1) << 5)); }
__host__ __device__ __forceinline__ void stage_rc(int b, int& R, int& C) { const int st = b / 1024, sb = b % 1024, swz = sb ^ (((sb >> 9) & 1) << 5); R = (st >> 1) * 16 + swz / 64; C = (st & 1) * 32 + (swz % 64) / 2; }
__host__ __device__ __forceinline__ int perm32(int rho) { const int n = rho >> 4, i = rho & 15; return 8 * (i >> 2) + 4 * n + (i & 3); }

struct Unit { int pm, pn; };
struct Gemm { const bf16_t* A; const bf16_t* Bt; int M, N, K; };

struct StaticOrder {
    int nM, nN, nwg, G, c;
    __host__ __device__ void init(int M, int N, int G_, int c_) { nM = M / BM; nN = N / BM; nwg = nM * nN; G = G_; c = c_; }
    __host__ __device__ bool next(int i, Unit& u) const {
        const long L = (long)i * G + c; if (L >= nwg) return false;
        int wgid = (int)L; { const int q = nwg / NXCD, r = nwg % NXCD, xcd = wgid % NXCD, off = wgid / NXCD; wgid = (xcd < r ? xcd * (q + 1) : r * (q + 1) + (xcd - r) * q) + off; }
        const int nig = WGM * nN, gid = wgid / nig, fm = gid * WGM, gsz = (nM - fm) < WGM ? (nM - fm) : WGM;
        u.pm = fm + ((wgid % nig) % gsz); u.pn = (wgid % nig) / gsz; return true;
    }
    __device__ __forceinline__ void a_ready(const Unit&) const {}
    __device__ __forceinline__ void done(const Unit&) const {}
};
__device__ __forceinline__ unsigned cvt_pk_bf16(float lo, float hi) { unsigned r; asm volatile("v_cvt_pk_bf16_f32 %0, %1, %2" : "=v"(r) : "v"(lo), "v"(hi)); return r; }
typedef float f32x2 __attribute__((ext_vector_type(2)));
__device__ __forceinline__ float gelu_tanh_f(float x) {
    const float u = 1.5957691216057308f * (x + 0.044715f * x * x * x);
    return x * __builtin_amdgcn_rcpf(1.0f + __expf(-u));
}
struct EpiH {
    static constexpr bool PERM = true, AFTER_DRAIN = false;
    bf16_t* O; int ldc; int act_lo, act_hi;
    __device__ __forceinline__ void operator()(const f32x4 (&acc)[2][2][4][2], const Unit& u, int wr, int wc, int fr, int fq) const {
        const int row0 = u.pm * BM + wr * 64 + fr; const int col0 = u.pn * BM + wc * 32 + 8 * fq;
        const bool act = (u.pn >= act_lo) && (u.pn < act_hi);
#pragma unroll
        for (int ai = 0; ai < 2; ++ai)
#pragma unroll
            for (int m = 0; m < 4; ++m) { bf16_t* rowp = O + (size_t)(row0 + ai * HALF + m * 16) * ldc + col0;
#pragma unroll
                for (int bj = 0; bj < 2; ++bj) { f32x4 v0 = acc[ai][bj][m][0], v1 = acc[ai][bj][m][1];
                    if (act) {
#pragma unroll
                        for (int j = 0; j < 4; ++j) { v0[j] = gelu_tanh_f(v0[j]); v1[j] = gelu_tanh_f(v1[j]); } }
                    u32x4 w; w.x = cvt_pk_bf16(v0[0], v0[1]); w.y = cvt_pk_bf16(v0[2], v0[3]); w.z = cvt_pk_bf16(v1[0], v1[1]); w.w = cvt_pk_bf16(v1[2], v1[3]);
                    *(u32x4*)(rowp + bj * HALF) = w; } }
    }
};
struct EpiRes {
    static constexpr bool PERM = false, AFTER_DRAIN = false;
    float* C; const float* X; int ldc; float alpha;
    __device__ __forceinline__ void operator()(const f32x4 (&acc)[2][2][4][2], const Unit& u, int wr, int wc, int fr, int fq) const {
        const int row0 = u.pm * BM + wr * 64 + fr, col0 = u.pn * BM + wc * 32 + 4 * fq;
#pragma unroll
        for (int ai = 0; ai < 2; ++ai)
#pragma unroll
            for (int m = 0; m < 4; ++m) { const size_t off = (size_t)(row0 + ai * HALF + m * 16) * ldc + col0;
#pragma unroll
                for (int bj = 0; bj < 2; ++bj)
#pragma unroll
                    for (int n = 0; n < 2; ++n) { const size_t o2 = off + bj * HALF + n * 16; const f32x4 xv = *(const f32x4*)(X + o2); *(f32x4*)(C + o2) = acc[ai][bj][m][n] + xv * alpha; } }
    }
};
struct EpiResB {
    static constexpr bool PERM = true, AFTER_DRAIN = false;
    bf16_t* C; const bf16_t* X; int ldc; float alpha;
    __device__ __forceinline__ void operator()(const f32x4 (&acc)[2][2][4][2], const Unit& u, int wr, int wc, int fr, int fq) const {
        const int row0 = u.pm * BM + wr * 64 + fr; const int col0 = u.pn * BM + wc * 32 + 8 * fq;
#pragma unroll
        for (int ai = 0; ai < 2; ++ai)
#pragma unroll
            for (int m = 0; m < 4; ++m) { const size_t off = (size_t)(row0 + ai * HALF + m * 16) * ldc + col0;
#pragma unroll
                for (int bj = 0; bj < 2; ++bj) { const f32x4 v0 = acc[ai][bj][m][0], v1 = acc[ai][bj][m][1]; const u32x4 xw = *(const u32x4*)(X + off + bj * HALF);
                    u32x4 w;
                    w.x = cvt_pk_bf16(v0[0] + alpha * __uint_as_float(xw.x << 16), v0[1] + alpha * __uint_as_float(xw.x & 0xffff0000u));
                    w.y = cvt_pk_bf16(v0[2] + alpha * __uint_as_float(xw.y << 16), v0[3] + alpha * __uint_as_float(xw.y & 0xffff0000u));
                    w.z = cvt_pk_bf16(v1[0] + alpha * __uint_as_float(xw.z << 16), v1[1] + alpha * __uint_as_float(xw.z & 0xffff0000u));
                    w.w = cvt_pk_bf16(v1[2] + alpha * __uint_as_float(xw.w << 16), v1[3] + alpha * __uint_as_float(xw.w & 0xffff0000u));
                    *(u32x4*)(C + off + bj * HALF) = w; } }
    }
};
typedef _Float16 f16x2_e __attribute__((ext_vector_type(2)));
typedef float f32x2_e __attribute__((ext_vector_type(2)));
__device__ __forceinline__ unsigned cvt_pk_f16(float lo, float hi) { f32x2_e v; v.x = lo; v.y = hi; return __builtin_bit_cast(unsigned, __builtin_convertvector(v, f16x2_e)); }
struct EpiF16 {
    static constexpr bool PERM = true, AFTER_DRAIN = false;
    unsigned short* C; int ldc;
    __device__ __forceinline__ void operator()(const f32x4 (&acc)[2][2][4][2], const Unit& u, int wr, int wc, int fr, int fq) const {
        const int row0 = u.pm * BM + wr * 64 + fr; const int col0 = u.pn * BM + wc * 32 + 8 * fq;
#pragma unroll
        for (int ai = 0; ai < 2; ++ai)
#pragma unroll
            for (int m = 0; m < 4; ++m) { unsigned short* rowp = C + (size_t)(row0 + ai * HALF + m * 16) * ldc + col0;
#pragma unroll
                for (int bj = 0; bj < 2; ++bj) { const f32x4 v0 = acc[ai][bj][m][0], v1 = acc[ai][bj][m][1];
                    u32x4 w; w.x = cvt_pk_f16(v0[0], v0[1]); w.y = cvt_pk_f16(v0[2], v0[3]); w.z = cvt_pk_f16(v1[0], v1[1]); w.w = cvt_pk_f16(v1[2], v1[3]);
                    *(u32x4*)(rowp + bj * HALF) = w; } }
    }
};
struct EpiF32 {
    static constexpr bool PERM = false, AFTER_DRAIN = false;
    float* C; int ldc;
    __device__ __forceinline__ void operator()(const f32x4 (&acc)[2][2][4][2], const Unit& u, int wr, int wc, int fr, int fq) const {
        const int row0 = u.pm * BM + wr * 64 + fr, col0 = u.pn * BM + wc * 32 + 4 * fq;
#pragma unroll
        for (int ai = 0; ai < 2; ++ai)
#pragma unroll
            for (int m = 0; m < 4; ++m) { float* rowp = C + (size_t)(row0 + ai * HALF + m * 16) * ldc + col0;
#pragma unroll
                for (int bj = 0; bj < 2; ++bj)
#pragma unroll
                    for (int n = 0; n < 2; ++n) *(f32x4*)(rowp + bj * HALF + n * 16) = acc[ai][bj][m][n]; }
    }
};
template <class Epi, class Sched, bool ALIGN_EPI = false, bool SP2 = false>
__device__ __forceinline__ void gemm_phase(PG8_LAS unsigned char* lds, const Gemm g, const Sched& S, const Epi& E, const int tid) {
    const int wid = __builtin_amdgcn_readfirstlane(tid >> 6), lane = tid & 63, wr = wid >> 2, wc = wid & 3, fr = lane & 15, fq = lane >> 4;
    const int K = g.K, nt = K / BK;
    unsigned voffA[2], voffB[2];
#pragma unroll
    for (int i = 0; i < 2; ++i) { int R, C; stage_rc(tid * 16 + i * 8192, R, C); const int Rb = Epi::PERM ? ((R & ~31) + perm32(R & 31)) : R;
        voffA[i] = (unsigned)(R * K + C) * 2u; voffB[i] = (unsigned)(Rb * K + C) * 2u; }
    const size_t kstep = (size_t)(BK * 2);
    const size_t hstep = (size_t)HALF * K * 2;
    const size_t tstep = 2 * hstep;
    const unsigned ldsw = (unsigned)wid * 1024u;
    const int aoff = lds_byte(wr * 64 + fr, fq * 8), boff = lds_byte(wc * 32 + fr, fq * 8);
#define PG8_SA(b, h) (((b) * 2 + (h)) * HTB)
#define PG8_SB(b, h) ((4 + (b) * 2 + (h)) * HTB)
#define PG8_STAGE(bufoff, gbase, voff) do { _Pragma("unroll") for (int _i = 0; _i < 2; ++_i) \
        __builtin_amdgcn_global_load_lds((const unsigned*)((const char*)(gbase) + (voff)[_i]), (PG8_LAS unsigned*)(lds + (bufoff) + ldsw + _i * 8192), 16, 0, 0); } while (0)
#define PG8_LDA(dst, b, h) do { _Pragma("unroll") for (int m = 0; m < 4; ++m) _Pragma("unroll") for (int k = 0; k < 2; ++k) dst[m][k] = *(const PG8_LAS bf16x8*)(lds + PG8_SA(b, h) + aoff + m * 2048 + k * 1024); } while (0)
#define PG8_LDB(dst, b, h) do { _Pragma("unroll") for (int n = 0; n < 2; ++n) _Pragma("unroll") for (int k = 0; k < 2; ++k) dst[n][k] = *(const PG8_LAS bf16x8*)(lds + PG8_SB(b, h) + boff + n * 2048 + k * 1024); } while (0)
#define PG8_MMA(ai, bj, At, Bt) do { __builtin_amdgcn_s_setprio(1); _Pragma("unroll") for (int m = 0; m < 4; ++m) _Pragma("unroll") for (int n = 0; n < 2; ++n) _Pragma("unroll") for (int k = 0; k < 2; ++k) \
        acc[ai][bj][m][n] = __builtin_amdgcn_mfma_f32_16x16x32_bf16(Bt[n][k], At[m][k], acc[ai][bj][m][n], 0, 0, 0); __builtin_amdgcn_s_setprio(0); } while (0)
#define PG8_WAIT_V(n) asm volatile("s_waitcnt vmcnt(" #n ")" ::: "memory")
#define PG8_WAIT_L(n) asm volatile("s_waitcnt lgkmcnt(" #n ")" ::: "memory")
#define PG8_BAR __builtin_amdgcn_s_barrier()
#define PG8_SCHED __builtin_amdgcn_sched_barrier(0)
    Unit cur, nxt; int ui = 0;
    if (!S.next(0, cur)) return;
    f32x4 acc[2][2][4][2];
#pragma unroll
    for (int a = 0; a < 2; ++a)
#pragma unroll
        for (int b = 0; b < 2; ++b)
#pragma unroll
            for (int m = 0; m < 4; ++m)
#pragma unroll
                for (int n = 0; n < 2; ++n) acc[a][b][m][n] = (f32x4){0.f, 0.f, 0.f, 0.f};
    bf16x8 At[4][2], B0[2][2], B1[2][2];
    const char* cA = (const char*)g.A + (size_t)cur.pm * tstep; const char* cB = (const char*)g.Bt + (size_t)cur.pn * tstep;
    S.a_ready(cur);
    if constexpr (SP2) {
        PG8_STAGE(PG8_SB(0, 0), cB, voffB); PG8_STAGE(PG8_SB(0, 1), cB + hstep, voffB); PG8_STAGE(PG8_SA(0, 0), cA, voffA); PG8_STAGE(PG8_SA(0, 1), cA + hstep, voffA);
        if (wr == 1) PG8_BAR;
        PG8_WAIT_V(2); PG8_BAR;
        PG8_STAGE(PG8_SB(1, 0), cB + kstep, voffB); PG8_STAGE(PG8_SA(1, 0), cA + kstep, voffA); PG8_STAGE(PG8_SB(1, 1), cB + hstep + kstep, voffB);
        PG8_WAIT_V(6); PG8_BAR;
    } else {
        PG8_STAGE(PG8_SB(0, 0), cB, voffB); PG8_STAGE(PG8_SA(0, 0), cA, voffA); PG8_STAGE(PG8_SB(0, 1), cB + hstep, voffB); PG8_STAGE(PG8_SA(0, 1), cA + hstep, voffA);
        if (wr == 1) PG8_BAR;
        PG8_WAIT_V(4); PG8_BAR;
        PG8_STAGE(PG8_SB(1, 0), cB + kstep, voffB); PG8_STAGE(PG8_SA(1, 0), cA + kstep, voffA); PG8_STAGE(PG8_SB(1, 1), cB + hstep + kstep, voffB);
        PG8_WAIT_V(6); PG8_BAR;
    }
    for (;;) {
        const bool has_next = S.next(ui + 1, nxt);
        const char* nA = has_next ? (const char*)g.A + (size_t)nxt.pm * tstep : cA; const char* nB = has_next ? (const char*)g.Bt + (size_t)nxt.pn * tstep : cB;
        for (int t = 0; t < nt; t += 2) {
            const bool last = (t == nt - 2);
            const char* a1 = cA + (size_t)(t + 1) * kstep;
            const char* a2 = last ? nA : cA + (size_t)(t + 2) * kstep; const char* b2 = last ? nB : cB + (size_t)(t + 2) * kstep;
            const char* a3 = a2 + kstep; const char* b3 = b2 + kstep;
            if (last && has_next) S.a_ready(nxt);
            if constexpr (SP2) {
            PG8_LDB(B0, 0, 0); PG8_LDB(B1, 0, 1); PG8_SCHED; PG8_LDA(At, 0, 0); PG8_STAGE(PG8_SA(1, 1), a1 + hstep, voffA);
            PG8_WAIT_V(8); PG8_WAIT_L(0); PG8_BAR; PG8_MMA(0, 0, At, B0); PG8_MMA(0, 1, At, B1); PG8_BAR; PG8_SCHED;
            PG8_LDA(At, 0, 1); PG8_STAGE(PG8_SB(0, 0), b2, voffB); PG8_STAGE(PG8_SB(0, 1), b2 + hstep, voffB); PG8_STAGE(PG8_SA(0, 0), a2, voffA);
            PG8_WAIT_V(8); PG8_WAIT_L(0); PG8_BAR; PG8_MMA(1, 0, At, B0); PG8_MMA(1, 1, At, B1); PG8_BAR; PG8_SCHED;
            PG8_LDB(B0, 1, 0); PG8_LDB(B1, 1, 1); PG8_SCHED; PG8_LDA(At, 1, 0); PG8_STAGE(PG8_SA(0, 1), a2 + hstep, voffA);
            PG8_WAIT_V(8); PG8_WAIT_L(0); PG8_BAR; PG8_MMA(0, 0, At, B0); PG8_MMA(0, 1, At, B1); PG8_BAR; PG8_SCHED;
            PG8_LDA(At, 1, 1); PG8_STAGE(PG8_SB(1, 0), b3, voffB); PG8_STAGE(PG8_SB(1, 1), b3 + hstep, voffB); PG8_STAGE(PG8_SA(1, 0), a3, voffA);
            PG8_WAIT_V(8); PG8_WAIT_L(0); PG8_BAR; PG8_MMA(1, 0, At, B0); PG8_MMA(1, 1, At, B1); PG8_BAR; PG8_SCHED;
            } else {
            PG8_LDB(B0, 0, 0); PG8_SCHED; PG8_LDA(At, 0, 0); PG8_STAGE(PG8_SA(1, 1), a1 + hstep, voffA);
            PG8_WAIT_L(8); PG8_BAR; PG8_WAIT_L(0); PG8_MMA(0, 0, At, B0); PG8_BAR; PG8_SCHED;
            PG8_LDB(B1, 0, 1); PG8_STAGE(PG8_SB(0, 0), b2, voffB);
            PG8_BAR; PG8_WAIT_L(0); PG8_MMA(0, 1, At, B1); PG8_BAR;
            PG8_LDA(At, 0, 1); PG8_STAGE(PG8_SA(0, 0), a2, voffA);
            PG8_BAR; PG8_WAIT_L(0); PG8_MMA(1, 0, At, B0); PG8_BAR; PG8_SCHED;
            PG8_STAGE(PG8_SB(0, 1), b2 + hstep, voffB);
            PG8_WAIT_V(6); PG8_BAR; PG8_MMA(1, 1, At, B1); PG8_BAR;
            PG8_LDB(B0, 1, 0); PG8_SCHED; PG8_LDA(At, 1, 0); PG8_STAGE(PG8_SA(0, 1), a2 + hstep, voffA);
            PG8_WAIT_L(8); PG8_BAR; PG8_WAIT_L(0); PG8_MMA(0, 0, At, B0); PG8_BAR; PG8_SCHED;
            PG8_LDB(B1, 1, 1); PG8_STAGE(PG8_SB(1, 0), b3, voffB);
            PG8_BAR; PG8_WAIT_L(0); PG8_MMA(0, 1, At, B1); PG8_BAR;
            PG8_LDA(At, 1, 1); PG8_STAGE(PG8_SA(1, 0), a3, voffA);
            PG8_BAR; PG8_WAIT_L(0); PG8_MMA(1, 0, At, B0); PG8_BAR; PG8_SCHED;
            PG8_STAGE(PG8_SB(1, 1), b3 + hstep, voffB);
            PG8_WAIT_V(6); PG8_BAR; PG8_MMA(1, 1, At, B1); PG8_BAR;
            }
        }
        if constexpr (ALIGN_EPI) { if (wr == 0) PG8_BAR; }
        if constexpr (!Epi::AFTER_DRAIN) { E(acc, cur, wr, wc, fr, fq); S.done(cur); }
        if (!has_next) break;
#pragma unroll
        for (int a = 0; a < 2; ++a)
#pragma unroll
            for (int b = 0; b < 2; ++b)
#pragma unroll
                for (int m = 0; m < 4; ++m)
#pragma unroll
                    for (int n = 0; n < 2; ++n) acc[a][b][m][n] = (f32x4){0.f, 0.f, 0.f, 0.f};
        cur = nxt; cA = nA; cB = nB; ++ui;
        if constexpr (ALIGN_EPI) { if (wr == 1) PG8_BAR; }
    }
    PG8_WAIT_V(0);
    if constexpr (!ALIGN_EPI) { if (wr == 0) PG8_BAR; }
    PG8_BAR;
    if constexpr (Epi::AFTER_DRAIN) { E.fused(acc, cur, wr, wc, fr, fq, lds, wid, lane); S.done(cur); }
#undef PG8_SA
#undef PG8_SB
#undef PG8_STAGE
#undef PG8_LDA
#undef PG8_LDB
#undef PG8_MMA
#undef PG8_WAIT_V
#undef PG8_WAIT_L
#undef PG8_BAR
#undef PG8_SCHED
}
}
#define XB_TMO      128
#define XB_XCNT(j)  (256  + 64 * (j))
#define XB_XSUB(j)  (1280 + 64 * (j))
#define XB_XGEN(j)  (2304 + 64 * (j))
#define XB_TOP      3328
#define XB_TOPGEN   3392
#define XCD_BAR_WORDS 3456
#define XB_SPIN_CAP (1u << 18)

__device__ __forceinline__ unsigned xb_ld(unsigned* p)              { return __hip_atomic_load(p, __ATOMIC_RELAXED, __HIP_MEMORY_SCOPE_AGENT); }
__device__ __forceinline__ unsigned xb_add(unsigned* p, unsigned v) { return __hip_atomic_fetch_add(p, v, __ATOMIC_RELAXED, __HIP_MEMORY_SCOPE_AGENT); }
__device__ __forceinline__ unsigned xb_xcc_id() { return (unsigned)__builtin_amdgcn_s_getreg((3 << 11) | 20) & 0xFu; }
#define XB_SPIN(cond, bar) do { unsigned _sp = 0; while (cond) { __builtin_amdgcn_s_sleep(1); \
    if ((++_sp & 255u) == 0u) { if (xb_ld(&(bar)[XB_TMO])) break; if (_sp > XB_SPIN_CAP) { atomicAdd(&(bar)[XB_TMO], 1u); break; } } } } while (0)

struct XcdBarrier {
    unsigned* bar; unsigned x; unsigned w0;
    volatile LAS unsigned* st;
};

__device__ __forceinline__ bool xb_tid0(unsigned w0) { return w0 != 0u && __builtin_amdgcn_mbcnt_hi(0xffffffffu, __builtin_amdgcn_mbcnt_lo(0xffffffffu, 0u)) == 0u; }
__device__ __forceinline__ XcdBarrier xcd_barrier_post(unsigned* bar, volatile LAS unsigned* st) {
    XcdBarrier b; b.bar = bar; b.x = xb_xcc_id(); b.st = st; b.w0 = (__builtin_amdgcn_readfirstlane(threadIdx.x >> 6) == 0) ? 1u : 0u;
    if (threadIdx.x == 0) (void)xb_add(&bar[XB_XCNT(b.x)], 1u);
    return b;
}
__device__ __forceinline__ void xcd_barrier_complete(unsigned* bar, unsigned x, unsigned& nloc, unsigned& nx) {
    const unsigned G = gridDim.x * gridDim.y * gridDim.z;
    unsigned sum, cnt, mine, sp = 0u;
    for (;;) {
        sum = 0u; cnt = 0u; mine = 0u;
#pragma unroll
        for (unsigned j = 0; j < 16; ++j) { const unsigned c = xb_ld(&bar[XB_XCNT(j)]); sum += c; cnt += (c > 0u) ? 1u : 0u; mine = (j == x) ? c : mine; }
        if (sum == G) break;
        __builtin_amdgcn_s_sleep(1);
        if ((++sp & 255u) == 0u) { if (xb_ld(&bar[XB_TMO])) break; if (sp > XB_SPIN_CAP) { atomicAdd(&bar[XB_TMO], 1u); break; } }
    }
    nloc = mine > 0u ? mine : 1u; nx = cnt > 0u ? cnt : 1u;
}

__device__ __forceinline__ void xcd_barrier(const XcdBarrier& b) {
    asm volatile("s_waitcnt vmcnt(0)" ::: "memory");
    __syncthreads();
    if (xb_tid0(b.w0)) {
        unsigned* bar = b.bar;
        __builtin_amdgcn_s_waitcnt(0);
        unsigned nloc = b.st[0], nx = b.st[1];
        if (nloc == 0u) { xcd_barrier_complete(bar, b.x, nloc, nx); b.st[0] = nloc; b.st[1] = nx; }
        const unsigned old = xb_add(&bar[XB_XSUB(b.x)], 1u);
        const unsigned gen = old / nloc;
        if (old + 1u == (gen + 1u) * nloc) {
            __builtin_amdgcn_fence(__ATOMIC_RELEASE, "agent");
            asm volatile("s_waitcnt vmcnt(0)" ::: "memory");
            const unsigned og = xb_add(&bar[XB_TOP], 1u);
            const unsigned tg = og / nx;
            if (og + 1u == (tg + 1u) * nx) xb_add(&bar[XB_TOPGEN], 1u);
            else XB_SPIN(xb_ld(&bar[XB_TOPGEN]) == tg, bar);
            __builtin_amdgcn_fence(__ATOMIC_ACQUIRE, "agent");
            xb_add(&bar[XB_XGEN(b.x)], 1u);
            asm volatile("s_waitcnt vmcnt(0)" ::: "memory");
        } else {
            XB_SPIN(xb_ld(&bar[XB_XGEN(b.x)]) == gen, bar);
            __builtin_amdgcn_fence(__ATOMIC_ACQUIRE, "agent");
            asm volatile("s_waitcnt vmcnt(0)" ::: "memory");
        }
    }
    __syncthreads();
}

#ifndef PROBE_DUP
#define PROBE_DUP -1
#endif
#define REP(i) for (int rep_ = 0; rep_ < ((PROBE_DUP == (i)) ? 2 : 1); ++rep_)
constexpr int NB = 4, T = 2048, D = 2048, NTOK = NB * T, DEPTH = 4;
constexpr int INW = 5168, INWP = 5376;
constexpr int C_RQ = 0, C_RK = 256, C_RV = 512, C_RG = 1024, C_SU = 1536, C_SV = 2048, C_NQ = 2560, C_KC = 3584, C_VC = 3840, C_KS = 4096, C_VS = 4352, C_KW = 4608, C_VW = 4864, C_NG = 5120;
constexpr float ALPHA = 1.6817928305074290f;
constexpr float LN_EPS = 1e-5f;
constexpr float LOG2E = 1.4426950408889634f;

constexpr size_t MiB = (size_t)1 << 20;
constexpr size_t WS_CTL = 0, CTL_ZERO_BYTES = 64 * 1024;
constexpr size_t WS_ROPE = 1 * MiB;
constexpr size_t WS_WIN = 2 * MiB;
constexpr size_t WS_WOUT = 86 * MiB;
constexpr size_t WS_WQ = 118 * MiB;
constexpr size_t WS_PU = 160 * MiB;
constexpr size_t WS_PV = 416 * MiB;
constexpr size_t WS_H = 672 * MiB;
constexpr size_t WS_YMIX = 756 * MiB;
constexpr size_t YB_SEL = (size_t)16 * 1024 * 1024, YB_WIN = (size_t)160 * 1024 * 1024;
constexpr size_t WS_YSG = 1108 * MiB;
constexpr size_t WS_MIXED = 820 * MiB;
constexpr size_t WS_Z = 852 * MiB;
constexpr size_t WS_X1 = 916 * MiB;
constexpr size_t WS_X1B = 980 * MiB;
constexpr size_t WS_QP = 1012 * MiB;
constexpr size_t WS_XC = 1076 * MiB;
constexpr size_t WS_XB = 1140 * MiB;
constexpr size_t WS_KC = 1172 * MiB;
constexpr size_t WS_KVST = 1174 * MiB;
constexpr size_t WS_SC = 1184 * MiB;
constexpr size_t WS_PSC = 1248 * MiB;
constexpr size_t WS_W1T = 1250 * MiB;
constexpr size_t WS_W2T = 1258 * MiB;
constexpr size_t WS_PKB = 1260 * MiB;
#ifndef PEER_NBKT
#define PEER_NBKT 8
#endif
#ifndef PEER_PG
#define PEER_PG 4
#endif
constexpr int PG = PEER_PG;
constexpr int NBKT = PEER_NBKT, NRND = NBKT / 8, FCAP = 4096, BSH = (NBKT == 16) ? 10 : 11;
constexpr size_t WS_FE = 1262 * MiB;
constexpr size_t WS_FW = 1326 * MiB;
constexpr size_t WS_FHW = 1390 * MiB;
constexpr size_t WS_GST = 1454 * MiB;
constexpr size_t WS_PART = 1456 * MiB;
constexpr size_t WS_PSCL = 1600 * MiB;
constexpr size_t WS_X1Q = 1712 * MiB;
constexpr size_t WS_XSC = 1728 * MiB;
constexpr size_t WS_END = 1730 * MiB;
constexpr int CW_BAR = 4096;
static_assert((CW_BAR + XCD_BAR_WORDS) * 4 <= (int)CTL_ZERO_BYTES, "barrier words inside the zeroed region");

constexpr int LDS_BYTES = 147456;
constexpr int MISC_OFF = 143360;

#define GAS __attribute__((address_space(1)))
typedef float f4 __attribute__((ext_vector_type(4)));
typedef float f2 __attribute__((ext_vector_type(2)));
typedef unsigned u4 __attribute__((ext_vector_type(4)));
typedef unsigned u2 __attribute__((ext_vector_type(2)));
__device__ __forceinline__ f4 mk_f4(float a, float b, float c, float d) { f4 r; r.x = a; r.y = b; r.z = c; r.w = d; return r; }
__device__ __forceinline__ f2 mk_f2(float a, float b) { f2 r; r.x = a; r.y = b; return r; }
__device__ __forceinline__ u2 mk_u2(unsigned a, unsigned b) { u2 r; r.x = a; r.y = b; return r; }
typedef unsigned short bf16;
#define LDS_WAIT() asm volatile("s_waitcnt lgkmcnt(0)" ::: "memory")
#define VM_WAIT() asm volatile("s_waitcnt vmcnt(0)" ::: "memory")

struct Params {
    const float* in[25];
    float* out;
    unsigned char* ws;
    double inv_rev[32];
    float lg2[4];
    int ph_lo, ph_hi, use_bar, pad0;
};

__device__ __forceinline__ float bf2f(unsigned short b) { return __uint_as_float(((unsigned)b) << 16); }
__device__ __forceinline__ unsigned f2bf(float f) { unsigned u = __float_as_uint(f); return (u + 0x7fffu + ((u >> 16) & 1u)) >> 16; }
typedef unsigned u2v_t __attribute__((ext_vector_type(2)));
__device__ __forceinline__ float x16_sum(float x) { const u2v_t r = __builtin_amdgcn_permlane16_swap(__float_as_uint(x), __float_as_uint(x), false, false); return __uint_as_float(r.x) + __uint_as_float(r.y); }
__device__ __forceinline__ float x32_sum(float x) { const u2v_t r = __builtin_amdgcn_permlane32_swap(__float_as_uint(x), __float_as_uint(x), false, false); return __uint_as_float(r.x) + __uint_as_float(r.y); }
__device__ __forceinline__ float x16_max(float x) { const u2v_t r = __builtin_amdgcn_permlane16_swap(__float_as_uint(x), __float_as_uint(x), false, false); return fmaxf(__uint_as_float(r.x), __uint_as_float(r.y)); }
__device__ __forceinline__ float x32_max(float x) { const u2v_t r = __builtin_amdgcn_permlane32_swap(__float_as_uint(x), __float_as_uint(x), false, false); return fmaxf(__uint_as_float(r.x), __uint_as_float(r.y)); }
__device__ __forceinline__ float wave_sum(float v) {
#pragma unroll
    for (int o = 1; o < 16; o <<= 1) v += __shfl_xor(v, o);
    return x32_sum(x16_sum(v));
}
__device__ __forceinline__ void unpack8(const u4& v, float* f) {
    f[0] = __uint_as_float(v.x << 16); f[1] = __uint_as_float(v.x & 0xffff0000u);
    f[2] = __uint_as_float(v.y << 16); f[3] = __uint_as_float(v.y & 0xffff0000u);
    f[4] = __uint_as_float(v.z << 16); f[5] = __uint_as_float(v.z & 0xffff0000u);
    f[6] = __uint_as_float(v.w << 16); f[7] = __uint_as_float(v.w & 0xffff0000u);
}
__device__ __forceinline__ float gelu_tanh(float x) { return pg8::gelu_tanh_f(x); }
typedef pg8::bf16x8 bf16x8;
typedef short s16x4 __attribute__((ext_vector_type(4)));
typedef __bf16 bf16x2_t __attribute__((ext_vector_type(2)));
__device__ __forceinline__ unsigned pkbf(float a, float b) { f2 v; v.x = a; v.y = b; return __builtin_bit_cast(unsigned, __builtin_convertvector(v, bf16x2_t)); }
__device__ __forceinline__ unsigned pk2(float lo, float hi) { return pkbf(lo, hi); }
#define MFMA16(a, b, c) __builtin_amdgcn_mfma_f32_16x16x32_bf16((a), (b), (c), 0, 0, 0)
#define DPP_F(v, ctrl) __int_as_float(__builtin_amdgcn_update_dpp(0, __float_as_int(v), (ctrl), 0xf, 0xf, true))

template <bool FRAG = false>
__device__ __forceinline__ void transpose_tile(const float* __restrict__ W, int K, int N, bf16* __restrict__ WT, LAS float* scr, int kb, int nb, int lane) {
    const int k0 = kb * 64, n0 = nb * 32, rsub = lane >> 3, c4 = (lane & 7) * 4; const bool ok = (n0 + c4) < N;
    f4 v[8];
#pragma unroll
    for (int i = 0; i < 8; ++i) v[i] = ok ? *(const f4*)(W + (size_t)(k0 + 8 * i + rsub) * N + n0 + c4) : mk_f4(0.f, 0.f, 0.f, 0.f);
#pragma unroll
    for (int i = 0; i < 8; ++i) { LAS float* d = scr + (8 * i + rsub) * 33 + c4; d[0] = v[i].x; d[1] = v[i].y; d[2] = v[i].z; d[3] = v[i].w; }
    LDS_WAIT();
    const int c = lane & 7;
#pragma unroll
    for (int j = 0; j < 4; ++j) { const int n = (lane >> 3) + 8 * j; const LAS float* s = scr + (8 * c) * 33 + n;
        u4 o; o.x = pk2(s[0 * 33], s[1 * 33]); o.y = pk2(s[2 * 33], s[3 * 33]); o.z = pk2(s[4 * 33], s[5 * 33]); o.w = pk2(s[6 * 33], s[7 * 33]);
        if (FRAG) { const int ng = n0 + n, k8 = (k0 >> 3) + c; *(u4*)(WT + ((size_t)((ng >> 4) * (K >> 5) + (k8 >> 2)) * 64 + (k8 & 3) * 16 + (ng & 15)) * 8) = o; }
        else *(u4*)(WT + (size_t)(n0 + n) * K + k0 + 8 * c) = o; }
    LDS_WAIT();
}
__device__ __forceinline__ void cvt_bf16_stream(const float* __restrict__ src, bf16* __restrict__ dst, size_t nchunks, size_t gt, size_t GT) {
    for (size_t c = gt; c < nchunks; c += GT) { const f4 a = ((const f4*)src)[2 * c], b = ((const f4*)src)[2 * c + 1];
        u4 o; o.x = pk2(a.x, a.y); o.y = pk2(a.z, a.w); o.z = pk2(b.x, b.y); o.w = pk2(b.z, b.w); ((u4*)dst)[c] = o; }
}
#ifndef PEER_TAIL_ROWS
#define PEER_TAIL_ROWS 12288
#endif
constexpr int TAIL_ROWS = PEER_TAIL_ROWS;
__device__ __forceinline__ void convert_peer_tables(const Params& P, unsigned char* ws, int layer, int r_lo, int r_hi, int gw, int NGW, int lane) {
    for (int r2 = r_lo + gw; r2 < r_hi; r2 += NGW) {
        const int tab = r2 >> 14, rr = layer * 16384 + (r2 & 16383), row = tab * (DEPTH * 16384) + rr;
        const float* src = P.in[21 + tab] + (size_t)rr * 2048;
        f4 v[8]; float am = 0.f;
#pragma unroll
        for (int j = 0; j < 2; ++j)
#pragma unroll
            for (int q = 0; q < 4; ++q) { const f4 a = *(const f4*)(src + 1024 * j + 16 * lane + 4 * q); v[4 * j + q] = a; am = fmaxf(am, fmaxf(fmaxf(fabsf(a.x), fabsf(a.y)), fmaxf(fabsf(a.z), fabsf(a.w)))); }
#pragma unroll
        for (int o = 1; o < 64; o <<= 1) am = fmaxf(am, __shfl_xor(am, o));
        unsigned char* dst = ws + (tab ? WS_PV : WS_PU) + (size_t)rr * 2048;
        if (tab) {
            const float sc = (am > 0.f) ? 448.f / am : 1.f;
            if (lane == 0) ((float*)(ws + WS_PSC))[row] = (am > 0.f) ? am * (1.f / 448.f) : 1.f;
#pragma unroll
            for (int j = 0; j < 2; ++j) { u4 w;
#pragma unroll
                for (int q = 0; q < 4; ++q) { const f4 a = v[4 * j + q]; int r = __builtin_amdgcn_cvt_pk_fp8_f32(a.x * sc, a.y * sc, 0, false); r = __builtin_amdgcn_cvt_pk_fp8_f32(a.z * sc, a.w * sc, r, true); w[q] = (unsigned)r; }
                *(u4*)(dst + 1024 * j + 16 * lane) = w; }
        } else {
            const float sc = (am > 0.f) ? 127.f / am : 1.f;
            if (lane == 0) ((float*)(ws + WS_PSC))[row] = (am > 0.f) ? am * (1.f / 127.f) : 1.f;
#pragma unroll
            for (int j = 0; j < 2; ++j) { u4 w;
#pragma unroll
                for (int q = 0; q < 4; ++q) { const f4 a = v[4 * j + q];
                    const int b0 = (int)rintf(a.x * sc), b1 = (int)rintf(a.y * sc), b2 = (int)rintf(a.z * sc), b3 = (int)rintf(a.w * sc);
                    w[q] = (unsigned)(b0 & 0xff) | ((unsigned)(b1 & 0xff) << 8) | ((unsigned)(b2 & 0xff) << 16) | ((unsigned)b3 << 24); }
                *(u4*)(dst + 1024 * j + 16 * lane) = w; }
        }
    }
}
__device__ __forceinline__ void unit_wprime(const Params& P, unsigned char* ws, LAS unsigned char* lds, int u, int tid) {
    const int l = u >> 6, hh = (u >> 2) & 15, cq = u & 3, h = hh >> 1, half = hh & 1;
    const float* kg = P.in[half ? 20 : 19] + ((size_t)l * 8 + h) * 16384;
    const float* wq = P.in[18] + (size_t)l * D * D;
    bf16* WT = (bf16*)(ws + WS_WQ) + (size_t)l * D * D;
    LAS bf16* Kl = (LAS bf16*)lds;
    { const int key = tid >> 2, part = tid & 3; const f4* sp = (const f4*)(kg + key * 128 + part * 32); LAS u4* dp = (LAS u4*)(Kl + key * 136 + part * 32);
#pragma unroll
        for (int j = 0; j < 4; ++j) { const f4 a = sp[2 * j], b = sp[2 * j + 1]; u4 w; w.x = pkbf(a.x, a.y); w.y = pkbf(a.z, a.w); w.z = pkbf(b.x, b.y); w.w = pkbf(b.z, b.w); dp[j] = w; } }
    __syncthreads();
    const int lane = tid & 63, wv = __builtin_amdgcn_readfirstlane(tid >> 6), c = lane & 15, kq = lane >> 4;
#pragma unroll 1
    for (int ct = 0; ct < 4; ++ct) { const int cbase = cq * 512 + wv * 64 + ct * 16;
        bf16x8 xf[4];
#pragma unroll
        for (int ks = 0; ks < 4; ++ks) { const f4* wp = (const f4*)(wq + (size_t)(cbase + c) * D + hh * 128 + 32 * ks + 8 * kq); const f4 a = wp[0], b = wp[1];
            u4 w; w.x = pkbf(a.x, a.y); w.y = pkbf(a.z, a.w); w.z = pkbf(b.x, b.y); w.w = pkbf(b.z, b.w); xf[ks] = __builtin_bit_cast(bf16x8, w); }
#pragma unroll 2
        for (int kt = 0; kt < 8; ++kt) { f4 acc = mk_f4(0.f, 0.f, 0.f, 0.f);
#pragma unroll
            for (int ks = 0; ks < 4; ++ks) acc = MFMA16(xf[ks], *(const LAS bf16x8*)(Kl + (16 * kt + c) * 136 + 32 * ks + 8 * kq), acc);
            u2 w; w.x = pkbf(acc.x, acc.y); w.y = pkbf(acc.z, acc.w);
            *(u2*)(WT + (size_t)(hh * 128 + 16 * kt + c) * D + cbase + 4 * kq) = w; } }
    __syncthreads();
}
__device__ __forceinline__ void phase_prologue(const Params& P, unsigned char* ws, LAS unsigned char* lds, int tid, int lane, int wave) {
    LAS float* scr = (LAS float*)(lds + wave * 8704);
    const int gw = blockIdx.x * 8 + wave, NGW = gridDim.x * 8;
    constexpr int I_IN = 32 * 168, I_SQ = 32 * 64, I_L = I_IN + I_SQ;
    REP(21) for (int it = gw; it < DEPTH * I_L; it += NGW) {
        const int l = it / I_L; int r = it % I_L;
        if (r < I_IN) transpose_tile(P.in[1] + (size_t)l * D * INW, D, INW, (bf16*)(ws + WS_WIN) + (size_t)l * INWP * D, scr, r / 168, r % 168, lane);
        else { r -= I_IN;
            if (r < I_SQ) transpose_tile(P.in[15] + (size_t)l * D * D, D, D, (bf16*)(ws + WS_WOUT) + (size_t)l * D * D, scr, r / 64, r % 64, lane);
            else { } }
    }
    for (int it = gw; it < DEPTH * 2 * (32 * 8 + 4 * 2); it += NGW) {
        const int lk = it / 264, r = it % 264, l = lk >> 1, kv = lk & 1;
        if (r < 256) transpose_tile<true>(P.in[kv ? 12 : 9] + (size_t)l * 2048 * 256, 2048, 256, (bf16*)(ws + WS_W1T) + (size_t)lk * 256 * 2048, scr, r >> 3, r & 7, lane);
        else transpose_tile(P.in[kv ? 13 : 10] + (size_t)l * 256 * 64, 256, 64, (bf16*)(ws + WS_W2T) + (size_t)lk * 64 * 256, scr, (r - 256) >> 1, (r - 256) & 1, lane);
    }
    const size_t gt = (size_t)blockIdx.x * 512 + tid, GT = (size_t)gridDim.x * 512;
    REP(22) { convert_peer_tables(P, ws, 0, 0, 2 * 16384, gw, NGW, lane);
        for (int ly = 1; ly < DEPTH; ++ly) convert_peer_tables(P, ws, ly, TAIL_ROWS, 2 * 16384, gw, NGW, lane); }
    cvt_bf16_stream(P.in[0], (bf16*)(ws + WS_XB), (size_t)NTOK * D / 8, gt, GT);
    f2* rope = (f2*)(ws + WS_ROPE);
    for (size_t idx = gt; idx < (size_t)T * 32; idx += GT) { const int t = (int)(idx >> 5), i = (int)(idx & 31);
        double a = (double)t * P.inv_rev[i]; a -= floor(a); const float fr = (float)a;
        rope[idx] = mk_f2(__builtin_amdgcn_cosf(fr), __builtin_amdgcn_sinf(fr)); }
    for (int u = blockIdx.x; u < DEPTH * 64; u += gridDim.x) unit_wprime(P, ws, lds, u, tid);
}

constexpr int NS = 80;
constexpr float NSA_SC = 0.125f * LOG2E;
__device__ __forceinline__ void nsa_scores(f4 (&st)[4][2], const LAS bf16* Kl, const bf16x8 (&Yq)[2][2], int lane) {
    const int r = lane & 15, kq = lane >> 4;
#pragma unroll
    for (int kt = 0; kt < 4; ++kt) { const LAS bf16* kp = Kl + (16 * kt + r) * NS + 8 * kq;
        const bf16x8 k0 = *(const LAS bf16x8*)kp, k1 = *(const LAS bf16x8*)(kp + 32);
#pragma unroll
        for (int qp = 0; qp < 2; ++qp) { f4 a = mk_f4(0.f, 0.f, 0.f, 0.f); a = MFMA16(k0, Yq[qp][0], a); a = MFMA16(k1, Yq[qp][1], a); st[kt][qp] = a; } }
}
__device__ __forceinline__ void nsa_softmax_pv(f4 (&st)[4][2], float (&m)[2], float (&l)[2], f4 (&ot)[4][2], const LAS bf16* Vl, const int (&lo)[2], const int (&hi)[2], int mmode, int lane) {
    const int kq = lane >> 4, q = (lane & 15) >> 2, p = lane & 3;
    bf16x8 Pf[2][2];
#pragma unroll
    for (int qp = 0; qp < 2; ++qp) {
        if (mmode == 1) {
#pragma unroll
            for (int kt = 0; kt < 4; ++kt)
#pragma unroll
                for (int i = 0; i < 4; ++i) { const int kl = 16 * kt + 4 * kq + i; if (kl < lo[qp] || kl > hi[qp]) st[kt][qp][i] = -1e30f; } }
        const bool off = (mmode == 2) && (hi[qp] < 0);
        float mx = st[0][qp][0];
#pragma unroll
        for (int kt = 0; kt < 4; ++kt)
#pragma unroll
            for (int i = 0; i < 4; ++i) mx = fmaxf(mx, st[kt][qp][i]);
        mx = x32_max(x16_max(mx)); if (off) mx = -1e30f;
        const float mn = fmaxf(m[qp], mx); const float corr = __builtin_amdgcn_exp2f((m[qp] - mn) * NSA_SC); m[qp] = mn; l[qp] *= corr;
#pragma unroll
        for (int dt = 0; dt < 4; ++dt) ot[dt][qp] *= corr;
        const float msc = off ? 1e30f : mn * NSA_SC; float ps = 0.f;
#pragma unroll
        for (int kt = 0; kt < 4; ++kt)
#pragma unroll
            for (int i = 0; i < 4; ++i) { const float pv = __builtin_amdgcn_exp2f(st[kt][qp][i] * NSA_SC - msc); st[kt][qp][i] = pv; ps += pv; }
        l[qp] += ps;
#pragma unroll
        for (int ksp = 0; ksp < 2; ++ksp) { u4 w; w.x = pkbf(st[2 * ksp][qp][0], st[2 * ksp][qp][1]); w.y = pkbf(st[2 * ksp][qp][2], st[2 * ksp][qp][3]);
            w.z = pkbf(st[2 * ksp + 1][qp][0], st[2 * ksp + 1][qp][1]); w.w = pkbf(st[2 * ksp + 1][qp][2], st[2 * ksp + 1][qp][3]); Pf[qp][ksp] = __builtin_bit_cast(bf16x8, w); }
    }
#pragma unroll
    for (int dt = 0; dt < 4; ++dt)
#pragma unroll
        for (int ksp = 0; ksp < 2; ++ksp) { const LAS bf16* vp = Vl + (32 * ksp + 4 * kq + q) * NS + 16 * dt + 4 * p;
            const s16x4 va = __builtin_amdgcn_ds_read_tr16_b64_v4i16((LAS s16x4*)vp), vb = __builtin_amdgcn_ds_read_tr16_b64_v4i16((LAS s16x4*)(vp + 16 * NS));
            const bf16x8 vf = __builtin_shufflevector(va, vb, 0, 1, 2, 3, 4, 5, 6, 7);
#pragma unroll
            for (int qp = 0; qp < 2; ++qp) ot[dt][qp] = MFMA16(vf, Pf[qp][ksp], ot[dt][qp]); }
}
__device__ __forceinline__ void nsa_flush(bf16* __restrict__ y0, bf16* __restrict__ y1, const f4 (&ot)[4][2], const float (&l)[2], const float (&gate)[2], size_t boff, int kq) {
#pragma unroll
    for (int qp = 0; qp < 2; ++qp) { float lt = x32_sum(x16_sum(l[qp])); const float sc = (lt > 0.f) ? gate[qp] / lt : 0.f;
        bf16* yp = (qp ? y1 : y0) + boff + 4 * kq;
#pragma unroll
        for (int dt = 0; dt < 4; ++dt) { const f4 o = ot[dt][qp] * sc; *(u2*)(yp + 16 * dt) = mk_u2(pkbf(o.x, o.y), pkbf(o.z, o.w)); } }
}
__device__ __forceinline__ void nsa_pair_next(unsigned& rem, int& ja, int& jb) { ja = __builtin_ctz(rem); rem &= rem - 1u; if (rem) { jb = __builtin_ctz(rem); rem &= rem - 1u; } else jb = -1; }
__device__ __forceinline__ void nsa_pair_prefetch(const bf16* __restrict__ Hb, int tok0, int ja, int jb, int colK, int colV, int tid, u4 (&R)[4]) {
    const int key = tid >> 3, d8 = (tid & 7) * 8; const int j1 = jb < 0 ? ja : jb;
    const bf16* pa = Hb + (size_t)(tok0 + 64 * ja + key) * INWP + d8; const bf16* pb = Hb + (size_t)(tok0 + 64 * j1 + key) * INWP + d8;
    R[0] = *(const u4*)(pa + colK); R[1] = *(const u4*)(pa + colV); R[2] = *(const u4*)(pb + colK); R[3] = *(const u4*)(pb + colV);
}
__device__ __forceinline__ void nsa_pair_store(LAS bf16* buf, int tid, const u4 (&R)[4]) {
    LAS bf16* p = buf + (tid >> 3) * NS + (tid & 7) * 8;
    *(LAS u4*)p = R[0]; *(LAS u4*)(p + 128 * NS) = R[1]; *(LAS u4*)(p + 64 * NS) = R[2]; *(LAS u4*)(p + 192 * NS) = R[3];
}
template <int MODE>
__device__ __forceinline__ void nsa_branch(unsigned chunks, const bf16* __restrict__ Hb, int tok0, int colK, int colV, LAS bf16* buf0, LAS bf16* buf1, int tid, int lane, int qt, const int (&tq)[2], const unsigned (&mym)[2],
                                           const bf16x8 (&Yq)[2][2], f4 (&ot)[4][2], float (&m)[2], float (&l)[2]) {
    u4 R[4]; unsigned rem = chunks; int ja, jb, na = 0, nb = -1; f4 st[4][2]; int lo[2], hi[2];
    nsa_pair_next(rem, ja, jb);
    nsa_pair_prefetch(Hb, tok0, ja, jb, colK, colV, tid, R);
    __syncthreads();
    nsa_pair_store(buf0, tid, R);
    bool more = (rem != 0u);
    if (more) { nsa_pair_next(rem, na, nb); nsa_pair_prefetch(Hb, tok0, na, nb, colK, colV, tid, R); }
    __syncthreads();
    int it = 0;
#pragma unroll 1
    for (;;) {
        LAS bf16* cur = (it & 1) ? buf1 : buf0;
#pragma unroll 1
        for (int sub = 0; sub < 2; ++sub) { const int j = sub ? jb : ja;
            if (j < 0) break;
            bool anyv = false, full = true;
#pragma unroll
            for (int qp = 0; qp < 2; ++qp) {
                if (MODE == 0) { const bool sel = (mym[qp] >> j) & 1u; lo[qp] = sel ? 0 : 64; hi[qp] = sel ? ((j == qt) ? tq[qp] : 63) : -1; anyv |= sel; full &= (sel && j != qt); }
                else { lo[qp] = (j == qt - 8) ? tq[qp] + 1 : 0; hi[qp] = (j == qt) ? tq[qp] : 63; anyv = true; full &= (j != qt && j != qt - 8); } }
            if (__builtin_amdgcn_ballot_w64(anyv) != 0ull) {
                const bool need_mask = __builtin_amdgcn_ballot_w64(!full) != 0ull;
                nsa_scores(st, cur + sub * 64 * NS, Yq, lane);
                nsa_softmax_pv(st, m, l, ot, cur + 128 * NS + sub * 64 * NS, lo, hi, !need_mask ? 0 : ((MODE == 0 && j != qt) ? 2 : 1), lane); } }
        if (!more) break;
        nsa_pair_store((it & 1) ? buf0 : buf1, tid, R);
        ja = na; jb = nb; more = (rem != 0u);
        if (more) { nsa_pair_next(rem, na, nb); nsa_pair_prefetch(Hb, tok0, na, nb, colK, colV, tid, R); }
        __syncthreads(); ++it;
    }
}
__device__ __forceinline__ void unit_nsa(const Params& P, unsigned char* ws, int l_, LAS unsigned char* lds, int u, int tid) {
    const int b = (u >> 7) & 3, g = (u >> 5) & 3, qt = (u & 256) ? 31 - (u & 31) : (u & 31);
    const bf16* Hb = (const bf16*)(ws + WS_H);
    LAS bf16* buf0 = (LAS bf16*)lds;
    LAS bf16* buf1 = (LAS bf16*)(lds + 40960);
    LAS float* impG = (LAS float*)(lds + 40960);
    LAS float* impE = (LAS float*)(lds + 73728);
    LAS unsigned* selm = (LAS unsigned*)(lds + 106496);
    const int lane = tid & 63, wv = __builtin_amdgcn_readfirstlane(tid >> 6), h = wv >> 1, qh = wv & 1;
    const int c = lane & 15, kq = lane >> 4;
    const int t0 = qt * 64;
    int tq[2]; size_t tok[2];
#pragma unroll
    for (int qp = 0; qp < 2; ++qp) { tq[qp] = 32 * qh + 16 * qp + c; tok[qp] = (size_t)b * T + t0 + tq[qp]; }
    bf16x8 Yq[2][2];
#pragma unroll
    for (int qp = 0; qp < 2; ++qp)
#pragma unroll
        for (int ks = 0; ks < 2; ++ks) Yq[qp][ks] = *(const bf16x8*)(Hb + tok[qp] * INWP + C_NQ + g * 256 + h * 64 + 32 * ks + 8 * kq);
    float gate[3][2];
#pragma unroll
    for (int k = 0; k < 3; ++k)
#pragma unroll
        for (int qp = 0; qp < 2; ++qp) { const float gv = bf2f(Hb[tok[qp] * INWP + C_NG + g * 12 + h * 3 + k]); gate[k][qp] = __builtin_amdgcn_rcpf(1.f + __expf(-gv)); }
    bf16* y0 = (bf16*)(ws + WS_YMIX) + tok[0] * D + 1024 + g * 256 + h * 64; bf16* y1 = (bf16*)(ws + WS_YMIX) + tok[1] * D + 1024 + g * 256 + h * 64;
    if (tid == 0) selm[64] = 0u;
    f4 ot[4][2]; float m[2], l[2];
#pragma unroll
    for (int dt = 0; dt < 4; ++dt)
#pragma unroll
        for (int qp = 0; qp < 2; ++qp) ot[dt][qp] = mk_f4(0.f, 0.f, 0.f, 0.f);
    int cmax[2];
#pragma unroll
    for (int qp = 0; qp < 2; ++qp) { const int t = t0 + tq[qp]; cmax[qp] = (t >= 31) ? (((t - 31) >> 4) < 126 ? ((t - 31) >> 4) : 126) : -1; }
    __syncthreads();
    { const bf16* KCk = (const bf16*)(ws + WS_KC) + (size_t)((0 * 4 + b) * 4 + g) * 8192; const bf16* KCv = (const bf16*)(ws + WS_KC) + (size_t)((1 * 4 + b) * 4 + g) * 8192;
#pragma unroll
        for (int i = 0; i < 2; ++i) { const int idx = tid + 512 * i, key = idx >> 3, d8 = (idx & 7) * 8;
            *(LAS u4*)(buf0 + key * NS + d8) = *(const u4*)(KCk + key * 64 + d8); *(LAS u4*)(buf0 + (128 + key) * NS + d8) = *(const u4*)(KCv + key * 64 + d8); } }
    __syncthreads();
    m[0] = m[1] = -1e4f; l[0] = l[1] = 0.f;
    { f4 st[4][2]; int lo[2], hi[2];
#pragma unroll 1
        for (int cc = 0; cc < 2; ++cc) {
            if (cc * 64 * 16 + 31 > t0 + 63) break;
#pragma unroll
            for (int qp = 0; qp < 2; ++qp) { lo[qp] = 0; hi[qp] = cmax[qp] - 64 * cc; }
            nsa_scores(st, buf0 + cc * 64 * NS, Yq, lane);
            nsa_softmax_pv(st, m, l, ot, buf0 + 128 * NS + cc * 64 * NS, lo, hi, 1, lane);
        }
        { const float g2[2] = {gate[0][0], gate[0][1]}; nsa_flush(y0, y1, ot, l, g2, 0, kq); }
        float invl[2], msc[2];
#pragma unroll
        for (int qp = 0; qp < 2; ++qp) { float lt = x32_sum(x16_sum(l[qp])); invl[qp] = (lt > 0.f) ? 1.f / lt : 0.f; msc[qp] = m[qp] * NSA_SC; }
#pragma unroll 1
        for (int cc = 0; cc < 2; ++cc) {
            nsa_scores(st, buf0 + cc * 64 * NS, Yq, lane);
#pragma unroll
            for (int kt = 0; kt < 4; ++kt)
#pragma unroll
                for (int qp = 0; qp < 2; ++qp) { float pp[4];
#pragma unroll
                    for (int i = 0; i < 4; ++i) { const int ci = 64 * cc + 16 * kt + 4 * kq + i; pp[i] = (ci <= cmax[qp]) ? __builtin_amdgcn_exp2f(st[kt][qp][i] * NSA_SC - msc[qp]) * invl[qp] : 0.f; }
                    const int j = 16 * cc + 4 * kt + kq;
                    impG[(h * 32 + j) * 64 + tq[qp]] = (pp[0] + pp[1]) + (pp[2] + pp[3]);
                    if (j < 31) impE[(h * 32 + j + 1) * 64 + tq[qp]] = pp[3]; }
        } }
    __syncthreads();
    { LAS int* impS = (LAS int*)(lds + 107008);
#pragma unroll
        for (int k = 0; k < 4; ++k) { const int idx = tid + 512 * k, tqs = idx & 63, j = idx >> 6; float v;
            if (j <= qt) { const bool forced = (j == 0) || (j == qt) || (j == qt - 1);
                float s4 = (impG[(0 * 32 + j) * 64 + tqs] + impG[(1 * 32 + j) * 64 + tqs]) + (impG[(2 * 32 + j) * 64 + tqs] + impG[(3 * 32 + j) * 64 + tqs]);
                if (j > 0) s4 += (impE[(0 * 32 + j) * 64 + tqs] + impE[(1 * 32 + j) * 64 + tqs]) + (impE[(2 * 32 + j) * 64 + tqs] + impE[(3 * 32 + j) * 64 + tqs]);
                v = forced ? 1e6f : s4; }
            else v = -1e9f;
            const int bits = __float_as_int(v); const int sk = bits ^ ((bits >> 31) & 0x7fffffff);
            impS[tqs * 33 + j] = (sk & ~31) | (31 - j); }
        __syncthreads();
        if (tid < 64) { int t8[8];
#pragma unroll
            for (int k = 0; k < 8; ++k) t8[k] = (int)0x80000000;
#pragma unroll 4
            for (int j = 0; j < 32; ++j) { int x = impS[tid * 33 + j];
#pragma unroll
                for (int k = 0; k < 8; ++k) { const int hi_ = max(t8[k], x); x = min(t8[k], x); t8[k] = hi_; } }
            unsigned msk = 0u;
#pragma unroll
            for (int k = 0; k < 8; ++k) { const int jj = 31 - (t8[k] & 31); if (jj <= qt) msk |= (1u << jj); }
            selm[tid] = msk; atomicOr((unsigned*)&selm[64], msk); } }
    __syncthreads();
    unsigned mymask[2];
#pragma unroll
    for (int qp = 0; qp < 2; ++qp) mymask[qp] = selm[tq[qp]];
    const unsigned umask = selm[64];
#pragma unroll
    for (int dt = 0; dt < 4; ++dt)
#pragma unroll
        for (int qp = 0; qp < 2; ++qp) ot[dt][qp] = mk_f4(0.f, 0.f, 0.f, 0.f);
    m[0] = m[1] = -1e4f; l[0] = l[1] = 0.f;
    nsa_branch<0>(umask, Hb, b * T, C_KS + g * 64, C_VS + g * 64, buf0, buf1, tid, lane, qt, tq, mymask, Yq, ot, m, l);
    { const float g2[2] = {gate[1][0], gate[1][1]}; nsa_flush(y0, y1, ot, l, g2, YB_SEL, kq); }
#pragma unroll
    for (int dt = 0; dt < 4; ++dt)
#pragma unroll
        for (int qp = 0; qp < 2; ++qp) ot[dt][qp] = mk_f4(0.f, 0.f, 0.f, 0.f);
    m[0] = m[1] = -1e4f; l[0] = l[1] = 0.f;
    { const int jw0 = qt >= 8 ? qt - 8 : 0; const unsigned wmask = ((qt == 31) ? 0xffffffffu : ((1u << (qt + 1)) - 1u)) & ~((1u << jw0) - 1u);
        nsa_branch<1>(wmask, Hb, b * T, C_KW + g * 64, C_VW + g * 64, buf0, buf1, tid, lane, qt, tq, mymask, Yq, ot, m, l); }
    { const float g2[2] = {gate[2][0], gate[2][1]}; nsa_flush(y0, y1, ot, l, g2, YB_WIN, kq); }
    __syncthreads();
}

__device__ __forceinline__ void unit_compress_mfma(const Params& P, unsigned char* ws, int l, LAS unsigned char* lds, int u, int tid) {
    const int kv = u >> 7, b = (u >> 5) & 3, g = (u >> 3) & 3, r8 = u & 7, i0 = 16 * r8;
    const bf16* Hb = (const bf16*)(ws + WS_H);
    const bf16* W1T = (const bf16*)(ws + WS_W1T) + (size_t)(l * 2 + kv) * 256 * 2048;
    const bf16* W2T = (const bf16*)(ws + WS_W2T) + (size_t)(l * 2 + kv) * 64 * 256;
    const float* pe = P.in[kv ? 11 : 8] + (size_t)l * 2048;
    constexpr int AS = 2056;
    LAS bf16* Al = (LAS bf16*)lds;
    LAS bf16* hidL = (LAS bf16*)(lds + 16 * AS * 2);
    const int lane = tid & 63, wv = __builtin_amdgcn_readfirstlane(tid >> 6), c = lane & 15, kq = lane >> 4;
    const int col0 = (kv ? C_VC : C_KC) + g * 64;
#pragma unroll 4
    for (int it = 0; it < 8; ++it) { const int idx = tid + 512 * it; const int r = idx >> 8, pos = (idx >> 3) & 31, d8 = (idx & 7) * 8;
        int t = 16 * (i0 + r) + pos; t = t < T ? t : T - 1;
        const u4 a = *(const u4*)(Hb + (size_t)(b * T + t) * INWP + col0 + d8); float f[8]; unpack8(a, f);
        const f4 p0 = *(const f4*)(pe + pos * 64 + d8), p1 = *(const f4*)(pe + pos * 64 + d8 + 4);
        u4 w; w.x = pkbf(f[0] + p0.x, f[1] + p0.y); w.y = pkbf(f[2] + p0.z, f[3] + p0.w); w.z = pkbf(f[4] + p1.x, f[5] + p1.y); w.w = pkbf(f[6] + p1.z, f[7] + p1.w);
        *(LAS u4*)(Al + r * AS + pos * 64 + d8) = w; }
    __syncthreads();
    f4 acc[2];
#pragma unroll
    for (int nt = 0; nt < 2; ++nt) acc[nt] = mk_f4(0.f, 0.f, 0.f, 0.f);
    const bf16* wrow[2];
#pragma unroll
    for (int nt = 0; nt < 2; ++nt) wrow[nt] = W1T + (size_t)(2 * wv + nt) * 64 * 512 + lane * 8;
    const LAS bf16* arow = Al + c * AS + 8 * kq;
    bf16x8 xfA[2][4], xfB[2][4], xfC[2][4];
#define CMP_LOADW(XF, p2_) do { _Pragma("unroll") for (int nt = 0; nt < 2; ++nt) _Pragma("unroll") for (int ks = 0; ks < 4; ++ks) XF[nt][ks] = *(const bf16x8*)(wrow[nt] + ((p2_) * 4 + ks) * 512); } while (0)
#define CMP_MMAW(XF, p2_) do { _Pragma("unroll") for (int ks = 0; ks < 4; ++ks) { const bf16x8 yf_ = *(const LAS bf16x8*)(arow + (p2_) * 128 + 32 * ks); \
        _Pragma("unroll") for (int nt = 0; nt < 2; ++nt) acc[nt] = MFMA16(XF[nt][ks], yf_, acc[nt]); } } while (0)
    CMP_LOADW(xfA, 0); CMP_LOADW(xfB, 1);
#pragma unroll 1
    for (int p2 = 0; p2 < 15; p2 += 3) {
        CMP_LOADW(xfC, p2 + 2);
        CMP_MMAW(xfA, p2);
        CMP_LOADW(xfA, p2 + 3);
        CMP_MMAW(xfB, p2 + 1);
        if (p2 + 4 < 16) CMP_LOADW(xfB, p2 + 4);
        CMP_MMAW(xfC, p2 + 2);
    }
    CMP_MMAW(xfA, 15);
#undef CMP_LOADW
#undef CMP_MMAW
#pragma unroll
    for (int nt = 0; nt < 2; ++nt) { const f4 a = acc[nt]; u2 w; w.x = pkbf(gelu_tanh(a.x), gelu_tanh(a.y)); w.y = pkbf(gelu_tanh(a.z), gelu_tanh(a.w));
        *(LAS u2*)(hidL + c * 264 + 32 * wv + 16 * nt + 4 * kq) = w; }
    __syncthreads();
    if (wv < 4) { const int ot = wv; f4 o = mk_f4(0.f, 0.f, 0.f, 0.f);
        const bf16* w2p = W2T + (size_t)(16 * ot + c) * 256 + 8 * kq; const LAS bf16* hp = hidL + c * 264 + 8 * kq;
#pragma unroll
        for (int ks = 0; ks < 8; ++ks) { const bf16x8 xw = *(const bf16x8*)(w2p + 32 * ks); const bf16x8 yh = *(const LAS bf16x8*)(hp + 32 * ks); o = MFMA16(xw, yh, o); }
        const int ci = i0 + c;
        u2 w; w.x = pkbf(o.x, o.y); w.y = pkbf(o.z, o.w); if (ci > 126) { w.x = 0u; w.y = 0u; }
        *(u2*)((bf16*)(ws + WS_KC) + ((size_t)((kv * 4 + b) * 4 + g) * 128 + ci) * 64 + 16 * ot + 4 * kq) = w; }
    __syncthreads();
}

__device__ __forceinline__ void unit_retention_mfma(const Params& P, unsigned char* ws, int l, LAS unsigned char* lds, int u, int tid) {
    const int b = u >> 6, h = (u >> 4) & 3, c = u & 15;
    const bf16* Hb = (const bf16*)(ws + WS_H); const f2* rope = (const f2*)(ws + WS_ROPE);
    LAS bf16* Ql = (LAS bf16*)lds;
    LAS bf16* Kl = (LAS bf16*)(lds + 18432);
    LAS bf16* Vr = (LAS bf16*)(lds + 36864);
    LAS bf16* St = (LAS bf16*)(lds + 73728);
    const float lg2h = P.lg2[h];
    const int tok0 = b * T + c * 128;
    { const int m = tid >> 2, p = tid & 3;
        const f4* rp = (const f4*)(rope + (size_t)(c * 128 + m) * 32 + p * 8);
        const f4 r0 = rp[0], r1 = rp[1], r2 = rp[2], r3 = rp[3];
        const float cs[8] = {r0.x, r0.z, r1.x, r1.z, r2.x, r2.z, r3.x, r3.z}, sn[8] = {r0.y, r0.w, r1.y, r1.w, r2.y, r2.w, r3.y, r3.w};
#pragma unroll
        for (int which = 0; which < 2; ++which) { const bf16* src = Hb + (size_t)(tok0 + m) * INWP + (which ? C_RK : C_RQ) + h * 64 + p * 8;
            const u4 a = *(const u4*)src, bb = *(const u4*)(src + 32); float x1[8], x2[8]; unpack8(a, x1); unpack8(bb, x2);
            const float sc = which ? 0.125f : 1.0f; float o1[8], o2[8];
#pragma unroll
            for (int i = 0; i < 8; ++i) { o1[i] = (x1[i] * cs[i] - x2[i] * sn[i]) * sc; o2[i] = (x1[i] * sn[i] + x2[i] * cs[i]) * sc; }
            LAS bf16* dst = (which ? Kl : Ql) + m * 72 + p * 8;
            u4 w1, w2; w1.x = pkbf(o1[0], o1[1]); w1.y = pkbf(o1[2], o1[3]); w1.z = pkbf(o1[4], o1[5]); w1.w = pkbf(o1[6], o1[7]); w2.x = pkbf(o2[0], o2[1]); w2.y = pkbf(o2[2], o2[3]); w2.z = pkbf(o2[4], o2[5]); w2.w = pkbf(o2[6], o2[7]);
            *(LAS u4*)dst = w1; *(LAS u4*)(dst + 32) = w2; } }
#pragma unroll
    for (int q = 0; q < 4; ++q) { const int mr = 32 * q + (tid >> 4), pc = tid & 15;
        *(LAS u4*)(Vr + mr * 144 + pc * 8) = *(const u4*)(Hb + (size_t)(tok0 + mr) * INWP + C_RV + h * 128 + pc * 8); }
    { float a[16];
#pragma unroll
        for (int i = 0; i < 16; ++i) a[i] = 0.f;
        const float* kvb = (const float*)(ws + WS_KVST) + (size_t)((b * 4 + h) * 16) * 8192 + tid * 4;
#pragma unroll 5
        for (int j = 0; j < c; ++j) { const float w = exp2f(lg2h * 128.f * (float)(c - 1 - j)); const f4* sp = (const f4*)(kvb + (size_t)j * 8192);
#pragma unroll
            for (int q = 0; q < 4; ++q) { const f4 v = sp[512 * q]; a[4 * q] += w * v.x; a[4 * q + 1] += w * v.y; a[4 * q + 2] += w * v.z; a[4 * q + 3] += w * v.w; } }
        const int d0 = tid >> 5, e0 = (tid & 31) * 4;
#pragma unroll
        for (int i = 0; i < 16; ++i) St[(e0 + (i & 3)) * 72 + 16 * (i >> 2) + d0] = (bf16)f2bf(a[i]); }
    __syncthreads();
    const int lane = tid & 63, wv = __builtin_amdgcn_readfirstlane(tid >> 6), cc = lane & 15, kq = lane >> 4;
    const int nn = 16 * wv + cc;
    bf16x8 yq[2];
#pragma unroll
    for (int ks = 0; ks < 2; ++ks) yq[ks] = *(const LAS bf16x8*)(Ql + nn * 72 + 32 * ks + 8 * kq);
    f4 ot[8];
#pragma unroll
    for (int et = 0; et < 8; ++et) { f4 a = mk_f4(0.f, 0.f, 0.f, 0.f); const LAS bf16* sp = St + (16 * et + cc) * 72 + 8 * kq;
        a = MFMA16(*(const LAS bf16x8*)sp, yq[0], a); a = MFMA16(*(const LAS bf16x8*)(sp + 32), yq[1], a); ot[et] = a; }
    { const float xi = exp2f(lg2h * (float)(nn + 1));
#pragma unroll
        for (int et = 0; et < 8; ++et) ot[et] *= xi; }
    const int nks = (wv >> 1) + 1;
#pragma unroll 1
    for (int ksp = 0; ksp < nks; ++ksp) { f4 st[2];
#pragma unroll
        for (int j = 0; j < 2; ++j) { const int mt = 2 * ksp + j; const LAS bf16* kp = Kl + (16 * mt + cc) * 72 + 8 * kq;
            f4 a = mk_f4(0.f, 0.f, 0.f, 0.f); a = MFMA16(*(const LAS bf16x8*)kp, yq[0], a); a = MFMA16(*(const LAS bf16x8*)(kp + 32), yq[1], a);
#pragma unroll
            for (int i = 0; i < 4; ++i) { const int mm = 16 * mt + 4 * kq + i; a[i] = (mm <= nn) ? a[i] * exp2f(lg2h * (float)(nn - mm)) : 0.f; }
            st[j] = a; }
        u4 w; w.x = pkbf(st[0].x, st[0].y); w.y = pkbf(st[0].z, st[0].w); w.z = pkbf(st[1].x, st[1].y); w.w = pkbf(st[1].z, st[1].w);
        const bf16x8 pf = __builtin_bit_cast(bf16x8, w);
#pragma unroll
        for (int et = 0; et < 8; ++et) { const LAS bf16* vp = Vr + (32 * ksp + 4 * kq + (cc >> 2)) * 144 + 16 * et + 4 * (cc & 3);
            const s16x4 va = __builtin_amdgcn_ds_read_tr16_b64_v4i16((LAS s16x4*)vp), vb = __builtin_amdgcn_ds_read_tr16_b64_v4i16((LAS s16x4*)(vp + 16 * 144));
            ot[et] = MFMA16(__builtin_shufflevector(va, vb, 0, 1, 2, 3, 4, 5, 6, 7), pf, ot[et]); }
    }
    float s1 = 0.f;
#pragma unroll
    for (int et = 0; et < 8; ++et) s1 += (ot[et].x + ot[et].y) + (ot[et].z + ot[et].w);
    s1 = x32_sum(x16_sum(s1));
    const float mu = s1 * (1.f / 128.f); float s2 = 0.f;
#pragma unroll
    for (int et = 0; et < 8; ++et) { const f4 dd = ot[et] - mu; s2 += (dd.x * dd.x + dd.y * dd.y) + (dd.z * dd.z + dd.w * dd.w); }
    s2 = x32_sum(x16_sum(s2));
    const float rstd = rsqrtf(s2 * (1.f / 128.f) + LN_EPS);
    const float* gg = P.in[2] + l * 512 + h * 128; const float* gb = P.in[3] + l * 512 + h * 128;
    const bf16* gp = Hb + (size_t)(tok0 + nn) * INWP + C_RG + h * 128;
    bf16* yo = (bf16*)(ws + WS_YMIX) + (size_t)(tok0 + nn) * D + h * 128;
#pragma unroll
    for (int et = 0; et < 8; ++et) { const int e = 16 * et + 4 * kq; const f4 g4 = *(const f4*)(gg + e), b4 = *(const f4*)(gb + e); const u2 gr = *(const u2*)(gp + e);
        const float gv[4] = {__uint_as_float(gr.x << 16), __uint_as_float(gr.x & 0xffff0000u), __uint_as_float(gr.y << 16), __uint_as_float(gr.y & 0xffff0000u)};
        f4 o;
#pragma unroll
        for (int i = 0; i < 4; ++i) { const float y = (ot[et][i] - mu) * rstd * g4[i] + b4[i]; o[i] = y * gv[i] * __builtin_amdgcn_rcpf(1.f + __expf(-gv[i])); }
        *(u2*)(yo + e) = mk_u2(pkbf(o[0], o[1]), pkbf(o[2], o[3])); }
    __syncthreads();
}

__device__ __forceinline__ bf16x8 tr_frag(const LAS bf16* p, int rowstride4) {
    const s16x4 a = __builtin_amdgcn_ds_read_tr16_b64_v4i16((LAS s16x4*)p), b = __builtin_amdgcn_ds_read_tr16_b64_v4i16((LAS s16x4*)(p + rowstride4));
    return __builtin_shufflevector(a, b, 0, 1, 2, 3, 4, 5, 6, 7);
}
__device__ __forceinline__ void unit_kvstate_mfma(const Params& P, unsigned char* ws, LAS unsigned char* lds, int u, int tid) {
    const int b = u / 60, r = u % 60, h = r / 15, j = r % 15;
    const bf16* Hb = (const bf16*)(ws + WS_H); const f2* rope = (const f2*)(ws + WS_ROPE);
    LAS bf16* Kz = (LAS bf16*)lds;
    LAS bf16* Vl = (LAS bf16*)(lds + 20480);
    const int tok0 = b * T + j * 128; const float lg2h = P.lg2[h];
    { const int m = tid >> 2, p = tid & 3;
        const f4* rp = (const f4*)(rope + (size_t)(j * 128 + m) * 32 + p * 8);
        const f4 r0 = rp[0], r1 = rp[1], r2 = rp[2], r3 = rp[3];
        const float cs[8] = {r0.x, r0.z, r1.x, r1.z, r2.x, r2.z, r3.x, r3.z}, sn[8] = {r0.y, r0.w, r1.y, r1.w, r2.y, r2.w, r3.y, r3.w};
        const bf16* src = Hb + (size_t)(tok0 + m) * INWP + C_RK + h * 64 + p * 8;
        const u4 a = *(const u4*)src, bb = *(const u4*)(src + 32); float x1[8], x2[8]; unpack8(a, x1); unpack8(bb, x2);
        const float sc = 0.125f * exp2f(lg2h * (float)(127 - m)); float o1[8], o2[8];
#pragma unroll
        for (int i = 0; i < 8; ++i) { o1[i] = (x1[i] * cs[i] - x2[i] * sn[i]) * sc; o2[i] = (x1[i] * sn[i] + x2[i] * cs[i]) * sc; }
        u4 w1, w2; w1.x = pkbf(o1[0], o1[1]); w1.y = pkbf(o1[2], o1[3]); w1.z = pkbf(o1[4], o1[5]); w1.w = pkbf(o1[6], o1[7]); w2.x = pkbf(o2[0], o2[1]); w2.y = pkbf(o2[2], o2[3]); w2.z = pkbf(o2[4], o2[5]); w2.w = pkbf(o2[6], o2[7]);
        *(LAS u4*)(Kz + m * 80 + p * 8) = w1; *(LAS u4*)(Kz + m * 80 + 32 + p * 8) = w2;
#pragma unroll
        for (int q = 0; q < 4; ++q) { const int mr = 32 * q + (tid >> 4), pc = tid & 15;
            *(LAS u4*)(Vl + mr * 144 + pc * 8) = *(const u4*)(Hb + (size_t)(tok0 + mr) * INWP + C_RV + h * 128 + pc * 8); } }
    __syncthreads();
    { const int lane = tid & 63, et = __builtin_amdgcn_readfirstlane(tid >> 6), c = lane & 15, kq = lane >> 4, q = (lane & 15) >> 2, p4 = lane & 3;
        bf16x8 yv[4];
#pragma unroll
        for (int ks = 0; ks < 4; ++ks) yv[ks] = tr_frag(Vl + (32 * ks + 8 * kq + q) * 144 + 16 * et + 4 * p4, 4 * 144);
        float* dst = (float*)(ws + WS_KVST) + (size_t)((b * 4 + h) * 16 + j) * 8192 + 16 * et + c;
#pragma unroll
        for (int dt = 0; dt < 4; ++dt) { f4 acc = mk_f4(0.f, 0.f, 0.f, 0.f);
#pragma unroll
            for (int ks = 0; ks < 4; ++ks) acc = MFMA16(tr_frag(Kz + (32 * ks + 8 * kq + q) * 80 + 16 * dt + 4 * p4, 4 * 80), yv[ks], acc);
#pragma unroll
            for (int i = 0; i < 4; ++i) dst[(16 * dt + 4 * kq + i) * 128] = acc[i]; } }
    __syncthreads();
}
__device__ __forceinline__ void unit_sgu_mfma(const Params& P, unsigned char* ws, int l, LAS unsigned char* lds, int u, int tid, int lane, int wave) {
    const int b = u >> 6, c = (u >> 2) & 15, g = u & 3;
    const bf16* Hb = (const bf16*)(ws + WS_H);
    LAS bf16* vn = (LAS bf16*)lds;
    const int tok0 = b * T + c * 128;
    const float* lng = P.in[4] + l * 512 + g * 128; const float* lnb = P.in[5] + l * 512 + g * 128;
    { const int srow = tid >> 2, part = tid & 3;
        const u4* vp = (const u4*)(Hb + (size_t)(tok0 + srow) * INWP + C_SV + g * 128 + part * 8);
        float f[32];
#pragma unroll
        for (int j = 0; j < 4; ++j) { const u4 a = vp[4 * j]; unpack8(a, f + 8 * j); }
        float s1 = 0.f;
#pragma unroll
        for (int i = 0; i < 32; ++i) s1 += f[i];
        s1 += DPP_F(s1, 0xB1); s1 += DPP_F(s1, 0x4E);
        const float mu = s1 * (1.f / 128.f); float s2 = 0.f;
#pragma unroll
        for (int i = 0; i < 32; ++i) { f[i] -= mu; s2 += f[i] * f[i]; }
        s2 += DPP_F(s2, 0xB1); s2 += DPP_F(s2, 0x4E);
        const float rstd = rsqrtf(s2 * (1.f / 128.f) + LN_EPS);
        LAS u4* dp = (LAS u4*)(vn + srow * 144 + part * 8);
#pragma unroll
        for (int j = 0; j < 4; ++j) { const f4 ga = *(const f4*)(lng + part * 8 + 32 * j), gb = *(const f4*)(lng + part * 8 + 32 * j + 4), ba = *(const f4*)(lnb + part * 8 + 32 * j), bb = *(const f4*)(lnb + part * 8 + 32 * j + 4);
            u4 w; w.x = pkbf(f[8 * j] * rstd * ga.x + ba.x, f[8 * j + 1] * rstd * ga.y + ba.y); w.y = pkbf(f[8 * j + 2] * rstd * ga.z + ba.z, f[8 * j + 3] * rstd * ga.w + ba.w);
            w.z = pkbf(f[8 * j + 4] * rstd * gb.x + bb.x, f[8 * j + 5] * rstd * gb.y + bb.y); w.w = pkbf(f[8 * j + 6] * rstd * gb.z + bb.z, f[8 * j + 7] * rstd * gb.w + bb.w);
            dp[4 * j] = w; } }
    __syncthreads();
    { const int cc = lane & 15, kq = lane >> 4, q = (lane & 15) >> 2, p4 = lane & 3, t = 16 * wave + cc, nks = (wave >> 1) + 1;
        const float* wrow = P.in[6] + ((size_t)l * 4 + g) * 16384 + (size_t)t * 128 + 8 * kq;
        bf16x8 xw[4];
#pragma unroll
        for (int ks = 0; ks < 4; ++ks) { u4 w = {0u, 0u, 0u, 0u};
            if (ks < nks) { const f4 a0 = *(const f4*)(wrow + 32 * ks), a1 = *(const f4*)(wrow + 32 * ks + 4); const int s0 = 32 * ks + 8 * kq;
                w.x = pkbf(s0 + 0 <= t ? a0.x : 0.f, s0 + 1 <= t ? a0.y : 0.f); w.y = pkbf(s0 + 2 <= t ? a0.z : 0.f, s0 + 3 <= t ? a0.w : 0.f);
                w.z = pkbf(s0 + 4 <= t ? a1.x : 0.f, s0 + 5 <= t ? a1.y : 0.f); w.w = pkbf(s0 + 6 <= t ? a1.z : 0.f, s0 + 7 <= t ? a1.w : 0.f); }
            xw[ks] = __builtin_bit_cast(bf16x8, w); }
        f4 bs4; { const float* bsp = P.in[7] + (l * 4 + g) * 128 + 16 * wave + 4 * kq; bs4 = *(const f4*)bsp; }
#pragma unroll 2
        for (int dt = 0; dt < 8; ++dt) { f4 acc = mk_f4(0.f, 0.f, 0.f, 0.f);
#pragma unroll
            for (int ks = 0; ks < 4; ++ks) if (ks < nks) acc = MFMA16(xw[ks], tr_frag(vn + (32 * ks + 8 * kq + q) * 144 + 16 * dt + 4 * p4, 4 * 144), acc);
            const int d = 16 * dt + cc;
#pragma unroll
            for (int i = 0; i < 4; ++i) { const int tt = 16 * wave + 4 * kq + i; const float uu = bf2f(Hb[(size_t)(tok0 + tt) * INWP + C_SU + g * 128 + d]);
                ((float*)(ws + WS_YSG))[(size_t)(tok0 + tt) * 512 + g * 128 + d] = uu * (acc[i] + bs4[i]); } } }
    __syncthreads();
}

__device__ __forceinline__ void row_mixnorm(const Params& P, unsigned char* ws, int l, int rowi, int lane) {
    const u2* yp = (const u2*)((const bf16*)(ws + WS_YMIX) + (size_t)rowi * D) + lane; const f4* ysg = (const f4*)((const float*)(ws + WS_YSG) + (size_t)rowi * 512) + lane;
    const f4* gp = (const f4*)(P.in[14] + (size_t)l * D) + lane;
    f4 v[8]; float ss[8];
#pragma unroll
    for (int j = 0; j < 8; ++j) { if (j == 2 || j == 3) v[j] = ysg[64 * (j - 2)]; else { const u2 w = yp[64 * j]; v[j] = mk_f4(__uint_as_float(w.x << 16), __uint_as_float(w.x & 0xffff0000u), __uint_as_float(w.y << 16), __uint_as_float(w.y & 0xffff0000u));
            if (j >= 4) { const u2 w1 = yp[64 * j + YB_SEL / 4], w2 = yp[64 * j + YB_WIN / 4];
                v[j] += mk_f4(__uint_as_float(w1.x << 16), __uint_as_float(w1.x & 0xffff0000u), __uint_as_float(w1.y << 16), __uint_as_float(w1.y & 0xffff0000u)) + mk_f4(__uint_as_float(w2.x << 16), __uint_as_float(w2.x & 0xffff0000u), __uint_as_float(w2.y << 16), __uint_as_float(w2.y & 0xffff0000u)); } }
        ss[j] = v[j].x * v[j].x + v[j].y * v[j].y + v[j].z * v[j].z + v[j].w * v[j].w; }
    const float r0 = rsqrtf(wave_sum(ss[0] + ss[1]) * (1.f / 512.f) + LN_EPS);
    const float r1 = rsqrtf(wave_sum(ss[2] + ss[3]) * (1.f / 512.f) + LN_EPS);
    const float r2 = rsqrtf(wave_sum((ss[4] + ss[5]) + (ss[6] + ss[7])) * (1.f / 1024.f) + LN_EPS);
    u2* op = (u2*)((bf16*)(ws + WS_MIXED) + (size_t)rowi * D) + lane;
#pragma unroll
    for (int j = 0; j < 8; ++j) { const float r = (j < 2) ? r0 : ((j < 4) ? r1 : r2); const f4 g4 = gp[64 * j];
        op[64 * j] = mk_u2(pk2(v[j].x * r * g4.x, v[j].y * r * g4.y), pk2(v[j].z * r * g4.z, v[j].w * r * g4.w)); }
}
__device__ __forceinline__ void row_ln(const bf16* __restrict__ zin, const float* __restrict__ gam, const float* __restrict__ bet, float* __restrict__ of32, bf16* __restrict__ obf, unsigned* __restrict__ oq, float* __restrict__ osc, int rowi, int lane) {
    const u2* zp = (const u2*)(zin + (size_t)rowi * D) + lane;
    f4 v[8]; float s = 0.f;
#pragma unroll
    for (int j = 0; j < 8; ++j) { const u2 zw = zp[64 * j]; v[j] = mk_f4(__uint_as_float(zw.x << 16), __uint_as_float(zw.x & 0xffff0000u), __uint_as_float(zw.y << 16), __uint_as_float(zw.y & 0xffff0000u)); s += (v[j].x + v[j].y) + (v[j].z + v[j].w); }
    const float mu = wave_sum(s) * (1.f / D); float s2 = 0.f;
#pragma unroll
    for (int j = 0; j < 8; ++j) { v[j].x -= mu; v[j].y -= mu; v[j].z -= mu; v[j].w -= mu; s2 += (v[j].x * v[j].x + v[j].y * v[j].y) + (v[j].z * v[j].z + v[j].w * v[j].w); }
    const float rstd = rsqrtf(wave_sum(s2) * (1.f / D) + LN_EPS);
    if (lane == 0) *(f2*)(of32 + 2 * (size_t)rowi) = mk_f2(mu, rstd);
    u2* o2 = (u2*)(obf + (size_t)rowi * D) + lane;
    const f4* gp = (const f4*)gam + lane; const f4* bp = (const f4*)bet + lane;
    float am = 0.f;
#pragma unroll
    for (int j = 0; j < 8; ++j) { const f4 g4 = gp[64 * j], b4 = bp[64 * j];
        const f4 o = mk_f4(v[j].x * rstd * g4.x + b4.x, v[j].y * rstd * g4.y + b4.y, v[j].z * rstd * g4.z + b4.z, v[j].w * rstd * g4.w + b4.w);
        o2[64 * j] = mk_u2(pk2(o.x, o.y), pk2(o.z, o.w)); v[j] = o;
        am = fmaxf(am, fmaxf(fmaxf(fabsf(o.x), fabsf(o.y)), fmaxf(fabsf(o.z), fabsf(o.w)))); }
#pragma unroll
    for (int o = 1; o < 64; o <<= 1) am = fmaxf(am, __shfl_xor(am, o));
    const float sc = (am > 0.f) ? 127.f / am : 1.f;
    if (lane == 0) osc[rowi] = (am > 0.f) ? am * (1.f / 127.f) : 1.f;
    unsigned* qp = oq + (size_t)rowi * (D / 4) + lane;
#pragma unroll
    for (int j = 0; j < 8; ++j) { const int b0 = (int)rintf(v[j].x * sc), b1 = (int)rintf(v[j].y * sc), b2 = (int)rintf(v[j].z * sc), b3 = (int)rintf(v[j].w * sc);
        qp[64 * j] = (unsigned)(b0 & 0xff) | ((unsigned)(b1 & 0xff) << 8) | ((unsigned)(b2 & 0xff) << 16) | ((unsigned)b3 << 24); }
}

__device__ __forceinline__ float dot8_bf16(const u4& w, const float* x) {
    float f[8]; unpack8(w, f);
    return ((f[0] * x[0] + f[1] * x[1]) + (f[2] * x[2] + f[3] * x[3])) + ((f[4] * x[4] + f[5] * x[5]) + (f[6] * x[6] + f[7] * x[7]));
}
__device__ __forceinline__ void ce_desc(int& a, int& b) { const int hi_ = max(a, b), lo_ = min(a, b); a = hi_; b = lo_; }
__device__ __forceinline__ void sort16_desc(int (&v)[16]) {
#pragma unroll
    for (int k = 2; k <= 16; k <<= 1)
#pragma unroll
        for (int j = k >> 1; j > 0; j >>= 1)
#pragma unroll
            for (int i = 0; i < 16; ++i) { const int l2 = i ^ j; if (l2 > i) { if ((i & k) == 0) ce_desc(v[i], v[l2]); else ce_desc(v[l2], v[i]); } }
}
__device__ __forceinline__ void merge16_desc(int (&t)[16], const int (&b)[16]) {
#pragma unroll
    for (int i = 0; i < 16; ++i) t[i] = max(t[i], b[15 - i]);
#pragma unroll
    for (int j = 8; j > 0; j >>= 1)
#pragma unroll
        for (int i = 0; i < 16; ++i) { const int l2 = i ^ j; if (l2 > i) ce_desc(t[i], t[l2]); }
}
__device__ __forceinline__ void unit_peer(const Params& P, unsigned char* ws, int l, LAS unsigned char* lds, int u, int tid_in, int lane_in, int wave, float* __restrict__ xout) {
    int tid = tid_in; asm volatile("" : "+v"(tid)); int lane = tid & 63;
    const int n0 = u * 32;
    const unsigned short* SC = (const unsigned short*)(ws + WS_SC);
    LAS int* TK = (LAS int*)lds;
    { const int tk = tid >> 4, hh = tid & 15;
        const u4* sp = (const u4*)(SC + ((size_t)(n0 + tk) * 16 + hh) * 128);
        int t[16];
#pragma unroll
        for (int k = 0; k < 16; ++k) t[k] = (int)0x80000000;
#pragma unroll 1
        for (int c8 = 0; c8 < 2; ++c8) { u4 sb[8];
#pragma unroll
            for (int i = 0; i < 8; ++i) sb[i] = sp[8 * c8 + i];
            const int ib = 127 - 64 * c8;
#pragma unroll
            for (int blk = 0; blk < 4; ++blk) { int bk[16];
#pragma unroll
                for (int e = 0; e < 8; ++e) { const unsigned w = (e < 4) ? sb[2 * blk][e & 3] : sb[2 * blk + 1][e & 3];
                    int lo_ = (int)(w << 16), hi_ = (int)(w & 0xffff0000u);
                    lo_ ^= (lo_ >> 31) & 0x7fff0000; hi_ ^= (hi_ >> 31) & 0x7fff0000;
                    bk[2 * e] = lo_ | (ib - (16 * blk + 2 * e)); bk[2 * e + 1] = hi_ | (ib - (16 * blk + 2 * e + 1)); }
                sort16_desc(bk); merge16_desc(t, bk); } }
#pragma unroll
        for (int k = 0; k < 16; ++k) TK[tid * 17 + k] = t[k]; }
    __syncthreads();
    tid = tid_in; asm volatile("" : "+v"(tid)); lane = tid & 63;
    LAS int* PE = (LAS int*)(lds + 69632);
    LAS float* PW = (LAS float*)(lds + 86016);
    if (tid < 256) { const int tk = tid >> 3, h = tid & 7; const int r1 = tk * 16 + 2 * h, r2 = r1 + 1;
        float v1[16], v2[16];
#pragma unroll
        for (int k = 0; k < 16; ++k) { const int k1 = TK[r1 * 17 + k] & 0xffff0000, k2 = TK[r2 * 17 + k] & 0xffff0000;
            v1[k] = (float)__builtin_bit_cast(_Float16, (unsigned short)((unsigned)(k1 ^ ((k1 >> 31) & 0x7fff0000)) >> 16));
            v2[k] = (float)__builtin_bit_cast(_Float16, (unsigned short)((unsigned)(k2 ^ ((k2 >> 31) & 0x7fff0000)) >> 16)); }
        int t[16];
#pragma unroll
        for (int k = 0; k < 16; ++k) t[k] = (int)0x80000000;
#pragma unroll
        for (int a = 0; a < 16; ++a)
#pragma unroll
            for (int bq = 0; bq < 16; ++bq) if ((a + 1) * (bq + 1) <= 16) { const int bits = __float_as_int(v1[a] + v2[bq]); const int sk = bits ^ ((bits >> 31) & 0x7fffffff);
                int x = (sk & ~255) | (255 - (a * 16 + bq));
#pragma unroll
                for (int k = 0; k < 16; ++k) { const int hi_ = max(t[k], x); x = min(t[k], x); t[k] = hi_; } }
        float w[16], wsum = 0.f; const int kt0 = t[0] & ~255; const float top = __int_as_float(kt0 ^ ((kt0 >> 31) & 0x7fffffff));
#pragma unroll
        for (int k = 0; k < 16; ++k) { const int kk = t[k] & ~255; const float sv = __int_as_float(kk ^ ((kk >> 31) & 0x7fffffff)); w[k] = __expf(sv - top); wsum += w[k]; }
        const float inv = 1.f / wsum;
#pragma unroll
        for (int k = 0; k < 16; ++k) { const int ab = 255 - (t[k] & 255); const int a = ab >> 4, bq = ab & 15;
            const int i1 = 127 - (TK[r1 * 17 + a] & 127), i2 = 127 - (TK[r2 * 17 + bq] & 127);
            PE[tk * 128 + h * 16 + k] = i1 * 128 + i2; PW[tk * 128 + h * 16 + k] = w[k] * inv; } }
    __syncthreads();
    tid = tid_in; asm volatile("" : "+v"(tid)); lane = tid & 63;
    { int* FE = (int*)(ws + WS_FE) + (size_t)u * 16 * FCAP; float* FW = (float*)(ws + WS_FW) + (size_t)u * 16 * FCAP; int* GST = (int*)(ws + WS_GST) + (size_t)u * 16 * 64;
        LAS int* CNT = (LAS int*)(lds + 118784);
        LAS int* STA = (LAS int*)(lds + 120832);
#pragma unroll 1
        for (int it = 0; it < 4; ++it) { const int tk = wave * 4 + it;
            const int k0 = PE[tk * 128 + lane] >> BSH, k1 = PE[tk * 128 + 64 + lane] >> BSH; int mycnt = 0;
#pragma unroll
            for (int v = 0; v < NBKT; ++v) { const int c = __builtin_popcountll(__builtin_amdgcn_ballot_w64(k0 == v)) + __builtin_popcountll(__builtin_amdgcn_ballot_w64(k1 == v)); if (lane == v) mycnt = (c + PG - 1) & ~(PG - 1); }
            if (lane < NBKT) CNT[tk * 16 + lane] = mycnt; }
        __syncthreads();
        if (tid < NBKT) { int run = 0;
#pragma unroll 1
            for (int t = 0; t < 32; ++t) { STA[t * 16 + tid] = run; run += CNT[t * 16 + tid]; }
            STA[32 * 16 + tid] = run; }
        __syncthreads();
        for (int i = tid; i < NBKT * 33; i += 512) { const int bb = i / 33, t = i % 33; GST[bb * 64 + t] = STA[t * 16 + bb]; }
#pragma unroll 1
        for (int it = 0; it < 4; ++it) { const int tk = wave * 4 + it;
            const int e0 = PE[tk * 128 + lane], e1 = PE[tk * 128 + 64 + lane]; const float w0 = PW[tk * 128 + lane], w1 = PW[tk * 128 + 64 + lane];
            const int k0 = e0 >> BSH, k1 = e1 >> BSH; int pos0 = 0, pos1 = 0;
#pragma unroll
            for (int v = 0; v < NBKT; ++v) { const unsigned long long b0 = __builtin_amdgcn_ballot_w64(k0 == v), b1 = __builtin_amdgcn_ballot_w64(k1 == v);
                const int c0 = __builtin_popcountll(b0), c = c0 + __builtin_popcountll(b1), pc = (c + PG - 1) & ~(PG - 1); const int base = STA[tk * 16 + v];
                const int r0 = (int)__builtin_amdgcn_mbcnt_hi((unsigned)(b0 >> 32), __builtin_amdgcn_mbcnt_lo((unsigned)b0, 0u));
                const int r1 = c0 + (int)__builtin_amdgcn_mbcnt_hi((unsigned)(b1 >> 32), __builtin_amdgcn_mbcnt_lo((unsigned)b1, 0u));
                if (k0 == v) pos0 = v * FCAP + base + r0;
                if (k1 == v) pos1 = v * FCAP + base + r1;
                if (lane < pc - c) { FE[v * FCAP + base + c + lane] = v << BSH; FW[v * FCAP + base + c + lane] = 0.f; } }
            FE[pos0] = e0; FW[pos0] = w0; FE[pos1] = e1; FW[pos1] = w1; } }
    __syncthreads();
}

__device__ __forceinline__ void peer3_rows(u4 (&R)[PG][2], const unsigned char* __restrict__ TAB, int ev, int g, int lane) {
#pragma unroll
    for (int k = 0; k < PG; ++k) { const int e = __builtin_amdgcn_readlane(ev, PG * g + k); const unsigned char* rowp = TAB + (size_t)(unsigned)e * 2048u; R[k][0] = *(const u4*)(rowp + (unsigned)lane * 16u); R[k][1] = *(const u4*)(rowp + 1024u + (unsigned)lane * 16u); }
}
__device__ __forceinline__ float wave_sum_dpp(float v) {
    v += DPP_F(v, 0xB1); v += DPP_F(v, 0x4E); v += DPP_F(v, 0x141); v += DPP_F(v, 0x140);
    const int iv = __float_as_int(v);
    return (__int_as_float(__builtin_amdgcn_readlane(iv, 0)) + __int_as_float(__builtin_amdgcn_readlane(iv, 16))) + (__int_as_float(__builtin_amdgcn_readlane(iv, 32)) + __int_as_float(__builtin_amdgcn_readlane(iv, 48)));
}
__device__ __forceinline__ float dot16_pk(const u4& w, const f2* x) {
    f2 a = {0.f, 0.f};
#pragma unroll
    for (int q = 0; q < 4; ++q) { const f2 lo = __builtin_amdgcn_cvt_pk_f32_fp8((int)w[q], false), hi = __builtin_amdgcn_cvt_pk_f32_fp8((int)w[q], true);
        a = __builtin_elementwise_fma(lo, x[2 * q], a); a = __builtin_elementwise_fma(hi, x[2 * q + 1], a); }
    return a.x + a.y;
}
__device__ __forceinline__ int wave_isum_dpp(int v) {
    v += __builtin_amdgcn_update_dpp(0, v, 0xB1, 0xf, 0xf, true); v += __builtin_amdgcn_update_dpp(0, v, 0x4E, 0xf, 0xf, true);
    v += __builtin_amdgcn_update_dpp(0, v, 0x141, 0xf, 0xf, true); v += __builtin_amdgcn_update_dpp(0, v, 0x140, 0xf, 0xf, true);
    return (__builtin_amdgcn_readlane(v, 0) + __builtin_amdgcn_readlane(v, 16)) + (__builtin_amdgcn_readlane(v, 32) + __builtin_amdgcn_readlane(v, 48));
}
__device__ __forceinline__ int wave_isum4_t(const int (&d)[4], int lane) {
    const bool o1 = lane & 1, o2 = lane & 2;
    int a = o1 ? d[1] : d[0], b = o1 ? d[0] : d[1], c = o1 ? d[3] : d[2], e = o1 ? d[2] : d[3];
    a += __builtin_amdgcn_update_dpp(0, b, 0xB1, 0xf, 0xf, true);
    c += __builtin_amdgcn_update_dpp(0, e, 0xB1, 0xf, 0xf, true);
    int f = o2 ? c : a, g = o2 ? a : c;
    f += __builtin_amdgcn_update_dpp(0, g, 0x4E, 0xf, 0xf, true);
    f += __builtin_amdgcn_update_dpp(0, f, 0x124, 0xf, 0xf, true);
    f += __builtin_amdgcn_update_dpp(0, f, 0x128, 0xf, 0xf, true);
    f = x32_sum(x16_sum(f));
    return f;
}
__device__ __forceinline__ void peer3_dots(const u4 (&R)[PG][2], const u4 (&xq)[2], LAS int* redrow, int g) {
    static_assert(PG == 4, "one 16-byte LDS store per row group");
    int d[4];
#pragma unroll
    for (int k = 0; k < 4; ++k) { int a = 0;
#pragma unroll
        for (int j = 0; j < 2; ++j)
#pragma unroll
            for (int q = 0; q < 4; ++q) a = __builtin_amdgcn_sdot4((int)R[k][j][q], (int)xq[j][q], a, false);
        d[k] = a; }
    u4 w; w.x = (unsigned)d[0]; w.y = (unsigned)d[1]; w.z = (unsigned)d[2]; w.w = (unsigned)d[3];
    *(LAS u4*)(redrow + 4 * g) = w;
}
__device__ __forceinline__ void peer3_axpy(const u4 (&R)[PG][2], f2 (&acc)[16], int hwv, int g) {
#pragma unroll
    for (int k = 0; k < PG; ++k) { const float hw = __int_as_float(__builtin_amdgcn_readlane(hwv, PG * g + k)); const f2 hw2 = {hw, hw};
#pragma unroll
        for (int j = 0; j < 2; ++j)
#pragma unroll
            for (int q = 0; q < 4; ++q) { const f2 lo = __builtin_amdgcn_cvt_pk_f32_fp8((int)R[k][j][q], false), hi = __builtin_amdgcn_cvt_pk_f32_fp8((int)R[k][j][q], true);
                acc[8 * j + 2 * q] = __builtin_elementwise_fma(lo, hw2, acc[8 * j + 2 * q]); acc[8 * j + 2 * q + 1] = __builtin_elementwise_fma(hi, hw2, acc[8 * j + 2 * q + 1]); }
        __builtin_amdgcn_sched_barrier(0); }
}
__device__ __forceinline__ void unpack_row(const u4 (&X)[4], f2 (&o)[16]) {
#pragma unroll
    for (int i = 0; i < 4; ++i) { o[4 * i].x = __uint_as_float(X[i].x << 16); o[4 * i].y = __uint_as_float(X[i].x & 0xffff0000u); o[4 * i + 1].x = __uint_as_float(X[i].y << 16); o[4 * i + 1].y = __uint_as_float(X[i].y & 0xffff0000u);
        o[4 * i + 2].x = __uint_as_float(X[i].z << 16); o[4 * i + 2].y = __uint_as_float(X[i].z & 0xffff0000u); o[4 * i + 3].x = __uint_as_float(X[i].w << 16); o[4 * i + 3].y = __uint_as_float(X[i].w & 0xffff0000u); }
}
__device__ __forceinline__ float wave_max_dpp(float v) {
    v = fmaxf(v, DPP_F(v, 0xB1)); v = fmaxf(v, DPP_F(v, 0x4E)); v = fmaxf(v, DPP_F(v, 0x141)); v = fmaxf(v, DPP_F(v, 0x140));
    const int iv = __float_as_int(v);
    return fmaxf(fmaxf(__int_as_float(__builtin_amdgcn_readlane(iv, 0)), __int_as_float(__builtin_amdgcn_readlane(iv, 16))), fmaxf(__int_as_float(__builtin_amdgcn_readlane(iv, 32)), __int_as_float(__builtin_amdgcn_readlane(iv, 48))));
}
__device__ __forceinline__ void peer3_rowstore(unsigned char* __restrict__ base, float* __restrict__ scl, unsigned n, int lane, const f2 (&acc)[16]) {
    float am = 0.f;
#pragma unroll
    for (int i = 0; i < 16; ++i) am = fmaxf(am, fmaxf(fabsf(acc[i].x), fabsf(acc[i].y)));
    am = wave_max_dpp(am);
    const float sc = (am > 0.f) ? 448.f / am : 1.f;
    if (lane == 0) scl[n] = (am > 0.f) ? am * (1.f / 448.f) : 0.f;
    unsigned char* p = base + ((size_t)n * 2048u + (unsigned)(16 * lane));
#pragma unroll
    for (int j = 0; j < 2; ++j) { u4 w;
#pragma unroll
        for (int q = 0; q < 4; ++q) { const f2 a = acc[8 * j + 2 * q], b = acc[8 * j + 2 * q + 1]; int r = __builtin_amdgcn_cvt_pk_fp8_f32(a.x * sc, a.y * sc, 0, false); r = __builtin_amdgcn_cvt_pk_fp8_f32(b.x * sc, b.y * sc, r, true); w[q] = (unsigned)r; }
        __builtin_nontemporal_store(w, (u4*)(p + 1024 * j)); }
}
__device__ __forceinline__ int peer3_next_nonempty(int gstv, int t) {
    while (t < 32 && __builtin_amdgcn_readlane(gstv, t + 1) == __builtin_amdgcn_readlane(gstv, t)) ++t;
    return t;
}
__device__ __forceinline__ void phase_peer_bucket(const Params& P, unsigned char* ws, int l, LAS unsigned char* lds, int bid, int G, int lane, int wave) {
    LAS int* red = (LAS int*)lds + wave * (64 * 68);
    const int x = bid & 7, r = bid >> 3;
    const int u = r * 8 + wave; const unsigned nbase = (unsigned)u * 32u;
    const unsigned char* PU = ws + WS_PU + (size_t)l * 16384 * 2048; const unsigned char* PV = ws + WS_PV + (size_t)l * 16384 * 2048;
    const float* USC = (const float*)(ws + WS_PSC) + (size_t)l * 16384; const float* VSC = (const float*)(ws + WS_PSC) + (size_t)(DEPTH + l) * 16384;
    const bf16* X1B = (const bf16*)(ws + WS_X1B);
    static_assert(NRND == 1, "fp8 partials are written once: one round per workgroup");
    unsigned char* PART = ws + WS_PART + (size_t)x * NTOK * D; float* PSCL = (float*)(ws + WS_PSCL) + (size_t)x * NTOK;
#pragma unroll 1
    for (int rnd = 0; rnd < NRND; ++rnd) { const int xb = x + 8 * rnd;
        const int* FE = (const int*)(ws + WS_FE) + ((size_t)u * 16 + xb) * FCAP; const float* FW = (const float*)(ws + WS_FW) + ((size_t)u * 16 + xb) * FCAP; float* FHW = (float*)(ws + WS_FHW) + ((size_t)u * 16 + xb) * FCAP;
        int gstv = 0; if (lane <= 32) gstv = ((const int*)(ws + WS_GST))[((size_t)u * 16 + xb) * 64 + lane];
        const int total = __builtin_amdgcn_readlane(gstv, 32);
        REP(30) if (total > 0) {
            const unsigned char* X1Q = ws + WS_X1Q;
            float xsc_v = 0.f; if (lane < 32) xsc_v = ((const float*)(ws + WS_XSC))[nbase + lane];
            int tcur = peer3_next_nonempty(gstv, 0); int tnx = peer3_next_nonempty(gstv, tcur + 1); int tend = __builtin_amdgcn_readlane(gstv, tcur + 1);
            u4 xq[2], xn[2];
            { const unsigned char* p = X1Q + (size_t)(nbase + tcur) * 2048u + (unsigned)lane * 16u; xq[0] = __builtin_nontemporal_load((const u4*)p); xq[1] = __builtin_nontemporal_load((const u4*)(p + 1024)); }
            if (tnx < 32) { const unsigned char* p = X1Q + (size_t)(nbase + tnx) * 2048u + (unsigned)lane * 16u; xn[0] = __builtin_nontemporal_load((const u4*)p); xn[1] = __builtin_nontemporal_load((const u4*)(p + 1024)); }
            float xs = __int_as_float(__builtin_amdgcn_readlane(__float_as_int(xsc_v), tcur));
            int evn = 0; float wvn = 0.f;
            if (lane < total) { evn = __builtin_nontemporal_load(FE + lane); wvn = __builtin_nontemporal_load(FW + lane); }
#define PU_SWITCH(gi) if (blk + PG * (gi) >= tend) { tcur = tnx; xq[0] = xn[0]; xq[1] = xn[1]; xs = __int_as_float(__builtin_amdgcn_readlane(__float_as_int(xsc_v), tcur)); tend = __builtin_amdgcn_readlane(gstv, tcur + 1); \
                        tnx = peer3_next_nonempty(gstv, tcur + 1); if (tnx < 32) { const unsigned char* p_ = X1Q + (size_t)(nbase + tnx) * 2048u + (unsigned)lane * 16u; xn[0] = __builtin_nontemporal_load((const u4*)p_); xn[1] = __builtin_nontemporal_load((const u4*)(p_ + 1024)); } }
#define PU_DO(R, gi) do { PU_SWITCH(gi) peer3_dots(R, xq, red + lane * 68, (gi)); xsv = (lane >= PG * (gi) && lane < PG * (gi) + PG) ? xs : xsv; } while (0)
#pragma unroll 1
            for (int blk = 0; blk < total; blk += 64) { const int blen = (total - blk) < 64 ? (total - blk) : 64, ng = blen / PG;
                const int ev = evn; const float wv = wvn;
                if (blk + 64 + lane < total) { evn = __builtin_nontemporal_load(FE + blk + 64 + lane); wvn = __builtin_nontemporal_load(FW + blk + 64 + lane); }
                const float us = USC[ev], vs = VSC[ev];
                float xsv = 0.f; u4 A[PG][2], B[PG][2], C[PG][2], Dq[PG][2];
                peer3_rows(A, PU, ev, 0, lane); if (1 < ng) peer3_rows(B, PU, ev, 1, lane); if (2 < ng) peer3_rows(C, PU, ev, 2, lane);
#pragma unroll 1
                for (int g = 0; g < ng; g += 4) {
                    if (g + 3 < ng) peer3_rows(Dq, PU, ev, g + 3, lane);
                    PU_DO(A, g);
                    if (g + 4 < ng) peer3_rows(A, PU, ev, g + 4, lane);
                    if (g + 1 < ng) PU_DO(B, g + 1);
                    if (g + 5 < ng) peer3_rows(B, PU, ev, g + 5, lane);
                    if (g + 2 < ng) PU_DO(C, g + 2);
                    if (g + 6 < ng) peer3_rows(C, PU, ev, g + 6, lane);
                    if (g + 3 < ng) PU_DO(Dq, g + 3);
                }
                int dv = 0;
#pragma unroll 16
                for (int r_ = 0; r_ < 64; ++r_) dv += red[r_ * 68 + lane];
                if (lane < blen) FHW[blk + lane] = wv * gelu_tanh((float)dv * us * xsv) * vs;
            }
#undef PU_SWITCH
#undef PU_DO
        }
        VM_WAIT();
        REP(31) { f2 acc[16];
#pragma unroll
            for (int i = 0; i < 16; ++i) acc[i] = (f2){0.f, 0.f};
#pragma unroll 1
            for (int t = 0; t < 32; ++t) if (__builtin_amdgcn_readlane(gstv, t + 1) == __builtin_amdgcn_readlane(gstv, t)) peer3_rowstore(PART, PSCL, nbase + t, lane, acc);
            if (total > 0) {
                int tcur = peer3_next_nonempty(gstv, 0); int tnx = peer3_next_nonempty(gstv, tcur + 1); int tend = __builtin_amdgcn_readlane(gstv, tcur + 1);
                int evn = 0, hwn = 0;
                if (lane < total) { evn = __builtin_nontemporal_load(FE + lane); hwn = (int)__hip_atomic_load((const unsigned*)(FHW + lane), __ATOMIC_RELAXED, __HIP_MEMORY_SCOPE_AGENT); }
#define PV_SWITCH(gi) if (blk + PG * (gi) >= tend) { peer3_rowstore(PART, PSCL, nbase + tcur, lane, acc); tcur = tnx; tend = __builtin_amdgcn_readlane(gstv, tcur + 1); \
                        _Pragma("unroll") for (int i_ = 0; i_ < 16; ++i_) acc[i_] = (f2){0.f, 0.f}; tnx = peer3_next_nonempty(gstv, tcur + 1); }
#define PV_DO(R, gi) do { PV_SWITCH(gi) peer3_axpy(R, acc, hwv, (gi)); } while (0)
#pragma unroll 1
                for (int blk = 0; blk < total; blk += 64) { const int blen = (total - blk) < 64 ? (total - blk) : 64, ng = blen / PG;
                    const int ev = evn, hwv = hwn;
                    if (blk + 64 + lane < total) { evn = __builtin_nontemporal_load(FE + blk + 64 + lane); hwn = (int)__hip_atomic_load((const unsigned*)(FHW + blk + 64 + lane), __ATOMIC_RELAXED, __HIP_MEMORY_SCOPE_AGENT); }
                    u4 A[PG][2], B[PG][2], C[PG][2], Dq[PG][2];
                    peer3_rows(A, PV, ev, 0, lane); if (1 < ng) peer3_rows(B, PV, ev, 1, lane); if (2 < ng) peer3_rows(C, PV, ev, 2, lane);
#pragma unroll 1
                    for (int g = 0; g < ng; g += 4) {
                        if (g + 3 < ng) peer3_rows(Dq, PV, ev, g + 3, lane);
                        PV_DO(A, g);
                        if (g + 4 < ng) peer3_rows(A, PV, ev, g + 4, lane);
                        if (g + 1 < ng) PV_DO(B, g + 1);
                        if (g + 5 < ng) peer3_rows(B, PV, ev, g + 5, lane);
                        if (g + 2 < ng) PV_DO(C, g + 2);
                        if (g + 6 < ng) peer3_rows(C, PV, ev, g + 6, lane);
                        if (g + 3 < ng) PV_DO(Dq, g + 3);
                    } }
#undef PV_SWITCH
#undef PV_DO
                peer3_rowstore(PART, PSCL, nbase + tcur, lane, acc);
            } }
        VM_WAIT();
    }
}
__device__ __forceinline__ void row_peer_reduce(const Params& P, unsigned char* ws, int l, int rowi, int lane, float* __restrict__ xout) {
    const size_t n = (size_t)rowi; const bf16* Z = (const bf16*)(ws + WS_Z); const unsigned char* PARTQ = ws + WS_PART; const float* PSCL = (const float*)(ws + WS_PSCL);
    const f2 st = *(const f2*)((const float*)(ws + WS_X1) + 2 * n);
    const float* g1 = P.in[16] + (size_t)l * D; const float* b1 = P.in[17] + (size_t)l * D;
    float acc[32];
#pragma unroll
    for (int j = 0; j < 2; ++j)
#pragma unroll
        for (int q = 0; q < 4; ++q) { const int col = 1024 * j + 16 * lane + 4 * q; const u2 zw = *(const u2*)(Z + n * D + col); const f4 a = mk_f4(__uint_as_float(zw.x << 16), __uint_as_float(zw.x & 0xffff0000u), __uint_as_float(zw.y << 16), __uint_as_float(zw.y & 0xffff0000u)), gg = *(const f4*)(g1 + col), bb = *(const f4*)(b1 + col);
            acc[16 * j + 4 * q] = ALPHA * ((a.x - st.x) * st.y * gg.x + bb.x); acc[16 * j + 4 * q + 1] = ALPHA * ((a.y - st.x) * st.y * gg.y + bb.y);
            acc[16 * j + 4 * q + 2] = ALPHA * ((a.z - st.x) * st.y * gg.z + bb.z); acc[16 * j + 4 * q + 3] = ALPHA * ((a.w - st.x) * st.y * gg.w + bb.w); }
#pragma unroll 2
    for (int xb_ = 0; xb_ < 8; ++xb_) { const unsigned char* pp = PARTQ + ((size_t)xb_ * NTOK + n) * 2048u + (unsigned)(16 * lane); const float psc = PSCL[(size_t)xb_ * NTOK + n];
#pragma unroll
        for (int j = 0; j < 2; ++j) { const u4 a = *(const u4*)(pp + 1024 * j);
#pragma unroll
            for (int q = 0; q < 4; ++q) { const f2 lo = __builtin_amdgcn_cvt_pk_f32_fp8((int)a[q], false), hi = __builtin_amdgcn_cvt_pk_f32_fp8((int)a[q], true);
                acc[16 * j + 4 * q] += psc * lo.x; acc[16 * j + 4 * q + 1] += psc * lo.y; acc[16 * j + 4 * q + 2] += psc * hi.x; acc[16 * j + 4 * q + 3] += psc * hi.y; } } }
    float s = 0.f;
#pragma unroll
    for (int i = 0; i < 32; ++i) s += acc[i];
    const float mu = wave_sum(s) * (1.f / D); float s2 = 0.f;
#pragma unroll
    for (int i = 0; i < 32; ++i) { acc[i] -= mu; s2 += acc[i] * acc[i]; }
    const float rstd = rsqrtf(wave_sum(s2) * (1.f / D) + LN_EPS);
    const float* gam = P.in[23] + (size_t)l * D; const float* bet = P.in[24] + (size_t)l * D;
    bf16* xb = (bf16*)(ws + WS_XB);
#pragma unroll
    for (int j = 0; j < 2; ++j) { const int col = 1024 * j + 16 * lane; float o[16];
#pragma unroll
        for (int q = 0; q < 4; ++q) { const f4 g4 = *(const f4*)(gam + col + 4 * q), b4 = *(const f4*)(bet + col + 4 * q);
            o[4 * q] = acc[16 * j + 4 * q] * rstd * g4.x + b4.x; o[4 * q + 1] = acc[16 * j + 4 * q + 1] * rstd * g4.y + b4.y; o[4 * q + 2] = acc[16 * j + 4 * q + 2] * rstd * g4.z + b4.z; o[4 * q + 3] = acc[16 * j + 4 * q + 3] * rstd * g4.w + b4.w;
            if (xout) *(f4*)(xout + n * D + col + 4 * q) = mk_f4(o[4 * q], o[4 * q + 1], o[4 * q + 2], o[4 * q + 3]); }
        if (xout) continue;
        u4 p0, p1; p0.x = pk2(o[0], o[1]); p0.y = pk2(o[2], o[3]); p0.z = pk2(o[4], o[5]); p0.w = pk2(o[6], o[7]); p1.x = pk2(o[8], o[9]); p1.y = pk2(o[10], o[11]); p1.z = pk2(o[12], o[13]); p1.w = pk2(o[14], o[15]);
        *(u4*)(xb + n * D + col) = p0; *(u4*)(xb + n * D + col + 8) = p1; }
}

template <class T> __device__ __forceinline__ T* uniform_ptr(T* p) { const unsigned long long v = (unsigned long long)p; const unsigned lo = __builtin_amdgcn_readfirstlane((unsigned)v), hi = __builtin_amdgcn_readfirstlane((unsigned)(v >> 32)); return (T*)(__attribute__((address_space(1))) T*)(((unsigned long long)hi << 32) | lo); }
constexpr int PH_PER_LAYER = 10, N_PHASES = 1 + DEPTH * PH_PER_LAYER;
#ifndef ONLY_PHASE
#define ONLY_PHASE -1
#endif
#define EN(i) (ONLY_PHASE < 0 || ONLY_PHASE == (i))
__global__ void __launch_bounds__(512, 2) mk_fwd(Params P) {
    extern __shared__ __attribute__((aligned(16))) unsigned char lds_raw[];
    LAS unsigned char* lds = (LAS unsigned char*)lds_raw;
    volatile LAS unsigned* MISC = (volatile LAS unsigned*)(lds + MISC_OFF);
    const int tid = threadIdx.x, lane = tid & 63, wave = __builtin_amdgcn_readfirstlane(tid >> 6);
    const int G = gridDim.x, bid = blockIdx.x;
    if (tid < 64) MISC[tid] = 0u;
    __syncthreads();
    unsigned char* const ws0 = uniform_ptr(P.ws);
    unsigned* ctl = (unsigned*)(ws0 + WS_CTL);
    const XcdBarrier bar = xcd_barrier_post(ctl + CW_BAR, MISC + 8);
    const int lo = P.ph_lo, hi = P.ph_hi;
#define IN(k) (lo <= (k) && (k) < hi)
#define LAUNDER() int tl; asm volatile("v_mbcnt_lo_u32_b32 %0, -1, 0\n\tv_mbcnt_hi_u32_b32 %0, -1, %0" : "=v"(tl)); tl |= (wave << 6); __attribute__((address_space(1))) unsigned char* wsg_ = (__attribute__((address_space(1))) unsigned char*)ws0; asm volatile("" : "+s"(wsg_)); unsigned char* ws = (unsigned char*)wsg_; const int ll = tl & 63; const int wl = __builtin_amdgcn_readfirstlane(tl >> 6); (void)ll; (void)wl
#define SEAM(k) do { if (IN((k) + 1)) xcd_barrier(bar); } while (0)
    if (IN(0) && EN(20)) { LAUNDER(); REP(20) phase_prologue(P, ws, lds, tl, ll, wl); SEAM(0); }
    for (int l = 0; l < DEPTH; ++l) {
        const int pb = 1 + l * PH_PER_LAYER;
        float* xout = (l == DEPTH - 1) ? P.out : nullptr;
        if (IN(pb + 0) && EN(0)) { LAUNDER();
            pg8::Gemm g{(const pg8::bf16_t*)(ws + WS_XB), (const pg8::bf16_t*)(ws + WS_WIN) + (size_t)l * INWP * D, NTOK, INWP, D};
            pg8::StaticOrder S; S.init(NTOK, INWP, G, bid);
            pg8::EpiH E{(pg8::bf16_t*)(ws + WS_H), INWP, 6, 10};
            REP(0) pg8::gemm_phase<pg8::EpiH, pg8::StaticOrder, true, true>(lds, g, S, E, tl);
            { constexpr int NFULL = (NTOK / 256) * (INWP / 256) - 2 * 256;
                if (l + 1 < DEPTH && G == 256 && bid >= NFULL) convert_peer_tables(P, ws, l + 1, 0, TAIL_ROWS, (bid - NFULL) * 8 + wl, (256 - NFULL) * 8, ll); }
            SEAM(pb + 0);
        }
        if (IN(pb + 1) && EN(1)) { LAUNDER();
            REP(1) for (int u = bid; u < 240; u += G) unit_kvstate_mfma(P, ws, lds, u, tl);
            REP(13) for (int u = bid; u < 256; u += G) unit_sgu_mfma(P, ws, l, lds, u, tl, ll, wl);
            REP(12) for (int u = bid; u < 256; u += G) unit_compress_mfma(P, ws, l, lds, u, tl);
            SEAM(pb + 1);
        }
        if (IN(pb + 2) && EN(2)) { LAUNDER();
            REP(10) for (int u = bid; u < 256; u += G) unit_retention_mfma(P, ws, l, lds, u, tl);
            REP(11) for (int u = bid; u < 512; u += G) unit_nsa(P, ws, l, lds, u, tl);
            SEAM(pb + 2);
        }
        if (IN(pb + 3) && EN(3)) { LAUNDER();
            REP(3) for (int r = bid * 8 + wl; r < NTOK; r += G * 8) row_mixnorm(P, ws, l, r, ll);
            SEAM(pb + 3);
        }
        if (IN(pb + 4) && EN(4)) { LAUNDER();
            pg8::Gemm g{(const pg8::bf16_t*)(ws + WS_MIXED), (const pg8::bf16_t*)(ws + WS_WOUT) + (size_t)l * D * D, NTOK, D, D};
            pg8::StaticOrder S; S.init(NTOK, D, G, bid);
            pg8::EpiResB E{(pg8::bf16_t*)(ws + WS_Z), (const pg8::bf16_t*)(ws + WS_XB), D, ALPHA};
            REP(4) pg8::gemm_phase<pg8::EpiResB, pg8::StaticOrder, true, true>(lds, g, S, E, tl);
            SEAM(pb + 4);
        }
        if (IN(pb + 5) && EN(5)) { LAUNDER();
            REP(5) for (int r = bid * 8 + wl; r < NTOK; r += G * 8) row_ln((const bf16*)(ws + WS_Z), P.in[16] + (size_t)l * D, P.in[17] + (size_t)l * D, (float*)(ws + WS_X1), (bf16*)(ws + WS_X1B), (unsigned*)(ws + WS_X1Q), (float*)(ws + WS_XSC), r, ll);
            SEAM(pb + 5);
        }
        if (IN(pb + 6) && EN(6)) { LAUNDER();
            pg8::Gemm g{(const pg8::bf16_t*)(ws + WS_X1B), (const pg8::bf16_t*)(ws + WS_WQ) + (size_t)l * D * D, NTOK, D, D};
            pg8::StaticOrder S; S.init(NTOK, D, G, bid);
            pg8::EpiF16 E{(unsigned short*)(ws + WS_SC), D};
            pg8::gemm_phase<pg8::EpiF16, pg8::StaticOrder, true, true>(lds, g, S, E, tl);
            SEAM(pb + 6);
        }
        if (IN(pb + 7) && EN(7)) { LAUNDER();
            REP(7) for (int u = bid; u < NTOK / 32; u += G) unit_peer(P, ws, l, lds, u, tl, ll, wl, xout);
            SEAM(pb + 7);
        }
        if (IN(pb + 8) && EN(8)) { LAUNDER();
            REP(8) phase_peer_bucket(P, ws, l, lds, bid, G, ll, wl);
            SEAM(pb + 8);
        }
        if (IN(pb + 9) && EN(9)) { LAUNDER();
            REP(9) for (int r = bid * 8 + wl; r < NTOK; r += G * 8) row_peer_reduce(P, ws, l, r, ll, xout);
            SEAM(pb + 9);
        }
    }
#undef IN
#undef SEAM
}

#ifndef MK_ONE_LAUNCH
#define MK_ONE_LAUNCH 1
#endif
extern "C" void kernel_launch(void* const* d_in, const int* in_sizes, int n_in, void* d_out, int out_size, void* d_ws, size_t ws_size, hipStream_t stream) {
    static int grid = 0;
    if (grid == 0) {
        if (n_in != 25 || out_size != NTOK * D || ws_size < WS_END) { fprintf(stderr, "kernel_launch: unexpected shapes: n_in %d out %d ws %zu (need %zu)\n", n_in, out_size, ws_size, (size_t)WS_END); grid = -1; return; }
        int dev = 0, cus = 0, per_cu = 0;
        if (hipGetDevice(&dev) != hipSuccess || hipDeviceGetAttribute(&cus, hipDeviceAttributeMultiprocessorCount, dev) != hipSuccess) { grid = -1; return; }
        if (hipFuncSetAttribute((const void*)mk_fwd, hipFuncAttributeMaxDynamicSharedMemorySize, LDS_BYTES) != hipSuccess) { fprintf(stderr, "kernel_launch: hipFuncSetAttribute failed\n"); grid = -1; return; }
        if (hipOccupancyMaxActiveBlocksPerMultiprocessor(&per_cu, (const void*)mk_fwd, 512, LDS_BYTES) != hipSuccess || per_cu < 1) fprintf(stderr, "kernel_launch: occupancy query says %d\n", per_cu);
        (void)hipGetLastError();
        if (cus != 256) fprintf(stderr, "kernel_launch: built for a 256-CU device (one workgroup per CU); this device reports %d CUs\n", cus);
        grid = 256;
    }
    if (grid < 0) return;
    (void)hipMemsetAsync((char*)d_ws + WS_CTL, 0, CTL_ZERO_BYTES, stream);
    Params p{};
    for (int i = 0; i < 25; ++i) p.in[i] = (const float*)d_in[i];
    p.out = (float*)d_out; p.ws = (unsigned char*)d_ws;
    for (int i = 0; i < 32; ++i) p.inv_rev[i] = pow(10000.0, -(double)i / 32.0) / (2.0 * 3.14159265358979323846);
    for (int h = 0; h < 4; ++h) p.lg2[h] = (float)log2(1.0 - pow(2.0, -5.0 - (double)h));
#if MK_ONE_LAUNCH
    p.ph_lo = 0; p.ph_hi = N_PHASES; p.use_bar = 1;
    hipLaunchKernelGGL(mk_fwd, dim3(grid), dim3(512), LDS_BYTES, stream, p);
#else
    for (int k = 0; k < N_PHASES; ++k) { p.ph_lo = k; p.ph_hi = k + 1; p.use_bar = 0;
        hipLaunchKernelGGL(mk_fwd, dim3(grid), dim3(512), LDS_BYTES, stream, p); }
#endif
}
```

```cpp
#include <hip/hip_runtime.h>
#include <cstdio>
#include <cstdint>
#include <cmath>
#define LAS __attribute__((address_space(3)))
namespace pg8 {
#define PG8_LAS __attribute__((address_space(3)))
typedef unsigned short bf16_t;
typedef short bf16x8 __attribute__((ext_vector_type(8)));
typedef float f32x4 __attribute__((ext_vector_type(4)));
typedef unsigned u32x4 __attribute__((ext_vector_type(4)));
constexpr int BM = 256, BK = 64, HALF = 128, HTB = HALF * BK * 2  , STAGE_BYTES = 8 * HTB, NXCD = 8, WGM = 8;

__host__ __device__ __forceinline__ int lds_byte(int r, int c) { const int st = (r >> 4) * 2 + (c >> 5), rr = r & 15, cc = c & 31, ob = rr * 64 + cc * 2; return st * 1024 + (ob ^ (((ob >> 9) & 1) << 5)); }
__host__ __device__ __forceinline__ void stage_rc(int b, int& R, int& C) { const int st = b / 1024, sb = b % 1024, swz = sb ^ (((sb >> 9) & 1) << 5); R = (st >> 1) * 16 + swz / 64; C = (st & 1) * 32 + (swz % 64) / 2; }
__host__ __device__ __forceinline__ int perm32(int rho) { const int n = rho >> 4, i = rho & 15; return 8 * (i >> 2) + 4 * n + (i & 3); }

struct Unit { int pm, pn; };
struct Gemm { const bf16_t* A; const bf16_t* Bt; int M, N, K; };

struct StaticOrder {
    int nM, nN, nwg, G, c;
    __host__ __device__ void init(int M, int N, int G_, int c_) { nM = M / BM; nN = N / BM; nwg = nM * nN; G = G_; c = c_; }
    __host__ __device__ bool next(int i, Unit& u) const {
        const long L = (long)i * G + c; if (L >= nwg) return false;
        int wgid = (int)L; { const int q = nwg / NXCD, r = nwg % NXCD, xcd = wgid % NXCD, off = wgid / NXCD; wgid = (xcd < r ? xcd * (q + 1) : r * (q + 1) + (xcd - r) * q) + off; }
        const int nig = WGM * nN, gid = wgid / nig, fm = gid * WGM, gsz = (nM - fm) < WGM ? (nM - fm) : WGM;
        u.pm = fm + ((wgid % nig) % gsz); u.pn = (wgid % nig) / gsz; return true;
    }
    __device__ __forceinline__ void a_ready(const Unit&) const {}
    __device__ __forceinline__ void done(const Unit&) const {}
};
__device__ __forceinline__ unsigned cvt_pk_bf16(float lo, float hi) { unsigned r; asm volatile("v_cvt_pk_bf16_f32 %0, %1, %2" : "=v"(r) : "v"(lo), "v"(hi)); return r; }
typedef float f32x2 __attribute__((ext_vector_type(2)));
__device__ __forceinline__ float gelu_tanh_f(float x) {
    const float u = 1.5957691216057308f * (x + 0.044715f * x * x * x);
    return x * __builtin_amdgcn_rcpf(1.0f + __expf(-u));
}
struct EpiH {
    static constexpr bool PERM = true, AFTER_DRAIN = false;
    bf16_t* O; int ldc; int act_lo, act_hi;
    __device__ __forceinline__ void operator()(const f32x4 (&acc)[2][2][4][2], const Unit& u, int wr, int wc, int fr, int fq) const {
        const int row0 = u.pm * BM + wr * 64 + fr; const int col0 = u.pn * BM + wc * 32 + 8 * fq;
        const bool act = (u.pn >= act_lo) && (u.pn < act_hi);
#pragma unroll
        for (int ai = 0; ai < 2; ++ai)
#pragma unroll
            for (int m = 0; m < 4; ++m) { bf16_t* rowp = O + (size_t)(row0 + ai * HALF + m * 16) * ldc + col0;
#pragma unroll
                for (int bj = 0; bj < 2; ++bj) { f32x4 v0 = acc[ai][bj][m][0], v1 = acc[ai][bj][m][1];
                    if (act) {
#pragma unroll
                        for (int j = 0; j < 4; ++j) { v0[j] = gelu_tanh_f(v0[j]); v1[j] = gelu_tanh_f(v1[j]); } }
                    u32x4 w; w.x = cvt_pk_bf16(v0[0], v0[1]); w.y = cvt_pk_bf16(v0[2], v0[3]); w.z = cvt_pk_bf16(v1[0], v1[1]); w.w = cvt_pk_bf16(v1[2], v1[3]);
                    *(u32x4*)(rowp + bj * HALF) = w; } }
    }
};
struct EpiRes {
    static constexpr bool PERM = false, AFTER_DRAIN = false;
    float* C; const float* X; int ldc; float alpha;
    __device__ __forceinline__ void operator()(const f32x4 (&acc)[2][2][4][2], const Unit& u, int wr, int wc, int fr, int fq) const {
        const int row0 = u.pm * BM + wr * 64 + fr, col0 = u.pn * BM + wc * 32 + 4 * fq;
#pragma unroll
        for (int ai = 0; ai < 2; ++ai)
#pragma unroll
            for (int m = 0; m < 4; ++m) { const size_t off = (size_t)(row0 + ai * HALF + m * 16) * ldc + col0;
#pragma unroll
                for (int bj = 0; bj < 2; ++bj)
#pragma unroll
                    for (int n = 0; n < 2; ++n) { const size_t o2 = off + bj * HALF + n * 16; const f32x4 xv = *(const f32x4*)(X + o2); *(f32x4*)(C + o2) = acc[ai][bj][m][n] + xv * alpha; } }
    }
};
struct EpiResB {
    static constexpr bool PERM = true, AFTER_DRAIN = false;
    bf16_t* C; const bf16_t* X; int ldc; float alpha;
    __device__ __forceinline__ void operator()(const f32x4 (&acc)[2][2][4][2], const Unit& u, int wr, int wc, int fr, int fq) const {
        const int row0 = u.pm * BM + wr * 64 + fr; const int col0 = u.pn * BM + wc * 32 + 8 * fq;
#pragma unroll
        for (int ai = 0; ai < 2; ++ai)
#pragma unroll
            for (int m = 0; m < 4; ++m) { const size_t off = (size_t)(row0 + ai * HALF + m * 16) * ldc + col0;
#pragma unroll
                for (int bj = 0; bj < 2; ++bj) { const f32x4 v0 = acc[ai][bj][m][0], v1 = acc[ai][bj][m][1]; const u32x4 xw = *(const u32x4*)(X + off + bj * HALF);
                    u32x4 w;
                    w.x = cvt_pk_bf16(v0[0] + alpha * __uint_as_float(xw.x << 16), v0[1] + alpha * __uint_as_float(xw.x & 0xffff0000u));
                    w.y = cvt_pk_bf16(v0[2] + alpha * __uint_as_float(xw.y << 16), v0[3] + alpha * __uint_as_float(xw.y & 0xffff0000u));
                    w.z = cvt_pk_bf16(v1[0] + alpha * __uint_as_float(xw.z << 16), v1[1] + alpha * __uint_as_float(xw.z & 0xffff0000u));
                    w.w = cvt_pk_bf16(v1[2] + alpha * __uint_as_float(xw.w << 16), v1[3] + alpha * __uint_as_float(xw.w & 0xffff0000u));
                    *(u32x4*)(C + off + bj * HALF) = w; } }
    }
};
typedef _Float16 f16x2_e __attribute__((ext_vector_type(2)));
typedef float f32x2_e __attribute__((ext_vector_type(2)));
__device__ __forceinline__ unsigned cvt_pk_f16(float lo, float hi) { f32x2_e v; v.x = lo; v.y = hi; return __builtin_bit_cast(unsigned, __builtin_convertvector(v, f16x2_e)); }
struct EpiF16 {
    static constexpr bool PERM = true, AFTER_DRAIN = false;
    unsigned short* C; int ldc;
    __device__ __forceinline__ void operator()(const f32x4 (&acc)[2][2][4][2], const Unit& u, int wr, int wc, int fr, int fq) const {
        const int row0 = u.pm * BM + wr * 64 + fr; const int col0 = u.pn * BM + wc * 32 + 8 * fq;
#pragma unroll
        for (int ai = 0; ai < 2; ++ai)
#pragma unroll
            for (int m = 0; m < 4; ++m) { unsigned short* rowp = C + (size_t)(row0 + ai * HALF + m * 16) * ldc + col0;
#pragma unroll
                for (int bj = 0; bj < 2; ++bj) { const f32x4 v0 = acc[ai][bj][m][0], v1 = acc[ai][bj][m][1];
                    u32x4 w; w.x = cvt_pk_f16(v0[0], v0[1]); w.y = cvt_pk_f16(v0[2], v0[3]); w.z = cvt_pk_f16(v1[0], v1[1]); w.w = cvt_pk_f16(v1[2], v1[3]);
                    *(u32x4*)(rowp + bj * HALF) = w; } }
    }
};
struct EpiF32 {
    static constexpr bool PERM = false, AFTER_DRAIN = false;
    float* C; int ldc;
    __device__ __forceinline__ void operator()(const f32x4 (&acc)[2][2][4][2], const Unit& u, int wr, int wc, int fr, int fq) const {
        const int row0 = u.pm * BM + wr * 64 + fr, col0 = u.pn * BM + wc * 32 + 4 * fq;
#pragma unroll
        for (int ai = 0; ai < 2; ++ai)
#pragma unroll
            for (int m = 0; m < 4; ++m) { float* rowp = C + (size_t)(row0 + ai * HALF + m * 16) * ldc + col0;
#pragma unroll
                for (int bj = 0; bj < 2; ++bj)
#pragma unroll
                    for (int n = 0; n < 2; ++n) *(f32x4*)(rowp + bj * HALF + n * 16) = acc[ai][bj][m][n]; }
    }
};
template <class Epi, class Sched, bool ALIGN_EPI = false, bool SP2 = false>
__device__ __forceinline__ void gemm_phase(PG8_LAS unsigned char* lds, const Gemm g, const Sched& S, const Epi& E, const int tid) {
    const int wid = __builtin_amdgcn_readfirstlane(tid >> 6), lane = tid & 63, wr = wid >> 2, wc = wid & 3, fr = lane & 15, fq = lane >> 4;
    const int K = g.K, nt = K / BK;
    unsigned voffA[2], voffB[2];
#pragma unroll
    for (int i = 0; i < 2; ++i) { int R, C; stage_rc(tid * 16 + i * 8192, R, C); const int Rb = Epi::PERM ? ((R & ~31) + perm32(R & 31)) : R;
        voffA[i] = (unsigned)(R * K + C) * 2u; voffB[i] = (unsigned)(Rb * K + C) * 2u; }
    const size_t kstep = (size_t)(BK * 2);
    const size_t hstep = (size_t)HALF * K * 2;
    const size_t tstep = 2 * hstep;
    const unsigned ldsw = (unsigned)wid * 1024u;
    const int aoff = lds_byte(wr * 64 + fr, fq * 8), boff = lds_byte(wc * 32 + fr, fq * 8);
#define PG8_SA(b, h) (((b) * 2 + (h)) * HTB)
#define PG8_SB(b, h) ((4 + (b) * 2 + (h)) * HTB)
#define PG8_STAGE(bufoff, gbase, voff) do { _Pragma("unroll") for (int _i = 0; _i < 2; ++_i) \
        __builtin_amdgcn_global_load_lds((const unsigned*)((const char*)(gbase) + (voff)[_i]), (PG8_LAS unsigned*)(lds + (bufoff) + ldsw + _i * 8192), 16, 0, 0); } while (0)
#define PG8_LDA(dst, b, h) do { _Pragma("unroll") for (int m = 0; m < 4; ++m) _Pragma("unroll") for (int k = 0; k < 2; ++k) dst[m][k] = *(const PG8_LAS bf16x8*)(lds + PG8_SA(b, h) + aoff + m * 2048 + k * 1024); } while (0)
#define PG8_LDB(dst, b, h) do { _Pragma("unroll") for (int n = 0; n < 2; ++n) _Pragma("unroll") for (int k = 0; k < 2; ++k) dst[n][k] = *(const PG8_LAS bf16x8*)(lds + PG8_SB(b, h) + boff + n * 2048 + k * 1024); } while (0)
#define PG8_MMA(ai, bj, At, Bt) do { __builtin_amdgcn_s_setprio(1); _Pragma("unroll") for (int m = 0; m < 4; ++m) _Pragma("unroll") for (int n = 0; n < 2; ++n) _Pragma("unroll") for (int k = 0; k < 2; ++k) \
        acc[ai][bj][m][n] = __builtin_amdgcn_mfma_f32_16x16x32_bf16(Bt[n][k], At[m][k], acc[ai][bj][m][n], 0, 0, 0); __builtin_amdgcn_s_setprio(0); } while (0)
#define PG8_WAIT_V(n) asm volatile("s_waitcnt vmcnt(" #n ")" ::: "memory")
#define PG8_WAIT_L(n) asm volatile("s_waitcnt lgkmcnt(" #n ")" ::: "memory")
#define PG8_BAR __builtin_amdgcn_s_barrier()
#define PG8_SCHED __builtin_amdgcn_sched_barrier(0)
    Unit cur, nxt; int ui = 0;
    if (!S.next(0, cur)) return;
    f32x4 acc[2][2][4][2];
#pragma unroll
    for (int a = 0; a < 2; ++a)
#pragma unroll
        for (int b = 0; b < 2; ++b)
#pragma unroll
            for (int m = 0; m < 4; ++m)
#pragma unroll
                for (int n = 0; n < 2; ++n) acc[a][b][m][n] = (f32x4){0.f, 0.f, 0.f, 0.f};
    bf16x8 At[4][2], B0[2][2], B1[2][2];
    const char* cA = (const char*)g.A + (size_t)cur.pm * tstep; const char* cB = (const char*)g.Bt + (size_t)cur.pn * tstep;
    S.a_ready(cur);
    if constexpr (SP2) {
        PG8_STAGE(PG8_SB(0, 0), cB, voffB); PG8_STAGE(PG8_SB(0, 1), cB + hstep, voffB); PG8_STAGE(PG8_SA(0, 0), cA, voffA); PG8_STAGE(PG8_SA(0, 1), cA + hstep, voffA);
        if (wr == 1) PG8_BAR;
        PG8_WAIT_V(2); PG8_BAR;
        PG8_STAGE(PG8_SB(1, 0), cB + kstep, voffB); PG8_STAGE(PG8_SA(1, 0), cA + kstep, voffA); PG8_STAGE(PG8_SB(1, 1), cB + hstep + kstep, voffB);
        PG8_WAIT_V(6); PG8_BAR;
    } else {
        PG8_STAGE(PG8_SB(0, 0), cB, voffB); PG8_STAGE(PG8_SA(0, 0), cA, voffA); PG8_STAGE(PG8_SB(0, 1), cB + hstep, voffB); PG8_STAGE(PG8_SA(0, 1), cA + hstep, voffA);
        if (wr == 1) PG8_BAR;
        PG8_WAIT_V(4); PG8_BAR;
        PG8_STAGE(PG8_SB(1, 0), cB + kstep, voffB); PG8_STAGE(PG8_SA(1, 0), cA + kstep, voffA); PG8_STAGE(PG8_SB(1, 1), cB + hstep + kstep, voffB);
        PG8_WAIT_V(6); PG8_BAR;
    }
    for (;;) {
        const bool has_next = S.next(ui + 1, nxt);
        const char* nA = has_next ? (const char*)g.A + (size_t)nxt.pm * tstep : cA; const char* nB = has_next ? (const char*)g.Bt + (size_t)nxt.pn * tstep : cB;
        for (int t = 0; t < nt; t += 2) {
            const bool last = (t == nt - 2);
            const char* a1 = cA + (size_t)(t + 1) * kstep;
            const char* a2 = last ? nA : cA + (size_t)(t + 2) * kstep; const char* b2 = last ? nB : cB + (size_t)(t + 2) * kstep;
            const char* a3 = a2 + kstep; const char* b3 = b2 + kstep;
            if (last && has_next) S.a_ready(nxt);
            if constexpr (SP2) {
            PG8_LDB(B0, 0, 0); PG8_LDB(B1, 0, 1); PG8_SCHED; PG8_LDA(At, 0, 0); PG8_STAGE(PG8_SA(1, 1), a1 + hstep, voffA);
            PG8_WAIT_V(8); PG8_WAIT_L(0); PG8_BAR; PG8_MMA(0, 0, At, B0); PG8_MMA(0, 1, At, B1); PG8_BAR; PG8_SCHED;
            PG8_LDA(At, 0, 1); PG8_STAGE(PG8_SB(0, 0), b2, voffB); PG8_STAGE(PG8_SB(0, 1), b2 + hstep, voffB); PG8_STAGE(PG8_SA(0, 0), a2, voffA);
            PG8_WAIT_V(8); PG8_WAIT_L(0); PG8_BAR; PG8_MMA(1, 0, At, B0); PG8_MMA(1, 1, At, B1); PG8_BAR; PG8_SCHED;
            PG8_LDB(B0, 1, 0); PG8_LDB(B1, 1, 1); PG8_SCHED; PG8_LDA(At, 1, 0); PG8_STAGE(PG8_SA(0, 1), a2 + hstep, voffA);
            PG8_WAIT_V(8); PG8_WAIT_L(0); PG8_BAR; PG8_MMA(0, 0, At, B0); PG8_MMA(0, 1, At, B1); PG8_BAR; PG8_SCHED;
            PG8_LDA(At, 1, 1); PG8_STAGE(PG8_SB(1, 0), b3, voffB); PG8_STAGE(PG8_SB(1, 1), b3 + hstep, voffB); PG8_STAGE(PG8_SA(1, 0), a3, voffA);
            PG8_WAIT_V(8); PG8_WAIT_L(0); PG8_BAR; PG8_MMA(1, 0, At, B0); PG8_MMA(1, 1, At, B1); PG8_BAR; PG8_SCHED;
            } else {
            PG8_LDB(B0, 0, 0); PG8_SCHED; PG8_LDA(At, 0, 0); PG8_STAGE(PG8_SA(1, 1), a1 + hstep, voffA);
            PG8_WAIT_L(8); PG8_BAR; PG8_WAIT_L(0); PG8_MMA(0, 0, At, B0); PG8_BAR; PG8_SCHED;
            PG8_LDB(B1, 0, 1); PG8_STAGE(PG8_SB(0, 0), b2, voffB);
            PG8_BAR; PG8_WAIT_L(0); PG8_MMA(0, 1, At, B1); PG8_BAR;
            PG8_LDA(At, 0, 1); PG8_STAGE(PG8_SA(0, 0), a2, voffA);
            PG8_BAR; PG8_WAIT_L(0); PG8_MMA(1, 0, At, B0); PG8_BAR; PG8_SCHED;
            PG8_STAGE(PG8_SB(0, 1), b2 + hstep, voffB);
            PG8_WAIT_V(6); PG8_BAR; PG8_MMA(1, 1, At, B1); PG8_BAR;
            PG8_LDB(B0, 1, 0); PG8_SCHED; PG8_LDA(At, 1, 0); PG8_STAGE(PG8_SA(0, 1), a2 + hstep, voffA);
            PG8_WAIT_L(8); PG8_BAR; PG8_WAIT_L(0); PG8_MMA(0, 0, At, B0); PG8_BAR; PG8_SCHED;
            PG8_LDB(B1, 1, 1); PG8_STAGE(PG8_SB(1, 0), b3, voffB);
            PG8_BAR; PG8_WAIT_L(0); PG8_MMA(0, 1, At, B1); PG8_BAR;
            PG8_LDA(At, 1, 1); PG8_STAGE(PG8_SA(1, 0), a3, voffA);
            PG8_BAR; PG8_WAIT_L(0); PG8_MMA(1, 0, At, B0); PG8_BAR; PG8_SCHED;
            PG8_STAGE(PG8_SB(1, 1), b3 + hstep, voffB);
            PG8_WAIT_V(6); PG8_BAR; PG8_MMA(1, 1, At, B1); PG8_BAR;
            }
        }
        if constexpr (ALIGN_EPI) { if (wr == 0) PG8_BAR; }
        if constexpr (!Epi::AFTER_DRAIN) { E(acc, cur, wr, wc, fr, fq); S.done(cur); }
        if (!has_next) break;
#pragma unroll
        for (int a = 0; a < 2; ++a)
#pragma unroll
            for (int b = 0; b < 2; ++b)
#pragma unroll
                for (int m = 0; m < 4; ++m)
#pragma unroll
                    for (int n = 0; n < 2; ++n) acc[a][b][m][n] = (f32x4){0.f, 0.f, 0.f, 0.f};
        cur = nxt; cA = nA; cB = nB; ++ui;
        if constexpr (ALIGN_EPI) { if (wr == 1) PG8_BAR; }
    }
    PG8_WAIT_V(0);
    if constexpr (!ALIGN_EPI) { if (wr == 0) PG8_BAR; }
    PG8_BAR;
    if constexpr (Epi::AFTER_DRAIN) { E.fused(acc, cur, wr, wc, fr, fq, lds, wid, lane); S.done(cur); }
#undef PG8_SA
#undef PG8_SB
#undef PG8_STAGE
#undef PG8_LDA
#undef PG8_LDB
#undef PG8_MMA
#undef PG8_WAIT_V
#undef PG8_WAIT_L
#undef PG8_BAR
#undef PG8_SCHED
}
}
#define XB_TMO      128
#define XB_XCNT(j)  (256  + 64 * (j))
#define XB_XSUB(j)  (1280 + 64 * (j))
#define XB_XGEN(j)  (2304 + 64 * (j))
#define XB_TOP      3328
#define XB_TOPGEN   3392
#define XCD_BAR_WORDS 3456
#define XB_SPIN_CAP (1u << 18)

__device__ __forceinline__ unsigned xb_ld(unsigned* p)              { return __hip_atomic_load(p, __ATOMIC_RELAXED, __HIP_MEMORY_SCOPE_AGENT); }
__device__ __forceinline__ unsigned xb_add(unsigned* p, unsigned v) { return __hip_atomic_fetch_add(p, v, __ATOMIC_RELAXED, __HIP_MEMORY_SCOPE_AGENT); }
__device__ __forceinline__ unsigned xb_xcc_id() { return (unsigned)__builtin_amdgcn_s_getreg((3 << 11) | 20) & 0xFu; }
#define XB_SPIN(cond, bar) do { unsigned _sp = 0; while (cond) { __builtin_amdgcn_s_sleep(1); \
    if ((++_sp & 255u) == 0u) { if (xb_ld(&(bar)[XB_TMO])) break; if (_sp > XB_SPIN_CAP) { atomicAdd(&(bar)[XB_TMO], 1u); break; } } } } while (0)

struct XcdBarrier {
    unsigned* bar; unsigned x; unsigned w0;
    volatile LAS unsigned* st;
};

__device__ __forceinline__ bool xb_tid0(unsigned w0) { return w0 != 0u && __builtin_amdgcn_mbcnt_hi(0xffffffffu, __builtin_amdgcn_mbcnt_lo(0xffffffffu, 0u)) == 0u; }
__device__ __forceinline__ XcdBarrier xcd_barrier_post(unsigned* bar, volatile LAS unsigned* st) {
    XcdBarrier b; b.bar = bar; b.x = xb_xcc_id(); b.st = st; b.w0 = (__builtin_amdgcn_readfirstlane(threadIdx.x >> 6) == 0) ? 1u : 0u;
    if (threadIdx.x == 0) (void)xb_add(&bar[XB_XCNT(b.x)], 1u);
    return b;
}
__device__ __forceinline__ void xcd_barrier_complete(unsigned* bar, unsigned x, unsigned& nloc, unsigned& nx) {
    const unsigned G = gridDim.x * gridDim.y * gridDim.z;
    unsigned sum, cnt, mine, sp = 0u;
    for (;;) {
        sum = 0u; cnt = 0u; mine = 0u;
#pragma unroll
        for (unsigned j = 0; j < 16; ++j) { const unsigned c = xb_ld(&bar[XB_XCNT(j)]); sum += c; cnt += (c > 0u) ? 1u : 0u; mine = (j == x) ? c : mine; }
        if (sum == G) break;
        __builtin_amdgcn_s_sleep(1);
        if ((++sp & 255u) == 0u) { if (xb_ld(&bar[XB_TMO])) break; if (sp > XB_SPIN_CAP) { atomicAdd(&bar[XB_TMO], 1u); break; } }
    }
    nloc = mine > 0u ? mine : 1u; nx = cnt > 0u ? cnt : 1u;
}

__device__ __forceinline__ void xcd_barrier(const XcdBarrier& b) {
    asm volatile("s_waitcnt vmcnt(0)" ::: "memory");
    __syncthreads();
    if (xb_tid0(b.w0)) {
        unsigned* bar = b.bar;
        __builtin_amdgcn_s_waitcnt(0);
        unsigned nloc = b.st[0], nx = b.st[1];
        if (nloc == 0u) { xcd_barrier_complete(bar, b.x, nloc, nx); b.st[0] = nloc; b.st[1] = nx; }
        const unsigned old = xb_add(&bar[XB_XSUB(b.x)], 1u);
        const unsigned gen = old / nloc;
        if (old + 1u == (gen + 1u) * nloc) {
            __builtin_amdgcn_fence(__ATOMIC_RELEASE, "agent");
            asm volatile("s_waitcnt vmcnt(0)" ::: "memory");
            const unsigned og = xb_add(&bar[XB_TOP], 1u);
            const unsigned tg = og / nx;
            if (og + 1u == (tg + 1u) * nx) xb_add(&bar[XB_TOPGEN], 1u);
            else XB_SPIN(xb_ld(&bar[XB_TOPGEN]) == tg, bar);
            __builtin_amdgcn_fence(__ATOMIC_ACQUIRE, "agent");
            xb_add(&bar[XB_XGEN(b.x)], 1u);
            asm volatile("s_waitcnt vmcnt(0)" ::: "memory");
        } else {
            XB_SPIN(xb_ld(&bar[XB_XGEN(b.x)]) == gen, bar);
            __builtin_amdgcn_fence(__ATOMIC_ACQUIRE, "agent");
            asm volatile("s_waitcnt vmcnt(0)" ::: "memory");
        }
    }
    __syncthreads();
}

#ifndef PROBE_DUP
#define PROBE_DUP -1
#endif
#define REP(i) for (int rep_ = 0; rep_ < ((PROBE_DUP == (i)) ? 2 : 1); ++rep_)
constexpr int NB = 4, T = 2048, D = 2048, NTOK = NB * T, DEPTH = 4;
constexpr int INW = 5168, INWP = 5376;
constexpr int C_RQ = 0, C_RK = 256, C_RV = 512, C_RG = 1024, C_SU = 1536, C_SV = 2048, C_NQ = 2560, C_KC = 3584, C_VC = 3840, C_KS = 4096, C_VS = 4352, C_KW = 4608, C_VW = 4864, C_NG = 5120;
constexpr float ALPHA = 1.6817928305074290f;
constexpr float LN_EPS = 1e-5f;
constexpr float LOG2E = 1.4426950408889634f;

constexpr size_t MiB = (size_t)1 << 20;
constexpr size_t WS_CTL = 0, CTL_ZERO_BYTES = 64 * 1024;
constexpr size_t WS_ROPE = 1 * MiB;
constexpr size_t WS_WIN = 2 * MiB;
constexpr size_t WS_WOUT = 86 * MiB;
constexpr size_t WS_WQ = 118 * MiB;
constexpr size_t WS_PU = 160 * MiB;
constexpr size_t WS_PV = 416 * MiB;
constexpr size_t WS_H = 672 * MiB;
constexpr size_t WS_YMIX = 756 * MiB;
constexpr size_t YB_SEL = (size_t)16 * 1024 * 1024, YB_WIN = (size_t)160 * 1024 * 1024;
constexpr size_t WS_YSG = 1108 * MiB;
constexpr size_t WS_MIXED = 820 * MiB;
constexpr size_t WS_Z = 852 * MiB;
constexpr size_t WS_X1 = 916 * MiB;
constexpr size_t WS_X1B = 980 * MiB;
constexpr size_t WS_QP = 1012 * MiB;
constexpr size_t WS_XC = 1076 * MiB;
constexpr size_t WS_XB = 1140 * MiB;
constexpr size_t WS_KC = 1172 * MiB;
constexpr size_t WS_KVST = 1174 * MiB;
constexpr size_t WS_SC = 1184 * MiB;
constexpr size_t WS_PSC = 1248 * MiB;
constexpr size_t WS_W1T = 1250 * MiB;
constexpr size_t WS_W2T = 1258 * MiB;
constexpr size_t WS_PKB = 1260 * MiB;
#ifndef PEER_NBKT
#define PEER_NBKT 8
#endif
#ifndef PEER_PG
#define PEER_PG 4
#endif
constexpr int PG = PEER_PG;
constexpr int NBKT = PEER_NBKT, NRND = NBKT / 8, FCAP = 4096, BSH = (NBKT == 16) ? 10 : 11;
constexpr size_t WS_FE = 1262 * MiB;
constexpr size_t WS_FW = 1326 * MiB;
constexpr size_t WS_FHW = 1390 * MiB;
constexpr size_t WS_GST = 1454 * MiB;
constexpr size_t WS_PART = 1456 * MiB;
constexpr size_t WS_PSCL = 1600 * MiB;
constexpr size_t WS_X1Q = 1712 * MiB;
constexpr size_t WS_XSC = 1728 * MiB;
constexpr size_t WS_END = 1730 * MiB;
constexpr int CW_BAR = 4096;
static_assert((CW_BAR + XCD_BAR_WORDS) * 4 <= (int)CTL_ZERO_BYTES, "barrier words inside the zeroed region");

constexpr int LDS_BYTES = 147456;
constexpr int MISC_OFF = 143360;

#define GAS __attribute__((address_space(1)))
typedef float f4 __attribute__((ext_vector_type(4)));
typedef float f2 __attribute__((ext_vector_type(2)));
typedef unsigned u4 __attribute__((ext_vector_type(4)));
typedef unsigned u2 __attribute__((ext_vector_type(2)));
__device__ __forceinline__ f4 mk_f4(float a, float b, float c, float d) { f4 r; r.x = a; r.y = b; r.z = c; r.w = d; return r; }
__device__ __forceinline__ f2 mk_f2(float a, float b) { f2 r; r.x = a; r.y = b; return r; }
__device__ __forceinline__ u2 mk_u2(unsigned a, unsigned b) { u2 r; r.x = a; r.y = b; return r; }
typedef unsigned short bf16;
#define LDS_WAIT() asm volatile("s_waitcnt lgkmcnt(0)" ::: "memory")
#define VM_WAIT() asm volatile("s_waitcnt vmcnt(0)" ::: "memory")

struct Params {
    const float* in[25];
    float* out;
    unsigned char* ws;
    double inv_rev[32];
    float lg2[4];
    int ph_lo, ph_hi, use_bar, pad0;
};

__device__ __forceinline__ float bf2f(unsigned short b) { return __uint_as_float(((unsigned)b) << 16); }
__device__ __forceinline__ unsigned f2bf(float f) { unsigned u = __float_as_uint(f); return (u + 0x7fffu + ((u >> 16) & 1u)) >> 16; }
typedef unsigned u2v_t __attribute__((ext_vector_type(2)));
__device__ __forceinline__ float x16_sum(float x) { const u2v_t r = __builtin_amdgcn_permlane16_swap(__float_as_uint(x), __float_as_uint(x), false, false); return __uint_as_float(r.x) + __uint_as_float(r.y); }
__device__ __forceinline__ float x32_sum(float x) { const u2v_t r = __builtin_amdgcn_permlane32_swap(__float_as_uint(x), __float_as_uint(x), false, false); return __uint_as_float(r.x) + __uint_as_float(r.y); }
__device__ __forceinline__ float x16_max(float x) { const u2v_t r = __builtin_amdgcn_permlane16_swap(__float_as_uint(x), __float_as_uint(x), false, false); return fmaxf(__uint_as_float(r.x), __uint_as_float(r.y)); }
__device__ __forceinline__ float x32_max(float x) { const u2v_t r = __builtin_amdgcn_permlane32_swap(__float_as_uint(x), __float_as_uint(x), false, false); return fmaxf(__uint_as_float(r.x), __uint_as_float(r.y)); }
__device__ __forceinline__ float wave_sum(float v) {
#pragma unroll
    for (int o = 1; o < 16; o <<= 1) v += __shfl_xor(v, o);
    return x32_sum(x16_sum(v));
}
__device__ __forceinline__ void unpack8(const u4& v, float* f) {
    f[0] = __uint_as_float(v.x << 16); f[1] = __uint_as_float(v.x & 0xffff0000u);
    f[2] = __uint_as_float(v.y << 16); f[3] = __uint_as_float(v.y & 0xffff0000u);
    f[4] = __uint_as_float(v.z << 16); f[5] = __uint_as_float(v.z & 0xffff0000u);
    f[6] = __uint_as_float(v.w << 16); f[7] = __uint_as_float(v.w & 0xffff0000u);
}
__device__ __forceinline__ float gelu_tanh(float x) { return pg8::gelu_tanh_f(x); }
typedef pg8::bf16x8 bf16x8;
typedef short s16x4 __attribute__((ext_vector_type(4)));
typedef __bf16 bf16x2_t __attribute__((ext_vector_type(2)));
__device__ __forceinline__ unsigned pkbf(float a, float b) { f2 v; v.x = a; v.y = b; return __builtin_bit_cast(unsigned, __builtin_convertvector(v, bf16x2_t)); }
__device__ __forceinline__ unsigned pk2(float lo, float hi) { return pkbf(lo, hi); }
#define MFMA16(a, b, c) __builtin_amdgcn_mfma_f32_16x16x32_bf16((a), (b), (c), 0, 0, 0)
#define DPP_F(v, ctrl) __int_as_float(__builtin_amdgcn_update_dpp(0, __float_as_int(v), (ctrl), 0xf, 0xf, true))

template <bool FRAG = false>
__device__ __forceinline__ void transpose_tile(const float* __restrict__ W, int K, int N, bf16* __restrict__ WT, LAS float* scr, int kb, int nb, int lane) {
    const int k0 = kb * 64, n0 = nb * 32, rsub = lane >> 3, c4 = (lane & 7) * 4; const bool ok = (n0 + c4) < N;
    f4 v[8];
#pragma unroll
    for (int i = 0; i < 8; ++i) v[i] = ok ? *(const f4*)(W + (size_t)(k0 + 8 * i + rsub) * N + n0 + c4) : mk_f4(0.f, 0.f, 0.f, 0.f);
#pragma unroll
    for (int i = 0; i < 8; ++i) { LAS float* d = scr + (8 * i + rsub) * 33 + c4; d[0] = v[i].x; d[1] = v[i].y; d[2] = v[i].z; d[3] = v[i].w; }
    LDS_WAIT();
    const int c = lane & 7;
#pragma unroll
    for (int j = 0; j < 4; ++j) { const int n = (lane >> 3) + 8 * j; const LAS float* s = scr + (8 * c) * 33 + n;
        u4 o; o.x = pk2(s[0 * 33], s[1 * 33]); o.y = pk2(s[2 * 33], s[3 * 33]); o.z = pk2(s[4 * 33], s[5 * 33]); o.w = pk2(s[6 * 33], s[7 * 33]);
        if (FRAG) { const int ng = n0 + n, k8 = (k0 >> 3) + c; *(u4*)(WT + ((size_t)((ng >> 4) * (K >> 5) + (k8 >> 2)) * 64 + (k8 & 3) * 16 + (ng & 15)) * 8) = o; }
        else *(u4*)(WT + (size_t)(n0 + n) * K + k0 + 8 * c) = o; }
    LDS_WAIT();
}
__device__ __forceinline__ void cvt_bf16_stream(const float* __restrict__ src, bf16* __restrict__ dst, size_t nchunks, size_t gt, size_t GT) {
    for (size_t c = gt; c < nchunks; c += GT) { const f4 a = ((const f4*)src)[2 * c], b = ((const f4*)src)[2 * c + 1];
        u4 o; o.x = pk2(a.x, a.y); o.y = pk2(a.z, a.w); o.z = pk2(b.x, b.y); o.w = pk2(b.z, b.w); ((u4*)dst)[c] = o; }
}
#ifndef PEER_TAIL_ROWS
#define PEER_TAIL_ROWS 12288
#endif
constexpr int TAIL_ROWS = PEER_TAIL_ROWS;
__device__ __forceinline__ void cpt_load(const Params& P, int layer, int r2, int lane, f4 (&v)[8]) {
    const int tab = r2 >> 14, rr = layer * 16384 + (r2 & 16383); const float* src = P.in[21 + tab] + (size_t)rr * 2048;
#pragma unroll
    for (int j = 0; j < 2; ++j)
#pragma unroll
        for (int q = 0; q < 4; ++q) v[4 * j + q] = *(const f4*)(src + 1024 * j + 16 * lane + 4 * q);
}
__device__ __forceinline__ void cpt_row(const Params& P, unsigned char* ws, int layer, int r2, int lane, const f4 (&v)[8]) {
    {
        const int tab = r2 >> 14, rr = layer * 16384 + (r2 & 16383), row = tab * (DEPTH * 16384) + rr;
        float am = 0.f, ss = 0.f;
#pragma unroll
        for (int j = 0; j < 2; ++j)
#pragma unroll
            for (int q = 0; q < 4; ++q) { const f4 a = v[4 * j + q]; am = fmaxf(am, fmaxf(fmaxf(fabsf(a.x), fabsf(a.y)), fmaxf(fabsf(a.z), fabsf(a.w)))); ss += (a.x * a.x + a.y * a.y) + (a.z * a.z + a.w * a.w); }
#pragma unroll
        for (int o = 1; o < 64; o <<= 1) am = fmaxf(am, __shfl_xor(am, o));
        unsigned char* dst = ws + (tab ? WS_PV : WS_PU) + (size_t)rr * 1024;
        if (tab) {
            const float sc = (am > 0.f) ? 6.f / am : 1.f;
            if (lane == 0) ((float*)(ws + WS_PSC))[row] = (am > 0.f) ? am * (1.f / 6.f) : 1.f;
            u4 w;
#pragma unroll
            for (int j = 0; j < 2; ++j)
#pragma unroll
                for (int h = 0; h < 2; ++h) { unsigned r = 0u; const f4 a0 = v[4 * j + 2 * h], a1 = v[4 * j + 2 * h + 1];
                    r = __builtin_amdgcn_cvt_scalef32_pk_fp4_f32(r, a0.x * sc, a0.y * sc, 1.0f, 0); r = __builtin_amdgcn_cvt_scalef32_pk_fp4_f32(r, a0.z * sc, a0.w * sc, 1.0f, 1);
                    r = __builtin_amdgcn_cvt_scalef32_pk_fp4_f32(r, a1.x * sc, a1.y * sc, 1.0f, 2); r = __builtin_amdgcn_cvt_scalef32_pk_fp4_f32(r, a1.z * sc, a1.w * sc, 1.0f, 3);
                    w[2 * j + h] = r; }
            *(u4*)(dst + 16 * lane) = w;
        } else {
            ss = wave_sum(ss);
            const float step = (ss > 0.f) ? 0.335f * sqrtf(ss * (1.f / 2048.f)) : 1.f, inv = 1.f / step;
            if (lane == 0) ((float*)(ws + WS_PSC))[row] = step * (1.f / 32.f);
            u4 w;
#pragma unroll
            for (int q = 0; q < 4; ++q) { const f4 a = v[q], c = v[4 + q];
                const int a0 = min(max((int)floorf(a.x * inv + 8.f), 0), 15), a1 = min(max((int)floorf(a.y * inv + 8.f), 0), 15), a2 = min(max((int)floorf(a.z * inv + 8.f), 0), 15), a3 = min(max((int)floorf(a.w * inv + 8.f), 0), 15);
                const int c0 = min(max((int)floorf(c.x * inv + 8.f), 0), 15), c1 = min(max((int)floorf(c.y * inv + 8.f), 0), 15), c2 = min(max((int)floorf(c.z * inv + 8.f), 0), 15), c3 = min(max((int)floorf(c.w * inv + 8.f), 0), 15);
                w[q] = (unsigned)(a0 | (((c0 - 8) & 15) << 4)) | ((unsigned)(a1 | (((c1 - 8) & 15) << 4)) << 8) | ((unsigned)(a2 | (((c2 - 8) & 15) << 4)) << 16) | ((unsigned)(a3 | (((c3 - 8) & 15) << 4)) << 24); }
            *(u4*)(dst + 16 * lane) = w;
        }
    }
}
__device__ __forceinline__ void convert_peer_tables(const Params& P, unsigned char* ws, int layer, int r_lo, int r_hi, int gw, int NGW, int lane) {
    for (int r2 = r_lo + gw; r2 < r_hi; r2 += 2 * NGW) { const bool hb = r2 + NGW < r_hi; const int rb = hb ? r2 + NGW : r2;
        f4 va[8], vb[8]; cpt_load(P, layer, r2, lane, va); cpt_load(P, layer, rb, lane, vb);
        cpt_row(P, ws, layer, r2, lane, va); if (hb) cpt_row(P, ws, layer, rb, lane, vb); }
}
__device__ __forceinline__ void unit_wprime(const Params& P, unsigned char* ws, LAS unsigned char* lds, int u, int tid) {
    const int l = u >> 6, hh = (u >> 2) & 15, cq = u & 3, h = hh >> 1, half = hh & 1;
    const float* kg = P.in[half ? 20 : 19] + ((size_t)l * 8 + h) * 16384;
    const float* wq = P.in[18] + (size_t)l * D * D;
    bf16* WT = (bf16*)(ws + WS_WQ) + (size_t)l * D * D;
    LAS bf16* Kl = (LAS bf16*)lds;
    { const int key = tid >> 2, part = tid & 3; const f4* sp = (const f4*)(kg + key * 128 + part * 32); LAS u4* dp = (LAS u4*)(Kl + key * 136 + part * 32);
#pragma unroll
        for (int j = 0; j < 4; ++j) { const f4 a = sp[2 * j], b = sp[2 * j + 1]; u4 w; w.x = pkbf(a.x, a.y); w.y = pkbf(a.z, a.w); w.z = pkbf(b.x, b.y); w.w = pkbf(b.z, b.w); dp[j] = w; } }
    __syncthreads();
    const int lane = tid & 63, wv = __builtin_amdgcn_readfirstlane(tid >> 6), c = lane & 15, kq = lane >> 4;
#pragma unroll 1
    for (int ct = 0; ct < 4; ++ct) { const int cbase = cq * 512 + wv * 64 + ct * 16;
        bf16x8 xf[4];
#pragma unroll
        for (int ks = 0; ks < 4; ++ks) { const f4* wp = (const f4*)(wq + (size_t)(cbase + c) * D + hh * 128 + 32 * ks + 8 * kq); const f4 a = wp[0], b = wp[1];
            u4 w; w.x = pkbf(a.x, a.y); w.y = pkbf(a.z, a.w); w.z = pkbf(b.x, b.y); w.w = pkbf(b.z, b.w); xf[ks] = __builtin_bit_cast(bf16x8, w); }
#pragma unroll 2
        for (int kt = 0; kt < 8; ++kt) { f4 acc = mk_f4(0.f, 0.f, 0.f, 0.f);
#pragma unroll
            for (int ks = 0; ks < 4; ++ks) acc = MFMA16(xf[ks], *(const LAS bf16x8*)(Kl + (16 * kt + c) * 136 + 32 * ks + 8 * kq), acc);
            u2 w; w.x = pkbf(acc.x, acc.y); w.y = pkbf(acc.z, acc.w);
            *(u2*)(WT + (size_t)(hh * 128 + 16 * kt + c) * D + cbase + 4 * kq) = w; } }
    __syncthreads();
}
__device__ __forceinline__ void phase_prologue(const Params& P, unsigned char* ws, LAS unsigned char* lds, int tid, int lane, int wave) {
    LAS float* scr = (LAS float*)(lds + wave * 8704);
    const int gw = blockIdx.x * 8 + wave, NGW = gridDim.x * 8;
    constexpr int I_IN = 32 * 168, I_SQ = 32 * 64, I_L = I_IN + I_SQ;
    REP(21) for (int it = gw; it < DEPTH * I_L; it += NGW) {
        const int l = it / I_L; int r = it % I_L;
        if (r < I_IN) transpose_tile(P.in[1] + (size_t)l * D * INW, D, INW, (bf16*)(ws + WS_WIN) + (size_t)l * INWP * D, scr, r / 168, r % 168, lane);
        else { r -= I_IN;
            if (r < I_SQ) transpose_tile(P.in[15] + (size_t)l * D * D, D, D, (bf16*)(ws + WS_WOUT) + (size_t)l * D * D, scr, r / 64, r % 64, lane);
            else { } }
    }
    for (int it = gw; it < DEPTH * 2 * (32 * 8 + 4 * 2); it += NGW) {
        const int lk = it / 264, r = it % 264, l = lk >> 1, kv = lk & 1;
        if (r < 256) transpose_tile<true>(P.in[kv ? 12 : 9] + (size_t)l * 2048 * 256, 2048, 256, (bf16*)(ws + WS_W1T) + (size_t)lk * 256 * 2048, scr, r >> 3, r & 7, lane);
        else transpose_tile(P.in[kv ? 13 : 10] + (size_t)l * 256 * 64, 256, 64, (bf16*)(ws + WS_W2T) + (size_t)lk * 64 * 256, scr, (r - 256) >> 1, (r - 256) & 1, lane);
    }
    const size_t gt = (size_t)blockIdx.x * 512 + tid, GT = (size_t)gridDim.x * 512;
    REP(22) { convert_peer_tables(P, ws, 0, 0, 2 * 16384, gw, NGW, lane);
        for (int ly = 1; ly < DEPTH; ++ly) convert_peer_tables(P, ws, ly, TAIL_ROWS, 2 * 16384, gw, NGW, lane); }
    cvt_bf16_stream(P.in[0], (bf16*)(ws + WS_XB), (size_t)NTOK * D / 8, gt, GT);
    f2* rope = (f2*)(ws + WS_ROPE);
    for (size_t idx = gt; idx < (size_t)T * 32; idx += GT) { const int t = (int)(idx >> 5), i = (int)(idx & 31);
        double a = (double)t * P.inv_rev[i]; a -= floor(a); const float fr = (float)a;
        rope[idx] = mk_f2(__builtin_amdgcn_cosf(fr), __builtin_amdgcn_sinf(fr)); }
    __syncthreads();
    for (int u = blockIdx.x; u < DEPTH * 64; u += gridDim.x) unit_wprime(P, ws, lds, u, tid);
}

constexpr int NS = 80;
constexpr float NSA_SC = 0.125f * LOG2E;
__device__ __forceinline__ void nsa_scores(f4 (&st)[4][2], const LAS bf16* Kl, const bf16x8 (&Yq)[2][2], int lane) {
    const int r = lane & 15, kq = lane >> 4;
#pragma unroll
    for (int kt = 0; kt < 4; ++kt) { const LAS bf16* kp = Kl + (16 * kt + r) * NS + 8 * kq;
        const bf16x8 k0 = *(const LAS bf16x8*)kp, k1 = *(const LAS bf16x8*)(kp + 32);
#pragma unroll
        for (int qp = 0; qp < 2; ++qp) { f4 a = mk_f4(0.f, 0.f, 0.f, 0.f); a = MFMA16(k0, Yq[qp][0], a); a = MFMA16(k1, Yq[qp][1], a); st[kt][qp] = a; } }
}
__device__ __forceinline__ void nsa_softmax_pv(f4 (&st)[4][2], float (&m)[2], float (&l)[2], f4 (&ot)[4][2], const LAS bf16* Vl, const int (&lo)[2], const int (&hi)[2], int mmode, int lane) {
    const int kq = lane >> 4, q = (lane & 15) >> 2, p = lane & 3;
    bf16x8 Pf[2][2];
#pragma unroll
    for (int qp = 0; qp < 2; ++qp) {
        if (mmode == 1) {
#pragma unroll
            for (int kt = 0; kt < 4; ++kt)
#pragma unroll
                for (int i = 0; i < 4; ++i) { const int kl = 16 * kt + 4 * kq + i; if (kl < lo[qp] || kl > hi[qp]) st[kt][qp][i] = -1e30f; } }
        const bool off = (mmode == 2) && (hi[qp] < 0);
        float mx = st[0][qp][0];
#pragma unroll
        for (int kt = 0; kt < 4; ++kt)
#pragma unroll
            for (int i = 0; i < 4; ++i) mx = fmaxf(mx, st[kt][qp][i]);
        mx = x32_max(x16_max(mx)); if (off) mx = -1e30f;
        const float mn = fmaxf(m[qp], mx); const float corr = __builtin_amdgcn_exp2f((m[qp] - mn) * NSA_SC); m[qp] = mn; l[qp] *= corr;
#pragma unroll
        for (int dt = 0; dt < 4; ++dt) ot[dt][qp] *= corr;
        const float msc = off ? 1e30f : mn * NSA_SC; float ps = 0.f;
#pragma unroll
        for (int kt = 0; kt < 4; ++kt)
#pragma unroll
            for (int i = 0; i < 4; ++i) { const float pv = __builtin_amdgcn_exp2f(st[kt][qp][i] * NSA_SC - msc); st[kt][qp][i] = pv; ps += pv; }
        l[qp] += ps;
#pragma unroll
        for (int ksp = 0; ksp < 2; ++ksp) { u4 w; w.x = pkbf(st[2 * ksp][qp][0], st[2 * ksp][qp][1]); w.y = pkbf(st[2 * ksp][qp][2], st[2 * ksp][qp][3]);
            w.z = pkbf(st[2 * ksp + 1][qp][0], st[2 * ksp + 1][qp][1]); w.w = pkbf(st[2 * ksp + 1][qp][2], st[2 * ksp + 1][qp][3]); Pf[qp][ksp] = __builtin_bit_cast(bf16x8, w); }
    }
#pragma unroll
    for (int dt = 0; dt < 4; ++dt)
#pragma unroll
        for (int ksp = 0; ksp < 2; ++ksp) { const LAS bf16* vp = Vl + (32 * ksp + 4 * kq + q) * NS + 16 * dt + 4 * p;
            const s16x4 va = __builtin_amdgcn_ds_read_tr16_b64_v4i16((LAS s16x4*)vp), vb = __builtin_amdgcn_ds_read_tr16_b64_v4i16((LAS s16x4*)(vp + 16 * NS));
            const bf16x8 vf = __builtin_shufflevector(va, vb, 0, 1, 2, 3, 4, 5, 6, 7);
#pragma unroll
            for (int qp = 0; qp < 2; ++qp) ot[dt][qp] = MFMA16(vf, Pf[qp][ksp], ot[dt][qp]); }
}
__device__ __forceinline__ void nsa_flush(bf16* __restrict__ y0, bf16* __restrict__ y1, const f4 (&ot)[4][2], const float (&l)[2], const float (&gate)[2], size_t boff, int kq) {
#pragma unroll
    for (int qp = 0; qp < 2; ++qp) { float lt = x32_sum(x16_sum(l[qp])); const float sc = (lt > 0.f) ? gate[qp] / lt : 0.f;
        bf16* yp = (qp ? y1 : y0) + boff + 4 * kq;
#pragma unroll
        for (int dt = 0; dt < 4; ++dt) { const f4 o = ot[dt][qp] * sc; *(u2*)(yp + 16 * dt) = mk_u2(pkbf(o.x, o.y), pkbf(o.z, o.w)); } }
}
__device__ __forceinline__ void nsa_pair_next(unsigned& rem, int& ja, int& jb) { ja = __builtin_ctz(rem); rem &= rem - 1u; if (rem) { jb = __builtin_ctz(rem); rem &= rem - 1u; } else jb = -1; }
__device__ __forceinline__ void nsa_pair_prefetch(const bf16* __restrict__ Hb, int tok0, int ja, int jb, int colK, int colV, int tid, u4 (&R)[4]) {
    const int key = tid >> 3, d8 = (tid & 7) * 8; const int j1 = jb < 0 ? ja : jb;
    const bf16* pa = Hb + (size_t)(tok0 + 64 * ja + key) * INWP + d8; const bf16* pb = Hb + (size_t)(tok0 + 64 * j1 + key) * INWP + d8;
    R[0] = *(const u4*)(pa + colK); R[1] = *(const u4*)(pa + colV); R[2] = *(const u4*)(pb + colK); R[3] = *(const u4*)(pb + colV);
}
__device__ __forceinline__ void nsa_pair_store(LAS bf16* buf, int tid, const u4 (&R)[4]) {
    LAS bf16* p = buf + (tid >> 3) * NS + (tid & 7) * 8;
    *(LAS u4*)p = R[0]; *(LAS u4*)(p + 128 * NS) = R[1]; *(LAS u4*)(p + 64 * NS) = R[2]; *(LAS u4*)(p + 192 * NS) = R[3];
}
template <int MODE>
__device__ __forceinline__ void nsa_branch(unsigned chunks, const bf16* __restrict__ Hb, int tok0, int colK, int colV, LAS bf16* buf0, LAS bf16* buf1, int tid, int lane, int qt, const int (&tq)[2], const unsigned (&mym)[2],
                                           const bf16x8 (&Yq)[2][2], f4 (&ot)[4][2], float (&m)[2], float (&l)[2]) {
    u4 R[4]; unsigned rem = chunks; int ja, jb, na = 0, nb = -1; f4 st[4][2]; int lo[2], hi[2];
    nsa_pair_next(rem, ja, jb);
    nsa_pair_prefetch(Hb, tok0, ja, jb, colK, colV, tid, R);
    __syncthreads();
    nsa_pair_store(buf0, tid, R);
    bool more = (rem != 0u);
    if (more) { nsa_pair_next(rem, na, nb); nsa_pair_prefetch(Hb, tok0, na, nb, colK, colV, tid, R); }
    __syncthreads();
    int it = 0;
#pragma unroll 1
    for (;;) {
        LAS bf16* cur = (it & 1) ? buf1 : buf0;
#pragma unroll 1
        for (int sub = 0; sub < 2; ++sub) { const int j = sub ? jb : ja;
            if (j < 0) break;
            bool anyv = false, full = true;
#pragma unroll
            for (int qp = 0; qp < 2; ++qp) {
                if (MODE == 0) { const bool sel = (mym[qp] >> j) & 1u; lo[qp] = sel ? 0 : 64; hi[qp] = sel ? ((j == qt) ? tq[qp] : 63) : -1; anyv |= sel; full &= (sel && j != qt); }
                else { lo[qp] = (j == qt - 8) ? tq[qp] + 1 : 0; hi[qp] = (j == qt) ? tq[qp] : 63; anyv = true; full &= (j != qt && j != qt - 8); } }
            if (__builtin_amdgcn_ballot_w64(anyv) != 0ull) {
                const bool need_mask = __builtin_amdgcn_ballot_w64(!full) != 0ull;
                nsa_scores(st, cur + sub * 64 * NS, Yq, lane);
                nsa_softmax_pv(st, m, l, ot, cur + 128 * NS + sub * 64 * NS, lo, hi, !need_mask ? 0 : ((MODE == 0 && j != qt) ? 2 : 1), lane); } }
        if (!more) break;
        nsa_pair_store((it & 1) ? buf0 : buf1, tid, R);
        ja = na; jb = nb; more = (rem != 0u);
        if (more) { nsa_pair_next(rem, na, nb); nsa_pair_prefetch(Hb, tok0, na, nb, colK, colV, tid, R); }
        __syncthreads(); ++it;
    }
}
__device__ __forceinline__ void unit_nsa(const Params& P, unsigned char* ws, int l_, LAS unsigned char* lds, int u, int tid) {
    const int xcd_ = u & 7, slot_ = (u >> 3) & 31, second_ = (u >> 8) & 1, bg_ = 2 * xcd_ + second_;
    const int b = bg_ >> 2, g = bg_ & 3, qt = second_ ? 31 - slot_ : slot_;
    const bf16* Hb = (const bf16*)(ws + WS_H);
    LAS bf16* buf0 = (LAS bf16*)lds;
    LAS bf16* buf1 = (LAS bf16*)(lds + 40960);
    LAS float* impG = (LAS float*)(lds + 40960);
    LAS float* impE = (LAS float*)(lds + 73728);
    LAS unsigned* selm = (LAS unsigned*)(lds + 106496);
    const int lane = tid & 63, wv = __builtin_amdgcn_readfirstlane(tid >> 6), h = wv >> 1, qh = wv & 1;
    const int c = lane & 15, kq = lane >> 4;
    const int t0 = qt * 64;
    int tq[2]; size_t tok[2];
#pragma unroll
    for (int qp = 0; qp < 2; ++qp) { tq[qp] = 32 * qh + 16 * qp + c; tok[qp] = (size_t)b * T + t0 + tq[qp]; }
    bf16x8 Yq[2][2];
#pragma unroll
    for (int qp = 0; qp < 2; ++qp)
#pragma unroll
        for (int ks = 0; ks < 2; ++ks) Yq[qp][ks] = *(const bf16x8*)(Hb + tok[qp] * INWP + C_NQ + g * 256 + h * 64 + 32 * ks + 8 * kq);
    float gate[3][2];
#pragma unroll
    for (int k = 0; k < 3; ++k)
#pragma unroll
        for (int qp = 0; qp < 2; ++qp) { const float gv = bf2f(Hb[tok[qp] * INWP + C_NG + g * 12 + h * 3 + k]); gate[k][qp] = __builtin_amdgcn_rcpf(1.f + __expf(-gv)); }
    bf16* y0 = (bf16*)(ws + WS_YMIX) + tok[0] * D + 1024 + g * 256 + h * 64; bf16* y1 = (bf16*)(ws + WS_YMIX) + tok[1] * D + 1024 + g * 256 + h * 64;
    if (tid == 0) selm[64] = 0u;
    f4 ot[4][2]; float m[2], l[2];
#pragma unroll
    for (int dt = 0; dt < 4; ++dt)
#pragma unroll
        for (int qp = 0; qp < 2; ++qp) ot[dt][qp] = mk_f4(0.f, 0.f, 0.f, 0.f);
    int cmax[2];
#pragma unroll
    for (int qp = 0; qp < 2; ++qp) { const int t = t0 + tq[qp]; cmax[qp] = (t >= 31) ? (((t - 31) >> 4) < 126 ? ((t - 31) >> 4) : 126) : -1; }
    { const bf16* KCk = (const bf16*)(ws + WS_KC) + (size_t)((0 * 4 + b) * 4 + g) * 8192; const bf16* KCv = (const bf16*)(ws + WS_KC) + (size_t)((1 * 4 + b) * 4 + g) * 8192;
        u4 kc[2], vc[2];
#pragma unroll
        for (int i = 0; i < 2; ++i) { const int idx = tid + 512 * i, key = idx >> 3, d8 = (idx & 7) * 8; kc[i] = *(const u4*)(KCk + key * 64 + d8); vc[i] = *(const u4*)(KCv + key * 64 + d8); }
        __syncthreads();
#pragma unroll
        for (int i = 0; i < 2; ++i) { const int idx = tid + 512 * i, key = idx >> 3, d8 = (idx & 7) * 8;
            *(LAS u4*)(buf0 + key * NS + d8) = kc[i]; *(LAS u4*)(buf0 + (128 + key) * NS + d8) = vc[i]; } }
    __syncthreads();
    m[0] = m[1] = -1e4f; l[0] = l[1] = 0.f;
    { f4 st[4][2]; int lo[2], hi[2];
#pragma unroll 1
        for (int cc = 0; cc < 2; ++cc) {
            if (cc * 64 * 16 + 31 > t0 + 63) break;
#pragma unroll
            for (int qp = 0; qp < 2; ++qp) { lo[qp] = 0; hi[qp] = cmax[qp] - 64 * cc; }
            nsa_scores(st, buf0 + cc * 64 * NS, Yq, lane);
            nsa_softmax_pv(st, m, l, ot, buf0 + 128 * NS + cc * 64 * NS, lo, hi, 1, lane);
        }
        { const float g2[2] = {gate[0][0], gate[0][1]}; nsa_flush(y0, y1, ot, l, g2, 0, kq); }
        float invl[2], msc[2];
#pragma unroll
        for (int qp = 0; qp < 2; ++qp) { float lt = x32_sum(x16_sum(l[qp])); invl[qp] = (lt > 0.f) ? 1.f / lt : 0.f; msc[qp] = m[qp] * NSA_SC; }
#pragma unroll 1
        for (int cc = 0; cc < 2; ++cc) {
            nsa_scores(st, buf0 + cc * 64 * NS, Yq, lane);
#pragma unroll
            for (int kt = 0; kt < 4; ++kt)
#pragma unroll
                for (int qp = 0; qp < 2; ++qp) { float pp[4];
#pragma unroll
                    for (int i = 0; i < 4; ++i) { const int ci = 64 * cc + 16 * kt + 4 * kq + i; pp[i] = (ci <= cmax[qp]) ? __builtin_amdgcn_exp2f(st[kt][qp][i] * NSA_SC - msc[qp]) * invl[qp] : 0.f; }
                    const int j = 16 * cc + 4 * kt + kq;
                    impG[(h * 32 + j) * 64 + tq[qp]] = (pp[0] + pp[1]) + (pp[2] + pp[3]);
                    if (j < 31) impE[(h * 32 + j + 1) * 64 + tq[qp]] = pp[3]; }
        } }
    __syncthreads();
    { LAS int* impS = (LAS int*)(lds + 107008);
#pragma unroll
        for (int k = 0; k < 4; ++k) { const int idx = tid + 512 * k, tqs = idx & 63, j = idx >> 6; float v;
            if (j <= qt) { const bool forced = (j == 0) || (j == qt) || (j == qt - 1);
                float s4 = (impG[(0 * 32 + j) * 64 + tqs] + impG[(1 * 32 + j) * 64 + tqs]) + (impG[(2 * 32 + j) * 64 + tqs] + impG[(3 * 32 + j) * 64 + tqs]);
                if (j > 0) s4 += (impE[(0 * 32 + j) * 64 + tqs] + impE[(1 * 32 + j) * 64 + tqs]) + (impE[(2 * 32 + j) * 64 + tqs] + impE[(3 * 32 + j) * 64 + tqs]);
                v = forced ? 1e6f : s4; }
            else v = -1e9f;
            const int bits = __float_as_int(v); const int sk = bits ^ ((bits >> 31) & 0x7fffffff);
            impS[tqs * 33 + j] = (sk & ~31) | (31 - j); }
        __syncthreads();
        if (tid < 64) { int t8[8];
#pragma unroll
            for (int k = 0; k < 8; ++k) t8[k] = (int)0x80000000;
#pragma unroll 4
            for (int j = 0; j < 32; ++j) { int x = impS[tid * 33 + j];
#pragma unroll
                for (int k = 0; k < 8; ++k) { const int hi_ = max(t8[k], x); x = min(t8[k], x); t8[k] = hi_; } }
            unsigned msk = 0u;
#pragma unroll
            for (int k = 0; k < 8; ++k) { const int jj = 31 - (t8[k] & 31); if (jj <= qt) msk |= (1u << jj); }
            selm[tid] = msk; atomicOr((unsigned*)&selm[64], msk); } }
    __syncthreads();
    unsigned mymask[2];
#pragma unroll
    for (int qp = 0; qp < 2; ++qp) mymask[qp] = selm[tq[qp]];
    const unsigned umask = selm[64];
#pragma unroll
    for (int dt = 0; dt < 4; ++dt)
#pragma unroll
        for (int qp = 0; qp < 2; ++qp) ot[dt][qp] = mk_f4(0.f, 0.f, 0.f, 0.f);
    m[0] = m[1] = -1e4f; l[0] = l[1] = 0.f;
    nsa_branch<0>(umask, Hb, b * T, C_KS + g * 64, C_VS + g * 64, buf0, buf1, tid, lane, qt, tq, mymask, Yq, ot, m, l);
    { const float g2[2] = {gate[1][0], gate[1][1]}; nsa_flush(y0, y1, ot, l, g2, YB_SEL, kq); }
#pragma unroll
    for (int dt = 0; dt < 4; ++dt)
#pragma unroll
        for (int qp = 0; qp < 2; ++qp) ot[dt][qp] = mk_f4(0.f, 0.f, 0.f, 0.f);
    m[0] = m[1] = -1e4f; l[0] = l[1] = 0.f;
    { const int jw0 = qt >= 8 ? qt - 8 : 0; const unsigned wmask = ((qt == 31) ? 0xffffffffu : ((1u << (qt + 1)) - 1u)) & ~((1u << jw0) - 1u);
        nsa_branch<1>(wmask, Hb, b * T, C_KW + g * 64, C_VW + g * 64, buf0, buf1, tid, lane, qt, tq, mymask, Yq, ot, m, l); }
    { const float g2[2] = {gate[2][0], gate[2][1]}; nsa_flush(y0, y1, ot, l, g2, YB_WIN, kq); }
    __syncthreads();
}

__device__ __forceinline__ void unit_compress_mfma(const Params& P, unsigned char* ws, int l, LAS unsigned char* lds, int u, int tid) {
    const int kv = u >> 7, b = (u >> 5) & 3, g = (u >> 3) & 3, r8 = u & 7, i0 = 16 * r8;
    const bf16* Hb = (const bf16*)(ws + WS_H);
    const bf16* W1T = (const bf16*)(ws + WS_W1T) + (size_t)(l * 2 + kv) * 256 * 2048;
    const bf16* W2T = (const bf16*)(ws + WS_W2T) + (size_t)(l * 2 + kv) * 64 * 256;
    const float* pe = P.in[kv ? 11 : 8] + (size_t)l * 2048;
    constexpr int AS = 2056;
    LAS bf16* Al = (LAS bf16*)lds;
    LAS bf16* hidL = (LAS bf16*)(lds + 16 * AS * 2);
    const int lane = tid & 63, wv = __builtin_amdgcn_readfirstlane(tid >> 6), c = lane & 15, kq = lane >> 4;
    const int col0 = (kv ? C_VC : C_KC) + g * 64;
#pragma unroll 4
    for (int it = 0; it < 8; ++it) { const int idx = tid + 512 * it; const int r = idx >> 8, pos = (idx >> 3) & 31, d8 = (idx & 7) * 8;
        int t = 16 * (i0 + r) + pos; t = t < T ? t : T - 1;
        const u4 a = *(const u4*)(Hb + (size_t)(b * T + t) * INWP + col0 + d8); float f[8]; unpack8(a, f);
        const f4 p0 = *(const f4*)(pe + pos * 64 + d8), p1 = *(const f4*)(pe + pos * 64 + d8 + 4);
        u4 w; w.x = pkbf(f[0] + p0.x, f[1] + p0.y); w.y = pkbf(f[2] + p0.z, f[3] + p0.w); w.z = pkbf(f[4] + p1.x, f[5] + p1.y); w.w = pkbf(f[6] + p1.z, f[7] + p1.w);
        *(LAS u4*)(Al + r * AS + pos * 64 + d8) = w; }
    __syncthreads();
    f4 acc[2];
#pragma unroll
    for (int nt = 0; nt < 2; ++nt) acc[nt] = mk_f4(0.f, 0.f, 0.f, 0.f);
    const bf16* wrow[2];
#pragma unroll
    for (int nt = 0; nt < 2; ++nt) wrow[nt] = W1T + (size_t)(2 * wv + nt) * 64 * 512 + lane * 8;
    const LAS bf16* arow = Al + c * AS + 8 * kq;
    const int krot = 2 * r8;
    bf16x8 xfA[2][4], xfB[2][4], xfC[2][4];
#define CMP_LOADW(XF, p2_) do { _Pragma("unroll") for (int nt = 0; nt < 2; ++nt) _Pragma("unroll") for (int ks = 0; ks < 4; ++ks) XF[nt][ks] = *(const bf16x8*)(wrow[nt] + ((((p2_) + krot) & 15) * 4 + ks) * 512); } while (0)
#define CMP_MMAW(XF, p2_) do { _Pragma("unroll") for (int ks = 0; ks < 4; ++ks) { const bf16x8 yf_ = *(const LAS bf16x8*)(arow + (((p2_) + krot) & 15) * 128 + 32 * ks); \
        _Pragma("unroll") for (int nt = 0; nt < 2; ++nt) acc[nt] = MFMA16(XF[nt][ks], yf_, acc[nt]); } } while (0)
    CMP_LOADW(xfA, 0); CMP_LOADW(xfB, 1);
#pragma unroll 1
    for (int p2 = 0; p2 < 15; p2 += 3) {
        CMP_LOADW(xfC, p2 + 2);
        CMP_MMAW(xfA, p2);
        CMP_LOADW(xfA, p2 + 3);
        CMP_MMAW(xfB, p2 + 1);
        if (p2 + 4 < 16) CMP_LOADW(xfB, p2 + 4);
        CMP_MMAW(xfC, p2 + 2);
    }
    CMP_MMAW(xfA, 15);
#undef CMP_LOADW
#undef CMP_MMAW
#pragma unroll
    for (int nt = 0; nt < 2; ++nt) { const f4 a = acc[nt]; u2 w; w.x = pkbf(gelu_tanh(a.x), gelu_tanh(a.y)); w.y = pkbf(gelu_tanh(a.z), gelu_tanh(a.w));
        *(LAS u2*)(hidL + c * 264 + 32 * wv + 16 * nt + 4 * kq) = w; }
    __syncthreads();
    if (wv < 4) { const int ot = wv; f4 o = mk_f4(0.f, 0.f, 0.f, 0.f);
        const bf16* w2p = W2T + (size_t)(16 * ot + c) * 256 + 8 * kq; const LAS bf16* hp = hidL + c * 264 + 8 * kq;
#pragma unroll
        for (int ks = 0; ks < 8; ++ks) { const bf16x8 xw = *(const bf16x8*)(w2p + 32 * ks); const bf16x8 yh = *(const LAS bf16x8*)(hp + 32 * ks); o = MFMA16(xw, yh, o); }
        const int ci = i0 + c;
        u2 w; w.x = pkbf(o.x, o.y); w.y = pkbf(o.z, o.w); if (ci > 126) { w.x = 0u; w.y = 0u; }
        *(u2*)((bf16*)(ws + WS_KC) + ((size_t)((kv * 4 + b) * 4 + g) * 128 + ci) * 64 + 16 * ot + 4 * kq) = w; }
    __syncthreads();
}

__device__ __forceinline__ void unit_retention_mfma(const Params& P, unsigned char* ws, int l, LAS unsigned char* lds, int u, int tid) {
    const int bh_ = 2 * (u & 7) + ((u >> 7) & 1), b = bh_ >> 2, h = bh_ & 3, c = (u >> 3) & 15;
    const bf16* Hb = (const bf16*)(ws + WS_H); const f2* rope = (const f2*)(ws + WS_ROPE);
    LAS bf16* Ql = (LAS bf16*)lds;
    LAS bf16* Kl = (LAS bf16*)(lds + 18432);
    LAS bf16* Vr = (LAS bf16*)(lds + 36864);
    LAS bf16* St = (LAS bf16*)(lds + 73728);
    const float lg2h = P.lg2[h];
    const int tok0 = b * T + c * 128;
    { const int m = tid >> 2, p = tid & 3;
        const f4* rp = (const f4*)(rope + (size_t)(c * 128 + m) * 32 + p * 8);
        const f4 r0 = rp[0], r1 = rp[1], r2 = rp[2], r3 = rp[3];
        const float cs[8] = {r0.x, r0.z, r1.x, r1.z, r2.x, r2.z, r3.x, r3.z}, sn[8] = {r0.y, r0.w, r1.y, r1.w, r2.y, r2.w, r3.y, r3.w};
#pragma unroll
        for (int which = 0; which < 2; ++which) { const bf16* src = Hb + (size_t)(tok0 + m) * INWP + (which ? C_RK : C_RQ) + h * 64 + p * 8;
            const u4 a = *(const u4*)src, bb = *(const u4*)(src + 32); float x1[8], x2[8]; unpack8(a, x1); unpack8(bb, x2);
            const float sc = which ? 0.125f : 1.0f; float o1[8], o2[8];
#pragma unroll
            for (int i = 0; i < 8; ++i) { o1[i] = (x1[i] * cs[i] - x2[i] * sn[i]) * sc; o2[i] = (x1[i] * sn[i] + x2[i] * cs[i]) * sc; }
            LAS bf16* dst = (which ? Kl : Ql) + m * 72 + p * 8;
            u4 w1, w2; w1.x = pkbf(o1[0], o1[1]); w1.y = pkbf(o1[2], o1[3]); w1.z = pkbf(o1[4], o1[5]); w1.w = pkbf(o1[6], o1[7]); w2.x = pkbf(o2[0], o2[1]); w2.y = pkbf(o2[2], o2[3]); w2.z = pkbf(o2[4], o2[5]); w2.w = pkbf(o2[6], o2[7]);
            *(LAS u4*)dst = w1; *(LAS u4*)(dst + 32) = w2; } }
#pragma unroll
    for (int q = 0; q < 4; ++q) { const int mr = 32 * q + (tid >> 4), pc = tid & 15;
        *(LAS u4*)(Vr + mr * 144 + pc * 8) = *(const u4*)(Hb + (size_t)(tok0 + mr) * INWP + C_RV + h * 128 + pc * 8); }
    { float a[16];
#pragma unroll
        for (int i = 0; i < 16; ++i) a[i] = 0.f;
        const float* kvb = (const float*)(ws + WS_KVST) + (size_t)((b * 4 + h) * 16) * 8192 + tid * 4;
#pragma unroll 1
        for (int j0 = 0; j0 < c; j0 += 8) {
            f4 sv[8][4]; float wj[8];
#pragma unroll
            for (int jj = 0; jj < 8; ++jj) { const int j = j0 + jj, jc = j < c ? j : c - 1; wj[jj] = j < c ? exp2f(lg2h * 128.f * (float)(c - 1 - j)) : 0.f; const f4* sp = (const f4*)(kvb + (size_t)jc * 8192);
#pragma unroll
                for (int q = 0; q < 4; ++q) sv[jj][q] = sp[512 * q]; }
#pragma unroll
            for (int jj = 0; jj < 8; ++jj)
#pragma unroll
                for (int q = 0; q < 4; ++q) { const f4 v = sv[jj][q]; const float w = wj[jj]; a[4 * q] += w * v.x; a[4 * q + 1] += w * v.y; a[4 * q + 2] += w * v.z; a[4 * q + 3] += w * v.w; } }
        const int d0 = tid >> 5, e0 = (tid & 31) * 4;
#pragma unroll
        for (int i = 0; i < 16; ++i) St[(e0 + (i & 3)) * 72 + 16 * (i >> 2) + d0] = (bf16)f2bf(a[i]); }
    __syncthreads();
    const int lane = tid & 63, wv = __builtin_amdgcn_readfirstlane(tid >> 6), cc = lane & 15, kq = lane >> 4;
    const int nn = 16 * wv + cc;
    bf16x8 yq[2];
#pragma unroll
    for (int ks = 0; ks < 2; ++ks) yq[ks] = *(const LAS bf16x8*)(Ql + nn * 72 + 32 * ks + 8 * kq);
    f4 ot[8];
#pragma unroll
    for (int et = 0; et < 8; ++et) { f4 a = mk_f4(0.f, 0.f, 0.f, 0.f); const LAS bf16* sp = St + (16 * et + cc) * 72 + 8 * kq;
        a = MFMA16(*(const LAS bf16x8*)sp, yq[0], a); a = MFMA16(*(const LAS bf16x8*)(sp + 32), yq[1], a); ot[et] = a; }
    { const float xi = exp2f(lg2h * (float)(nn + 1));
#pragma unroll
        for (int et = 0; et < 8; ++et) ot[et] *= xi; }
    const int nks = (wv >> 1) + 1;
#pragma unroll 1
    for (int ksp = 0; ksp < nks; ++ksp) { f4 st[2];
#pragma unroll
        for (int j = 0; j < 2; ++j) { const int mt = 2 * ksp + j; const LAS bf16* kp = Kl + (16 * mt + cc) * 72 + 8 * kq;
            f4 a = mk_f4(0.f, 0.f, 0.f, 0.f); a = MFMA16(*(const LAS bf16x8*)kp, yq[0], a); a = MFMA16(*(const LAS bf16x8*)(kp + 32), yq[1], a);
#pragma unroll
            for (int i = 0; i < 4; ++i) { const int mm = 16 * mt + 4 * kq + i; a[i] = (mm <= nn) ? a[i] * exp2f(lg2h * (float)(nn - mm)) : 0.f; }
            st[j] = a; }
        u4 w; w.x = pkbf(st[0].x, st[0].y); w.y = pkbf(st[0].z, st[0].w); w.z = pkbf(st[1].x, st[1].y); w.w = pkbf(st[1].z, st[1].w);
        const bf16x8 pf = __builtin_bit_cast(bf16x8, w);
#pragma unroll
        for (int et = 0; et < 8; ++et) { const LAS bf16* vp = Vr + (32 * ksp + 4 * kq + (cc >> 2)) * 144 + 16 * et + 4 * (cc & 3);
            const s16x4 va = __builtin_amdgcn_ds_read_tr16_b64_v4i16((LAS s16x4*)vp), vb = __builtin_amdgcn_ds_read_tr16_b64_v4i16((LAS s16x4*)(vp + 16 * 144));
            ot[et] = MFMA16(__builtin_shufflevector(va, vb, 0, 1, 2, 3, 4, 5, 6, 7), pf, ot[et]); }
    }
    float s1 = 0.f;
#pragma unroll
    for (int et = 0; et < 8; ++et) s1 += (ot[et].x + ot[et].y) + (ot[et].z + ot[et].w);
    s1 = x32_sum(x16_sum(s1));
    const float mu = s1 * (1.f / 128.f); float s2 = 0.f;
#pragma unroll
    for (int et = 0; et < 8; ++et) { const f4 dd = ot[et] - mu; s2 += (dd.x * dd.x + dd.y * dd.y) + (dd.z * dd.z + dd.w * dd.w); }
    s2 = x32_sum(x16_sum(s2));
    const float rstd = rsqrtf(s2 * (1.f / 128.f) + LN_EPS);
    const float* gg = P.in[2] + l * 512 + h * 128; const float* gb = P.in[3] + l * 512 + h * 128;
    const bf16* gp = Hb + (size_t)(tok0 + nn) * INWP + C_RG + h * 128;
    bf16* yo = (bf16*)(ws + WS_YMIX) + (size_t)(tok0 + nn) * D + h * 128;
#pragma unroll
    for (int et = 0; et < 8; ++et) { const int e = 16 * et + 4 * kq; const f4 g4 = *(const f4*)(gg + e), b4 = *(const f4*)(gb + e); const u2 gr = *(const u2*)(gp + e);
        const float gv[4] = {__uint_as_float(gr.x << 16), __uint_as_float(gr.x & 0xffff0000u), __uint_as_float(gr.y << 16), __uint_as_float(gr.y & 0xffff0000u)};
        f4 o;
#pragma unroll
        for (int i = 0; i < 4; ++i) { const float y = (ot[et][i] - mu) * rstd * g4[i] + b4[i]; o[i] = y * gv[i] * __builtin_amdgcn_rcpf(1.f + __expf(-gv[i])); }
        *(u2*)(yo + e) = mk_u2(pkbf(o[0], o[1]), pkbf(o[2], o[3])); }
    __syncthreads();
}

__device__ __forceinline__ bf16x8 tr_frag(const LAS bf16* p, int rowstride4) {
    const s16x4 a = __builtin_amdgcn_ds_read_tr16_b64_v4i16((LAS s16x4*)p), b = __builtin_amdgcn_ds_read_tr16_b64_v4i16((LAS s16x4*)(p + rowstride4));
    return __builtin_shufflevector(a, b, 0, 1, 2, 3, 4, 5, 6, 7);
}
__device__ __forceinline__ void unit_kvstate_mfma(const Params& P, unsigned char* ws, LAS unsigned char* lds, int u, int tid) {
    const int b = u / 60, r = u % 60, h = r / 15, j = r % 15;
    const bf16* Hb = (const bf16*)(ws + WS_H); const f2* rope = (const f2*)(ws + WS_ROPE);
    LAS bf16* Kz = (LAS bf16*)lds;
    LAS bf16* Vl = (LAS bf16*)(lds + 20480);
    const int tok0 = b * T + j * 128; const float lg2h = P.lg2[h];
    { const int m = tid >> 2, p = tid & 3;
        const f4* rp = (const f4*)(rope + (size_t)(j * 128 + m) * 32 + p * 8);
        const f4 r0 = rp[0], r1 = rp[1], r2 = rp[2], r3 = rp[3];
        const float cs[8] = {r0.x, r0.z, r1.x, r1.z, r2.x, r2.z, r3.x, r3.z}, sn[8] = {r0.y, r0.w, r1.y, r1.w, r2.y, r2.w, r3.y, r3.w};
        const bf16* src = Hb + (size_t)(tok0 + m) * INWP + C_RK + h * 64 + p * 8;
        const u4 a = *(const u4*)src, bb = *(const u4*)(src + 32); float x1[8], x2[8]; unpack8(a, x1); unpack8(bb, x2);
        const float sc = 0.125f * exp2f(lg2h * (float)(127 - m)); float o1[8], o2[8];
#pragma unroll
        for (int i = 0; i < 8; ++i) { o1[i] = (x1[i] * cs[i] - x2[i] * sn[i]) * sc; o2[i] = (x1[i] * sn[i] + x2[i] * cs[i]) * sc; }
        u4 w1, w2; w1.x = pkbf(o1[0], o1[1]); w1.y = pkbf(o1[2], o1[3]); w1.z = pkbf(o1[4], o1[5]); w1.w = pkbf(o1[6], o1[7]); w2.x = pkbf(o2[0], o2[1]); w2.y = pkbf(o2[2], o2[3]); w2.z = pkbf(o2[4], o2[5]); w2.w = pkbf(o2[6], o2[7]);
        *(LAS u4*)(Kz + m * 80 + p * 8) = w1; *(LAS u4*)(Kz + m * 80 + 32 + p * 8) = w2;
#pragma unroll
        for (int q = 0; q < 4; ++q) { const int mr = 32 * q + (tid >> 4), pc = tid & 15;
            *(LAS u4*)(Vl + mr * 144 + pc * 8) = *(const u4*)(Hb + (size_t)(tok0 + mr) * INWP + C_RV + h * 128 + pc * 8); } }
    __syncthreads();
    { const int lane = tid & 63, et = __builtin_amdgcn_readfirstlane(tid >> 6), c = lane & 15, kq = lane >> 4, q = (lane & 15) >> 2, p4 = lane & 3;
        bf16x8 yv[4];
#pragma unroll
        for (int ks = 0; ks < 4; ++ks) yv[ks] = tr_frag(Vl + (32 * ks + 8 * kq + q) * 144 + 16 * et + 4 * p4, 4 * 144);
        float* dst = (float*)(ws + WS_KVST) + (size_t)((b * 4 + h) * 16 + j) * 8192 + 16 * et + c;
#pragma unroll
        for (int dt = 0; dt < 4; ++dt) { f4 acc = mk_f4(0.f, 0.f, 0.f, 0.f);
#pragma unroll
            for (int ks = 0; ks < 4; ++ks) acc = MFMA16(tr_frag(Kz + (32 * ks + 8 * kq + q) * 80 + 16 * dt + 4 * p4, 4 * 80), yv[ks], acc);
#pragma unroll
            for (int i = 0; i < 4; ++i) dst[(16 * dt + 4 * kq + i) * 128] = acc[i]; } }
    __syncthreads();
}
__device__ __forceinline__ void unit_sgu_mfma(const Params& P, unsigned char* ws, int l, LAS unsigned char* lds, int u, int tid, int lane, int wave) {
    const int b = u >> 6, c = (u >> 2) & 15, g = u & 3;
    const bf16* Hb = (const bf16*)(ws + WS_H);
    LAS bf16* vn = (LAS bf16*)lds;
    const int tok0 = b * T + c * 128;
    const float* lng = P.in[4] + l * 512 + g * 128; const float* lnb = P.in[5] + l * 512 + g * 128;
    { const int srow = tid >> 2, part = tid & 3;
        const u4* vp = (const u4*)(Hb + (size_t)(tok0 + srow) * INWP + C_SV + g * 128 + part * 8);
        float f[32];
#pragma unroll
        for (int j = 0; j < 4; ++j) { const u4 a = vp[4 * j]; unpack8(a, f + 8 * j); }
        float s1 = 0.f;
#pragma unroll
        for (int i = 0; i < 32; ++i) s1 += f[i];
        s1 += DPP_F(s1, 0xB1); s1 += DPP_F(s1, 0x4E);
        const float mu = s1 * (1.f / 128.f); float s2 = 0.f;
#pragma unroll
        for (int i = 0; i < 32; ++i) { f[i] -= mu; s2 += f[i] * f[i]; }
        s2 += DPP_F(s2, 0xB1); s2 += DPP_F(s2, 0x4E);
        const float rstd = rsqrtf(s2 * (1.f / 128.f) + LN_EPS);
        LAS u4* dp = (LAS u4*)(vn + srow * 144 + part * 8);
#pragma unroll
        for (int j = 0; j < 4; ++j) { const f4 ga = *(const f4*)(lng + part * 8 + 32 * j), gb = *(const f4*)(lng + part * 8 + 32 * j + 4), ba = *(const f4*)(lnb + part * 8 + 32 * j), bb = *(const f4*)(lnb + part * 8 + 32 * j + 4);
            u4 w; w.x = pkbf(f[8 * j] * rstd * ga.x + ba.x, f[8 * j + 1] * rstd * ga.y + ba.y); w.y = pkbf(f[8 * j + 2] * rstd * ga.z + ba.z, f[8 * j + 3] * rstd * ga.w + ba.w);
            w.z = pkbf(f[8 * j + 4] * rstd * gb.x + bb.x, f[8 * j + 5] * rstd * gb.y + bb.y); w.w = pkbf(f[8 * j + 6] * rstd * gb.z + bb.z, f[8 * j + 7] * rstd * gb.w + bb.w);
            dp[4 * j] = w; } }
    __syncthreads();
    { const int cc = lane & 15, kq = lane >> 4, q = (lane & 15) >> 2, p4 = lane & 3, t = 16 * wave + cc, nks = (wave >> 1) + 1;
        const float* wrow = P.in[6] + ((size_t)l * 4 + g) * 16384 + (size_t)t * 128 + 8 * kq;
        bf16x8 xw[4];
#pragma unroll
        for (int ks = 0; ks < 4; ++ks) { u4 w = {0u, 0u, 0u, 0u};
            if (ks < nks) { const f4 a0 = *(const f4*)(wrow + 32 * ks), a1 = *(const f4*)(wrow + 32 * ks + 4); const int s0 = 32 * ks + 8 * kq;
                w.x = pkbf(s0 + 0 <= t ? a0.x : 0.f, s0 + 1 <= t ? a0.y : 0.f); w.y = pkbf(s0 + 2 <= t ? a0.z : 0.f, s0 + 3 <= t ? a0.w : 0.f);
                w.z = pkbf(s0 + 4 <= t ? a1.x : 0.f, s0 + 5 <= t ? a1.y : 0.f); w.w = pkbf(s0 + 6 <= t ? a1.z : 0.f, s0 + 7 <= t ? a1.w : 0.f); }
            xw[ks] = __builtin_bit_cast(bf16x8, w); }
        f4 bs4; { const float* bsp = P.in[7] + (l * 4 + g) * 128 + 16 * wave + 4 * kq; bs4 = *(const f4*)bsp; }
#pragma unroll 2
        for (int dt = 0; dt < 8; ++dt) { f4 acc = mk_f4(0.f, 0.f, 0.f, 0.f);
#pragma unroll
            for (int ks = 0; ks < 4; ++ks) if (ks < nks) acc = MFMA16(xw[ks], tr_frag(vn + (32 * ks + 8 * kq + q) * 144 + 16 * dt + 4 * p4, 4 * 144), acc);
            const int d = 16 * dt + cc;
#pragma unroll
            for (int i = 0; i < 4; ++i) { const int tt = 16 * wave + 4 * kq + i; const float uu = bf2f(Hb[(size_t)(tok0 + tt) * INWP + C_SU + g * 128 + d]);
                ((float*)(ws + WS_YSG))[(size_t)(tok0 + tt) * 512 + g * 128 + d] = uu * (acc[i] + bs4[i]); } } }
    __syncthreads();
}

__device__ __forceinline__ void row_mixnorm(const Params& P, unsigned char* ws, int l, int rowi, int lane) {
    const u2* yp = (const u2*)((const bf16*)(ws + WS_YMIX) + (size_t)rowi * D) + lane; const f4* ysg = (const f4*)((const float*)(ws + WS_YSG) + (size_t)rowi * 512) + lane;
    const f4* gp = (const f4*)(P.in[14] + (size_t)l * D) + lane;
    f4 v[8]; float ss[8];
#pragma unroll
    for (int j = 0; j < 8; ++j) { if (j == 2 || j == 3) v[j] = ysg[64 * (j - 2)]; else { const u2 w = yp[64 * j]; v[j] = mk_f4(__uint_as_float(w.x << 16), __uint_as_float(w.x & 0xffff0000u), __uint_as_float(w.y << 16), __uint_as_float(w.y & 0xffff0000u));
            if (j >= 4) { const u2 w1 = yp[64 * j + YB_SEL / 4], w2 = yp[64 * j + YB_WIN / 4];
                v[j] += mk_f4(__uint_as_float(w1.x << 16), __uint_as_float(w1.x & 0xffff0000u), __uint_as_float(w1.y << 16), __uint_as_float(w1.y & 0xffff0000u)) + mk_f4(__uint_as_float(w2.x << 16), __uint_as_float(w2.x & 0xffff0000u), __uint_as_float(w2.y << 16), __uint_as_float(w2.y & 0xffff0000u)); } }
        ss[j] = v[j].x * v[j].x + v[j].y * v[j].y + v[j].z * v[j].z + v[j].w * v[j].w; }
    const float r0 = rsqrtf(wave_sum(ss[0] + ss[1]) * (1.f / 512.f) + LN_EPS);
    const float r1 = rsqrtf(wave_sum(ss[2] + ss[3]) * (1.f / 512.f) + LN_EPS);
    const float r2 = rsqrtf(wave_sum((ss[4] + ss[5]) + (ss[6] + ss[7])) * (1.f / 1024.f) + LN_EPS);
    u2* op = (u2*)((bf16*)(ws + WS_MIXED) + (size_t)rowi * D) + lane;
#pragma unroll
    for (int j = 0; j < 8; ++j) { const float r = (j < 2) ? r0 : ((j < 4) ? r1 : r2); const f4 g4 = gp[64 * j];
        op[64 * j] = mk_u2(pk2(v[j].x * r * g4.x, v[j].y * r * g4.y), pk2(v[j].z * r * g4.z, v[j].w * r * g4.w)); }
}
__device__ __forceinline__ void row_ln(const bf16* __restrict__ zin, const float* __restrict__ gam, const float* __restrict__ bet, float* __restrict__ of32, bf16* __restrict__ obf, unsigned* __restrict__ oq, float* __restrict__ osc, int rowi, int lane) {
    const u2* zp = (const u2*)(zin + (size_t)rowi * D) + lane;
    f4 v[8]; float s = 0.f;
#pragma unroll
    for (int j = 0; j < 8; ++j) { const u2 zw = zp[64 * j]; v[j] = mk_f4(__uint_as_float(zw.x << 16), __uint_as_float(zw.x & 0xffff0000u), __uint_as_float(zw.y << 16), __uint_as_float(zw.y & 0xffff0000u)); s += (v[j].x + v[j].y) + (v[j].z + v[j].w); }
    const float mu = wave_sum(s) * (1.f / D); float s2 = 0.f;
#pragma unroll
    for (int j = 0; j < 8; ++j) { v[j].x -= mu; v[j].y -= mu; v[j].z -= mu; v[j].w -= mu; s2 += (v[j].x * v[j].x + v[j].y * v[j].y) + (v[j].z * v[j].z + v[j].w * v[j].w); }
    const float rstd = rsqrtf(wave_sum(s2) * (1.f / D) + LN_EPS);
    if (lane == 0) *(f2*)(of32 + 2 * (size_t)rowi) = mk_f2(mu, rstd);
    u2* o2 = (u2*)(obf + (size_t)rowi * D) + lane;
    const f4* gp = (const f4*)gam + lane; const f4* bp = (const f4*)bet + lane;
    float am = 0.f;
#pragma unroll
    for (int j = 0; j < 8; ++j) { const f4 g4 = gp[64 * j], b4 = bp[64 * j];
        const f4 o = mk_f4(v[j].x * rstd * g4.x + b4.x, v[j].y * rstd * g4.y + b4.y, v[j].z * rstd * g4.z + b4.z, v[j].w * rstd * g4.w + b4.w);
        o2[64 * j] = mk_u2(pk2(o.x, o.y), pk2(o.z, o.w)); v[j] = o;
        am = fmaxf(am, fmaxf(fmaxf(fabsf(o.x), fabsf(o.y)), fmaxf(fabsf(o.z), fabsf(o.w)))); }
#pragma unroll
    for (int o = 1; o < 64; o <<= 1) am = fmaxf(am, __shfl_xor(am, o));
    const float sc = (am > 0.f) ? 127.f / am : 1.f;
    if (lane == 0) osc[rowi] = (am > 0.f) ? am * (1.f / 127.f) : 1.f;
    unsigned* qp = oq + (size_t)rowi * (D / 4) + lane;
#pragma unroll
    for (int j = 0; j < 8; ++j) { const int b0 = (int)rintf(v[j].x * sc), b1 = (int)rintf(v[j].y * sc), b2 = (int)rintf(v[j].z * sc), b3 = (int)rintf(v[j].w * sc);
        qp[64 * j] = (unsigned)(b0 & 0xff) | ((unsigned)(b1 & 0xff) << 8) | ((unsigned)(b2 & 0xff) << 16) | ((unsigned)b3 << 24); }
}

__device__ __forceinline__ float dot8_bf16(const u4& w, const float* x) {
    float f[8]; unpack8(w, f);
    return ((f[0] * x[0] + f[1] * x[1]) + (f[2] * x[2] + f[3] * x[3])) + ((f[4] * x[4] + f[5] * x[5]) + (f[6] * x[6] + f[7] * x[7]));
}
__device__ __forceinline__ void ce_desc(int& a, int& b) { const int hi_ = max(a, b), lo_ = min(a, b); a = hi_; b = lo_; }
__device__ __forceinline__ void sort16_desc(int (&v)[16]) {
#pragma unroll
    for (int k = 2; k <= 16; k <<= 1)
#pragma unroll
        for (int j = k >> 1; j > 0; j >>= 1)
#pragma unroll
            for (int i = 0; i < 16; ++i) { const int l2 = i ^ j; if (l2 > i) { if ((i & k) == 0) ce_desc(v[i], v[l2]); else ce_desc(v[l2], v[i]); } }
}
__device__ __forceinline__ void merge16_desc(int (&t)[16], const int (&b)[16]) {
#pragma unroll
    for (int i = 0; i < 16; ++i) t[i] = max(t[i], b[15 - i]);
#pragma unroll
    for (int j = 8; j > 0; j >>= 1)
#pragma unroll
        for (int i = 0; i < 16; ++i) { const int l2 = i ^ j; if (l2 > i) ce_desc(t[i], t[l2]); }
}
__device__ __forceinline__ void unit_peer(const Params& P, unsigned char* ws, int l, LAS unsigned char* lds, int u, int tid_in, int lane_in, int wave, float* __restrict__ xout) {
    int tid = tid_in; asm volatile("" : "+v"(tid)); int lane = tid & 63;
    const int n0 = u * 32;
    const unsigned short* SC = (const unsigned short*)(ws + WS_SC);
    LAS int* TK = (LAS int*)lds;
    { const int tk = tid >> 4, hh = tid & 15;
        const u4* sp = (const u4*)(SC + ((size_t)(n0 + tk) * 16 + hh) * 128);
        int t[16];
#pragma unroll
        for (int k = 0; k < 16; ++k) t[k] = (int)0x80000000;
#pragma unroll 1
        for (int c8 = 0; c8 < 2; ++c8) { u4 sb[8];
#pragma unroll
            for (int i = 0; i < 8; ++i) sb[i] = sp[8 * c8 + i];
            const int ib = 127 - 64 * c8;
#pragma unroll
            for (int blk = 0; blk < 4; ++blk) { int bk[16];
#pragma unroll
                for (int e = 0; e < 8; ++e) { const unsigned w = (e < 4) ? sb[2 * blk][e & 3] : sb[2 * blk + 1][e & 3];
                    int lo_ = (int)(w << 16), hi_ = (int)(w & 0xffff0000u);
                    lo_ ^= (lo_ >> 31) & 0x7fff0000; hi_ ^= (hi_ >> 31) & 0x7fff0000;
                    bk[2 * e] = lo_ | (ib - (16 * blk + 2 * e)); bk[2 * e + 1] = hi_ | (ib - (16 * blk + 2 * e + 1)); }
                sort16_desc(bk); merge16_desc(t, bk); } }
#pragma unroll
        for (int k = 0; k < 16; ++k) TK[tid * 17 + k] = t[k]; }
    __syncthreads();
    tid = tid_in; asm volatile("" : "+v"(tid)); lane = tid & 63;
    LAS int* PE = (LAS int*)(lds + 69632);
    LAS float* PW = (LAS float*)(lds + 86016);
    if (tid < 256) { const int tk = tid >> 3, h = tid & 7; const int r1 = tk * 16 + 2 * h, r2 = r1 + 1;
        float v1[16], v2[16];
#pragma unroll
        for (int k = 0; k < 16; ++k) { const int k1 = TK[r1 * 17 + k] & 0xffff0000, k2 = TK[r2 * 17 + k] & 0xffff0000;
            v1[k] = (float)__builtin_bit_cast(_Float16, (unsigned short)((unsigned)(k1 ^ ((k1 >> 31) & 0x7fff0000)) >> 16));
            v2[k] = (float)__builtin_bit_cast(_Float16, (unsigned short)((unsigned)(k2 ^ ((k2 >> 31) & 0x7fff0000)) >> 16)); }
        int t[16];
#pragma unroll
        for (int k = 0; k < 16; ++k) t[k] = (int)0x80000000;
#pragma unroll
        for (int a = 0; a < 16; ++a)
#pragma unroll
            for (int bq = 0; bq < 16; ++bq) if ((a + 1) * (bq + 1) <= 16) { const int bits = __float_as_int(v1[a] + v2[bq]); const int sk = bits ^ ((bits >> 31) & 0x7fffffff);
                int x = (sk & ~255) | (255 - (a * 16 + bq));
#pragma unroll
                for (int k = 0; k < 16; ++k) { const int hi_ = max(t[k], x); x = min(t[k], x); t[k] = hi_; } }
        float w[16], wsum = 0.f; const int kt0 = t[0] & ~255; const float top = __int_as_float(kt0 ^ ((kt0 >> 31) & 0x7fffffff));
#pragma unroll
        for (int k = 0; k < 16; ++k) { const int kk = t[k] & ~255; const float sv = __int_as_float(kk ^ ((kk >> 31) & 0x7fffffff)); w[k] = __expf(sv - top); wsum += w[k]; }
        const float inv = 1.f / wsum;
#pragma unroll
        for (int k = 0; k < 16; ++k) { const int ab = 255 - (t[k] & 255); const int a = ab >> 4, bq = ab & 15;
            const int i1 = 127 - (TK[r1 * 17 + a] & 127), i2 = 127 - (TK[r2 * 17 + bq] & 127);
            PE[tk * 128 + h * 16 + k] = i1 * 128 + i2; PW[tk * 128 + h * 16 + k] = w[k] * inv; } }
    __syncthreads();
    tid = tid_in; asm volatile("" : "+v"(tid)); lane = tid & 63;
    { int* FE = (int*)(ws + WS_FE) + (size_t)u * 16 * FCAP; float* FW = (float*)(ws + WS_FW) + (size_t)u * 16 * FCAP; int* GST = (int*)(ws + WS_GST) + (size_t)u * 16 * 64;
        LAS int* CNT = (LAS int*)(lds + 118784);
        LAS int* STA = (LAS int*)(lds + 120832);
#pragma unroll 1
        for (int it = 0; it < 4; ++it) { const int tk = wave * 4 + it;
            const int k0 = PE[tk * 128 + lane] >> BSH, k1 = PE[tk * 128 + 64 + lane] >> BSH; int mycnt = 0;
#pragma unroll
            for (int v = 0; v < NBKT; ++v) { const int c = __builtin_popcountll(__builtin_amdgcn_ballot_w64(k0 == v)) + __builtin_popcountll(__builtin_amdgcn_ballot_w64(k1 == v)); if (lane == v) mycnt = (c + PG - 1) & ~(PG - 1); }
            if (lane < NBKT) CNT[tk * 16 + lane] = mycnt; }
        __syncthreads();
        if (tid < NBKT) { int run = 0;
#pragma unroll 1
            for (int t = 0; t < 32; ++t) { STA[t * 16 + tid] = run; run += CNT[t * 16 + tid]; }
            STA[32 * 16 + tid] = run; }
        __syncthreads();
        for (int i = tid; i < NBKT * 33; i += 512) { const int bb = i / 33, t = i % 33; GST[bb * 64 + t] = STA[t * 16 + bb]; }
#pragma unroll 1
        for (int it = 0; it < 4; ++it) { const int tk = wave * 4 + it;
            const int e0 = PE[tk * 128 + lane], e1 = PE[tk * 128 + 64 + lane]; const float w0 = PW[tk * 128 + lane], w1 = PW[tk * 128 + 64 + lane];
            const int k0 = e0 >> BSH, k1 = e1 >> BSH; int pos0 = 0, pos1 = 0;
#pragma unroll
            for (int v = 0; v < NBKT; ++v) { const unsigned long long b0 = __builtin_amdgcn_ballot_w64(k0 == v), b1 = __builtin_amdgcn_ballot_w64(k1 == v);
                const int c0 = __builtin_popcountll(b0), c = c0 + __builtin_popcountll(b1), pc = (c + PG - 1) & ~(PG - 1); const int base = STA[tk * 16 + v];
                const int r0 = (int)__builtin_amdgcn_mbcnt_hi((unsigned)(b0 >> 32), __builtin_amdgcn_mbcnt_lo((unsigned)b0, 0u));
                const int r1 = c0 + (int)__builtin_amdgcn_mbcnt_hi((unsigned)(b1 >> 32), __builtin_amdgcn_mbcnt_lo((unsigned)b1, 0u));
                if (k0 == v) pos0 = v * FCAP + base + r0;
                if (k1 == v) pos1 = v * FCAP + base + r1;
                if (lane < pc - c) { FE[v * FCAP + base + c + lane] = v << BSH; FW[v * FCAP + base + c + lane] = 0.f; } }
            FE[pos0] = e0; FW[pos0] = w0; FE[pos1] = e1; FW[pos1] = w1; } }
    __syncthreads();
}

template <bool HALFROW = false>
__device__ __forceinline__ void peer3_rows(u4 (&R)[PG][2], const unsigned char* __restrict__ TAB, int ev, int g, int lane) {
#pragma unroll
    for (int k = 0; k < PG; ++k) { const int e = __builtin_amdgcn_readlane(ev, PG * g + k);
        if (HALFROW) { R[k][0] = *(const u4*)(TAB + (size_t)(unsigned)e * 1024u + (unsigned)lane * 16u); }
        else { const unsigned char* rowp = TAB + (size_t)(unsigned)e * 2048u; R[k][0] = *(const u4*)(rowp + (unsigned)lane * 16u); R[k][1] = *(const u4*)(rowp + 1024u + (unsigned)lane * 16u); } }
}
__device__ __forceinline__ float wave_sum_dpp(float v) {
    v += DPP_F(v, 0xB1); v += DPP_F(v, 0x4E); v += DPP_F(v, 0x141); v += DPP_F(v, 0x140);
    const int iv = __float_as_int(v);
    return (__int_as_float(__builtin_amdgcn_readlane(iv, 0)) + __int_as_float(__builtin_amdgcn_readlane(iv, 16))) + (__int_as_float(__builtin_amdgcn_readlane(iv, 32)) + __int_as_float(__builtin_amdgcn_readlane(iv, 48)));
}
__device__ __forceinline__ float dot16_pk(const u4& w, const f2* x) {
    f2 a = {0.f, 0.f};
#pragma unroll
    for (int q = 0; q < 4; ++q) { const f2 lo = __builtin_amdgcn_cvt_pk_f32_fp8((int)w[q], false), hi = __builtin_amdgcn_cvt_pk_f32_fp8((int)w[q], true);
        a = __builtin_elementwise_fma(lo, x[2 * q], a); a = __builtin_elementwise_fma(hi, x[2 * q + 1], a); }
    return a.x + a.y;
}
__device__ __forceinline__ int wave_isum_dpp(int v) {
    v += __builtin_amdgcn_update_dpp(0, v, 0xB1, 0xf, 0xf, true); v += __builtin_amdgcn_update_dpp(0, v, 0x4E, 0xf, 0xf, true);
    v += __builtin_amdgcn_update_dpp(0, v, 0x141, 0xf, 0xf, true); v += __builtin_amdgcn_update_dpp(0, v, 0x140, 0xf, 0xf, true);
    return (__builtin_amdgcn_readlane(v, 0) + __builtin_amdgcn_readlane(v, 16)) + (__builtin_amdgcn_readlane(v, 32) + __builtin_amdgcn_readlane(v, 48));
}
__device__ __forceinline__ int wave_isum4_t(const int (&d)[4], int lane) {
    const bool o1 = lane & 1, o2 = lane & 2;
    int a = o1 ? d[1] : d[0], b = o1 ? d[0] : d[1], c = o1 ? d[3] : d[2], e = o1 ? d[2] : d[3];
    a += __builtin_amdgcn_update_dpp(0, b, 0xB1, 0xf, 0xf, true);
    c += __builtin_amdgcn_update_dpp(0, e, 0xB1, 0xf, 0xf, true);
    int f = o2 ? c : a, g = o2 ? a : c;
    f += __builtin_amdgcn_update_dpp(0, g, 0x4E, 0xf, 0xf, true);
    f += __builtin_amdgcn_update_dpp(0, f, 0x124, 0xf, 0xf, true);
    f += __builtin_amdgcn_update_dpp(0, f, 0x128, 0xf, 0xf, true);
    f = x32_sum(x16_sum(f));
    return f;
}
__device__ __forceinline__ void peer3_dots(const u4 (&R)[PG][2], const u4 (&xq)[2], int sx15, LAS int* redrow, int g) {
    static_assert(PG == 4, "one 16-byte LDS store per row group");
    int d[4];
#pragma unroll
    for (int k = 0; k < 4; ++k) { int a = 0, ah = 0;
#pragma unroll
        for (int q = 0; q < 4; ++q) { const unsigned w = R[k][0][q];
            a = __builtin_amdgcn_sdot4((int)(w & 0x0f0f0f0fu), (int)xq[0][q], a, false); ah = __builtin_amdgcn_sdot4((int)(w & 0xf0f0f0f0u), (int)xq[1][q], ah, false); }
        d[k] = 32 * a + 2 * ah - sx15; }
    u4 w; w.x = (unsigned)d[0]; w.y = (unsigned)d[1]; w.z = (unsigned)d[2]; w.w = (unsigned)d[3];
    *(LAS u4*)(redrow + 4 * g) = w;
}
typedef _Float16 h2 __attribute__((ext_vector_type(2)));
__device__ __forceinline__ void peer3_axpy(const u4 (&R)[PG][2], h2 (&acc)[16], int hwv, int g) {
#pragma unroll
    for (int k = 0; k < PG; ++k) { const h2 hw2 = __builtin_bit_cast(h2, __builtin_amdgcn_readlane(hwv, PG * g + k));
#pragma unroll
        for (int d = 0; d < 4; ++d) { const unsigned w = R[k][0][d];
            acc[4 * d + 0] = __builtin_elementwise_fma(__builtin_bit_cast(h2, __builtin_amdgcn_cvt_scalef32_pk_f16_fp4(w, 1.0f, 0)), hw2, acc[4 * d + 0]);
            acc[4 * d + 1] = __builtin_elementwise_fma(__builtin_bit_cast(h2, __builtin_amdgcn_cvt_scalef32_pk_f16_fp4(w, 1.0f, 1)), hw2, acc[4 * d + 1]);
            acc[4 * d + 2] = __builtin_elementwise_fma(__builtin_bit_cast(h2, __builtin_amdgcn_cvt_scalef32_pk_f16_fp4(w, 1.0f, 2)), hw2, acc[4 * d + 2]);
            acc[4 * d + 3] = __builtin_elementwise_fma(__builtin_bit_cast(h2, __builtin_amdgcn_cvt_scalef32_pk_f16_fp4(w, 1.0f, 3)), hw2, acc[4 * d + 3]); }
        __builtin_amdgcn_sched_barrier(0); }
}
__device__ __forceinline__ void unpack_row(const u4 (&X)[4], f2 (&o)[16]) {
#pragma unroll
    for (int i = 0; i < 4; ++i) { o[4 * i].x = __uint_as_float(X[i].x << 16); o[4 * i].y = __uint_as_float(X[i].x & 0xffff0000u); o[4 * i + 1].x = __uint_as_float(X[i].y << 16); o[4 * i + 1].y = __uint_as_float(X[i].y & 0xffff0000u);
        o[4 * i + 2].x = __uint_as_float(X[i].z << 16); o[4 * i + 2].y = __uint_as_float(X[i].z & 0xffff0000u); o[4 * i + 3].x = __uint_as_float(X[i].w << 16); o[4 * i + 3].y = __uint_as_float(X[i].w & 0xffff0000u); }
}
__device__ __forceinline__ float wave_max_dpp(float v) {
    v = fmaxf(v, DPP_F(v, 0xB1)); v = fmaxf(v, DPP_F(v, 0x4E)); v = fmaxf(v, DPP_F(v, 0x141)); v = fmaxf(v, DPP_F(v, 0x140));
    const int iv = __float_as_int(v);
    return fmaxf(fmaxf(__int_as_float(__builtin_amdgcn_readlane(iv, 0)), __int_as_float(__builtin_amdgcn_readlane(iv, 16))), fmaxf(__int_as_float(__builtin_amdgcn_readlane(iv, 32)), __int_as_float(__builtin_amdgcn_readlane(iv, 48))));
}
__device__ __forceinline__ void peer3_rowstore(unsigned char* __restrict__ base, float* __restrict__ scl, unsigned n, int lane, const h2 (&acch)[16], float hinv, unsigned rskew) {
    f2 acc[16]; float am = 0.f;
#pragma unroll
    for (int i = 0; i < 16; ++i) { acc[i].x = (float)acch[i].x; acc[i].y = (float)acch[i].y; am = fmaxf(am, fmaxf(fabsf(acc[i].x), fabsf(acc[i].y))); }
    am = wave_max_dpp(am);
    const float sc = (am > 0.f) ? 6.f / am : 1.f;
    if (lane == 0) scl[n] = (am > 0.f) ? am * hinv * (1.f / 6.f) : 0.f;
    u4 w;
#pragma unroll
    for (int d = 0; d < 4; ++d) { unsigned r = 0u;
        r = __builtin_amdgcn_cvt_scalef32_pk_fp4_f32(r, acc[4 * d].x * sc, acc[4 * d].y * sc, 1.0f, 0); r = __builtin_amdgcn_cvt_scalef32_pk_fp4_f32(r, acc[4 * d + 1].x * sc, acc[4 * d + 1].y * sc, 1.0f, 1);
        r = __builtin_amdgcn_cvt_scalef32_pk_fp4_f32(r, acc[4 * d + 2].x * sc, acc[4 * d + 2].y * sc, 1.0f, 2); r = __builtin_amdgcn_cvt_scalef32_pk_fp4_f32(r, acc[4 * d + 3].x * sc, acc[4 * d + 3].y * sc, 1.0f, 3);
        w[d] = r; }
    __builtin_nontemporal_store(w, (u4*)(base + ((size_t)((n + rskew) & (unsigned)(NTOK - 1)) * 1024u + (unsigned)(16 * lane))));
}
__device__ __forceinline__ int peer3_next_nonempty(int gstv, int t) {
    while (t < 32 && __builtin_amdgcn_readlane(gstv, t + 1) == __builtin_amdgcn_readlane(gstv, t)) ++t;
    return t;
}
__device__ __forceinline__ void phase_peer_bucket(const Params& P, unsigned char* ws, int l, LAS unsigned char* lds, int bid, int G, int lane, int wave) {
    LAS int* red = (LAS int*)lds + wave * (64 * 68);
    const int x = bid & 7, r = bid >> 3;
    const int u = r * 8 + wave; const unsigned nbase = (unsigned)u * 32u;
    const unsigned char* PU = ws + WS_PU + (size_t)l * 16384 * 1024; const unsigned char* PV = ws + WS_PV + (size_t)l * 16384 * 1024;
    const float* USC = (const float*)(ws + WS_PSC) + (size_t)l * 16384; const float* VSC = (const float*)(ws + WS_PSC) + (size_t)(DEPTH + l) * 16384;
    const bf16* X1B = (const bf16*)(ws + WS_X1B);
    static_assert(NRND == 1, "fp8 partials are written once: one round per workgroup");
    unsigned char* PART = ws + WS_PART + (size_t)x * NTOK * 1024; float* PSCL = (float*)(ws + WS_PSCL) + (size_t)x * NTOK;
#pragma unroll 1
    for (int rnd = 0; rnd < NRND; ++rnd) { const int xb = x + 8 * rnd;
        const int* FE = (const int*)(ws + WS_FE) + ((size_t)u * 16 + xb) * FCAP; const float* FW = (const float*)(ws + WS_FW) + ((size_t)u * 16 + xb) * FCAP; float* FHW = (float*)(ws + WS_FHW) + ((size_t)u * 16 + xb) * FCAP;
        int gstv = 0; if (lane <= 32) gstv = ((const int*)(ws + WS_GST))[((size_t)u * 16 + xb) * 64 + lane];
        const int total = __builtin_amdgcn_readlane(gstv, 32);
        float hmax = 0.f;
        REP(30) if (total > 0) {
            const unsigned char* X1Q = ws + WS_X1Q;
            float xsc_v = 0.f; if (lane < 32) xsc_v = ((const float*)(ws + WS_XSC))[nbase + lane];
            int tcur = peer3_next_nonempty(gstv, 0); int tnx = peer3_next_nonempty(gstv, tcur + 1); int tend = __builtin_amdgcn_readlane(gstv, tcur + 1);
            u4 xq[2];
            { const unsigned char* p = X1Q + (size_t)(nbase + tcur) * 2048u + (unsigned)lane * 16u; xq[0] = __builtin_nontemporal_load((const u4*)p); xq[1] = __builtin_nontemporal_load((const u4*)(p + 1024)); }
            int lt = tnx, lts = (lt < 32) ? __builtin_amdgcn_readlane(gstv, lt) : 0x7fffffff;
            float xs = __int_as_float(__builtin_amdgcn_readlane(__float_as_int(xsc_v), tcur));
            int evn = 0; float wvn = 0.f;
            if (lane < total) { evn = __builtin_nontemporal_load(FE + lane); wvn = __builtin_nontemporal_load(FW + lane); }
#define PU_SX() do { int a_ = 0, b_ = 0; _Pragma("unroll") for (int q_ = 0; q_ < 4; ++q_) { a_ = __builtin_amdgcn_sdot4((int)xq[0][q_], 0x01010101, a_, false); b_ = __builtin_amdgcn_sdot4((int)xq[1][q_], 0x01010101, b_, false); } sx15 = 240 * a_ - 16 * b_; } while (0)
            int sx15; PU_SX();
#define PU_SWITCH(R, gi) if (blk + PG * (gi) >= tend) { tcur = tnx; xq[0] = R[0][1]; xq[1] = R[1][1]; PU_SX(); xs = __int_as_float(__builtin_amdgcn_readlane(__float_as_int(xsc_v), tcur)); tend = __builtin_amdgcn_readlane(gstv, tcur + 1); \
                        tnx = peer3_next_nonempty(gstv, tcur + 1); }
#define PU_ROWS(R, gi) do { peer3_rows<true>(R, PU, ev, (gi), lane); if (blk + PG * (gi) == lts) { const unsigned char* p_ = X1Q + (size_t)(nbase + lt) * 2048u + (unsigned)lane * 16u; R[0][1] = __builtin_nontemporal_load((const u4*)p_); R[1][1] = __builtin_nontemporal_load((const u4*)(p_ + 1024)); \
                        lt = peer3_next_nonempty(gstv, lt + 1); lts = (lt < 32) ? __builtin_amdgcn_readlane(gstv, lt) : 0x7fffffff; } } while (0)
#define PU_ROWS_N(R, gi) do { peer3_rows<true>(R, PU, evn, (gi), lane); if (blk + 64 + PG * (gi) == lts) { const unsigned char* p_ = X1Q + (size_t)(nbase + lt) * 2048u + (unsigned)lane * 16u; R[0][1] = __builtin_nontemporal_load((const u4*)p_); R[1][1] = __builtin_nontemporal_load((const u4*)(p_ + 1024)); \
                        lt = peer3_next_nonempty(gstv, lt + 1); lts = (lt < 32) ? __builtin_amdgcn_readlane(gstv, lt) : 0x7fffffff; } } while (0)
#define PU_DO(R, gi) do { PU_SWITCH(R, gi) peer3_dots(R, xq, sx15, red + lane * 68, (gi)); xsv = (lane >= PG * (gi) && lane < PG * (gi) + PG) ? xs : xsv; } while (0)
            bool pre = false; u4 A[PG][2], B[PG][2], C[PG][2], Dq[PG][2];
#pragma unroll 1
            for (int blk = 0; blk < total; blk += 64) { const int blen = (total - blk) < 64 ? (total - blk) : 64, ng = blen / PG;
                const int ev = evn; const float wv = wvn;
                if (blk + 64 + lane < total) { evn = __builtin_nontemporal_load(FE + blk + 64 + lane); wvn = __builtin_nontemporal_load(FW + blk + 64 + lane); }
                const float us = USC[ev], vs = VSC[ev];
                float xsv = 0.f;
                if (ng == 16) {
                    const bool nextfull = blk + 128 <= total;
                    if (!pre) { PU_ROWS(A, 0); PU_ROWS(B, 1); PU_ROWS(C, 2); }
#pragma unroll 1
                    for (int g = 0; g < 12; g += 4) {
                        PU_ROWS(Dq, g + 3); PU_DO(A, g); PU_ROWS(A, g + 4); PU_DO(B, g + 1); PU_ROWS(B, g + 5); PU_DO(C, g + 2); PU_ROWS(C, g + 6); PU_DO(Dq, g + 3);
                    }
                    PU_ROWS(Dq, 15); PU_DO(A, 12); if (nextfull) PU_ROWS_N(A, 0); PU_DO(B, 13); if (nextfull) PU_ROWS_N(B, 1); PU_DO(C, 14); if (nextfull) PU_ROWS_N(C, 2); PU_DO(Dq, 15);
                    pre = nextfull;
                } else {
                PU_ROWS(A, 0); if (1 < ng) PU_ROWS(B, 1); if (2 < ng) PU_ROWS(C, 2);
#pragma unroll 1
                for (int g = 0; g < ng; g += 4) {
                    if (g + 3 < ng) PU_ROWS(Dq, g + 3);
                    PU_DO(A, g);
                    if (g + 4 < ng) PU_ROWS(A, g + 4);
                    if (g + 1 < ng) PU_DO(B, g + 1);
                    if (g + 5 < ng) PU_ROWS(B, g + 5);
                    if (g + 2 < ng) PU_DO(C, g + 2);
                    if (g + 6 < ng) PU_ROWS(C, g + 6);
                    if (g + 3 < ng) PU_DO(Dq, g + 3);
                } }
                int dv = 0;
                int dv1 = 0, dv2 = 0, dv3 = 0;
#pragma unroll
                for (int r_ = 0; r_ < 64; r_ += 4) { dv += red[r_ * 68 + lane]; dv1 += red[(r_ + 1) * 68 + lane]; dv2 += red[(r_ + 2) * 68 + lane]; dv3 += red[(r_ + 3) * 68 + lane]; }
                dv += dv1 + dv2 + dv3;
                if (lane < blen) { const float hwval = wv * gelu_tanh((float)dv * us * xsv) * vs; FHW[blk + lane] = hwval; hmax = fmaxf(hmax, fabsf(hwval)); }
            }
#undef PU_SWITCH
#undef PU_SX
#undef PU_ROWS
#undef PU_ROWS_N
#undef PU_DO
        }
        VM_WAIT();
        hmax = wave_max_dpp(hmax);
        const int hex_ = (__float_as_int(hmax) >> 23) & 0xff;
        const float hs = (hmax > 0.f) ? __int_as_float((251 - hex_) << 23) : 1.f, hinv = (hmax > 0.f) ? __int_as_float((hex_ + 3) << 23) : 1.f;
        REP(31) { h2 acc[16];
#pragma unroll
            for (int i = 0; i < 16; ++i) acc[i] = (h2){(_Float16)0.f, (_Float16)0.f};
#pragma unroll 1
            for (int t = 0; t < 32; ++t) if (__builtin_amdgcn_readlane(gstv, t + 1) == __builtin_amdgcn_readlane(gstv, t)) peer3_rowstore(PART, PSCL, nbase + t, lane, acc, hinv, 5u * (unsigned)x);
            if (total > 0) {
                int tcur = peer3_next_nonempty(gstv, 0); int tnx = peer3_next_nonempty(gstv, tcur + 1); int tend = __builtin_amdgcn_readlane(gstv, tcur + 1);
                int evn = 0, hwn = 0;
                if (lane < total) { evn = __builtin_nontemporal_load(FE + lane); hwn = (int)__hip_atomic_load((const unsigned*)(FHW + lane), __ATOMIC_RELAXED, __HIP_MEMORY_SCOPE_AGENT); }
#define PV_SWITCH(gi) if (blk + PG * (gi) >= tend) { peer3_rowstore(PART, PSCL, nbase + tcur, lane, acc, hinv, 5u * (unsigned)x); tcur = tnx; tend = __builtin_amdgcn_readlane(gstv, tcur + 1); \
                        _Pragma("unroll") for (int i_ = 0; i_ < 16; ++i_) acc[i_] = (h2){(_Float16)0.f, (_Float16)0.f}; tnx = peer3_next_nonempty(gstv, tcur + 1); }
#define PV_DO(R, gi) do { PV_SWITCH(gi) peer3_axpy(R, acc, hwv, (gi)); } while (0)
#pragma unroll 1
                for (int blk = 0; blk < total; blk += 64) { const int blen = (total - blk) < 64 ? (total - blk) : 64, ng = blen / PG;
                    const int ev = evn; int hwv; { const _Float16 hh = (_Float16)(__int_as_float(hwn) * hs); const unsigned hb = (unsigned)__builtin_bit_cast(unsigned short, hh); hwv = (int)(hb | (hb << 16)); }
                    if (blk + 64 + lane < total) { evn = __builtin_nontemporal_load(FE + blk + 64 + lane); hwn = (int)__hip_atomic_load((const unsigned*)(FHW + blk + 64 + lane), __ATOMIC_RELAXED, __HIP_MEMORY_SCOPE_AGENT); }
                    u4 Rb0[PG][2], Rb1[PG][2], Rb2[PG][2], Rb3[PG][2], Rb4[PG][2], Rb5[PG][2], Rb6[PG][2], Rb7[PG][2];
                    const bool pre = false;
#define PV_ROWS(R, gi) do { __builtin_amdgcn_sched_barrier(0); peer3_rows<true>(R, PV, ev, (gi), lane); __builtin_amdgcn_sched_barrier(0); } while (0)
#define PV_ROWS_N(R, gi) do { __builtin_amdgcn_sched_barrier(0); peer3_rows<true>(R, PV, evn, (gi), lane); __builtin_amdgcn_sched_barrier(0); } while (0)
                    if (ng == 16) {
                        const bool nextfull = false;
                        if (!pre) { PV_ROWS(Rb0, 0); PV_ROWS(Rb1, 1); PV_ROWS(Rb2, 2); PV_ROWS(Rb3, 3); PV_ROWS(Rb4, 4); PV_ROWS(Rb5, 5); PV_ROWS(Rb6, 6); }
                        PV_ROWS(Rb7, 7); PV_DO(Rb0, 0); PV_ROWS(Rb0, 8); PV_DO(Rb1, 1); PV_ROWS(Rb1, 9); PV_DO(Rb2, 2); PV_ROWS(Rb2, 10); PV_DO(Rb3, 3); PV_ROWS(Rb3, 11); PV_DO(Rb4, 4); PV_ROWS(Rb4, 12); PV_DO(Rb5, 5); PV_ROWS(Rb5, 13); PV_DO(Rb6, 6); PV_ROWS(Rb6, 14); PV_DO(Rb7, 7);
                        PV_ROWS(Rb7, 15); PV_DO(Rb0, 8);
                        if (nextfull) { PV_ROWS_N(Rb0, 0); PV_DO(Rb1, 9); PV_ROWS_N(Rb1, 1); PV_DO(Rb2, 10); PV_ROWS_N(Rb2, 2); PV_DO(Rb3, 11); PV_ROWS_N(Rb3, 3); PV_DO(Rb4, 12); PV_ROWS_N(Rb4, 4); PV_DO(Rb5, 13); PV_ROWS_N(Rb5, 5); PV_DO(Rb6, 14); PV_ROWS_N(Rb6, 6); PV_DO(Rb7, 15); }
                        else { PV_DO(Rb1, 9); PV_DO(Rb2, 10); PV_DO(Rb3, 11); PV_DO(Rb4, 12); PV_DO(Rb5, 13); PV_DO(Rb6, 14); PV_DO(Rb7, 15); }
                    } else {
                    PV_ROWS(Rb0, 0); if (1 < ng) PV_ROWS(Rb1, 1); if (2 < ng) PV_ROWS(Rb2, 2);
#pragma unroll 1
                    for (int g = 0; g < ng; g += 4) {
                        if (g + 3 < ng) PV_ROWS(Rb3, g + 3);
                        PV_DO(Rb0, g);
                        if (g + 4 < ng) PV_ROWS(Rb0, g + 4);
                        if (g + 1 < ng) PV_DO(Rb1, g + 1);
                        if (g + 5 < ng) PV_ROWS(Rb1, g + 5);
                        if (g + 2 < ng) PV_DO(Rb2, g + 2);
                        if (g + 6 < ng) PV_ROWS(Rb2, g + 6);
                        if (g + 3 < ng) PV_DO(Rb3, g + 3);
                    } } }
#undef PV_ROWS
#undef PV_ROWS_N
#undef PV_SWITCH
#undef PV_DO
                peer3_rowstore(PART, PSCL, nbase + tcur, lane, acc, hinv, 5u * (unsigned)x);
            } }
        VM_WAIT();
    }
}
__device__ __forceinline__ void row_peer_reduce(const Params& P, unsigned char* ws, int l, int rowi, int lane, float* __restrict__ xout) {
    const size_t n = (size_t)rowi; const bf16* Z = (const bf16*)(ws + WS_Z); const unsigned char* PARTQ = ws + WS_PART; const float* PSCL = (const float*)(ws + WS_PSCL);
    const f2 st = *(const f2*)((const float*)(ws + WS_X1) + 2 * n);
    const float* g1 = P.in[16] + (size_t)l * D; const float* b1 = P.in[17] + (size_t)l * D;
    float acc[32];
#pragma unroll
    for (int j = 0; j < 2; ++j)
#pragma unroll
        for (int q = 0; q < 4; ++q) { const int col = 1024 * j + 16 * lane + 4 * q; const u2 zw = *(const u2*)(Z + n * D + col); const f4 a = mk_f4(__uint_as_float(zw.x << 16), __uint_as_float(zw.x & 0xffff0000u), __uint_as_float(zw.y << 16), __uint_as_float(zw.y & 0xffff0000u)), gg = *(const f4*)(g1 + col), bb = *(const f4*)(b1 + col);
            acc[16 * j + 4 * q] = ALPHA * ((a.x - st.x) * st.y * gg.x + bb.x); acc[16 * j + 4 * q + 1] = ALPHA * ((a.y - st.x) * st.y * gg.y + bb.y);
            acc[16 * j + 4 * q + 2] = ALPHA * ((a.z - st.x) * st.y * gg.z + bb.z); acc[16 * j + 4 * q + 3] = ALPHA * ((a.w - st.x) * st.y * gg.w + bb.w); }
#pragma unroll 4
    for (int xb_ = 0; xb_ < 8; ++xb_) { const u4 a = *(const u4*)(PARTQ + ((size_t)xb_ * NTOK + ((n + 5u * (unsigned)xb_) & (size_t)(NTOK - 1))) * 1024u + (unsigned)(16 * lane)); const float psc = PSCL[(size_t)xb_ * NTOK + n];
#pragma unroll
        for (int d = 0; d < 4; ++d) { const f2 p0 = __builtin_amdgcn_cvt_scalef32_pk_f32_fp4(a[d], 1.0f, 0), p1 = __builtin_amdgcn_cvt_scalef32_pk_f32_fp4(a[d], 1.0f, 1), p2 = __builtin_amdgcn_cvt_scalef32_pk_f32_fp4(a[d], 1.0f, 2), p3 = __builtin_amdgcn_cvt_scalef32_pk_f32_fp4(a[d], 1.0f, 3);
            const int o = 16 * (d >> 1) + 8 * (d & 1);
            acc[o] += psc * p0.x; acc[o + 1] += psc * p0.y; acc[o + 2] += psc * p1.x; acc[o + 3] += psc * p1.y; acc[o + 4] += psc * p2.x; acc[o + 5] += psc * p2.y; acc[o + 6] += psc * p3.x; acc[o + 7] += psc * p3.y; } }
    float s = 0.f;
#pragma unroll
    for (int i = 0; i < 32; ++i) s += acc[i];
    const float mu = wave_sum(s) * (1.f / D); float s2 = 0.f;
#pragma unroll
    for (int i = 0; i < 32; ++i) { acc[i] -= mu; s2 += acc[i] * acc[i]; }
    const float rstd = rsqrtf(wave_sum(s2) * (1.f / D) + LN_EPS);
    const float* gam = P.in[23] + (size_t)l * D; const float* bet = P.in[24] + (size_t)l * D;
    bf16* xb = (bf16*)(ws + WS_XB);
#pragma unroll
    for (int j = 0; j < 2; ++j) { const int col = 1024 * j + 16 * lane; float o[16];
#pragma unroll
        for (int q = 0; q < 4; ++q) { const f4 g4 = *(const f4*)(gam + col + 4 * q), b4 = *(const f4*)(bet + col + 4 * q);
            o[4 * q] = acc[16 * j + 4 * q] * rstd * g4.x + b4.x; o[4 * q + 1] = acc[16 * j + 4 * q + 1] * rstd * g4.y + b4.y; o[4 * q + 2] = acc[16 * j + 4 * q + 2] * rstd * g4.z + b4.z; o[4 * q + 3] = acc[16 * j + 4 * q + 3] * rstd * g4.w + b4.w;
            if (xout) *(f4*)(xout + n * D + col + 4 * q) = mk_f4(o[4 * q], o[4 * q + 1], o[4 * q + 2], o[4 * q + 3]); }
        if (xout) continue;
        u4 p0, p1; p0.x = pk2(o[0], o[1]); p0.y = pk2(o[2], o[3]); p0.z = pk2(o[4], o[5]); p0.w = pk2(o[6], o[7]); p1.x = pk2(o[8], o[9]); p1.y = pk2(o[10], o[11]); p1.z = pk2(o[12], o[13]); p1.w = pk2(o[14], o[15]);
        *(u4*)(xb + n * D + col) = p0; *(u4*)(xb + n * D + col + 8) = p1; }
}

template <class T> __device__ __forceinline__ T* uniform_ptr(T* p) { const unsigned long long v = (unsigned long long)p; const unsigned lo = __builtin_amdgcn_readfirstlane((unsigned)v), hi = __builtin_amdgcn_readfirstlane((unsigned)(v >> 32)); return (T*)(__attribute__((address_space(1))) T*)(((unsigned long long)hi << 32) | lo); }
constexpr int PH_PER_LAYER = 10, N_PHASES = 1 + DEPTH * PH_PER_LAYER;
#ifndef ONLY_PHASE
#define ONLY_PHASE -1
#endif
#define EN(i) (ONLY_PHASE < 0 || ONLY_PHASE == (i))
__global__ void __launch_bounds__(512, 2) mk_fwd(Params P) {
    extern __shared__ __attribute__((aligned(16))) unsigned char lds_raw[];
    LAS unsigned char* lds = (LAS unsigned char*)lds_raw;
    volatile LAS unsigned* MISC = (volatile LAS unsigned*)(lds + MISC_OFF);
    const int tid = threadIdx.x, lane = tid & 63, wave = __builtin_amdgcn_readfirstlane(tid >> 6);
    const int G = gridDim.x, bid = blockIdx.x;
    if (tid < 64) MISC[tid] = 0u;
    __syncthreads();
    unsigned char* const ws0 = uniform_ptr(P.ws);
    unsigned* ctl = (unsigned*)(ws0 + WS_CTL);
    const XcdBarrier bar = xcd_barrier_post(ctl + CW_BAR, MISC + 8);
    const int lo = P.ph_lo, hi = P.ph_hi;
#define IN(k) (lo <= (k) && (k) < hi)
#define LAUNDER() int tl; asm volatile("v_mbcnt_lo_u32_b32 %0, -1, 0\n\tv_mbcnt_hi_u32_b32 %0, -1, %0" : "=v"(tl)); tl |= (wave << 6); __attribute__((address_space(1))) unsigned char* wsg_ = (__attribute__((address_space(1))) unsigned char*)ws0; asm volatile("" : "+s"(wsg_)); unsigned char* ws = (unsigned char*)wsg_; const int ll = tl & 63; const int wl = __builtin_amdgcn_readfirstlane(tl >> 6); (void)ll; (void)wl
#define SEAM(k) do { if (IN((k) + 1)) xcd_barrier(bar); } while (0)
    if (IN(0) && EN(20)) { LAUNDER(); REP(20) phase_prologue(P, ws, lds, tl, ll, wl); SEAM(0); }
    for (int l = 0; l < DEPTH; ++l) {
        const int pb = 1 + l * PH_PER_LAYER;
        float* xout = (l == DEPTH - 1) ? P.out : nullptr;
        if (IN(pb + 0) && EN(0)) { LAUNDER();
            pg8::Gemm g{(const pg8::bf16_t*)(ws + WS_XB), (const pg8::bf16_t*)(ws + WS_WIN) + (size_t)l * INWP * D, NTOK, INWP, D};
            pg8::StaticOrder S; S.init(NTOK, INWP, G, bid);
            pg8::EpiH E{(pg8::bf16_t*)(ws + WS_H), INWP, 6, 10};
            REP(0) pg8::gemm_phase<pg8::EpiH, pg8::StaticOrder, true, true>(lds, g, S, E, tl);
            { constexpr int NFULL = (NTOK / 256) * (INWP / 256) - 2 * 256;
                if (l + 1 < DEPTH && G == 256 && bid >= NFULL) convert_peer_tables(P, ws, l + 1, 0, TAIL_ROWS, (bid - NFULL) * 8 + wl, (256 - NFULL) * 8, ll); }
            SEAM(pb + 0);
        }
        if (IN(pb + 1) && EN(1)) { LAUNDER();
            if (bid & 1) { REP(12) for (int u = bid; u < 256; u += G) unit_compress_mfma(P, ws, l, lds, u, tl); }
            REP(1) for (int u = bid; u < 240; u += G) unit_kvstate_mfma(P, ws, lds, u, tl);
            REP(13) for (int u = bid; u < 256; u += G) unit_sgu_mfma(P, ws, l, lds, u, tl, ll, wl);
            if (!(bid & 1)) { REP(12) for (int u = bid; u < 256; u += G) unit_compress_mfma(P, ws, l, lds, u, tl); }
            SEAM(pb + 1);
        }
        if (IN(pb + 2) && EN(2)) { LAUNDER();
            REP(10) for (int u = bid; u < 256; u += G) unit_retention_mfma(P, ws, l, lds, u, tl);
            REP(11) for (int u = bid; u < 512; u += G) unit_nsa(P, ws, l, lds, u, tl);
            SEAM(pb + 2);
        }
        if (IN(pb + 3) && EN(3)) { LAUNDER();
            REP(3) for (int r = bid * 8 + wl; r < NTOK; r += G * 8) row_mixnorm(P, ws, l, r, ll);
            SEAM(pb + 3);
        }
        if (IN(pb + 4) && EN(4)) { LAUNDER();
            pg8::Gemm g{(const pg8::bf16_t*)(ws + WS_MIXED), (const pg8::bf16_t*)(ws + WS_WOUT) + (size_t)l * D * D, NTOK, D, D};
            pg8::StaticOrder S; S.init(NTOK, D, G, bid);
            pg8::EpiResB E{(pg8::bf16_t*)(ws + WS_Z), (const pg8::bf16_t*)(ws + WS_XB), D, ALPHA};
            REP(4) pg8::gemm_phase<pg8::EpiResB, pg8::StaticOrder, true, true>(lds, g, S, E, tl);
            SEAM(pb + 4);
        }
        if (IN(pb + 5) && EN(5)) { LAUNDER();
            REP(5) for (int r = bid * 8 + wl; r < NTOK; r += G * 8) row_ln((const bf16*)(ws + WS_Z), P.in[16] + (size_t)l * D, P.in[17] + (size_t)l * D, (float*)(ws + WS_X1), (bf16*)(ws + WS_X1B), (unsigned*)(ws + WS_X1Q), (float*)(ws + WS_XSC), r, ll);
            SEAM(pb + 5);
        }
        if (IN(pb + 6) && EN(6)) { LAUNDER();
            pg8::Gemm g{(const pg8::bf16_t*)(ws + WS_X1B), (const pg8::bf16_t*)(ws + WS_WQ) + (size_t)l * D * D, NTOK, D, D};
            pg8::StaticOrder S; S.init(NTOK, D, G, bid);
            pg8::EpiF16 E{(unsigned short*)(ws + WS_SC), D};
            pg8::gemm_phase<pg8::EpiF16, pg8::StaticOrder, true, true>(lds, g, S, E, tl);
            SEAM(pb + 6);
        }
        if (IN(pb + 7) && EN(7)) { LAUNDER();
            REP(7) for (int u = bid; u < NTOK / 32; u += G) unit_peer(P, ws, l, lds, u, tl, ll, wl, xout);
            SEAM(pb + 7);
        }
        if (IN(pb + 8) && EN(8)) { LAUNDER();
            REP(8) phase_peer_bucket(P, ws, l, lds, bid, G, ll, wl);
            SEAM(pb + 8);
        }
        if (IN(pb + 9) && EN(9)) { LAUNDER();
            REP(9) for (int r = bid * 8 + wl; r < NTOK; r += G * 8) row_peer_reduce(P, ws, l, r, ll, xout);
            SEAM(pb + 9);
        }
    }
#undef IN
#undef SEAM
}

#ifndef MK_ONE_LAUNCH
#define MK_ONE_LAUNCH 1
#endif
extern "C" void kernel_launch(void* const* d_in, const int* in_sizes, int n_in, void* d_out, int out_size, void* d_ws, size_t ws_size, hipStream_t stream) {
    static int grid = 0;
    if (grid == 0) {
        if (n_in != 25 || out_size != NTOK * D || ws_size < WS_END) { fprintf(stderr, "kernel_launch: unexpected shapes: n_in %d out %d ws %zu (need %zu)\n", n_in, out_size, ws_size, (size_t)WS_END); grid = -1; return; }
        int dev = 0, cus = 0, per_cu = 0;
        if (hipGetDevice(&dev) != hipSuccess || hipDeviceGetAttribute(&cus, hipDeviceAttributeMultiprocessorCount, dev) != hipSuccess) { grid = -1; return; }
        if (hipFuncSetAttribute((const void*)mk_fwd, hipFuncAttributeMaxDynamicSharedMemorySize, LDS_BYTES) != hipSuccess) { fprintf(stderr, "kernel_launch: hipFuncSetAttribute failed\n"); grid = -1; return; }
        if (hipOccupancyMaxActiveBlocksPerMultiprocessor(&per_cu, (const void*)mk_fwd, 512, LDS_BYTES) != hipSuccess || per_cu < 1) fprintf(stderr, "kernel_launch: occupancy query says %d\n", per_cu);
        (void)hipGetLastError();
        if (cus != 256) fprintf(stderr, "kernel_launch: built for a 256-CU device (one workgroup per CU); this device reports %d CUs\n", cus);
        grid = 256;
    }
    if (grid < 0) return;
    (void)hipMemsetAsync((char*)d_ws + WS_CTL, 0, CTL_ZERO_BYTES, stream);
    Params p{};
    for (int i = 0; i < 25; ++i) p.in[i] = (const float*)d_in[i];
    p.out = (float*)d_out; p.ws = (unsigned char*)d_ws;
    for (int i = 0; i < 32; ++i) p.inv_rev[i] = pow(10000.0, -(double)i / 32.0) / (2.0 * 3.14159265358979323846);
    for (int h = 0; h < 4; ++h) p.lg2[h] = (float)log2(1.0 - pow(2.0, -5.0 - (double)h));
#if MK_ONE_LAUNCH
    p.ph_lo = 0; p.ph_hi = N_PHASES; p.use_bar = 1;
    hipLaunchKernelGGL(mk_fwd, dim3(grid), dim3(512), LDS_BYTES, stream, p);
#else
    for (int k = 0; k < N_PHASES; ++k) { p.ph_lo = k; p.ph_hi = k + 1; p.use_bar = 0;
        hipLaunchKernelGGL(mk_fwd, dim3(grid), dim3(512), LDS_BYTES, stream, p); }
#endif
}
```
